# Optimizing an MI355X kernel written in HIP

```python
import math
import jax, jax.numpy as jnp
from jax import lax
import numpy as np

D_MODEL = 1024
BATCH = 2
SEQ = 8192
DEPTH = 4

N_A_LAYERS = DEPTH // 2
N_B_LAYERS = DEPTH - N_A_LAYERS
N_DENSE = (DEPTH + 1) // 2
N_MOE = DEPTH // 2

HEAD_DIM = 64
N_HEADS = D_MODEL // HEAD_DIM
LORA_DECAY = 64
LORA_ICLR = 64
LORA_VRES = 32
LORA_GATE = 160
GN_EPS = 64e-5
LN_EPS = 1e-5

MOBA_BLOCK = 256
MOBA_TOPK = 3
QUERY_CHUNK = 64

D_FF = 2816
N_EXPERTS = 8
TOP_K_EXPERTS = 2
D_FF_EXPERT = 3584

DEEPNORM_ALPHA = (2.0 * DEPTH) ** 0.25
DEEPNORM_BETA = (8.0 * DEPTH) ** -0.25

kernel_name = 'rwkv7_moba_yoco_deepnorm_moe'


def _heads(t):
    return t.reshape(t.shape[0], t.shape[1], N_HEADS, HEAD_DIM)


def layer_norm(x, g, b):
    xf = x.astype(jnp.float32)
    mu = jnp.mean(xf, axis=-1, keepdims=True)
    var = jnp.mean(jnp.square(xf - mu), axis=-1, keepdims=True)
    y = (xf - mu) * lax.rsqrt(var + LN_EPS)
    return (y * g + b).astype(x.dtype)


def deepnorm_residual(x, sub, g, b):
    return layer_norm(DEEPNORM_ALPHA * x + sub, g, b)


def wkv7_scan(r, decay, k, v, a, b):
    bsz, T, H, N = r.shape
    xs = tuple(jnp.moveaxis(t.astype(jnp.float32), 1, 0) for t in (r, decay, k, v, a, b))

    def step(S, inp):
        r_t, w_t, k_t, v_t, a_t, b_t = inp
        sa = jnp.einsum('bhvk,bhk->bhv', S, a_t)
        S = (S * w_t[:, :, None, :] + sa[..., None] * b_t[:, :, None, :]
             + v_t[..., None] * k_t[:, :, None, :])
        return S, jnp.einsum('bhvk,bhk->bhv', S, r_t)

    S0 = jnp.zeros((bsz, H, N, N), jnp.float32)
    _, y = lax.scan(step, S0, xs)
    return jnp.moveaxis(y, 0, 1)


def rwkv7_time_mix(x, v_first, mu, w_rkv, w_out, decay_w0, decay_w1, decay_w2,
                   iclr_a0, iclr_a1, iclr_a2, vres_v0, vres_v1, vres_v2,
                   gate_g1, gate_g2, k_k, k_a, r_k, gn_g, gn_b):
    bsz, T, D = x.shape
    x_prev = jnp.pad(x[:, :-1], ((0, 0), (1, 0), (0, 0)))
    xx = x_prev - x
    xm = x[None] + xx[None] * mu[:, None, None, :]
    rkv = jnp.einsum('cbtd,cde->cbte', xm[:3], w_rkv)
    r, k, v = rkv[0], rkv[1], rkv[2]
    xw, xa, xg = xm[3], xm[4], xm[5]
    w = -jax.nn.softplus(-(decay_w0 + jnp.tanh(xw @ decay_w1) @ decay_w2)) - 0.5
    if vres_v0 is None:
        v_first = v
    else:
        v = v + (v_first - v) * jax.nn.sigmoid(vres_v0 + (xm[2] @ vres_v1) @ vres_v2)
    a = jax.nn.sigmoid(iclr_a0 + (xa @ iclr_a1) @ iclr_a2)
    g = jax.nn.sigmoid(xg @ gate_g1) @ gate_g2
    kk = _heads((k * k_k).astype(jnp.float32))
    kk = kk * lax.rsqrt(jnp.maximum(jnp.sum(kk * kk, axis=-1, keepdims=True), 1e-24))
    k = k * (1 + (a - 1) * k_a)
    decay = jnp.exp(-jnp.exp(w.astype(jnp.float32)))
    a_h = _heads(a.astype(jnp.float32))
    y = wkv7_scan(_heads(r), _heads(decay), _heads(k), _heads(v), -kk, kk * a_h)
    mean = jnp.mean(y, axis=-1, keepdims=True)
    var = jnp.mean(jnp.square(y - mean), axis=-1, keepdims=True)
    y = ((y - mean) * lax.rsqrt(var + GN_EPS)).reshape(bsz, T, D) * gn_g + gn_b
    bonus = jnp.sum(_heads(r) * _heads(k) * r_k, axis=-1, keepdims=True) * _heads(v)
    y = y + bonus.reshape(bsz, T, D)
    out = (y * g) @ w_out
    return out.astype(x.dtype), v_first


def moba_shared_kv(h, w_k, w_v):
    bsz, T, D = h.shape
    nb = -(-T // MOBA_BLOCK)
    pad = nb * MOBA_BLOCK - T

    def blocks(t):
        t = _heads(t).transpose(0, 2, 1, 3)
        t = jnp.pad(t, ((0, 0), (0, 0), (0, pad), (0, 0)))
        return t.reshape(bsz, N_HEADS, nb, MOBA_BLOCK, HEAD_DIM)

    k_blocks = blocks(h @ w_k)
    v_blocks = blocks(h @ w_v)
    k_means = jnp.mean(k_blocks.astype(jnp.float32), axis=3)
    return k_blocks, v_blocks, k_means


def moba_attention(x, w_q, w_o, k_blocks, v_blocks, k_means):
    bsz, T, D = x.shape
    nb = k_blocks.shape[2]
    topk = min(MOBA_TOPK, nb)
    scale = HEAD_DIM ** -0.5
    q = _heads(x @ w_q).transpose(0, 2, 1, 3)
    n_chunks = T // QUERY_CHUNK
    q_chunks = q.reshape(bsz, N_HEADS, n_chunks, QUERY_CHUNK, HEAD_DIM).transpose(2, 0, 1, 3, 4)
    gather_blocks = jax.vmap(jax.vmap(lambda blk_arr, idx: blk_arr[idx]))

    def attend_chunk(args):
        c, q_c = args
        start = c * QUERY_CHUNK
        own = start // MOBA_BLOCK
        q_pos = start + jnp.arange(QUERY_CHUNK)
        gate = jnp.einsum('bhqd,bhnd->bhqn', q_c.astype(jnp.float32), k_means)
        gate = jnp.where(jnp.arange(nb) < own, gate, -jnp.inf)
        _, sel = lax.top_k(gate, topk)
        k_sel = gather_blocks(k_blocks, sel)
        v_sel = gather_blocks(v_blocks, sel)
        s_sel = jnp.einsum('bhqd,bhqsjd->bhqsj', q_c, k_sel).astype(jnp.float32) * scale
        slot_ok = jnp.arange(topk) < own
        s_sel = jnp.where(slot_ok[:, None], s_sel, -jnp.inf)
        s_sel = s_sel.reshape(bsz, N_HEADS, QUERY_CHUNK, topk * MOBA_BLOCK)
        k_own = lax.dynamic_index_in_dim(k_blocks, own, axis=2, keepdims=False)
        v_own = lax.dynamic_index_in_dim(v_blocks, own, axis=2, keepdims=False)
        s_own = jnp.einsum('bhqd,bhkd->bhqk', q_c, k_own).astype(jnp.float32) * scale
        k_pos = own * MOBA_BLOCK + jnp.arange(MOBA_BLOCK)
        s_own = jnp.where(k_pos[None, :] <= q_pos[:, None], s_own, -jnp.inf)
        p = jax.nn.softmax(jnp.concatenate([s_sel, s_own], axis=-1), axis=-1)
        p_sel = p[..., :topk * MOBA_BLOCK].reshape(bsz, N_HEADS, QUERY_CHUNK, topk, MOBA_BLOCK)
        p_own = p[..., topk * MOBA_BLOCK:]
        o = (jnp.einsum('bhqsj,bhqsjd->bhqd', p_sel.astype(v_sel.dtype), v_sel)
             + jnp.einsum('bhqk,bhkd->bhqd', p_own.astype(v_own.dtype), v_own))
        return o

    o = lax.map(attend_chunk, (jnp.arange(n_chunks), q_chunks))
    o = o.transpose(1, 0, 3, 2, 4).reshape(bsz, T, D)
    return (o @ w_o).astype(x.dtype)


def swiglu(x, w_gate, w_up, w_down):
    return (jax.nn.silu(x @ w_gate) * (x @ w_up)) @ w_down


def moe_swiglu(x, router, w_gate, w_up, w_down):
    logits = (x @ router).astype(jnp.float32)
    top_logits, top_idx = lax.top_k(logits, TOP_K_EXPERTS)
    top_w = jax.nn.softmax(top_logits, axis=-1)
    gates = jnp.sum(jax.nn.one_hot(top_idx, N_EXPERTS, dtype=jnp.float32) * top_w[..., None], axis=-2)
    gates = gates.astype(x.dtype)
    out = jnp.zeros_like(x)
    for e in range(N_EXPERTS):
        out = out + gates[..., e:e + 1] * swiglu(x, w_gate[e], w_up[e], w_down[e])
    return out


def setup_inputs(seed: int = 0) -> dict:
    key = jax.random.key(seed)
    ks = iter(jax.random.split(key, 48))
    D, H, N = D_MODEL, N_HEADS, HEAD_DIM
    f32 = jnp.float32

    def nrm(shape, scale):
        return jax.random.normal(next(ks), shape, f32) * scale

    def unif(shape, lo, hi):
        return jax.random.uniform(next(ks), shape, f32, lo, hi)

    beta = DEEPNORM_BETA
    nA, nV = N_A_LAYERS, max(N_A_LAYERS - 1, 0)
    rkv_scale = jnp.array([1.0, 1.0, beta], f32)[:, None, None]
    return {
        'x': nrm((BATCH, SEQ, D), 1.0),
        'rwkv_mu': unif((nA, 6, D), 0.0, 1.0),
        'rwkv_w_rkv': nrm((nA, 3, D, D), D ** -0.5) * rkv_scale,
        'rwkv_w_out': nrm((nA, D, D), D ** -0.5 * beta),
        'rwkv_decay_w0': unif((nA, D), -6.0, -1.0),
        'rwkv_decay_w1': nrm((nA, D, LORA_DECAY), D ** -0.5),
        'rwkv_decay_w2': nrm((nA, LORA_DECAY, D), 0.1 * LORA_DECAY ** -0.5),
        'rwkv_iclr_a0': nrm((nA, D), 0.1),
        'rwkv_iclr_a1': nrm((nA, D, LORA_ICLR), D ** -0.5),
        'rwkv_iclr_a2': nrm((nA, LORA_ICLR, D), 0.1 * LORA_ICLR ** -0.5),
        'rwkv_vres_v0': 1.0 + nrm((nV, D), 0.1),
        'rwkv_vres_v1': nrm((nV, D, LORA_VRES), D ** -0.5),
        'rwkv_vres_v2': nrm((nV, LORA_VRES, D), 0.1 * LORA_VRES ** -0.5),
        'rwkv_gate_g1': nrm((nA, D, LORA_GATE), D ** -0.5),
        'rwkv_gate_g2': nrm((nA, LORA_GATE, D), LORA_GATE ** -0.5),
        'rwkv_k_k': 0.85 + nrm((nA, D), 0.05),
        'rwkv_k_a': 1.0 + nrm((nA, D), 0.05),
        'rwkv_r_k': nrm((nA, H, N), 0.1),
        'rwkv_gn_g': 1.0 + nrm((nA, D), 0.05),
        'rwkv_gn_b': nrm((nA, D), 0.01),
        'moba_w_k': nrm((D, D), D ** -0.5),
        'moba_w_v': nrm((D, D), D ** -0.5 * beta),
        'moba_w_q': nrm((N_B_LAYERS, D, D), D ** -0.5),
        'moba_w_o': nrm((N_B_LAYERS, D, D), D ** -0.5 * beta),
        'ffn_w_gate': nrm((N_DENSE, D, D_FF), D ** -0.5),
        'ffn_w_up': nrm((N_DENSE, D, D_FF), D ** -0.5),
        'ffn_w_down': nrm((N_DENSE, D_FF, D), D_FF ** -0.5 * beta),
        'moe_router': nrm((N_MOE, D, N_EXPERTS), D ** -0.5),
        'moe_w_gate': nrm((N_MOE, N_EXPERTS, D, D_FF_EXPERT), D ** -0.5),
        'moe_w_up': nrm((N_MOE, N_EXPERTS, D, D_FF_EXPERT), D ** -0.5),
        'moe_w_down': nrm((N_MOE, N_EXPERTS, D_FF_EXPERT, D), D_FF_EXPERT ** -0.5 * beta),
        'ln_g': 1.0 + nrm((DEPTH, 2, D), 0.05),
        'ln_b': nrm((DEPTH, 2, D), 0.01),
    }


def reference(x, rwkv_mu, rwkv_w_rkv, rwkv_w_out, rwkv_decay_w0, rwkv_decay_w1, rwkv_decay_w2,
              rwkv_iclr_a0, rwkv_iclr_a1, rwkv_iclr_a2, rwkv_vres_v0, rwkv_vres_v1, rwkv_vres_v2,
              rwkv_gate_g1, rwkv_gate_g2, rwkv_k_k, rwkv_k_a, rwkv_r_k, rwkv_gn_g, rwkv_gn_b,
              moba_w_k, moba_w_v, moba_w_q, moba_w_o,
              ffn_w_gate, ffn_w_up, ffn_w_down,
              moe_router, moe_w_gate, moe_w_up, moe_w_down,
              ln_g, ln_b):
    h = x
    v_first = None
    kv = None
    for layer in range(DEPTH):
        if layer < N_A_LAYERS:
            i = layer
            if i == 0:
                v0, v1, v2 = None, None, None
            else:
                v0, v1, v2 = rwkv_vres_v0[i - 1], rwkv_vres_v1[i - 1], rwkv_vres_v2[i - 1]
            mix, v_first = rwkv7_time_mix(
                h, v_first, rwkv_mu[i], rwkv_w_rkv[i], rwkv_w_out[i],
                rwkv_decay_w0[i], rwkv_decay_w1[i], rwkv_decay_w2[i],
                rwkv_iclr_a0[i], rwkv_iclr_a1[i], rwkv_iclr_a2[i], v0, v1, v2,
                rwkv_gate_g1[i], rwkv_gate_g2[i], rwkv_k_k[i], rwkv_k_a[i], rwkv_r_k[i],
                rwkv_gn_g[i], rwkv_gn_b[i])
        else:
            j = layer - N_A_LAYERS
            k_blocks, v_blocks, k_means = kv
            mix = moba_attention(h, moba_w_q[j], moba_w_o[j], k_blocks, v_blocks, k_means)
        h = deepnorm_residual(h, mix, ln_g[layer, 0], ln_b[layer, 0])
        if layer % 2 == 0:
            e = layer // 2
            ffn = swiglu(h, ffn_w_gate[e], ffn_w_up[e], ffn_w_down[e])
        else:
            e = layer // 2
            ffn = moe_swiglu(h, moe_router[e], moe_w_gate[e], moe_w_up[e], moe_w_down[e])
        h = deepnorm_residual(h, ffn, ln_g[layer, 1], ln_b[layer, 1])
        if layer == N_A_LAYERS - 1:
            kv = moba_shared_kv(h, moba_w_k, moba_w_v)
    return h
```

```cpp
#include <hip/hip_runtime.h>
#include <cstdio>
#include <cstdint>
#include <hip/hip_bf16.h>
#include <cmath>
__device__ __forceinline__ int fresh_lane() { int l; asm volatile("v_mbcnt_lo_u32_b32 %0, -1, 0\n\tv_mbcnt_hi_u32_b32 %0, -1, %0" : "=v"(l)); return l; }
namespace pg8 {
#define PG8_LAS __attribute__((address_space(3)))
typedef unsigned short bf16_t;
typedef short bf16x8 __attribute__((ext_vector_type(8)));
typedef float f32x4 __attribute__((ext_vector_type(4)));
typedef unsigned u32x4 __attribute__((ext_vector_type(4)));
constexpr int BM = 256, BK = 64, HALF = 128, HTB = HALF * BK * 2  , STAGE_BYTES = 8 * HTB, NXCD = 8, WGM = 8;

__host__ __device__ __forceinline__ int lds_byte(int r, int c) { const int st = (r >> 4) * 2 + (c >> 5), rr = r & 15, cc = c & 31, ob = rr * 64 + cc * 2; return st * 1024 + (ob ^ (((ob >> 9) & 1) << 5)); }
__host__ __device__ __forceinline__ void stage_rc(int b, int& R, int& C) { const int st = b / 1024, sb = b % 1024, swz = sb ^ (((sb >> 9) & 1) << 5); R = (st >> 1) * 16 + swz / 64; C = (st & 1) * 32 + (swz % 64) / 2; }
__host__ __device__ __forceinline__ int perm32(int rho) { const int n = rho >> 4, i = rho & 15; return 8 * (i >> 2) + 4 * n + (i & 3); }

struct Unit { int pm, pn, e; };
struct Gemm { int K, lda, ldb; };

__device__ __forceinline__ unsigned cvt_pk_bf16(float lo, float hi) { unsigned r; asm volatile("v_cvt_pk_bf16_f32 %0, %1, %2" : "=v"(r) : "v"(lo), "v"(hi)); return r; }
__device__ __forceinline__ float fsigmoid(float x) { return __builtin_amdgcn_rcpf(1.0f + __expf(-x)); }
__device__ __forceinline__ float ftanh(float x) { return 1.0f - 2.0f * __builtin_amdgcn_rcpf(1.0f + __expf(2.0f * x)); }

struct SchedStd {
    int nM, nN, nwg, G, c, amode; const char* A; const char* B; size_t atile, btile, ag;
    __device__ __forceinline__ void init(int M, int N, int G_, int c_, const void* A_, size_t lda, const void* B_, size_t ldb, int amode_ = 0, size_t ag_ = 0) {
        nM = M / BM; nN = N / BM; nwg = nM * nN; G = G_; c = c_; A = (const char*)A_; B = (const char*)B_; atile = (size_t)BM * lda * 2; btile = (size_t)BM * ldb * 2; amode = amode_; ag = ag_; }
    __device__ __forceinline__ bool next(int i, Unit& u) const {
        const long L = (long)i * G + c; if (L >= nwg) return false;
        int wgid = (int)L; { const int q = nwg / NXCD, r = nwg % NXCD, xcd = wgid % NXCD, off = wgid / NXCD; wgid = (xcd < r ? xcd * (q + 1) : r * (q + 1) + (xcd - r) * q) + off; }
        const int nig = WGM * nN, gid = wgid / nig, fm = gid * WGM, gsz = (nM - fm) < WGM ? (nM - fm) : WGM;
        u.pm = fm + ((wgid % nig) % gsz); u.pn = (wgid % nig) / gsz; u.e = 0; return true;
    }
    __device__ __forceinline__ const char* abase(const Unit& u) const {
        size_t off = (size_t)u.pm * atile;
        if (amode == 1) { const int gs = u.pn < 12 ? (u.pn >> 2) : (u.pn == 12 ? 3 : (u.pn == 13 ? 4 : (u.pn == 14 ? 2 : 5))); off += (size_t)gs * ag; }
        else if (amode == 2) off += (size_t)(u.pn >> 2) * 512;
        return A + off; }
    __device__ __forceinline__ const char* bbase(const Unit& u) const { return B + (size_t)u.pn * btile; }
    __device__ __forceinline__ void a_ready(const Unit&) const {}
    __device__ __forceinline__ void done(const Unit&) const {}
};
struct SchedMoe {
    int nN, G, c; const PG8_LAS int* pp; const char* A; const char* B; size_t atile, btile, bexp;
    __device__ __forceinline__ bool next(int i, Unit& u) const {
        const int L = i * G + c, tot = pp[8] * nN; if (L >= tot) return false;
        const int pm = L / nN; u.pm = pm; u.pn = L - pm * nN; int e = 0;
#pragma unroll
        for (int k = 1; k < 8; ++k) e += (pm >= pp[k]) ? 1 : 0;
        u.e = __builtin_amdgcn_readfirstlane(e); return true; }
    __device__ __forceinline__ const char* abase(const Unit& u) const { return A + (size_t)u.pm * atile; }
    __device__ __forceinline__ const char* bbase(const Unit& u) const { return B + (size_t)u.e * bexp + (size_t)u.pn * btile; }
    __device__ __forceinline__ void a_ready(const Unit&) const {}
    __device__ __forceinline__ void done(const Unit&) const {}
};

#define PG8_PACK8(w, v0, v1) do { w.x = cvt_pk_bf16(v0[0], v0[1]); w.y = cvt_pk_bf16(v0[2], v0[3]); w.z = cvt_pk_bf16(v1[0], v1[1]); w.w = cvt_pk_bf16(v1[2], v1[3]); } while (0)

struct EpiQKV {
    static constexpr bool PERM = true, AFTER_DRAIN = false;
    bf16_t* O0; long d1, d2; float s0;
    __device__ __forceinline__ void operator()(const f32x4 (&acc)[2][2][4][2], const Unit& u, int wr, int wc, int fr, int fq) const {
        const int t = u.pn >> 2; bf16_t* base = O0 + (long)(t == 1) * d1 + (long)(t == 2) * d2; const float sc = t == 0 ? s0 : 1.0f;
        const int row0 = u.pm * BM + wr * 64 + fr, col0 = (u.pn & 3) * BM + wc * 32 + 8 * fq;
#pragma unroll
        for (int ai = 0; ai < 2; ++ai)
#pragma unroll
            for (int m = 0; m < 4; ++m) { bf16_t* rowp = base + (size_t)(row0 + ai * HALF + m * 16) * 1024 + col0;
#pragma unroll
                for (int bj = 0; bj < 2; ++bj) { const f32x4 v0 = acc[ai][bj][m][0] * sc, v1 = acc[ai][bj][m][1] * sc; u32x4 w; PG8_PACK8(w, v0, v1); *(u32x4*)(rowp + bj * HALF) = w; } }
    }
};
struct EpiRkv {
    static constexpr bool PERM = true, AFTER_DRAIN = false;
    bf16_t* RKV; long dLH; size_t mstride;
    __device__ __forceinline__ void operator()(const f32x4 (&acc)[2][2][4][2], const Unit& u, int wr, int wc, int fr, int fq) const {
        const int pn = u.pn; const bool lora = pn >= 12;
        bf16_t* base = (bf16_t*)((char*)RKV + (lora ? dLH : (long)((size_t)(pn >> 2) * mstride * 2))); const int colt = lora ? (pn - 12) * BM : (pn & 3) * BM;
        const int row0 = u.pm * BM + wr * 64 + fr, col0 = colt + wc * 32 + 8 * fq;
#pragma unroll
        for (int ai = 0; ai < 2; ++ai)
#pragma unroll
            for (int m = 0; m < 4; ++m) { bf16_t* rowp = base + (size_t)(row0 + ai * HALF + m * 16) * 1024 + col0;
#pragma unroll
                for (int bj = 0; bj < 2; ++bj) { f32x4 v0 = acc[ai][bj][m][0], v1 = acc[ai][bj][m][1];
                    if (pn == 12) {
#pragma unroll
                        for (int i = 0; i < 4; ++i) { v0[i] = ftanh(v0[i]); v1[i] = ftanh(v1[i]); } }
                    else if (pn == 15) {
#pragma unroll
                        for (int i = 0; i < 4; ++i) { v0[i] = fsigmoid(v0[i]); v1[i] = fsigmoid(v1[i]); } }
                    u32x4 w; PG8_PACK8(w, v0, v1); *(u32x4*)(rowp + bj * HALF) = w; } }
    }
};
template <int GRP> struct EpiLoraUp {
    static constexpr bool PERM = true, AFTER_DRAIN = false;
    void* O; const float* bias;
    __device__ __forceinline__ void operator()(const f32x4 (&acc)[2][2][4][2], const Unit& u, int wr, int wc, int fr, int fq) const {
        const int row0 = u.pm * BM + wr * 64 + fr, col0 = u.pn * BM + wc * 32 + 8 * fq;
#pragma unroll
        for (int bj = 0; bj < 2; ++bj) {
            f32x4 bv0 = (f32x4){0.f, 0.f, 0.f, 0.f}, bv1 = bv0;
            if (GRP < 3) { bv0 = *(const f32x4*)(bias + col0 + bj * HALF); bv1 = *(const f32x4*)(bias + col0 + bj * HALF + 4); }
#pragma unroll
            for (int ai = 0; ai < 2; ++ai)
#pragma unroll
                for (int m = 0; m < 4; ++m) { const size_t ro = (size_t)(row0 + ai * HALF + m * 16) * 1024 + col0 + bj * HALF;
                    f32x4 v0_ = acc[ai][bj][m][0] + bv0, v1_ = acc[ai][bj][m][1] + bv1;
                    if (GRP == 0) {
#pragma unroll
                        for (int i = 0; i < 4; ++i) { v0_[i] = __expf(-0.6065306597f * fsigmoid(v0_[i])); v1_[i] = __expf(-0.6065306597f * fsigmoid(v1_[i])); }
                    } else if (GRP < 3) {
#pragma unroll
                        for (int i = 0; i < 4; ++i) { v0_[i] = fsigmoid(v0_[i]); v1_[i] = fsigmoid(v1_[i]); }
                    }
                    if (GRP < 2) { *(f32x4*)((float*)O + ro) = v0_; *(f32x4*)((float*)O + ro + 4) = v1_; }
                    else { u32x4 w; PG8_PACK8(w, v0_, v1_); *(u32x4*)((bf16_t*)O + ro) = w; } }
        }
    }
};
struct EpiLoraUpAll {
    static constexpr bool PERM = true, AFTER_DRAIN = false;
    EpiLoraUp<0> e0; EpiLoraUp<1> e1; EpiLoraUp<2> e2; EpiLoraUp<3> e3;
    __device__ __forceinline__ void operator()(const f32x4 (&acc)[2][2][4][2], const Unit& u, int wr, int wc, int fr, int fq) const {
        Unit v = u; v.pn = u.pn & 3; const int g = u.pn >> 2;
        if (g == 0) e0(acc, v, wr, wc, fr, fq); else if (g == 1) e1(acc, v, wr, wc, fr, fq); else if (g == 2) e2(acc, v, wr, wc, fr, fq); else e3(acc, v, wr, wc, fr, fq);
    }
};
struct EpiResF32 {
    static constexpr bool PERM = false, AFTER_DRAIN = false;
    const float* base; float* out; float alpha;
    __device__ __forceinline__ void operator()(const f32x4 (&acc)[2][2][4][2], const Unit& u, int wr, int wc, int fr, int fq) const {
        const int row0 = u.pm * BM + wr * 64 + fr, col0 = u.pn * BM + wc * 32 + 4 * fq;
#pragma unroll
        for (int ai = 0; ai < 2; ++ai)
#pragma unroll
            for (int m = 0; m < 4; ++m) { const size_t ro = (size_t)(row0 + ai * HALF + m * 16) * 1024 + col0;
#pragma unroll
                for (int bj = 0; bj < 2; ++bj)
#pragma unroll
                    for (int n = 0; n < 2; ++n) { const f32x4 b = *(const f32x4*)(base + ro + bj * HALF + n * 16); *(f32x4*)(out + ro + bj * HALF + n * 16) = b * alpha + acc[ai][bj][m][n]; } }
    }
};
struct EpiSwiGLU {
    static constexpr bool PERM = true, AFTER_DRAIN = false;
    bf16_t* Hd; int ldh;
    __device__ __forceinline__ void operator()(const f32x4 (&acc)[2][2][4][2], const Unit& u, int wr, int wc, int fr, int fq) const {
        const int row0 = u.pm * BM + wr * 64 + fr, col0 = u.pn * HALF + wc * 32 + 8 * fq;
#pragma unroll
        for (int ai = 0; ai < 2; ++ai)
#pragma unroll
            for (int m = 0; m < 4; ++m) { bf16_t* rowp = Hd + (size_t)(row0 + ai * HALF + m * 16) * ldh + col0;
                f32x4 v0, v1;
#pragma unroll
                for (int i = 0; i < 4; ++i) { const float g0 = acc[ai][0][m][0][i], g1 = acc[ai][0][m][1][i];
                    v0[i] = g0 * fsigmoid(g0) * acc[ai][1][m][0][i]; v1[i] = g1 * fsigmoid(g1) * acc[ai][1][m][1][i]; }
                u32x4 w; PG8_PACK8(w, v0, v1); *(u32x4*)rowp = w; }
    }
};
struct EpiMoeDown {
    static constexpr bool PERM = false, AFTER_DRAIN = false;
    float* YP; const float* gw;
    __device__ __forceinline__ void operator()(const f32x4 (&acc)[2][2][4][2], const Unit& u, int wr, int wc, int fr, int fq) const {
        const int row0 = u.pm * BM + wr * 64 + fr, col0 = u.pn * BM + wc * 32 + 4 * fq;
#pragma unroll
        for (int ai = 0; ai < 2; ++ai)
#pragma unroll
            for (int m = 0; m < 4; ++m) { const int row = row0 + ai * HALF + m * 16; const float s = gw[row]; const size_t ro = (size_t)row * 1024 + col0;
#pragma unroll
                for (int bj = 0; bj < 2; ++bj)
#pragma unroll
                    for (int n = 0; n < 2; ++n) *(f32x4*)(YP + ro + bj * HALF + n * 16) = acc[ai][bj][m][n] * s; }
    }
};

template <class Epi, class Sched, bool ALIGN_EPI = false, bool SP2 = false>
__device__ __forceinline__ void gemm_phase(PG8_LAS unsigned char* lds, const Gemm g, const Sched& S, const Epi& E, int wave) {
    const int lane = fresh_lane(), wid = wave, tid = wid * 64 + lane, wr = wid >> 2, wc = wid & 3, fr = lane & 15, fq = lane >> 4;
    const int K = g.K, nt = K / BK;
    unsigned voffA[2], voffB[2];
#pragma unroll
    for (int i = 0; i < 2; ++i) { int R, C; stage_rc(tid * 16 + i * 8192, R, C); const int Rb = Epi::PERM ? ((R & ~31) + perm32(R & 31)) : R;
        voffA[i] = (unsigned)(R * g.lda + C) * 2u; voffB[i] = (unsigned)(Rb * g.ldb + C) * 2u; }
    const size_t kstep = (size_t)(BK * 2);
    const size_t hsA = (size_t)HALF * g.lda * 2, hsB = (size_t)HALF * g.ldb * 2;
    const unsigned ldsw = (unsigned)wid * 1024u;
    const int aoff = lds_byte(wr * 64 + fr, fq * 8), boff = lds_byte(wc * 32 + fr, fq * 8);
#define PG8_SA(b, h) (((b) * 2 + (h)) * HTB)
#define PG8_SB(b, h) ((4 + (b) * 2 + (h)) * HTB)
#define PG8_STAGE(bufoff, gbase, voff) do { _Pragma("unroll") for (int _i = 0; _i < 2; ++_i) \
        __builtin_amdgcn_global_load_lds((const unsigned*)((const char*)(gbase) + (voff)[_i]), (PG8_LAS unsigned*)(lds + (bufoff) + ldsw + _i * 8192), 16, 0, 0); } while (0)
#define PG8_LDA(dst, b, h) do { _Pragma("unroll") for (int m = 0; m < 4; ++m) _Pragma("unroll") for (int k = 0; k < 2; ++k) dst[m][k] = *(const PG8_LAS bf16x8*)(lds + PG8_SA(b, h) + aoff + m * 2048 + k * 1024); } while (0)
#define PG8_LDB(dst, b, h) do { _Pragma("unroll") for (int n = 0; n < 2; ++n) _Pragma("unroll") for (int k = 0; k < 2; ++k) dst[n][k] = *(const PG8_LAS bf16x8*)(lds + PG8_SB(b, h) + boff + n * 2048 + k * 1024); } while (0)
#define PG8_MMA(ai, bj, At, Bt) do { __builtin_amdgcn_s_setprio(1); _Pragma("unroll") for (int m = 0; m < 4; ++m) _Pragma("unroll") for (int n = 0; n < 2; ++n) _Pragma("unroll") for (int k = 0; k < 2; ++k) \
        acc[ai][bj][m][n] = __builtin_amdgcn_mfma_f32_16x16x32_bf16(Bt[n][k], At[m][k], acc[ai][bj][m][n], 0, 0, 0); __builtin_amdgcn_s_setprio(0); } while (0)
#define PG8_WAIT_V(n) asm volatile("s_waitcnt vmcnt(" #n ")" ::: "memory")
#define PG8_WAIT_L(n) asm volatile("s_waitcnt lgkmcnt(" #n ")" ::: "memory")
#define PG8_BAR __builtin_amdgcn_s_barrier()
#define PG8_SCHED __builtin_amdgcn_sched_barrier(0)
    Unit cur, nxt; int ui = 0;
    if (!S.next(0, cur)) return;
    f32x4 acc[2][2][4][2];
#pragma unroll
    for (int a = 0; a < 2; ++a)
#pragma unroll
        for (int b = 0; b < 2; ++b)
#pragma unroll
            for (int m = 0; m < 4; ++m)
#pragma unroll
                for (int n = 0; n < 2; ++n) acc[a][b][m][n] = (f32x4){0.f, 0.f, 0.f, 0.f};
    bf16x8 At[4][2], B0[2][2], B1[2][2];
    const char* cA = S.abase(cur); const char* cB = S.bbase(cur);
    S.a_ready(cur);
    if constexpr (SP2) {
        PG8_STAGE(PG8_SB(0, 0), cB, voffB); PG8_STAGE(PG8_SB(0, 1), cB + hsB, voffB); PG8_STAGE(PG8_SA(0, 0), cA, voffA); PG8_STAGE(PG8_SA(0, 1), cA + hsA, voffA);
        if (wr == 1) PG8_BAR;
        PG8_WAIT_V(2); PG8_BAR;
        PG8_STAGE(PG8_SB(1, 0), cB + kstep, voffB); PG8_STAGE(PG8_SA(1, 0), cA + kstep, voffA); PG8_STAGE(PG8_SB(1, 1), cB + hsB + kstep, voffB);
        PG8_WAIT_V(6); PG8_BAR;
    } else {
        PG8_STAGE(PG8_SB(0, 0), cB, voffB); PG8_STAGE(PG8_SA(0, 0), cA, voffA); PG8_STAGE(PG8_SB(0, 1), cB + hsB, voffB); PG8_STAGE(PG8_SA(0, 1), cA + hsA, voffA);
        if (wr == 1) PG8_BAR;
        PG8_WAIT_V(4); PG8_BAR;
        PG8_STAGE(PG8_SB(1, 0), cB + kstep, voffB); PG8_STAGE(PG8_SA(1, 0), cA + kstep, voffA); PG8_STAGE(PG8_SB(1, 1), cB + hsB + kstep, voffB);
        PG8_WAIT_V(6); PG8_BAR;
    }
    for (;;) {
        const bool has_next = S.next(ui + 1, nxt);
        const char* nA = has_next ? S.abase(nxt) : cA; const char* nB = has_next ? S.bbase(nxt) : cB;
#pragma nounroll
        for (int t = 0; t < nt; t += 2) {
            const bool last = (t == nt - 2);
            const char* a1 = cA + (size_t)(t + 1) * kstep;
            const char* a2 = last ? nA : cA + (size_t)(t + 2) * kstep; const char* b2 = last ? nB : cB + (size_t)(t + 2) * kstep;
            const char* a3 = a2 + kstep; const char* b3 = b2 + kstep;
            if (last && has_next) S.a_ready(nxt);
            if constexpr (SP2) {
            PG8_LDB(B0, 0, 0); PG8_LDB(B1, 0, 1); PG8_SCHED; PG8_LDA(At, 0, 0); PG8_STAGE(PG8_SA(1, 1), a1 + hsA, voffA);
            PG8_WAIT_V(8); PG8_WAIT_L(0); PG8_BAR; PG8_MMA(0, 0, At, B0); PG8_MMA(0, 1, At, B1); PG8_BAR; PG8_SCHED;
            PG8_LDA(At, 0, 1); PG8_STAGE(PG8_SB(0, 0), b2, voffB); PG8_STAGE(PG8_SB(0, 1), b2 + hsB, voffB); PG8_STAGE(PG8_SA(0, 0), a2, voffA);
            PG8_WAIT_V(8); PG8_WAIT_L(0); PG8_BAR; PG8_MMA(1, 0, At, B0); PG8_MMA(1, 1, At, B1); PG8_BAR; PG8_SCHED;
            PG8_LDB(B0, 1, 0); PG8_LDB(B1, 1, 1); PG8_SCHED; PG8_LDA(At, 1, 0); PG8_STAGE(PG8_SA(0, 1), a2 + hsA, voffA);
            PG8_WAIT_V(8); PG8_WAIT_L(0); PG8_BAR; PG8_MMA(0, 0, At, B0); PG8_MMA(0, 1, At, B1); PG8_BAR; PG8_SCHED;
            PG8_LDA(At, 1, 1); PG8_STAGE(PG8_SB(1, 0), b3, voffB); PG8_STAGE(PG8_SB(1, 1), b3 + hsB, voffB); PG8_STAGE(PG8_SA(1, 0), a3, voffA);
            PG8_WAIT_V(8); PG8_WAIT_L(0); PG8_BAR; PG8_MMA(1, 0, At, B0); PG8_MMA(1, 1, At, B1); PG8_BAR; PG8_SCHED;
            } else {
            PG8_LDB(B0, 0, 0); PG8_SCHED; PG8_LDA(At, 0, 0); PG8_STAGE(PG8_SA(1, 1), a1 + hsA, voffA);
            PG8_WAIT_L(8); PG8_BAR; PG8_WAIT_L(0); PG8_MMA(0, 0, At, B0); PG8_BAR; PG8_SCHED;
            PG8_LDB(B1, 0, 1); PG8_STAGE(PG8_SB(0, 0), b2, voffB);
            PG8_BAR; PG8_WAIT_L(0); PG8_MMA(0, 1, At, B1); PG8_BAR;
            PG8_LDA(At, 0, 1); PG8_STAGE(PG8_SA(0, 0), a2, voffA);
            PG8_BAR; PG8_WAIT_L(0); PG8_MMA(1, 0, At, B0); PG8_BAR; PG8_SCHED;
            PG8_STAGE(PG8_SB(0, 1), b2 + hsB, voffB);
            PG8_WAIT_V(6); PG8_BAR; PG8_MMA(1, 1, At, B1); PG8_BAR;
            PG8_LDB(B0, 1, 0); PG8_SCHED; PG8_LDA(At, 1, 0); PG8_STAGE(PG8_SA(0, 1), a2 + hsA, voffA);
            PG8_WAIT_L(8); PG8_BAR; PG8_WAIT_L(0); PG8_MMA(0, 0, At, B0); PG8_BAR; PG8_SCHED;
            PG8_LDB(B1, 1, 1); PG8_STAGE(PG8_SB(1, 0), b3, voffB);
            PG8_BAR; PG8_WAIT_L(0); PG8_MMA(0, 1, At, B1); PG8_BAR;
            PG8_LDA(At, 1, 1); PG8_STAGE(PG8_SA(1, 0), a3, voffA);
            PG8_BAR; PG8_WAIT_L(0); PG8_MMA(1, 0, At, B0); PG8_BAR; PG8_SCHED;
            PG8_STAGE(PG8_SB(1, 1), b3 + hsB, voffB);
            PG8_WAIT_V(6); PG8_BAR; PG8_MMA(1, 1, At, B1); PG8_BAR;
            }
        }
        if constexpr (ALIGN_EPI) { if (wr == 0) PG8_BAR; }
        if constexpr (!Epi::AFTER_DRAIN) { E(acc, cur, wr, wc, fr, fq); S.done(cur); }
        if (!has_next) break;
#pragma unroll
        for (int a = 0; a < 2; ++a)
#pragma unroll
            for (int b = 0; b < 2; ++b)
#pragma unroll
                for (int m = 0; m < 4; ++m)
#pragma unroll
                    for (int n = 0; n < 2; ++n) acc[a][b][m][n] = (f32x4){0.f, 0.f, 0.f, 0.f};
        cur = nxt; cA = nA; cB = nB; ++ui;
        if constexpr (ALIGN_EPI) { if (wr == 1) PG8_BAR; }
    }
    PG8_WAIT_V(0);
    if constexpr (!ALIGN_EPI) { if (wr == 0) PG8_BAR; }
    PG8_BAR;
    if constexpr (Epi::AFTER_DRAIN) { E.fused(acc, cur, wr, wc, fr, fq, lds, wid, lane); S.done(cur); }
#undef PG8_SA
#undef PG8_SB
#undef PG8_STAGE
#undef PG8_LDA
#undef PG8_LDB
#undef PG8_MMA
#undef PG8_WAIT_V
#undef PG8_WAIT_L
#undef PG8_BAR
#undef PG8_SCHED
}
}

#ifndef MOBA_MASK_ON
#define MOBA_MASK_ON 1
#endif
namespace attn_body {
using bf16=__hip_bfloat16;
using bf16x8=__attribute__((ext_vector_type(8)))short;
using s16x4=__attribute__((ext_vector_type(4)))short;
using f32x16=__attribute__((ext_vector_type(16)))float;
using u32x4=__attribute__((ext_vector_type(4)))unsigned;
constexpr int BATCH=2,NHEAD=16,SEQ=8192,D=64,DM=NHEAD*D;
constexpr int NW=8,QBLK=32,QB=QBLK*NW,KVBLK=64,NQB=SEQ/QB;
constexpr int ATTN_PITCH=DM, ATTN_UNIT_ROWS=QB;
__device__ __forceinline__ int crow(int r,int hi){return (r&3)+8*(r>>2)+4*hi;}
#define SBAR() __builtin_amdgcn_sched_barrier(0)
__device__ __forceinline__ void cmask(f32x16&p0,f32x16&p1,int jb,int qrel,int hi){
  const float NEG=-INFINITY; int d=qrel-(64*jb+4*hi); asm volatile("":"+v"(d));
  #pragma unroll
  for(int r=0;r<16;++r){const int c=(r&3)+8*(r>>2); if(c>d)p0[r]=NEG; if(c+32>d)p1[r]=NEG;}
}

constexpr int NSLOT=3, SLOTB=8192;
constexpr int LDS_K=0, LDS_V=NSLOT*SLOTB, LDS_WS=2*NSLOT*SLOTB, LDS_OST=LDS_WS+NW*64*4, LDS_BYTES=LDS_OST+NW*4096;
constexpr float C2=0.125f*1.4426950408889634f;
__device__ __forceinline__ void glds16(const void*gsrc,unsigned lds_dst){unsigned keep;
  asm volatile("s_mov_b32 %0, m0\n\ts_mov_b32 m0, %2\n\ts_nop 0\n\tglobal_load_lds_dwordx4 %1, off\n\ts_mov_b32 m0, %0":"=&s"(keep):"v"(gsrc),"s"(lds_dst):"memory");}
__device__ __forceinline__ float max3f(float a,float b,float c){float r;asm("v_max3_f32 %0, %1, %2, %3":"=v"(r):"v"(a),"v"(b),"v"(c));return r;}
__device__ __forceinline__ float max2f(float a,float b){float r;asm("v_max_f32_e32 %0, %1, %2":"=v"(r):"v"(a),"v"(b));return r;}
__device__ __forceinline__ float fadd_s(float a,float b){float r;asm("v_add_f32_e32 %0, %1, %2":"=v"(r):"v"(a),"v"(b));return r;}
__device__ __forceinline__ float fsub_s(float a,float b){float r;asm("v_sub_f32_e32 %0, %1, %2":"=v"(r):"v"(a),"v"(b));return r;}
typedef float f32x2_t __attribute__((ext_vector_type(2))); typedef __bf16 bf16x2_t __attribute__((ext_vector_type(2)));
__device__ __forceinline__ unsigned cvtpk_s(float lo,float hi){f32x2_t v={lo,hi};bf16x2_t b=__builtin_convertvector(v,bf16x2_t);return __builtin_bit_cast(unsigned,b);}
#define WAIT_BAR(N) asm volatile("s_waitcnt vmcnt(" #N ") lgkmcnt(0)\n\ts_barrier":::"memory")

__device__ __forceinline__ void qkt(f32x16&p0,f32x16&p1,const char*Kslot,const bf16x8*qr,int r32,int hi){
  const char*kb=Kslot+hi*1024+r32*16;
  #pragma unroll
  for(int d0=0;d0<4;++d0){
    const bf16x8 b0=*reinterpret_cast<const bf16x8*>(kb+d0*2048);
    const bf16x8 b1=*reinterpret_cast<const bf16x8*>(kb+d0*2048+512);
    if(d0==0){p0=__builtin_amdgcn_mfma_f32_32x32x16_bf16(b0,qr[0],f32x16{},0,0,0);p1=__builtin_amdgcn_mfma_f32_32x32x16_bf16(b1,qr[0],f32x16{},0,0,0);}
    else{p0=__builtin_amdgcn_mfma_f32_32x32x16_bf16(b0,qr[d0],p0,0,0,0);p1=__builtin_amdgcn_mfma_f32_32x32x16_bf16(b1,qr[d0],p1,0,0,0);}}
}
typedef __attribute__((address_space(3))) const char* lds_cptr;
typedef short v4i16_t __attribute__((ext_vector_type(4)));
__device__ __forceinline__ void kload8(bf16x8*kf,lds_cptr kp){
  kf[0]=*(const __attribute__((address_space(3))) bf16x8*)(kp);      kf[1]=*(const __attribute__((address_space(3))) bf16x8*)(kp+512);
  kf[2]=*(const __attribute__((address_space(3))) bf16x8*)(kp+2048); kf[3]=*(const __attribute__((address_space(3))) bf16x8*)(kp+2560);
  kf[4]=*(const __attribute__((address_space(3))) bf16x8*)(kp+4096); kf[5]=*(const __attribute__((address_space(3))) bf16x8*)(kp+4608);
  kf[6]=*(const __attribute__((address_space(3))) bf16x8*)(kp+6144); kf[7]=*(const __attribute__((address_space(3))) bf16x8*)(kp+6656);
}
__device__ __forceinline__ void kload2(bf16x8*kf,lds_cptr kp,int j){ kf[2*j]=*(const __attribute__((address_space(3))) bf16x8*)(kp+j*2048); kf[2*j+1]=*(const __attribute__((address_space(3))) bf16x8*)(kp+j*2048+512); }
__device__ __forceinline__ s16x4 vtr(lds_cptr p){ return __builtin_bit_cast(s16x4,__builtin_amdgcn_ds_read_tr16_b64_v4i16((__attribute__((address_space(3))) v4i16_t*)p)); }
__device__ __forceinline__ float rowmax(const f32x16&p0,const f32x16&p1){
  float a=max3f(p0[0],p0[1],p1[0]),b=max3f(p0[2],p0[3],p1[1]);a=max3f(a,p1[2],p1[3]);
  #pragma unroll
  for(int r=4;r<16;r+=4){a=max3f(a,p0[r],p0[r+1]);b=max3f(b,p0[r+2],p0[r+3]);a=max3f(a,p1[r],p1[r+1]);b=max3f(b,p1[r+2],p1[r+3]);}
  const float m=max2f(a,b);
  auto rr=__builtin_amdgcn_permlane32_swap(__float_as_uint(m),__float_as_uint(m),false,false);
  return max2f(__uint_as_float(rr[0]),__uint_as_float(rr[1]));
}
__device__ __forceinline__ void pv(f32x16*o,int vb,bf16x8 pa0,bf16x8 pa1,bf16x8 pa2,bf16x8 pa3){
  #pragma unroll
  for(int d0=0;d0<2;++d0){s16x4 lo[4],hi[4];
    #pragma unroll
    for(int ks=0;ks<4;++ks){
      asm volatile("ds_read_b64_tr_b16 %0,%1 offset:%c2":"=&v"(lo[ks]):"v"(vb),"i"(d0*4096+ks*1024):"memory");
      asm volatile("ds_read_b64_tr_b16 %0,%1 offset:%c2":"=&v"(hi[ks]):"v"(vb),"i"(d0*4096+ks*1024+512):"memory");}
    asm volatile("s_waitcnt lgkmcnt(0)":::"memory");SBAR();
    #define PK(k) (bf16x8){lo[k][0],lo[k][1],lo[k][2],lo[k][3],hi[k][0],hi[k][1],hi[k][2],hi[k][3]}
    o[d0]=__builtin_amdgcn_mfma_f32_32x32x16_bf16(pa0,PK(0),o[d0],0,0,0);
    o[d0]=__builtin_amdgcn_mfma_f32_32x32x16_bf16(pa1,PK(1),o[d0],0,0,0);
    o[d0]=__builtin_amdgcn_mfma_f32_32x32x16_bf16(pa2,PK(2),o[d0],0,0,0);
    o[d0]=__builtin_amdgcn_mfma_f32_32x32x16_bf16(pa3,PK(3),o[d0],0,0,0);
    #undef PK
  }
}

#ifndef ATTN_STORE16
#define ATTN_STORE16(p,v) (*(u32x4*)(p)=(v))
#endif
template<int THRL> __device__ __forceinline__ void attn_unit(int b,int h,int qb,const bf16*Q,const bf16*__restrict__ K,const bf16*__restrict__ V,bf16*O,const unsigned*__restrict__ SEL,char*shm,int wave){
  const int lane=fresh_lane(),wid=wave,tid=wid*64+lane,r32=lane&31,hi=lane>>5; (void)tid;
  const long rowbase=(long)b*SEQ; const int q0=qb*QB;
  const bf16*Qw=Q+(rowbase+q0+wid*QBLK)*DM+h*D;
  const bf16*Kh=K+rowbase*DM+h*D,*Vh=V+rowbase*DM+h*D;
  const unsigned lds0=(unsigned)(uintptr_t)shm;
  float*wsf=(float*)(shm+LDS_WS)+wid*64;
  const bf16*ksrc=Kh+(long)lane*DM+wid*8;
  const bf16*vsrc=Vh+(long)(16*(wid&3)+(lane>>2))*DM+(wid>>2)*32+(lane&3)*8;
  const unsigned kdst=lds0+LDS_K+wid*1024, vdst=lds0+LDS_V+wid*1024;
  #define DMA_K(t,slot) glds16(ksrc+(long)(t)*KVBLK*DM,(unsigned)__builtin_amdgcn_readfirstlane(kdst+(slot)))
  #define DMA_V(t,slot) glds16(vsrc+(long)(t)*KVBLK*DM,(unsigned)__builtin_amdgcn_readfirstlane(vdst+(slot)))
  const int vb0=(int)(lds0+LDS_V)+((lane>>4)&1)*32+(lane&3)*8+(4*hi+((lane&15)>>2))*64;
  const char*Kbase=shm+LDS_K; bf16x8 kf[8];
  const lds_cptr shm3=(lds_cptr)shm; const lds_cptr kp0=shm3+LDS_K+hi*1024+r32*16; const lds_cptr vp0=shm3+LDS_V+((lane>>4)&1)*32+(lane&3)*8+(4*hi+((lane&15)>>2))*64;
  const int NT=(q0+QB)/KVBLK;
  DMA_K(0,0);DMA_V(0,0);DMA_K(1,SLOTB);
  bf16x8 qr[4];
  #pragma unroll
  for(int d0=0;d0<4;++d0)qr[d0]=*reinterpret_cast<const bf16x8*>(&Qw[(long)r32*DM+d0*16+hi*8]);
  float mhat=0.f,l_reg=0.f;f32x16 o[2];o[0]=f32x16{};o[1]=f32x16{};
  const int qrel=wid*QBLK+r32;
  #define SELW() ((volatile __attribute__((address_space(3))) unsigned*)(lds_cptr)((const char*)wsf)+32+r32)
  if(hi==0)*SELW()=SEL[(rowbase+q0+qrel)*NHEAD+h];
  asm volatile("s_waitcnt vmcnt(0) lgkmcnt(0)":::"memory");
  #define CMASK(P0,P1,t) do{int jb_=(t)-(NT-4); if(jb_>=0)cmask(P0,P1,jb_,qrel,hi); else if(MOBA_MASK_ON && !(((*SELW())>>((t)>>2))&1u)){ _Pragma("unroll") for(int r_=0;r_<16;++r_){P0[r_]=-INFINITY;P1[r_]=-INFINITY;} } }while(0)
  bool resc=false;
  #define START(P0,P1) do{ const float rm=rowmax(P0,P1); resc=false; \
    { const float dl=max2f(rm,-100.f); mhat=fadd_s(mhat,dl); \
      _Pragma("unroll") for(int r=0;r<16;++r){P0[r]=fsub_s(P0[r],dl);P1[r]=fsub_s(P1[r],dl);} \
      } \
    _Pragma("unroll") for(int r=0;r<16;++r)P0[r]=__builtin_amdgcn_exp2f(P0[r]); }while(0)
  #define RESC() do{ if(resc){ asm volatile("s_waitcnt lgkmcnt(0)":::"memory"); \
      _Pragma("unroll") for(int d_=0;d_<2;++d_) _Pragma("unroll") for(int r=0;r<16;++r)o[d_][r]*=wsf[crow(r,hi)]; } }while(0)
  f32x16 pA0,pA1,pB0,pB1;
  int sl_prev=0,sl_cur=0,sl_next=SLOTB;
  #define ROT() do{sl_prev=sl_cur;sl_cur=sl_next;sl_next=(sl_next==(NSLOT-1)*SLOTB)?0:sl_next+SLOTB;}while(0)
  DMA_K(2,2*SLOTB);
  WAIT_BAR(3);
  qkt(pA0,pA1,Kbase,qr,r32,hi);asm volatile("s_nop 15\n\ts_nop 7":"+v"(pA0),"+v"(pA1));CMASK(pA0,pA1,0);
  START(pA0,pA1);
  _Pragma("unroll") for(int r=0;r<16;++r)pA1[r]=__builtin_amdgcn_exp2f(pA1[r]);
  WAIT_BAR(0);
  DMA_K(3,0);DMA_V(1,SLOTB);
  ROT();
  kload8(kf,kp0+sl_cur);
  WAIT_BAR(2);
  s16x4 vlo[8],vhi[8]; u32x4 pw0,pw1,pw2,pw3;
  #define PKW(P,B) cvtpk_s(P[B],P[B+1])
  #define PAF(k) __builtin_bit_cast(bf16x8,pw##k)
  #define VFR(i) (bf16x8){vlo[i][0],vlo[i][1],vlo[i][2],vlo[i][3],vhi[i][0],vhi[i][1],vhi[i][2],vhi[i][3]}
  #define PIN(x) asm volatile("":"+v"(x))
  #define MX3(a,b,c) __builtin_fmaxf(__builtin_fmaxf((a),(b)),(c))
  #define GAPA(MF,A0,A1,A2,A3,W0,W1,PW) do{ MF; sacc+=A0; sacc+=A1; sacc+=A2; sacc+=A3; PIN(sacc); W0; W1; PIN(PW); SBAR(); }while(0)
  #define EX(v) __builtin_amdgcn_exp2f(v)
  #define GAPB(MF,X,B) do{ MF; X[B]=EX(X[B]); X[B+1]=EX(X[B+1]); X[B+2]=EX(X[B+2]); X[B+3]=EX(X[B+3]); PIN(X); SBAR(); }while(0)
  #define VRD(i) do{ vlo[i]=vtr(vp_+(((i)>>2)*4096+((i)&3)*1024)); vhi[i]=vtr(vp_+(((i)>>2)*4096+((i)&3)*1024+512)); }while(0)
  #define KRD(G,j) do{ if(G){ kload2(kf,kp0+sl_next,j); SBAR(); } }while(0)
  #define STEP(C0,C1,P0,P1,t,GK,GV,GL) do{ SBAR(); \
    const lds_cptr vp_=vp0+sl_prev; \
    VRD(0); SBAR(); float sacc=(P0[0]+P0[1]); \
    GAPA(C0=__builtin_amdgcn_mfma_f32_32x32x16_bf16(kf[0],qr[0],f32x16{},0,0,0), P0[2],P0[3],P0[4],P0[5],     pw0[0]=PKW(P0,0), pw0[1]=PKW(P0,2), pw0); \
    VRD(4); SBAR(); GAPA(C1=__builtin_amdgcn_mfma_f32_32x32x16_bf16(kf[1],qr[0],f32x16{},0,0,0), P0[6],P0[7],P0[8],P0[9],     pw0[2]=PKW(P0,4), pw0[3]=PKW(P0,6), pw0); \
    VRD(1); SBAR(); GAPA(C0=__builtin_amdgcn_mfma_f32_32x32x16_bf16(kf[2],qr[1],C0,0,0,0),   P0[10],P0[11],P0[12],P0[13], pw1[0]=PKW(P0,8), pw1[1]=PKW(P0,10), pw1); \
    VRD(5); SBAR(); GAPA(C1=__builtin_amdgcn_mfma_f32_32x32x16_bf16(kf[3],qr[1],C1,0,0,0),   P0[14],P0[15],P1[0],P1[1],   pw1[2]=PKW(P0,12),pw1[3]=PKW(P0,14), pw1); \
    VRD(2); SBAR(); GAPA(C0=__builtin_amdgcn_mfma_f32_32x32x16_bf16(kf[4],qr[2],C0,0,0,0),   P1[2],P1[3],P1[4],P1[5],     pw2[0]=PKW(P1,0), pw2[1]=PKW(P1,2), pw2); \
    VRD(6); SBAR(); GAPA(C1=__builtin_amdgcn_mfma_f32_32x32x16_bf16(kf[5],qr[2],C1,0,0,0),   P1[6],P1[7],P1[8],P1[9],     pw2[2]=PKW(P1,4), pw2[3]=PKW(P1,6), pw2); \
    VRD(3); SBAR(); GAPA(C0=__builtin_amdgcn_mfma_f32_32x32x16_bf16(kf[6],qr[3],C0,0,0,0),   P1[10],P1[11],P1[12],P1[13], pw3[0]=PKW(P1,8), pw3[1]=PKW(P1,10), pw3); \
    VRD(7); SBAR(); GAPA(C1=__builtin_amdgcn_mfma_f32_32x32x16_bf16(kf[7],qr[3],C1,0,0,0),   P1[14],P1[15],0.f,0.f,       pw3[2]=PKW(P1,12),pw3[3]=PKW(P1,14), pw3); \
    l_reg+=sacc; \
    if(GK){DMA_K((t)+3,sl_cur);} if(GV){DMA_V((t)+1,sl_next);} \
    _Pragma("unroll") for(int r=0;r<16;++r){C0[r]-=mhat;C1[r]-=mhat;} \
    CMASK(C0,C1,t); \
    { float a=MX3(C0[0],C0[1],C1[0]),b=MX3(C0[2],C0[3],C1[1]); a=MX3(a,C1[2],C1[3]); \
      _Pragma("unroll") for(int r=4;r<16;r+=4){a=MX3(a,C0[r],C0[r+1]);b=MX3(b,C0[r+2],C0[r+3]);a=MX3(a,C1[r],C1[r+1]);b=MX3(b,C1[r+2],C1[r+3]);} \
      float rm=__builtin_fmaxf(a,b); { auto rr=__builtin_amdgcn_permlane32_swap(__float_as_uint(rm),__float_as_uint(rm),false,false); rm=__builtin_fmaxf(__uint_as_float(rr[0]),__uint_as_float(rr[1])); } \
      resc=false; \
      if(__builtin_expect(__any(rm>(float)THRL),0)){ const float dl=__builtin_fmaxf(rm,0.f); mhat+=dl; \
        _Pragma("unroll") for(int r=0;r<16;++r){C0[r]-=dl;C1[r]-=dl;} \
        const float f=__builtin_amdgcn_exp2f(-dl); l_reg*=f; if(hi==0)wsf[r32]=f; resc=true; } } \
    SBAR(); \
    GAPB(o[0]=__builtin_amdgcn_mfma_f32_32x32x16_bf16(PAF(0),VFR(0),o[0],0,0,0), C0,0); \
    GAPB(o[1]=__builtin_amdgcn_mfma_f32_32x32x16_bf16(PAF(0),VFR(4),o[1],0,0,0), C0,4); \
    KRD(GL,0); GAPB(o[0]=__builtin_amdgcn_mfma_f32_32x32x16_bf16(PAF(1),VFR(1),o[0],0,0,0), C0,8); \
    KRD(GL,1); GAPB(o[1]=__builtin_amdgcn_mfma_f32_32x32x16_bf16(PAF(1),VFR(5),o[1],0,0,0), C0,12); \
    KRD(GL,2); GAPB(o[0]=__builtin_amdgcn_mfma_f32_32x32x16_bf16(PAF(2),VFR(2),o[0],0,0,0), C1,0); \
    KRD(GL,3); GAPB(o[1]=__builtin_amdgcn_mfma_f32_32x32x16_bf16(PAF(2),VFR(6),o[1],0,0,0), C1,4); \
    GAPB(o[0]=__builtin_amdgcn_mfma_f32_32x32x16_bf16(PAF(3),VFR(3),o[0],0,0,0), C1,8); \
    GAPB(o[1]=__builtin_amdgcn_mfma_f32_32x32x16_bf16(PAF(3),VFR(7),o[1],0,0,0), C1,12); \
    }while(0)
  int t=1;
  for(;t+5<NT;t+=2){
    STEP(pB0,pB1,pA0,pA1,t,true,true,true);     WAIT_BAR(2); RESC(); ROT();
    STEP(pA0,pA1,pB0,pB1,t+1,true,true,true);   WAIT_BAR(2); RESC(); ROT();
  }
  #undef CMASK
  #define CMASK(P0,P1,t) do{int jb_=(t)-(NT-4); if(jb_>=0)cmask(P0,P1,jb_,qrel,hi); else if(MOBA_MASK_ON && !(((*SELW())>>((t)>>2))&1u)){ _Pragma("unroll") for(int r_=0;r_<16;++r_){P0[r_]=-INFINITY;P1[r_]=-INFINITY;} } }while(0)
  #define ENDW(tt) do{ if((tt)+3<NT){WAIT_BAR(2);} else if((tt)+2<NT){WAIT_BAR(1);} else {WAIT_BAR(0);} }while(0)
  for(;t+1<NT;t+=2){
    STEP(pB0,pB1,pA0,pA1,t,(t+3<NT),(t+1<NT),(t+1<NT));       ENDW(t);   RESC(); ROT();
    STEP(pA0,pA1,pB0,pB1,t+1,(t+4<NT),(t+2<NT),(t+2<NT));     ENDW(t+1); RESC(); ROT();
  }
  STEP(pB0,pB1,pA0,pA1,NT-1,false,false,false); RESC();
  { float sacc=pB0[0]+pB0[1]; _Pragma("unroll") for(int r=2;r<16;++r)sacc+=pB0[r]; _Pragma("unroll") for(int r=0;r<16;++r)sacc+=pB1[r]; l_reg+=sacc;
    pw0=(u32x4){PKW(pB0,0),PKW(pB0,2),PKW(pB0,4),PKW(pB0,6)};pw1=(u32x4){PKW(pB0,8),PKW(pB0,10),PKW(pB0,12),PKW(pB0,14)};pw2=(u32x4){PKW(pB1,0),PKW(pB1,2),PKW(pB1,4),PKW(pB1,6)};pw3=(u32x4){PKW(pB1,8),PKW(pB1,10),PKW(pB1,12),PKW(pB1,14)};
    SBAR(); pv(o,vb0+sl_cur,PAF(0),PAF(1),PAF(2),PAF(3)); }
  #undef PKW
  #undef PAF
  #undef VFR
  #undef PIN
  #undef MX3
  #undef GAPA
  #undef GAPB
  #undef EX
  #undef VRD
  #undef KRD
  #undef STEP
  #undef ENDW
  {auto rr=__builtin_amdgcn_permlane32_swap(__float_as_uint(l_reg),__float_as_uint(l_reg),false,false);l_reg=__uint_as_float(rr[0])+__uint_as_float(rr[1]);}
  if(hi==0)wsf[32+r32]=l_reg;asm volatile("s_waitcnt lgkmcnt(0)":::"memory");
  float rli[16];
  #pragma unroll
  for(int r=0;r<16;++r)rli[r]=__builtin_amdgcn_rcpf(wsf[32+crow(r,hi)]);
  bf16*Ow=O+(rowbase+q0+wid*QBLK)*DM+h*D;
  { bf16*stg=(bf16*)(shm+LDS_OST)+wid*2048;
    #pragma unroll
    for(int r=0;r<16;++r){const int orow=crow(r,hi);
      #pragma unroll
      for(int d0=0;d0<2;++d0)stg[orow*64+d0*32+r32]=__float2bfloat16(o[d0][r]*rli[r]);}
    asm volatile("s_waitcnt lgkmcnt(0)":::"memory");
    #pragma unroll
    for(int i=0;i<4;++i){const int row=i*8+(lane>>3),ch=lane&7; const u32x4 v=*(const u32x4*)(stg+row*64+ch*8); ATTN_STORE16(Ow+(long)row*DM+ch*8,v);} }
  asm volatile("s_waitcnt lgkmcnt(0)\n\ts_barrier":::"memory");
  #undef SELW
  #undef DMA_K
  #undef DMA_V
  #undef CMASK
  #undef START
  #undef RESC
  #undef ROT
}
constexpr int ATTN_LDS_BYTES=LDS_BYTES;
struct AttnTensors { const bf16* Q; const bf16* K; const bf16* V; bf16* O; const unsigned* SEL; };
struct AttnUnit { int bh; int qb; };
struct StaticOrder {
  int vcu;
  __device__ __forceinline__ explicit StaticOrder(int grid,int block):vcu((block%8)*(grid/8)+block/8){}
  __device__ __forceinline__ bool next(int i,AttnUnit&u)const{ if(i>=4)return false; const int s=vcu&7; u.bh=vcu>>3; u.qb=(i==0)?s:(i==1)?15-s:(i==2)?16+s:31-s; return true; }
  __device__ __forceinline__ void a_ready(const AttnUnit&)const{}
  __device__ __forceinline__ void done(const AttnUnit&)const{}
};
template<class Sched,int THRL=8> __device__ __forceinline__ void attn_phase(char*lds,const AttnTensors&T,const Sched&S,int wave){
  AttnUnit u;
  for(int i=0;S.next(i,u);++i){ S.a_ready(u); attn_unit<THRL>(u.bh/NHEAD,u.bh%NHEAD,u.qb,T.Q,T.K,T.V,T.O,T.SEL,lds,wave); S.done(u); }
}
#undef SBAR
#undef WAIT_BAR
}

constexpr int NWAVES = 8;
constexpr int BATCH = 2, T = 8192, D = 1024, H = 16, HD = 64, M = BATCH * T;
constexpr int FF = 2816, FFE = 3584, NE = 8, MOE_ROWS = 34816  ;
constexpr float LN_EPS = 1e-5f, GN_EPS = 64e-5f, ALPHA = 1.6817928305074292f  ;
constexpr size_t MiB = 1u << 20;
constexpr size_t WS_CTL = 0, CTL_ZERO_BYTES = 1 * MiB;
constexpr size_t WS_KMEAN = 1 * MiB;
constexpr size_t WS_SEL = 2 * MiB;
constexpr size_t WS_TOKE = 3 * MiB;
constexpr size_t WS_TOKW = WS_TOKE + 128 * 1024;
constexpr size_t WS_TOKR = WS_TOKW + 128 * 1024;
constexpr size_t WS_GW = WS_TOKR + 128 * 1024;
constexpr size_t WS_BLKCNT = WS_GW + 256 * 1024;
constexpr size_t WS_WMIX = 16 * MiB;
constexpr size_t WS_WFFN = 32 * MiB;
constexpr size_t WS_H = 200 * MiB;
constexpr size_t WS_HB = 264 * MiB;
constexpr size_t WS_K = 296 * MiB, WS_V = 328 * MiB;
constexpr size_t WS_VFIRST = WS_K;
constexpr size_t WS_Y = WS_V;
constexpr size_t WS_SCR = 360 * MiB;
constexpr size_t WS_END = 896 * MiB;
constexpr size_t RS_XM = WS_SCR;
constexpr size_t RS_KP = WS_SCR, RS_AP = WS_SCR + 64 * MiB, RS_VP = WS_SCR + 128 * MiB;
constexpr size_t RS_RKV = WS_SCR + 192 * MiB;
constexpr size_t RS_PRE = RS_RKV;
constexpr size_t RS_LH = WS_SCR + 288 * MiB;
constexpr size_t RS_YG = RS_LH;
constexpr size_t RS_DEC = WS_SCR + 320 * MiB;
constexpr size_t RS_AB = WS_SCR + 384 * MiB;
constexpr size_t RS_VG = WS_SCR + 448 * MiB;
constexpr size_t RS_GG = WS_SCR + 480 * MiB;
constexpr size_t BS_Q = WS_SCR, BS_PRE = WS_SCR + 32 * MiB, BS_O = WS_SCR + 96 * MiB;
constexpr size_t FS_HID = WS_SCR, FS_PRE = WS_SCR + 88 * MiB;
constexpr size_t ES_XG = WS_SCR, ES_HID = WS_SCR + 68 * MiB, ES_YP = WS_SCR + 306 * MiB;
static_assert(RS_GG + 32 * MiB <= WS_END && ES_YP + 136 * MiB <= WS_END && FS_PRE + 64 * MiB <= WS_END, "d_ws map");
constexpr size_t RW_LSTRIDE = 872 * MiB - WS_WMIX;
constexpr size_t WM_BT1 = WS_WMIX, WM_BT2 = WS_WMIX + 8 * MiB, WM_OUT = WS_WMIX + 10 * MiB;
constexpr size_t WM_QKV = WS_WMIX, WM_O = WS_WMIX + 8 * MiB;
constexpr size_t WF_GU = WS_WFFN, WF_DN = WS_WFFN + 12 * MiB;
constexpr size_t WE_GU = WS_WFFN, WE_DN = WS_WFFN + 112 * MiB;
constexpr int CW_TMO = 0, CW_CODE = 1, CW_BAR = 4096;
constexpr int RING_OFF = 0, RING_BYTES = 131072;
constexpr int LDSCTL_OFF = RING_BYTES, MISC_OFF = LDSCTL_OFF + 320;
constexpr int LDS_BYTES = 147456;
static_assert(MISC_OFF + 128 <= LDS_BYTES, "LDS map");

#define GAS __attribute__((address_space(1)))
#define LAS __attribute__((address_space(3)))
typedef unsigned short bf16;
typedef unsigned v4u __attribute__((ext_vector_type(4)));
typedef float f32x4 __attribute__((ext_vector_type(4)));
typedef short bf16x8 __attribute__((ext_vector_type(8)));
typedef GAS unsigned gu32;
typedef GAS unsigned long long gu64;
#define RLX_AGENT __ATOMIC_RELAXED, __HIP_MEMORY_SCOPE_AGENT
#define LDS_WAIT() asm volatile("s_waitcnt lgkmcnt(0)" ::: "memory")
#define VM_WAIT() asm volatile("s_waitcnt vmcnt(0)" ::: "memory")
__device__ __forceinline__ unsigned long long rt() { return __builtin_amdgcn_s_memrealtime(); }
__device__ __forceinline__ unsigned f2bf(float f) { unsigned u = __builtin_bit_cast(unsigned, f); return (u + 0x7fffu + ((u >> 16) & 1u)) >> 16; }
__device__ __forceinline__ unsigned pk2(float lo, float hi) { return f2bf(lo) | (f2bf(hi) << 16); }

#define XB_TMO      128
#define XB_XCNT(j)  (256  + 64 * (j))
#define XB_XSUB(j)  (1280 + 64 * (j))
#define XB_XGEN(j)  (2304 + 64 * (j))
#define XB_TOP      3328
#define XB_TOPGEN   3392
#define XCD_BAR_WORDS 3456
#define XB_SPIN_CAP (1u << 18)

__device__ __forceinline__ unsigned xb_ld(unsigned* p)              { return __hip_atomic_load(p, __ATOMIC_RELAXED, __HIP_MEMORY_SCOPE_AGENT); }
__device__ __forceinline__ unsigned xb_add(unsigned* p, unsigned v) { return __hip_atomic_fetch_add(p, v, __ATOMIC_RELAXED, __HIP_MEMORY_SCOPE_AGENT); }
__device__ __forceinline__ unsigned xb_xcc_id() { return (unsigned)__builtin_amdgcn_s_getreg((3 << 11) | 20) & 0xFu; }
#define XB_SPIN(cond, bar) do { unsigned _sp = 0; while (cond) { __builtin_amdgcn_s_sleep(1); \
    if ((++_sp & 255u) == 0u) { if (xb_ld(&(bar)[XB_TMO])) break; if (_sp > XB_SPIN_CAP) { atomicAdd(&(bar)[XB_TMO], 1u); break; } } } } while (0)

struct XcdBarrier {
    unsigned* bar; unsigned x;
    volatile LAS unsigned* st;
};

__device__ __forceinline__ XcdBarrier xcd_barrier_post(unsigned* bar, volatile LAS unsigned* st, bool t0  ) {
    XcdBarrier b; b.bar = bar; b.x = xb_xcc_id(); b.st = st;
    if (t0) (void)xb_add(&bar[XB_XCNT(b.x)], 1u);
    return b;
}
__device__ __forceinline__ void xcd_barrier_complete(unsigned* bar, unsigned x, unsigned& nloc, unsigned& nx) {
    const unsigned G = gridDim.x * gridDim.y * gridDim.z;
    unsigned sum, cnt, mine, sp = 0u;
    for (;;) {
        sum = 0u; cnt = 0u; mine = 0u;
#pragma unroll
        for (unsigned j = 0; j < 16; ++j) { const unsigned c = xb_ld(&bar[XB_XCNT(j)]); sum += c; cnt += (c > 0u) ? 1u : 0u; mine = (j == x) ? c : mine; }
        if (sum == G) break;
        __builtin_amdgcn_s_sleep(1);
        if ((++sp & 255u) == 0u) { if (xb_ld(&bar[XB_TMO])) break; if (sp > XB_SPIN_CAP) { atomicAdd(&bar[XB_TMO], 1u); break; } }
    }
    nloc = mine > 0u ? mine : 1u; nx = cnt > 0u ? cnt : 1u;
}

__device__ __forceinline__ void xcd_barrier(const XcdBarrier& b, bool t0  ) {
    asm volatile("s_waitcnt vmcnt(0)" ::: "memory");
    __syncthreads();
    if (t0) {
        unsigned* bar = b.bar;
        __builtin_amdgcn_s_waitcnt(0);
        unsigned nloc = b.st[0], nx = b.st[1];
        if (nloc == 0u) { xcd_barrier_complete(bar, b.x, nloc, nx); b.st[0] = nloc; b.st[1] = nx; }
        const unsigned old = xb_add(&bar[XB_XSUB(b.x)], 1u);
        const unsigned gen = old / nloc;
        if (old + 1u == (gen + 1u) * nloc) {
            __builtin_amdgcn_fence(__ATOMIC_RELEASE, "agent");
            asm volatile("s_waitcnt vmcnt(0)" ::: "memory");
            const unsigned og = xb_add(&bar[XB_TOP], 1u);
            const unsigned tg = og / nx;
            if (og + 1u == (tg + 1u) * nx) xb_add(&bar[XB_TOPGEN], 1u);
            else XB_SPIN(xb_ld(&bar[XB_TOPGEN]) == tg, bar);
#ifdef XB_L2_INV
            __builtin_amdgcn_fence(__ATOMIC_ACQUIRE, "");
#else
            __builtin_amdgcn_fence(__ATOMIC_ACQUIRE, "agent");
#endif
            xb_add(&bar[XB_XGEN(b.x)], 1u);
            asm volatile("s_waitcnt vmcnt(0)" ::: "memory");
        } else {
            XB_SPIN(xb_ld(&bar[XB_XGEN(b.x)]) == gen, bar);
            __builtin_amdgcn_fence(__ATOMIC_ACQUIRE, "agent");
            asm volatile("s_waitcnt vmcnt(0)" ::: "memory");
        }
    }
    __syncthreads();
}

struct Args { const float* in[33]; float* out; unsigned char* ws; };
enum InIdx { I_X = 0, I_MU, I_WRKV, I_WOUT, I_W0, I_W1, I_W2, I_A0, I_A1, I_A2, I_V0, I_V1, I_V2, I_G1, I_G2, I_KK, I_KA, I_RK, I_GNG, I_GNB,
             I_MK, I_MV, I_MQ, I_MO, I_FG, I_FU, I_FD, I_ROUTER, I_EG, I_EU, I_ED, I_LNG, I_LNB };
struct Frame {
    LAS unsigned char* lds; volatile LAS unsigned* MISC; gu32* ctl; unsigned char* ws;
    int tid, lane, wave, vcu, G, gw, NGW;
};
typedef float f32x2 __attribute__((ext_vector_type(2)));
typedef unsigned u32x2 __attribute__((ext_vector_type(2)));
__device__ __forceinline__ float dpp_sum16(float v) {
    v += __builtin_bit_cast(float, __builtin_amdgcn_update_dpp(0, __builtin_bit_cast(int, v), 0xB1, 0xF, 0xF, true));
    v += __builtin_bit_cast(float, __builtin_amdgcn_update_dpp(0, __builtin_bit_cast(int, v), 0x4E, 0xF, 0xF, true));
    v += __builtin_bit_cast(float, __builtin_amdgcn_update_dpp(0, __builtin_bit_cast(int, v), 0x141, 0xF, 0xF, true));
    v += __builtin_bit_cast(float, __builtin_amdgcn_update_dpp(0, __builtin_bit_cast(int, v), 0x140, 0xF, 0xF, true));
    return v;
}
__device__ __forceinline__ float wave_sum(float v, int lane) {
    v = dpp_sum16(v);
    v += __builtin_bit_cast(float, __builtin_amdgcn_ds_bpermute((lane ^ 16) << 2, __builtin_bit_cast(int, v)));
    v += __builtin_bit_cast(float, __builtin_amdgcn_ds_bpermute((lane ^ 32) << 2, __builtin_bit_cast(int, v)));
    return v;
}
__device__ __forceinline__ float sum16(float v) { return dpp_sum16(v); }
__device__ __forceinline__ float bf2f(unsigned short b) { return __uint_as_float((unsigned)b << 16); }
__device__ __forceinline__ f32x4 bf4_to_f32(u32x2 w) { f32x4 r; r.x = __uint_as_float(w.x << 16); r.y = __uint_as_float(w.x & 0xffff0000u); r.z = __uint_as_float(w.y << 16); r.w = __uint_as_float(w.y & 0xffff0000u); return r; }
__device__ __forceinline__ u32x2 f32_to_bf4(f32x4 v) { u32x2 w; w.x = pk2(v.x, v.y); w.y = pk2(v.z, v.w); return w; }

__device__ __forceinline__ void tr_item(const float* W, int ldw, int Kr, int Nr, int nblk, bf16* WT, int ldt, int row0, int mode, LAS float* scr, int item, int lane) {
    const int kb = item / nblk, nb = item - kb * nblk, k0 = 64 * kb, n0 = 32 * nb;
    const int n = n0 + (lane & 31);
#pragma unroll 8
    for (int i = 0; i < 32; ++i) { const int kk = 2 * i + (lane >> 5), k = k0 + kk; float v = 0.f; if (k < Kr && n < Nr) v = W[(size_t)k * ldw + n]; scr[kk * 33 + (lane & 31)] = v; }
    LDS_WAIT(); asm volatile("" ::: "memory");
    const int c = lane & 7;
#pragma unroll
    for (int j = 0; j < 4; ++j) { const int nl = (lane >> 3) + 8 * j, nn = n0 + nl; const LAS float* s = scr + (8 * c) * 33 + nl;
        const int drow = mode == 0 ? row0 + nn : row0 + ((nn >> 7) << 8) + (nn & 127);
        v4u o; o.x = pk2(s[0 * 33], s[1 * 33]); o.y = pk2(s[2 * 33], s[3 * 33]); o.z = pk2(s[4 * 33], s[5 * 33]); o.w = pk2(s[6 * 33], s[7 * 33]);
        *(GAS v4u*)(WT + (size_t)drow * ldt + k0 + 8 * c) = o; }
    LDS_WAIT(); asm volatile("" ::: "memory");
}
#define KIN(i) ({ const __attribute__((address_space(4))) char* k_ = (const __attribute__((address_space(4))) char*)__builtin_amdgcn_kernarg_segment_ptr(); asm volatile("" : "+s"(k_)); const GAS float* g_ = (const GAS float*)(*(const float* const __attribute__((address_space(4)))*)(k_ + 8 * (i))); asm volatile("" : "+s"(g_)); (const float*)g_; })
#define CONV_BEGIN() F.lane = fresh_lane(); F.tid = F.wave * 64 + F.lane; asm volatile("" : "+s"(F.G), "+s"(F.wave), "+s"(F.vcu), "+s"(F.gw), "+s"(F.NGW)); GAS unsigned char* cws0_ = (GAS unsigned char*)F.ws; asm volatile("" : "+s"(cws0_)); unsigned char* cws_ = (unsigned char*)cws0_; LAS float* scr_ = (LAS float*)(F.lds + RING_OFF + F.wave * 16384); int it_ = F.gw, base_ = 0
#define JOB(W, ldw, Kr, Nr, Kp, Np, WT, ldt, row0, mode) do { const int nblk_ = (Np) / 32, n_ = ((Kp) / 64) * nblk_; \
    while (it_ < base_ + n_) { tr_item((W), (ldw), (Kr), (Nr), nblk_, (WT), (ldt), (row0), (mode), scr_, it_ - base_, F.lane); it_ += F.NGW; } base_ += n_; } while (0)

__device__ __forceinline__ void conv_rwkv(Frame& F, int l) {
    CONV_BEGIN();
    cws_ += (size_t)l * RW_LSTRIDE; bf16* BT1 = (bf16*)(cws_ + WM_BT1); bf16* BT2 = (bf16*)(cws_ + WM_BT2); bf16* WO = (bf16*)(cws_ + WM_OUT);
    for (int c = 0; c < 3; ++c) JOB(KIN(I_WRKV) + (size_t)(l * 3 + c) * D * D, D, D, D, D, D, BT1, D, c * D, 0);
    JOB(KIN(I_W1) + (size_t)l * D * 64, 64, D, 64, D, 256, BT1, D, 3072, 0);
    JOB(KIN(I_A1) + (size_t)l * D * 64, 64, D, 64, D, 256, BT1, D, 3328, 0);
    JOB(KIN(I_V1), 32, D, (l == 0 ? 0 : 32), D, 256, BT1, D, 3584, 0);
    JOB(KIN(I_G1) + (size_t)l * D * 160, 160, D, 160, D, 256, BT1, D, 3840, 0);
    JOB(KIN(I_W2) + (size_t)l * 64 * D, D, 64, D, 256, D, BT2, 256, 0, 0);
    JOB(KIN(I_A2) + (size_t)l * 64 * D, D, 64, D, 256, D, BT2, 256, 1024, 0);
    JOB(KIN(I_V2), D, (l == 0 ? 0 : 32), D, 256, D, BT2, 256, 2048, 0);
    JOB(KIN(I_G2) + (size_t)l * 160 * D, D, 160, D, 256, D, BT2, 256, 3072, 0);
    JOB(KIN(I_WOUT) + (size_t)l * D * D, D, D, D, D, D, WO, D, 0, 0);
}
__device__ __forceinline__ void conv_moba(Frame& F, int j) {
    CONV_BEGIN();
    bf16* WQ = (bf16*)(cws_ + WM_QKV); bf16* WO = (bf16*)(cws_ + WM_O);
    JOB(KIN(I_MQ) + (size_t)j * D * D, D, D, D, D, D, WQ, D, 0, 0);
    if (j == 0) { JOB(KIN(I_MK), D, D, D, D, D, WQ, D, D, 0); JOB(KIN(I_MV), D, D, D, D, D, WQ, D, 2 * D, 0); }
    JOB(KIN(I_MO) + (size_t)j * D * D, D, D, D, D, D, WO, D, 0, 0);
}
__device__ __forceinline__ void conv_dense(Frame& F, int e) {
    CONV_BEGIN();
    bf16* GU = (bf16*)(cws_ + WF_GU); bf16* DN = (bf16*)(cws_ + WF_DN);
    JOB(KIN(I_FG) + (size_t)e * D * FF, FF, D, FF, D, FF, GU, D, 0, 1);
    JOB(KIN(I_FU) + (size_t)e * D * FF, FF, D, FF, D, FF, GU, D, 128, 1);
    JOB(KIN(I_FD) + (size_t)e * FF * D, D, FF, D, FF, D, DN, FF, 0, 0);
}
__device__ __forceinline__ void conv_moe(Frame& F, int e) {
    CONV_BEGIN();
    bf16* GU = (bf16*)(cws_ + WE_GU); bf16* DN = (bf16*)(cws_ + WE_DN);
    for (int x = 0; x < NE; ++x) {
        JOB(KIN(I_EG) + (size_t)(e * NE + x) * D * FFE, FFE, D, FFE, D, FFE, GU, D, x * 2 * FFE, 1);
        JOB(KIN(I_EU) + (size_t)(e * NE + x) * D * FFE, FFE, D, FFE, D, FFE, GU, D, x * 2 * FFE + 128, 1);
        JOB(KIN(I_ED) + (size_t)(e * NE + x) * FFE * D, D, FFE, D, FFE, D, DN, FFE, x * D, 0);
    }
}

__device__ __forceinline__ void ln_stats(const f32x4 (&v)[4], float& mean, float& rstd, int lane) {
    float s = 0.f;
#pragma unroll
    for (int j = 0; j < 4; ++j) s += (v[j].x + v[j].y) + (v[j].z + v[j].w);
    mean = wave_sum(s, lane) * (1.f / D); float s2 = 0.f;
#pragma unroll
    for (int j = 0; j < 4; ++j) { const f32x4 d = v[j] - mean; s2 += (d.x * d.x + d.y * d.y) + (d.z * d.z + d.w * d.w); }
    rstd = 1.f / sqrtf(wave_sum(s2, lane) * (1.f / D) + LN_EPS);
}
template <int SRC, bool ROUTER>
__device__ __forceinline__ void ln_phase(Frame& F, const float* PRE, const float* Hin, const float* YP, const int* tokr, const float* gln, const float* bln,
                                         float* Hout, bf16* HB, const float* router, int* toke, float* tokw, int* blkcnt) {
    LAS int* cnt = (LAS int*)(F.lds + RING_OFF + 131072 - 64);
    if (ROUTER) { if (F.tid < 8) cnt[F.tid] = 0; __syncthreads(); }
    f32x4 g4[4], b4[4];
#pragma unroll
    for (int j = 0; j < 4; ++j) { g4[j] = *(const f32x4*)(gln + 4 * F.lane + 256 * j); b4[j] = *(const f32x4*)(bln + 4 * F.lane + 256 * j); }
    const int rpb = M / F.G, rpw = rpb / NWAVES;
    for (int i = 0; i < rpw; ++i) {
        const int m = blockIdx.x * rpb + F.wave * rpw + i;
        f32x4 v[4];
        if (SRC == 0) {
#pragma unroll
            for (int j = 0; j < 4; ++j) v[j] = *(const f32x4*)(PRE + (size_t)m * D + 4 * F.lane + 256 * j);
        } else {
            const int r0 = tokr[2 * m], r1 = tokr[2 * m + 1];
#pragma unroll
            for (int j = 0; j < 4; ++j) { const int c = 4 * F.lane + 256 * j;
                v[j] = *(const f32x4*)(Hin + (size_t)m * D + c) * ALPHA + *(const f32x4*)(YP + (size_t)r0 * D + c) + *(const f32x4*)(YP + (size_t)r1 * D + c); }
        }
        float mean, rstd; ln_stats(v, mean, rstd, F.lane);
#pragma unroll
        for (int j = 0; j < 4; ++j) { v[j] = (v[j] - mean) * rstd * g4[j] + b4[j];
            *(f32x4*)(Hout + (size_t)m * D + 4 * F.lane + 256 * j) = v[j];
            if (HB) *(u32x2*)(HB + (size_t)m * D + 4 * F.lane + 256 * j) = f32_to_bf4(v[j]); }
        if (ROUTER) {
            float lg[8];
#pragma unroll
            for (int e = 0; e < 8; ++e) lg[e] = 0.f;
#pragma unroll
            for (int j = 0; j < 4; ++j)
#pragma unroll
                for (int q = 0; q < 4; ++q) { const float xv = v[j][q]; const f32x4* rp = (const f32x4*)(router + (size_t)(4 * F.lane + 256 * j + q) * 8); const f32x4 ra = rp[0], rb = rp[1];
                    lg[0] += xv * ra.x; lg[1] += xv * ra.y; lg[2] += xv * ra.z; lg[3] += xv * ra.w; lg[4] += xv * rb.x; lg[5] += xv * rb.y; lg[6] += xv * rb.z; lg[7] += xv * rb.w; }
#pragma unroll
            for (int e = 0; e < 8; ++e) lg[e] = wave_sum(lg[e], F.lane);
            int e0 = 0; float l0 = lg[0];
#pragma unroll
            for (int e = 1; e < 8; ++e) if (lg[e] > l0) { l0 = lg[e]; e0 = e; }
            int e1 = -1; float l1 = -INFINITY;
#pragma unroll
            for (int e = 0; e < 8; ++e) if (e != e0 && lg[e] > l1) { l1 = lg[e]; e1 = e; }
            const float w0 = 1.f / (1.f + __expf(l1 - l0)), w1 = 1.f - w0;
            if (F.lane == 0) { toke[2 * m] = e0; toke[2 * m + 1] = e1; tokw[2 * m] = w0; tokw[2 * m + 1] = w1; atomicAdd((int*)&cnt[e0], 1); atomicAdd((int*)&cnt[e1], 1); }
        }
    }
    if (ROUTER) { __syncthreads(); if (F.tid < 8) blkcnt[blockIdx.x * 8 + F.tid] = cnt[F.tid]; }
}

__device__ __forceinline__ void mix_phase(Frame& F, const float* Hx, const float* mu, bf16* XM) {
    f32x4 mu4[6][4];
#pragma unroll
    for (int c = 0; c < 6; ++c)
#pragma unroll
        for (int j = 0; j < 4; ++j) mu4[c][j] = *(const f32x4*)(mu + c * D + 4 * F.lane + 256 * j);
    for (int m = F.gw; m < M; m += F.NGW) {
        const bool first = (m % T) == 0;
#pragma unroll
        for (int j = 0; j < 4; ++j) { const int c0 = 4 * F.lane + 256 * j;
            const f32x4 x = *(const f32x4*)(Hx + (size_t)m * D + c0);
            f32x4 xp = (f32x4){0.f, 0.f, 0.f, 0.f}; if (!first) xp = *(const f32x4*)(Hx + (size_t)(m - 1) * D + c0);
            const f32x4 xx = xp - x;
#pragma unroll
            for (int c = 0; c < 6; ++c) *(u32x2*)(XM + ((size_t)c * M + m) * D + c0) = f32_to_bf4(x + xx * mu4[c][j]); }
    }
}
__device__ __forceinline__ void prep_phase(Frame& F, int l, const bf16* RKV, float* AB, const bf16* LH, const float* v0, const float* v2, bf16* VF, const float* k_k, const float* k_a, float* KP, float* AP, float* VP) {
    f32x4 kk4[4], ka4[4];
#pragma unroll
    for (int j = 0; j < 4; ++j) { kk4[j] = *(const f32x4*)(k_k + 4 * F.lane + 256 * j); ka4[j] = *(const f32x4*)(k_a + 4 * F.lane + 256 * j); }
    for (int m = F.gw; m < M; m += F.NGW) {
#pragma unroll
        for (int j = 0; j < 4; ++j) { const size_t o = (size_t)m * D + 4 * F.lane + 256 * j;
            const f32x4 k = bf4_to_f32(*(const u32x2*)(RKV + (size_t)M * D + o)); const u32x2 vraw = *(const u32x2*)(RKV + (size_t)2 * M * D + o); f32x4 v = bf4_to_f32(vraw);
            const f32x4 a = *(const f32x4*)(AB + o);
            f32x4 kk = k * kk4[j]; const float ss = sum16((kk.x * kk.x + kk.y * kk.y) + (kk.z * kk.z + kk.w * kk.w));
            kk = kk * (1.0f / sqrtf(fmaxf(ss, 1e-24f)));
            const f32x4 kp = k * ((a - 1.0f) * ka4[j] + 1.0f);
            if (l == 0) *(u32x2*)(VF + o) = vraw;
            else {
                f32x4 z = *(const f32x4*)(v0 + 4 * F.lane + 256 * j);
                const bf16* lh = LH + (size_t)m * D + 512;
#pragma unroll 8
                for (int q = 0; q < 32; ++q) z += *(const f32x4*)(v2 + (size_t)q * D + 4 * F.lane + 256 * j) * bf2f(lh[q]);
                f32x4 vg; vg.x = 1.f / (1.f + __expf(-z.x)); vg.y = 1.f / (1.f + __expf(-z.y)); vg.z = 1.f / (1.f + __expf(-z.z)); vg.w = 1.f / (1.f + __expf(-z.w));
                const f32x4 vf = bf4_to_f32(*(const u32x2*)(VF + o)); v = v + (vf - v) * vg; }
            *(f32x4*)(KP + o) = kp; *(f32x4*)(VP + o) = v; *(f32x4*)(AP + o) = -kk; *(f32x4*)(AB + o) = kk * a; }
    }
}
__device__ __forceinline__ void post_phase(Frame& F, const bf16* Y, const bf16* R, const float* KP, const float* VP, const bf16* GG, const float* r_k, const float* gng, const float* gnb, bf16* YG) {
    f32x4 rk4[4], gg4[4], gb4[4];
#pragma unroll
    for (int j = 0; j < 4; ++j) { rk4[j] = *(const f32x4*)(r_k + 4 * F.lane + 256 * j); gg4[j] = *(const f32x4*)(gng + 4 * F.lane + 256 * j); gb4[j] = *(const f32x4*)(gnb + 4 * F.lane + 256 * j); }
    for (int m = F.gw; m < M; m += F.NGW) {
#pragma unroll
        for (int j = 0; j < 4; ++j) { const size_t o = (size_t)m * D + 4 * F.lane + 256 * j;
            const f32x4 y = bf4_to_f32(*(const u32x2*)(Y + o)), r = bf4_to_f32(*(const u32x2*)(R + o)), g = bf4_to_f32(*(const u32x2*)(GG + o));
            const f32x4 kp = *(const f32x4*)(KP + o), vp = *(const f32x4*)(VP + o);
            const float mean = sum16((y.x + y.y) + (y.z + y.w)) * (1.f / 64.f); const f32x4 d = y - mean;
            const float var = sum16((d.x * d.x + d.y * d.y) + (d.z * d.z + d.w * d.w)) * (1.f / 64.f);
            const f32x4 rkk = r * kp * rk4[j]; const float bon = sum16((rkk.x + rkk.y) + (rkk.z + rkk.w));
            const f32x4 yn = d * (1.0f / sqrtf(var + GN_EPS)) * gg4[j] + gb4[j] + vp * bon;
            *(u32x2*)(YG + o) = f32_to_bf4(yn * g); }
    }
}
__device__ __forceinline__ void scan_phase(Frame& F, const bf16* R, const float* DEC, const float* KP, const float* AP, const float* BP, const float* VP, bf16* Y) {
    if (F.vcu >= 128) return;
    constexpr int TS = 32, BUFB = 45056, YB_OFF = 2 * BUFB;
    const int head = F.vcu >> 2, part = F.vcu & 3, b = head >> 4, hh = head & 15;
    const size_t rowb = (size_t)b * T; const int col0 = hh * 64;
    const int tr = F.tid >> 4, pc = F.tid & 15;
    const int tr2 = (F.tid & 255) >> 3, pc2 = F.tid & 7;
    const int rr = F.lane >> 4, q = F.lane & 15, myrow = 16 * part + 4 * F.wave + rr;
    LAS unsigned char* L = F.lds + RING_OFF;
    f32x4 lw, lk, la, lb, lv; v4u lr;
#define SC_LOAD(c) do { const size_t g_ = (rowb + (size_t)(c) * TS + tr) * D + col0 + pc * 4; lw = *(const f32x4*)(DEC + g_); lk = *(const f32x4*)(KP + g_); la = *(const f32x4*)(AP + g_); \
        lb = *(const f32x4*)(BP + g_); lv = *(const f32x4*)(VP + g_); if (F.tid < 256) lr = *(const v4u*)(R + (rowb + (size_t)(c) * TS + tr2) * D + col0 + pc2 * 8); } while (0)
#define SC_STORE(bf) do { LAS unsigned char* d_ = L + (bf) * BUFB + tr * 256 + pc * 16; *(LAS f32x4*)(d_) = lw; *(LAS f32x4*)(d_ + 8192) = lk; *(LAS f32x4*)(d_ + 16384) = la; \
        *(LAS f32x4*)(d_ + 24576) = lb; *(LAS f32x4*)(d_ + 32768) = lv; if (F.tid < 256) *(LAS v4u*)(L + (bf) * BUFB + 40960 + tr2 * 128 + pc2 * 16) = lr; } while (0)
    SC_LOAD(0); SC_STORE(0); __syncthreads();
    f32x4 S = (f32x4){0.f, 0.f, 0.f, 0.f};
    constexpr int NCH = T / TS;
    for (int c = 0; c < NCH; ++c) {
        const int bf = c & 1;
        if (c + 1 < NCH) SC_LOAD(c + 1);
        if (F.wave < 4) {
            const LAS unsigned char* B0 = L + bf * BUFB + q * 16; const LAS unsigned char* Bv = L + bf * BUFB + 32768 + myrow * 4; const LAS unsigned char* Br = L + bf * BUFB + 40960 + q * 8;
            LAS unsigned short* yb = (LAS unsigned short*)(L + YB_OFF + bf * 1024) + 4 * F.wave + rr;
#pragma unroll 4
            for (int t = 0; t < TS; ++t) {
                const f32x4 w4 = *(const LAS f32x4*)(B0 + t * 256), k4 = *(const LAS f32x4*)(B0 + 8192 + t * 256), a4 = *(const LAS f32x4*)(B0 + 16384 + t * 256), b4 = *(const LAS f32x4*)(B0 + 24576 + t * 256);
                const float vv = *(const LAS float*)(Bv + t * 256); const f32x4 r4 = bf4_to_f32(*(const LAS u32x2*)(Br + t * 128));
                const f32x4 sa4 = S * a4; const float sa = dpp_sum16((sa4.x + sa4.y) + (sa4.z + sa4.w));
                S = S * w4 + (b4 * sa + k4 * vv);
                const f32x4 y4 = S * r4; const float y = dpp_sum16((y4.x + y4.y) + (y4.z + y4.w));
                if (q == 0) yb[t * 16] = (unsigned short)f2bf(y);
            }
        }
        if (c + 1 < NCH) SC_STORE(bf ^ 1);
        __syncthreads();
        if (F.tid < 64) { const int t = F.tid >> 1, hf = F.tid & 1; const v4u yv = *(const LAS v4u*)(L + YB_OFF + bf * 1024 + t * 32 + hf * 16);
            *(v4u*)(Y + (rowb + (size_t)c * TS + t) * D + col0 + part * 16 + hf * 8) = yv; }
    }
#undef SC_LOAD
#undef SC_STORE
}

__device__ __forceinline__ void kmean_phase(Frame& F, const bf16* Kb, float* KM) {
    LAS float* red = (LAS float*)(F.lds + RING_OFF);
    for (int u = blockIdx.x; u < 2 * 32 * 4; u += F.G) {
        const int qc = u & 3, blk = (u >> 2) & 31, b = u >> 7; const int c = F.tid & 255, rh = F.tid >> 8;
        const bf16* p = Kb + ((size_t)b * T + blk * 256 + rh * 128) * D + qc * 256 + c; float s = 0.f;
#pragma unroll 8
        for (int r = 0; r < 128; ++r) s += bf2f(p[(size_t)r * D]);
        if (rh == 1) red[c] = s;
        __syncthreads();
        if (rh == 0) { const int col = qc * 256 + c; KM[(((size_t)b * H + (col >> 6)) * 32 + blk) * 64 + (col & 63)] = (s + red[c]) * (1.f / 256.f); }
        __syncthreads();
    }
}
__device__ __forceinline__ void gate_phase(Frame& F, const bf16* Q, const float* KM, unsigned* SEL) {
    LAS float* km = (LAS float*)(F.lds + RING_OFF);
    for (int u = blockIdx.x; u < M / 64; u += F.G) {
        const int m0 = u * 64, b = m0 / T, own = (m0 % T) >> 8;
        for (int i = F.tid; i < 16 * 32 * 16; i += NWAVES * 64) *(LAS f32x4*)(km + 4 * i) = *(const f32x4*)(KM + (size_t)b * 16 * 32 * 64 + 4 * i);
        __syncthreads();
        const int m = m0 + F.lane;
#pragma unroll 1
        for (int hi = 0; hi < 2; ++hi) { const int h = 2 * F.wave + hi;
            float qv[64];
#pragma unroll
            for (int i = 0; i < 8; ++i) { const v4u w = *(const v4u*)(Q + (size_t)m * D + h * 64 + 8 * i);
                qv[8 * i + 0] = __uint_as_float(w.x << 16); qv[8 * i + 1] = __uint_as_float(w.x & 0xffff0000u); qv[8 * i + 2] = __uint_as_float(w.y << 16); qv[8 * i + 3] = __uint_as_float(w.y & 0xffff0000u);
                qv[8 * i + 4] = __uint_as_float(w.z << 16); qv[8 * i + 5] = __uint_as_float(w.z & 0xffff0000u); qv[8 * i + 6] = __uint_as_float(w.w << 16); qv[8 * i + 7] = __uint_as_float(w.w & 0xffff0000u); }
            float v0 = -INFINITY, v1 = -INFINITY, v2 = -INFINITY; int i0 = -1, i1 = -1, i2 = -1;
            for (int j = 0; j < own; ++j) { const LAS f32x4* kp = (const LAS f32x4*)(km + (h * 32 + j) * 64); float s = 0.f;
#pragma unroll
                for (int i = 0; i < 16; ++i) { const f32x4 kv = kp[i]; s += qv[4 * i] * kv.x + qv[4 * i + 1] * kv.y + qv[4 * i + 2] * kv.z + qv[4 * i + 3] * kv.w; }
                if (s > v0) { v2 = v1; i2 = i1; v1 = v0; i1 = i0; v0 = s; i0 = j; } else if (s > v1) { v2 = v1; i2 = i1; v1 = s; i1 = j; } else if (s > v2) { v2 = s; i2 = j; } }
            unsigned mask = 0u; if (i0 >= 0) mask |= 1u << i0; if (i1 >= 0) mask |= 1u << i1; if (i2 >= 0) mask |= 1u << i2;
            SEL[(size_t)m * H + h] = mask; }
        __syncthreads();
    }
}

__device__ __forceinline__ void moe_prefix(Frame& F, const int* blkcnt, LAS int* pre_mine  ) {
    LAS int* tmp = (LAS int*)(F.lds + RING_OFF);
    for (int i = F.tid; i < F.G * 8; i += NWAVES * 64) tmp[i] = blkcnt[i];
    __syncthreads();
    if (F.tid < 8) { int tot = 0, mine = 0; for (int g = 0; g < F.G; ++g) { if (g == (int)blockIdx.x) mine = tot; tot += tmp[g * 8 + F.tid]; }
        pre_mine[F.tid] = mine; pre_mine[8 + F.tid] = tot; }
    __syncthreads();
    if (F.tid == 0) { int p = 0; for (int e = 0; e < 8; ++e) { F.MISC[16 + e] = (unsigned)p; p += (pre_mine[8 + e] + 255) >> 8; } F.MISC[24] = (unsigned)p; }
    __syncthreads();
}
__device__ __forceinline__ void moe_gather_phase(Frame& F, const int* blkcnt, const int* toke, const float* tokw, int* tokr, float* gw, const bf16* HB, bf16* XG) {
    LAS int* pm = (LAS int*)(F.lds + RING_OFF + 16384);
    LAS int* rows = (LAS int*)(F.lds + RING_OFF + 16384 + 64);
    moe_prefix(F, blkcnt, pm);
    const int rpb = M / F.G;
    if (F.wave == 0) {
        const int m = blockIdx.x * rpb + F.lane; const bool ok = F.lane < rpb;
        const int e0 = ok ? toke[2 * m] : -1, e1 = ok ? toke[2 * m + 1] : -1;
        int r0 = 0, r1 = 0;
        for (int e = 0; e < 8; ++e) { const unsigned long long b0 = __ballot(e0 == e), b1 = __ballot(e1 == e); const unsigned long long lt = (1ull << F.lane) - 1ull;
            const int base = (int)F.MISC[16 + e] * 256 + pm[e];
            if (e0 == e) r0 = base + __popcll(b0 & lt);
            if (e1 == e) r1 = base + __popcll(b0) + __popcll(b1 & lt); }
        if (ok) { tokr[2 * m] = r0; tokr[2 * m + 1] = r1; gw[r0] = tokw[2 * m]; gw[r1] = tokw[2 * m + 1]; rows[2 * F.lane] = r0; rows[2 * F.lane + 1] = r1; }
    }
    __syncthreads();
    for (int i = F.wave; i < 2 * rpb; i += NWAVES) { const int m = blockIdx.x * rpb + (i >> 1), r = rows[i];
        const v4u v0 = *(const v4u*)(HB + (size_t)m * D + 8 * F.lane), v1 = *(const v4u*)(HB + (size_t)m * D + 512 + 8 * F.lane);
        *(v4u*)(XG + (size_t)r * D + 8 * F.lane) = v0; *(v4u*)(XG + (size_t)r * D + 512 + 8 * F.lane) = v1; }
    __syncthreads();
}
__device__ __forceinline__ void attn_direct_phase(Frame& F, const bf16* Q, const bf16* Kb, const bf16* Vb, const unsigned* SEL, bf16* O) {
    for (int u = F.gw; u < (M / 64) * H; u += F.NGW) {
        const int h = u & 15, m0 = (u >> 4) * 64, b = m0 / T, t0 = m0 % T, own = t0 >> 8, m = m0 + F.lane, tpos = t0 + F.lane;
        float q[64], o[64];
#pragma unroll
        for (int i = 0; i < 8; ++i) { const v4u w = *(const v4u*)(Q + (size_t)m * D + h * 64 + 8 * i);
            q[8 * i + 0] = __uint_as_float(w.x << 16); q[8 * i + 1] = __uint_as_float(w.x & 0xffff0000u); q[8 * i + 2] = __uint_as_float(w.y << 16); q[8 * i + 3] = __uint_as_float(w.y & 0xffff0000u);
            q[8 * i + 4] = __uint_as_float(w.z << 16); q[8 * i + 5] = __uint_as_float(w.z & 0xffff0000u); q[8 * i + 6] = __uint_as_float(w.w << 16); q[8 * i + 7] = __uint_as_float(w.w & 0xffff0000u); }
#pragma unroll
        for (int i = 0; i < 64; ++i) o[i] = 0.f;
        const unsigned sel = SEL[(size_t)m * H + h];
        float mrun = -INFINITY, l = 0.f;
        for (int j = 0; j <= own; ++j) {
            const bool pastsel = (sel >> j) & 1u;
            if (j < own && !__any(pastsel)) continue;
            const int nk = (j < own) ? 256 : (t0 & 255) + 64;
            for (int kk = 0; kk < nk; ++kk) {
                const int kpos = j * 256 + kk; const size_t ro = ((size_t)b * T + kpos) * D + h * 64;
                float s = 0.f;
#pragma unroll
                for (int i = 0; i < 8; ++i) { const v4u w = *(const v4u*)(Kb + ro + 8 * i);
                    s += q[8 * i + 0] * __uint_as_float(w.x << 16) + q[8 * i + 1] * __uint_as_float(w.x & 0xffff0000u) + q[8 * i + 2] * __uint_as_float(w.y << 16) + q[8 * i + 3] * __uint_as_float(w.y & 0xffff0000u)
                       + q[8 * i + 4] * __uint_as_float(w.z << 16) + q[8 * i + 5] * __uint_as_float(w.z & 0xffff0000u) + q[8 * i + 6] * __uint_as_float(w.w << 16) + q[8 * i + 7] * __uint_as_float(w.w & 0xffff0000u); }
                const bool act = (j < own) ? pastsel : (kpos <= tpos);
                if (act) {
                    if (s > mrun) { const float c = exp2f(mrun - s); l *= c;
#pragma unroll
                        for (int i = 0; i < 64; ++i) o[i] *= c;
                        mrun = s; }
                    const float p = exp2f(s - mrun); l += p;
#pragma unroll
                    for (int i = 0; i < 8; ++i) { const v4u w = *(const v4u*)(Vb + ro + 8 * i);
                        o[8 * i + 0] += p * __uint_as_float(w.x << 16); o[8 * i + 1] += p * __uint_as_float(w.x & 0xffff0000u); o[8 * i + 2] += p * __uint_as_float(w.y << 16); o[8 * i + 3] += p * __uint_as_float(w.y & 0xffff0000u);
                        o[8 * i + 4] += p * __uint_as_float(w.z << 16); o[8 * i + 5] += p * __uint_as_float(w.z & 0xffff0000u); o[8 * i + 6] += p * __uint_as_float(w.w << 16); o[8 * i + 7] += p * __uint_as_float(w.w & 0xffff0000u); }
                }
            }
        }
        const float rl = 1.0f / l;
#pragma unroll
        for (int i = 0; i < 8; ++i) { v4u w; w.x = pk2(o[8 * i] * rl, o[8 * i + 1] * rl); w.y = pk2(o[8 * i + 2] * rl, o[8 * i + 3] * rl); w.z = pk2(o[8 * i + 4] * rl, o[8 * i + 5] * rl); w.w = pk2(o[8 * i + 6] * rl, o[8 * i + 7] * rl);
            *(v4u*)(O + (size_t)m * D + h * 64 + 8 * i) = w; }
    }
}


#ifdef DBG_CUT
__device__ __forceinline__ void dbg_copy(Frame& F, const void* src, bool is_bf16, float* out) {
    for (size_t i = (size_t)F.gw * 64 + F.lane; i < (size_t)M * D; i += (size_t)F.NGW * 64) out[i] = is_bf16 ? bf2f(((const bf16*)src)[i]) : ((const float*)src)[i];
}
#ifndef DBG_LAYER
#define DBG_LAYER -1
#endif
#define CUT(k, off, isbf) if (DBG_CUT == (k) && (DBG_LAYER < 0 || layer == DBG_LAYER)) { unsigned char* ws = WSB(); dbg_copy(F, ws + (off), (isbf), GOUT()); return; }
#else
#define CUT(k, off, isbf)
#endif
#define GEMM_BIG(EpiT, SchedT) pg8::gemm_phase<EpiT, SchedT, true, true>
#define GEMM_ONE(EpiT, SchedT) pg8::gemm_phase<EpiT, SchedT, false, true>
__global__ void __launch_bounds__(NWAVES * 64, 2) fwd_kernel(Args args) {
    extern __shared__ __attribute__((aligned(16))) unsigned char lds[];
    Frame F;
    F.lds = (LAS unsigned char*)lds; F.MISC = (volatile LAS unsigned*)(F.lds + MISC_OFF);
    F.wave = __builtin_amdgcn_readfirstlane((int)threadIdx.x >> 6); F.lane = fresh_lane(); F.tid = F.wave * 64 + F.lane;
    F.G = gridDim.x; { const int bx = blockIdx.x; F.vcu = (F.G % 8 == 0) ? (bx % 8) * (F.G / 8) + bx / 8 : bx; }
    F.gw = F.vcu * NWAVES + F.wave; F.NGW = F.G * NWAVES;
    F.ws = args.ws; F.ctl = (gu32*)(args.ws + WS_CTL);
#ifdef DBG_LDSZERO
    for (int u = F.tid; u < LDS_BYTES / 4; u += NWAVES * 64) ((LAS unsigned*)(F.lds))[u] = 0u;
#else
    for (int u = F.tid; u < (LDS_BYTES - LDSCTL_OFF) / 4; u += NWAVES * 64) ((LAS unsigned*)(F.lds + LDSCTL_OFF))[u] = 0u;
#endif
    __syncthreads();
    XcdBarrier bar = xcd_barrier_post((unsigned*)(F.ctl + CW_BAR), F.MISC + 8, F.tid == 0);
#define GRID_BAR() do { { GAS unsigned* b_ = (GAS unsigned*)bar.bar; asm volatile("" : "+s"(b_), "+s"(bar.x)); bar.bar = (unsigned*)b_; } xcd_barrier(bar, F.wave == 0 && fresh_lane() == 0); } while (0)
#define WSB() ({ F.lane = fresh_lane(); F.tid = F.wave * 64 + F.lane; asm volatile("" : "+s"(F.G), "+s"(F.wave), "+s"(F.vcu), "+s"(F.gw), "+s"(F.NGW), "+s"(bx)); GAS unsigned char* p_ = (GAS unsigned char*)args.ws; asm volatile("" : "+s"(p_)); (unsigned char*)p_; })
#define GOUT() ({ GAS float* o_ = (GAS float*)args.out; asm volatile("" : "+s"(o_)); (float*)o_; })
#define INP(i) ({ const __attribute__((address_space(4))) char* k_ = (const __attribute__((address_space(4))) char*)__builtin_amdgcn_kernarg_segment_ptr(); asm volatile("" : "+s"(k_)); const GAS float* g_ = (const GAS float*)(*(const float* const __attribute__((address_space(4)))*)(k_ + 8 * (i))); asm volatile("" : "+s"(g_)); (const float*)g_; })
    LAS unsigned char* ring = F.lds + RING_OFF;
    int bx = (int)blockIdx.x;

    conv_rwkv(F, 0); conv_dense(F, 0);
    GRID_BAR();

#ifndef LAYER_LO
#define LAYER_LO 0
#define LAYER_HI 4
#endif
    for (int layer = LAYER_LO; layer < LAYER_HI; ++layer) {
        const bool moe = (layer & 1) != 0; const int fe = layer >> 1;
        if (layer < 2) {
            const int l = layer;
            { unsigned char* ws = WSB(); mix_phase(F, layer == 0 ? INP(I_X) : (const float*)(ws + WS_H), INP(I_MU) + (size_t)l * 6 * D, (bf16*)(ws + RS_XM)); }
            GRID_BAR();
            { unsigned char* ws = WSB(); pg8::Gemm g{D, D, D}; pg8::SchedStd S; S.init(M, 4096, F.G, bx, ws + RS_XM, D, ws + WM_BT1 + (size_t)l * RW_LSTRIDE, D, 1, (size_t)M * D * 2);
              pg8::EpiRkv E{(bf16*)(ws + RS_RKV), (long)RS_LH - (long)RS_RKV, (size_t)M * D};
              GEMM_BIG(pg8::EpiRkv, pg8::SchedStd)(ring, g, S, E, F.wave); }
            GRID_BAR();
            CUT(1, RS_RKV, true)
            { unsigned char* ws = WSB(); pg8::Gemm g{256, D, 256}; pg8::SchedStd S; S.init(M, 4096, F.G, bx, ws + RS_LH, D, ws + WM_BT2 + (size_t)l * RW_LSTRIDE, 256, 2, 0);
              pg8::EpiLoraUpAll E{{(void*)(ws + RS_DEC), INP(I_W0) + (size_t)l * D}, {(void*)(ws + RS_AB), INP(I_A0) + (size_t)l * D}, {(void*)(ws + RS_VG), INP(I_V0)}, {(void*)(ws + RS_GG), nullptr}};
              GEMM_BIG(pg8::EpiLoraUpAll, pg8::SchedStd)(ring, g, S, E, F.wave); }
            GRID_BAR();
            CUT(2, RS_DEC, false) CUT(60, RS_VG, true) CUT(61, RS_GG, true) CUT(62, RS_LH, true) CUT(63, RS_AB, false)
            { unsigned char* ws = WSB(); prep_phase(F, l, (bf16*)(ws + RS_RKV), (float*)(ws + RS_AB), (bf16*)(ws + RS_LH), INP(I_V0), INP(I_V2), (bf16*)(ws + WS_VFIRST), INP(I_KK) + (size_t)l * D, INP(I_KA) + (size_t)l * D,
                                                   (float*)(ws + RS_KP), (float*)(ws + RS_AP), (float*)(ws + RS_VP)); }
            GRID_BAR();
            CUT(3, RS_KP, false) CUT(7, RS_VP, false) CUT(8, RS_AB, false) CUT(9, RS_DEC, false)
#ifndef NO_SCAN
            { unsigned char* ws = WSB(); scan_phase(F, (bf16*)(ws + RS_RKV), (float*)(ws + RS_DEC), (float*)(ws + RS_KP), (float*)(ws + RS_AP), (float*)(ws + RS_AB), (float*)(ws + RS_VP), (bf16*)(ws + WS_Y)); }
#endif
            GRID_BAR();
            CUT(4, WS_Y, true)
            { unsigned char* ws = WSB(); post_phase(F, (bf16*)(ws + WS_Y), (bf16*)(ws + RS_RKV), (float*)(ws + RS_KP), (float*)(ws + RS_VP), (bf16*)(ws + RS_GG),
                                                   INP(I_RK) + (size_t)l * D, INP(I_GNG) + (size_t)l * D, INP(I_GNB) + (size_t)l * D, (bf16*)(ws + RS_YG)); }
            GRID_BAR();
            CUT(5, RS_YG, true)
            { unsigned char* ws = WSB(); pg8::Gemm g{D, D, D}; pg8::SchedStd S; S.init(M, D, F.G, bx, ws + RS_YG, D, ws + WM_OUT + (size_t)l * RW_LSTRIDE, D);
              pg8::EpiResF32 E{layer == 0 ? INP(I_X) : (const float*)(ws + WS_H), (float*)(ws + RS_PRE), ALPHA};
              GEMM_ONE(pg8::EpiResF32, pg8::SchedStd)(ring, g, S, E, F.wave); }
            GRID_BAR();
            CUT(6, RS_PRE, false)
        } else {
            const int j = layer - 2;
            { unsigned char* ws = WSB(); pg8::Gemm g{D, D, D}; pg8::SchedStd S; S.init(M, j == 0 ? 3 * D : D, F.G, bx, ws + WS_HB, D, ws + WM_QKV, D);
              pg8::EpiQKV E{(bf16*)(ws + BS_Q), ((long)WS_K - (long)BS_Q) / 2, ((long)WS_V - (long)BS_Q) / 2, attn_body::C2};
              GEMM_BIG(pg8::EpiQKV, pg8::SchedStd)(ring, g, S, E, F.wave); }
            GRID_BAR();
            CUT(31, BS_Q, true) CUT(32, WS_K, true) CUT(33, WS_V, true)
            if (j == 0) { unsigned char* ws = WSB(); kmean_phase(F, (bf16*)(ws + WS_K), (float*)(ws + WS_KMEAN)); GRID_BAR(); }
#ifndef NO_GATE
            { unsigned char* ws = WSB(); gate_phase(F, (bf16*)(ws + BS_Q), (float*)(ws + WS_KMEAN), (unsigned*)(ws + WS_SEL)); }
#endif
            GRID_BAR();
#ifdef DBG_CUT
            if (DBG_CUT == 35) { unsigned char* ws = WSB(); const unsigned* s_ = (const unsigned*)(ws + WS_SEL); for (size_t i = (size_t)F.gw * 64 + F.lane; i < (size_t)M * D; i += (size_t)F.NGW * 64) args.out[i] = (float)(s_[i & (size_t)(M * 16 - 1)] % 65521u); return; }
#endif
            { unsigned char* ws = WSB(); attn_direct_phase(F, (const bf16*)(ws + BS_Q), (const bf16*)(ws + WS_K), (const bf16*)(ws + WS_V), (const unsigned*)(ws + WS_SEL), (bf16*)(ws + BS_O)); }
            GRID_BAR();
            CUT(36, BS_O, true)
            { unsigned char* ws = WSB(); pg8::Gemm g{D, D, D}; pg8::SchedStd S; S.init(M, D, F.G, bx, ws + BS_O, D, ws + WM_O, D);
              pg8::EpiResF32 E{(const float*)(ws + WS_H), (float*)(ws + BS_PRE), ALPHA};
              GEMM_ONE(pg8::EpiResF32, pg8::SchedStd)(ring, g, S, E, F.wave); }
            GRID_BAR();
        }
        { unsigned char* ws = WSB(); const float* PREm = (const float*)(ws + (layer < 2 ? RS_PRE : BS_PRE));
          const float* g0 = INP(I_LNG) + (size_t)(layer * 2) * D; const float* b0 = INP(I_LNB) + (size_t)(layer * 2) * D;
          if (moe) ln_phase<0, true>(F, PREm, nullptr, nullptr, nullptr, g0, b0, (float*)(ws + WS_H), (bf16*)(ws + WS_HB), INP(I_ROUTER) + (size_t)fe * D * NE, (int*)(ws + WS_TOKE), (float*)(ws + WS_TOKW), (int*)(ws + WS_BLKCNT));
          else ln_phase<0, false>(F, PREm, nullptr, nullptr, nullptr, g0, b0, (float*)(ws + WS_H), (bf16*)(ws + WS_HB), nullptr, nullptr, nullptr, nullptr); }
        if (layer == 0) conv_rwkv(F, 1); else if (layer == 1) conv_moba(F, 0); else if (layer == 2) conv_moba(F, 1);
        GRID_BAR();
        CUT(10 + layer, WS_H, false)
        if (!moe) {
            { unsigned char* ws = WSB(); pg8::Gemm g{D, D, D}; pg8::SchedStd S; S.init(M, 2 * FF, F.G, bx, ws + WS_HB, D, ws + WF_GU, D);
              pg8::EpiSwiGLU E{(bf16*)(ws + FS_HID), FF};
              GEMM_BIG(pg8::EpiSwiGLU, pg8::SchedStd)(ring, g, S, E, F.wave); }
            GRID_BAR();
            { unsigned char* ws = WSB(); pg8::Gemm g{FF, FF, FF}; pg8::SchedStd S; S.init(M, D, F.G, bx, ws + FS_HID, FF, ws + WF_DN, FF);
              pg8::EpiResF32 E{(const float*)(ws + WS_H), (float*)(ws + FS_PRE), ALPHA};
              GEMM_ONE(pg8::EpiResF32, pg8::SchedStd)(ring, g, S, E, F.wave); }
            GRID_BAR();
            { unsigned char* ws = WSB(); const float* g1 = INP(I_LNG) + (size_t)(layer * 2 + 1) * D; const float* b1 = INP(I_LNB) + (size_t)(layer * 2 + 1) * D;
              ln_phase<0, false>(F, (const float*)(ws + FS_PRE), nullptr, nullptr, nullptr, g1, b1, (float*)(ws + WS_H), (bf16*)(ws + WS_HB), nullptr, nullptr, nullptr, nullptr); }
            conv_moe(F, fe);
            GRID_BAR();
        } else {
            { unsigned char* ws = WSB(); moe_gather_phase(F, (const int*)(ws + WS_BLKCNT), (const int*)(ws + WS_TOKE), (const float*)(ws + WS_TOKW), (int*)(ws + WS_TOKR), (float*)(ws + WS_GW), (bf16*)(ws + WS_HB), (bf16*)(ws + ES_XG)); }
            GRID_BAR();
            { unsigned char* ws = WSB(); const LAS int* pp = (const LAS int*)(F.lds + MISC_OFF + 64);
              pg8::Gemm g{D, D, D}; pg8::SchedMoe S{2 * FFE / 256, F.G, bx, pp, (const char*)(ws + ES_XG), (const char*)(ws + WE_GU), (size_t)256 * D * 2, (size_t)256 * D * 2, (size_t)2 * FFE * D * 2};
              pg8::EpiSwiGLU E{(bf16*)(ws + ES_HID), FFE};
              GEMM_BIG(pg8::EpiSwiGLU, pg8::SchedMoe)(ring, g, S, E, F.wave); }
            GRID_BAR();
            { unsigned char* ws = WSB(); const LAS int* pp = (const LAS int*)(F.lds + MISC_OFF + 64);
              pg8::Gemm g{FFE, FFE, FFE}; pg8::SchedMoe S{D / 256, F.G, bx, pp, (const char*)(ws + ES_HID), (const char*)(ws + WE_DN), (size_t)256 * FFE * 2, (size_t)256 * FFE * 2, (size_t)D * FFE * 2};
              pg8::EpiMoeDown E{(float*)(ws + ES_YP), (const float*)(ws + WS_GW)};
              GEMM_BIG(pg8::EpiMoeDown, pg8::SchedMoe)(ring, g, S, E, F.wave); }
            GRID_BAR();
            { unsigned char* ws = WSB(); const float* g1 = INP(I_LNG) + (size_t)(layer * 2 + 1) * D; const float* b1 = INP(I_LNB) + (size_t)(layer * 2 + 1) * D;
              if (layer == 3) ln_phase<1, false>(F, nullptr, (const float*)(ws + WS_H), (const float*)(ws + ES_YP), (const int*)(ws + WS_TOKR), g1, b1, GOUT(), nullptr, nullptr, nullptr, nullptr, nullptr);
              else ln_phase<1, false>(F, nullptr, (const float*)(ws + WS_H), (const float*)(ws + ES_YP), (const int*)(ws + WS_TOKR), g1, b1, (float*)(ws + WS_H), (bf16*)(ws + WS_HB), nullptr, nullptr, nullptr, nullptr); }
            if (layer == 1) conv_dense(F, 1);
            GRID_BAR();
        }
        CUT(20 + layer, WS_H, false)
        CUT(40 + layer, WS_HB, true)
#ifdef DBG_CUT
        if (DBG_CUT == 50 + layer) { unsigned char* ws = WSB(); const bf16* s_ = (const bf16*)(ws + WS_WMIX); float* o_ = GOUT(); for (size_t i = (size_t)F.gw * 64 + F.lane; i < (size_t)M * D; i += (size_t)F.NGW * 64) o_[i] = i < (size_t)6 * 1024 * 1024 ? bf2f(s_[i]) : 0.f; return; }
#endif
    }
}

extern "C" void kernel_launch(void* const* d_in, const int* in_sizes, int n_in, void* d_out, int out_size, void* d_ws, size_t ws_size, hipStream_t stream) {
    static int grid = 0;
    if (grid == 0) {
        if (n_in != 33 || in_sizes[0] != M * D || out_size != M * D || ws_size < WS_END) { fprintf(stderr, "kernel_launch: unexpected problem shape (n_in %d, in0 %d, out %d, ws %zu); nothing launched\n", n_in, n_in > 0 ? in_sizes[0] : -1, out_size, ws_size); grid = -1; return; }
        int dev = 0, cus = 0, per_cu = 0;
        if (hipGetDevice(&dev) != hipSuccess || hipDeviceGetAttribute(&cus, hipDeviceAttributeMultiprocessorCount, dev) != hipSuccess) { grid = -1; return; }
        if (hipFuncSetAttribute((const void*)fwd_kernel, hipFuncAttributeMaxDynamicSharedMemorySize, LDS_BYTES) != hipSuccess) { fprintf(stderr, "kernel_launch: hipFuncSetAttribute failed\n"); grid = -1; return; }
        if (hipOccupancyMaxActiveBlocksPerMultiprocessor(&per_cu, (const void*)fwd_kernel, NWAVES * 64, LDS_BYTES) != hipSuccess || per_cu < 1) { fprintf(stderr, "kernel_launch: occupancy query reports %d workgroups per CU\n", per_cu); }
        (void)hipGetLastError();
        grid = cus;
        if (grid != 256) { fprintf(stderr, "kernel_launch: built for 256 CUs, device has %d; nothing launched\n", cus); grid = -1; return; }
    }
    if (grid < 0) return;
    if (hipMemsetAsync((char*)d_ws + WS_CTL, 0, CTL_ZERO_BYTES, stream) != hipSuccess) return;
#ifdef DBG_FILL
    (void)hipMemsetAsync((char*)d_ws + CTL_ZERO_BYTES, DBG_FILL, WS_END - CTL_ZERO_BYTES, stream);
#endif
    Args a{};
    for (int i = 0; i < 33; ++i) a.in[i] = (const float*)d_in[i];
    a.out = (float*)d_out; a.ws = (unsigned char*)d_ws;
    hipLaunchKernelGGL(fwd_kernel, dim3(grid), dim3(NWAVES * 64), LDS_BYTES, stream, a);
}
```

```cpp
#include <hip/hip_runtime.h>
#include <cstdio>
#include <cstdint>
#include <hip/hip_bf16.h>
#include <cmath>
__device__ __forceinline__ int fresh_lane() { int l; asm volatile("v_mbcnt_lo_u32_b32 %0, -1, 0\n\tv_mbcnt_hi_u32_b32 %0, -1, %0" : "=v"(l)); return l; }
namespace pg8 {
#define PG8_LAS __attribute__((address_space(3)))
typedef unsigned short bf16_t;
typedef short bf16x8 __attribute__((ext_vector_type(8)));
typedef float f32x4 __attribute__((ext_vector_type(4)));
typedef unsigned u32x4 __attribute__((ext_vector_type(4)));
constexpr int BM = 256, BK = 64, HALF = 128, HTB = HALF * BK * 2  , STAGE_BYTES = 8 * HTB, NXCD = 8, WGM = 8;

__host__ __device__ __forceinline__ int lds_byte(int r, int c) { const int st = (r >> 4) * 2 + (c >> 5), rr = r & 15, cc = c & 31, ob = rr * 64 + cc * 2; return st * 1024 + (ob ^ (((ob >> 9) & 1) << 5)); }
__host__ __device__ __forceinline__ void stage_rc(int b, int& R, int& C) { const int st = b / 1024, sb = b % 1024, swz = sb ^ (((sb >> 9) & 1) << 5); R = (st >> 1) * 16 + swz / 64; C = (st & 1) * 32 + (swz % 64) / 2; }
__host__ __device__ __forceinline__ int perm32(int rho) { const int n = rho >> 4, i = rho & 15; return 8 * (i >> 2) + 4 * n + (i & 3); }

struct Unit { int pm, pn, e; };
struct Gemm { int K, lda, ldb; };

__device__ __forceinline__ unsigned cvt_pk_bf16(float lo, float hi) { unsigned r; asm volatile("v_cvt_pk_bf16_f32 %0, %1, %2" : "=v"(r) : "v"(lo), "v"(hi)); return r; }
__device__ __forceinline__ float fsigmoid(float x) { return __builtin_amdgcn_rcpf(1.0f + __expf(-x)); }
__device__ __forceinline__ float ftanh(float x) { return 1.0f - 2.0f * __builtin_amdgcn_rcpf(1.0f + __expf(2.0f * x)); }

struct SchedStd {
    int nM, nN, nwg, G, c, amode; const char* A; const char* B; size_t atile, btile, ag;
    __device__ __forceinline__ void init(int M, int N, int G_, int c_, const void* A_, size_t lda, const void* B_, size_t ldb, int amode_ = 0, size_t ag_ = 0) {
        nM = M / BM; nN = N / BM; nwg = nM * nN; G = G_; c = c_; A = (const char*)A_; B = (const char*)B_; atile = (size_t)BM * lda * 2; btile = (size_t)BM * ldb * 2; amode = amode_; ag = ag_; }
    __device__ __forceinline__ bool next(int i, Unit& u) const {
        const long L = (long)i * G + c; if (L >= nwg) return false;
        int wgid = (int)L; { const int q = nwg / NXCD, r = nwg % NXCD, xcd = wgid % NXCD, off = wgid / NXCD; wgid = (xcd < r ? xcd * (q + 1) : r * (q + 1) + (xcd - r) * q) + off; }
        const int nig = WGM * nN, gid = wgid / nig, fm = gid * WGM, gsz = (nM - fm) < WGM ? (nM - fm) : WGM;
        u.pm = fm + ((wgid % nig) % gsz); u.pn = (wgid % nig) / gsz; u.e = 0; return true;
    }
    __device__ __forceinline__ const char* abase(const Unit& u) const {
        size_t off = (size_t)u.pm * atile;
        if (amode == 1) { const int gs = u.pn < 12 ? (u.pn >> 2) : (u.pn == 12 ? 3 : (u.pn == 13 ? 4 : (u.pn == 14 ? 2 : 5))); off += (size_t)gs * ag; }
        else if (amode == 2) off += (size_t)(u.pn >> 2) * 512;
        return A + off; }
    __device__ __forceinline__ const char* bbase(const Unit& u) const { return B + (size_t)u.pn * btile; }
    __device__ __forceinline__ void a_ready(const Unit&) const {}
    __device__ __forceinline__ void done(const Unit&) const {}
};
struct SchedMoe {
    int nN, G, c; const PG8_LAS int* pp; const char* A; const char* B; size_t atile, btile, bexp;
    __device__ __forceinline__ bool next(int i, Unit& u) const {
        const int L = i * G + c, tot = pp[8] * nN; if (L >= tot) return false;
        const int pm = L / nN; u.pm = pm; u.pn = L - pm * nN; int e = 0;
#pragma unroll
        for (int k = 1; k < 8; ++k) e += (pm >= pp[k]) ? 1 : 0;
        u.e = __builtin_amdgcn_readfirstlane(e); return true; }
    __device__ __forceinline__ const char* abase(const Unit& u) const { return A + (size_t)u.pm * atile; }
    __device__ __forceinline__ const char* bbase(const Unit& u) const { return B + (size_t)u.e * bexp + (size_t)u.pn * btile; }
    __device__ __forceinline__ void a_ready(const Unit&) const {}
    __device__ __forceinline__ void done(const Unit&) const {}
};

#define PG8_PACK8(w, v0, v1) do { w.x = cvt_pk_bf16(v0[0], v0[1]); w.y = cvt_pk_bf16(v0[2], v0[3]); w.z = cvt_pk_bf16(v1[0], v1[1]); w.w = cvt_pk_bf16(v1[2], v1[3]); } while (0)

struct EpiQKV {
    static constexpr bool PERM = true, AFTER_DRAIN = false;
    bf16_t* O0; long d1, d2; float s0;
    __device__ __forceinline__ void operator()(const f32x4 (&acc)[2][2][4][2], const Unit& u, int wr, int wc, int fr, int fq) const {
        const int t = u.pn >> 2; bf16_t* base = O0 + (long)(t == 1) * d1 + (long)(t == 2) * d2; const float sc = t == 0 ? s0 : 1.0f;
        const int row0 = u.pm * BM + wr * 64 + fr, col0 = (u.pn & 3) * BM + wc * 32 + 8 * fq;
#pragma unroll
        for (int ai = 0; ai < 2; ++ai)
#pragma unroll
            for (int m = 0; m < 4; ++m) { bf16_t* rowp = base + (size_t)(row0 + ai * HALF + m * 16) * 1024 + col0;
#pragma unroll
                for (int bj = 0; bj < 2; ++bj) { const f32x4 v0 = acc[ai][bj][m][0] * sc, v1 = acc[ai][bj][m][1] * sc; u32x4 w; PG8_PACK8(w, v0, v1); *(u32x4*)(rowp + bj * HALF) = w; } }
    }
};
struct EpiRkv {
    static constexpr bool PERM = true, AFTER_DRAIN = false;
    bf16_t* RKV; long dLH; size_t mstride;
    __device__ __forceinline__ void operator()(const f32x4 (&acc)[2][2][4][2], const Unit& u, int wr, int wc, int fr, int fq) const {
        const int pn = u.pn; const bool lora = pn >= 12;
        bf16_t* base = (bf16_t*)((char*)RKV + (lora ? dLH : (long)((size_t)(pn >> 2) * mstride * 2))); const int colt = lora ? (pn - 12) * BM : (pn & 3) * BM;
        const int row0 = u.pm * BM + wr * 64 + fr, col0 = colt + wc * 32 + 8 * fq;
#pragma unroll
        for (int ai = 0; ai < 2; ++ai)
#pragma unroll
            for (int m = 0; m < 4; ++m) { bf16_t* rowp = base + (size_t)(row0 + ai * HALF + m * 16) * 1024 + col0;
#pragma unroll
                for (int bj = 0; bj < 2; ++bj) { f32x4 v0 = acc[ai][bj][m][0], v1 = acc[ai][bj][m][1];
                    if (pn == 12) {
#pragma unroll
                        for (int i = 0; i < 4; ++i) { v0[i] = ftanh(v0[i]); v1[i] = ftanh(v1[i]); } }
                    else if (pn == 15) {
#pragma unroll
                        for (int i = 0; i < 4; ++i) { v0[i] = fsigmoid(v0[i]); v1[i] = fsigmoid(v1[i]); } }
                    u32x4 w; PG8_PACK8(w, v0, v1); *(u32x4*)(rowp + bj * HALF) = w; } }
    }
};
template <int GRP> struct EpiLoraUp {
    static constexpr bool PERM = true, AFTER_DRAIN = false;
    void* O; const float* bias;
    __device__ __forceinline__ void operator()(const f32x4 (&acc)[2][2][4][2], const Unit& u, int wr, int wc, int fr, int fq) const {
        const int row0 = u.pm * BM + wr * 64 + fr, col0 = u.pn * BM + wc * 32 + 8 * fq;
#pragma unroll
        for (int bj = 0; bj < 2; ++bj) {
            f32x4 bv0 = (f32x4){0.f, 0.f, 0.f, 0.f}, bv1 = bv0;
            if (GRP < 3) { bv0 = *(const f32x4*)(bias + col0 + bj * HALF); bv1 = *(const f32x4*)(bias + col0 + bj * HALF + 4); }
#pragma unroll
            for (int ai = 0; ai < 2; ++ai)
#pragma unroll
                for (int m = 0; m < 4; ++m) { const size_t ro = (size_t)(row0 + ai * HALF + m * 16) * 1024 + col0 + bj * HALF;
                    f32x4 v0_ = acc[ai][bj][m][0] + bv0, v1_ = acc[ai][bj][m][1] + bv1;
                    if (GRP == 0) {
#pragma unroll
                        for (int i = 0; i < 4; ++i) { v0_[i] = __expf(-0.6065306597f * fsigmoid(v0_[i])); v1_[i] = __expf(-0.6065306597f * fsigmoid(v1_[i])); }
                    } else if (GRP < 3) {
#pragma unroll
                        for (int i = 0; i < 4; ++i) { v0_[i] = fsigmoid(v0_[i]); v1_[i] = fsigmoid(v1_[i]); }
                    }
                    if (GRP < 2) { *(f32x4*)((float*)O + ro) = v0_; *(f32x4*)((float*)O + ro + 4) = v1_; }
                    else { u32x4 w; PG8_PACK8(w, v0_, v1_); *(u32x4*)((bf16_t*)O + ro) = w; } }
        }
    }
};
struct EpiLoraUpAll {
    static constexpr bool PERM = true, AFTER_DRAIN = false;
    EpiLoraUp<0> e0; EpiLoraUp<1> e1; EpiLoraUp<2> e2; EpiLoraUp<3> e3;
    __device__ __forceinline__ void operator()(const f32x4 (&acc)[2][2][4][2], const Unit& u, int wr, int wc, int fr, int fq) const {
        Unit v = u; v.pn = u.pn & 3; const int g = u.pn >> 2;
        if (g == 0) e0(acc, v, wr, wc, fr, fq); else if (g == 1) e1(acc, v, wr, wc, fr, fq); else if (g == 2) e2(acc, v, wr, wc, fr, fq); else e3(acc, v, wr, wc, fr, fq);
    }
};
struct EpiResF32 {
    static constexpr bool PERM = false, AFTER_DRAIN = false;
    const float* base; float* out; float alpha;
    __device__ __forceinline__ void operator()(const f32x4 (&acc)[2][2][4][2], const Unit& u, int wr, int wc, int fr, int fq) const {
        const int row0 = u.pm * BM + wr * 64 + fr, col0 = u.pn * BM + wc * 32 + 4 * fq;
#pragma unroll
        for (int ai = 0; ai < 2; ++ai)
#pragma unroll
            for (int m = 0; m < 4; ++m) { const size_t ro = (size_t)(row0 + ai * HALF + m * 16) * 1024 + col0;
#pragma unroll
                for (int bj = 0; bj < 2; ++bj)
#pragma unroll
                    for (int n = 0; n < 2; ++n) { const f32x4 b = *(const f32x4*)(base + ro + bj * HALF + n * 16); *(f32x4*)(out + ro + bj * HALF + n * 16) = b * alpha + acc[ai][bj][m][n]; } }
    }
};
struct EpiSwiGLU {
    static constexpr bool PERM = true, AFTER_DRAIN = false;
    bf16_t* Hd; int ldh;
    __device__ __forceinline__ void operator()(const f32x4 (&acc)[2][2][4][2], const Unit& u, int wr, int wc, int fr, int fq) const {
        const int row0 = u.pm * BM + wr * 64 + fr, col0 = u.pn * HALF + wc * 32 + 8 * fq;
#pragma unroll
        for (int ai = 0; ai < 2; ++ai)
#pragma unroll
            for (int m = 0; m < 4; ++m) { bf16_t* rowp = Hd + (size_t)(row0 + ai * HALF + m * 16) * ldh + col0;
                f32x4 v0, v1;
#pragma unroll
                for (int i = 0; i < 4; ++i) { const float g0 = acc[ai][0][m][0][i], g1 = acc[ai][0][m][1][i];
                    v0[i] = g0 * fsigmoid(g0) * acc[ai][1][m][0][i]; v1[i] = g1 * fsigmoid(g1) * acc[ai][1][m][1][i]; }
                u32x4 w; PG8_PACK8(w, v0, v1); *(u32x4*)rowp = w; }
    }
};
struct EpiMoeDown {
    static constexpr bool PERM = false, AFTER_DRAIN = false;
    float* YP; const float* gw;
    __device__ __forceinline__ void operator()(const f32x4 (&acc)[2][2][4][2], const Unit& u, int wr, int wc, int fr, int fq) const {
        const int row0 = u.pm * BM + wr * 64 + fr, col0 = u.pn * BM + wc * 32 + 4 * fq;
#pragma unroll
        for (int ai = 0; ai < 2; ++ai)
#pragma unroll
            for (int m = 0; m < 4; ++m) { const int row = row0 + ai * HALF + m * 16; const float s = gw[row]; const size_t ro = (size_t)row * 1024 + col0;
#pragma unroll
                for (int bj = 0; bj < 2; ++bj)
#pragma unroll
                    for (int n = 0; n < 2; ++n) *(f32x4*)(YP + ro + bj * HALF + n * 16) = acc[ai][bj][m][n] * s; }
    }
};

template <class Epi, class Sched, bool ALIGN_EPI = false, bool SP2 = false>
__device__ __forceinline__ void gemm_phase(PG8_LAS unsigned char* lds, const Gemm g, const Sched& S, const Epi& E, int wave) {
    const int lane = fresh_lane(), wid = wave, tid = wid * 64 + lane, wr = wid >> 2, wc = wid & 3, fr = lane & 15, fq = lane >> 4;
    const int K = g.K, nt = K / BK;
    unsigned voffA[2], voffB[2];
#pragma unroll
    for (int i = 0; i < 2; ++i) { int R, C; stage_rc(tid * 16 + i * 8192, R, C); const int Rb = Epi::PERM ? ((R & ~31) + perm32(R & 31)) : R;
        voffA[i] = (unsigned)(R * g.lda + C) * 2u; voffB[i] = (unsigned)(Rb * g.ldb + C) * 2u; }
    const size_t kstep = (size_t)(BK * 2);
    const size_t hsA = (size_t)HALF * g.lda * 2, hsB = (size_t)HALF * g.ldb * 2;
    const unsigned ldsw = (unsigned)wid * 1024u;
    const int aoff = lds_byte(wr * 64 + fr, fq * 8), boff = lds_byte(wc * 32 + fr, fq * 8);
#define PG8_SA(b, h) (((b) * 2 + (h)) * HTB)
#define PG8_SB(b, h) ((4 + (b) * 2 + (h)) * HTB)
#define PG8_STAGE(bufoff, gbase, voff) do { _Pragma("unroll") for (int _i = 0; _i < 2; ++_i) \
        __builtin_amdgcn_global_load_lds((const unsigned*)((const char*)(gbase) + (voff)[_i]), (PG8_LAS unsigned*)(lds + (bufoff) + ldsw + _i * 8192), 16, 0, 0); } while (0)
#define PG8_LDA(dst, b, h) do { _Pragma("unroll") for (int m = 0; m < 4; ++m) _Pragma("unroll") for (int k = 0; k < 2; ++k) dst[m][k] = *(const PG8_LAS bf16x8*)(lds + PG8_SA(b, h) + aoff + m * 2048 + k * 1024); } while (0)
#define PG8_LDB(dst, b, h) do { _Pragma("unroll") for (int n = 0; n < 2; ++n) _Pragma("unroll") for (int k = 0; k < 2; ++k) dst[n][k] = *(const PG8_LAS bf16x8*)(lds + PG8_SB(b, h) + boff + n * 2048 + k * 1024); } while (0)
#define PG8_MMA(ai, bj, At, Bt) do { __builtin_amdgcn_s_setprio(1); _Pragma("unroll") for (int m = 0; m < 4; ++m) _Pragma("unroll") for (int n = 0; n < 2; ++n) _Pragma("unroll") for (int k = 0; k < 2; ++k) \
        acc[ai][bj][m][n] = __builtin_amdgcn_mfma_f32_16x16x32_bf16(Bt[n][k], At[m][k], acc[ai][bj][m][n], 0, 0, 0); __builtin_amdgcn_s_setprio(0); } while (0)
#define PG8_WAIT_V(n) asm volatile("s_waitcnt vmcnt(" #n ")" ::: "memory")
#define PG8_WAIT_L(n) asm volatile("s_waitcnt lgkmcnt(" #n ")" ::: "memory")
#define PG8_BAR __builtin_amdgcn_s_barrier()
#define PG8_SCHED __builtin_amdgcn_sched_barrier(0)
    Unit cur, nxt; int ui = 0;
    if (!S.next(0, cur)) return;
    f32x4 acc[2][2][4][2];
#pragma unroll
    for (int a = 0; a < 2; ++a)
#pragma unroll
        for (int b = 0; b < 2; ++b)
#pragma unroll
            for (int m = 0; m < 4; ++m)
#pragma unroll
                for (int n = 0; n < 2; ++n) acc[a][b][m][n] = (f32x4){0.f, 0.f, 0.f, 0.f};
    bf16x8 At[4][2], B0[2][2], B1[2][2];
    const char* cA = S.abase(cur); const char* cB = S.bbase(cur);
    S.a_ready(cur);
    if constexpr (SP2) {
        PG8_STAGE(PG8_SB(0, 0), cB, voffB); PG8_STAGE(PG8_SB(0, 1), cB + hsB, voffB); PG8_STAGE(PG8_SA(0, 0), cA, voffA); PG8_STAGE(PG8_SA(0, 1), cA + hsA, voffA);
        if (wr == 1) PG8_BAR;
        PG8_WAIT_V(2); PG8_BAR;
        PG8_STAGE(PG8_SB(1, 0), cB + kstep, voffB); PG8_STAGE(PG8_SA(1, 0), cA + kstep, voffA); PG8_STAGE(PG8_SB(1, 1), cB + hsB + kstep, voffB);
        PG8_WAIT_V(6); PG8_BAR;
    } else {
        PG8_STAGE(PG8_SB(0, 0), cB, voffB); PG8_STAGE(PG8_SA(0, 0), cA, voffA); PG8_STAGE(PG8_SB(0, 1), cB + hsB, voffB); PG8_STAGE(PG8_SA(0, 1), cA + hsA, voffA);
        if (wr == 1) PG8_BAR;
        PG8_WAIT_V(4); PG8_BAR;
        PG8_STAGE(PG8_SB(1, 0), cB + kstep, voffB); PG8_STAGE(PG8_SA(1, 0), cA + kstep, voffA); PG8_STAGE(PG8_SB(1, 1), cB + hsB + kstep, voffB);
        PG8_WAIT_V(6); PG8_BAR;
    }
    for (;;) {
        const bool has_next = S.next(ui + 1, nxt);
        const char* nA = has_next ? S.abase(nxt) : cA; const char* nB = has_next ? S.bbase(nxt) : cB;
#pragma nounroll
        for (int t = 0; t < nt; t += 2) {
            const bool last = (t == nt - 2);
            const char* a1 = cA + (size_t)(t + 1) * kstep;
            const char* a2 = last ? nA : cA + (size_t)(t + 2) * kstep; const char* b2 = last ? nB : cB + (size_t)(t + 2) * kstep;
            const char* a3 = a2 + kstep; const char* b3 = b2 + kstep;
            if (last && has_next) S.a_ready(nxt);
            if constexpr (SP2) {
            PG8_LDB(B0, 0, 0); PG8_LDB(B1, 0, 1); PG8_SCHED; PG8_LDA(At, 0, 0); PG8_STAGE(PG8_SA(1, 1), a1 + hsA, voffA);
            PG8_WAIT_V(8); PG8_WAIT_L(0); PG8_BAR; PG8_MMA(0, 0, At, B0); PG8_MMA(0, 1, At, B1); PG8_BAR; PG8_SCHED;
            PG8_LDA(At, 0, 1); PG8_STAGE(PG8_SB(0, 0), b2, voffB); PG8_STAGE(PG8_SB(0, 1), b2 + hsB, voffB); PG8_STAGE(PG8_SA(0, 0), a2, voffA);
            PG8_WAIT_V(8); PG8_WAIT_L(0); PG8_BAR; PG8_MMA(1, 0, At, B0); PG8_MMA(1, 1, At, B1); PG8_BAR; PG8_SCHED;
            PG8_LDB(B0, 1, 0); PG8_LDB(B1, 1, 1); PG8_SCHED; PG8_LDA(At, 1, 0); PG8_STAGE(PG8_SA(0, 1), a2 + hsA, voffA);
            PG8_WAIT_V(8); PG8_WAIT_L(0); PG8_BAR; PG8_MMA(0, 0, At, B0); PG8_MMA(0, 1, At, B1); PG8_BAR; PG8_SCHED;
            PG8_LDA(At, 1, 1); PG8_STAGE(PG8_SB(1, 0), b3, voffB); PG8_STAGE(PG8_SB(1, 1), b3 + hsB, voffB); PG8_STAGE(PG8_SA(1, 0), a3, voffA);
            PG8_WAIT_V(8); PG8_WAIT_L(0); PG8_BAR; PG8_MMA(1, 0, At, B0); PG8_MMA(1, 1, At, B1); PG8_BAR; PG8_SCHED;
            } else {
            PG8_LDB(B0, 0, 0); PG8_SCHED; PG8_LDA(At, 0, 0); PG8_STAGE(PG8_SA(1, 1), a1 + hsA, voffA);
            PG8_WAIT_L(8); PG8_BAR; PG8_WAIT_L(0); PG8_MMA(0, 0, At, B0); PG8_BAR; PG8_SCHED;
            PG8_LDB(B1, 0, 1); PG8_STAGE(PG8_SB(0, 0), b2, voffB);
            PG8_BAR; PG8_WAIT_L(0); PG8_MMA(0, 1, At, B1); PG8_BAR;
            PG8_LDA(At, 0, 1); PG8_STAGE(PG8_SA(0, 0), a2, voffA);
            PG8_BAR; PG8_WAIT_L(0); PG8_MMA(1, 0, At, B0); PG8_BAR; PG8_SCHED;
            PG8_STAGE(PG8_SB(0, 1), b2 + hsB, voffB);
            PG8_WAIT_V(6); PG8_BAR; PG8_MMA(1, 1, At, B1); PG8_BAR;
            PG8_LDB(B0, 1, 0); PG8_SCHED; PG8_LDA(At, 1, 0); PG8_STAGE(PG8_SA(0, 1), a2 + hsA, voffA);
            PG8_WAIT_L(8); PG8_BAR; PG8_WAIT_L(0); PG8_MMA(0, 0, At, B0); PG8_BAR; PG8_SCHED;
            PG8_LDB(B1, 1, 1); PG8_STAGE(PG8_SB(1, 0), b3, voffB);
            PG8_BAR; PG8_WAIT_L(0); PG8_MMA(0, 1, At, B1); PG8_BAR;
            PG8_LDA(At, 1, 1); PG8_STAGE(PG8_SA(1, 0), a3, voffA);
            PG8_BAR; PG8_WAIT_L(0); PG8_MMA(1, 0, At, B0); PG8_BAR; PG8_SCHED;
            PG8_STAGE(PG8_SB(1, 1), b3 + hsB, voffB);
            PG8_WAIT_V(6); PG8_BAR; PG8_MMA(1, 1, At, B1); PG8_BAR;
            }
        }
        if constexpr (ALIGN_EPI) { if (wr == 0) PG8_BAR; }
        if constexpr (!Epi::AFTER_DRAIN) { E(acc, cur, wr, wc, fr, fq); S.done(cur); }
        if (!has_next) break;
#pragma unroll
        for (int a = 0; a < 2; ++a)
#pragma unroll
            for (int b = 0; b < 2; ++b)
#pragma unroll
                for (int m = 0; m < 4; ++m)
#pragma unroll
                    for (int n = 0; n < 2; ++n) acc[a][b][m][n] = (f32x4){0.f, 0.f, 0.f, 0.f};
        cur = nxt; cA = nA; cB = nB; ++ui;
        if constexpr (ALIGN_EPI) { if (wr == 1) PG8_BAR; }
    }
    PG8_WAIT_V(0);
    if constexpr (!ALIGN_EPI) { if (wr == 0) PG8_BAR; }
    PG8_BAR;
    if constexpr (Epi::AFTER_DRAIN) { E.fused(acc, cur, wr, wc, fr, fq, lds, wid, lane); S.done(cur); }
#undef PG8_SA
#undef PG8_SB
#undef PG8_STAGE
#undef PG8_LDA
#undef PG8_LDB
#undef PG8_MMA
#undef PG8_WAIT_V
#undef PG8_WAIT_L
#undef PG8_BAR
#undef PG8_SCHED
}
}

#ifndef MOBA_MASK_ON
#define MOBA_MASK_ON 1
#endif
namespace attn_body {
using bf16=__hip_bfloat16;
using bf16x8=__attribute__((ext_vector_type(8)))short;
using s16x4=__attribute__((ext_vector_type(4)))short;
using f32x16=__attribute__((ext_vector_type(16)))float;
using u32x4=__attribute__((ext_vector_type(4)))unsigned;
constexpr int BATCH=2,NHEAD=16,SEQ=8192,D=64,DM=NHEAD*D;
constexpr int NW=8,QBLK=32,QB=QBLK*NW,KVBLK=64,NQB=SEQ/QB;
constexpr int ATTN_PITCH=DM, ATTN_UNIT_ROWS=QB;
__device__ __forceinline__ int crow(int r,int hi){return (r&3)+8*(r>>2)+4*hi;}
#define SBAR() __builtin_amdgcn_sched_barrier(0)
__device__ __forceinline__ void cmask(f32x16&p0,f32x16&p1,int jb,int qrel,int hi){
  const float NEG=-INFINITY; int d=qrel-(64*jb+4*hi); asm volatile("":"+v"(d));
  #pragma unroll
  for(int r=0;r<16;++r){const int c=(r&3)+8*(r>>2); if(c>d)p0[r]=NEG; if(c+32>d)p1[r]=NEG;}
}

constexpr int NSLOT=3, SLOTB=8192;
constexpr int LDS_K=0, LDS_V=NSLOT*SLOTB, LDS_WS=2*NSLOT*SLOTB, LDS_OST=LDS_WS+NW*64*4, LDS_BYTES=LDS_OST+NW*4096;
constexpr float C2=0.125f*1.4426950408889634f;
__device__ __forceinline__ void glds16(const void*gsrc,unsigned lds_dst){unsigned keep;
  asm volatile("s_mov_b32 %0, m0\n\ts_mov_b32 m0, %2\n\ts_nop 0\n\tglobal_load_lds_dwordx4 %1, off\n\ts_mov_b32 m0, %0":"=&s"(keep):"v"(gsrc),"s"(lds_dst):"memory");}
__device__ __forceinline__ float max3f(float a,float b,float c){float r;asm("v_max3_f32 %0, %1, %2, %3":"=v"(r):"v"(a),"v"(b),"v"(c));return r;}
__device__ __forceinline__ float max2f(float a,float b){float r;asm("v_max_f32_e32 %0, %1, %2":"=v"(r):"v"(a),"v"(b));return r;}
__device__ __forceinline__ float fadd_s(float a,float b){float r;asm("v_add_f32_e32 %0, %1, %2":"=v"(r):"v"(a),"v"(b));return r;}
__device__ __forceinline__ float fsub_s(float a,float b){float r;asm("v_sub_f32_e32 %0, %1, %2":"=v"(r):"v"(a),"v"(b));return r;}
typedef float f32x2_t __attribute__((ext_vector_type(2))); typedef __bf16 bf16x2_t __attribute__((ext_vector_type(2)));
__device__ __forceinline__ unsigned cvtpk_s(float lo,float hi){f32x2_t v={lo,hi};bf16x2_t b=__builtin_convertvector(v,bf16x2_t);return __builtin_bit_cast(unsigned,b);}
#define WAIT_BAR(N) asm volatile("s_waitcnt vmcnt(" #N ") lgkmcnt(0)\n\ts_barrier":::"memory")

__device__ __forceinline__ void qkt(f32x16&p0,f32x16&p1,const char*Kslot,const bf16x8*qr,int r32,int hi){
  const char*kb=Kslot+hi*1024+r32*16;
  #pragma unroll
  for(int d0=0;d0<4;++d0){
    const bf16x8 b0=*reinterpret_cast<const bf16x8*>(kb+d0*2048);
    const bf16x8 b1=*reinterpret_cast<const bf16x8*>(kb+d0*2048+512);
    if(d0==0){p0=__builtin_amdgcn_mfma_f32_32x32x16_bf16(b0,qr[0],f32x16{},0,0,0);p1=__builtin_amdgcn_mfma_f32_32x32x16_bf16(b1,qr[0],f32x16{},0,0,0);}
    else{p0=__builtin_amdgcn_mfma_f32_32x32x16_bf16(b0,qr[d0],p0,0,0,0);p1=__builtin_amdgcn_mfma_f32_32x32x16_bf16(b1,qr[d0],p1,0,0,0);}}
}
typedef __attribute__((address_space(3))) const char* lds_cptr;
typedef short v4i16_t __attribute__((ext_vector_type(4)));
__device__ __forceinline__ void kload8(bf16x8*kf,lds_cptr kp){
  kf[0]=*(const __attribute__((address_space(3))) bf16x8*)(kp);      kf[1]=*(const __attribute__((address_space(3))) bf16x8*)(kp+512);
  kf[2]=*(const __attribute__((address_space(3))) bf16x8*)(kp+2048); kf[3]=*(const __attribute__((address_space(3))) bf16x8*)(kp+2560);
  kf[4]=*(const __attribute__((address_space(3))) bf16x8*)(kp+4096); kf[5]=*(const __attribute__((address_space(3))) bf16x8*)(kp+4608);
  kf[6]=*(const __attribute__((address_space(3))) bf16x8*)(kp+6144); kf[7]=*(const __attribute__((address_space(3))) bf16x8*)(kp+6656);
}
__device__ __forceinline__ void kload2(bf16x8*kf,lds_cptr kp,int j){ kf[2*j]=*(const __attribute__((address_space(3))) bf16x8*)(kp+j*2048); kf[2*j+1]=*(const __attribute__((address_space(3))) bf16x8*)(kp+j*2048+512); }
__device__ __forceinline__ s16x4 vtr(lds_cptr p){ return __builtin_bit_cast(s16x4,__builtin_amdgcn_ds_read_tr16_b64_v4i16((__attribute__((address_space(3))) v4i16_t*)p)); }
__device__ __forceinline__ float rowmax(const f32x16&p0,const f32x16&p1){
  float a=max3f(p0[0],p0[1],p1[0]),b=max3f(p0[2],p0[3],p1[1]);a=max3f(a,p1[2],p1[3]);
  #pragma unroll
  for(int r=4;r<16;r+=4){a=max3f(a,p0[r],p0[r+1]);b=max3f(b,p0[r+2],p0[r+3]);a=max3f(a,p1[r],p1[r+1]);b=max3f(b,p1[r+2],p1[r+3]);}
  const float m=max2f(a,b);
  auto rr=__builtin_amdgcn_permlane32_swap(__float_as_uint(m),__float_as_uint(m),false,false);
  return max2f(__uint_as_float(rr[0]),__uint_as_float(rr[1]));
}
__device__ __forceinline__ void pv(f32x16*o,int vb,bf16x8 pa0,bf16x8 pa1,bf16x8 pa2,bf16x8 pa3){
  #pragma unroll
  for(int d0=0;d0<2;++d0){s16x4 lo[4],hi[4];
    #pragma unroll
    for(int ks=0;ks<4;++ks){
      asm volatile("ds_read_b64_tr_b16 %0,%1 offset:%c2":"=&v"(lo[ks]):"v"(vb),"i"(d0*4096+ks*1024):"memory");
      asm volatile("ds_read_b64_tr_b16 %0,%1 offset:%c2":"=&v"(hi[ks]):"v"(vb),"i"(d0*4096+ks*1024+512):"memory");}
    asm volatile("s_waitcnt lgkmcnt(0)":::"memory");SBAR();
    #define PK(k) (bf16x8){lo[k][0],lo[k][1],lo[k][2],lo[k][3],hi[k][0],hi[k][1],hi[k][2],hi[k][3]}
    o[d0]=__builtin_amdgcn_mfma_f32_32x32x16_bf16(pa0,PK(0),o[d0],0,0,0);
    o[d0]=__builtin_amdgcn_mfma_f32_32x32x16_bf16(pa1,PK(1),o[d0],0,0,0);
    o[d0]=__builtin_amdgcn_mfma_f32_32x32x16_bf16(pa2,PK(2),o[d0],0,0,0);
    o[d0]=__builtin_amdgcn_mfma_f32_32x32x16_bf16(pa3,PK(3),o[d0],0,0,0);
    #undef PK
  }
}

#ifndef ATTN_STORE16
#define ATTN_STORE16(p,v) (*(u32x4*)(p)=(v))
#endif
template<int THRL> __device__ __forceinline__ void attn_unit(int b,int h,int qb,const bf16*Q,const bf16*__restrict__ K,const bf16*__restrict__ V,bf16*O,const unsigned*__restrict__ SEL,char*shm,int wave){
  const int lane=fresh_lane(),wid=wave,tid=wid*64+lane,r32=lane&31,hi=lane>>5; (void)tid;
  const long rowbase=(long)b*SEQ; const int q0=qb*QB;
  const bf16*Qw=Q+(rowbase+q0+wid*QBLK)*DM+h*D;
  const bf16*Kh=K+rowbase*DM+h*D,*Vh=V+rowbase*DM+h*D;
  const unsigned lds0=(unsigned)(uintptr_t)shm;
  float*wsf=(float*)(shm+LDS_WS)+wid*64;
  const bf16*ksrc=Kh+(long)lane*DM+wid*8;
  const bf16*vsrc=Vh+(long)(16*(wid&3)+(lane>>2))*DM+(wid>>2)*32+(lane&3)*8;
  const unsigned kdst=lds0+LDS_K+wid*1024, vdst=lds0+LDS_V+wid*1024;
  #define DMA_K(t,slot) glds16(ksrc+(long)(t)*KVBLK*DM,(unsigned)__builtin_amdgcn_readfirstlane(kdst+(slot)))
  #define DMA_V(t,slot) glds16(vsrc+(long)(t)*KVBLK*DM,(unsigned)__builtin_amdgcn_readfirstlane(vdst+(slot)))
  const int vb0=(int)(lds0+LDS_V)+((lane>>4)&1)*32+(lane&3)*8+(4*hi+((lane&15)>>2))*64;
  const char*Kbase=shm+LDS_K; bf16x8 kf[8];
  const lds_cptr shm3=(lds_cptr)shm; const lds_cptr kp0=shm3+LDS_K+hi*1024+r32*16; const lds_cptr vp0=shm3+LDS_V+((lane>>4)&1)*32+(lane&3)*8+(4*hi+((lane&15)>>2))*64;
  const int NT=(q0+QB)/KVBLK;
  DMA_K(0,0);DMA_V(0,0);DMA_K(1,SLOTB);
  bf16x8 qr[4];
  #pragma unroll
  for(int d0=0;d0<4;++d0)qr[d0]=*reinterpret_cast<const bf16x8*>(&Qw[(long)r32*DM+d0*16+hi*8]);
  float mhat=0.f,l_reg=0.f;f32x16 o[2];o[0]=f32x16{};o[1]=f32x16{};
  const int qrel=wid*QBLK+r32;
  #define SELW() ((volatile __attribute__((address_space(3))) unsigned*)(lds_cptr)((const char*)wsf)+32+r32)
  if(hi==0)*SELW()=SEL[(rowbase+q0+qrel)*NHEAD+h];
  asm volatile("s_waitcnt vmcnt(0) lgkmcnt(0)":::"memory");
  #define CMASK(P0,P1,t) do{int jb_=(t)-(NT-4); if(jb_>=0)cmask(P0,P1,jb_,qrel,hi); else if(MOBA_MASK_ON && !(((*SELW())>>((t)>>2))&1u)){ _Pragma("unroll") for(int r_=0;r_<16;++r_){P0[r_]=-INFINITY;P1[r_]=-INFINITY;} } }while(0)
  bool resc=false;
  #define START(P0,P1) do{ const float rm=rowmax(P0,P1); resc=false; \
    { const float dl=max2f(rm,-100.f); mhat=fadd_s(mhat,dl); \
      _Pragma("unroll") for(int r=0;r<16;++r){P0[r]=fsub_s(P0[r],dl);P1[r]=fsub_s(P1[r],dl);} \
      } \
    _Pragma("unroll") for(int r=0;r<16;++r)P0[r]=__builtin_amdgcn_exp2f(P0[r]); }while(0)
  #define RESC() do{ if(resc){ asm volatile("s_waitcnt lgkmcnt(0)":::"memory"); \
      _Pragma("unroll") for(int d_=0;d_<2;++d_) _Pragma("unroll") for(int r=0;r<16;++r)o[d_][r]*=wsf[crow(r,hi)]; } }while(0)
  f32x16 pA0,pA1,pB0,pB1;
  int sl_prev=0,sl_cur=0,sl_next=SLOTB;
  #define ROT() do{sl_prev=sl_cur;sl_cur=sl_next;sl_next=(sl_next==(NSLOT-1)*SLOTB)?0:sl_next+SLOTB;}while(0)
  DMA_K(2,2*SLOTB);
  WAIT_BAR(3);
  qkt(pA0,pA1,Kbase,qr,r32,hi);asm volatile("s_nop 15\n\ts_nop 7":"+v"(pA0),"+v"(pA1));CMASK(pA0,pA1,0);
  START(pA0,pA1);
  _Pragma("unroll") for(int r=0;r<16;++r)pA1[r]=__builtin_amdgcn_exp2f(pA1[r]);
  WAIT_BAR(0);
  DMA_K(3,0);DMA_V(1,SLOTB);
  ROT();
  kload8(kf,kp0+sl_cur);
  WAIT_BAR(2);
  s16x4 vlo[8],vhi[8]; u32x4 pw0,pw1,pw2,pw3;
  #define PKW(P,B) cvtpk_s(P[B],P[B+1])
  #define PAF(k) __builtin_bit_cast(bf16x8,pw##k)
  #define VFR(i) (bf16x8){vlo[i][0],vlo[i][1],vlo[i][2],vlo[i][3],vhi[i][0],vhi[i][1],vhi[i][2],vhi[i][3]}
  #define PIN(x) asm volatile("":"+v"(x))
  #define MX3(a,b,c) __builtin_fmaxf(__builtin_fmaxf((a),(b)),(c))
  #define GAPA(MF,A0,A1,A2,A3,W0,W1,PW) do{ MF; sacc+=A0; sacc+=A1; sacc+=A2; sacc+=A3; PIN(sacc); W0; W1; PIN(PW); SBAR(); }while(0)
  #define EX(v) __builtin_amdgcn_exp2f(v)
  #define GAPB(MF,X,B) do{ MF; X[B]=EX(X[B]); X[B+1]=EX(X[B+1]); X[B+2]=EX(X[B+2]); X[B+3]=EX(X[B+3]); PIN(X); SBAR(); }while(0)
  #define VRD(i) do{ vlo[i]=vtr(vp_+(((i)>>2)*4096+((i)&3)*1024)); vhi[i]=vtr(vp_+(((i)>>2)*4096+((i)&3)*1024+512)); }while(0)
  #define KRD(G,j) do{ if(G){ kload2(kf,kp0+sl_next,j); SBAR(); } }while(0)
  #define STEP(C0,C1,P0,P1,t,GK,GV,GL) do{ SBAR(); \
    const lds_cptr vp_=vp0+sl_prev; \
    VRD(0); SBAR(); float sacc=(P0[0]+P0[1]); \
    GAPA(C0=__builtin_amdgcn_mfma_f32_32x32x16_bf16(kf[0],qr[0],f32x16{},0,0,0), P0[2],P0[3],P0[4],P0[5],     pw0[0]=PKW(P0,0), pw0[1]=PKW(P0,2), pw0); \
    VRD(4); SBAR(); GAPA(C1=__builtin_amdgcn_mfma_f32_32x32x16_bf16(kf[1],qr[0],f32x16{},0,0,0), P0[6],P0[7],P0[8],P0[9],     pw0[2]=PKW(P0,4), pw0[3]=PKW(P0,6), pw0); \
    VRD(1); SBAR(); GAPA(C0=__builtin_amdgcn_mfma_f32_32x32x16_bf16(kf[2],qr[1],C0,0,0,0),   P0[10],P0[11],P0[12],P0[13], pw1[0]=PKW(P0,8), pw1[1]=PKW(P0,10), pw1); \
    VRD(5); SBAR(); GAPA(C1=__builtin_amdgcn_mfma_f32_32x32x16_bf16(kf[3],qr[1],C1,0,0,0),   P0[14],P0[15],P1[0],P1[1],   pw1[2]=PKW(P0,12),pw1[3]=PKW(P0,14), pw1); \
    VRD(2); SBAR(); GAPA(C0=__builtin_amdgcn_mfma_f32_32x32x16_bf16(kf[4],qr[2],C0,0,0,0),   P1[2],P1[3],P1[4],P1[5],     pw2[0]=PKW(P1,0), pw2[1]=PKW(P1,2), pw2); \
    VRD(6); SBAR(); GAPA(C1=__builtin_amdgcn_mfma_f32_32x32x16_bf16(kf[5],qr[2],C1,0,0,0),   P1[6],P1[7],P1[8],P1[9],     pw2[2]=PKW(P1,4), pw2[3]=PKW(P1,6), pw2); \
    VRD(3); SBAR(); GAPA(C0=__builtin_amdgcn_mfma_f32_32x32x16_bf16(kf[6],qr[3],C0,0,0,0),   P1[10],P1[11],P1[12],P1[13], pw3[0]=PKW(P1,8), pw3[1]=PKW(P1,10), pw3); \
    VRD(7); SBAR(); GAPA(C1=__builtin_amdgcn_mfma_f32_32x32x16_bf16(kf[7],qr[3],C1,0,0,0),   P1[14],P1[15],0.f,0.f,       pw3[2]=PKW(P1,12),pw3[3]=PKW(P1,14), pw3); \
    l_reg+=sacc; \
    if(GK){DMA_K((t)+3,sl_cur);} if(GV){DMA_V((t)+1,sl_next);} \
    _Pragma("unroll") for(int r=0;r<16;++r){C0[r]-=mhat;C1[r]-=mhat;} \
    CMASK(C0,C1,t); \
    { float a=MX3(C0[0],C0[1],C1[0]),b=MX3(C0[2],C0[3],C1[1]); a=MX3(a,C1[2],C1[3]); \
      _Pragma("unroll") for(int r=4;r<16;r+=4){a=MX3(a,C0[r],C0[r+1]);b=MX3(b,C0[r+2],C0[r+3]);a=MX3(a,C1[r],C1[r+1]);b=MX3(b,C1[r+2],C1[r+3]);} \
      float rm=__builtin_fmaxf(a,b); { auto rr=__builtin_amdgcn_permlane32_swap(__float_as_uint(rm),__float_as_uint(rm),false,false); rm=__builtin_fmaxf(__uint_as_float(rr[0]),__uint_as_float(rr[1])); } \
      resc=false; \
      if(__builtin_expect(__any(rm>(float)THRL),0)){ const float dl=__builtin_fmaxf(rm,0.f); mhat+=dl; \
        _Pragma("unroll") for(int r=0;r<16;++r){C0[r]-=dl;C1[r]-=dl;} \
        const float f=__builtin_amdgcn_exp2f(-dl); l_reg*=f; if(hi==0)wsf[r32]=f; resc=true; } } \
    SBAR(); \
    GAPB(o[0]=__builtin_amdgcn_mfma_f32_32x32x16_bf16(PAF(0),VFR(0),o[0],0,0,0), C0,0); \
    GAPB(o[1]=__builtin_amdgcn_mfma_f32_32x32x16_bf16(PAF(0),VFR(4),o[1],0,0,0), C0,4); \
    KRD(GL,0); GAPB(o[0]=__builtin_amdgcn_mfma_f32_32x32x16_bf16(PAF(1),VFR(1),o[0],0,0,0), C0,8); \
    KRD(GL,1); GAPB(o[1]=__builtin_amdgcn_mfma_f32_32x32x16_bf16(PAF(1),VFR(5),o[1],0,0,0), C0,12); \
    KRD(GL,2); GAPB(o[0]=__builtin_amdgcn_mfma_f32_32x32x16_bf16(PAF(2),VFR(2),o[0],0,0,0), C1,0); \
    KRD(GL,3); GAPB(o[1]=__builtin_amdgcn_mfma_f32_32x32x16_bf16(PAF(2),VFR(6),o[1],0,0,0), C1,4); \
    GAPB(o[0]=__builtin_amdgcn_mfma_f32_32x32x16_bf16(PAF(3),VFR(3),o[0],0,0,0), C1,8); \
    GAPB(o[1]=__builtin_amdgcn_mfma_f32_32x32x16_bf16(PAF(3),VFR(7),o[1],0,0,0), C1,12); \
    }while(0)
  int t=1;
  for(;t+5<NT;t+=2){
    STEP(pB0,pB1,pA0,pA1,t,true,true,true);     WAIT_BAR(2); RESC(); ROT();
    STEP(pA0,pA1,pB0,pB1,t+1,true,true,true);   WAIT_BAR(2); RESC(); ROT();
  }
  #undef CMASK
  #define CMASK(P0,P1,t) do{int jb_=(t)-(NT-4); if(jb_>=0)cmask(P0,P1,jb_,qrel,hi); else if(MOBA_MASK_ON && !(((*SELW())>>((t)>>2))&1u)){ _Pragma("unroll") for(int r_=0;r_<16;++r_){P0[r_]=-INFINITY;P1[r_]=-INFINITY;} } }while(0)
  #define ENDW(tt) do{ if((tt)+3<NT){WAIT_BAR(2);} else if((tt)+2<NT){WAIT_BAR(1);} else {WAIT_BAR(0);} }while(0)
  for(;t+1<NT;t+=2){
    STEP(pB0,pB1,pA0,pA1,t,(t+3<NT),(t+1<NT),(t+1<NT));       ENDW(t);   RESC(); ROT();
    STEP(pA0,pA1,pB0,pB1,t+1,(t+4<NT),(t+2<NT),(t+2<NT));     ENDW(t+1); RESC(); ROT();
  }
  STEP(pB0,pB1,pA0,pA1,NT-1,false,false,false); RESC();
  { float sacc=pB0[0]+pB0[1]; _Pragma("unroll") for(int r=2;r<16;++r)sacc+=pB0[r]; _Pragma("unroll") for(int r=0;r<16;++r)sacc+=pB1[r]; l_reg+=sacc;
    pw0=(u32x4){PKW(pB0,0),PKW(pB0,2),PKW(pB0,4),PKW(pB0,6)};pw1=(u32x4){PKW(pB0,8),PKW(pB0,10),PKW(pB0,12),PKW(pB0,14)};pw2=(u32x4){PKW(pB1,0),PKW(pB1,2),PKW(pB1,4),PKW(pB1,6)};pw3=(u32x4){PKW(pB1,8),PKW(pB1,10),PKW(pB1,12),PKW(pB1,14)};
    SBAR(); pv(o,vb0+sl_cur,PAF(0),PAF(1),PAF(2),PAF(3)); }
  #undef PKW
  #undef PAF
  #undef VFR
  #undef PIN
  #undef MX3
  #undef GAPA
  #undef GAPB
  #undef EX
  #undef VRD
  #undef KRD
  #undef STEP
  #undef ENDW
  {auto rr=__builtin_amdgcn_permlane32_swap(__float_as_uint(l_reg),__float_as_uint(l_reg),false,false);l_reg=__uint_as_float(rr[0])+__uint_as_float(rr[1]);}
  if(hi==0)wsf[32+r32]=l_reg;asm volatile("s_waitcnt lgkmcnt(0)":::"memory");
  float rli[16];
  #pragma unroll
  for(int r=0;r<16;++r)rli[r]=__builtin_amdgcn_rcpf(wsf[32+crow(r,hi)]);
  bf16*Ow=O+(rowbase+q0+wid*QBLK)*DM+h*D;
  { bf16*stg=(bf16*)(shm+LDS_OST)+wid*2048;
    #pragma unroll
    for(int r=0;r<16;++r){const int orow=crow(r,hi);
      #pragma unroll
      for(int d0=0;d0<2;++d0)stg[orow*64+d0*32+r32]=__float2bfloat16(o[d0][r]*rli[r]);}
    asm volatile("s_waitcnt lgkmcnt(0)":::"memory");
    #pragma unroll
    for(int i=0;i<4;++i){const int row=i*8+(lane>>3),ch=lane&7; const u32x4 v=*(const u32x4*)(stg+row*64+ch*8); ATTN_STORE16(Ow+(long)row*DM+ch*8,v);} }
  asm volatile("s_waitcnt lgkmcnt(0)\n\ts_barrier":::"memory");
  #undef SELW
  #undef DMA_K
  #undef DMA_V
  #undef CMASK
  #undef START
  #undef RESC
  #undef ROT
}
constexpr int ATTN_LDS_BYTES=LDS_BYTES;
struct AttnTensors { const bf16* Q; const bf16* K; const bf16* V; bf16* O; const unsigned* SEL; };
struct AttnUnit { int bh; int qb; };
struct StaticOrder {
  int vcu;
  __device__ __forceinline__ explicit StaticOrder(int grid,int block):vcu((block%8)*(grid/8)+block/8){}
  __device__ __forceinline__ bool next(int i,AttnUnit&u)const{ if(i>=4)return false; const int s=vcu&7; u.bh=vcu>>3; u.qb=(i==0)?s:(i==1)?15-s:(i==2)?16+s:31-s; return true; }
  __device__ __forceinline__ void a_ready(const AttnUnit&)const{}
  __device__ __forceinline__ void done(const AttnUnit&)const{}
};
template<class Sched,int THRL=8> __device__ __forceinline__ void attn_phase(char*lds,const AttnTensors&T,const Sched&S,int wave){
  AttnUnit u;
  for(int i=0;S.next(i,u);++i){ S.a_ready(u); attn_unit<THRL>(u.bh/NHEAD,u.bh%NHEAD,u.qb,T.Q,T.K,T.V,T.O,T.SEL,lds,wave); S.done(u); }
}
#undef SBAR
#undef WAIT_BAR
}

constexpr int NWAVES = 8;
constexpr int BATCH = 2, T = 8192, D = 1024, H = 16, HD = 64, M = BATCH * T;
constexpr int FF = 2816, FFE = 3584, NE = 8, MOE_ROWS = 34816  ;
constexpr float LN_EPS = 1e-5f, GN_EPS = 64e-5f, ALPHA = 1.6817928305074292f  ;
constexpr size_t MiB = 1u << 20;
constexpr size_t WS_CTL = 0, CTL_ZERO_BYTES = 1 * MiB;
constexpr size_t WS_KMEAN = 1 * MiB;
constexpr size_t WS_SEL = 2 * MiB;
constexpr size_t WS_TOKE = 3 * MiB;
constexpr size_t WS_TOKW = WS_TOKE + 128 * 1024;
constexpr size_t WS_TOKR = WS_TOKW + 128 * 1024;
constexpr size_t WS_GW = WS_TOKR + 128 * 1024;
constexpr size_t WS_BLKCNT = WS_GW + 256 * 1024;
constexpr size_t WS_WMIX = 16 * MiB;
constexpr size_t WS_WFFN = 32 * MiB;
constexpr size_t WS_H = 200 * MiB;
constexpr size_t WS_HB = 264 * MiB;
constexpr size_t WS_K = 296 * MiB, WS_V = 328 * MiB;
constexpr size_t WS_VFIRST = WS_K;
constexpr size_t WS_Y = WS_V;
constexpr size_t WS_SCR = 360 * MiB;
constexpr size_t WS_END = 896 * MiB;
constexpr size_t RS_XM = WS_SCR;
constexpr size_t RS_KP = WS_SCR, RS_AP = WS_SCR + 32 * MiB, RS_VP = WS_SCR + 64 * MiB, RS_BP = WS_SCR + 96 * MiB;
constexpr size_t RS_RKV = WS_SCR + 192 * MiB;
constexpr size_t RS_PRE = RS_RKV;
constexpr size_t RS_LH = WS_SCR + 288 * MiB;
constexpr size_t RS_YG = RS_LH;
constexpr size_t RS_DEC = WS_SCR + 320 * MiB;
constexpr size_t RS_AB = WS_SCR + 384 * MiB;
constexpr size_t RS_VG = WS_SCR + 448 * MiB;
constexpr size_t RS_GG = WS_SCR + 480 * MiB;
constexpr size_t BS_Q = WS_SCR, BS_PRE = WS_SCR + 32 * MiB, BS_O = WS_SCR + 96 * MiB;
constexpr size_t BS_PO = WS_SCR + 128 * MiB, BS_ML = WS_SCR + 256 * MiB;
constexpr size_t FS_HID = WS_SCR, FS_PRE = WS_SCR + 88 * MiB;
constexpr size_t ES_XG = WS_SCR, ES_HID = WS_SCR + 68 * MiB, ES_YP = WS_SCR + 306 * MiB;
static_assert(RS_GG + 32 * MiB <= WS_END && ES_YP + 136 * MiB <= WS_END && FS_PRE + 64 * MiB <= WS_END, "d_ws map");
constexpr size_t RW_LSTRIDE = 872 * MiB - WS_WMIX;
constexpr size_t WM_BT1 = WS_WMIX, WM_BT2 = WS_WMIX + 8 * MiB, WM_OUT = WS_WMIX + 10 * MiB;
constexpr size_t WM_QKV = WS_WMIX, WM_O = WS_WMIX + 8 * MiB;
constexpr size_t WF_GU = WS_WFFN, WF_DN = WS_WFFN + 12 * MiB;
constexpr size_t WE_GU = WS_WFFN, WE_DN = WS_WFFN + 112 * MiB;
constexpr int CW_TMO = 0, CW_CODE = 1, CW_QCTR = 2048  , CW_BAR = 4096;
constexpr int RING_OFF = 0, RING_BYTES = 131072;
constexpr int LDSCTL_OFF = RING_BYTES, MISC_OFF = LDSCTL_OFF + 320;
constexpr int LDS_BYTES = 147456;
static_assert(MISC_OFF + 128 <= LDS_BYTES, "LDS map");

#define GAS __attribute__((address_space(1)))
#define LAS __attribute__((address_space(3)))
typedef unsigned short bf16;
typedef unsigned v4u __attribute__((ext_vector_type(4)));
typedef float f32x4 __attribute__((ext_vector_type(4)));
typedef short bf16x8 __attribute__((ext_vector_type(8)));
typedef GAS unsigned gu32;
typedef GAS unsigned long long gu64;
#define RLX_AGENT __ATOMIC_RELAXED, __HIP_MEMORY_SCOPE_AGENT
#define LDS_WAIT() asm volatile("s_waitcnt lgkmcnt(0)" ::: "memory")
#define VM_WAIT() asm volatile("s_waitcnt vmcnt(0)" ::: "memory")
__device__ __forceinline__ unsigned long long rt() { return __builtin_amdgcn_s_memrealtime(); }
__device__ __forceinline__ unsigned f2bf(float f) { unsigned u = __builtin_bit_cast(unsigned, f); return (u + 0x7fffu + ((u >> 16) & 1u)) >> 16; }
__device__ __forceinline__ unsigned pk2(float lo, float hi) { return f2bf(lo) | (f2bf(hi) << 16); }

#define XB_TMO      128
#define XB_XCNT(j)  (256  + 64 * (j))
#define XB_XSUB(j)  (1280 + 64 * (j))
#define XB_XGEN(j)  (2304 + 64 * (j))
#define XB_TOP      3328
#define XB_TOPGEN   3392
#define XCD_BAR_WORDS 3456
#define XB_SPIN_CAP (1u << 18)

__device__ __forceinline__ unsigned xb_ld(unsigned* p)              { return __hip_atomic_load(p, __ATOMIC_RELAXED, __HIP_MEMORY_SCOPE_AGENT); }
__device__ __forceinline__ unsigned xb_add(unsigned* p, unsigned v) { return __hip_atomic_fetch_add(p, v, __ATOMIC_RELAXED, __HIP_MEMORY_SCOPE_AGENT); }
__device__ __forceinline__ unsigned xb_xcc_id() { return (unsigned)__builtin_amdgcn_s_getreg((3 << 11) | 20) & 0xFu; }
#define XB_SPIN(cond, bar) do { unsigned _sp = 0; while (cond) { __builtin_amdgcn_s_sleep(1); \
    if ((++_sp & 255u) == 0u) { if (xb_ld(&(bar)[XB_TMO])) break; if (_sp > XB_SPIN_CAP) { atomicAdd(&(bar)[XB_TMO], 1u); break; } } } } while (0)

struct XcdBarrier {
    unsigned* bar; unsigned x;
    volatile LAS unsigned* st;
};

__device__ __forceinline__ XcdBarrier xcd_barrier_post(unsigned* bar, volatile LAS unsigned* st, bool t0  ) {
    XcdBarrier b; b.bar = bar; b.x = xb_xcc_id(); b.st = st;
    if (t0) (void)xb_add(&bar[XB_XCNT(b.x)], 1u);
    return b;
}
__device__ __forceinline__ void xcd_barrier_complete(unsigned* bar, unsigned x, unsigned& nloc, unsigned& nx) {
    const unsigned G = gridDim.x * gridDim.y * gridDim.z;
    unsigned sum, cnt, mine, sp = 0u;
    for (;;) {
        sum = 0u; cnt = 0u; mine = 0u;
#pragma unroll
        for (unsigned j = 0; j < 16; ++j) { const unsigned c = xb_ld(&bar[XB_XCNT(j)]); sum += c; cnt += (c > 0u) ? 1u : 0u; mine = (j == x) ? c : mine; }
        if (sum == G) break;
        __builtin_amdgcn_s_sleep(1);
        if ((++sp & 255u) == 0u) { if (xb_ld(&bar[XB_TMO])) break; if (sp > XB_SPIN_CAP) { atomicAdd(&bar[XB_TMO], 1u); break; } }
    }
    nloc = mine > 0u ? mine : 1u; nx = cnt > 0u ? cnt : 1u;
}

__device__ __forceinline__ void xcd_barrier(const XcdBarrier& b, bool t0  ) {
    asm volatile("s_waitcnt vmcnt(0)" ::: "memory");
    __syncthreads();
    if (t0) {
        unsigned* bar = b.bar;
        __builtin_amdgcn_s_waitcnt(0);
        unsigned nloc = b.st[0], nx = b.st[1];
        if (nloc == 0u) { xcd_barrier_complete(bar, b.x, nloc, nx); b.st[0] = nloc; b.st[1] = nx; }
        const unsigned old = xb_add(&bar[XB_XSUB(b.x)], 1u);
        const unsigned gen = old / nloc;
        if (old + 1u == (gen + 1u) * nloc) {
            __builtin_amdgcn_fence(__ATOMIC_RELEASE, "agent");
            asm volatile("s_waitcnt vmcnt(0)" ::: "memory");
            const unsigned og = xb_add(&bar[XB_TOP], 1u);
            const unsigned tg = og / nx;
            if (og + 1u == (tg + 1u) * nx) xb_add(&bar[XB_TOPGEN], 1u);
            else XB_SPIN(xb_ld(&bar[XB_TOPGEN]) == tg, bar);
#ifdef XB_L2_INV
            __builtin_amdgcn_fence(__ATOMIC_ACQUIRE, "");
#else
            __builtin_amdgcn_fence(__ATOMIC_ACQUIRE, "agent");
#endif
            xb_add(&bar[XB_XGEN(b.x)], 1u);
            asm volatile("s_waitcnt vmcnt(0)" ::: "memory");
        } else {
            XB_SPIN(xb_ld(&bar[XB_XGEN(b.x)]) == gen, bar);
            __builtin_amdgcn_fence(__ATOMIC_ACQUIRE, "agent");
            asm volatile("s_waitcnt vmcnt(0)" ::: "memory");
        }
    }
    __syncthreads();
}

struct Args { const float* in[33]; float* out; unsigned char* ws; };
enum InIdx { I_X = 0, I_MU, I_WRKV, I_WOUT, I_W0, I_W1, I_W2, I_A0, I_A1, I_A2, I_V0, I_V1, I_V2, I_G1, I_G2, I_KK, I_KA, I_RK, I_GNG, I_GNB,
             I_MK, I_MV, I_MQ, I_MO, I_FG, I_FU, I_FD, I_ROUTER, I_EG, I_EU, I_ED, I_LNG, I_LNB };
struct Frame {
    LAS unsigned char* lds; volatile LAS unsigned* MISC; gu32* ctl; unsigned char* ws;
    int tid, lane, wave, vcu, G, gw, NGW;
};
typedef float f32x2 __attribute__((ext_vector_type(2)));
typedef unsigned u32x2 __attribute__((ext_vector_type(2)));
__device__ __forceinline__ float dpp_sum16(float v) {
    v += __builtin_bit_cast(float, __builtin_amdgcn_update_dpp(0, __builtin_bit_cast(int, v), 0xB1, 0xF, 0xF, true));
    v += __builtin_bit_cast(float, __builtin_amdgcn_update_dpp(0, __builtin_bit_cast(int, v), 0x4E, 0xF, 0xF, true));
    v += __builtin_bit_cast(float, __builtin_amdgcn_update_dpp(0, __builtin_bit_cast(int, v), 0x141, 0xF, 0xF, true));
    v += __builtin_bit_cast(float, __builtin_amdgcn_update_dpp(0, __builtin_bit_cast(int, v), 0x140, 0xF, 0xF, true));
    return v;
}
__device__ __forceinline__ float wave_sum(float v, int lane) {
    v = dpp_sum16(v);
    v += __builtin_bit_cast(float, __builtin_amdgcn_ds_bpermute((lane ^ 16) << 2, __builtin_bit_cast(int, v)));
    v += __builtin_bit_cast(float, __builtin_amdgcn_ds_bpermute((lane ^ 32) << 2, __builtin_bit_cast(int, v)));
    return v;
}
__device__ __forceinline__ float sum16(float v) { return dpp_sum16(v); }
__device__ __forceinline__ float bf2f(unsigned short b) { return __uint_as_float((unsigned)b << 16); }
__device__ __forceinline__ f32x4 bf4_to_f32(u32x2 w) { f32x4 r; r.x = __uint_as_float(w.x << 16); r.y = __uint_as_float(w.x & 0xffff0000u); r.z = __uint_as_float(w.y << 16); r.w = __uint_as_float(w.y & 0xffff0000u); return r; }
__device__ __forceinline__ u32x2 f32_to_bf4(f32x4 v) { u32x2 w; w.x = pk2(v.x, v.y); w.y = pk2(v.z, v.w); return w; }

__device__ __forceinline__ void tr_item(const float* W, int ldw, int Kr, int Nr, int nblk, bf16* WT, int ldt, int row0, int mode, LAS float* scr, int item, int lane) {
    const int kb = item / nblk, nb = item - kb * nblk, k0 = 64 * kb, n0 = 32 * nb;
    const int n = n0 + (lane & 31);
#pragma unroll 8
    for (int i = 0; i < 32; ++i) { const int kk = 2 * i + (lane >> 5), k = k0 + kk; float v = 0.f; if (k < Kr && n < Nr) v = W[(size_t)k * ldw + n]; scr[kk * 33 + (lane & 31)] = v; }
    LDS_WAIT(); asm volatile("" ::: "memory");
    const int c = lane & 7;
#pragma unroll
    for (int j = 0; j < 4; ++j) { const int nl = (lane >> 3) + 8 * j, nn = n0 + nl; const LAS float* s = scr + (8 * c) * 33 + nl;
        const int drow = mode == 0 ? row0 + nn : row0 + ((nn >> 7) << 8) + (nn & 127);
        v4u o; o.x = pk2(s[0 * 33], s[1 * 33]); o.y = pk2(s[2 * 33], s[3 * 33]); o.z = pk2(s[4 * 33], s[5 * 33]); o.w = pk2(s[6 * 33], s[7 * 33]);
        *(GAS v4u*)(WT + (size_t)drow * ldt + k0 + 8 * c) = o; }
    LDS_WAIT(); asm volatile("" ::: "memory");
}
#define KIN(i) ({ const __attribute__((address_space(4))) char* k_ = (const __attribute__((address_space(4))) char*)__builtin_amdgcn_kernarg_segment_ptr(); asm volatile("" : "+s"(k_)); const GAS float* g_ = (const GAS float*)(*(const float* const __attribute__((address_space(4)))*)(k_ + 8 * (i))); asm volatile("" : "+s"(g_)); (const float*)g_; })
#define CONV_BEGIN() F.lane = fresh_lane(); F.tid = F.wave * 64 + F.lane; asm volatile("" : "+s"(F.G), "+s"(F.wave), "+s"(F.vcu), "+s"(F.gw), "+s"(F.NGW)); GAS unsigned char* cws0_ = (GAS unsigned char*)F.ws; asm volatile("" : "+s"(cws0_)); unsigned char* cws_ = (unsigned char*)cws0_; LAS float* scr_ = (LAS float*)(F.lds + RING_OFF + F.wave * 16384); int it_ = F.gw, base_ = 0
#define JOB(W, ldw, Kr, Nr, Kp, Np, WT, ldt, row0, mode) do { const int nblk_ = (Np) / 32, n_ = ((Kp) / 64) * nblk_; \
    while (it_ < base_ + n_) { tr_item((W), (ldw), (Kr), (Nr), nblk_, (WT), (ldt), (row0), (mode), scr_, it_ - base_, F.lane); it_ += F.NGW; } base_ += n_; } while (0)

__device__ __forceinline__ void conv_rwkv(Frame& F, int l) {
    CONV_BEGIN();
    cws_ += (size_t)l * RW_LSTRIDE; bf16* BT1 = (bf16*)(cws_ + WM_BT1); bf16* BT2 = (bf16*)(cws_ + WM_BT2); bf16* WO = (bf16*)(cws_ + WM_OUT);
    for (int c = 0; c < 3; ++c) JOB(KIN(I_WRKV) + (size_t)(l * 3 + c) * D * D, D, D, D, D, D, BT1, D, c * D, 0);
    JOB(KIN(I_W1) + (size_t)l * D * 64, 64, D, 64, D, 256, BT1, D, 3072, 0);
    JOB(KIN(I_A1) + (size_t)l * D * 64, 64, D, 64, D, 256, BT1, D, 3328, 0);
    JOB(KIN(I_V1), 32, D, (l == 0 ? 0 : 32), D, 256, BT1, D, 3584, 0);
    JOB(KIN(I_G1) + (size_t)l * D * 160, 160, D, 160, D, 256, BT1, D, 3840, 0);
    JOB(KIN(I_W2) + (size_t)l * 64 * D, D, 64, D, 256, D, BT2, 256, 0, 0);
    JOB(KIN(I_A2) + (size_t)l * 64 * D, D, 64, D, 256, D, BT2, 256, 1024, 0);
    JOB(KIN(I_V2), D, (l == 0 ? 0 : 32), D, 256, D, BT2, 256, 2048, 0);
    JOB(KIN(I_G2) + (size_t)l * 160 * D, D, 160, D, 256, D, BT2, 256, 3072, 0);
    JOB(KIN(I_WOUT) + (size_t)l * D * D, D, D, D, D, D, WO, D, 0, 0);
}
__device__ __forceinline__ void conv_moba(Frame& F, int j) {
    CONV_BEGIN();
    bf16* WQ = (bf16*)(cws_ + WM_QKV); bf16* WO = (bf16*)(cws_ + WM_O);
    JOB(KIN(I_MQ) + (size_t)j * D * D, D, D, D, D, D, WQ, D, 0, 0);
    if (j == 0) { JOB(KIN(I_MK), D, D, D, D, D, WQ, D, D, 0); JOB(KIN(I_MV), D, D, D, D, D, WQ, D, 2 * D, 0); }
    JOB(KIN(I_MO) + (size_t)j * D * D, D, D, D, D, D, WO, D, 0, 0);
}
__device__ __forceinline__ void conv_dense(Frame& F, int e) {
    CONV_BEGIN();
    bf16* GU = (bf16*)(cws_ + WF_GU); bf16* DN = (bf16*)(cws_ + WF_DN);
    JOB(KIN(I_FG) + (size_t)e * D * FF, FF, D, FF, D, FF, GU, D, 0, 1);
    JOB(KIN(I_FU) + (size_t)e * D * FF, FF, D, FF, D, FF, GU, D, 128, 1);
    JOB(KIN(I_FD) + (size_t)e * FF * D, D, FF, D, FF, D, DN, FF, 0, 0);
}
__device__ __forceinline__ void conv_moe(Frame& F, int e) {
    CONV_BEGIN();
    bf16* GU = (bf16*)(cws_ + WE_GU); bf16* DN = (bf16*)(cws_ + WE_DN);
    for (int x = 0; x < NE; ++x) {
        JOB(KIN(I_EG) + (size_t)(e * NE + x) * D * FFE, FFE, D, FFE, D, FFE, GU, D, x * 2 * FFE, 1);
        JOB(KIN(I_EU) + (size_t)(e * NE + x) * D * FFE, FFE, D, FFE, D, FFE, GU, D, x * 2 * FFE + 128, 1);
        JOB(KIN(I_ED) + (size_t)(e * NE + x) * FFE * D, D, FFE, D, FFE, D, DN, FFE, x * D, 0);
    }
}

__device__ __forceinline__ void ln_stats(const f32x4 (&v)[4], float& mean, float& rstd, int lane) {
    float s = 0.f;
#pragma unroll
    for (int j = 0; j < 4; ++j) s += (v[j].x + v[j].y) + (v[j].z + v[j].w);
    mean = wave_sum(s, lane) * (1.f / D); float s2 = 0.f;
#pragma unroll
    for (int j = 0; j < 4; ++j) { const f32x4 d = v[j] - mean; s2 += (d.x * d.x + d.y * d.y) + (d.z * d.z + d.w * d.w); }
    rstd = 1.f / sqrtf(wave_sum(s2, lane) * (1.f / D) + LN_EPS);
}
template <int SRC, bool ROUTER>
__device__ __forceinline__ void ln_phase(Frame& F, const float* PRE, const float* Hin, const float* YP, const int* tokr, const float* gln, const float* bln,
                                         float* Hout, bf16* HB, const float* router, int* toke, float* tokw, int* blkcnt) {
    LAS int* cnt = (LAS int*)(F.lds + RING_OFF + 131072 - 64);
    if (ROUTER) { if (F.tid < 8) cnt[F.tid] = 0; __syncthreads(); }
    f32x4 g4[4], b4[4];
#pragma unroll
    for (int j = 0; j < 4; ++j) { g4[j] = *(const f32x4*)(gln + 4 * F.lane + 256 * j); b4[j] = *(const f32x4*)(bln + 4 * F.lane + 256 * j); }
    const int rpb = M / F.G, rpw = rpb / NWAVES;
    for (int i = 0; i < rpw; ++i) {
        const int m = blockIdx.x * rpb + F.wave * rpw + i;
        f32x4 v[4];
        if (SRC == 0) {
#pragma unroll
            for (int j = 0; j < 4; ++j) v[j] = *(const f32x4*)(PRE + (size_t)m * D + 4 * F.lane + 256 * j);
        } else {
            const int r0 = tokr[2 * m], r1 = tokr[2 * m + 1];
#pragma unroll
            for (int j = 0; j < 4; ++j) { const int c = 4 * F.lane + 256 * j;
                v[j] = *(const f32x4*)(Hin + (size_t)m * D + c) * ALPHA + *(const f32x4*)(YP + (size_t)r0 * D + c) + *(const f32x4*)(YP + (size_t)r1 * D + c); }
        }
        float mean, rstd; ln_stats(v, mean, rstd, F.lane);
#pragma unroll
        for (int j = 0; j < 4; ++j) { v[j] = (v[j] - mean) * rstd * g4[j] + b4[j];
            *(f32x4*)(Hout + (size_t)m * D + 4 * F.lane + 256 * j) = v[j];
            if (HB) *(u32x2*)(HB + (size_t)m * D + 4 * F.lane + 256 * j) = f32_to_bf4(v[j]); }
        if (ROUTER) {
            float lg[8];
#pragma unroll
            for (int e = 0; e < 8; ++e) lg[e] = 0.f;
#pragma unroll
            for (int j = 0; j < 4; ++j)
#pragma unroll
                for (int q = 0; q < 4; ++q) { const float xv = v[j][q]; const f32x4* rp = (const f32x4*)(router + (size_t)(4 * F.lane + 256 * j + q) * 8); const f32x4 ra = rp[0], rb = rp[1];
                    lg[0] += xv * ra.x; lg[1] += xv * ra.y; lg[2] += xv * ra.z; lg[3] += xv * ra.w; lg[4] += xv * rb.x; lg[5] += xv * rb.y; lg[6] += xv * rb.z; lg[7] += xv * rb.w; }
#pragma unroll
            for (int e = 0; e < 8; ++e) lg[e] = wave_sum(lg[e], F.lane);
            int e0 = 0; float l0 = lg[0];
#pragma unroll
            for (int e = 1; e < 8; ++e) if (lg[e] > l0) { l0 = lg[e]; e0 = e; }
            int e1 = -1; float l1 = -INFINITY;
#pragma unroll
            for (int e = 0; e < 8; ++e) if (e != e0 && lg[e] > l1) { l1 = lg[e]; e1 = e; }
            const float w0 = 1.f / (1.f + __expf(l1 - l0)), w1 = 1.f - w0;
            if (F.lane == 0) { toke[2 * m] = e0; toke[2 * m + 1] = e1; tokw[2 * m] = w0; tokw[2 * m + 1] = w1; atomicAdd((int*)&cnt[e0], 1); atomicAdd((int*)&cnt[e1], 1); }
        }
    }
    if (ROUTER) { __syncthreads(); if (F.tid < 8) blkcnt[blockIdx.x * 8 + F.tid] = cnt[F.tid]; }
}

__device__ __forceinline__ void mix_phase(Frame& F, const float* Hx, const float* mu, bf16* XM) {
    f32x4 mu4[6][4];
#pragma unroll
    for (int c = 0; c < 6; ++c)
#pragma unroll
        for (int j = 0; j < 4; ++j) mu4[c][j] = *(const f32x4*)(mu + c * D + 4 * F.lane + 256 * j);
    for (int m = F.gw; m < M; m += F.NGW) {
        const bool first = (m % T) == 0;
#pragma unroll
        for (int j = 0; j < 4; ++j) { const int c0 = 4 * F.lane + 256 * j;
            const f32x4 x = *(const f32x4*)(Hx + (size_t)m * D + c0);
            f32x4 xp = (f32x4){0.f, 0.f, 0.f, 0.f}; if (!first) xp = *(const f32x4*)(Hx + (size_t)(m - 1) * D + c0);
            const f32x4 xx = xp - x;
#pragma unroll
            for (int c = 0; c < 6; ++c) *(u32x2*)(XM + ((size_t)c * M + m) * D + c0) = f32_to_bf4(x + xx * mu4[c][j]); }
    }
}
__device__ __forceinline__ void prep_phase(Frame& F, int l, const bf16* RKV, const float* AA, const bf16* LH, const float* v0, const float* v2, bf16* VF, const float* k_k, const float* k_a, bf16* KP, bf16* AP, bf16* BP, bf16* VP) {
    f32x4 kk4[4], ka4[4];
#pragma unroll
    for (int j = 0; j < 4; ++j) { kk4[j] = *(const f32x4*)(k_k + 4 * F.lane + 256 * j); ka4[j] = *(const f32x4*)(k_a + 4 * F.lane + 256 * j); }
    for (int m = F.gw; m < M; m += F.NGW) {
#pragma unroll
        for (int j = 0; j < 4; ++j) { const size_t o = (size_t)m * D + 4 * F.lane + 256 * j;
            const f32x4 k = bf4_to_f32(*(const u32x2*)(RKV + (size_t)M * D + o)); const u32x2 vraw = *(const u32x2*)(RKV + (size_t)2 * M * D + o); f32x4 v = bf4_to_f32(vraw);
            const f32x4 a = *(const f32x4*)(AA + o);
            f32x4 kk = k * kk4[j]; const float ss = sum16((kk.x * kk.x + kk.y * kk.y) + (kk.z * kk.z + kk.w * kk.w));
            kk = kk * (1.0f / sqrtf(fmaxf(ss, 1e-24f)));
            const f32x4 kp = k * ((a - 1.0f) * ka4[j] + 1.0f);
            if (l == 0) *(u32x2*)(VF + o) = vraw;
            else {
                f32x4 z = *(const f32x4*)(v0 + 4 * F.lane + 256 * j);
                const bf16* lh = LH + (size_t)m * D + 512;
#pragma unroll 8
                for (int q = 0; q < 32; ++q) z += *(const f32x4*)(v2 + (size_t)q * D + 4 * F.lane + 256 * j) * bf2f(lh[q]);
                f32x4 vg; vg.x = 1.f / (1.f + __expf(-z.x)); vg.y = 1.f / (1.f + __expf(-z.y)); vg.z = 1.f / (1.f + __expf(-z.z)); vg.w = 1.f / (1.f + __expf(-z.w));
                const f32x4 vf = bf4_to_f32(*(const u32x2*)(VF + o)); v = v + (vf - v) * vg; }
            *(u32x2*)(KP + o) = f32_to_bf4(kp); *(u32x2*)(VP + o) = f32_to_bf4(v); *(u32x2*)(AP + o) = f32_to_bf4(-kk); *(u32x2*)(BP + o) = f32_to_bf4(kk * a); }
    }
}
__device__ __forceinline__ void post_phase(Frame& F, const bf16* Y, const bf16* R, const bf16* KP, const bf16* VP, const bf16* GG, const float* r_k, const float* gng, const float* gnb, bf16* YG) {
    f32x4 rk4[4], gg4[4], gb4[4];
#pragma unroll
    for (int j = 0; j < 4; ++j) { rk4[j] = *(const f32x4*)(r_k + 4 * F.lane + 256 * j); gg4[j] = *(const f32x4*)(gng + 4 * F.lane + 256 * j); gb4[j] = *(const f32x4*)(gnb + 4 * F.lane + 256 * j); }
    for (int m = F.gw; m < M; m += F.NGW) {
#pragma unroll
        for (int j = 0; j < 4; ++j) { const size_t o = (size_t)m * D + 4 * F.lane + 256 * j;
            const f32x4 y = bf4_to_f32(*(const u32x2*)(Y + o)), r = bf4_to_f32(*(const u32x2*)(R + o)), g = bf4_to_f32(*(const u32x2*)(GG + o));
            const f32x4 kp = bf4_to_f32(*(const u32x2*)(KP + o)), vp = bf4_to_f32(*(const u32x2*)(VP + o));
            const float mean = sum16((y.x + y.y) + (y.z + y.w)) * (1.f / 64.f); const f32x4 d = y - mean;
            const float var = sum16((d.x * d.x + d.y * d.y) + (d.z * d.z + d.w * d.w)) * (1.f / 64.f);
            const f32x4 rkk = r * kp * rk4[j]; const float bon = sum16((rkk.x + rkk.y) + (rkk.z + rkk.w));
            const f32x4 yn = d * (1.0f / sqrtf(var + GN_EPS)) * gg4[j] + gb4[j] + vp * bon;
            *(u32x2*)(YG + o) = f32_to_bf4(yn * g); }
    }
}
__device__ __forceinline__ float fma_s(float a, float b, float c) { float r; asm("v_fma_f32 %0, %1, %2, %3" : "=v"(r) : "v"(a), "v"(b), "v"(c)); return r; }
__device__ __forceinline__ float mul_s(float a, float b) { float r; asm("v_mul_f32_e32 %0, %1, %2" : "=v"(r) : "v"(a), "v"(b)); return r; }
__device__ __forceinline__ float add_s(float a, float b) { float r; asm("v_add_f32_e32 %0, %1, %2" : "=v"(r) : "v"(a), "v"(b)); return r; }
__device__ __forceinline__ float dot4_s(const f32x4& x, const f32x4& y) { return add_s(fma_s(x.y, y.y, mul_s(x.x, y.x)), fma_s(x.w, y.w, mul_s(x.z, y.z))); }
__device__ __forceinline__ f32x4 upd_s(const f32x4& S, const f32x4& w, const f32x4& b, float sa, const f32x4& k, float v) {
    f32x4 r; r.x = fma_s(S.x, w.x, fma_s(b.x, sa, mul_s(k.x, v))); r.y = fma_s(S.y, w.y, fma_s(b.y, sa, mul_s(k.y, v))); r.z = fma_s(S.z, w.z, fma_s(b.z, sa, mul_s(k.z, v))); r.w = fma_s(S.w, w.w, fma_s(b.w, sa, mul_s(k.w, v))); return r; }
__device__ __forceinline__ void scan_phase(Frame& F, const bf16* R, const float* DEC, const bf16* KP, const bf16* AP, const bf16* BP, const bf16* VP, bf16* Y) {
    constexpr int TS = 32, BUFB = 57600, YB_OFF = 2 * BUFB;
    const int head = F.vcu >> 3, part = F.vcu & 7, b = head >> 4, hh = head & 15;
    const size_t rowb = (size_t)b * T; const int col0 = hh * 64;
    const int tr = F.tid >> 4, pc = F.tid & 15;
    const int tr2 = (F.tid & 255) >> 3, pc2 = F.tid & 7;
    const int rr = F.lane >> 4, q = F.lane & 15, myrow = 8 * part + 4 * F.wave + rr;
    LAS unsigned char* L = F.lds + RING_OFF;
    struct Stg { f32x4 lw; u32x2 rk, ra, rb, rv, rn; v4u lr; };
    Stg g0, g1;
#define SC_LOAD(c, G) do { const int t_ = (c) * TS + tr; const size_t g_ = (rowb + t_) * D + col0 + pc * 4; G.lw = *(const f32x4*)(DEC + g_); G.rk = *(const u32x2*)(KP + g_); G.ra = *(const u32x2*)(AP + g_); \
        G.rb = *(const u32x2*)(BP + g_); G.rv = *(const u32x2*)(VP + g_); G.rn = (u32x2){0u, 0u}; if (t_ + 1 < T) G.rn = *(const u32x2*)(AP + g_ + D); \
        if (F.tid < 256) G.lr = *(const v4u*)(R + (rowb + (size_t)(c) * TS + tr2) * D + col0 + pc2 * 8); } while (0)
#define SC_STORE(bf, G) do { const f32x4 lk_ = bf4_to_f32(G.rk), la_ = bf4_to_f32(G.ra), lb_ = bf4_to_f32(G.rb), lv_ = bf4_to_f32(G.rv), ln_ = bf4_to_f32(G.rn); LAS unsigned char* d_ = L + (bf) * BUFB + tr * 256 + pc * 16; *(LAS f32x4*)(d_) = G.lw; *(LAS f32x4*)(d_ + 8192) = lk_; *(LAS f32x4*)(d_ + 16384) = la_; \
        *(LAS f32x4*)(d_ + 24576) = lb_; *(LAS f32x4*)(d_ + 32768) = lv_; *(LAS f32x4*)(d_ + 49152) = G.lw * ln_; \
        { const f32x4 pb_ = lb_ * ln_, pk_ = lk_ * ln_; const float be_ = dpp_sum16((pb_.x + pb_.y) + (pb_.z + pb_.w)), ga_ = dpp_sum16((pk_.x + pk_.y) + (pk_.z + pk_.w)); \
          if (pc == 0) { *(LAS float*)(L + (bf) * BUFB + 57344 + tr * 4) = be_; *(LAS float*)(L + (bf) * BUFB + 57472 + tr * 4) = ga_; } } \
        if (F.tid < 256) { LAS unsigned char* r_ = L + (bf) * BUFB + 40960 + tr2 * 256 + pc2 * 32; \
            *(LAS f32x4*)(r_) = (f32x4){__uint_as_float(G.lr.x << 16), __uint_as_float(G.lr.x & 0xffff0000u), __uint_as_float(G.lr.y << 16), __uint_as_float(G.lr.y & 0xffff0000u)}; \
            *(LAS f32x4*)(r_ + 16) = (f32x4){__uint_as_float(G.lr.z << 16), __uint_as_float(G.lr.z & 0xffff0000u), __uint_as_float(G.lr.w << 16), __uint_as_float(G.lr.w & 0xffff0000u)}; } } while (0)
    SC_LOAD(0, g0); SC_STORE(0, g0); SC_LOAD(1, g0); __syncthreads();
    f32x4 S = (f32x4){0.f, 0.f, 0.f, 0.f};
    constexpr int NCH = T / TS;
    for (int c2 = 0; c2 < NCH; c2 += 2) {
#pragma unroll
      for (int par = 0; par < 2; ++par) {
        const int c = c2 + par, bf = par;
        if (c + 2 < NCH) { if (par == 0) SC_LOAD(c + 2, g1); else SC_LOAD(c + 2, g0); }
        if (F.wave < 2) {
            const LAS unsigned char* B0 = L + bf * BUFB + q * 16; const LAS unsigned char* Bv = L + bf * BUFB + 32768 + myrow * 4; const LAS unsigned char* Bs = L + bf * BUFB + 57344;
            LAS unsigned short* yb = (LAS unsigned short*)(L + YB_OFF + bf * 512) + q * 8 + 4 * F.wave + rr;
            struct Rnd { f32x4 a, aw, w0, b0, k0, r0, w1, b1, k1, r1; float v0, v1, be, ga; };
#define SC_FETCH(t_, X) do { X.a = *(const LAS f32x4*)(B0 + 16384 + (t_) * 256); X.aw = *(const LAS f32x4*)(B0 + 49152 + (t_) * 256); \
            X.w0 = *(const LAS f32x4*)(B0 + (t_) * 256); X.b0 = *(const LAS f32x4*)(B0 + 24576 + (t_) * 256); X.k0 = *(const LAS f32x4*)(B0 + 8192 + (t_) * 256); X.r0 = *(const LAS f32x4*)(B0 + 40960 + (t_) * 256); \
            X.w1 = *(const LAS f32x4*)(B0 + ((t_) + 1) * 256); X.b1 = *(const LAS f32x4*)(B0 + 24576 + ((t_) + 1) * 256); X.k1 = *(const LAS f32x4*)(B0 + 8192 + ((t_) + 1) * 256); X.r1 = *(const LAS f32x4*)(B0 + 40960 + ((t_) + 1) * 256); \
            X.v0 = *(const LAS float*)(Bv + (t_) * 256); X.v1 = *(const LAS float*)(Bv + ((t_) + 1) * 256); X.be = *(const LAS float*)(Bs + (t_) * 4); X.ga = *(const LAS float*)(Bs + 128 + (t_) * 4); } while (0)
            Rnd cu; float ykeep = 0.f, yra = 0.f, yrb = 0.f;
#define RED_STEP(x, ctl) asm volatile("v_add_f32_dpp %0, %0, %0 " ctl " row_mask:0xf bank_mask:0xf bound_ctrl:1" : "+v"(x))
#define RED_STEP0(x, ctl) asm volatile("s_nop 1\n\tv_add_f32_dpp %0, %0, %0 " ctl " row_mask:0xf bank_mask:0xf bound_ctrl:1" : "+v"(x))
#define RED4(a_, b_, c_, d_) do { \
            RED_STEP0(a_, "quad_perm:[1,0,3,2]"); RED_STEP0(b_, "quad_perm:[1,0,3,2]"); RED_STEP0(c_, "quad_perm:[1,0,3,2]"); RED_STEP0(d_, "quad_perm:[1,0,3,2]"); \
            RED_STEP(a_, "quad_perm:[2,3,0,1]"); RED_STEP(b_, "quad_perm:[2,3,0,1]"); RED_STEP(c_, "quad_perm:[2,3,0,1]"); RED_STEP(d_, "quad_perm:[2,3,0,1]"); \
            RED_STEP(a_, "row_half_mirror"); RED_STEP(b_, "row_half_mirror"); RED_STEP(c_, "row_half_mirror"); RED_STEP(d_, "row_half_mirror"); \
            RED_STEP(a_, "row_mirror"); RED_STEP(b_, "row_mirror"); RED_STEP(c_, "row_mirror"); RED_STEP(d_, "row_mirror"); } while (0)
            SC_FETCH(0, cu);
#pragma unroll
            for (int t = 0; t < TS; t += 2) {
                Rnd nx = cu;
                if (t + 2 < TS) SC_FETCH(t + 2, nx);
                const f32x4 p1 = S * cu.a, p2 = S * cu.aw;
                float u1 = (p1.x + p1.y) + (p1.z + p1.w), u2 = (p2.x + p2.y) + (p2.z + p2.w);
                RED4(u1, u2, yra, yrb);
                if (t > 0) { ykeep = (q == ((t - 2) & 15)) ? yra : ykeep; ykeep = (q == ((t - 1) & 15)) ? yrb : ykeep;
                             if (((t - 1) & 15) == 15) yb[(t - 16) * 8] = (unsigned short)f2bf(ykeep); }
                const float sa0 = u1, sa1 = u2 + sa0 * cu.be + cu.v0 * cu.ga;
                S = S * cu.w0 + (cu.b0 * sa0 + cu.k0 * cu.v0);
                const f32x4 y4a = S * cu.r0;
                S = S * cu.w1 + (cu.b1 * sa1 + cu.k1 * cu.v1);
                const f32x4 y4b = S * cu.r1;
                yra = (y4a.x + y4a.y) + (y4a.z + y4a.w); yrb = (y4b.x + y4b.y) + (y4b.z + y4b.w);
                cu = nx;
            }
            { float d0_ = 0.f, d1_ = 0.f; RED4(yra, yrb, d0_, d1_);
              ykeep = (q == 14) ? yra : ykeep; ykeep = (q == 15) ? yrb : ykeep; yb[16 * 8] = (unsigned short)f2bf(ykeep); }
#undef RED4
#undef RED_STEP0
#undef RED_STEP
#undef SC_FETCH
        }
        if (c + 1 < NCH) { if (par == 0) SC_STORE(1, g0); else SC_STORE(0, g1); }
        __syncthreads();
        if (F.tid < 32) { const v4u yv = *(const LAS v4u*)(L + YB_OFF + bf * 512 + F.tid * 16);
            *(v4u*)(Y + (rowb + (size_t)c * TS + F.tid) * D + col0 + part * 8) = yv; }
      }
    }
#undef SC_LOAD
#undef SC_STORE
}

__device__ __forceinline__ void kmean_phase(Frame& F, const bf16* Kb, float* KM) {
    LAS float* red = (LAS float*)(F.lds + RING_OFF);
    for (int u = blockIdx.x; u < 2 * 32 * 4; u += F.G) {
        const int qc = u & 3, blk = (u >> 2) & 31, b = u >> 7; const int c = F.tid & 255, rh = F.tid >> 8;
        const bf16* p = Kb + ((size_t)b * T + blk * 256 + rh * 128) * D + qc * 256 + c; float s = 0.f;
#pragma unroll 8
        for (int r = 0; r < 128; ++r) s += bf2f(p[(size_t)r * D]);
        if (rh == 1) red[c] = s;
        __syncthreads();
        if (rh == 0) { const int col = qc * 256 + c; KM[(((size_t)b * H + (col >> 6)) * 32 + blk) * 64 + (col & 63)] = (s + red[c]) * (1.f / 256.f); }
        __syncthreads();
    }
}
__device__ __forceinline__ void gate_phase(Frame& F, const bf16* Q, const float* KM, unsigned* SEL) {
    LAS float* km = (LAS float*)(F.lds + RING_OFF);
    for (int u = blockIdx.x; u < M / 64; u += F.G) {
        const int m0 = u * 64, b = m0 / T, own = (m0 % T) >> 8;
        for (int i = F.tid; i < 16 * 32 * 16; i += NWAVES * 64) *(LAS f32x4*)(km + 4 * i) = *(const f32x4*)(KM + (size_t)b * 16 * 32 * 64 + 4 * i);
        __syncthreads();
        const int m = m0 + F.lane;
#pragma unroll 1
        for (int hi = 0; hi < 2; ++hi) { const int h = 2 * F.wave + hi;
            float qv[64];
#pragma unroll
            for (int i = 0; i < 8; ++i) { const v4u w = *(const v4u*)(Q + (size_t)m * D + h * 64 + 8 * i);
                qv[8 * i + 0] = __uint_as_float(w.x << 16); qv[8 * i + 1] = __uint_as_float(w.x & 0xffff0000u); qv[8 * i + 2] = __uint_as_float(w.y << 16); qv[8 * i + 3] = __uint_as_float(w.y & 0xffff0000u);
                qv[8 * i + 4] = __uint_as_float(w.z << 16); qv[8 * i + 5] = __uint_as_float(w.z & 0xffff0000u); qv[8 * i + 6] = __uint_as_float(w.w << 16); qv[8 * i + 7] = __uint_as_float(w.w & 0xffff0000u); }
            float v0 = -INFINITY, v1 = -INFINITY, v2 = -INFINITY; int i0 = -1, i1 = -1, i2 = -1;
            for (int j = 0; j < own; ++j) { const LAS f32x4* kp = (const LAS f32x4*)(km + (h * 32 + j) * 64); float s = 0.f;
#pragma unroll
                for (int i = 0; i < 16; ++i) { const f32x4 kv = kp[i]; s += qv[4 * i] * kv.x + qv[4 * i + 1] * kv.y + qv[4 * i + 2] * kv.z + qv[4 * i + 3] * kv.w; }
                if (s > v0) { v2 = v1; i2 = i1; v1 = v0; i1 = i0; v0 = s; i0 = j; } else if (s > v1) { v2 = v1; i2 = i1; v1 = s; i1 = j; } else if (s > v2) { v2 = s; i2 = j; } }
            unsigned mask = 0u; if (i0 >= 0) mask |= 1u << i0; if (i1 >= 0) mask |= 1u << i1; if (i2 >= 0) mask |= 1u << i2;
            SEL[((size_t)b * H + h) * T + (m % T)] = mask; }
        __syncthreads();
    }
}

__device__ __forceinline__ void moe_prefix(Frame& F, const int* blkcnt, LAS int* pre_mine  ) {
    LAS int* tmp = (LAS int*)(F.lds + RING_OFF);
    for (int i = F.tid; i < F.G * 8; i += NWAVES * 64) tmp[i] = blkcnt[i];
    __syncthreads();
    if (F.tid < 8) { int tot = 0, mine = 0; for (int g = 0; g < F.G; ++g) { if (g == (int)blockIdx.x) mine = tot; tot += tmp[g * 8 + F.tid]; }
        pre_mine[F.tid] = mine; pre_mine[8 + F.tid] = tot; }
    __syncthreads();
    if (F.tid == 0) { int p = 0; for (int e = 0; e < 8; ++e) { F.MISC[16 + e] = (unsigned)p; p += (pre_mine[8 + e] + 255) >> 8; } F.MISC[24] = (unsigned)p; }
    __syncthreads();
}
__device__ __forceinline__ void moe_gather_phase(Frame& F, const int* blkcnt, const int* toke, const float* tokw, int* tokr, float* gw, const bf16* HB, bf16* XG) {
    LAS int* pm = (LAS int*)(F.lds + RING_OFF + 16384);
    LAS int* rows = (LAS int*)(F.lds + RING_OFF + 16384 + 64);
    moe_prefix(F, blkcnt, pm);
    const int rpb = M / F.G;
    if (F.wave == 0) {
        const int m = blockIdx.x * rpb + F.lane; const bool ok = F.lane < rpb;
        const int e0 = ok ? toke[2 * m] : -1, e1 = ok ? toke[2 * m + 1] : -1;
        int r0 = 0, r1 = 0;
        for (int e = 0; e < 8; ++e) { const unsigned long long b0 = __ballot(e0 == e), b1 = __ballot(e1 == e); const unsigned long long lt = (1ull << F.lane) - 1ull;
            const int base = (int)F.MISC[16 + e] * 256 + pm[e];
            if (e0 == e) r0 = base + __popcll(b0 & lt);
            if (e1 == e) r1 = base + __popcll(b0) + __popcll(b1 & lt); }
        if (ok) { tokr[2 * m] = r0; tokr[2 * m + 1] = r1; gw[r0] = tokw[2 * m]; gw[r1] = tokw[2 * m + 1]; rows[2 * F.lane] = r0; rows[2 * F.lane + 1] = r1; }
    }
    __syncthreads();
    for (int i = F.wave; i < 2 * rpb; i += NWAVES) { const int m = blockIdx.x * rpb + (i >> 1), r = rows[i];
        const v4u v0 = *(const v4u*)(HB + (size_t)m * D + 8 * F.lane), v1 = *(const v4u*)(HB + (size_t)m * D + 512 + 8 * F.lane);
        *(v4u*)(XG + (size_t)r * D + 8 * F.lane) = v0; *(v4u*)(XG + (size_t)r * D + 512 + 8 * F.lane) = v1; }
    __syncthreads();
}
__device__ __forceinline__ void attn_direct_phase(Frame& F, const bf16* Q, const bf16* Kb, const bf16* Vb, const unsigned* SEL, bf16* O) {
    for (int u = F.gw; u < (M / 64) * H; u += F.NGW) {
        const int h = u & 15, m0 = (u >> 4) * 64, b = m0 / T, t0 = m0 % T, own = t0 >> 8, m = m0 + F.lane, tpos = t0 + F.lane;
        float q[64], o[64];
#pragma unroll
        for (int i = 0; i < 8; ++i) { const v4u w = *(const v4u*)(Q + (size_t)m * D + h * 64 + 8 * i);
            q[8 * i + 0] = __uint_as_float(w.x << 16); q[8 * i + 1] = __uint_as_float(w.x & 0xffff0000u); q[8 * i + 2] = __uint_as_float(w.y << 16); q[8 * i + 3] = __uint_as_float(w.y & 0xffff0000u);
            q[8 * i + 4] = __uint_as_float(w.z << 16); q[8 * i + 5] = __uint_as_float(w.z & 0xffff0000u); q[8 * i + 6] = __uint_as_float(w.w << 16); q[8 * i + 7] = __uint_as_float(w.w & 0xffff0000u); }
#pragma unroll
        for (int i = 0; i < 64; ++i) o[i] = 0.f;
        const unsigned sel = SEL[((size_t)b * H + h) * T + tpos];
        float mrun = -INFINITY, l = 0.f;
        for (int j = 0; j <= own; ++j) {
            const bool pastsel = (sel >> j) & 1u;
            if (j < own && !__any(pastsel)) continue;
            const int nk = (j < own) ? 256 : (t0 & 255) + 64;
            for (int kk = 0; kk < nk; ++kk) {
                const int kpos = j * 256 + kk; const size_t ro = ((size_t)b * T + kpos) * D + h * 64;
                float s = 0.f;
#pragma unroll
                for (int i = 0; i < 8; ++i) { const v4u w = *(const v4u*)(Kb + ro + 8 * i);
                    s += q[8 * i + 0] * __uint_as_float(w.x << 16) + q[8 * i + 1] * __uint_as_float(w.x & 0xffff0000u) + q[8 * i + 2] * __uint_as_float(w.y << 16) + q[8 * i + 3] * __uint_as_float(w.y & 0xffff0000u)
                       + q[8 * i + 4] * __uint_as_float(w.z << 16) + q[8 * i + 5] * __uint_as_float(w.z & 0xffff0000u) + q[8 * i + 6] * __uint_as_float(w.w << 16) + q[8 * i + 7] * __uint_as_float(w.w & 0xffff0000u); }
                const bool act = (j < own) ? pastsel : (kpos <= tpos);
                if (act) {
                    if (s > mrun) { const float c = exp2f(mrun - s); l *= c;
#pragma unroll
                        for (int i = 0; i < 64; ++i) o[i] *= c;
                        mrun = s; }
                    const float p = exp2f(s - mrun); l += p;
#pragma unroll
                    for (int i = 0; i < 8; ++i) { const v4u w = *(const v4u*)(Vb + ro + 8 * i);
                        o[8 * i + 0] += p * __uint_as_float(w.x << 16); o[8 * i + 1] += p * __uint_as_float(w.x & 0xffff0000u); o[8 * i + 2] += p * __uint_as_float(w.y << 16); o[8 * i + 3] += p * __uint_as_float(w.y & 0xffff0000u);
                        o[8 * i + 4] += p * __uint_as_float(w.z << 16); o[8 * i + 5] += p * __uint_as_float(w.z & 0xffff0000u); o[8 * i + 6] += p * __uint_as_float(w.w << 16); o[8 * i + 7] += p * __uint_as_float(w.w & 0xffff0000u); }
                }
            }
        }
        const float rl = 1.0f / l;
#pragma unroll
        for (int i = 0; i < 8; ++i) { v4u w; w.x = pk2(o[8 * i] * rl, o[8 * i + 1] * rl); w.y = pk2(o[8 * i + 2] * rl, o[8 * i + 3] * rl); w.z = pk2(o[8 * i + 4] * rl, o[8 * i + 5] * rl); w.w = pk2(o[8 * i + 6] * rl, o[8 * i + 7] * rl);
            *(v4u*)(O + (size_t)m * D + h * 64 + 8 * i) = w; }
    }
}
namespace moba {
using attn_body::f32x16; using attn_body::crow;
constexpr int L_K = 0, L_V = 32768, L_LIST = 65536, L_WS = 81920, L_CTL = 84992;
__device__ __forceinline__ void qkt_l(f32x16& p0, f32x16& p1, const LAS unsigned char* Kslot, const bf16x8* qr, int r32, int hi) {
    const LAS unsigned char* kb = Kslot + hi * 1024 + r32 * 16;
#pragma unroll
    for (int d0 = 0; d0 < 4; ++d0) {
        const bf16x8 b0 = *(const LAS bf16x8*)(kb + d0 * 2048), b1 = *(const LAS bf16x8*)(kb + d0 * 2048 + 512);
        if (d0 == 0) { p0 = __builtin_amdgcn_mfma_f32_32x32x16_bf16(b0, qr[0], f32x16{}, 0, 0, 0); p1 = __builtin_amdgcn_mfma_f32_32x32x16_bf16(b1, qr[0], f32x16{}, 0, 0, 0); }
        else { p0 = __builtin_amdgcn_mfma_f32_32x32x16_bf16(b0, qr[d0], p0, 0, 0, 0); p1 = __builtin_amdgcn_mfma_f32_32x32x16_bf16(b1, qr[d0], p1, 0, 0, 0); } }
}
__device__ __forceinline__ float half_max(float v) { auto rr = __builtin_amdgcn_permlane32_swap(__float_as_uint(v), __float_as_uint(v), false, false); return fmaxf(__uint_as_float(rr[0]), __uint_as_float(rr[1])); }
__device__ __forceinline__ float half_sum(float v) { auto rr = __builtin_amdgcn_permlane32_swap(__float_as_uint(v), __float_as_uint(v), false, false); return __uint_as_float(rr[0]) + __uint_as_float(rr[1]); }
}
__device__ __forceinline__ void moba_attn_phase(Frame& F, const bf16* Q, const bf16* Kb, const bf16* Vb, const unsigned* SELT, bf16* PO, float* ML, gu32* qctr) {
    using namespace moba;
    const int lane = F.lane, wid = F.wave, r32 = lane & 31, hi = lane >> 5;
    LAS unsigned char* L = F.lds + RING_OFF;
    LAS unsigned short* list = (LAS unsigned short*)(L + L_LIST);
    LAS float* wsf = (LAS float*)(L + L_WS + wid * 256); LAS int* wsd = (LAS int*)(L + L_WS + wid * 256 + 128);
    LAS int* ctl = (LAS int*)(L + L_CTL);
    const int vb0 = RING_OFF + L_V + ((lane >> 4) & 1) * 32 + (lane & 3) * 8 + (4 * hi + ((lane & 15) >> 2)) * 64;
    for (;;) {
        __syncthreads();
        if (F.tid == 0) { ctl[0] = (int)__hip_atomic_fetch_add(qctr, 1u, __ATOMIC_RELAXED, __HIP_MEMORY_SCOPE_AGENT); ctl[1] = 0; }
        __syncthreads();
        const int u = __builtin_amdgcn_readfirstlane(ctl[0]);
        if (u >= 32 * 32) break;
        const int j = u >> 5, bh = u & 31, b = bh >> 4, h = bh & 15;
        const size_t rowb = (size_t)b * T;
        { const bf16* ksrc = Kb + (rowb + 256 * j + lane) * D + h * 64 + wid * 8;
          const bf16* vsrc = Vb + (rowb + 256 * j + 16 * (wid & 3) + (lane >> 2)) * D + h * 64 + (wid >> 2) * 32 + (lane & 3) * 8;
#pragma unroll
          for (int kt = 0; kt < 4; ++kt) { attn_body::glds16(ksrc + (size_t)kt * 64 * D, (unsigned)__builtin_amdgcn_readfirstlane(RING_OFF + L_K + kt * 8192 + wid * 1024));
                                           attn_body::glds16(vsrc + (size_t)kt * 64 * D, (unsigned)__builtin_amdgcn_readfirstlane(RING_OFF + L_V + kt * 8192 + wid * 1024)); } }
        const unsigned* selrow = SELT + (size_t)bh * T;
        for (int t0 = 256 * (j + 1); t0 < T; t0 += NWAVES * 64) { const int t = t0 + F.tid; const bool in = t < T;
            const bool p = in && ((selrow[in ? t : 0] >> j) & 1u);
            const unsigned long long bal = __ballot(p); const int np = __popcll(bal);
            int base = 0; if (lane == 0 && np) base = __hip_atomic_fetch_add(&ctl[1], np, __ATOMIC_RELAXED, __HIP_MEMORY_SCOPE_WORKGROUP);
            base = __builtin_amdgcn_readfirstlane(base);
            if (p) list[base + __popcll(bal & ((1ull << lane) - 1ull))] = (unsigned short)t; }
        asm volatile("s_waitcnt vmcnt(0) lgkmcnt(0)" ::: "memory");
        __syncthreads();
        const int total = 256 + ctl[1], nb = (total + 31) >> 5;
        for (int bi = wid; bi < nb; bi += NWAVES) {
            const int item = bi * 32 + r32; const bool valid = item < total; const int it2 = valid ? item : total - 1;
            const bool ownb = bi < 8;
            const int t = it2 < 256 ? 256 * j + it2 : (int)list[it2 - 256];
            const bf16* qrow = Q + (rowb + t) * D + h * 64;
            bf16x8 qr[4];
#pragma unroll
            for (int d0 = 0; d0 < 4; ++d0) qr[d0] = *(const bf16x8*)(qrow + d0 * 16 + hi * 8);
            f32x16 P[4][2];
#pragma unroll
            for (int kt = 0; kt < 4; ++kt) qkt_l(P[kt][0], P[kt][1], L + L_K + kt * 8192, qr, r32, hi);
            if (ownb) {
#pragma unroll
                for (int kt = 0; kt < 4; ++kt) attn_body::cmask(P[kt][0], P[kt][1], kt, t - 256 * j, hi); }
            float mx = -INFINITY;
#pragma unroll
            for (int kt = 0; kt < 4; ++kt)
#pragma unroll
                for (int r = 0; r < 16; ++r) mx = fmaxf(mx, fmaxf(P[kt][0][r], P[kt][1][r]));
            mx = half_max(mx);
            float ls = 0.f;
#pragma unroll
            for (int kt = 0; kt < 4; ++kt)
#pragma unroll
                for (int r = 0; r < 16; ++r) { P[kt][0][r] = __builtin_amdgcn_exp2f(P[kt][0][r] - mx); P[kt][1][r] = __builtin_amdgcn_exp2f(P[kt][1][r] - mx); ls += P[kt][0][r] + P[kt][1][r]; }
            ls = half_sum(ls);
            f32x16 o[2]; o[0] = f32x16{}; o[1] = f32x16{};
#pragma unroll
            for (int kt = 0; kt < 4; ++kt) {
                attn_body::u32x4 w0, w1, w2, w3;
#define PKW_(P_, B_) attn_body::cvtpk_s(P_[B_], P_[B_ + 1])
                w0 = (attn_body::u32x4){PKW_(P[kt][0], 0), PKW_(P[kt][0], 2), PKW_(P[kt][0], 4), PKW_(P[kt][0], 6)}; w1 = (attn_body::u32x4){PKW_(P[kt][0], 8), PKW_(P[kt][0], 10), PKW_(P[kt][0], 12), PKW_(P[kt][0], 14)};
                w2 = (attn_body::u32x4){PKW_(P[kt][1], 0), PKW_(P[kt][1], 2), PKW_(P[kt][1], 4), PKW_(P[kt][1], 6)}; w3 = (attn_body::u32x4){PKW_(P[kt][1], 8), PKW_(P[kt][1], 10), PKW_(P[kt][1], 12), PKW_(P[kt][1], 14)};
#undef PKW_
                attn_body::pv(o, vb0 + kt * 8192, __builtin_bit_cast(bf16x8, w0), __builtin_bit_cast(bf16x8, w1), __builtin_bit_cast(bf16x8, w2), __builtin_bit_cast(bf16x8, w3)); }
            const unsigned sel = selrow[t];
            const int slot = ownb ? 3 : __popc(sel & ((1u << j) - 1u));
            const int dest = (int)(((rowb + t) * H + h) * 4 + slot);
            if (hi == 0) { wsf[r32] = 1.0f / ls; wsd[r32] = valid ? dest : -1; if (valid) { ML[(size_t)dest * 2] = mx; ML[(size_t)dest * 2 + 1] = ls; } }
            asm volatile("s_waitcnt lgkmcnt(0)" ::: "memory");
#pragma unroll
            for (int r = 0; r < 16; ++r) { const int row = crow(r, hi); const float rl = wsf[row]; const int d = wsd[row];
                if (d >= 0) { PO[(size_t)d * 64 + r32] = (bf16)f2bf(o[0][r] * rl); PO[(size_t)d * 64 + 32 + r32] = (bf16)f2bf(o[1][r] * rl); } }
            asm volatile("s_waitcnt lgkmcnt(0)" ::: "memory");
        }
    }
}
__device__ __forceinline__ void moba_combine_phase(Frame& F, const unsigned* SELT, const bf16* PO, const float* ML, bf16* O) {
    for (int m = F.gw; m < M; m += F.NGW) {
        const int b = m / T, t = m % T, h = F.lane >> 2, qd = F.lane & 3;
        const unsigned sel = SELT[((size_t)b * H + h) * T + t]; const int cnt = __popc(sel);
        const size_t base = ((size_t)m * H + h) * 4;
        float ms[4], ls[4]; float mstar = -INFINITY;
#pragma unroll
        for (int s = 0; s < 4; ++s) { const bool on = (s == 3) || (s < cnt); ms[s] = on ? ML[(base + s) * 2] : -INFINITY; ls[s] = on ? ML[(base + s) * 2 + 1] : 0.f; mstar = fmaxf(mstar, ms[s]); }
        float wsum = 0.f, w[4];
#pragma unroll
        for (int s = 0; s < 4; ++s) { w[s] = ls[s] * __builtin_amdgcn_exp2f(ms[s] - mstar); wsum += w[s]; }
        const float rw = 1.0f / wsum;
        float acc[16];
#pragma unroll
        for (int i = 0; i < 16; ++i) acc[i] = 0.f;
#pragma unroll
        for (int s = 0; s < 4; ++s) { const bool on = (s == 3) || (s < cnt);
            if (on) { const float ws_ = w[s] * rw; const v4u a = *(const v4u*)(PO + (base + s) * 64 + qd * 16), c = *(const v4u*)(PO + (base + s) * 64 + qd * 16 + 8);
                const unsigned wv[8] = {a.x, a.y, a.z, a.w, c.x, c.y, c.z, c.w};
#pragma unroll
                for (int i = 0; i < 8; ++i) { acc[2 * i] += ws_ * __uint_as_float(wv[i] << 16); acc[2 * i + 1] += ws_ * __uint_as_float(wv[i] & 0xffff0000u); } } }
        v4u o0, o1; o0.x = pk2(acc[0], acc[1]); o0.y = pk2(acc[2], acc[3]); o0.z = pk2(acc[4], acc[5]); o0.w = pk2(acc[6], acc[7]); o1.x = pk2(acc[8], acc[9]); o1.y = pk2(acc[10], acc[11]); o1.z = pk2(acc[12], acc[13]); o1.w = pk2(acc[14], acc[15]);
        *(v4u*)(O + (size_t)m * D + h * 64 + qd * 16) = o0; *(v4u*)(O + (size_t)m * D + h * 64 + qd * 16 + 8) = o1;
    }
}


#ifdef DBG_CUT
__device__ __forceinline__ void dbg_copy(Frame& F, const void* src, bool is_bf16, float* out) {
    for (size_t i = (size_t)F.gw * 64 + F.lane; i < (size_t)M * D; i += (size_t)F.NGW * 64) out[i] = is_bf16 ? bf2f(((const bf16*)src)[i]) : ((const float*)src)[i];
}
#ifndef DBG_LAYER
#define DBG_LAYER -1
#endif
#define CUT(k, off, isbf) if (DBG_CUT == (k) && (DBG_LAYER < 0 || layer == DBG_LAYER)) { unsigned char* ws = WSB(); dbg_copy(F, ws + (off), (isbf), GOUT()); return; }
#else
#define CUT(k, off, isbf)
#endif
#ifndef REP_GEMM
#define REP_GEMM 1
#endif
#ifndef REP_THIN
#define REP_THIN 1
#endif
#ifndef REP_ATTN
#define REP_ATTN 1
#endif
#ifndef REP_BAR
#define REP_BAR 1
#endif
#define GEMM_BIG(EpiT, SchedT) for (int rg_ = 0; rg_ < REP_GEMM; ++rg_) pg8::gemm_phase<EpiT, SchedT, true, true>
#define GEMM_ONE(EpiT, SchedT) for (int rg_ = 0; rg_ < REP_GEMM; ++rg_) pg8::gemm_phase<EpiT, SchedT, false, true>
__global__ void __launch_bounds__(NWAVES * 64, 2) fwd_kernel(Args args) {
    extern __shared__ __attribute__((aligned(16))) unsigned char lds[];
    Frame F;
    F.lds = (LAS unsigned char*)lds; F.MISC = (volatile LAS unsigned*)(F.lds + MISC_OFF);
    F.wave = __builtin_amdgcn_readfirstlane((int)threadIdx.x >> 6); F.lane = fresh_lane(); F.tid = F.wave * 64 + F.lane;
    F.G = gridDim.x; { const int bx = blockIdx.x; F.vcu = (F.G % 8 == 0) ? (bx % 8) * (F.G / 8) + bx / 8 : bx; }
    F.gw = F.vcu * NWAVES + F.wave; F.NGW = F.G * NWAVES;
    F.ws = args.ws; F.ctl = (gu32*)(args.ws + WS_CTL);
#ifdef DBG_LDSZERO
    for (int u = F.tid; u < LDS_BYTES / 4; u += NWAVES * 64) ((LAS unsigned*)(F.lds))[u] = 0u;
#else
    for (int u = F.tid; u < (LDS_BYTES - LDSCTL_OFF) / 4; u += NWAVES * 64) ((LAS unsigned*)(F.lds + LDSCTL_OFF))[u] = 0u;
#endif
    __syncthreads();
    XcdBarrier bar = xcd_barrier_post((unsigned*)(F.ctl + CW_BAR), F.MISC + 8, F.tid == 0);
#define GRID_BAR() do { { GAS unsigned* b_ = (GAS unsigned*)bar.bar; asm volatile("" : "+s"(b_), "+s"(bar.x)); bar.bar = (unsigned*)b_; } for (int rb_ = 0; rb_ < REP_BAR; ++rb_) xcd_barrier(bar, F.wave == 0 && fresh_lane() == 0); } while (0)
#define WSB() ({ F.lane = fresh_lane(); F.tid = F.wave * 64 + F.lane; asm volatile("" : "+s"(F.G), "+s"(F.wave), "+s"(F.vcu), "+s"(F.gw), "+s"(F.NGW), "+s"(bx)); GAS unsigned char* p_ = (GAS unsigned char*)args.ws; asm volatile("" : "+s"(p_)); (unsigned char*)p_; })
#define GOUT() ({ GAS float* o_ = (GAS float*)args.out; asm volatile("" : "+s"(o_)); (float*)o_; })
#define INP(i) ({ const __attribute__((address_space(4))) char* k_ = (const __attribute__((address_space(4))) char*)__builtin_amdgcn_kernarg_segment_ptr(); asm volatile("" : "+s"(k_)); const GAS float* g_ = (const GAS float*)(*(const float* const __attribute__((address_space(4)))*)(k_ + 8 * (i))); asm volatile("" : "+s"(g_)); (const float*)g_; })
    LAS unsigned char* ring = F.lds + RING_OFF;
    int bx = (int)blockIdx.x;

    for (int rt_ = 0; rt_ < REP_THIN; ++rt_) conv_rwkv(F, 0); for (int rt_ = 0; rt_ < REP_THIN; ++rt_) conv_dense(F, 0);
    GRID_BAR();

#ifndef LAYER_LO
#define LAYER_LO 0
#define LAYER_HI 4
#endif
    for (int layer = LAYER_LO; layer < LAYER_HI; ++layer) {
        const bool moe = (layer & 1) != 0; const int fe = layer >> 1;
        if (layer < 2) {
            const int l = layer;
            { unsigned char* ws = WSB(); for (int rt_ = 0; rt_ < REP_THIN; ++rt_) mix_phase(F, layer == 0 ? INP(I_X) : (const float*)(ws + WS_H), INP(I_MU) + (size_t)l * 6 * D, (bf16*)(ws + RS_XM)); }
            GRID_BAR();
            { unsigned char* ws = WSB(); pg8::Gemm g{D, D, D}; pg8::SchedStd S; S.init(M, 4096, F.G, bx, ws + RS_XM, D, ws + WM_BT1 + (size_t)l * RW_LSTRIDE, D, 1, (size_t)M * D * 2);
              pg8::EpiRkv E{(bf16*)(ws + RS_RKV), (long)RS_LH - (long)RS_RKV, (size_t)M * D};
              GEMM_BIG(pg8::EpiRkv, pg8::SchedStd)(ring, g, S, E, F.wave); }
            GRID_BAR();
            CUT(1, RS_RKV, true)
            { unsigned char* ws = WSB(); pg8::Gemm g{256, D, 256}; pg8::SchedStd S; S.init(M, 4096, F.G, bx, ws + RS_LH, D, ws + WM_BT2 + (size_t)l * RW_LSTRIDE, 256, 2, 0);
              pg8::EpiLoraUpAll E{{(void*)(ws + RS_DEC), INP(I_W0) + (size_t)l * D}, {(void*)(ws + RS_AB), INP(I_A0) + (size_t)l * D}, {(void*)(ws + RS_VG), INP(I_V0)}, {(void*)(ws + RS_GG), nullptr}};
              GEMM_BIG(pg8::EpiLoraUpAll, pg8::SchedStd)(ring, g, S, E, F.wave); }
            GRID_BAR();
            CUT(2, RS_DEC, false) CUT(60, RS_VG, true) CUT(61, RS_GG, true) CUT(62, RS_LH, true) CUT(63, RS_AB, false)
            { unsigned char* ws = WSB(); for (int rt_ = 0; rt_ < REP_THIN; ++rt_) prep_phase(F, l, (bf16*)(ws + RS_RKV), (const float*)(ws + RS_AB), (bf16*)(ws + RS_LH), INP(I_V0), INP(I_V2), (bf16*)(ws + WS_VFIRST), INP(I_KK) + (size_t)l * D, INP(I_KA) + (size_t)l * D,
                                                   (bf16*)(ws + RS_KP), (bf16*)(ws + RS_AP), (bf16*)(ws + RS_BP), (bf16*)(ws + RS_VP)); }
            GRID_BAR();
            CUT(3, RS_KP, true) CUT(7, RS_VP, true) CUT(8, RS_BP, true) CUT(9, RS_DEC, false)
#ifndef NO_SCAN
#ifndef REP_SCAN
#define REP_SCAN 1
#endif
            for (int rep_ = 0; rep_ < REP_SCAN; ++rep_) {
              { unsigned char* ws = WSB(); scan_phase(F, (bf16*)(ws + RS_RKV), (float*)(ws + RS_DEC), (bf16*)(ws + RS_KP), (bf16*)(ws + RS_AP), (bf16*)(ws + RS_BP), (bf16*)(ws + RS_VP), (bf16*)(ws + WS_Y)); }
              if (rep_ + 1 < REP_SCAN) GRID_BAR(); }
#endif
            GRID_BAR();
            CUT(4, WS_Y, true)
            { unsigned char* ws = WSB(); for (int rt_ = 0; rt_ < REP_THIN; ++rt_) post_phase(F, (bf16*)(ws + WS_Y), (bf16*)(ws + RS_RKV), (bf16*)(ws + RS_KP), (bf16*)(ws + RS_VP), (bf16*)(ws + RS_GG),
                                                   INP(I_RK) + (size_t)l * D, INP(I_GNG) + (size_t)l * D, INP(I_GNB) + (size_t)l * D, (bf16*)(ws + RS_YG)); }
            GRID_BAR();
            CUT(5, RS_YG, true)
            { unsigned char* ws = WSB(); pg8::Gemm g{D, D, D}; pg8::SchedStd S; S.init(M, D, F.G, bx, ws + RS_YG, D, ws + WM_OUT + (size_t)l * RW_LSTRIDE, D);
              pg8::EpiResF32 E{layer == 0 ? INP(I_X) : (const float*)(ws + WS_H), (float*)(ws + RS_PRE), ALPHA};
              GEMM_ONE(pg8::EpiResF32, pg8::SchedStd)(ring, g, S, E, F.wave); }
            GRID_BAR();
            CUT(6, RS_PRE, false)
        } else {
            const int j = layer - 2;
            { unsigned char* ws = WSB(); pg8::Gemm g{D, D, D}; pg8::SchedStd S; S.init(M, j == 0 ? 3 * D : D, F.G, bx, ws + WS_HB, D, ws + WM_QKV, D);
              pg8::EpiQKV E{(bf16*)(ws + BS_Q), ((long)WS_K - (long)BS_Q) / 2, ((long)WS_V - (long)BS_Q) / 2, attn_body::C2};
              GEMM_BIG(pg8::EpiQKV, pg8::SchedStd)(ring, g, S, E, F.wave); }
            GRID_BAR();
            CUT(31, BS_Q, true) CUT(32, WS_K, true) CUT(33, WS_V, true)
            if (j == 0) { unsigned char* ws = WSB(); for (int rt_ = 0; rt_ < REP_THIN; ++rt_) kmean_phase(F, (bf16*)(ws + WS_K), (float*)(ws + WS_KMEAN)); GRID_BAR(); }
#ifndef NO_GATE
            { unsigned char* ws = WSB(); for (int rt_ = 0; rt_ < REP_THIN; ++rt_) gate_phase(F, (bf16*)(ws + BS_Q), (float*)(ws + WS_KMEAN), (unsigned*)(ws + WS_SEL)); }
#endif
            GRID_BAR();
#ifdef DBG_CUT
            if (DBG_CUT == 35) { unsigned char* ws = WSB(); const unsigned* s_ = (const unsigned*)(ws + WS_SEL); for (size_t i = (size_t)F.gw * 64 + F.lane; i < (size_t)M * D; i += (size_t)F.NGW * 64) args.out[i] = (float)(s_[i & (size_t)(M * 16 - 1)] % 65521u); return; }
#endif
#ifdef ATTN_DIRECT
            { unsigned char* ws = WSB(); attn_direct_phase(F, (const bf16*)(ws + BS_Q), (const bf16*)(ws + WS_K), (const bf16*)(ws + WS_V), (const unsigned*)(ws + WS_SEL), (bf16*)(ws + BS_O)); }
            GRID_BAR();
#else
            { unsigned char* ws = WSB(); for (int ra_ = 0; ra_ < REP_ATTN; ++ra_) moba_attn_phase(F, (const bf16*)(ws + BS_Q), (const bf16*)(ws + WS_K), (const bf16*)(ws + WS_V), (const unsigned*)(ws + WS_SEL), (bf16*)(ws + BS_PO), (float*)(ws + BS_ML), F.ctl + CW_QCTR + 64 * (j + 2 * ra_)); }
            GRID_BAR();
            { unsigned char* ws = WSB(); for (int rt_ = 0; rt_ < REP_THIN; ++rt_) moba_combine_phase(F, (const unsigned*)(ws + WS_SEL), (const bf16*)(ws + BS_PO), (const float*)(ws + BS_ML), (bf16*)(ws + BS_O)); }
            GRID_BAR();
#endif
            CUT(36, BS_O, true)
#ifdef DBG_CUT
            if (DBG_CUT == 37 && (DBG_LAYER < 0 || layer == DBG_LAYER)) {
                { unsigned char* ws = WSB(); attn_direct_phase(F, (const bf16*)(ws + BS_Q), (const bf16*)(ws + WS_K), (const bf16*)(ws + WS_V), (const unsigned*)(ws + WS_SEL), (bf16*)(ws + BS_PRE)); }
                GRID_BAR();
                { unsigned char* ws = WSB(); const bf16* a_ = (const bf16*)(ws + BS_O); const bf16* b_ = (const bf16*)(ws + BS_PRE); float* o_ = GOUT();
                  for (size_t i = (size_t)F.gw * 64 + F.lane; i < (size_t)M * D; i += (size_t)F.NGW * 64) o_[i] = 1000.f * (bf2f(a_[i]) - bf2f(b_[i])); }
                return; }
#endif
            { unsigned char* ws = WSB(); pg8::Gemm g{D, D, D}; pg8::SchedStd S; S.init(M, D, F.G, bx, ws + BS_O, D, ws + WM_O, D);
              pg8::EpiResF32 E{(const float*)(ws + WS_H), (float*)(ws + BS_PRE), ALPHA};
              GEMM_ONE(pg8::EpiResF32, pg8::SchedStd)(ring, g, S, E, F.wave); }
            GRID_BAR();
        }
        { unsigned char* ws = WSB(); const float* PREm = (const float*)(ws + (layer < 2 ? RS_PRE : BS_PRE));
          const float* g0 = INP(I_LNG) + (size_t)(layer * 2) * D; const float* b0 = INP(I_LNB) + (size_t)(layer * 2) * D;
          if (moe) for (int rt_ = 0; rt_ < REP_THIN; ++rt_) ln_phase<0, true>(F, PREm, nullptr, nullptr, nullptr, g0, b0, (float*)(ws + WS_H), (bf16*)(ws + WS_HB), INP(I_ROUTER) + (size_t)fe * D * NE, (int*)(ws + WS_TOKE), (float*)(ws + WS_TOKW), (int*)(ws + WS_BLKCNT));
          else for (int rt_ = 0; rt_ < REP_THIN; ++rt_) ln_phase<0, false>(F, PREm, nullptr, nullptr, nullptr, g0, b0, (float*)(ws + WS_H), (bf16*)(ws + WS_HB), nullptr, nullptr, nullptr, nullptr); }
        if (layer == 0) for (int rt_ = 0; rt_ < REP_THIN; ++rt_) conv_rwkv(F, 1); else if (layer == 1) for (int rt_ = 0; rt_ < REP_THIN; ++rt_) conv_moba(F, 0); else if (layer == 2) for (int rt_ = 0; rt_ < REP_THIN; ++rt_) conv_moba(F, 1);
        GRID_BAR();
        CUT(10 + layer, WS_H, false)
        if (!moe) {
            { unsigned char* ws = WSB(); pg8::Gemm g{D, D, D}; pg8::SchedStd S; S.init(M, 2 * FF, F.G, bx, ws + WS_HB, D, ws + WF_GU, D);
              pg8::EpiSwiGLU E{(bf16*)(ws + FS_HID), FF};
              GEMM_BIG(pg8::EpiSwiGLU, pg8::SchedStd)(ring, g, S, E, F.wave); }
            GRID_BAR();
            { unsigned char* ws = WSB(); pg8::Gemm g{FF, FF, FF}; pg8::SchedStd S; S.init(M, D, F.G, bx, ws + FS_HID, FF, ws + WF_DN, FF);
              pg8::EpiResF32 E{(const float*)(ws + WS_H), (float*)(ws + FS_PRE), ALPHA};
              GEMM_ONE(pg8::EpiResF32, pg8::SchedStd)(ring, g, S, E, F.wave); }
            GRID_BAR();
            { unsigned char* ws = WSB(); const float* g1 = INP(I_LNG) + (size_t)(layer * 2 + 1) * D; const float* b1 = INP(I_LNB) + (size_t)(layer * 2 + 1) * D;
              for (int rt_ = 0; rt_ < REP_THIN; ++rt_) ln_phase<0, false>(F, (const float*)(ws + FS_PRE), nullptr, nullptr, nullptr, g1, b1, (float*)(ws + WS_H), (bf16*)(ws + WS_HB), nullptr, nullptr, nullptr, nullptr); }
            for (int rt_ = 0; rt_ < REP_THIN; ++rt_) conv_moe(F, fe);
            GRID_BAR();
        } else {
            { unsigned char* ws = WSB(); for (int rt_ = 0; rt_ < REP_THIN; ++rt_) moe_gather_phase(F, (const int*)(ws + WS_BLKCNT), (const int*)(ws + WS_TOKE), (const float*)(ws + WS_TOKW), (int*)(ws + WS_TOKR), (float*)(ws + WS_GW), (bf16*)(ws + WS_HB), (bf16*)(ws + ES_XG)); }
            GRID_BAR();
            { unsigned char* ws = WSB(); const LAS int* pp = (const LAS int*)(F.lds + MISC_OFF + 64);
              pg8::Gemm g{D, D, D}; pg8::SchedMoe S{2 * FFE / 256, F.G, bx, pp, (const char*)(ws + ES_XG), (const char*)(ws + WE_GU), (size_t)256 * D * 2, (size_t)256 * D * 2, (size_t)2 * FFE * D * 2};
              pg8::EpiSwiGLU E{(bf16*)(ws + ES_HID), FFE};
              GEMM_BIG(pg8::EpiSwiGLU, pg8::SchedMoe)(ring, g, S, E, F.wave); }
            GRID_BAR();
            { unsigned char* ws = WSB(); const LAS int* pp = (const LAS int*)(F.lds + MISC_OFF + 64);
              pg8::Gemm g{FFE, FFE, FFE}; pg8::SchedMoe S{D / 256, F.G, bx, pp, (const char*)(ws + ES_HID), (const char*)(ws + WE_DN), (size_t)256 * FFE * 2, (size_t)256 * FFE * 2, (size_t)D * FFE * 2};
              pg8::EpiMoeDown E{(float*)(ws + ES_YP), (const float*)(ws + WS_GW)};
              GEMM_BIG(pg8::EpiMoeDown, pg8::SchedMoe)(ring, g, S, E, F.wave); }
            GRID_BAR();
            { unsigned char* ws = WSB(); const float* g1 = INP(I_LNG) + (size_t)(layer * 2 + 1) * D; const float* b1 = INP(I_LNB) + (size_t)(layer * 2 + 1) * D;
              if (layer == 3) ln_phase<1, false>(F, nullptr, (const float*)(ws + WS_H), (const float*)(ws + ES_YP), (const int*)(ws + WS_TOKR), g1, b1, GOUT(), nullptr, nullptr, nullptr, nullptr, nullptr);
              else ln_phase<1, false>(F, nullptr, (const float*)(ws + WS_H), (const float*)(ws + ES_YP), (const int*)(ws + WS_TOKR), g1, b1, (float*)(ws + WS_H), (bf16*)(ws + WS_HB), nullptr, nullptr, nullptr, nullptr); }
            if (layer == 1) for (int rt_ = 0; rt_ < REP_THIN; ++rt_) conv_dense(F, 1);
            GRID_BAR();
        }
        CUT(20 + layer, WS_H, false)
        CUT(40 + layer, WS_HB, true)
#ifdef DBG_CUT
        if (DBG_CUT == 50 + layer) { unsigned char* ws = WSB(); const bf16* s_ = (const bf16*)(ws + WS_WMIX); float* o_ = GOUT(); for (size_t i = (size_t)F.gw * 64 + F.lane; i < (size_t)M * D; i += (size_t)F.NGW * 64) o_[i] = i < (size_t)6 * 1024 * 1024 ? bf2f(s_[i]) : 0.f; return; }
#endif
    }
}

extern "C" void kernel_launch(void* const* d_in, const int* in_sizes, int n_in, void* d_out, int out_size, void* d_ws, size_t ws_size, hipStream_t stream) {
    static int grid = 0;
    if (grid == 0) {
        if (n_in != 33 || in_sizes[0] != M * D || out_size != M * D || ws_size < WS_END) { fprintf(stderr, "kernel_launch: unexpected problem shape (n_in %d, in0 %d, out %d, ws %zu); nothing launched\n", n_in, n_in > 0 ? in_sizes[0] : -1, out_size, ws_size); grid = -1; return; }
        int dev = 0, cus = 0, per_cu = 0;
        if (hipGetDevice(&dev) != hipSuccess || hipDeviceGetAttribute(&cus, hipDeviceAttributeMultiprocessorCount, dev) != hipSuccess) { grid = -1; return; }
        if (hipFuncSetAttribute((const void*)fwd_kernel, hipFuncAttributeMaxDynamicSharedMemorySize, LDS_BYTES) != hipSuccess) { fprintf(stderr, "kernel_launch: hipFuncSetAttribute failed\n"); grid = -1; return; }
        if (hipOccupancyMaxActiveBlocksPerMultiprocessor(&per_cu, (const void*)fwd_kernel, NWAVES * 64, LDS_BYTES) != hipSuccess || per_cu < 1) { fprintf(stderr, "kernel_launch: occupancy query reports %d workgroups per CU\n", per_cu); }
        (void)hipGetLastError();
        grid = cus;
        if (grid != 256) { fprintf(stderr, "kernel_launch: built for 256 CUs, device has %d; nothing launched\n", cus); grid = -1; return; }
    }
    if (grid < 0) return;
    if (hipMemsetAsync((char*)d_ws + WS_CTL, 0, CTL_ZERO_BYTES, stream) != hipSuccess) return;
#ifdef DBG_FILL
    (void)hipMemsetAsync((char*)d_ws + CTL_ZERO_BYTES, DBG_FILL, WS_END - CTL_ZERO_BYTES, stream);
#endif
    Args a{};
    for (int i = 0; i < 33; ++i) a.in[i] = (const float*)d_in[i];
    a.out = (float*)d_out; a.ws = (unsigned char*)d_ws;
    hipLaunchKernelGGL(fwd_kernel, dim3(grid), dim3(NWAVES * 64), LDS_BYTES, stream, a);
}
```

```cpp
#include <hip/hip_runtime.h>
#include <cstdio>
#include <cstdint>
#include <hip/hip_bf16.h>
#include <cmath>
__device__ __forceinline__ int fresh_lane() { int l; asm volatile("v_mbcnt_lo_u32_b32 %0, -1, 0\n\tv_mbcnt_hi_u32_b32 %0, -1, %0" : "=v"(l)); return l; }
namespace pg8 {
#define PG8_LAS __attribute__((address_space(3)))
typedef unsigned short bf16_t;
typedef short bf16x8 __attribute__((ext_vector_type(8)));
typedef float f32x4 __attribute__((ext_vector_type(4)));
typedef unsigned u32x4 __attribute__((ext_vector_type(4)));
constexpr int BM = 256, BK = 64, HALF = 128, HTB = HALF * BK * 2  , STAGE_BYTES = 8 * HTB, NXCD = 8, WGM = 8;

__host__ __device__ __forceinline__ int lds_byte(int r, int c) { const int st = (r >> 4) * 2 + (c >> 5), rr = r & 15, cc = c & 31, ob = rr * 64 + cc * 2; return st * 1024 + (ob ^ (((ob >> 9) & 1) << 5)); }
__host__ __device__ __forceinline__ void stage_rc(int b, int& R, int& C) { const int st = b / 1024, sb = b % 1024, swz = sb ^ (((sb >> 9) & 1) << 5); R = (st >> 1) * 16 + swz / 64; C = (st & 1) * 32 + (swz % 64) / 2; }
__host__ __device__ __forceinline__ int perm32(int rho) { const int n = rho >> 4, i = rho & 15; return 8 * (i >> 2) + 4 * n + (i & 3); }

struct Unit { int pm, pn, e; };
struct Gemm { int K, lda, ldb; };

__device__ __forceinline__ unsigned cvt_pk_bf16(float lo, float hi) { unsigned r; asm volatile("v_cvt_pk_bf16_f32 %0, %1, %2" : "=v"(r) : "v"(lo), "v"(hi)); return r; }
__device__ __forceinline__ float fsigmoid(float x) { return __builtin_amdgcn_rcpf(1.0f + __expf(-x)); }
__device__ __forceinline__ float ftanh(float x) { return 1.0f - 2.0f * __builtin_amdgcn_rcpf(1.0f + __expf(2.0f * x)); }

struct SchedStd {
    int nM, nN, nwg, G, c, amode; const char* A; const char* B; size_t atile, btile, ag;
    __device__ __forceinline__ void init(int M, int N, int G_, int c_, const void* A_, size_t lda, const void* B_, size_t ldb, int amode_ = 0, size_t ag_ = 0) {
        nM = M / BM; nN = N / BM; nwg = nM * nN; G = G_; c = c_; A = (const char*)A_; B = (const char*)B_; atile = (size_t)BM * lda * 2; btile = (size_t)BM * ldb * 2; amode = amode_; ag = ag_; }
    __device__ __forceinline__ bool next(int i, Unit& u) const {
        const long L = (long)i * G + c; if (L >= nwg) return false;
        int wgid = (int)L; { const int q = nwg / NXCD, r = nwg % NXCD, xcd = wgid % NXCD, off = wgid / NXCD; wgid = (xcd < r ? xcd * (q + 1) : r * (q + 1) + (xcd - r) * q) + off; }
        const int nig = WGM * nN, gid = wgid / nig, fm = gid * WGM, gsz = (nM - fm) < WGM ? (nM - fm) : WGM;
        u.pm = fm + ((wgid % nig) % gsz); u.pn = (wgid % nig) / gsz; u.e = 0; return true;
    }
    __device__ __forceinline__ const char* abase(const Unit& u) const {
        size_t off = (size_t)u.pm * atile;
        if (amode == 1) { const int gs = u.pn < 12 ? (u.pn >> 2) : (u.pn == 12 ? 3 : (u.pn == 13 ? 4 : (u.pn == 14 ? 2 : 5))); off += (size_t)gs * ag; }
        else if (amode == 2) off += (size_t)(u.pn >> 2) * 512;
        return A + off; }
    __device__ __forceinline__ const char* bbase(const Unit& u) const { return B + (size_t)u.pn * btile; }
    __device__ __forceinline__ void a_ready(const Unit&) const {}
    __device__ __forceinline__ void done(const Unit&) const {}
};
struct SchedMoe {
    int nN, G, c; const PG8_LAS int* pp; const char* A; const char* B; size_t atile, btile, bexp;
    __device__ __forceinline__ bool next(int i, Unit& u) const {
        const int L = i * G + c, tot = pp[8] * nN; if (L >= tot) return false;
        const int pm = L / nN; u.pm = pm; u.pn = L - pm * nN; int e = 0;
#pragma unroll
        for (int k = 1; k < 8; ++k) e += (pm >= pp[k]) ? 1 : 0;
        u.e = __builtin_amdgcn_readfirstlane(e); return true; }
    __device__ __forceinline__ const char* abase(const Unit& u) const { return A + (size_t)u.pm * atile; }
    __device__ __forceinline__ const char* bbase(const Unit& u) const { return B + (size_t)u.e * bexp + (size_t)u.pn * btile; }
    __device__ __forceinline__ void a_ready(const Unit&) const {}
    __device__ __forceinline__ void done(const Unit&) const {}
};

#define PG8_PACK8(w, v0, v1) do { w.x = cvt_pk_bf16(v0[0], v0[1]); w.y = cvt_pk_bf16(v0[2], v0[3]); w.z = cvt_pk_bf16(v1[0], v1[1]); w.w = cvt_pk_bf16(v1[2], v1[3]); } while (0)

struct EpiQKV {
    static constexpr bool PERM = true, AFTER_DRAIN = false;
    bf16_t* O0; long d1, d2; float s0;
    __device__ __forceinline__ void operator()(const f32x4 (&acc)[2][2][4][2], const Unit& u, int wr, int wc, int fr, int fq) const {
        const int t = u.pn >> 2; bf16_t* base = O0 + (long)(t == 1) * d1 + (long)(t == 2) * d2; const float sc = t == 0 ? s0 : 1.0f;
        const int row0 = u.pm * BM + wr * 64 + fr, col0 = (u.pn & 3) * BM + wc * 32 + 8 * fq;
#pragma unroll
        for (int ai = 0; ai < 2; ++ai)
#pragma unroll
            for (int m = 0; m < 4; ++m) { bf16_t* rowp = base + (size_t)(row0 + ai * HALF + m * 16) * 1024 + col0;
#pragma unroll
                for (int bj = 0; bj < 2; ++bj) { const f32x4 v0 = acc[ai][bj][m][0] * sc, v1 = acc[ai][bj][m][1] * sc; u32x4 w; PG8_PACK8(w, v0, v1); *(u32x4*)(rowp + bj * HALF) = w; } }
    }
};
struct EpiRkv {
    static constexpr bool PERM = true, AFTER_DRAIN = false;
    bf16_t* RKV; long dLH; size_t mstride;
    __device__ __forceinline__ void operator()(const f32x4 (&acc)[2][2][4][2], const Unit& u, int wr, int wc, int fr, int fq) const {
        const int pn = u.pn; const bool lora = pn >= 12;
        bf16_t* base = (bf16_t*)((char*)RKV + (lora ? dLH : (long)((size_t)(pn >> 2) * mstride * 2))); const int colt = lora ? (pn - 12) * BM : (pn & 3) * BM;
        const int row0 = u.pm * BM + wr * 64 + fr, col0 = colt + wc * 32 + 8 * fq;
#pragma unroll
        for (int ai = 0; ai < 2; ++ai)
#pragma unroll
            for (int m = 0; m < 4; ++m) { bf16_t* rowp = base + (size_t)(row0 + ai * HALF + m * 16) * 1024 + col0;
#pragma unroll
                for (int bj = 0; bj < 2; ++bj) { f32x4 v0 = acc[ai][bj][m][0], v1 = acc[ai][bj][m][1];
                    if (pn == 12) {
#pragma unroll
                        for (int i = 0; i < 4; ++i) { v0[i] = ftanh(v0[i]); v1[i] = ftanh(v1[i]); } }
                    else if (pn == 15) {
#pragma unroll
                        for (int i = 0; i < 4; ++i) { v0[i] = fsigmoid(v0[i]); v1[i] = fsigmoid(v1[i]); } }
                    u32x4 w; PG8_PACK8(w, v0, v1); *(u32x4*)(rowp + bj * HALF) = w; } }
    }
};
template <int GRP> struct EpiLoraUp {
    static constexpr bool PERM = true, AFTER_DRAIN = false;
    void* O; const float* bias;
    __device__ __forceinline__ void operator()(const f32x4 (&acc)[2][2][4][2], const Unit& u, int wr, int wc, int fr, int fq) const {
        const int row0 = u.pm * BM + wr * 64 + fr, col0 = u.pn * BM + wc * 32 + 8 * fq;
#pragma unroll
        for (int bj = 0; bj < 2; ++bj) {
            f32x4 bv0 = (f32x4){0.f, 0.f, 0.f, 0.f}, bv1 = bv0;
            if (GRP < 3) { bv0 = *(const f32x4*)(bias + col0 + bj * HALF); bv1 = *(const f32x4*)(bias + col0 + bj * HALF + 4); }
#pragma unroll
            for (int ai = 0; ai < 2; ++ai)
#pragma unroll
                for (int m = 0; m < 4; ++m) { const size_t ro = (size_t)(row0 + ai * HALF + m * 16) * 1024 + col0 + bj * HALF;
                    f32x4 v0_ = acc[ai][bj][m][0] + bv0, v1_ = acc[ai][bj][m][1] + bv1;
                    if (GRP == 0) {
#pragma unroll
                        for (int i = 0; i < 4; ++i) { v0_[i] = __expf(-0.6065306597f * fsigmoid(v0_[i])); v1_[i] = __expf(-0.6065306597f * fsigmoid(v1_[i])); }
                    } else if (GRP < 3) {
#pragma unroll
                        for (int i = 0; i < 4; ++i) { v0_[i] = fsigmoid(v0_[i]); v1_[i] = fsigmoid(v1_[i]); }
                    }
                    if (GRP < 2) { *(f32x4*)((float*)O + ro) = v0_; *(f32x4*)((float*)O + ro + 4) = v1_; }
                    else { u32x4 w; PG8_PACK8(w, v0_, v1_); *(u32x4*)((bf16_t*)O + ro) = w; } }
        }
    }
};
struct EpiLoraUpAll {
    static constexpr bool PERM = true, AFTER_DRAIN = false;
    EpiLoraUp<0> e0; EpiLoraUp<1> e1; EpiLoraUp<2> e2; EpiLoraUp<3> e3;
    __device__ __forceinline__ void operator()(const f32x4 (&acc)[2][2][4][2], const Unit& u, int wr, int wc, int fr, int fq) const {
        Unit v = u; v.pn = u.pn & 3; const int g = u.pn >> 2;
        if (g == 0) e0(acc, v, wr, wc, fr, fq); else if (g == 1) e1(acc, v, wr, wc, fr, fq); else if (g == 2) e2(acc, v, wr, wc, fr, fq); else e3(acc, v, wr, wc, fr, fq);
    }
};
struct EpiResF32 {
    static constexpr bool PERM = false, AFTER_DRAIN = false;
    const float* base; float* out; float alpha;
    __device__ __forceinline__ void operator()(const f32x4 (&acc)[2][2][4][2], const Unit& u, int wr, int wc, int fr, int fq) const {
        const int row0 = u.pm * BM + wr * 64 + fr, col0 = u.pn * BM + wc * 32 + 4 * fq;
#pragma unroll
        for (int ai = 0; ai < 2; ++ai)
#pragma unroll
            for (int m = 0; m < 4; ++m) { const size_t ro = (size_t)(row0 + ai * HALF + m * 16) * 1024 + col0;
#pragma unroll
                for (int bj = 0; bj < 2; ++bj)
#pragma unroll
                    for (int n = 0; n < 2; ++n) { const f32x4 b = *(const f32x4*)(base + ro + bj * HALF + n * 16); *(f32x4*)(out + ro + bj * HALF + n * 16) = b * alpha + acc[ai][bj][m][n]; } }
    }
};
struct EpiSwiGLU {
    static constexpr bool PERM = true, AFTER_DRAIN = false;
    bf16_t* Hd; int ldh; float sc;
    __device__ __forceinline__ void operator()(const f32x4 (&acc)[2][2][4][2], const Unit& u, int wr, int wc, int fr, int fq) const {
        const int row0 = u.pm * BM + wr * 64 + fr, col0 = u.pn * HALF + wc * 32 + 8 * fq;
#pragma unroll
        for (int ai = 0; ai < 2; ++ai)
#pragma unroll
            for (int m = 0; m < 4; ++m) { bf16_t* rowp = Hd + (size_t)(row0 + ai * HALF + m * 16) * ldh + col0;
                f32x4 v0, v1;
#pragma unroll
                for (int i = 0; i < 4; ++i) { const float g0 = acc[ai][0][m][0][i] * sc, g1 = acc[ai][0][m][1][i] * sc;
                    v0[i] = g0 * fsigmoid(g0) * (acc[ai][1][m][0][i] * sc); v1[i] = g1 * fsigmoid(g1) * (acc[ai][1][m][1][i] * sc); }
                u32x4 w; PG8_PACK8(w, v0, v1); *(u32x4*)rowp = w; }
    }
};
struct EpiMoeDown {
    static constexpr bool PERM = false, AFTER_DRAIN = false;
    float* YP; const float* gw;
    __device__ __forceinline__ void operator()(const f32x4 (&acc)[2][2][4][2], const Unit& u, int wr, int wc, int fr, int fq) const {
        const int row0 = u.pm * BM + wr * 64 + fr, col0 = u.pn * BM + wc * 32 + 4 * fq;
#pragma unroll
        for (int ai = 0; ai < 2; ++ai)
#pragma unroll
            for (int m = 0; m < 4; ++m) { const int row = row0 + ai * HALF + m * 16; const float s = gw[row]; const size_t ro = (size_t)row * 1024 + col0;
#pragma unroll
                for (int bj = 0; bj < 2; ++bj)
#pragma unroll
                    for (int n = 0; n < 2; ++n) *(f32x4*)(YP + ro + bj * HALF + n * 16) = acc[ai][bj][m][n] * s; }
    }
};

template <class Epi, class Sched, bool ALIGN_EPI = false, bool SP2 = false, bool F8 = false>
__device__ __forceinline__ void gemm_phase(PG8_LAS unsigned char* lds, const Gemm g, const Sched& S, const Epi& E, int wave) {
    const int lane = fresh_lane(), wid = wave, tid = wid * 64 + lane, wr = wid >> 2, wc = wid & 3, fr = lane & 15, fq = lane >> 4;
    const int K = g.K, nt = K / BK;
    unsigned voffA[2], voffB[2];
#pragma unroll
    for (int i = 0; i < 2; ++i) { int R, C; stage_rc(tid * 16 + i * 8192, R, C); const int Rb = Epi::PERM ? ((R & ~31) + perm32(R & 31)) : R;
        voffA[i] = (unsigned)(R * g.lda + C) * 2u; voffB[i] = (unsigned)(Rb * g.ldb + C) * 2u; }
    const size_t kstep = (size_t)(BK * 2);
    const size_t hsA = (size_t)HALF * g.lda * 2, hsB = (size_t)HALF * g.ldb * 2;
    const unsigned ldsw = (unsigned)wid * 1024u;
    const int aoff = lds_byte(wr * 64 + fr, fq * 8), boff = lds_byte(wc * 32 + fr, fq * 8);
#define PG8_SA(b, h) (((b) * 2 + (h)) * HTB)
#define PG8_SB(b, h) ((4 + (b) * 2 + (h)) * HTB)
#define PG8_STAGE(bufoff, gbase, voff) do { _Pragma("unroll") for (int _i = 0; _i < 2; ++_i) \
        __builtin_amdgcn_global_load_lds((const unsigned*)((const char*)(gbase) + (voff)[_i]), (PG8_LAS unsigned*)(lds + (bufoff) + ldsw + _i * 8192), 16, 0, 0); } while (0)
#define PG8_LDA(dst, b, h) do { _Pragma("unroll") for (int m = 0; m < 4; ++m) { const i32x4_ lo_ = *(const PG8_LAS i32x4_*)(lds + PG8_SA(b, h) + aoff + m * 2048), hi_ = *(const PG8_LAS i32x4_*)(lds + PG8_SA(b, h) + aoff + m * 2048 + 1024); \
        if constexpr (F8) dst##8[m] = __builtin_shufflevector(lo_, hi_, 0, 1, 2, 3, 4, 5, 6, 7); else { dst[m][0] = __builtin_bit_cast(bf16x8, lo_); dst[m][1] = __builtin_bit_cast(bf16x8, hi_); } } } while (0)
#define PG8_LDB(dst, b, h) do { _Pragma("unroll") for (int n = 0; n < 2; ++n) { const i32x4_ lo_ = *(const PG8_LAS i32x4_*)(lds + PG8_SB(b, h) + boff + n * 2048), hi_ = *(const PG8_LAS i32x4_*)(lds + PG8_SB(b, h) + boff + n * 2048 + 1024); \
        if constexpr (F8) dst##8[n] = __builtin_shufflevector(lo_, hi_, 0, 1, 2, 3, 4, 5, 6, 7); else { dst[n][0] = __builtin_bit_cast(bf16x8, lo_); dst[n][1] = __builtin_bit_cast(bf16x8, hi_); } } } while (0)
#define PG8_MMA(ai, bj, At, Bt) do { __builtin_amdgcn_s_setprio(1); _Pragma("unroll") for (int m = 0; m < 4; ++m) _Pragma("unroll") for (int n = 0; n < 2; ++n) { \
        if constexpr (F8) asm volatile("v_mfma_scale_f32_16x16x128_f8f6f4 %0, %1, %2, %0, %3, %3 op_sel_hi:[0,0,0]" : "+v"(acc[ai][bj][m][n]) : "v"(Bt##8[n]), "v"(At##8[m]), "v"(f8scale));   \
        else { _Pragma("unroll") for (int k = 0; k < 2; ++k) acc[ai][bj][m][n] = __builtin_amdgcn_mfma_f32_16x16x32_bf16(Bt[n][k], At[m][k], acc[ai][bj][m][n], 0, 0, 0); } } \
        __builtin_amdgcn_s_setprio(0); } while (0)
#define PG8_WAIT_V(n) asm volatile("s_waitcnt vmcnt(" #n ")" ::: "memory")
#define PG8_WAIT_L(n) asm volatile("s_waitcnt lgkmcnt(" #n ")" ::: "memory")
#define PG8_BAR __builtin_amdgcn_s_barrier()
#define PG8_SCHED __builtin_amdgcn_sched_barrier(0)
    Unit cur, nxt; int ui = 0;
    if (!S.next(0, cur)) return;
    f32x4 acc[2][2][4][2];
#pragma unroll
    for (int a = 0; a < 2; ++a)
#pragma unroll
        for (int b = 0; b < 2; ++b)
#pragma unroll
            for (int m = 0; m < 4; ++m)
#pragma unroll
                for (int n = 0; n < 2; ++n) acc[a][b][m][n] = (f32x4){0.f, 0.f, 0.f, 0.f};
    typedef int i32x4_ __attribute__((ext_vector_type(4))); typedef int i32x8_ __attribute__((ext_vector_type(8)));
    int f8scale = 0x7f7f7f7f; asm volatile("" : "+v"(f8scale));
    bf16x8 At[4][2], B0[2][2], B1[2][2]; i32x8_ At8[4], B08[2], B18[2];
    const char* cA = S.abase(cur); const char* cB = S.bbase(cur);
    S.a_ready(cur);
    if constexpr (SP2) {
        PG8_STAGE(PG8_SB(0, 0), cB, voffB); PG8_STAGE(PG8_SB(0, 1), cB + hsB, voffB); PG8_STAGE(PG8_SA(0, 0), cA, voffA); PG8_STAGE(PG8_SA(0, 1), cA + hsA, voffA);
        if (wr == 1) PG8_BAR;
        PG8_WAIT_V(2); PG8_BAR;
        PG8_STAGE(PG8_SB(1, 0), cB + kstep, voffB); PG8_STAGE(PG8_SA(1, 0), cA + kstep, voffA); PG8_STAGE(PG8_SB(1, 1), cB + hsB + kstep, voffB);
        PG8_WAIT_V(6); PG8_BAR;
    } else {
        PG8_STAGE(PG8_SB(0, 0), cB, voffB); PG8_STAGE(PG8_SA(0, 0), cA, voffA); PG8_STAGE(PG8_SB(0, 1), cB + hsB, voffB); PG8_STAGE(PG8_SA(0, 1), cA + hsA, voffA);
        if (wr == 1) PG8_BAR;
        PG8_WAIT_V(4); PG8_BAR;
        PG8_STAGE(PG8_SB(1, 0), cB + kstep, voffB); PG8_STAGE(PG8_SA(1, 0), cA + kstep, voffA); PG8_STAGE(PG8_SB(1, 1), cB + hsB + kstep, voffB);
        PG8_WAIT_V(6); PG8_BAR;
    }
    for (;;) {
        const bool has_next = S.next(ui + 1, nxt);
        const char* nA = has_next ? S.abase(nxt) : cA; const char* nB = has_next ? S.bbase(nxt) : cB;
#pragma nounroll
        for (int t = 0; t < nt; t += 2) {
            const bool last = (t == nt - 2);
            const char* a1 = cA + (size_t)(t + 1) * kstep;
            const char* a2 = last ? nA : cA + (size_t)(t + 2) * kstep; const char* b2 = last ? nB : cB + (size_t)(t + 2) * kstep;
            const char* a3 = a2 + kstep; const char* b3 = b2 + kstep;
            if (last && has_next) S.a_ready(nxt);
            if constexpr (SP2) {
            PG8_LDB(B0, 0, 0); PG8_LDB(B1, 0, 1); PG8_SCHED; PG8_LDA(At, 0, 0); PG8_STAGE(PG8_SA(1, 1), a1 + hsA, voffA);
            PG8_WAIT_V(8); PG8_WAIT_L(0); PG8_BAR; PG8_MMA(0, 0, At, B0); PG8_MMA(0, 1, At, B1); PG8_BAR; PG8_SCHED;
            PG8_LDA(At, 0, 1); PG8_STAGE(PG8_SB(0, 0), b2, voffB); PG8_STAGE(PG8_SB(0, 1), b2 + hsB, voffB); PG8_STAGE(PG8_SA(0, 0), a2, voffA);
            PG8_WAIT_V(8); PG8_WAIT_L(0); PG8_BAR; PG8_MMA(1, 0, At, B0); PG8_MMA(1, 1, At, B1); PG8_BAR; PG8_SCHED;
            PG8_LDB(B0, 1, 0); PG8_LDB(B1, 1, 1); PG8_SCHED; PG8_LDA(At, 1, 0); PG8_STAGE(PG8_SA(0, 1), a2 + hsA, voffA);
            PG8_WAIT_V(8); PG8_WAIT_L(0); PG8_BAR; PG8_MMA(0, 0, At, B0); PG8_MMA(0, 1, At, B1); PG8_BAR; PG8_SCHED;
            PG8_LDA(At, 1, 1); PG8_STAGE(PG8_SB(1, 0), b3, voffB); PG8_STAGE(PG8_SB(1, 1), b3 + hsB, voffB); PG8_STAGE(PG8_SA(1, 0), a3, voffA);
            PG8_WAIT_V(8); PG8_WAIT_L(0); PG8_BAR; PG8_MMA(1, 0, At, B0); PG8_MMA(1, 1, At, B1); PG8_BAR; PG8_SCHED;
            } else {
            PG8_LDB(B0, 0, 0); PG8_SCHED; PG8_LDA(At, 0, 0); PG8_STAGE(PG8_SA(1, 1), a1 + hsA, voffA);
            PG8_WAIT_L(8); PG8_BAR; PG8_WAIT_L(0); PG8_MMA(0, 0, At, B0); PG8_BAR; PG8_SCHED;
            PG8_LDB(B1, 0, 1); PG8_STAGE(PG8_SB(0, 0), b2, voffB);
            PG8_BAR; PG8_WAIT_L(0); PG8_MMA(0, 1, At, B1); PG8_BAR;
            PG8_LDA(At, 0, 1); PG8_STAGE(PG8_SA(0, 0), a2, voffA);
            PG8_BAR; PG8_WAIT_L(0); PG8_MMA(1, 0, At, B0); PG8_BAR; PG8_SCHED;
            PG8_STAGE(PG8_SB(0, 1), b2 + hsB, voffB);
            PG8_WAIT_V(6); PG8_BAR; PG8_MMA(1, 1, At, B1); PG8_BAR;
            PG8_LDB(B0, 1, 0); PG8_SCHED; PG8_LDA(At, 1, 0); PG8_STAGE(PG8_SA(0, 1), a2 + hsA, voffA);
            PG8_WAIT_L(8); PG8_BAR; PG8_WAIT_L(0); PG8_MMA(0, 0, At, B0); PG8_BAR; PG8_SCHED;
            PG8_LDB(B1, 1, 1); PG8_STAGE(PG8_SB(1, 0), b3, voffB);
            PG8_BAR; PG8_WAIT_L(0); PG8_MMA(0, 1, At, B1); PG8_BAR;
            PG8_LDA(At, 1, 1); PG8_STAGE(PG8_SA(1, 0), a3, voffA);
            PG8_BAR; PG8_WAIT_L(0); PG8_MMA(1, 0, At, B0); PG8_BAR; PG8_SCHED;
            PG8_STAGE(PG8_SB(1, 1), b3 + hsB, voffB);
            PG8_WAIT_V(6); PG8_BAR; PG8_MMA(1, 1, At, B1); PG8_BAR;
            }
        }
        if constexpr (ALIGN_EPI) { if (wr == 0) PG8_BAR; }
        if constexpr (!Epi::AFTER_DRAIN) { E(acc, cur, wr, wc, fr, fq); S.done(cur); }
        if (!has_next) break;
#pragma unroll
        for (int a = 0; a < 2; ++a)
#pragma unroll
            for (int b = 0; b < 2; ++b)
#pragma unroll
                for (int m = 0; m < 4; ++m)
#pragma unroll
                    for (int n = 0; n < 2; ++n) acc[a][b][m][n] = (f32x4){0.f, 0.f, 0.f, 0.f};
        cur = nxt; cA = nA; cB = nB; ++ui;
        if constexpr (ALIGN_EPI) { if (wr == 1) PG8_BAR; }
    }
    PG8_WAIT_V(0);
    if constexpr (!ALIGN_EPI) { if (wr == 0) PG8_BAR; }
    PG8_BAR;
    if constexpr (Epi::AFTER_DRAIN) { E.fused(acc, cur, wr, wc, fr, fq, lds, wid, lane); S.done(cur); }
#undef PG8_SA
#undef PG8_SB
#undef PG8_STAGE
#undef PG8_LDA
#undef PG8_LDB
#undef PG8_MMA
#undef PG8_WAIT_V
#undef PG8_WAIT_L
#undef PG8_BAR
#undef PG8_SCHED
}
}

#ifndef MOBA_MASK_ON
#define MOBA_MASK_ON 1
#endif
namespace attn_body {
using bf16=__hip_bfloat16;
using bf16x8=__attribute__((ext_vector_type(8)))short;
using s16x4=__attribute__((ext_vector_type(4)))short;
using f32x16=__attribute__((ext_vector_type(16)))float;
using u32x4=__attribute__((ext_vector_type(4)))unsigned;
constexpr int BATCH=2,NHEAD=16,SEQ=8192,D=64,DM=NHEAD*D;
constexpr int NW=8,QBLK=32,QB=QBLK*NW,KVBLK=64,NQB=SEQ/QB;
constexpr int ATTN_PITCH=DM, ATTN_UNIT_ROWS=QB;
__device__ __forceinline__ int crow(int r,int hi){return (r&3)+8*(r>>2)+4*hi;}
#define SBAR() __builtin_amdgcn_sched_barrier(0)
__device__ __forceinline__ void cmask(f32x16&p0,f32x16&p1,int jb,int qrel,int hi){
  const float NEG=-INFINITY; int d=qrel-(64*jb+4*hi); asm volatile("":"+v"(d));
  #pragma unroll
  for(int r=0;r<16;++r){const int c=(r&3)+8*(r>>2); if(c>d)p0[r]=NEG; if(c+32>d)p1[r]=NEG;}
}

constexpr int NSLOT=3, SLOTB=8192;
constexpr int LDS_K=0, LDS_V=NSLOT*SLOTB, LDS_WS=2*NSLOT*SLOTB, LDS_OST=LDS_WS+NW*64*4, LDS_BYTES=LDS_OST+NW*4096;
constexpr float C2=0.125f*1.4426950408889634f;
__device__ __forceinline__ void glds16(const void*gsrc,unsigned lds_dst){unsigned keep;
  asm volatile("s_mov_b32 %0, m0\n\ts_mov_b32 m0, %2\n\ts_nop 0\n\tglobal_load_lds_dwordx4 %1, off\n\ts_mov_b32 m0, %0":"=&s"(keep):"v"(gsrc),"s"(lds_dst):"memory");}
__device__ __forceinline__ float max3f(float a,float b,float c){float r;asm("v_max3_f32 %0, %1, %2, %3":"=v"(r):"v"(a),"v"(b),"v"(c));return r;}
__device__ __forceinline__ float max2f(float a,float b){float r;asm("v_max_f32_e32 %0, %1, %2":"=v"(r):"v"(a),"v"(b));return r;}
__device__ __forceinline__ float fadd_s(float a,float b){float r;asm("v_add_f32_e32 %0, %1, %2":"=v"(r):"v"(a),"v"(b));return r;}
__device__ __forceinline__ float fsub_s(float a,float b){float r;asm("v_sub_f32_e32 %0, %1, %2":"=v"(r):"v"(a),"v"(b));return r;}
typedef float f32x2_t __attribute__((ext_vector_type(2))); typedef __bf16 bf16x2_t __attribute__((ext_vector_type(2)));
__device__ __forceinline__ unsigned cvtpk_s(float lo,float hi){f32x2_t v={lo,hi};bf16x2_t b=__builtin_convertvector(v,bf16x2_t);return __builtin_bit_cast(unsigned,b);}
#define WAIT_BAR(N) asm volatile("s_waitcnt vmcnt(" #N ") lgkmcnt(0)\n\ts_barrier":::"memory")

__device__ __forceinline__ void qkt(f32x16&p0,f32x16&p1,const char*Kslot,const bf16x8*qr,int r32,int hi){
  const char*kb=Kslot+hi*1024+r32*16;
  #pragma unroll
  for(int d0=0;d0<4;++d0){
    const bf16x8 b0=*reinterpret_cast<const bf16x8*>(kb+d0*2048);
    const bf16x8 b1=*reinterpret_cast<const bf16x8*>(kb+d0*2048+512);
    if(d0==0){p0=__builtin_amdgcn_mfma_f32_32x32x16_bf16(b0,qr[0],f32x16{},0,0,0);p1=__builtin_amdgcn_mfma_f32_32x32x16_bf16(b1,qr[0],f32x16{},0,0,0);}
    else{p0=__builtin_amdgcn_mfma_f32_32x32x16_bf16(b0,qr[d0],p0,0,0,0);p1=__builtin_amdgcn_mfma_f32_32x32x16_bf16(b1,qr[d0],p1,0,0,0);}}
}
typedef __attribute__((address_space(3))) const char* lds_cptr;
typedef short v4i16_t __attribute__((ext_vector_type(4)));
__device__ __forceinline__ void kload8(bf16x8*kf,lds_cptr kp){
  kf[0]=*(const __attribute__((address_space(3))) bf16x8*)(kp);      kf[1]=*(const __attribute__((address_space(3))) bf16x8*)(kp+512);
  kf[2]=*(const __attribute__((address_space(3))) bf16x8*)(kp+2048); kf[3]=*(const __attribute__((address_space(3))) bf16x8*)(kp+2560);
  kf[4]=*(const __attribute__((address_space(3))) bf16x8*)(kp+4096); kf[5]=*(const __attribute__((address_space(3))) bf16x8*)(kp+4608);
  kf[6]=*(const __attribute__((address_space(3))) bf16x8*)(kp+6144); kf[7]=*(const __attribute__((address_space(3))) bf16x8*)(kp+6656);
}
__device__ __forceinline__ void kload2(bf16x8*kf,lds_cptr kp,int j){ kf[2*j]=*(const __attribute__((address_space(3))) bf16x8*)(kp+j*2048); kf[2*j+1]=*(const __attribute__((address_space(3))) bf16x8*)(kp+j*2048+512); }
__device__ __forceinline__ s16x4 vtr(lds_cptr p){ return __builtin_bit_cast(s16x4,__builtin_amdgcn_ds_read_tr16_b64_v4i16((__attribute__((address_space(3))) v4i16_t*)p)); }
__device__ __forceinline__ float rowmax(const f32x16&p0,const f32x16&p1){
  float a=max3f(p0[0],p0[1],p1[0]),b=max3f(p0[2],p0[3],p1[1]);a=max3f(a,p1[2],p1[3]);
  #pragma unroll
  for(int r=4;r<16;r+=4){a=max3f(a,p0[r],p0[r+1]);b=max3f(b,p0[r+2],p0[r+3]);a=max3f(a,p1[r],p1[r+1]);b=max3f(b,p1[r+2],p1[r+3]);}
  const float m=max2f(a,b);
  auto rr=__builtin_amdgcn_permlane32_swap(__float_as_uint(m),__float_as_uint(m),false,false);
  return max2f(__uint_as_float(rr[0]),__uint_as_float(rr[1]));
}
__device__ __forceinline__ void pv(f32x16*o,int vb,bf16x8 pa0,bf16x8 pa1,bf16x8 pa2,bf16x8 pa3){
  #pragma unroll
  for(int d0=0;d0<2;++d0){s16x4 lo[4],hi[4];
    #pragma unroll
    for(int ks=0;ks<4;++ks){
      asm volatile("ds_read_b64_tr_b16 %0,%1 offset:%c2":"=&v"(lo[ks]):"v"(vb),"i"(d0*4096+ks*1024):"memory");
      asm volatile("ds_read_b64_tr_b16 %0,%1 offset:%c2":"=&v"(hi[ks]):"v"(vb),"i"(d0*4096+ks*1024+512):"memory");}
    asm volatile("s_waitcnt lgkmcnt(0)":::"memory");SBAR();
    #define PK(k) (bf16x8){lo[k][0],lo[k][1],lo[k][2],lo[k][3],hi[k][0],hi[k][1],hi[k][2],hi[k][3]}
    o[d0]=__builtin_amdgcn_mfma_f32_32x32x16_bf16(pa0,PK(0),o[d0],0,0,0);
    o[d0]=__builtin_amdgcn_mfma_f32_32x32x16_bf16(pa1,PK(1),o[d0],0,0,0);
    o[d0]=__builtin_amdgcn_mfma_f32_32x32x16_bf16(pa2,PK(2),o[d0],0,0,0);
    o[d0]=__builtin_amdgcn_mfma_f32_32x32x16_bf16(pa3,PK(3),o[d0],0,0,0);
    #undef PK
  }
}

#ifndef ATTN_STORE16
#define ATTN_STORE16(p,v) (*(u32x4*)(p)=(v))
#endif
template<int THRL> __device__ __forceinline__ void attn_unit(int b,int h,int qb,const bf16*Q,const bf16*__restrict__ K,const bf16*__restrict__ V,bf16*O,const unsigned*__restrict__ SEL,char*shm,int wave){
  const int lane=fresh_lane(),wid=wave,tid=wid*64+lane,r32=lane&31,hi=lane>>5; (void)tid;
  const long rowbase=(long)b*SEQ; const int q0=qb*QB;
  const bf16*Qw=Q+(rowbase+q0+wid*QBLK)*DM+h*D;
  const bf16*Kh=K+rowbase*DM+h*D,*Vh=V+rowbase*DM+h*D;
  const unsigned lds0=(unsigned)(uintptr_t)shm;
  float*wsf=(float*)(shm+LDS_WS)+wid*64;
  const bf16*ksrc=Kh+(long)lane*DM+wid*8;
  const bf16*vsrc=Vh+(long)(16*(wid&3)+(lane>>2))*DM+(wid>>2)*32+(lane&3)*8;
  const unsigned kdst=lds0+LDS_K+wid*1024, vdst=lds0+LDS_V+wid*1024;
  #define DMA_K(t,slot) glds16(ksrc+(long)(t)*KVBLK*DM,(unsigned)__builtin_amdgcn_readfirstlane(kdst+(slot)))
  #define DMA_V(t,slot) glds16(vsrc+(long)(t)*KVBLK*DM,(unsigned)__builtin_amdgcn_readfirstlane(vdst+(slot)))
  const int vb0=(int)(lds0+LDS_V)+((lane>>4)&1)*32+(lane&3)*8+(4*hi+((lane&15)>>2))*64;
  const char*Kbase=shm+LDS_K; bf16x8 kf[8];
  const lds_cptr shm3=(lds_cptr)shm; const lds_cptr kp0=shm3+LDS_K+hi*1024+r32*16; const lds_cptr vp0=shm3+LDS_V+((lane>>4)&1)*32+(lane&3)*8+(4*hi+((lane&15)>>2))*64;
  const int NT=(q0+QB)/KVBLK;
  DMA_K(0,0);DMA_V(0,0);DMA_K(1,SLOTB);
  bf16x8 qr[4];
  #pragma unroll
  for(int d0=0;d0<4;++d0)qr[d0]=*reinterpret_cast<const bf16x8*>(&Qw[(long)r32*DM+d0*16+hi*8]);
  float mhat=0.f,l_reg=0.f;f32x16 o[2];o[0]=f32x16{};o[1]=f32x16{};
  const int qrel=wid*QBLK+r32;
  #define SELW() ((volatile __attribute__((address_space(3))) unsigned*)(lds_cptr)((const char*)wsf)+32+r32)
  if(hi==0)*SELW()=SEL[(rowbase+q0+qrel)*NHEAD+h];
  asm volatile("s_waitcnt vmcnt(0) lgkmcnt(0)":::"memory");
  #define CMASK(P0,P1,t) do{int jb_=(t)-(NT-4); if(jb_>=0)cmask(P0,P1,jb_,qrel,hi); else if(MOBA_MASK_ON && !(((*SELW())>>((t)>>2))&1u)){ _Pragma("unroll") for(int r_=0;r_<16;++r_){P0[r_]=-INFINITY;P1[r_]=-INFINITY;} } }while(0)
  bool resc=false;
  #define START(P0,P1) do{ const float rm=rowmax(P0,P1); resc=false; \
    { const float dl=max2f(rm,-100.f); mhat=fadd_s(mhat,dl); \
      _Pragma("unroll") for(int r=0;r<16;++r){P0[r]=fsub_s(P0[r],dl);P1[r]=fsub_s(P1[r],dl);} \
      } \
    _Pragma("unroll") for(int r=0;r<16;++r)P0[r]=__builtin_amdgcn_exp2f(P0[r]); }while(0)
  #define RESC() do{ if(resc){ asm volatile("s_waitcnt lgkmcnt(0)":::"memory"); \
      _Pragma("unroll") for(int d_=0;d_<2;++d_) _Pragma("unroll") for(int r=0;r<16;++r)o[d_][r]*=wsf[crow(r,hi)]; } }while(0)
  f32x16 pA0,pA1,pB0,pB1;
  int sl_prev=0,sl_cur=0,sl_next=SLOTB;
  #define ROT() do{sl_prev=sl_cur;sl_cur=sl_next;sl_next=(sl_next==(NSLOT-1)*SLOTB)?0:sl_next+SLOTB;}while(0)
  DMA_K(2,2*SLOTB);
  WAIT_BAR(3);
  qkt(pA0,pA1,Kbase,qr,r32,hi);asm volatile("s_nop 15\n\ts_nop 7":"+v"(pA0),"+v"(pA1));CMASK(pA0,pA1,0);
  START(pA0,pA1);
  _Pragma("unroll") for(int r=0;r<16;++r)pA1[r]=__builtin_amdgcn_exp2f(pA1[r]);
  WAIT_BAR(0);
  DMA_K(3,0);DMA_V(1,SLOTB);
  ROT();
  kload8(kf,kp0+sl_cur);
  WAIT_BAR(2);
  s16x4 vlo[8],vhi[8]; u32x4 pw0,pw1,pw2,pw3;
  #define PKW(P,B) cvtpk_s(P[B],P[B+1])
  #define PAF(k) __builtin_bit_cast(bf16x8,pw##k)
  #define VFR(i) (bf16x8){vlo[i][0],vlo[i][1],vlo[i][2],vlo[i][3],vhi[i][0],vhi[i][1],vhi[i][2],vhi[i][3]}
  #define PIN(x) asm volatile("":"+v"(x))
  #define MX3(a,b,c) __builtin_fmaxf(__builtin_fmaxf((a),(b)),(c))
  #define GAPA(MF,A0,A1,A2,A3,W0,W1,PW) do{ MF; sacc+=A0; sacc+=A1; sacc+=A2; sacc+=A3; PIN(sacc); W0; W1; PIN(PW); SBAR(); }while(0)
  #define EX(v) __builtin_amdgcn_exp2f(v)
  #define GAPB(MF,X,B) do{ MF; X[B]=EX(X[B]); X[B+1]=EX(X[B+1]); X[B+2]=EX(X[B+2]); X[B+3]=EX(X[B+3]); PIN(X); SBAR(); }while(0)
  #define VRD(i) do{ vlo[i]=vtr(vp_+(((i)>>2)*4096+((i)&3)*1024)); vhi[i]=vtr(vp_+(((i)>>2)*4096+((i)&3)*1024+512)); }while(0)
  #define KRD(G,j) do{ if(G){ kload2(kf,kp0+sl_next,j); SBAR(); } }while(0)
  #define STEP(C0,C1,P0,P1,t,GK,GV,GL) do{ SBAR(); \
    const lds_cptr vp_=vp0+sl_prev; \
    VRD(0); SBAR(); float sacc=(P0[0]+P0[1]); \
    GAPA(C0=__builtin_amdgcn_mfma_f32_32x32x16_bf16(kf[0],qr[0],f32x16{},0,0,0), P0[2],P0[3],P0[4],P0[5],     pw0[0]=PKW(P0,0), pw0[1]=PKW(P0,2), pw0); \
    VRD(4); SBAR(); GAPA(C1=__builtin_amdgcn_mfma_f32_32x32x16_bf16(kf[1],qr[0],f32x16{},0,0,0), P0[6],P0[7],P0[8],P0[9],     pw0[2]=PKW(P0,4), pw0[3]=PKW(P0,6), pw0); \
    VRD(1); SBAR(); GAPA(C0=__builtin_amdgcn_mfma_f32_32x32x16_bf16(kf[2],qr[1],C0,0,0,0),   P0[10],P0[11],P0[12],P0[13], pw1[0]=PKW(P0,8), pw1[1]=PKW(P0,10), pw1); \
    VRD(5); SBAR(); GAPA(C1=__builtin_amdgcn_mfma_f32_32x32x16_bf16(kf[3],qr[1],C1,0,0,0),   P0[14],P0[15],P1[0],P1[1],   pw1[2]=PKW(P0,12),pw1[3]=PKW(P0,14), pw1); \
    VRD(2); SBAR(); GAPA(C0=__builtin_amdgcn_mfma_f32_32x32x16_bf16(kf[4],qr[2],C0,0,0,0),   P1[2],P1[3],P1[4],P1[5],     pw2[0]=PKW(P1,0), pw2[1]=PKW(P1,2), pw2); \
    VRD(6); SBAR(); GAPA(C1=__builtin_amdgcn_mfma_f32_32x32x16_bf16(kf[5],qr[2],C1,0,0,0),   P1[6],P1[7],P1[8],P1[9],     pw2[2]=PKW(P1,4), pw2[3]=PKW(P1,6), pw2); \
    VRD(3); SBAR(); GAPA(C0=__builtin_amdgcn_mfma_f32_32x32x16_bf16(kf[6],qr[3],C0,0,0,0),   P1[10],P1[11],P1[12],P1[13], pw3[0]=PKW(P1,8), pw3[1]=PKW(P1,10), pw3); \
    VRD(7); SBAR(); GAPA(C1=__builtin_amdgcn_mfma_f32_32x32x16_bf16(kf[7],qr[3],C1,0,0,0),   P1[14],P1[15],0.f,0.f,       pw3[2]=PKW(P1,12),pw3[3]=PKW(P1,14), pw3); \
    l_reg+=sacc; \
    if(GK){DMA_K((t)+3,sl_cur);} if(GV){DMA_V((t)+1,sl_next);} \
    _Pragma("unroll") for(int r=0;r<16;++r){C0[r]-=mhat;C1[r]-=mhat;} \
    CMASK(C0,C1,t); \
    { float a=MX3(C0[0],C0[1],C1[0]),b=MX3(C0[2],C0[3],C1[1]); a=MX3(a,C1[2],C1[3]); \
      _Pragma("unroll") for(int r=4;r<16;r+=4){a=MX3(a,C0[r],C0[r+1]);b=MX3(b,C0[r+2],C0[r+3]);a=MX3(a,C1[r],C1[r+1]);b=MX3(b,C1[r+2],C1[r+3]);} \
      float rm=__builtin_fmaxf(a,b); { auto rr=__builtin_amdgcn_permlane32_swap(__float_as_uint(rm),__float_as_uint(rm),false,false); rm=__builtin_fmaxf(__uint_as_float(rr[0]),__uint_as_float(rr[1])); } \
      resc=false; \
      if(__builtin_expect(__any(rm>(float)THRL),0)){ const float dl=__builtin_fmaxf(rm,0.f); mhat+=dl; \
        _Pragma("unroll") for(int r=0;r<16;++r){C0[r]-=dl;C1[r]-=dl;} \
        const float f=__builtin_amdgcn_exp2f(-dl); l_reg*=f; if(hi==0)wsf[r32]=f; resc=true; } } \
    SBAR(); \
    GAPB(o[0]=__builtin_amdgcn_mfma_f32_32x32x16_bf16(PAF(0),VFR(0),o[0],0,0,0), C0,0); \
    GAPB(o[1]=__builtin_amdgcn_mfma_f32_32x32x16_bf16(PAF(0),VFR(4),o[1],0,0,0), C0,4); \
    KRD(GL,0); GAPB(o[0]=__builtin_amdgcn_mfma_f32_32x32x16_bf16(PAF(1),VFR(1),o[0],0,0,0), C0,8); \
    KRD(GL,1); GAPB(o[1]=__builtin_amdgcn_mfma_f32_32x32x16_bf16(PAF(1),VFR(5),o[1],0,0,0), C0,12); \
    KRD(GL,2); GAPB(o[0]=__builtin_amdgcn_mfma_f32_32x32x16_bf16(PAF(2),VFR(2),o[0],0,0,0), C1,0); \
    KRD(GL,3); GAPB(o[1]=__builtin_amdgcn_mfma_f32_32x32x16_bf16(PAF(2),VFR(6),o[1],0,0,0), C1,4); \
    GAPB(o[0]=__builtin_amdgcn_mfma_f32_32x32x16_bf16(PAF(3),VFR(3),o[0],0,0,0), C1,8); \
    GAPB(o[1]=__builtin_amdgcn_mfma_f32_32x32x16_bf16(PAF(3),VFR(7),o[1],0,0,0), C1,12); \
    }while(0)
  int t=1;
  for(;t+5<NT;t+=2){
    STEP(pB0,pB1,pA0,pA1,t,true,true,true);     WAIT_BAR(2); RESC(); ROT();
    STEP(pA0,pA1,pB0,pB1,t+1,true,true,true);   WAIT_BAR(2); RESC(); ROT();
  }
  #undef CMASK
  #define CMASK(P0,P1,t) do{int jb_=(t)-(NT-4); if(jb_>=0)cmask(P0,P1,jb_,qrel,hi); else if(MOBA_MASK_ON && !(((*SELW())>>((t)>>2))&1u)){ _Pragma("unroll") for(int r_=0;r_<16;++r_){P0[r_]=-INFINITY;P1[r_]=-INFINITY;} } }while(0)
  #define ENDW(tt) do{ if((tt)+3<NT){WAIT_BAR(2);} else if((tt)+2<NT){WAIT_BAR(1);} else {WAIT_BAR(0);} }while(0)
  for(;t+1<NT;t+=2){
    STEP(pB0,pB1,pA0,pA1,t,(t+3<NT),(t+1<NT),(t+1<NT));       ENDW(t);   RESC(); ROT();
    STEP(pA0,pA1,pB0,pB1,t+1,(t+4<NT),(t+2<NT),(t+2<NT));     ENDW(t+1); RESC(); ROT();
  }
  STEP(pB0,pB1,pA0,pA1,NT-1,false,false,false); RESC();
  { float sacc=pB0[0]+pB0[1]; _Pragma("unroll") for(int r=2;r<16;++r)sacc+=pB0[r]; _Pragma("unroll") for(int r=0;r<16;++r)sacc+=pB1[r]; l_reg+=sacc;
    pw0=(u32x4){PKW(pB0,0),PKW(pB0,2),PKW(pB0,4),PKW(pB0,6)};pw1=(u32x4){PKW(pB0,8),PKW(pB0,10),PKW(pB0,12),PKW(pB0,14)};pw2=(u32x4){PKW(pB1,0),PKW(pB1,2),PKW(pB1,4),PKW(pB1,6)};pw3=(u32x4){PKW(pB1,8),PKW(pB1,10),PKW(pB1,12),PKW(pB1,14)};
    SBAR(); pv(o,vb0+sl_cur,PAF(0),PAF(1),PAF(2),PAF(3)); }
  #undef PKW
  #undef PAF
  #undef VFR
  #undef PIN
  #undef MX3
  #undef GAPA
  #undef GAPB
  #undef EX
  #undef VRD
  #undef KRD
  #undef STEP
  #undef ENDW
  {auto rr=__builtin_amdgcn_permlane32_swap(__float_as_uint(l_reg),__float_as_uint(l_reg),false,false);l_reg=__uint_as_float(rr[0])+__uint_as_float(rr[1]);}
  if(hi==0)wsf[32+r32]=l_reg;asm volatile("s_waitcnt lgkmcnt(0)":::"memory");
  float rli[16];
  #pragma unroll
  for(int r=0;r<16;++r)rli[r]=__builtin_amdgcn_rcpf(wsf[32+crow(r,hi)]);
  bf16*Ow=O+(rowbase+q0+wid*QBLK)*DM+h*D;
  { bf16*stg=(bf16*)(shm+LDS_OST)+wid*2048;
    #pragma unroll
    for(int r=0;r<16;++r){const int orow=crow(r,hi);
      #pragma unroll
      for(int d0=0;d0<2;++d0)stg[orow*64+d0*32+r32]=__float2bfloat16(o[d0][r]*rli[r]);}
    asm volatile("s_waitcnt lgkmcnt(0)":::"memory");
    #pragma unroll
    for(int i=0;i<4;++i){const int row=i*8+(lane>>3),ch=lane&7; const u32x4 v=*(const u32x4*)(stg+row*64+ch*8); ATTN_STORE16(Ow+(long)row*DM+ch*8,v);} }
  asm volatile("s_waitcnt lgkmcnt(0)\n\ts_barrier":::"memory");
  #undef SELW
  #undef DMA_K
  #undef DMA_V
  #undef CMASK
  #undef START
  #undef RESC
  #undef ROT
}
constexpr int ATTN_LDS_BYTES=LDS_BYTES;
struct AttnTensors { const bf16* Q; const bf16* K; const bf16* V; bf16* O; const unsigned* SEL; };
struct AttnUnit { int bh; int qb; };
struct StaticOrder {
  int vcu;
  __device__ __forceinline__ explicit StaticOrder(int grid,int block):vcu((block%8)*(grid/8)+block/8){}
  __device__ __forceinline__ bool next(int i,AttnUnit&u)const{ if(i>=4)return false; const int s=vcu&7; u.bh=vcu>>3; u.qb=(i==0)?s:(i==1)?15-s:(i==2)?16+s:31-s; return true; }
  __device__ __forceinline__ void a_ready(const AttnUnit&)const{}
  __device__ __forceinline__ void done(const AttnUnit&)const{}
};
template<class Sched,int THRL=8> __device__ __forceinline__ void attn_phase(char*lds,const AttnTensors&T,const Sched&S,int wave){
  AttnUnit u;
  for(int i=0;S.next(i,u);++i){ S.a_ready(u); attn_unit<THRL>(u.bh/NHEAD,u.bh%NHEAD,u.qb,T.Q,T.K,T.V,T.O,T.SEL,lds,wave); S.done(u); }
}
#undef SBAR
#undef WAIT_BAR
}

constexpr int NWAVES = 8;
constexpr int BATCH = 2, T = 8192, D = 1024, H = 16, HD = 64, M = BATCH * T;
constexpr int FF = 2816, FFE = 3584, NE = 8, MOE_ROWS = 34816  ;
constexpr float MOE_WSCALE = 64.f;
constexpr float LN_EPS = 1e-5f, GN_EPS = 64e-5f, ALPHA = 1.6817928305074292f  ;
constexpr size_t MiB = 1u << 20;
constexpr size_t WS_CTL = 0, CTL_ZERO_BYTES = 1 * MiB;
constexpr size_t WS_KMEAN = 1 * MiB;
constexpr size_t WS_SEL = 2 * MiB;
constexpr size_t WS_TOKE = 3 * MiB;
constexpr size_t WS_TOKW = WS_TOKE + 128 * 1024;
constexpr size_t WS_TOKR = WS_TOKW + 128 * 1024;
constexpr size_t WS_GW = WS_TOKR + 128 * 1024;
constexpr size_t WS_BLKCNT = WS_GW + 256 * 1024;
constexpr size_t WS_WMIX = 16 * MiB;
constexpr size_t WS_WFFN = 32 * MiB;
constexpr size_t WS_H = 200 * MiB;
constexpr size_t WS_HB = 264 * MiB;
constexpr size_t WS_K = 296 * MiB, WS_V = 328 * MiB;
constexpr size_t WS_VFIRST = WS_K;
constexpr size_t WS_Y = WS_V;
constexpr size_t WS_SCR = 360 * MiB;
constexpr size_t WS_END = 896 * MiB;
constexpr size_t RS_XM = WS_SCR;
constexpr size_t RS_KP = WS_SCR, RS_AP = WS_SCR + 32 * MiB, RS_VP = WS_SCR + 64 * MiB, RS_BP = WS_SCR + 96 * MiB;
constexpr size_t RS_RKV = WS_SCR + 192 * MiB;
constexpr size_t RS_PRE = RS_RKV;
constexpr size_t RS_LH = WS_SCR + 288 * MiB;
constexpr size_t RS_YG = RS_LH;
constexpr size_t RS_DEC = WS_SCR + 320 * MiB;
constexpr size_t RS_AB = WS_SCR + 384 * MiB;
constexpr size_t RS_VG = WS_SCR + 448 * MiB;
constexpr size_t RS_GG = WS_SCR + 480 * MiB;
constexpr size_t BS_Q = WS_SCR, BS_PRE = WS_SCR + 32 * MiB, BS_O = WS_SCR + 96 * MiB;
constexpr size_t BS_PO = WS_SCR + 128 * MiB, BS_ML = WS_SCR + 256 * MiB;
constexpr size_t FS_HID = WS_SCR, FS_PRE = WS_SCR + 88 * MiB;
constexpr size_t ES_XG = WS_SCR, ES_HID = WS_SCR + 68 * MiB, ES_YP = WS_SCR + 306 * MiB;
static_assert(RS_GG + 32 * MiB <= WS_END && ES_YP + 136 * MiB <= WS_END && FS_PRE + 64 * MiB <= WS_END, "d_ws map");
constexpr size_t RW_LSTRIDE = 872 * MiB - WS_WMIX;
constexpr size_t WM_BT1 = WS_WMIX, WM_BT2 = WS_WMIX + 8 * MiB, WM_OUT = WS_WMIX + 10 * MiB;
constexpr size_t WM_QKV = WS_WMIX, WM_O = WS_WMIX + 8 * MiB;
constexpr size_t WF_GU = WS_WFFN, WF_DN = WS_WFFN + 12 * MiB;
constexpr size_t WE_GU = WS_WFFN, WE_DN = WS_WFFN + 112 * MiB;
constexpr int CW_TMO = 0, CW_CODE = 1, CW_QCTR = 2048  , CW_BAR = 4096;
constexpr int RING_OFF = 0, RING_BYTES = 131072;
constexpr int LDSCTL_OFF = RING_BYTES, MISC_OFF = LDSCTL_OFF + 320;
constexpr int LDS_BYTES = 147456;
static_assert(MISC_OFF + 128 <= LDS_BYTES, "LDS map");

#define GAS __attribute__((address_space(1)))
#define LAS __attribute__((address_space(3)))
typedef unsigned short bf16;
typedef unsigned v4u __attribute__((ext_vector_type(4)));
typedef float f32x4 __attribute__((ext_vector_type(4)));
typedef short bf16x8 __attribute__((ext_vector_type(8)));
typedef GAS unsigned gu32;
typedef GAS unsigned long long gu64;
#define RLX_AGENT __ATOMIC_RELAXED, __HIP_MEMORY_SCOPE_AGENT
#define LDS_WAIT() asm volatile("s_waitcnt lgkmcnt(0)" ::: "memory")
#define VM_WAIT() asm volatile("s_waitcnt vmcnt(0)" ::: "memory")
__device__ __forceinline__ unsigned long long rt() { return __builtin_amdgcn_s_memrealtime(); }
__device__ __forceinline__ unsigned f2bf(float f) { unsigned u = __builtin_bit_cast(unsigned, f); return (u + 0x7fffu + ((u >> 16) & 1u)) >> 16; }
__device__ __forceinline__ unsigned pk2(float lo, float hi) { return f2bf(lo) | (f2bf(hi) << 16); }

#define XB_TMO      128
#define XB_XCNT(j)  (256  + 64 * (j))
#define XB_XSUB(j)  (1280 + 64 * (j))
#define XB_XGEN(j)  (2304 + 64 * (j))
#define XB_TOP      3328
#define XB_TOPGEN   3392
#define XCD_BAR_WORDS 3456
#define XB_SPIN_CAP (1u << 18)

__device__ __forceinline__ unsigned xb_ld(unsigned* p)              { return __hip_atomic_load(p, __ATOMIC_RELAXED, __HIP_MEMORY_SCOPE_AGENT); }
__device__ __forceinline__ unsigned xb_add(unsigned* p, unsigned v) { return __hip_atomic_fetch_add(p, v, __ATOMIC_RELAXED, __HIP_MEMORY_SCOPE_AGENT); }
__device__ __forceinline__ unsigned xb_xcc_id() { return (unsigned)__builtin_amdgcn_s_getreg((3 << 11) | 20) & 0xFu; }
#define XB_SPIN(cond, bar) do { unsigned _sp = 0; while (cond) { __builtin_amdgcn_s_sleep(1); \
    if ((++_sp & 255u) == 0u) { if (xb_ld(&(bar)[XB_TMO])) break; if (_sp > XB_SPIN_CAP) { atomicAdd(&(bar)[XB_TMO], 1u); break; } } } } while (0)

struct XcdBarrier {
    unsigned* bar; unsigned x;
    volatile LAS unsigned* st;
};

__device__ __forceinline__ XcdBarrier xcd_barrier_post(unsigned* bar, volatile LAS unsigned* st, bool t0  ) {
    XcdBarrier b; b.bar = bar; b.x = xb_xcc_id(); b.st = st;
    if (t0) (void)xb_add(&bar[XB_XCNT(b.x)], 1u);
    return b;
}
__device__ __forceinline__ void xcd_barrier_complete(unsigned* bar, unsigned x, unsigned& nloc, unsigned& nx) {
    const unsigned G = gridDim.x * gridDim.y * gridDim.z;
    unsigned sum, cnt, mine, sp = 0u;
    for (;;) {
        sum = 0u; cnt = 0u; mine = 0u;
#pragma unroll
        for (unsigned j = 0; j < 16; ++j) { const unsigned c = xb_ld(&bar[XB_XCNT(j)]); sum += c; cnt += (c > 0u) ? 1u : 0u; mine = (j == x) ? c : mine; }
        if (sum == G) break;
        __builtin_amdgcn_s_sleep(1);
        if ((++sp & 255u) == 0u) { if (xb_ld(&bar[XB_TMO])) break; if (sp > XB_SPIN_CAP) { atomicAdd(&bar[XB_TMO], 1u); break; } }
    }
    nloc = mine > 0u ? mine : 1u; nx = cnt > 0u ? cnt : 1u;
}

__device__ __forceinline__ void xcd_barrier(const XcdBarrier& b, bool t0  ) {
    asm volatile("s_waitcnt vmcnt(0)" ::: "memory");
    __syncthreads();
    if (t0) {
        unsigned* bar = b.bar;
        __builtin_amdgcn_s_waitcnt(0);
        unsigned nloc = b.st[0], nx = b.st[1];
        if (nloc == 0u) { xcd_barrier_complete(bar, b.x, nloc, nx); b.st[0] = nloc; b.st[1] = nx; }
        const unsigned old = xb_add(&bar[XB_XSUB(b.x)], 1u);
        const unsigned gen = old / nloc;
        if (old + 1u == (gen + 1u) * nloc) {
            __builtin_amdgcn_fence(__ATOMIC_RELEASE, "agent");
            asm volatile("s_waitcnt vmcnt(0)" ::: "memory");
            const unsigned og = xb_add(&bar[XB_TOP], 1u);
            const unsigned tg = og / nx;
            if (og + 1u == (tg + 1u) * nx) xb_add(&bar[XB_TOPGEN], 1u);
            else XB_SPIN(xb_ld(&bar[XB_TOPGEN]) == tg, bar);
#ifdef XB_L2_INV
            __builtin_amdgcn_fence(__ATOMIC_ACQUIRE, "");
#else
            __builtin_amdgcn_fence(__ATOMIC_ACQUIRE, "agent");
#endif
            xb_add(&bar[XB_XGEN(b.x)], 1u);
            asm volatile("s_waitcnt vmcnt(0)" ::: "memory");
        } else {
            XB_SPIN(xb_ld(&bar[XB_XGEN(b.x)]) == gen, bar);
            __builtin_amdgcn_fence(__ATOMIC_ACQUIRE, "agent");
            asm volatile("s_waitcnt vmcnt(0)" ::: "memory");
        }
    }
    __syncthreads();
}

struct Args { const float* in[33]; float* out; unsigned char* ws; };
enum InIdx { I_X = 0, I_MU, I_WRKV, I_WOUT, I_W0, I_W1, I_W2, I_A0, I_A1, I_A2, I_V0, I_V1, I_V2, I_G1, I_G2, I_KK, I_KA, I_RK, I_GNG, I_GNB,
             I_MK, I_MV, I_MQ, I_MO, I_FG, I_FU, I_FD, I_ROUTER, I_EG, I_EU, I_ED, I_LNG, I_LNB };
struct Frame {
    LAS unsigned char* lds; volatile LAS unsigned* MISC; gu32* ctl; unsigned char* ws;
    int tid, lane, wave, vcu, G, gw, NGW;
};
typedef float f32x2 __attribute__((ext_vector_type(2)));
typedef unsigned u32x2 __attribute__((ext_vector_type(2)));
__device__ __forceinline__ float dpp_sum16(float v) {
    v += __builtin_bit_cast(float, __builtin_amdgcn_update_dpp(0, __builtin_bit_cast(int, v), 0xB1, 0xF, 0xF, true));
    v += __builtin_bit_cast(float, __builtin_amdgcn_update_dpp(0, __builtin_bit_cast(int, v), 0x4E, 0xF, 0xF, true));
    v += __builtin_bit_cast(float, __builtin_amdgcn_update_dpp(0, __builtin_bit_cast(int, v), 0x141, 0xF, 0xF, true));
    v += __builtin_bit_cast(float, __builtin_amdgcn_update_dpp(0, __builtin_bit_cast(int, v), 0x140, 0xF, 0xF, true));
    return v;
}
__device__ __forceinline__ float wave_sum(float v, int lane) {
    v = dpp_sum16(v);
    v += __builtin_bit_cast(float, __builtin_amdgcn_ds_bpermute((lane ^ 16) << 2, __builtin_bit_cast(int, v)));
    v += __builtin_bit_cast(float, __builtin_amdgcn_ds_bpermute((lane ^ 32) << 2, __builtin_bit_cast(int, v)));
    return v;
}
__device__ __forceinline__ float sum16(float v) { return dpp_sum16(v); }
__device__ __forceinline__ float bf2f(unsigned short b) { return __uint_as_float((unsigned)b << 16); }
__device__ __forceinline__ f32x4 bf4_to_f32(u32x2 w) { f32x4 r; r.x = __uint_as_float(w.x << 16); r.y = __uint_as_float(w.x & 0xffff0000u); r.z = __uint_as_float(w.y << 16); r.w = __uint_as_float(w.y & 0xffff0000u); return r; }
__device__ __forceinline__ u32x2 f32_to_bf4(f32x4 v) { u32x2 w; w.x = pk2(v.x, v.y); w.y = pk2(v.z, v.w); return w; }

__device__ __forceinline__ void tr_item(const float* W, int ldw, int Kr, int Nr, int nblk, bf16* WT, int ldt, int row0, int mode, LAS float* scr, int item, int lane) {
    const int kb = item / nblk, nb = item - kb * nblk, k0 = 64 * kb, n0 = 32 * nb;
    const int kg = lane >> 3, n = n0 + 4 * (lane & 7), kk = k0 + 8 * kg;
    f32x4 v[8];
#pragma unroll
    for (int i = 0; i < 8; ++i) { v[i] = (f32x4){0.f, 0.f, 0.f, 0.f}; if (kk + i < Kr && n < Nr) v[i] = *(const f32x4*)(W + (size_t)(kk + i) * ldw + n); }
#pragma unroll
    for (int e = 0; e < 4; ++e) { const int nn = n + e; const int drow = mode == 0 ? row0 + nn : row0 + ((nn >> 7) << 8) + (nn & 127);
        v4u o; o.x = pk2(v[0][e], v[1][e]); o.y = pk2(v[2][e], v[3][e]); o.z = pk2(v[4][e], v[5][e]); o.w = pk2(v[6][e], v[7][e]);
        *(GAS v4u*)(WT + (size_t)drow * ldt + kk) = o; }
}
__device__ __forceinline__ void tr_item8(const float* W, int ldw, int Kr, int Nr, int nblk, unsigned char* WT, int ldt, int row0, int mode, float scale, int item, int lane) {
    const int kb = item / nblk, nb = item - kb * nblk, k0 = 64 * kb, n0 = 32 * nb;
    const int kg = lane >> 3, n = n0 + 4 * (lane & 7), kk = k0 + 8 * kg;
    f32x4 v[8];
#pragma unroll
    for (int i = 0; i < 8; ++i) { v[i] = (f32x4){0.f, 0.f, 0.f, 0.f}; if (kk + i < Kr && n < Nr) v[i] = *(const f32x4*)(W + (size_t)(kk + i) * ldw + n) * scale; }
#pragma unroll
    for (int e = 0; e < 4; ++e) { const int nn = n + e; const int drow = mode == 0 ? row0 + nn : row0 + ((nn >> 7) << 8) + (nn & 127);
        int lo = __builtin_amdgcn_cvt_pk_fp8_f32(v[0][e], v[1][e], 0, false); lo = __builtin_amdgcn_cvt_pk_fp8_f32(v[2][e], v[3][e], lo, true);
        int hi = __builtin_amdgcn_cvt_pk_fp8_f32(v[4][e], v[5][e], 0, false); hi = __builtin_amdgcn_cvt_pk_fp8_f32(v[6][e], v[7][e], hi, true);
        u32x2 o; o.x = (unsigned)lo; o.y = (unsigned)hi; *(GAS u32x2*)(WT + (size_t)drow * ldt + kk) = o; }
}
#define KIN(i) ({ const __attribute__((address_space(4))) char* k_ = (const __attribute__((address_space(4))) char*)__builtin_amdgcn_kernarg_segment_ptr(); asm volatile("" : "+s"(k_)); const GAS float* g_ = (const GAS float*)(*(const float* const __attribute__((address_space(4)))*)(k_ + 8 * (i))); asm volatile("" : "+s"(g_)); (const float*)g_; })
#define CONV_BEGIN() F.lane = fresh_lane(); F.tid = F.wave * 64 + F.lane; asm volatile("" : "+s"(F.G), "+s"(F.wave), "+s"(F.vcu), "+s"(F.gw), "+s"(F.NGW)); GAS unsigned char* cws0_ = (GAS unsigned char*)F.ws; asm volatile("" : "+s"(cws0_)); unsigned char* cws_ = (unsigned char*)cws0_; LAS float* scr_ = (LAS float*)(F.lds + RING_OFF + F.wave * 16384); int it_ = F.gw, base_ = 0
#define JOB(W, ldw, Kr, Nr, Kp, Np, WT, ldt, row0, mode) do { const int nblk_ = (Np) / 32, n_ = ((Kp) / 64) * nblk_; \
    while (it_ < base_ + n_) { tr_item((W), (ldw), (Kr), (Nr), nblk_, (WT), (ldt), (row0), (mode), scr_, it_ - base_, F.lane); it_ += F.NGW; } base_ += n_; } while (0)
#define JOB8(W, ldw, Kr, Nr, Kp, Np, WT, ldt, row0, mode, scale) do { const int nblk_ = (Np) / 32, n_ = ((Kp) / 64) * nblk_; \
    while (it_ < base_ + n_) { tr_item8((W), (ldw), (Kr), (Nr), nblk_, (WT), (ldt), (row0), (mode), (scale), it_ - base_, F.lane); it_ += F.NGW; } base_ += n_; } while (0)

__device__ __forceinline__ void conv_rwkv(Frame& F, int l) {
    CONV_BEGIN();
    cws_ += (size_t)l * RW_LSTRIDE; bf16* BT1 = (bf16*)(cws_ + WM_BT1); bf16* BT2 = (bf16*)(cws_ + WM_BT2); bf16* WO = (bf16*)(cws_ + WM_OUT);
    for (int c = 0; c < 3; ++c) JOB(KIN(I_WRKV) + (size_t)(l * 3 + c) * D * D, D, D, D, D, D, BT1, D, c * D, 0);
    JOB(KIN(I_W1) + (size_t)l * D * 64, 64, D, 64, D, 256, BT1, D, 3072, 0);
    JOB(KIN(I_A1) + (size_t)l * D * 64, 64, D, 64, D, 256, BT1, D, 3328, 0);
    JOB(KIN(I_V1), 32, D, (l == 0 ? 0 : 32), D, 256, BT1, D, 3584, 0);
    JOB(KIN(I_G1) + (size_t)l * D * 160, 160, D, 160, D, 256, BT1, D, 3840, 0);
    JOB(KIN(I_W2) + (size_t)l * 64 * D, D, 64, D, 256, D, BT2, 256, 0, 0);
    JOB(KIN(I_A2) + (size_t)l * 64 * D, D, 64, D, 256, D, BT2, 256, 1024, 0);
    JOB(KIN(I_V2), D, (l == 0 ? 0 : 32), D, 256, D, BT2, 256, 2048, 0);
    JOB(KIN(I_G2) + (size_t)l * 160 * D, D, 160, D, 256, D, BT2, 256, 3072, 0);
    JOB(KIN(I_WOUT) + (size_t)l * D * D, D, D, D, D, D, WO, D, 0, 0);
}
__device__ __forceinline__ void conv_moba(Frame& F, int j) {
    CONV_BEGIN();
    bf16* WQ = (bf16*)(cws_ + WM_QKV); bf16* WO = (bf16*)(cws_ + WM_O);
    JOB(KIN(I_MQ) + (size_t)j * D * D, D, D, D, D, D, WQ, D, 0, 0);
    if (j == 0) { JOB(KIN(I_MK), D, D, D, D, D, WQ, D, D, 0); JOB(KIN(I_MV), D, D, D, D, D, WQ, D, 2 * D, 0); }
    JOB(KIN(I_MO) + (size_t)j * D * D, D, D, D, D, D, WO, D, 0, 0);
}
__device__ __forceinline__ void conv_dense(Frame& F, int e) {
    CONV_BEGIN();
    bf16* GU = (bf16*)(cws_ + WF_GU); bf16* DN = (bf16*)(cws_ + WF_DN);
    JOB(KIN(I_FG) + (size_t)e * D * FF, FF, D, FF, D, FF, GU, D, 0, 1);
    JOB(KIN(I_FU) + (size_t)e * D * FF, FF, D, FF, D, FF, GU, D, 128, 1);
    JOB(KIN(I_FD) + (size_t)e * FF * D, D, FF, D, FF, D, DN, FF, 0, 0);
}
__device__ __forceinline__ void conv_moe(Frame& F, int e) {
    CONV_BEGIN();
    bf16* GU = (bf16*)(cws_ + WE_GU); bf16* DN = (bf16*)(cws_ + WE_DN);
    for (int x = 0; x < NE; ++x) {
        JOB8(KIN(I_EG) + (size_t)(e * NE + x) * D * FFE, FFE, D, FFE, D, FFE, (unsigned char*)GU, D, x * 2 * FFE, 1, MOE_WSCALE);
        JOB8(KIN(I_EU) + (size_t)(e * NE + x) * D * FFE, FFE, D, FFE, D, FFE, (unsigned char*)GU, D, x * 2 * FFE + 128, 1, MOE_WSCALE);
        JOB(KIN(I_ED) + (size_t)(e * NE + x) * FFE * D, D, FFE, D, FFE, D, DN, FFE, x * D, 0);
    }
}

__device__ __forceinline__ void ln_stats(const f32x4 (&v)[4], float& mean, float& rstd, int lane) {
    float s = 0.f;
#pragma unroll
    for (int j = 0; j < 4; ++j) s += (v[j].x + v[j].y) + (v[j].z + v[j].w);
    mean = wave_sum(s, lane) * (1.f / D); float s2 = 0.f;
#pragma unroll
    for (int j = 0; j < 4; ++j) { const f32x4 d = v[j] - mean; s2 += (d.x * d.x + d.y * d.y) + (d.z * d.z + d.w * d.w); }
    rstd = 1.f / sqrtf(wave_sum(s2, lane) * (1.f / D) + LN_EPS);
}
template <int SRC, bool ROUTER>
__device__ __forceinline__ void ln_phase(Frame& F, const float* PRE, const float* Hin, const float* YP, const int* tokr, const float* gln, const float* bln,
                                         float* Hout, bf16* HB, const float* router, int* toke, float* tokw, int* blkcnt) {
    LAS int* cnt = (LAS int*)(F.lds + RING_OFF + 131072 - 64);
    if (ROUTER) { if (F.tid < 8) cnt[F.tid] = 0; __syncthreads(); }
    f32x4 g4[4], b4[4];
#pragma unroll
    for (int j = 0; j < 4; ++j) { g4[j] = *(const f32x4*)(gln + 4 * F.lane + 256 * j); b4[j] = *(const f32x4*)(bln + 4 * F.lane + 256 * j); }
    const int rpb = M / F.G, rpw = rpb / NWAVES;
    for (int i = 0; i < rpw; ++i) {
        const int m = blockIdx.x * rpb + F.wave * rpw + i;
        f32x4 v[4];
        if (SRC == 0) {
#pragma unroll
            for (int j = 0; j < 4; ++j) v[j] = *(const f32x4*)(PRE + (size_t)m * D + 4 * F.lane + 256 * j);
        } else {
            const int r0 = tokr[2 * m], r1 = tokr[2 * m + 1];
#pragma unroll
            for (int j = 0; j < 4; ++j) { const int c = 4 * F.lane + 256 * j;
                v[j] = *(const f32x4*)(Hin + (size_t)m * D + c) * ALPHA + *(const f32x4*)(YP + (size_t)r0 * D + c) + *(const f32x4*)(YP + (size_t)r1 * D + c); }
        }
        float mean, rstd; ln_stats(v, mean, rstd, F.lane);
#pragma unroll
        for (int j = 0; j < 4; ++j) { v[j] = (v[j] - mean) * rstd * g4[j] + b4[j];
            *(f32x4*)(Hout + (size_t)m * D + 4 * F.lane + 256 * j) = v[j];
            if (HB) *(u32x2*)(HB + (size_t)m * D + 4 * F.lane + 256 * j) = f32_to_bf4(v[j]); }
        if (ROUTER) {
            float lg[8];
#pragma unroll
            for (int e = 0; e < 8; ++e) lg[e] = 0.f;
#pragma unroll
            for (int j = 0; j < 4; ++j)
#pragma unroll
                for (int q = 0; q < 4; ++q) { const float xv = v[j][q]; const f32x4* rp = (const f32x4*)(router + (size_t)(4 * F.lane + 256 * j + q) * 8); const f32x4 ra = rp[0], rb = rp[1];
                    lg[0] += xv * ra.x; lg[1] += xv * ra.y; lg[2] += xv * ra.z; lg[3] += xv * ra.w; lg[4] += xv * rb.x; lg[5] += xv * rb.y; lg[6] += xv * rb.z; lg[7] += xv * rb.w; }
#pragma unroll
            for (int e = 0; e < 8; ++e) lg[e] = wave_sum(lg[e], F.lane);
            int e0 = 0; float l0 = lg[0];
#pragma unroll
            for (int e = 1; e < 8; ++e) if (lg[e] > l0) { l0 = lg[e]; e0 = e; }
            int e1 = -1; float l1 = -INFINITY;
#pragma unroll
            for (int e = 0; e < 8; ++e) if (e != e0 && lg[e] > l1) { l1 = lg[e]; e1 = e; }
            const float w0 = 1.f / (1.f + __expf(l1 - l0)), w1 = 1.f - w0;
            if (F.lane == 0) { toke[2 * m] = e0; toke[2 * m + 1] = e1; tokw[2 * m] = w0; tokw[2 * m + 1] = w1; atomicAdd((int*)&cnt[e0], 1); atomicAdd((int*)&cnt[e1], 1); }
        }
    }
    if (ROUTER) { __syncthreads(); if (F.tid < 8) blkcnt[blockIdx.x * 8 + F.tid] = cnt[F.tid]; }
}

__device__ __forceinline__ void mix_phase(Frame& F, const float* Hx, const float* mu, bf16* XM) {
    f32x4 mu4[6][4];
#pragma unroll
    for (int c = 0; c < 6; ++c)
#pragma unroll
        for (int j = 0; j < 4; ++j) mu4[c][j] = *(const f32x4*)(mu + c * D + 4 * F.lane + 256 * j);
    for (int m = F.gw; m < M; m += F.NGW) {
        const bool first = (m % T) == 0;
#pragma unroll
        for (int j = 0; j < 4; ++j) { const int c0 = 4 * F.lane + 256 * j;
            const f32x4 x = *(const f32x4*)(Hx + (size_t)m * D + c0);
            f32x4 xp = (f32x4){0.f, 0.f, 0.f, 0.f}; if (!first) xp = *(const f32x4*)(Hx + (size_t)(m - 1) * D + c0);
            const f32x4 xx = xp - x;
#pragma unroll
            for (int c = 0; c < 6; ++c) *(u32x2*)(XM + ((size_t)c * M + m) * D + c0) = f32_to_bf4(x + xx * mu4[c][j]); }
    }
}
__device__ __forceinline__ void prep_phase(Frame& F, int l, const bf16* RKV, const float* AA, const bf16* LH, const float* v0, const float* v2, bf16* VF, const float* k_k, const float* k_a, bf16* KP, bf16* AP, bf16* BP, bf16* VP) {
    f32x4 kk4[4], ka4[4];
#pragma unroll
    for (int j = 0; j < 4; ++j) { kk4[j] = *(const f32x4*)(k_k + 4 * F.lane + 256 * j); ka4[j] = *(const f32x4*)(k_a + 4 * F.lane + 256 * j); }
    for (int m = F.gw; m < M; m += F.NGW) {
#pragma unroll
        for (int j = 0; j < 4; ++j) { const size_t o = (size_t)m * D + 4 * F.lane + 256 * j;
            const f32x4 k = bf4_to_f32(*(const u32x2*)(RKV + (size_t)M * D + o)); const u32x2 vraw = *(const u32x2*)(RKV + (size_t)2 * M * D + o); f32x4 v = bf4_to_f32(vraw);
            const f32x4 a = *(const f32x4*)(AA + o);
            f32x4 kk = k * kk4[j]; const float ss = sum16((kk.x * kk.x + kk.y * kk.y) + (kk.z * kk.z + kk.w * kk.w));
            kk = kk * (1.0f / sqrtf(fmaxf(ss, 1e-24f)));
            const f32x4 kp = k * ((a - 1.0f) * ka4[j] + 1.0f);
            if (l == 0) *(u32x2*)(VF + o) = vraw;
            else {
                f32x4 z = *(const f32x4*)(v0 + 4 * F.lane + 256 * j);
                const bf16* lh = LH + (size_t)m * D + 512;
#pragma unroll 8
                for (int q = 0; q < 32; ++q) z += *(const f32x4*)(v2 + (size_t)q * D + 4 * F.lane + 256 * j) * bf2f(lh[q]);
                f32x4 vg; vg.x = 1.f / (1.f + __expf(-z.x)); vg.y = 1.f / (1.f + __expf(-z.y)); vg.z = 1.f / (1.f + __expf(-z.z)); vg.w = 1.f / (1.f + __expf(-z.w));
                const f32x4 vf = bf4_to_f32(*(const u32x2*)(VF + o)); v = v + (vf - v) * vg; }
            *(u32x2*)(KP + o) = f32_to_bf4(kp); *(u32x2*)(VP + o) = f32_to_bf4(v); *(u32x2*)(AP + o) = f32_to_bf4(-kk); *(u32x2*)(BP + o) = f32_to_bf4(kk * a); }
    }
}
__device__ __forceinline__ void post_phase(Frame& F, const bf16* Y, const bf16* R, const bf16* KP, const bf16* VP, const bf16* GG, const float* r_k, const float* gng, const float* gnb, bf16* YG) {
    f32x4 rk4[4], gg4[4], gb4[4];
#pragma unroll
    for (int j = 0; j < 4; ++j) { rk4[j] = *(const f32x4*)(r_k + 4 * F.lane + 256 * j); gg4[j] = *(const f32x4*)(gng + 4 * F.lane + 256 * j); gb4[j] = *(const f32x4*)(gnb + 4 * F.lane + 256 * j); }
    for (int m = F.gw; m < M; m += F.NGW) {
#pragma unroll
        for (int j = 0; j < 4; ++j) { const size_t o = (size_t)m * D + 4 * F.lane + 256 * j;
            const f32x4 y = bf4_to_f32(*(const u32x2*)(Y + o)), r = bf4_to_f32(*(const u32x2*)(R + o)), g = bf4_to_f32(*(const u32x2*)(GG + o));
            const f32x4 kp = bf4_to_f32(*(const u32x2*)(KP + o)), vp = bf4_to_f32(*(const u32x2*)(VP + o));
            const float mean = sum16((y.x + y.y) + (y.z + y.w)) * (1.f / 64.f); const f32x4 d = y - mean;
            const float var = sum16((d.x * d.x + d.y * d.y) + (d.z * d.z + d.w * d.w)) * (1.f / 64.f);
            const f32x4 rkk = r * kp * rk4[j]; const float bon = sum16((rkk.x + rkk.y) + (rkk.z + rkk.w));
            const f32x4 yn = d * (1.0f / sqrtf(var + GN_EPS)) * gg4[j] + gb4[j] + vp * bon;
            *(u32x2*)(YG + o) = f32_to_bf4(yn * g); }
    }
}
__device__ __forceinline__ float fma_s(float a, float b, float c) { float r; asm("v_fma_f32 %0, %1, %2, %3" : "=v"(r) : "v"(a), "v"(b), "v"(c)); return r; }
__device__ __forceinline__ float mul_s(float a, float b) { float r; asm("v_mul_f32_e32 %0, %1, %2" : "=v"(r) : "v"(a), "v"(b)); return r; }
__device__ __forceinline__ float add_s(float a, float b) { float r; asm("v_add_f32_e32 %0, %1, %2" : "=v"(r) : "v"(a), "v"(b)); return r; }
__device__ __forceinline__ float dot4_s(const f32x4& x, const f32x4& y) { return add_s(fma_s(x.y, y.y, mul_s(x.x, y.x)), fma_s(x.w, y.w, mul_s(x.z, y.z))); }
__device__ __forceinline__ f32x4 upd_s(const f32x4& S, const f32x4& w, const f32x4& b, float sa, const f32x4& k, float v) {
    f32x4 r; r.x = fma_s(S.x, w.x, fma_s(b.x, sa, mul_s(k.x, v))); r.y = fma_s(S.y, w.y, fma_s(b.y, sa, mul_s(k.y, v))); r.z = fma_s(S.z, w.z, fma_s(b.z, sa, mul_s(k.z, v))); r.w = fma_s(S.w, w.w, fma_s(b.w, sa, mul_s(k.w, v))); return r; }
__device__ __forceinline__ void scan_phase(Frame& F, const bf16* R, const float* DEC, const bf16* KP, const bf16* AP, const bf16* BP, const bf16* VP, bf16* Y) {
    constexpr int TS = 32, BUFB = 57600, YB_OFF = 2 * BUFB;
    const int head = F.vcu >> 3, part = F.vcu & 7, b = head >> 4, hh = head & 15;
    const size_t rowb = (size_t)b * T; const int col0 = hh * 64;
    const int tr = F.tid >> 4, pc = F.tid & 15;
    const int tr2 = (F.tid & 255) >> 3, pc2 = F.tid & 7;
    const int rr = F.lane >> 4, q = F.lane & 15, myrow = 8 * part + 4 * F.wave + rr;
    LAS unsigned char* L = F.lds + RING_OFF;
    struct Stg { f32x4 lw; u32x2 rk, ra, rb, rv, rn; v4u lr; };
    Stg g0, g1;
#define SC_LOAD(c, G) do { const int t_ = (c) * TS + tr; const size_t g_ = (rowb + t_) * D + col0 + pc * 4; G.lw = *(const f32x4*)(DEC + g_); G.rk = *(const u32x2*)(KP + g_); G.ra = *(const u32x2*)(AP + g_); \
        G.rb = *(const u32x2*)(BP + g_); G.rv = *(const u32x2*)(VP + g_); G.rn = (u32x2){0u, 0u}; if (t_ + 1 < T) G.rn = *(const u32x2*)(AP + g_ + D); \
        if (F.tid < 256) G.lr = *(const v4u*)(R + (rowb + (size_t)(c) * TS + tr2) * D + col0 + pc2 * 8); } while (0)
#define SC_STORE(bf, G) do { const f32x4 lk_ = bf4_to_f32(G.rk), la_ = bf4_to_f32(G.ra), lb_ = bf4_to_f32(G.rb), lv_ = bf4_to_f32(G.rv), ln_ = bf4_to_f32(G.rn); LAS unsigned char* d_ = L + (bf) * BUFB + tr * 256 + pc * 16; *(LAS f32x4*)(d_) = G.lw; *(LAS f32x4*)(d_ + 8192) = lk_; *(LAS f32x4*)(d_ + 16384) = la_; \
        *(LAS f32x4*)(d_ + 24576) = lb_; *(LAS f32x4*)(d_ + 32768) = lv_; *(LAS f32x4*)(d_ + 49152) = G.lw * ln_; \
        { const f32x4 pb_ = lb_ * ln_, pk_ = lk_ * ln_; const float be_ = dpp_sum16((pb_.x + pb_.y) + (pb_.z + pb_.w)), ga_ = dpp_sum16((pk_.x + pk_.y) + (pk_.z + pk_.w)); \
          if (pc == 0) { *(LAS float*)(L + (bf) * BUFB + 57344 + tr * 4) = be_; *(LAS float*)(L + (bf) * BUFB + 57472 + tr * 4) = ga_; } } \
        if (F.tid < 256) { LAS unsigned char* r_ = L + (bf) * BUFB + 40960 + tr2 * 256 + pc2 * 32; \
            *(LAS f32x4*)(r_) = (f32x4){__uint_as_float(G.lr.x << 16), __uint_as_float(G.lr.x & 0xffff0000u), __uint_as_float(G.lr.y << 16), __uint_as_float(G.lr.y & 0xffff0000u)}; \
            *(LAS f32x4*)(r_ + 16) = (f32x4){__uint_as_float(G.lr.z << 16), __uint_as_float(G.lr.z & 0xffff0000u), __uint_as_float(G.lr.w << 16), __uint_as_float(G.lr.w & 0xffff0000u)}; } } while (0)
    SC_LOAD(0, g0); SC_STORE(0, g0); SC_LOAD(1, g0); __syncthreads();
    f32x4 S = (f32x4){0.f, 0.f, 0.f, 0.f};
    constexpr int NCH = T / TS;
    for (int c2 = 0; c2 < NCH; c2 += 2) {
#pragma unroll
      for (int par = 0; par < 2; ++par) {
        const int c = c2 + par, bf = par;
        if (c + 2 < NCH) { if (par == 0) SC_LOAD(c + 2, g1); else SC_LOAD(c + 2, g0); }
        if (F.wave < 2) {
            const LAS unsigned char* B0 = L + bf * BUFB + q * 16; const LAS unsigned char* Bv = L + bf * BUFB + 32768 + myrow * 4; const LAS unsigned char* Bs = L + bf * BUFB + 57344;
            LAS unsigned short* yb = (LAS unsigned short*)(L + YB_OFF + bf * 512) + q * 8 + 4 * F.wave + rr;
            struct Rnd { f32x4 a, aw, w0, b0, k0, r0, w1, b1, k1, r1; float v0, v1, be, ga; };
#define SC_FETCH(t_, X) do { X.a = *(const LAS f32x4*)(B0 + 16384 + (t_) * 256); X.aw = *(const LAS f32x4*)(B0 + 49152 + (t_) * 256); \
            X.w0 = *(const LAS f32x4*)(B0 + (t_) * 256); X.b0 = *(const LAS f32x4*)(B0 + 24576 + (t_) * 256); X.k0 = *(const LAS f32x4*)(B0 + 8192 + (t_) * 256); X.r0 = *(const LAS f32x4*)(B0 + 40960 + (t_) * 256); \
            X.w1 = *(const LAS f32x4*)(B0 + ((t_) + 1) * 256); X.b1 = *(const LAS f32x4*)(B0 + 24576 + ((t_) + 1) * 256); X.k1 = *(const LAS f32x4*)(B0 + 8192 + ((t_) + 1) * 256); X.r1 = *(const LAS f32x4*)(B0 + 40960 + ((t_) + 1) * 256); \
            X.v0 = *(const LAS float*)(Bv + (t_) * 256); X.v1 = *(const LAS float*)(Bv + ((t_) + 1) * 256); X.be = *(const LAS float*)(Bs + (t_) * 4); X.ga = *(const LAS float*)(Bs + 128 + (t_) * 4); } while (0)
            Rnd cu; float ykeep = 0.f, yra = 0.f, yrb = 0.f;
#define RED_STEP(x, ctl) asm volatile("v_add_f32_dpp %0, %0, %0 " ctl " row_mask:0xf bank_mask:0xf bound_ctrl:1" : "+v"(x))
#define RED_STEP0(x, ctl) asm volatile("s_nop 1\n\tv_add_f32_dpp %0, %0, %0 " ctl " row_mask:0xf bank_mask:0xf bound_ctrl:1" : "+v"(x))
#define RED4(a_, b_, c_, d_) do { \
            RED_STEP0(a_, "quad_perm:[1,0,3,2]"); RED_STEP0(b_, "quad_perm:[1,0,3,2]"); RED_STEP0(c_, "quad_perm:[1,0,3,2]"); RED_STEP0(d_, "quad_perm:[1,0,3,2]"); \
            RED_STEP(a_, "quad_perm:[2,3,0,1]"); RED_STEP(b_, "quad_perm:[2,3,0,1]"); RED_STEP(c_, "quad_perm:[2,3,0,1]"); RED_STEP(d_, "quad_perm:[2,3,0,1]"); \
            RED_STEP(a_, "row_half_mirror"); RED_STEP(b_, "row_half_mirror"); RED_STEP(c_, "row_half_mirror"); RED_STEP(d_, "row_half_mirror"); \
            RED_STEP(a_, "row_mirror"); RED_STEP(b_, "row_mirror"); RED_STEP(c_, "row_mirror"); RED_STEP(d_, "row_mirror"); } while (0)
            SC_FETCH(0, cu);
#pragma unroll
            for (int t = 0; t < TS; t += 2) {
                Rnd nx = cu;
                if (t + 2 < TS) SC_FETCH(t + 2, nx);
                const f32x4 p1 = S * cu.a, p2 = S * cu.aw;
                float u1 = (p1.x + p1.y) + (p1.z + p1.w), u2 = (p2.x + p2.y) + (p2.z + p2.w);
                RED4(u1, u2, yra, yrb);
                if (t > 0) { ykeep = (q == ((t - 2) & 15)) ? yra : ykeep; ykeep = (q == ((t - 1) & 15)) ? yrb : ykeep;
                             if (((t - 1) & 15) == 15) yb[(t - 16) * 8] = (unsigned short)f2bf(ykeep); }
                const float sa0 = u1, sa1 = u2 + sa0 * cu.be + cu.v0 * cu.ga;
                S = S * cu.w0 + (cu.b0 * sa0 + cu.k0 * cu.v0);
                const f32x4 y4a = S * cu.r0;
                S = S * cu.w1 + (cu.b1 * sa1 + cu.k1 * cu.v1);
                const f32x4 y4b = S * cu.r1;
                yra = (y4a.x + y4a.y) + (y4a.z + y4a.w); yrb = (y4b.x + y4b.y) + (y4b.z + y4b.w);
                cu = nx;
            }
            { float d0_ = 0.f, d1_ = 0.f; RED4(yra, yrb, d0_, d1_);
              ykeep = (q == 14) ? yra : ykeep; ykeep = (q == 15) ? yrb : ykeep; yb[16 * 8] = (unsigned short)f2bf(ykeep); }
#undef RED4
#undef RED_STEP0
#undef RED_STEP
#undef SC_FETCH
        }
        if (c + 1 < NCH) { if (par == 0) SC_STORE(1, g0); else SC_STORE(0, g1); }
        __syncthreads();
        if (F.tid < 32) { const v4u yv = *(const LAS v4u*)(L + YB_OFF + bf * 512 + F.tid * 16);
            *(v4u*)(Y + (rowb + (size_t)c * TS + F.tid) * D + col0 + part * 8) = yv; }
      }
    }
#undef SC_LOAD
#undef SC_STORE
}

__device__ __forceinline__ void kmean_phase(Frame& F, const bf16* Kb, float* KM) {
    LAS float* red = (LAS float*)(F.lds + RING_OFF);
    for (int u = blockIdx.x; u < 2 * 32 * 4; u += F.G) {
        const int qc = u & 3, blk = (u >> 2) & 31, b = u >> 7; const int c = F.tid & 255, rh = F.tid >> 8;
        const bf16* p = Kb + ((size_t)b * T + blk * 256 + rh * 128) * D + qc * 256 + c; float s = 0.f;
#pragma unroll 8
        for (int r = 0; r < 128; ++r) s += bf2f(p[(size_t)r * D]);
        if (rh == 1) red[c] = s;
        __syncthreads();
        if (rh == 0) { const int col = qc * 256 + c; KM[(((size_t)b * H + (col >> 6)) * 32 + blk) * 64 + (col & 63)] = (s + red[c]) * (1.f / 256.f); }
        __syncthreads();
    }
}
__device__ __forceinline__ void gate_phase(Frame& F, const bf16* Q, const float* KM, unsigned* SEL) {
    LAS float* km = (LAS float*)(F.lds + RING_OFF);
    for (int u = blockIdx.x; u < M / 64; u += F.G) {
        const int m0 = u * 64, b = m0 / T, own = (m0 % T) >> 8;
        for (int i = F.tid; i < 16 * 32 * 16; i += NWAVES * 64) *(LAS f32x4*)(km + 4 * i) = *(const f32x4*)(KM + (size_t)b * 16 * 32 * 64 + 4 * i);
        __syncthreads();
        const int m = m0 + F.lane;
#pragma unroll 1
        for (int hi = 0; hi < 2; ++hi) { const int h = 2 * F.wave + hi;
            float qv[64];
#pragma unroll
            for (int i = 0; i < 8; ++i) { const v4u w = *(const v4u*)(Q + (size_t)m * D + h * 64 + 8 * i);
                qv[8 * i + 0] = __uint_as_float(w.x << 16); qv[8 * i + 1] = __uint_as_float(w.x & 0xffff0000u); qv[8 * i + 2] = __uint_as_float(w.y << 16); qv[8 * i + 3] = __uint_as_float(w.y & 0xffff0000u);
                qv[8 * i + 4] = __uint_as_float(w.z << 16); qv[8 * i + 5] = __uint_as_float(w.z & 0xffff0000u); qv[8 * i + 6] = __uint_as_float(w.w << 16); qv[8 * i + 7] = __uint_as_float(w.w & 0xffff0000u); }
            float v0 = -INFINITY, v1 = -INFINITY, v2 = -INFINITY; int i0 = -1, i1 = -1, i2 = -1;
            for (int j = 0; j < own; ++j) { const LAS f32x4* kp = (const LAS f32x4*)(km + (h * 32 + j) * 64); float s = 0.f;
#pragma unroll
                for (int i = 0; i < 16; ++i) { const f32x4 kv = kp[i]; s += qv[4 * i] * kv.x + qv[4 * i + 1] * kv.y + qv[4 * i + 2] * kv.z + qv[4 * i + 3] * kv.w; }
                if (s > v0) { v2 = v1; i2 = i1; v1 = v0; i1 = i0; v0 = s; i0 = j; } else if (s > v1) { v2 = v1; i2 = i1; v1 = s; i1 = j; } else if (s > v2) { v2 = s; i2 = j; } }
            unsigned mask = 0u; if (i0 >= 0) mask |= 1u << i0; if (i1 >= 0) mask |= 1u << i1; if (i2 >= 0) mask |= 1u << i2;
            SEL[((size_t)b * H + h) * T + (m % T)] = mask; }
        __syncthreads();
    }
}

__device__ __forceinline__ void moe_prefix(Frame& F, const int* blkcnt, LAS int* pre_mine  ) {
    LAS int* tmp = (LAS int*)(F.lds + RING_OFF);
    for (int i = F.tid; i < F.G * 8; i += NWAVES * 64) tmp[i] = blkcnt[i];
    __syncthreads();
    if (F.tid < 8) { int tot = 0, mine = 0; for (int g = 0; g < F.G; ++g) { if (g == (int)blockIdx.x) mine = tot; tot += tmp[g * 8 + F.tid]; }
        pre_mine[F.tid] = mine; pre_mine[8 + F.tid] = tot; }
    __syncthreads();
    if (F.tid == 0) { int p = 0; for (int e = 0; e < 8; ++e) { F.MISC[16 + e] = (unsigned)p; p += (pre_mine[8 + e] + 255) >> 8; } F.MISC[24] = (unsigned)p; }
    __syncthreads();
}
__device__ __forceinline__ void moe_gather_phase(Frame& F, const int* blkcnt, const int* toke, const float* tokw, int* tokr, float* gw, const float* Hs, unsigned char* XG) {
    LAS int* pm = (LAS int*)(F.lds + RING_OFF + 16384);
    LAS int* rows = (LAS int*)(F.lds + RING_OFF + 16384 + 64);
    moe_prefix(F, blkcnt, pm);
    const int rpb = M / F.G;
    if (F.wave == 0) {
        const int m = blockIdx.x * rpb + F.lane; const bool ok = F.lane < rpb;
        const int e0 = ok ? toke[2 * m] : -1, e1 = ok ? toke[2 * m + 1] : -1;
        int r0 = 0, r1 = 0;
        for (int e = 0; e < 8; ++e) { const unsigned long long b0 = __ballot(e0 == e), b1 = __ballot(e1 == e); const unsigned long long lt = (1ull << F.lane) - 1ull;
            const int base = (int)F.MISC[16 + e] * 256 + pm[e];
            if (e0 == e) r0 = base + __popcll(b0 & lt);
            if (e1 == e) r1 = base + __popcll(b0) + __popcll(b1 & lt); }
        if (ok) { tokr[2 * m] = r0; tokr[2 * m + 1] = r1; gw[r0] = tokw[2 * m]; gw[r1] = tokw[2 * m + 1]; rows[2 * F.lane] = r0; rows[2 * F.lane + 1] = r1; }
    }
    __syncthreads();
    for (int i = F.wave; i < 2 * rpb; i += NWAVES) { const int m = blockIdx.x * rpb + (i >> 1), r = rows[i];
        const f32x4* s = (const f32x4*)(Hs + (size_t)m * D + 16 * F.lane); const f32x4 a = s[0], b_ = s[1], c = s[2], d = s[3];
        v4u o; int w;
        w = __builtin_amdgcn_cvt_pk_fp8_f32(a.x, a.y, 0, false); w = __builtin_amdgcn_cvt_pk_fp8_f32(a.z, a.w, w, true); o.x = (unsigned)w;
        w = __builtin_amdgcn_cvt_pk_fp8_f32(b_.x, b_.y, 0, false); w = __builtin_amdgcn_cvt_pk_fp8_f32(b_.z, b_.w, w, true); o.y = (unsigned)w;
        w = __builtin_amdgcn_cvt_pk_fp8_f32(c.x, c.y, 0, false); w = __builtin_amdgcn_cvt_pk_fp8_f32(c.z, c.w, w, true); o.z = (unsigned)w;
        w = __builtin_amdgcn_cvt_pk_fp8_f32(d.x, d.y, 0, false); w = __builtin_amdgcn_cvt_pk_fp8_f32(d.z, d.w, w, true); o.w = (unsigned)w;
        *(v4u*)(XG + (size_t)r * D + 16 * F.lane) = o; }
    __syncthreads();
}
__device__ __forceinline__ void attn_direct_phase(Frame& F, const bf16* Q, const bf16* Kb, const bf16* Vb, const unsigned* SEL, bf16* O) {
    for (int u = F.gw; u < (M / 64) * H; u += F.NGW) {
        const int h = u & 15, m0 = (u >> 4) * 64, b = m0 / T, t0 = m0 % T, own = t0 >> 8, m = m0 + F.lane, tpos = t0 + F.lane;
        float q[64], o[64];
#pragma unroll
        for (int i = 0; i < 8; ++i) { const v4u w = *(const v4u*)(Q + (size_t)m * D + h * 64 + 8 * i);
            q[8 * i + 0] = __uint_as_float(w.x << 16); q[8 * i + 1] = __uint_as_float(w.x & 0xffff0000u); q[8 * i + 2] = __uint_as_float(w.y << 16); q[8 * i + 3] = __uint_as_float(w.y & 0xffff0000u);
            q[8 * i + 4] = __uint_as_float(w.z << 16); q[8 * i + 5] = __uint_as_float(w.z & 0xffff0000u); q[8 * i + 6] = __uint_as_float(w.w << 16); q[8 * i + 7] = __uint_as_float(w.w & 0xffff0000u); }
#pragma unroll
        for (int i = 0; i < 64; ++i) o[i] = 0.f;
        const unsigned sel = SEL[((size_t)b * H + h) * T + tpos];
        float mrun = -INFINITY, l = 0.f;
        for (int j = 0; j <= own; ++j) {
            const bool pastsel = (sel >> j) & 1u;
            if (j < own && !__any(pastsel)) continue;
            const int nk = (j < own) ? 256 : (t0 & 255) + 64;
            for (int kk = 0; kk < nk; ++kk) {
                const int kpos = j * 256 + kk; const size_t ro = ((size_t)b * T + kpos) * D + h * 64;
                float s = 0.f;
#pragma unroll
                for (int i = 0; i < 8; ++i) { const v4u w = *(const v4u*)(Kb + ro + 8 * i);
                    s += q[8 * i + 0] * __uint_as_float(w.x << 16) + q[8 * i + 1] * __uint_as_float(w.x & 0xffff0000u) + q[8 * i + 2] * __uint_as_float(w.y << 16) + q[8 * i + 3] * __uint_as_float(w.y & 0xffff0000u)
                       + q[8 * i + 4] * __uint_as_float(w.z << 16) + q[8 * i + 5] * __uint_as_float(w.z & 0xffff0000u) + q[8 * i + 6] * __uint_as_float(w.w << 16) + q[8 * i + 7] * __uint_as_float(w.w & 0xffff0000u); }
                const bool act = (j < own) ? pastsel : (kpos <= tpos);
                if (act) {
                    if (s > mrun) { const float c = exp2f(mrun - s); l *= c;
#pragma unroll
                        for (int i = 0; i < 64; ++i) o[i] *= c;
                        mrun = s; }
                    const float p = exp2f(s - mrun); l += p;
#pragma unroll
                    for (int i = 0; i < 8; ++i) { const v4u w = *(const v4u*)(Vb + ro + 8 * i);
                        o[8 * i + 0] += p * __uint_as_float(w.x << 16); o[8 * i + 1] += p * __uint_as_float(w.x & 0xffff0000u); o[8 * i + 2] += p * __uint_as_float(w.y << 16); o[8 * i + 3] += p * __uint_as_float(w.y & 0xffff0000u);
                        o[8 * i + 4] += p * __uint_as_float(w.z << 16); o[8 * i + 5] += p * __uint_as_float(w.z & 0xffff0000u); o[8 * i + 6] += p * __uint_as_float(w.w << 16); o[8 * i + 7] += p * __uint_as_float(w.w & 0xffff0000u); }
                }
            }
        }
        const float rl = 1.0f / l;
#pragma unroll
        for (int i = 0; i < 8; ++i) { v4u w; w.x = pk2(o[8 * i] * rl, o[8 * i + 1] * rl); w.y = pk2(o[8 * i + 2] * rl, o[8 * i + 3] * rl); w.z = pk2(o[8 * i + 4] * rl, o[8 * i + 5] * rl); w.w = pk2(o[8 * i + 6] * rl, o[8 * i + 7] * rl);
            *(v4u*)(O + (size_t)m * D + h * 64 + 8 * i) = w; }
    }
}
namespace moba {
using attn_body::f32x16; using attn_body::crow;
constexpr int L_K = 0, L_V = 32768, L_LIST = 65536, L_WS = 81920, L_CTL = 84992;
__device__ __forceinline__ void qkt_l(f32x16& p0, f32x16& p1, const LAS unsigned char* Kslot, const bf16x8* qr, int r32, int hi) {
    const LAS unsigned char* kb = Kslot + hi * 1024 + r32 * 16;
#pragma unroll
    for (int d0 = 0; d0 < 4; ++d0) {
        const bf16x8 b0 = *(const LAS bf16x8*)(kb + d0 * 2048), b1 = *(const LAS bf16x8*)(kb + d0 * 2048 + 512);
        if (d0 == 0) { p0 = __builtin_amdgcn_mfma_f32_32x32x16_bf16(b0, qr[0], f32x16{}, 0, 0, 0); p1 = __builtin_amdgcn_mfma_f32_32x32x16_bf16(b1, qr[0], f32x16{}, 0, 0, 0); }
        else { p0 = __builtin_amdgcn_mfma_f32_32x32x16_bf16(b0, qr[d0], p0, 0, 0, 0); p1 = __builtin_amdgcn_mfma_f32_32x32x16_bf16(b1, qr[d0], p1, 0, 0, 0); } }
}
__device__ __forceinline__ float half_max(float v) { auto rr = __builtin_amdgcn_permlane32_swap(__float_as_uint(v), __float_as_uint(v), false, false); return fmaxf(__uint_as_float(rr[0]), __uint_as_float(rr[1])); }
__device__ __forceinline__ float half_sum(float v) { auto rr = __builtin_amdgcn_permlane32_swap(__float_as_uint(v), __float_as_uint(v), false, false); return __uint_as_float(rr[0]) + __uint_as_float(rr[1]); }
}
__device__ __forceinline__ void moba_attn_phase(Frame& F, const bf16* Q, const bf16* Kb, const bf16* Vb, const unsigned* SELT, bf16* PO, float* ML, gu32* qctr) {
    using namespace moba;
    const int lane = F.lane, wid = F.wave, r32 = lane & 31, hi = lane >> 5;
    LAS unsigned char* L = F.lds + RING_OFF;
    LAS unsigned short* list = (LAS unsigned short*)(L + L_LIST);
    LAS float* wsf = (LAS float*)(L + L_WS + wid * 256); LAS int* wsd = (LAS int*)(L + L_WS + wid * 256 + 128);
    LAS int* ctl = (LAS int*)(L + L_CTL);
    const int vb0 = RING_OFF + L_V + ((lane >> 4) & 1) * 32 + (lane & 3) * 8 + (4 * hi + ((lane & 15) >> 2)) * 64;
    for (;;) {
        __syncthreads();
        if (F.tid == 0) { ctl[0] = (int)__hip_atomic_fetch_add(qctr, 1u, __ATOMIC_RELAXED, __HIP_MEMORY_SCOPE_AGENT); ctl[1] = 0; }
        __syncthreads();
        const int u = __builtin_amdgcn_readfirstlane(ctl[0]);
        if (u >= 32 * 32) break;
        const int j = u >> 5, bh = u & 31, b = bh >> 4, h = bh & 15;
        const size_t rowb = (size_t)b * T;
        { const bf16* ksrc = Kb + (rowb + 256 * j + lane) * D + h * 64 + wid * 8;
          const bf16* vsrc = Vb + (rowb + 256 * j + 16 * (wid & 3) + (lane >> 2)) * D + h * 64 + (wid >> 2) * 32 + (lane & 3) * 8;
#pragma unroll
          for (int kt = 0; kt < 4; ++kt) { attn_body::glds16(ksrc + (size_t)kt * 64 * D, (unsigned)__builtin_amdgcn_readfirstlane(RING_OFF + L_K + kt * 8192 + wid * 1024));
                                           attn_body::glds16(vsrc + (size_t)kt * 64 * D, (unsigned)__builtin_amdgcn_readfirstlane(RING_OFF + L_V + kt * 8192 + wid * 1024)); } }
        const unsigned* selrow = SELT + (size_t)bh * T;
        for (int t0 = 256 * (j + 1); t0 < T; t0 += NWAVES * 64) { const int t = t0 + F.tid; const bool in = t < T;
            const bool p = in && ((selrow[in ? t : 0] >> j) & 1u);
            const unsigned long long bal = __ballot(p); const int np = __popcll(bal);
            int base = 0; if (lane == 0 && np) base = __hip_atomic_fetch_add(&ctl[1], np, __ATOMIC_RELAXED, __HIP_MEMORY_SCOPE_WORKGROUP);
            base = __builtin_amdgcn_readfirstlane(base);
            if (p) list[base + __popcll(bal & ((1ull << lane) - 1ull))] = (unsigned short)t; }
        asm volatile("s_waitcnt vmcnt(0) lgkmcnt(0)" ::: "memory");
        __syncthreads();
        const int total = 256 + ctl[1], nb = (total + 31) >> 5;
        for (int bi = wid; bi < nb; bi += NWAVES) {
            const int item = bi * 32 + r32; const bool valid = item < total; const int it2 = valid ? item : total - 1;
            const bool ownb = bi < 8;
            const int t = it2 < 256 ? 256 * j + it2 : (int)list[it2 - 256];
            const bf16* qrow = Q + (rowb + t) * D + h * 64;
            bf16x8 qr[4];
#pragma unroll
            for (int d0 = 0; d0 < 4; ++d0) qr[d0] = *(const bf16x8*)(qrow + d0 * 16 + hi * 8);
            f32x16 P[4][2];
#pragma unroll
            for (int kt = 0; kt < 4; ++kt) qkt_l(P[kt][0], P[kt][1], L + L_K + kt * 8192, qr, r32, hi);
            if (ownb) {
#pragma unroll
                for (int kt = 0; kt < 4; ++kt) attn_body::cmask(P[kt][0], P[kt][1], kt, t - 256 * j, hi); }
            float mx = -INFINITY;
#pragma unroll
            for (int kt = 0; kt < 4; ++kt)
#pragma unroll
                for (int r = 0; r < 16; ++r) mx = fmaxf(mx, fmaxf(P[kt][0][r], P[kt][1][r]));
            mx = half_max(mx);
            float ls = 0.f;
#pragma unroll
            for (int kt = 0; kt < 4; ++kt)
#pragma unroll
                for (int r = 0; r < 16; ++r) { P[kt][0][r] = __builtin_amdgcn_exp2f(P[kt][0][r] - mx); P[kt][1][r] = __builtin_amdgcn_exp2f(P[kt][1][r] - mx); ls += P[kt][0][r] + P[kt][1][r]; }
            ls = half_sum(ls);
            f32x16 o[2]; o[0] = f32x16{}; o[1] = f32x16{};
#pragma unroll
            for (int kt = 0; kt < 4; ++kt) {
                attn_body::u32x4 w0, w1, w2, w3;
#define PKW_(P_, B_) attn_body::cvtpk_s(P_[B_], P_[B_ + 1])
                w0 = (attn_body::u32x4){PKW_(P[kt][0], 0), PKW_(P[kt][0], 2), PKW_(P[kt][0], 4), PKW_(P[kt][0], 6)}; w1 = (attn_body::u32x4){PKW_(P[kt][0], 8), PKW_(P[kt][0], 10), PKW_(P[kt][0], 12), PKW_(P[kt][0], 14)};
                w2 = (attn_body::u32x4){PKW_(P[kt][1], 0), PKW_(P[kt][1], 2), PKW_(P[kt][1], 4), PKW_(P[kt][1], 6)}; w3 = (attn_body::u32x4){PKW_(P[kt][1], 8), PKW_(P[kt][1], 10), PKW_(P[kt][1], 12), PKW_(P[kt][1], 14)};
#undef PKW_
                attn_body::pv(o, vb0 + kt * 8192, __builtin_bit_cast(bf16x8, w0), __builtin_bit_cast(bf16x8, w1), __builtin_bit_cast(bf16x8, w2), __builtin_bit_cast(bf16x8, w3)); }
            const unsigned sel = selrow[t];
            const int slot = ownb ? 3 : __popc(sel & ((1u << j) - 1u));
            const int dest = (int)(((rowb + t) * H + h) * 4 + slot);
            if (hi == 0) { wsf[r32] = 1.0f / ls; wsd[r32] = valid ? dest : -1; if (valid) { ML[(size_t)dest * 2] = mx; ML[(size_t)dest * 2 + 1] = ls; } }
            asm volatile("s_waitcnt lgkmcnt(0)" ::: "memory");
#pragma unroll
            for (int r = 0; r < 16; ++r) { const int row = crow(r, hi); const float rl = wsf[row]; const int d = wsd[row];
                if (d >= 0) { PO[(size_t)d * 64 + r32] = (bf16)f2bf(o[0][r] * rl); PO[(size_t)d * 64 + 32 + r32] = (bf16)f2bf(o[1][r] * rl); } }
            asm volatile("s_waitcnt lgkmcnt(0)" ::: "memory");
        }
    }
}
__device__ __forceinline__ void moba_combine_phase(Frame& F, const unsigned* SELT, const bf16* PO, const float* ML, bf16* O) {
    for (int m = F.gw; m < M; m += F.NGW) {
        const int b = m / T, t = m % T, h = F.lane >> 2, qd = F.lane & 3;
        const unsigned sel = SELT[((size_t)b * H + h) * T + t]; const int cnt = __popc(sel);
        const size_t base = ((size_t)m * H + h) * 4;
        float ms[4], ls[4]; float mstar = -INFINITY;
#pragma unroll
        for (int s = 0; s < 4; ++s) { const bool on = (s == 3) || (s < cnt); ms[s] = on ? ML[(base + s) * 2] : -INFINITY; ls[s] = on ? ML[(base + s) * 2 + 1] : 0.f; mstar = fmaxf(mstar, ms[s]); }
        float wsum = 0.f, w[4];
#pragma unroll
        for (int s = 0; s < 4; ++s) { w[s] = ls[s] * __builtin_amdgcn_exp2f(ms[s] - mstar); wsum += w[s]; }
        const float rw = 1.0f / wsum;
        float acc[16];
#pragma unroll
        for (int i = 0; i < 16; ++i) acc[i] = 0.f;
#pragma unroll
        for (int s = 0; s < 4; ++s) { const bool on = (s == 3) || (s < cnt);
            if (on) { const float ws_ = w[s] * rw; const v4u a = *(const v4u*)(PO + (base + s) * 64 + qd * 16), c = *(const v4u*)(PO + (base + s) * 64 + qd * 16 + 8);
                const unsigned wv[8] = {a.x, a.y, a.z, a.w, c.x, c.y, c.z, c.w};
#pragma unroll
                for (int i = 0; i < 8; ++i) { acc[2 * i] += ws_ * __uint_as_float(wv[i] << 16); acc[2 * i + 1] += ws_ * __uint_as_float(wv[i] & 0xffff0000u); } } }
        v4u o0, o1; o0.x = pk2(acc[0], acc[1]); o0.y = pk2(acc[2], acc[3]); o0.z = pk2(acc[4], acc[5]); o0.w = pk2(acc[6], acc[7]); o1.x = pk2(acc[8], acc[9]); o1.y = pk2(acc[10], acc[11]); o1.z = pk2(acc[12], acc[13]); o1.w = pk2(acc[14], acc[15]);
        *(v4u*)(O + (size_t)m * D + h * 64 + qd * 16) = o0; *(v4u*)(O + (size_t)m * D + h * 64 + qd * 16 + 8) = o1;
    }
}


#ifdef DBG_CUT
__device__ __forceinline__ void dbg_copy(Frame& F, const void* src, bool is_bf16, float* out) {
    for (size_t i = (size_t)F.gw * 64 + F.lane; i < (size_t)M * D; i += (size_t)F.NGW * 64) out[i] = is_bf16 ? bf2f(((const bf16*)src)[i]) : ((const float*)src)[i];
}
#ifndef DBG_LAYER
#define DBG_LAYER -1
#endif
#define CUT(k, off, isbf) if (DBG_CUT == (k) && (DBG_LAYER < 0 || layer == DBG_LAYER)) { unsigned char* ws = WSB(); dbg_copy(F, ws + (off), (isbf), GOUT()); return; }
#else
#define CUT(k, off, isbf)
#endif
#ifndef REP_GEMM
#define REP_GEMM 1
#endif
#ifndef REP_THIN
#define REP_THIN 1
#endif
#ifndef REP_CONV
#define REP_CONV REP_THIN
#endif
#ifndef REP_LN
#define REP_LN REP_THIN
#endif
#ifndef REP_RW
#define REP_RW REP_THIN
#endif
#ifndef REP_ATTN
#define REP_ATTN 1
#endif
#ifndef REP_BAR
#define REP_BAR 1
#endif
#define GEMM_BIG(EpiT, SchedT) for (int rg_ = 0; rg_ < REP_GEMM; ++rg_) pg8::gemm_phase<EpiT, SchedT, true, true>
#define GEMM_ONE(EpiT, SchedT) for (int rg_ = 0; rg_ < REP_GEMM; ++rg_) pg8::gemm_phase<EpiT, SchedT, false, true>
__global__ void __launch_bounds__(NWAVES * 64, 2) fwd_kernel(Args args) {
    extern __shared__ __attribute__((aligned(16))) unsigned char lds[];
    Frame F;
    F.lds = (LAS unsigned char*)lds; F.MISC = (volatile LAS unsigned*)(F.lds + MISC_OFF);
    F.wave = __builtin_amdgcn_readfirstlane((int)threadIdx.x >> 6); F.lane = fresh_lane(); F.tid = F.wave * 64 + F.lane;
    F.G = gridDim.x; { const int bx = blockIdx.x; F.vcu = (F.G % 8 == 0) ? (bx % 8) * (F.G / 8) + bx / 8 : bx; }
    F.gw = F.vcu * NWAVES + F.wave; F.NGW = F.G * NWAVES;
    F.ws = args.ws; F.ctl = (gu32*)(args.ws + WS_CTL);
#ifdef DBG_LDSZERO
    for (int u = F.tid; u < LDS_BYTES / 4; u += NWAVES * 64) ((LAS unsigned*)(F.lds))[u] = 0u;
#else
    for (int u = F.tid; u < (LDS_BYTES - LDSCTL_OFF) / 4; u += NWAVES * 64) ((LAS unsigned*)(F.lds + LDSCTL_OFF))[u] = 0u;
#endif
    __syncthreads();
    XcdBarrier bar = xcd_barrier_post((unsigned*)(F.ctl + CW_BAR), F.MISC + 8, F.tid == 0);
#define GRID_BAR() do { { GAS unsigned* b_ = (GAS unsigned*)bar.bar; asm volatile("" : "+s"(b_), "+s"(bar.x)); bar.bar = (unsigned*)b_; } for (int rb_ = 0; rb_ < REP_BAR; ++rb_) xcd_barrier(bar, F.wave == 0 && fresh_lane() == 0); } while (0)
#define WSB() ({ F.lane = fresh_lane(); F.tid = F.wave * 64 + F.lane; asm volatile("" : "+s"(F.G), "+s"(F.wave), "+s"(F.vcu), "+s"(F.gw), "+s"(F.NGW), "+s"(bx)); GAS unsigned char* p_ = (GAS unsigned char*)args.ws; asm volatile("" : "+s"(p_)); (unsigned char*)p_; })
#define GOUT() ({ GAS float* o_ = (GAS float*)args.out; asm volatile("" : "+s"(o_)); (float*)o_; })
#define INP(i) ({ const __attribute__((address_space(4))) char* k_ = (const __attribute__((address_space(4))) char*)__builtin_amdgcn_kernarg_segment_ptr(); asm volatile("" : "+s"(k_)); const GAS float* g_ = (const GAS float*)(*(const float* const __attribute__((address_space(4)))*)(k_ + 8 * (i))); asm volatile("" : "+s"(g_)); (const float*)g_; })
    LAS unsigned char* ring = F.lds + RING_OFF;
    int bx = (int)blockIdx.x;

    for (int rt_ = 0; rt_ < REP_CONV; ++rt_) conv_rwkv(F, 0); for (int rt_ = 0; rt_ < REP_CONV; ++rt_) conv_dense(F, 0);
    GRID_BAR();

#ifndef LAYER_LO
#define LAYER_LO 0
#define LAYER_HI 4
#endif
    for (int layer = LAYER_LO; layer < LAYER_HI; ++layer) {
        const bool moe = (layer & 1) != 0; const int fe = layer >> 1;
        if (layer < 2) {
            const int l = layer;
            { unsigned char* ws = WSB(); for (int rt_ = 0; rt_ < REP_RW; ++rt_) mix_phase(F, layer == 0 ? INP(I_X) : (const float*)(ws + WS_H), INP(I_MU) + (size_t)l * 6 * D, (bf16*)(ws + RS_XM)); }
            GRID_BAR();
            { unsigned char* ws = WSB(); pg8::Gemm g{D, D, D}; pg8::SchedStd S; S.init(M, 4096, F.G, bx, ws + RS_XM, D, ws + WM_BT1 + (size_t)l * RW_LSTRIDE, D, 1, (size_t)M * D * 2);
              pg8::EpiRkv E{(bf16*)(ws + RS_RKV), (long)RS_LH - (long)RS_RKV, (size_t)M * D};
              GEMM_BIG(pg8::EpiRkv, pg8::SchedStd)(ring, g, S, E, F.wave); }
            GRID_BAR();
            CUT(1, RS_RKV, true)
            { unsigned char* ws = WSB(); pg8::Gemm g{256, D, 256}; pg8::SchedStd S; S.init(M, 4096, F.G, bx, ws + RS_LH, D, ws + WM_BT2 + (size_t)l * RW_LSTRIDE, 256, 2, 0);
              pg8::EpiLoraUpAll E{{(void*)(ws + RS_DEC), INP(I_W0) + (size_t)l * D}, {(void*)(ws + RS_AB), INP(I_A0) + (size_t)l * D}, {(void*)(ws + RS_VG), INP(I_V0)}, {(void*)(ws + RS_GG), nullptr}};
              GEMM_BIG(pg8::EpiLoraUpAll, pg8::SchedStd)(ring, g, S, E, F.wave); }
            GRID_BAR();
            CUT(2, RS_DEC, false) CUT(60, RS_VG, true) CUT(61, RS_GG, true) CUT(62, RS_LH, true) CUT(63, RS_AB, false)
            { unsigned char* ws = WSB(); for (int rt_ = 0; rt_ < REP_RW; ++rt_) prep_phase(F, l, (bf16*)(ws + RS_RKV), (const float*)(ws + RS_AB), (bf16*)(ws + RS_LH), INP(I_V0), INP(I_V2), (bf16*)(ws + WS_VFIRST), INP(I_KK) + (size_t)l * D, INP(I_KA) + (size_t)l * D,
                                                   (bf16*)(ws + RS_KP), (bf16*)(ws + RS_AP), (bf16*)(ws + RS_BP), (bf16*)(ws + RS_VP)); }
            GRID_BAR();
            CUT(3, RS_KP, true) CUT(7, RS_VP, true) CUT(8, RS_BP, true) CUT(9, RS_DEC, false)
#ifndef NO_SCAN
#ifndef REP_SCAN
#define REP_SCAN 1
#endif
            for (int rep_ = 0; rep_ < REP_SCAN; ++rep_) {
              { unsigned char* ws = WSB(); scan_phase(F, (bf16*)(ws + RS_RKV), (float*)(ws + RS_DEC), (bf16*)(ws + RS_KP), (bf16*)(ws + RS_AP), (bf16*)(ws + RS_BP), (bf16*)(ws + RS_VP), (bf16*)(ws + WS_Y)); }
              if (rep_ + 1 < REP_SCAN) GRID_BAR(); }
#endif
            GRID_BAR();
            CUT(4, WS_Y, true)
            { unsigned char* ws = WSB(); for (int rt_ = 0; rt_ < REP_RW; ++rt_) post_phase(F, (bf16*)(ws + WS_Y), (bf16*)(ws + RS_RKV), (bf16*)(ws + RS_KP), (bf16*)(ws + RS_VP), (bf16*)(ws + RS_GG),
                                                   INP(I_RK) + (size_t)l * D, INP(I_GNG) + (size_t)l * D, INP(I_GNB) + (size_t)l * D, (bf16*)(ws + RS_YG)); }
            GRID_BAR();
            CUT(5, RS_YG, true)
            { unsigned char* ws = WSB(); pg8::Gemm g{D, D, D}; pg8::SchedStd S; S.init(M, D, F.G, bx, ws + RS_YG, D, ws + WM_OUT + (size_t)l * RW_LSTRIDE, D);
              pg8::EpiResF32 E{layer == 0 ? INP(I_X) : (const float*)(ws + WS_H), (float*)(ws + RS_PRE), ALPHA};
              GEMM_ONE(pg8::EpiResF32, pg8::SchedStd)(ring, g, S, E, F.wave); }
            GRID_BAR();
            CUT(6, RS_PRE, false)
        } else {
            const int j = layer - 2;
            { unsigned char* ws = WSB(); pg8::Gemm g{D, D, D}; pg8::SchedStd S; S.init(M, j == 0 ? 3 * D : D, F.G, bx, ws + WS_HB, D, ws + WM_QKV, D);
              pg8::EpiQKV E{(bf16*)(ws + BS_Q), ((long)WS_K - (long)BS_Q) / 2, ((long)WS_V - (long)BS_Q) / 2, attn_body::C2};
              GEMM_BIG(pg8::EpiQKV, pg8::SchedStd)(ring, g, S, E, F.wave); }
            GRID_BAR();
            CUT(31, BS_Q, true) CUT(32, WS_K, true) CUT(33, WS_V, true)
            if (j == 0) { unsigned char* ws = WSB(); for (int rt_ = 0; rt_ < REP_THIN; ++rt_) kmean_phase(F, (bf16*)(ws + WS_K), (float*)(ws + WS_KMEAN)); GRID_BAR(); }
#ifndef NO_GATE
            { unsigned char* ws = WSB(); for (int rt_ = 0; rt_ < REP_THIN; ++rt_) gate_phase(F, (bf16*)(ws + BS_Q), (float*)(ws + WS_KMEAN), (unsigned*)(ws + WS_SEL)); }
#endif
            GRID_BAR();
#ifdef DBG_CUT
            if (DBG_CUT == 35) { unsigned char* ws = WSB(); const unsigned* s_ = (const unsigned*)(ws + WS_SEL); for (size_t i = (size_t)F.gw * 64 + F.lane; i < (size_t)M * D; i += (size_t)F.NGW * 64) args.out[i] = (float)(s_[i & (size_t)(M * 16 - 1)] % 65521u); return; }
#endif
#ifdef ATTN_DIRECT
            { unsigned char* ws = WSB(); attn_direct_phase(F, (const bf16*)(ws + BS_Q), (const bf16*)(ws + WS_K), (const bf16*)(ws + WS_V), (const unsigned*)(ws + WS_SEL), (bf16*)(ws + BS_O)); }
            GRID_BAR();
#else
            { unsigned char* ws = WSB(); for (int ra_ = 0; ra_ < REP_ATTN; ++ra_) moba_attn_phase(F, (const bf16*)(ws + BS_Q), (const bf16*)(ws + WS_K), (const bf16*)(ws + WS_V), (const unsigned*)(ws + WS_SEL), (bf16*)(ws + BS_PO), (float*)(ws + BS_ML), F.ctl + CW_QCTR + 64 * (j + 2 * ra_)); }
            GRID_BAR();
            { unsigned char* ws = WSB(); for (int rt_ = 0; rt_ < REP_THIN; ++rt_) moba_combine_phase(F, (const unsigned*)(ws + WS_SEL), (const bf16*)(ws + BS_PO), (const float*)(ws + BS_ML), (bf16*)(ws + BS_O)); }
            GRID_BAR();
#endif
            CUT(36, BS_O, true)
#ifdef DBG_CUT
            if (DBG_CUT == 37 && (DBG_LAYER < 0 || layer == DBG_LAYER)) {
                { unsigned char* ws = WSB(); attn_direct_phase(F, (const bf16*)(ws + BS_Q), (const bf16*)(ws + WS_K), (const bf16*)(ws + WS_V), (const unsigned*)(ws + WS_SEL), (bf16*)(ws + BS_PRE)); }
                GRID_BAR();
                { unsigned char* ws = WSB(); const bf16* a_ = (const bf16*)(ws + BS_O); const bf16* b_ = (const bf16*)(ws + BS_PRE); float* o_ = GOUT();
                  for (size_t i = (size_t)F.gw * 64 + F.lane; i < (size_t)M * D; i += (size_t)F.NGW * 64) o_[i] = 1000.f * (bf2f(a_[i]) - bf2f(b_[i])); }
                return; }
#endif
            { unsigned char* ws = WSB(); pg8::Gemm g{D, D, D}; pg8::SchedStd S; S.init(M, D, F.G, bx, ws + BS_O, D, ws + WM_O, D);
              pg8::EpiResF32 E{(const float*)(ws + WS_H), (float*)(ws + BS_PRE), ALPHA};
              GEMM_ONE(pg8::EpiResF32, pg8::SchedStd)(ring, g, S, E, F.wave); }
            GRID_BAR();
        }
        { unsigned char* ws = WSB(); const float* PREm = (const float*)(ws + (layer < 2 ? RS_PRE : BS_PRE));
          const float* g0 = INP(I_LNG) + (size_t)(layer * 2) * D; const float* b0 = INP(I_LNB) + (size_t)(layer * 2) * D;
          if (moe) for (int rt_ = 0; rt_ < REP_LN; ++rt_) ln_phase<0, true>(F, PREm, nullptr, nullptr, nullptr, g0, b0, (float*)(ws + WS_H), (bf16*)(ws + WS_HB), INP(I_ROUTER) + (size_t)fe * D * NE, (int*)(ws + WS_TOKE), (float*)(ws + WS_TOKW), (int*)(ws + WS_BLKCNT));
          else for (int rt_ = 0; rt_ < REP_LN; ++rt_) ln_phase<0, false>(F, PREm, nullptr, nullptr, nullptr, g0, b0, (float*)(ws + WS_H), (bf16*)(ws + WS_HB), nullptr, nullptr, nullptr, nullptr); }
        if (layer == 0) for (int rt_ = 0; rt_ < REP_CONV; ++rt_) conv_rwkv(F, 1); else if (layer == 1) for (int rt_ = 0; rt_ < REP_CONV; ++rt_) conv_moba(F, 0); else if (layer == 2) for (int rt_ = 0; rt_ < REP_CONV; ++rt_) conv_moba(F, 1);
        GRID_BAR();
        CUT(10 + layer, WS_H, false)
        if (!moe) {
            { unsigned char* ws = WSB(); pg8::Gemm g{D, D, D}; pg8::SchedStd S; S.init(M, 2 * FF, F.G, bx, ws + WS_HB, D, ws + WF_GU, D);
              pg8::EpiSwiGLU E{(bf16*)(ws + FS_HID), FF, 1.0f};
              GEMM_BIG(pg8::EpiSwiGLU, pg8::SchedStd)(ring, g, S, E, F.wave); }
            GRID_BAR();
            { unsigned char* ws = WSB(); pg8::Gemm g{FF, FF, FF}; pg8::SchedStd S; S.init(M, D, F.G, bx, ws + FS_HID, FF, ws + WF_DN, FF);
              pg8::EpiResF32 E{(const float*)(ws + WS_H), (float*)(ws + FS_PRE), ALPHA};
              GEMM_ONE(pg8::EpiResF32, pg8::SchedStd)(ring, g, S, E, F.wave); }
            GRID_BAR();
            { unsigned char* ws = WSB(); const float* g1 = INP(I_LNG) + (size_t)(layer * 2 + 1) * D; const float* b1 = INP(I_LNB) + (size_t)(layer * 2 + 1) * D;
              for (int rt_ = 0; rt_ < REP_LN; ++rt_) ln_phase<0, false>(F, (const float*)(ws + FS_PRE), nullptr, nullptr, nullptr, g1, b1, (float*)(ws + WS_H), (bf16*)(ws + WS_HB), nullptr, nullptr, nullptr, nullptr); }
            for (int rt_ = 0; rt_ < REP_CONV; ++rt_) conv_moe(F, fe);
            GRID_BAR();
        } else {
            { unsigned char* ws = WSB(); for (int rt_ = 0; rt_ < REP_THIN; ++rt_) moe_gather_phase(F, (const int*)(ws + WS_BLKCNT), (const int*)(ws + WS_TOKE), (const float*)(ws + WS_TOKW), (int*)(ws + WS_TOKR), (float*)(ws + WS_GW), (const float*)(ws + WS_H), (unsigned char*)(ws + ES_XG)); }
            GRID_BAR();
            { unsigned char* ws = WSB(); const LAS int* pp = (const LAS int*)(F.lds + MISC_OFF + 64);
              pg8::Gemm g{D / 2, D / 2, D / 2};
              pg8::SchedMoe S{2 * FFE / 256, F.G, bx, pp, (const char*)(ws + ES_XG), (const char*)(ws + WE_GU), (size_t)256 * D, (size_t)256 * D, (size_t)2 * FFE * D};
              pg8::EpiSwiGLU E{(bf16*)(ws + ES_HID), FFE, 1.0f / MOE_WSCALE};
              for (int rg_ = 0; rg_ < REP_GEMM; ++rg_) pg8::gemm_phase<pg8::EpiSwiGLU, pg8::SchedMoe, true, true, true>(ring, g, S, E, F.wave); }
            GRID_BAR();
            { unsigned char* ws = WSB(); const LAS int* pp = (const LAS int*)(F.lds + MISC_OFF + 64);
              pg8::Gemm g{FFE, FFE, FFE}; pg8::SchedMoe S{D / 256, F.G, bx, pp, (const char*)(ws + ES_HID), (const char*)(ws + WE_DN), (size_t)256 * FFE * 2, (size_t)256 * FFE * 2, (size_t)D * FFE * 2};
              pg8::EpiMoeDown E{(float*)(ws + ES_YP), (const float*)(ws + WS_GW)};
              GEMM_BIG(pg8::EpiMoeDown, pg8::SchedMoe)(ring, g, S, E, F.wave); }
            GRID_BAR();
            { unsigned char* ws = WSB(); const float* g1 = INP(I_LNG) + (size_t)(layer * 2 + 1) * D; const float* b1 = INP(I_LNB) + (size_t)(layer * 2 + 1) * D;
              if (layer == 3) ln_phase<1, false>(F, nullptr, (const float*)(ws + WS_H), (const float*)(ws + ES_YP), (const int*)(ws + WS_TOKR), g1, b1, GOUT(), nullptr, nullptr, nullptr, nullptr, nullptr);
              else ln_phase<1, false>(F, nullptr, (const float*)(ws + WS_H), (const float*)(ws + ES_YP), (const int*)(ws + WS_TOKR), g1, b1, (float*)(ws + WS_H), (bf16*)(ws + WS_HB), nullptr, nullptr, nullptr, nullptr); }
            if (layer == 1) for (int rt_ = 0; rt_ < REP_CONV; ++rt_) conv_dense(F, 1);
            GRID_BAR();
        }
        CUT(20 + layer, WS_H, false)
        CUT(40 + layer, WS_HB, true)
#ifdef DBG_CUT
        if (DBG_CUT == 50 + layer) { unsigned char* ws = WSB(); const bf16* s_ = (const bf16*)(ws + WS_WMIX); float* o_ = GOUT(); for (size_t i = (size_t)F.gw * 64 + F.lane; i < (size_t)M * D; i += (size_t)F.NGW * 64) o_[i] = i < (size_t)6 * 1024 * 1024 ? bf2f(s_[i]) : 0.f; return; }
#endif
    }
}

extern "C" void kernel_launch(void* const* d_in, const int* in_sizes, int n_in, void* d_out, int out_size, void* d_ws, size_t ws_size, hipStream_t stream) {
    static int grid = 0;
    if (grid == 0) {
        if (n_in != 33 || in_sizes[0] != M * D || out_size != M * D || ws_size < WS_END) { fprintf(stderr, "kernel_launch: unexpected problem shape (n_in %d, in0 %d, out %d, ws %zu); nothing launched\n", n_in, n_in > 0 ? in_sizes[0] : -1, out_size, ws_size); grid = -1; return; }
        int dev = 0, cus = 0, per_cu = 0;
        if (hipGetDevice(&dev) != hipSuccess || hipDeviceGetAttribute(&cus, hipDeviceAttributeMultiprocessorCount, dev) != hipSuccess) { grid = -1; return; }
        if (hipFuncSetAttribute((const void*)fwd_kernel, hipFuncAttributeMaxDynamicSharedMemorySize, LDS_BYTES) != hipSuccess) { fprintf(stderr, "kernel_launch: hipFuncSetAttribute failed\n"); grid = -1; return; }
        if (hipOccupancyMaxActiveBlocksPerMultiprocessor(&per_cu, (const void*)fwd_kernel, NWAVES * 64, LDS_BYTES) != hipSuccess || per_cu < 1) { fprintf(stderr, "kernel_launch: occupancy query reports %d workgroups per CU\n", per_cu); }
        (void)hipGetLastError();
        grid = cus;
        if (grid != 256) { fprintf(stderr, "kernel_launch: built for 256 CUs, device has %d; nothing launched\n", cus); grid = -1; return; }
    }
    if (grid < 0) return;
    if (hipMemsetAsync((char*)d_ws + WS_CTL, 0, CTL_ZERO_BYTES, stream) != hipSuccess) return;
#ifdef DBG_FILL
    (void)hipMemsetAsync((char*)d_ws + CTL_ZERO_BYTES, DBG_FILL, WS_END - CTL_ZERO_BYTES, stream);
#endif
    Args a{};
    for (int i = 0; i < 33; ++i) a.in[i] = (const float*)d_in[i];
    a.out = (float*)d_out; a.ws = (unsigned char*)d_ws;
    hipLaunchKernelGGL(fwd_kernel, dim3(grid), dim3(NWAVES * 64), LDS_BYTES, stream, a);
}
```

```cpp
#include <hip/hip_runtime.h>
#include <cstdio>
#include <cstdint>
#include <hip/hip_bf16.h>
#include <cmath>
__device__ __forceinline__ int fresh_lane() { int l; asm volatile("v_mbcnt_lo_u32_b32 %0, -1, 0\n\tv_mbcnt_hi_u32_b32 %0, -1, %0" : "=v"(l)); return l; }
namespace pg8 {
#define PG8_LAS __attribute__((address_space(3)))
typedef unsigned short bf16_t;
typedef short bf16x8 __attribute__((ext_vector_type(8)));
typedef float f32x4 __attribute__((ext_vector_type(4)));
typedef unsigned u32x4 __attribute__((ext_vector_type(4)));
constexpr int BM = 256, BK = 64, HALF = 128, HTB = HALF * BK * 2  , STAGE_BYTES = 8 * HTB, NXCD = 8, WGM = 8;

__host__ __device__ __forceinline__ int lds_byte(int r, int c) { const int st = (r >> 4) * 2 + (c >> 5), rr = r & 15, cc = c & 31, ob = rr * 64 + cc * 2; return st * 1024 + (ob ^ (((ob >> 9) & 1) << 5)); }
__host__ __device__ __forceinline__ void stage_rc(int b, int& R, int& C) { const int st = b / 1024, sb = b % 1024, swz = sb ^ (((sb >> 9) & 1) << 5); R = (st >> 1) * 16 + swz / 64; C = (st & 1) * 32 + (swz % 64) / 2; }
__host__ __device__ __forceinline__ int perm32(int rho) { const int n = rho >> 4, i = rho & 15; return 8 * (i >> 2) + 4 * n + (i & 3); }

struct Unit { int pm, pn, e; };
struct Gemm { int K, lda, ldb; };

__device__ __forceinline__ unsigned cvt_pk_bf16(float lo, float hi) { unsigned r; asm volatile("v_cvt_pk_bf16_f32 %0, %1, %2" : "=v"(r) : "v"(lo), "v"(hi)); return r; }
__device__ __forceinline__ float fsigmoid(float x) { return __builtin_amdgcn_rcpf(1.0f + __expf(-x)); }
__device__ __forceinline__ float ftanh(float x) { return 1.0f - 2.0f * __builtin_amdgcn_rcpf(1.0f + __expf(2.0f * x)); }

struct SchedStd {
    int nM, nN, nwg, G, c, amode; const char* A; const char* B; size_t atile, btile, ag;
    __device__ __forceinline__ void init(int M, int N, int G_, int c_, const void* A_, size_t lda, const void* B_, size_t ldb, int amode_ = 0, size_t ag_ = 0) {
        nM = M / BM; nN = N / BM; nwg = nM * nN; G = G_; c = c_; A = (const char*)A_; B = (const char*)B_; atile = (size_t)BM * lda * 2; btile = (size_t)BM * ldb * 2; amode = amode_; ag = ag_; }
    __device__ __forceinline__ bool next(int i, Unit& u) const {
        const long L = (long)i * G + c; if (L >= nwg) return false;
        int wgid = (int)L; { const int q = nwg / NXCD, r = nwg % NXCD, xcd = wgid % NXCD, off = wgid / NXCD; wgid = (xcd < r ? xcd * (q + 1) : r * (q + 1) + (xcd - r) * q) + off; }
        const int nig = WGM * nN, gid = wgid / nig, fm = gid * WGM, gsz = (nM - fm) < WGM ? (nM - fm) : WGM;
        u.pm = fm + ((wgid % nig) % gsz); u.pn = (wgid % nig) / gsz; u.e = 0; return true;
    }
    __device__ __forceinline__ const char* abase(const Unit& u) const {
        size_t off = (size_t)u.pm * atile;
        if (amode == 1) { const int gs = u.pn < 12 ? (u.pn >> 2) : (u.pn == 12 ? 3 : (u.pn == 13 ? 4 : (u.pn == 14 ? 2 : 5))); off += (size_t)gs * ag; }
        else if (amode == 2) off += (size_t)(u.pn >> 2) * 512;
        return A + off; }
    __device__ __forceinline__ const char* bbase(const Unit& u) const { return B + (size_t)u.pn * btile; }
    __device__ __forceinline__ void a_ready(const Unit&) const {}
    __device__ __forceinline__ void done(const Unit&) const {}
};
struct SchedMoe {
    int nN, G, c; const PG8_LAS int* pp; const char* A; const char* B; size_t atile, btile, bexp; int cap;
    __device__ __forceinline__ bool next(int i, Unit& u) const {
        const int L = i * G + c; int tot = pp[8] * nN; if (cap && tot > cap) tot = cap; if (L >= tot) return false;
        const int pm = L / nN; u.pm = pm; u.pn = L - pm * nN; int e = 0;
#pragma unroll
        for (int k = 1; k < 8; ++k) e += (pm >= pp[k]) ? 1 : 0;
        u.e = __builtin_amdgcn_readfirstlane(e); return true; }
    __device__ __forceinline__ const char* abase(const Unit& u) const { return A + (size_t)u.pm * atile; }
    __device__ __forceinline__ const char* bbase(const Unit& u) const { return B + (size_t)u.e * bexp + (size_t)u.pn * btile; }
    __device__ __forceinline__ void a_ready(const Unit&) const {}
    __device__ __forceinline__ void done(const Unit&) const {}
};

struct SchedMoeTail {
    int nN, G, c, first, NS; const PG8_LAS int* pp; const char* A; const char* B; size_t atile, btile, bexp, kslice;
    __device__ __forceinline__ bool next(int i, Unit& u) const {
        if (i > 0) return false;
        const int L = first + c / NS, tot = pp[8] * nN; if (L >= tot) return false;
        const int pm = L / nN; u.pm = pm; u.pn = L - pm * nN; int e = 0;
#pragma unroll
        for (int k = 1; k < 8; ++k) e += (pm >= pp[k]) ? 1 : 0;
        u.e = __builtin_amdgcn_readfirstlane(e); return true; }
    __device__ __forceinline__ const char* abase(const Unit& u) const { return A + (size_t)u.pm * atile + (size_t)(c % NS) * kslice; }
    __device__ __forceinline__ const char* bbase(const Unit& u) const { return B + (size_t)u.e * bexp + (size_t)u.pn * btile + (size_t)(c % NS) * kslice; }
    __device__ __forceinline__ void a_ready(const Unit&) const {}
    __device__ __forceinline__ void done(const Unit&) const {}
};
#define PG8_PACK8(w, v0, v1) do { w.x = cvt_pk_bf16(v0[0], v0[1]); w.y = cvt_pk_bf16(v0[2], v0[3]); w.z = cvt_pk_bf16(v1[0], v1[1]); w.w = cvt_pk_bf16(v1[2], v1[3]); } while (0)

struct EpiQKV {
    static constexpr bool PERM = true, AFTER_DRAIN = false;
    bf16_t* O0; long d1, d2; float s0;
    __device__ __forceinline__ void operator()(const f32x4 (&acc)[2][2][4][2], const Unit& u, int wr, int wc, int fr, int fq) const {
        const int t = u.pn >> 2; bf16_t* base = O0 + (long)(t == 1) * d1 + (long)(t == 2) * d2; const float sc = t == 0 ? s0 : 1.0f;
        const int row0 = u.pm * BM + wr * 64 + fr, col0 = (u.pn & 3) * BM + wc * 32 + 8 * fq;
#pragma unroll
        for (int ai = 0; ai < 2; ++ai)
#pragma unroll
            for (int m = 0; m < 4; ++m) { bf16_t* rowp = base + (size_t)(row0 + ai * HALF + m * 16) * 1024 + col0;
#pragma unroll
                for (int bj = 0; bj < 2; ++bj) { const f32x4 v0 = acc[ai][bj][m][0] * sc, v1 = acc[ai][bj][m][1] * sc; u32x4 w; PG8_PACK8(w, v0, v1); *(u32x4*)(rowp + bj * HALF) = w; } }
    }
};
struct EpiRkv {
    static constexpr bool PERM = true, AFTER_DRAIN = false;
    bf16_t* RKV; long dLH; size_t mstride;
    __device__ __forceinline__ void operator()(const f32x4 (&acc)[2][2][4][2], const Unit& u, int wr, int wc, int fr, int fq) const {
        const int pn = u.pn; const bool lora = pn >= 12;
        bf16_t* base = (bf16_t*)((char*)RKV + (lora ? dLH : (long)((size_t)(pn >> 2) * mstride * 2))); const int colt = lora ? (pn - 12) * BM : (pn & 3) * BM;
        const int row0 = u.pm * BM + wr * 64 + fr, col0 = colt + wc * 32 + 8 * fq;
#pragma unroll
        for (int ai = 0; ai < 2; ++ai)
#pragma unroll
            for (int m = 0; m < 4; ++m) { bf16_t* rowp = base + (size_t)(row0 + ai * HALF + m * 16) * 1024 + col0;
#pragma unroll
                for (int bj = 0; bj < 2; ++bj) { f32x4 v0 = acc[ai][bj][m][0], v1 = acc[ai][bj][m][1];
                    if (pn == 12) {
#pragma unroll
                        for (int i = 0; i < 4; ++i) { v0[i] = ftanh(v0[i]); v1[i] = ftanh(v1[i]); } }
                    else if (pn == 15) {
#pragma unroll
                        for (int i = 0; i < 4; ++i) { v0[i] = fsigmoid(v0[i]); v1[i] = fsigmoid(v1[i]); } }
                    u32x4 w; PG8_PACK8(w, v0, v1); *(u32x4*)(rowp + bj * HALF) = w; } }
    }
};
template <int GRP> struct EpiLoraUp {
    static constexpr bool PERM = true, AFTER_DRAIN = false;
    void* O; const float* bias;
    __device__ __forceinline__ void operator()(const f32x4 (&acc)[2][2][4][2], const Unit& u, int wr, int wc, int fr, int fq) const {
        const int row0 = u.pm * BM + wr * 64 + fr, col0 = u.pn * BM + wc * 32 + 8 * fq;
#pragma unroll
        for (int bj = 0; bj < 2; ++bj) {
            f32x4 bv0 = (f32x4){0.f, 0.f, 0.f, 0.f}, bv1 = bv0;
            if (GRP < 3) { bv0 = *(const f32x4*)(bias + col0 + bj * HALF); bv1 = *(const f32x4*)(bias + col0 + bj * HALF + 4); }
#pragma unroll
            for (int ai = 0; ai < 2; ++ai)
#pragma unroll
                for (int m = 0; m < 4; ++m) { const size_t ro = (size_t)(row0 + ai * HALF + m * 16) * 1024 + col0 + bj * HALF;
                    f32x4 v0_ = acc[ai][bj][m][0] + bv0, v1_ = acc[ai][bj][m][1] + bv1;
                    if (GRP == 0) {
#pragma unroll
                        for (int i = 0; i < 4; ++i) { v0_[i] = __expf(-0.6065306597f * fsigmoid(v0_[i])); v1_[i] = __expf(-0.6065306597f * fsigmoid(v1_[i])); }
                    } else if (GRP < 3) {
#pragma unroll
                        for (int i = 0; i < 4; ++i) { v0_[i] = fsigmoid(v0_[i]); v1_[i] = fsigmoid(v1_[i]); }
                    }
                    if (GRP < 2) { *(f32x4*)((float*)O + ro) = v0_; *(f32x4*)((float*)O + ro + 4) = v1_; }
                    else { u32x4 w; PG8_PACK8(w, v0_, v1_); *(u32x4*)((bf16_t*)O + ro) = w; } }
        }
    }
};
struct EpiLoraUpAll {
    static constexpr bool PERM = true, AFTER_DRAIN = false;
    EpiLoraUp<0> e0; EpiLoraUp<1> e1; EpiLoraUp<2> e2; EpiLoraUp<3> e3;
    __device__ __forceinline__ void operator()(const f32x4 (&acc)[2][2][4][2], const Unit& u, int wr, int wc, int fr, int fq) const {
        Unit v = u; v.pn = u.pn & 3; const int g = u.pn >> 2;
        if (g == 0) e0(acc, v, wr, wc, fr, fq); else if (g == 1) e1(acc, v, wr, wc, fr, fq); else if (g == 2) e2(acc, v, wr, wc, fr, fq); else e3(acc, v, wr, wc, fr, fq);
    }
};
struct EpiResF32 {
    static constexpr bool PERM = false, AFTER_DRAIN = false;
    const float* base; float* out; float alpha;
    __device__ __forceinline__ void operator()(const f32x4 (&acc)[2][2][4][2], const Unit& u, int wr, int wc, int fr, int fq) const {
        const int row0 = u.pm * BM + wr * 64 + fr, col0 = u.pn * BM + wc * 32 + 4 * fq;
#pragma unroll
        for (int ai = 0; ai < 2; ++ai)
#pragma unroll
            for (int m = 0; m < 4; ++m) { const size_t ro = (size_t)(row0 + ai * HALF + m * 16) * 1024 + col0;
#pragma unroll
                for (int bj = 0; bj < 2; ++bj)
#pragma unroll
                    for (int n = 0; n < 2; ++n) { const f32x4 b = *(const f32x4*)(base + ro + bj * HALF + n * 16); *(f32x4*)(out + ro + bj * HALF + n * 16) = b * alpha + acc[ai][bj][m][n]; } }
    }
};
struct EpiSwiGLU {
    static constexpr bool PERM = true, AFTER_DRAIN = false;
    bf16_t* Hd; int ldh; float sc;
    __device__ __forceinline__ void operator()(const f32x4 (&acc)[2][2][4][2], const Unit& u, int wr, int wc, int fr, int fq) const {
        const int row0 = u.pm * BM + wr * 64 + fr, col0 = u.pn * HALF + wc * 32 + 8 * fq;
#pragma unroll
        for (int ai = 0; ai < 2; ++ai)
#pragma unroll
            for (int m = 0; m < 4; ++m) { bf16_t* rowp = Hd + (size_t)(row0 + ai * HALF + m * 16) * ldh + col0;
                f32x4 v0, v1;
#pragma unroll
                for (int i = 0; i < 4; ++i) { const float g0 = acc[ai][0][m][0][i] * sc, g1 = acc[ai][0][m][1][i] * sc;
                    v0[i] = g0 * fsigmoid(g0) * (acc[ai][1][m][0][i] * sc); v1[i] = g1 * fsigmoid(g1) * (acc[ai][1][m][1][i] * sc); }
                u32x4 w; PG8_PACK8(w, v0, v1); *(u32x4*)rowp = w; }
    }
};
struct EpiMoeDown {
    static constexpr bool PERM = false, AFTER_DRAIN = false;
    float* YP; const float* gw;
    __device__ __forceinline__ void operator()(const f32x4 (&acc)[2][2][4][2], const Unit& u, int wr, int wc, int fr, int fq) const {
        const int row0 = u.pm * BM + wr * 64 + fr, col0 = u.pn * BM + wc * 32 + 4 * fq;
#pragma unroll
        for (int ai = 0; ai < 2; ++ai)
#pragma unroll
            for (int m = 0; m < 4; ++m) { const int row = row0 + ai * HALF + m * 16; const float s = gw[row]; const size_t ro = (size_t)row * 1024 + col0;
#pragma unroll
                for (int bj = 0; bj < 2; ++bj)
#pragma unroll
                    for (int n = 0; n < 2; ++n) *(f32x4*)(YP + ro + bj * HALF + n * 16) = acc[ai][bj][m][n] * s; }
    }
};

struct EpiMoeDownSlab {
    static constexpr bool PERM = false, AFTER_DRAIN = false;
    float* YS; const float* gw; int c, NS;
    __device__ __forceinline__ void operator()(const f32x4 (&acc)[2][2][4][2], const Unit& u, int wr, int wc, int fr, int fq) const {
        const int row0 = u.pm * BM + wr * 64 + fr, col0 = u.pn * BM + wc * 32 + 4 * fq; float* slab = YS + (size_t)(c % NS) * 2048 * 1024;
#pragma unroll
        for (int ai = 0; ai < 2; ++ai)
#pragma unroll
            for (int m = 0; m < 4; ++m) { const int row = row0 + ai * HALF + m * 16; const float s = gw[row]; const size_t ro = (size_t)(row - 32768) * 1024 + col0;
#pragma unroll
                for (int bj = 0; bj < 2; ++bj)
#pragma unroll
                    for (int n = 0; n < 2; ++n) *(f32x4*)(slab + ro + bj * HALF + n * 16) = acc[ai][bj][m][n] * s; }
    }
};
template <class Epi, class Sched, bool ALIGN_EPI = false, bool SP2 = false, bool F8 = false>
__device__ __forceinline__ void gemm_phase(PG8_LAS unsigned char* lds, const Gemm g, const Sched& S, const Epi& E, int wave) {
    const int lane = fresh_lane(), wid = wave, tid = wid * 64 + lane, wr = wid >> 2, wc = wid & 3, fr = lane & 15, fq = lane >> 4;
    const int K = g.K, nt = K / BK;
    unsigned voffA[2], voffB[2];
#pragma unroll
    for (int i = 0; i < 2; ++i) { int R, C; stage_rc(tid * 16 + i * 8192, R, C); const int Rb = Epi::PERM ? ((R & ~31) + perm32(R & 31)) : R;
        voffA[i] = (unsigned)(R * g.lda + C) * 2u; voffB[i] = (unsigned)(Rb * g.ldb + C) * 2u; }
    const size_t kstep = (size_t)(BK * 2);
    const size_t hsA = (size_t)HALF * g.lda * 2, hsB = (size_t)HALF * g.ldb * 2;
    const unsigned ldsw = (unsigned)wid * 1024u;
    const int aoff = lds_byte(wr * 64 + fr, fq * 8), boff = lds_byte(wc * 32 + fr, fq * 8);
#define PG8_SA(b, h) (((b) * 2 + (h)) * HTB)
#define PG8_SB(b, h) ((4 + (b) * 2 + (h)) * HTB)
#define PG8_STAGE(bufoff, gbase, voff) do { _Pragma("unroll") for (int _i = 0; _i < 2; ++_i) \
        __builtin_amdgcn_global_load_lds((const unsigned*)((const char*)(gbase) + (voff)[_i]), (PG8_LAS unsigned*)(lds + (bufoff) + ldsw + _i * 8192), 16, 0, 0); } while (0)
#define PG8_LDA(dst, b, h) do { _Pragma("unroll") for (int m = 0; m < 4; ++m) { const i32x4_ lo_ = *(const PG8_LAS i32x4_*)(lds + PG8_SA(b, h) + aoff + m * 2048), hi_ = *(const PG8_LAS i32x4_*)(lds + PG8_SA(b, h) + aoff + m * 2048 + 1024); \
        if constexpr (F8) dst##8[m] = __builtin_shufflevector(lo_, hi_, 0, 1, 2, 3, 4, 5, 6, 7); else { dst[m][0] = __builtin_bit_cast(bf16x8, lo_); dst[m][1] = __builtin_bit_cast(bf16x8, hi_); } } } while (0)
#define PG8_LDB(dst, b, h) do { _Pragma("unroll") for (int n = 0; n < 2; ++n) { const i32x4_ lo_ = *(const PG8_LAS i32x4_*)(lds + PG8_SB(b, h) + boff + n * 2048), hi_ = *(const PG8_LAS i32x4_*)(lds + PG8_SB(b, h) + boff + n * 2048 + 1024); \
        if constexpr (F8) dst##8[n] = __builtin_shufflevector(lo_, hi_, 0, 1, 2, 3, 4, 5, 6, 7); else { dst[n][0] = __builtin_bit_cast(bf16x8, lo_); dst[n][1] = __builtin_bit_cast(bf16x8, hi_); } } } while (0)
#define PG8_MMA(ai, bj, At, Bt) do { __builtin_amdgcn_s_setprio(1); _Pragma("unroll") for (int m = 0; m < 4; ++m) _Pragma("unroll") for (int n = 0; n < 2; ++n) { \
        if constexpr (F8) asm volatile("v_mfma_scale_f32_16x16x128_f8f6f4 %0, %1, %2, %0, %3, %3 op_sel_hi:[0,0,0]" : "+v"(acc[ai][bj][m][n]) : "v"(Bt##8[n]), "v"(At##8[m]), "v"(f8scale));   \
        else { _Pragma("unroll") for (int k = 0; k < 2; ++k) acc[ai][bj][m][n] = __builtin_amdgcn_mfma_f32_16x16x32_bf16(Bt[n][k], At[m][k], acc[ai][bj][m][n], 0, 0, 0); } } \
        __builtin_amdgcn_s_setprio(0); } while (0)
#define PG8_WAIT_V(n) asm volatile("s_waitcnt vmcnt(" #n ")" ::: "memory")
#define PG8_WAIT_L(n) asm volatile("s_waitcnt lgkmcnt(" #n ")" ::: "memory")
#define PG8_BAR __builtin_amdgcn_s_barrier()
#define PG8_SCHED __builtin_amdgcn_sched_barrier(0)
    Unit cur, nxt; int ui = 0;
    if (!S.next(0, cur)) return;
    f32x4 acc[2][2][4][2];
#pragma unroll
    for (int a = 0; a < 2; ++a)
#pragma unroll
        for (int b = 0; b < 2; ++b)
#pragma unroll
            for (int m = 0; m < 4; ++m)
#pragma unroll
                for (int n = 0; n < 2; ++n) acc[a][b][m][n] = (f32x4){0.f, 0.f, 0.f, 0.f};
    typedef int i32x4_ __attribute__((ext_vector_type(4))); typedef int i32x8_ __attribute__((ext_vector_type(8)));
    int f8scale = 0x7f7f7f7f; asm volatile("" : "+v"(f8scale));
    bf16x8 At[4][2], B0[2][2], B1[2][2]; i32x8_ At8[4], B08[2], B18[2];
    const char* cA = S.abase(cur); const char* cB = S.bbase(cur);
    S.a_ready(cur);
    if constexpr (SP2) {
        PG8_STAGE(PG8_SB(0, 0), cB, voffB); PG8_STAGE(PG8_SB(0, 1), cB + hsB, voffB); PG8_STAGE(PG8_SA(0, 0), cA, voffA); PG8_STAGE(PG8_SA(0, 1), cA + hsA, voffA);
        if (wr == 1) PG8_BAR;
        PG8_WAIT_V(2); PG8_BAR;
        PG8_STAGE(PG8_SB(1, 0), cB + kstep, voffB); PG8_STAGE(PG8_SA(1, 0), cA + kstep, voffA); PG8_STAGE(PG8_SB(1, 1), cB + hsB + kstep, voffB);
        PG8_WAIT_V(6); PG8_BAR;
    } else {
        PG8_STAGE(PG8_SB(0, 0), cB, voffB); PG8_STAGE(PG8_SA(0, 0), cA, voffA); PG8_STAGE(PG8_SB(0, 1), cB + hsB, voffB); PG8_STAGE(PG8_SA(0, 1), cA + hsA, voffA);
        if (wr == 1) PG8_BAR;
        PG8_WAIT_V(4); PG8_BAR;
        PG8_STAGE(PG8_SB(1, 0), cB + kstep, voffB); PG8_STAGE(PG8_SA(1, 0), cA + kstep, voffA); PG8_STAGE(PG8_SB(1, 1), cB + hsB + kstep, voffB);
        PG8_WAIT_V(6); PG8_BAR;
    }
    for (;;) {
        const bool has_next = S.next(ui + 1, nxt);
        const char* nA = has_next ? S.abase(nxt) : cA; const char* nB = has_next ? S.bbase(nxt) : cB;
#pragma nounroll
        for (int t = 0; t < nt; t += 2) {
            const bool last = (t == nt - 2);
            const char* a1 = cA + (size_t)(t + 1) * kstep;
            const char* a2 = last ? nA : cA + (size_t)(t + 2) * kstep; const char* b2 = last ? nB : cB + (size_t)(t + 2) * kstep;
            const char* a3 = a2 + kstep; const char* b3 = b2 + kstep;
            if (last && has_next) S.a_ready(nxt);
            if constexpr (SP2) {
            PG8_LDB(B0, 0, 0); PG8_LDB(B1, 0, 1); PG8_SCHED; PG8_LDA(At, 0, 0); PG8_STAGE(PG8_SA(1, 1), a1 + hsA, voffA);
            PG8_WAIT_V(8); PG8_WAIT_L(0); PG8_BAR; PG8_MMA(0, 0, At, B0); PG8_MMA(0, 1, At, B1); PG8_BAR; PG8_SCHED;
            PG8_LDA(At, 0, 1); PG8_STAGE(PG8_SB(0, 0), b2, voffB); PG8_STAGE(PG8_SB(0, 1), b2 + hsB, voffB); PG8_STAGE(PG8_SA(0, 0), a2, voffA);
            PG8_WAIT_V(8); PG8_WAIT_L(0); PG8_BAR; PG8_MMA(1, 0, At, B0); PG8_MMA(1, 1, At, B1); PG8_BAR; PG8_SCHED;
            PG8_LDB(B0, 1, 0); PG8_LDB(B1, 1, 1); PG8_SCHED; PG8_LDA(At, 1, 0); PG8_STAGE(PG8_SA(0, 1), a2 + hsA, voffA);
            PG8_WAIT_V(8); PG8_WAIT_L(0); PG8_BAR; PG8_MMA(0, 0, At, B0); PG8_MMA(0, 1, At, B1); PG8_BAR; PG8_SCHED;
            PG8_LDA(At, 1, 1); PG8_STAGE(PG8_SB(1, 0), b3, voffB); PG8_STAGE(PG8_SB(1, 1), b3 + hsB, voffB); PG8_STAGE(PG8_SA(1, 0), a3, voffA);
            PG8_WAIT_V(8); PG8_WAIT_L(0); PG8_BAR; PG8_MMA(1, 0, At, B0); PG8_MMA(1, 1, At, B1); PG8_BAR; PG8_SCHED;
            } else {
            PG8_LDB(B0, 0, 0); PG8_SCHED; PG8_LDA(At, 0, 0); PG8_STAGE(PG8_SA(1, 1), a1 + hsA, voffA);
            PG8_WAIT_L(8); PG8_BAR; PG8_WAIT_L(0); PG8_MMA(0, 0, At, B0); PG8_BAR; PG8_SCHED;
            PG8_LDB(B1, 0, 1); PG8_STAGE(PG8_SB(0, 0), b2, voffB);
            PG8_BAR; PG8_WAIT_L(0); PG8_MMA(0, 1, At, B1); PG8_BAR;
            PG8_LDA(At, 0, 1); PG8_STAGE(PG8_SA(0, 0), a2, voffA);
            PG8_BAR; PG8_WAIT_L(0); PG8_MMA(1, 0, At, B0); PG8_BAR; PG8_SCHED;
            PG8_STAGE(PG8_SB(0, 1), b2 + hsB, voffB);
            PG8_WAIT_V(6); PG8_BAR; PG8_MMA(1, 1, At, B1); PG8_BAR;
            PG8_LDB(B0, 1, 0); PG8_SCHED; PG8_LDA(At, 1, 0); PG8_STAGE(PG8_SA(0, 1), a2 + hsA, voffA);
            PG8_WAIT_L(8); PG8_BAR; PG8_WAIT_L(0); PG8_MMA(0, 0, At, B0); PG8_BAR; PG8_SCHED;
            PG8_LDB(B1, 1, 1); PG8_STAGE(PG8_SB(1, 0), b3, voffB);
            PG8_BAR; PG8_WAIT_L(0); PG8_MMA(0, 1, At, B1); PG8_BAR;
            PG8_LDA(At, 1, 1); PG8_STAGE(PG8_SA(1, 0), a3, voffA);
            PG8_BAR; PG8_WAIT_L(0); PG8_MMA(1, 0, At, B0); PG8_BAR; PG8_SCHED;
            PG8_STAGE(PG8_SB(1, 1), b3 + hsB, voffB);
            PG8_WAIT_V(6); PG8_BAR; PG8_MMA(1, 1, At, B1); PG8_BAR;
            }
        }
        if constexpr (ALIGN_EPI) { if (wr == 0) PG8_BAR; }
        if constexpr (!Epi::AFTER_DRAIN) { E(acc, cur, wr, wc, fr, fq); S.done(cur); }
        if (!has_next) break;
#pragma unroll
        for (int a = 0; a < 2; ++a)
#pragma unroll
            for (int b = 0; b < 2; ++b)
#pragma unroll
                for (int m = 0; m < 4; ++m)
#pragma unroll
                    for (int n = 0; n < 2; ++n) acc[a][b][m][n] = (f32x4){0.f, 0.f, 0.f, 0.f};
        cur = nxt; cA = nA; cB = nB; ++ui;
        if constexpr (ALIGN_EPI) { if (wr == 1) PG8_BAR; }
    }
    PG8_WAIT_V(0);
    if constexpr (!ALIGN_EPI) { if (wr == 0) PG8_BAR; }
    PG8_BAR;
    if constexpr (Epi::AFTER_DRAIN) { E.fused(acc, cur, wr, wc, fr, fq, lds, wid, lane); S.done(cur); }
#undef PG8_SA
#undef PG8_SB
#undef PG8_STAGE
#undef PG8_LDA
#undef PG8_LDB
#undef PG8_MMA
#undef PG8_WAIT_V
#undef PG8_WAIT_L
#undef PG8_BAR
#undef PG8_SCHED
}
}

#ifndef MOBA_MASK_ON
#define MOBA_MASK_ON 1
#endif
namespace attn_body {
using bf16=__hip_bfloat16;
using bf16x8=__attribute__((ext_vector_type(8)))short;
using s16x4=__attribute__((ext_vector_type(4)))short;
using f32x16=__attribute__((ext_vector_type(16)))float;
using u32x4=__attribute__((ext_vector_type(4)))unsigned;
constexpr int BATCH=2,NHEAD=16,SEQ=8192,D=64,DM=NHEAD*D;
constexpr int NW=8,QBLK=32,QB=QBLK*NW,KVBLK=64,NQB=SEQ/QB;
constexpr int ATTN_PITCH=DM, ATTN_UNIT_ROWS=QB;
__device__ __forceinline__ int crow(int r,int hi){return (r&3)+8*(r>>2)+4*hi;}
#define SBAR() __builtin_amdgcn_sched_barrier(0)
__device__ __forceinline__ void cmask(f32x16&p0,f32x16&p1,int jb,int qrel,int hi){
  const float NEG=-INFINITY; int d=qrel-(64*jb+4*hi); asm volatile("":"+v"(d));
  #pragma unroll
  for(int r=0;r<16;++r){const int c=(r&3)+8*(r>>2); if(c>d)p0[r]=NEG; if(c+32>d)p1[r]=NEG;}
}

constexpr int NSLOT=3, SLOTB=8192;
constexpr int LDS_K=0, LDS_V=NSLOT*SLOTB, LDS_WS=2*NSLOT*SLOTB, LDS_OST=LDS_WS+NW*64*4, LDS_BYTES=LDS_OST+NW*4096;
constexpr float C2=0.125f*1.4426950408889634f;
__device__ __forceinline__ void glds16(const void*gsrc,unsigned lds_dst){unsigned keep;
  asm volatile("s_mov_b32 %0, m0\n\ts_mov_b32 m0, %2\n\ts_nop 0\n\tglobal_load_lds_dwordx4 %1, off\n\ts_mov_b32 m0, %0":"=&s"(keep):"v"(gsrc),"s"(lds_dst):"memory");}
__device__ __forceinline__ float max3f(float a,float b,float c){float r;asm("v_max3_f32 %0, %1, %2, %3":"=v"(r):"v"(a),"v"(b),"v"(c));return r;}
__device__ __forceinline__ float max2f(float a,float b){float r;asm("v_max_f32_e32 %0, %1, %2":"=v"(r):"v"(a),"v"(b));return r;}
__device__ __forceinline__ float fadd_s(float a,float b){float r;asm("v_add_f32_e32 %0, %1, %2":"=v"(r):"v"(a),"v"(b));return r;}
__device__ __forceinline__ float fsub_s(float a,float b){float r;asm("v_sub_f32_e32 %0, %1, %2":"=v"(r):"v"(a),"v"(b));return r;}
typedef float f32x2_t __attribute__((ext_vector_type(2))); typedef __bf16 bf16x2_t __attribute__((ext_vector_type(2)));
__device__ __forceinline__ unsigned cvtpk_s(float lo,float hi){f32x2_t v={lo,hi};bf16x2_t b=__builtin_convertvector(v,bf16x2_t);return __builtin_bit_cast(unsigned,b);}
#define WAIT_BAR(N) asm volatile("s_waitcnt vmcnt(" #N ") lgkmcnt(0)\n\ts_barrier":::"memory")

__device__ __forceinline__ void qkt(f32x16&p0,f32x16&p1,const char*Kslot,const bf16x8*qr,int r32,int hi){
  const char*kb=Kslot+hi*1024+r32*16;
  #pragma unroll
  for(int d0=0;d0<4;++d0){
    const bf16x8 b0=*reinterpret_cast<const bf16x8*>(kb+d0*2048);
    const bf16x8 b1=*reinterpret_cast<const bf16x8*>(kb+d0*2048+512);
    if(d0==0){p0=__builtin_amdgcn_mfma_f32_32x32x16_bf16(b0,qr[0],f32x16{},0,0,0);p1=__builtin_amdgcn_mfma_f32_32x32x16_bf16(b1,qr[0],f32x16{},0,0,0);}
    else{p0=__builtin_amdgcn_mfma_f32_32x32x16_bf16(b0,qr[d0],p0,0,0,0);p1=__builtin_amdgcn_mfma_f32_32x32x16_bf16(b1,qr[d0],p1,0,0,0);}}
}
typedef __attribute__((address_space(3))) const char* lds_cptr;
typedef short v4i16_t __attribute__((ext_vector_type(4)));
__device__ __forceinline__ void kload8(bf16x8*kf,lds_cptr kp){
  kf[0]=*(const __attribute__((address_space(3))) bf16x8*)(kp);      kf[1]=*(const __attribute__((address_space(3))) bf16x8*)(kp+512);
  kf[2]=*(const __attribute__((address_space(3))) bf16x8*)(kp+2048); kf[3]=*(const __attribute__((address_space(3))) bf16x8*)(kp+2560);
  kf[4]=*(const __attribute__((address_space(3))) bf16x8*)(kp+4096); kf[5]=*(const __attribute__((address_space(3))) bf16x8*)(kp+4608);
  kf[6]=*(const __attribute__((address_space(3))) bf16x8*)(kp+6144); kf[7]=*(const __attribute__((address_space(3))) bf16x8*)(kp+6656);
}
__device__ __forceinline__ void kload2(bf16x8*kf,lds_cptr kp,int j){ kf[2*j]=*(const __attribute__((address_space(3))) bf16x8*)(kp+j*2048); kf[2*j+1]=*(const __attribute__((address_space(3))) bf16x8*)(kp+j*2048+512); }
__device__ __forceinline__ s16x4 vtr(lds_cptr p){ return __builtin_bit_cast(s16x4,__builtin_amdgcn_ds_read_tr16_b64_v4i16((__attribute__((address_space(3))) v4i16_t*)p)); }
__device__ __forceinline__ float rowmax(const f32x16&p0,const f32x16&p1){
  float a=max3f(p0[0],p0[1],p1[0]),b=max3f(p0[2],p0[3],p1[1]);a=max3f(a,p1[2],p1[3]);
  #pragma unroll
  for(int r=4;r<16;r+=4){a=max3f(a,p0[r],p0[r+1]);b=max3f(b,p0[r+2],p0[r+3]);a=max3f(a,p1[r],p1[r+1]);b=max3f(b,p1[r+2],p1[r+3]);}
  const float m=max2f(a,b);
  auto rr=__builtin_amdgcn_permlane32_swap(__float_as_uint(m),__float_as_uint(m),false,false);
  return max2f(__uint_as_float(rr[0]),__uint_as_float(rr[1]));
}
__device__ __forceinline__ void pv(f32x16*o,int vb,bf16x8 pa0,bf16x8 pa1,bf16x8 pa2,bf16x8 pa3){
  #pragma unroll
  for(int d0=0;d0<2;++d0){s16x4 lo[4],hi[4];
    #pragma unroll
    for(int ks=0;ks<4;++ks){
      asm volatile("ds_read_b64_tr_b16 %0,%1 offset:%c2":"=&v"(lo[ks]):"v"(vb),"i"(d0*4096+ks*1024):"memory");
      asm volatile("ds_read_b64_tr_b16 %0,%1 offset:%c2":"=&v"(hi[ks]):"v"(vb),"i"(d0*4096+ks*1024+512):"memory");}
    asm volatile("s_waitcnt lgkmcnt(0)":::"memory");SBAR();
    #define PK(k) (bf16x8){lo[k][0],lo[k][1],lo[k][2],lo[k][3],hi[k][0],hi[k][1],hi[k][2],hi[k][3]}
    o[d0]=__builtin_amdgcn_mfma_f32_32x32x16_bf16(pa0,PK(0),o[d0],0,0,0);
    o[d0]=__builtin_amdgcn_mfma_f32_32x32x16_bf16(pa1,PK(1),o[d0],0,0,0);
    o[d0]=__builtin_amdgcn_mfma_f32_32x32x16_bf16(pa2,PK(2),o[d0],0,0,0);
    o[d0]=__builtin_amdgcn_mfma_f32_32x32x16_bf16(pa3,PK(3),o[d0],0,0,0);
    #undef PK
  }
}

#ifndef ATTN_STORE16
#define ATTN_STORE16(p,v) (*(u32x4*)(p)=(v))
#endif
template<int THRL> __device__ __forceinline__ void attn_unit(int b,int h,int qb,const bf16*Q,const bf16*__restrict__ K,const bf16*__restrict__ V,bf16*O,const unsigned*__restrict__ SEL,char*shm,int wave){
  const int lane=fresh_lane(),wid=wave,tid=wid*64+lane,r32=lane&31,hi=lane>>5; (void)tid;
  const long rowbase=(long)b*SEQ; const int q0=qb*QB;
  const bf16*Qw=Q+(rowbase+q0+wid*QBLK)*DM+h*D;
  const bf16*Kh=K+rowbase*DM+h*D,*Vh=V+rowbase*DM+h*D;
  const unsigned lds0=(unsigned)(uintptr_t)shm;
  float*wsf=(float*)(shm+LDS_WS)+wid*64;
  const bf16*ksrc=Kh+(long)lane*DM+wid*8;
  const bf16*vsrc=Vh+(long)(16*(wid&3)+(lane>>2))*DM+(wid>>2)*32+(lane&3)*8;
  const unsigned kdst=lds0+LDS_K+wid*1024, vdst=lds0+LDS_V+wid*1024;
  #define DMA_K(t,slot) glds16(ksrc+(long)(t)*KVBLK*DM,(unsigned)__builtin_amdgcn_readfirstlane(kdst+(slot)))
  #define DMA_V(t,slot) glds16(vsrc+(long)(t)*KVBLK*DM,(unsigned)__builtin_amdgcn_readfirstlane(vdst+(slot)))
  const int vb0=(int)(lds0+LDS_V)+((lane>>4)&1)*32+(lane&3)*8+(4*hi+((lane&15)>>2))*64;
  const char*Kbase=shm+LDS_K; bf16x8 kf[8];
  const lds_cptr shm3=(lds_cptr)shm; const lds_cptr kp0=shm3+LDS_K+hi*1024+r32*16; const lds_cptr vp0=shm3+LDS_V+((lane>>4)&1)*32+(lane&3)*8+(4*hi+((lane&15)>>2))*64;
  const int NT=(q0+QB)/KVBLK;
  DMA_K(0,0);DMA_V(0,0);DMA_K(1,SLOTB);
  bf16x8 qr[4];
  #pragma unroll
  for(int d0=0;d0<4;++d0)qr[d0]=*reinterpret_cast<const bf16x8*>(&Qw[(long)r32*DM+d0*16+hi*8]);
  float mhat=0.f,l_reg=0.f;f32x16 o[2];o[0]=f32x16{};o[1]=f32x16{};
  const int qrel=wid*QBLK+r32;
  #define SELW() ((volatile __attribute__((address_space(3))) unsigned*)(lds_cptr)((const char*)wsf)+32+r32)
  if(hi==0)*SELW()=SEL[(rowbase+q0+qrel)*NHEAD+h];
  asm volatile("s_waitcnt vmcnt(0) lgkmcnt(0)":::"memory");
  #define CMASK(P0,P1,t) do{int jb_=(t)-(NT-4); if(jb_>=0)cmask(P0,P1,jb_,qrel,hi); else if(MOBA_MASK_ON && !(((*SELW())>>((t)>>2))&1u)){ _Pragma("unroll") for(int r_=0;r_<16;++r_){P0[r_]=-INFINITY;P1[r_]=-INFINITY;} } }while(0)
  bool resc=false;
  #define START(P0,P1) do{ const float rm=rowmax(P0,P1); resc=false; \
    { const float dl=max2f(rm,-100.f); mhat=fadd_s(mhat,dl); \
      _Pragma("unroll") for(int r=0;r<16;++r){P0[r]=fsub_s(P0[r],dl);P1[r]=fsub_s(P1[r],dl);} \
      } \
    _Pragma("unroll") for(int r=0;r<16;++r)P0[r]=__builtin_amdgcn_exp2f(P0[r]); }while(0)
  #define RESC() do{ if(resc){ asm volatile("s_waitcnt lgkmcnt(0)":::"memory"); \
      _Pragma("unroll") for(int d_=0;d_<2;++d_) _Pragma("unroll") for(int r=0;r<16;++r)o[d_][r]*=wsf[crow(r,hi)]; } }while(0)
  f32x16 pA0,pA1,pB0,pB1;
  int sl_prev=0,sl_cur=0,sl_next=SLOTB;
  #define ROT() do{sl_prev=sl_cur;sl_cur=sl_next;sl_next=(sl_next==(NSLOT-1)*SLOTB)?0:sl_next+SLOTB;}while(0)
  DMA_K(2,2*SLOTB);
  WAIT_BAR(3);
  qkt(pA0,pA1,Kbase,qr,r32,hi);asm volatile("s_nop 15\n\ts_nop 7":"+v"(pA0),"+v"(pA1));CMASK(pA0,pA1,0);
  START(pA0,pA1);
  _Pragma("unroll") for(int r=0;r<16;++r)pA1[r]=__builtin_amdgcn_exp2f(pA1[r]);
  WAIT_BAR(0);
  DMA_K(3,0);DMA_V(1,SLOTB);
  ROT();
  kload8(kf,kp0+sl_cur);
  WAIT_BAR(2);
  s16x4 vlo[8],vhi[8]; u32x4 pw0,pw1,pw2,pw3;
  #define PKW(P,B) cvtpk_s(P[B],P[B+1])
  #define PAF(k) __builtin_bit_cast(bf16x8,pw##k)
  #define VFR(i) (bf16x8){vlo[i][0],vlo[i][1],vlo[i][2],vlo[i][3],vhi[i][0],vhi[i][1],vhi[i][2],vhi[i][3]}
  #define PIN(x) asm volatile("":"+v"(x))
  #define MX3(a,b,c) __builtin_fmaxf(__builtin_fmaxf((a),(b)),(c))
  #define GAPA(MF,A0,A1,A2,A3,W0,W1,PW) do{ MF; sacc+=A0; sacc+=A1; sacc+=A2; sacc+=A3; PIN(sacc); W0; W1; PIN(PW); SBAR(); }while(0)
  #define EX(v) __builtin_amdgcn_exp2f(v)
  #define GAPB(MF,X,B) do{ MF; X[B]=EX(X[B]); X[B+1]=EX(X[B+1]); X[B+2]=EX(X[B+2]); X[B+3]=EX(X[B+3]); PIN(X); SBAR(); }while(0)
  #define VRD(i) do{ vlo[i]=vtr(vp_+(((i)>>2)*4096+((i)&3)*1024)); vhi[i]=vtr(vp_+(((i)>>2)*4096+((i)&3)*1024+512)); }while(0)
  #define KRD(G,j) do{ if(G){ kload2(kf,kp0+sl_next,j); SBAR(); } }while(0)
  #define STEP(C0,C1,P0,P1,t,GK,GV,GL) do{ SBAR(); \
    const lds_cptr vp_=vp0+sl_prev; \
    VRD(0); SBAR(); float sacc=(P0[0]+P0[1]); \
    GAPA(C0=__builtin_amdgcn_mfma_f32_32x32x16_bf16(kf[0],qr[0],f32x16{},0,0,0), P0[2],P0[3],P0[4],P0[5],     pw0[0]=PKW(P0,0), pw0[1]=PKW(P0,2), pw0); \
    VRD(4); SBAR(); GAPA(C1=__builtin_amdgcn_mfma_f32_32x32x16_bf16(kf[1],qr[0],f32x16{},0,0,0), P0[6],P0[7],P0[8],P0[9],     pw0[2]=PKW(P0,4), pw0[3]=PKW(P0,6), pw0); \
    VRD(1); SBAR(); GAPA(C0=__builtin_amdgcn_mfma_f32_32x32x16_bf16(kf[2],qr[1],C0,0,0,0),   P0[10],P0[11],P0[12],P0[13], pw1[0]=PKW(P0,8), pw1[1]=PKW(P0,10), pw1); \
    VRD(5); SBAR(); GAPA(C1=__builtin_amdgcn_mfma_f32_32x32x16_bf16(kf[3],qr[1],C1,0,0,0),   P0[14],P0[15],P1[0],P1[1],   pw1[2]=PKW(P0,12),pw1[3]=PKW(P0,14), pw1); \
    VRD(2); SBAR(); GAPA(C0=__builtin_amdgcn_mfma_f32_32x32x16_bf16(kf[4],qr[2],C0,0,0,0),   P1[2],P1[3],P1[4],P1[5],     pw2[0]=PKW(P1,0), pw2[1]=PKW(P1,2), pw2); \
    VRD(6); SBAR(); GAPA(C1=__builtin_amdgcn_mfma_f32_32x32x16_bf16(kf[5],qr[2],C1,0,0,0),   P1[6],P1[7],P1[8],P1[9],     pw2[2]=PKW(P1,4), pw2[3]=PKW(P1,6), pw2); \
    VRD(3); SBAR(); GAPA(C0=__builtin_amdgcn_mfma_f32_32x32x16_bf16(kf[6],qr[3],C0,0,0,0),   P1[10],P1[11],P1[12],P1[13], pw3[0]=PKW(P1,8), pw3[1]=PKW(P1,10), pw3); \
    VRD(7); SBAR(); GAPA(C1=__builtin_amdgcn_mfma_f32_32x32x16_bf16(kf[7],qr[3],C1,0,0,0),   P1[14],P1[15],0.f,0.f,       pw3[2]=PKW(P1,12),pw3[3]=PKW(P1,14), pw3); \
    l_reg+=sacc; \
    if(GK){DMA_K((t)+3,sl_cur);} if(GV){DMA_V((t)+1,sl_next);} \
    _Pragma("unroll") for(int r=0;r<16;++r){C0[r]-=mhat;C1[r]-=mhat;} \
    CMASK(C0,C1,t); \
    { float a=MX3(C0[0],C0[1],C1[0]),b=MX3(C0[2],C0[3],C1[1]); a=MX3(a,C1[2],C1[3]); \
      _Pragma("unroll") for(int r=4;r<16;r+=4){a=MX3(a,C0[r],C0[r+1]);b=MX3(b,C0[r+2],C0[r+3]);a=MX3(a,C1[r],C1[r+1]);b=MX3(b,C1[r+2],C1[r+3]);} \
      float rm=__builtin_fmaxf(a,b); { auto rr=__builtin_amdgcn_permlane32_swap(__float_as_uint(rm),__float_as_uint(rm),false,false); rm=__builtin_fmaxf(__uint_as_float(rr[0]),__uint_as_float(rr[1])); } \
      resc=false; \
      if(__builtin_expect(__any(rm>(float)THRL),0)){ const float dl=__builtin_fmaxf(rm,0.f); mhat+=dl; \
        _Pragma("unroll") for(int r=0;r<16;++r){C0[r]-=dl;C1[r]-=dl;} \
        const float f=__builtin_amdgcn_exp2f(-dl); l_reg*=f; if(hi==0)wsf[r32]=f; resc=true; } } \
    SBAR(); \
    GAPB(o[0]=__builtin_amdgcn_mfma_f32_32x32x16_bf16(PAF(0),VFR(0),o[0],0,0,0), C0,0); \
    GAPB(o[1]=__builtin_amdgcn_mfma_f32_32x32x16_bf16(PAF(0),VFR(4),o[1],0,0,0), C0,4); \
    KRD(GL,0); GAPB(o[0]=__builtin_amdgcn_mfma_f32_32x32x16_bf16(PAF(1),VFR(1),o[0],0,0,0), C0,8); \
    KRD(GL,1); GAPB(o[1]=__builtin_amdgcn_mfma_f32_32x32x16_bf16(PAF(1),VFR(5),o[1],0,0,0), C0,12); \
    KRD(GL,2); GAPB(o[0]=__builtin_amdgcn_mfma_f32_32x32x16_bf16(PAF(2),VFR(2),o[0],0,0,0), C1,0); \
    KRD(GL,3); GAPB(o[1]=__builtin_amdgcn_mfma_f32_32x32x16_bf16(PAF(2),VFR(6),o[1],0,0,0), C1,4); \
    GAPB(o[0]=__builtin_amdgcn_mfma_f32_32x32x16_bf16(PAF(3),VFR(3),o[0],0,0,0), C1,8); \
    GAPB(o[1]=__builtin_amdgcn_mfma_f32_32x32x16_bf16(PAF(3),VFR(7),o[1],0,0,0), C1,12); \
    }while(0)
  int t=1;
  for(;t+5<NT;t+=2){
    STEP(pB0,pB1,pA0,pA1,t,true,true,true);     WAIT_BAR(2); RESC(); ROT();
    STEP(pA0,pA1,pB0,pB1,t+1,true,true,true);   WAIT_BAR(2); RESC(); ROT();
  }
  #undef CMASK
  #define CMASK(P0,P1,t) do{int jb_=(t)-(NT-4); if(jb_>=0)cmask(P0,P1,jb_,qrel,hi); else if(MOBA_MASK_ON && !(((*SELW())>>((t)>>2))&1u)){ _Pragma("unroll") for(int r_=0;r_<16;++r_){P0[r_]=-INFINITY;P1[r_]=-INFINITY;} } }while(0)
  #define ENDW(tt) do{ if((tt)+3<NT){WAIT_BAR(2);} else if((tt)+2<NT){WAIT_BAR(1);} else {WAIT_BAR(0);} }while(0)
  for(;t+1<NT;t+=2){
    STEP(pB0,pB1,pA0,pA1,t,(t+3<NT),(t+1<NT),(t+1<NT));       ENDW(t);   RESC(); ROT();
    STEP(pA0,pA1,pB0,pB1,t+1,(t+4<NT),(t+2<NT),(t+2<NT));     ENDW(t+1); RESC(); ROT();
  }
  STEP(pB0,pB1,pA0,pA1,NT-1,false,false,false); RESC();
  { float sacc=pB0[0]+pB0[1]; _Pragma("unroll") for(int r=2;r<16;++r)sacc+=pB0[r]; _Pragma("unroll") for(int r=0;r<16;++r)sacc+=pB1[r]; l_reg+=sacc;
    pw0=(u32x4){PKW(pB0,0),PKW(pB0,2),PKW(pB0,4),PKW(pB0,6)};pw1=(u32x4){PKW(pB0,8),PKW(pB0,10),PKW(pB0,12),PKW(pB0,14)};pw2=(u32x4){PKW(pB1,0),PKW(pB1,2),PKW(pB1,4),PKW(pB1,6)};pw3=(u32x4){PKW(pB1,8),PKW(pB1,10),PKW(pB1,12),PKW(pB1,14)};
    SBAR(); pv(o,vb0+sl_cur,PAF(0),PAF(1),PAF(2),PAF(3)); }
  #undef PKW
  #undef PAF
  #undef VFR
  #undef PIN
  #undef MX3
  #undef GAPA
  #undef GAPB
  #undef EX
  #undef VRD
  #undef KRD
  #undef STEP
  #undef ENDW
  {auto rr=__builtin_amdgcn_permlane32_swap(__float_as_uint(l_reg),__float_as_uint(l_reg),false,false);l_reg=__uint_as_float(rr[0])+__uint_as_float(rr[1]);}
  if(hi==0)wsf[32+r32]=l_reg;asm volatile("s_waitcnt lgkmcnt(0)":::"memory");
  float rli[16];
  #pragma unroll
  for(int r=0;r<16;++r)rli[r]=__builtin_amdgcn_rcpf(wsf[32+crow(r,hi)]);
  bf16*Ow=O+(rowbase+q0+wid*QBLK)*DM+h*D;
  { bf16*stg=(bf16*)(shm+LDS_OST)+wid*2048;
    #pragma unroll
    for(int r=0;r<16;++r){const int orow=crow(r,hi);
      #pragma unroll
      for(int d0=0;d0<2;++d0)stg[orow*64+d0*32+r32]=__float2bfloat16(o[d0][r]*rli[r]);}
    asm volatile("s_waitcnt lgkmcnt(0)":::"memory");
    #pragma unroll
    for(int i=0;i<4;++i){const int row=i*8+(lane>>3),ch=lane&7; const u32x4 v=*(const u32x4*)(stg+row*64+ch*8); ATTN_STORE16(Ow+(long)row*DM+ch*8,v);} }
  asm volatile("s_waitcnt lgkmcnt(0)\n\ts_barrier":::"memory");
  #undef SELW
  #undef DMA_K
  #undef DMA_V
  #undef CMASK
  #undef START
  #undef RESC
  #undef ROT
}
constexpr int ATTN_LDS_BYTES=LDS_BYTES;
struct AttnTensors { const bf16* Q; const bf16* K; const bf16* V; bf16* O; const unsigned* SEL; };
struct AttnUnit { int bh; int qb; };
struct StaticOrder {
  int vcu;
  __device__ __forceinline__ explicit StaticOrder(int grid,int block):vcu((block%8)*(grid/8)+block/8){}
  __device__ __forceinline__ bool next(int i,AttnUnit&u)const{ if(i>=4)return false; const int s=vcu&7; u.bh=vcu>>3; u.qb=(i==0)?s:(i==1)?15-s:(i==2)?16+s:31-s; return true; }
  __device__ __forceinline__ void a_ready(const AttnUnit&)const{}
  __device__ __forceinline__ void done(const AttnUnit&)const{}
};
template<class Sched,int THRL=8> __device__ __forceinline__ void attn_phase(char*lds,const AttnTensors&T,const Sched&S,int wave){
  AttnUnit u;
  for(int i=0;S.next(i,u);++i){ S.a_ready(u); attn_unit<THRL>(u.bh/NHEAD,u.bh%NHEAD,u.qb,T.Q,T.K,T.V,T.O,T.SEL,lds,wave); S.done(u); }
}
#undef SBAR
#undef WAIT_BAR
}

constexpr int NWAVES = 8;
constexpr int BATCH = 2, T = 8192, D = 1024, H = 16, HD = 64, M = BATCH * T;
constexpr int FF = 2816, FFE = 3584, NE = 8, MOE_ROWS = 34816  ;
constexpr float MOE_WSCALE = 64.f;
constexpr float LN_EPS = 1e-5f, GN_EPS = 64e-5f, ALPHA = 1.6817928305074292f  ;
constexpr size_t MiB = 1u << 20;
constexpr size_t WS_CTL = 0, CTL_ZERO_BYTES = 1 * MiB;
constexpr size_t WS_KMEAN = 1 * MiB;
constexpr size_t WS_SEL = 2 * MiB;
constexpr size_t WS_TOKE = 3 * MiB;
constexpr size_t WS_TOKW = WS_TOKE + 128 * 1024;
constexpr size_t WS_TOKR = WS_TOKW + 128 * 1024;
constexpr size_t WS_GW = WS_TOKR + 128 * 1024;
constexpr size_t WS_BLKCNT = WS_GW + 256 * 1024;
constexpr size_t WS_WMIX = 16 * MiB;
constexpr size_t WS_WFFN = 32 * MiB;
constexpr size_t WS_H = 200 * MiB;
constexpr size_t WS_HB = 264 * MiB;
constexpr size_t WS_K = 296 * MiB, WS_V = 328 * MiB;
constexpr size_t WS_VFIRST = WS_K;
constexpr size_t WS_Y = WS_V;
constexpr size_t WS_SCR = 360 * MiB;
constexpr size_t WS_END = 896 * MiB;
constexpr size_t RS_XM = WS_SCR;
constexpr size_t RS_KP = WS_SCR, RS_AP = WS_SCR + 32 * MiB, RS_VP = WS_SCR + 64 * MiB, RS_BP = WS_SCR + 96 * MiB;
constexpr size_t RS_RKV = WS_SCR + 192 * MiB;
constexpr size_t RS_PRE = RS_RKV;
constexpr size_t RS_LH = WS_SCR + 288 * MiB;
constexpr size_t RS_YG = RS_LH;
constexpr size_t RS_DEC = WS_SCR + 320 * MiB;
constexpr size_t RS_AB = WS_SCR + 384 * MiB;
constexpr size_t RS_VG = WS_SCR + 448 * MiB;
constexpr size_t RS_GG = WS_SCR + 480 * MiB;
constexpr size_t BS_Q = WS_SCR, BS_PRE = WS_SCR + 32 * MiB, BS_O = WS_SCR + 96 * MiB;
constexpr size_t BS_PO = WS_SCR + 128 * MiB, BS_ML = WS_SCR + 256 * MiB;
constexpr size_t FS_HID = WS_SCR, FS_PRE = WS_SCR + 88 * MiB;
constexpr size_t ES_XG = WS_SCR, ES_HID = WS_SCR + 68 * MiB, ES_YP = WS_SCR + 306 * MiB, ES_YS = WS_SCR + 442 * MiB;
static_assert(RS_GG + 32 * MiB <= WS_END && ES_YS + 56 * MiB <= WS_END && FS_PRE + 64 * MiB <= WS_END, "d_ws map");
constexpr size_t RW_LSTRIDE = 872 * MiB - WS_WMIX;
constexpr size_t WM_BT1 = WS_WMIX, WM_BT2 = WS_WMIX + 8 * MiB, WM_OUT = WS_WMIX + 10 * MiB;
constexpr size_t WM_QKV = WS_WMIX, WM_O = WS_WMIX + 8 * MiB;
constexpr size_t WF_GU = WS_WFFN, WF_DN = WS_WFFN + 12 * MiB;
constexpr size_t WE_GU = WS_WFFN, WE_DN = WS_WFFN + 112 * MiB;
constexpr int CW_TMO = 0, CW_CODE = 1, CW_QCTR = 2048  , CW_BAR = 4096;
constexpr int RING_OFF = 0, RING_BYTES = 131072;
constexpr int LDSCTL_OFF = RING_BYTES, MISC_OFF = LDSCTL_OFF + 320;
constexpr int LDS_BYTES = 147456;
static_assert(MISC_OFF + 128 <= LDS_BYTES, "LDS map");

#define GAS __attribute__((address_space(1)))
#define LAS __attribute__((address_space(3)))
typedef unsigned short bf16;
typedef unsigned v4u __attribute__((ext_vector_type(4)));
typedef float f32x4 __attribute__((ext_vector_type(4)));
typedef short bf16x8 __attribute__((ext_vector_type(8)));
typedef GAS unsigned gu32;
typedef GAS unsigned long long gu64;
#define RLX_AGENT __ATOMIC_RELAXED, __HIP_MEMORY_SCOPE_AGENT
#define LDS_WAIT() asm volatile("s_waitcnt lgkmcnt(0)" ::: "memory")
#define VM_WAIT() asm volatile("s_waitcnt vmcnt(0)" ::: "memory")
__device__ __forceinline__ unsigned long long rt() { return __builtin_amdgcn_s_memrealtime(); }
__device__ __forceinline__ unsigned f2bf(float f) { unsigned u = __builtin_bit_cast(unsigned, f); return (u + 0x7fffu + ((u >> 16) & 1u)) >> 16; }
__device__ __forceinline__ unsigned pk2(float lo, float hi) { return f2bf(lo) | (f2bf(hi) << 16); }

#define XB_TMO      128
#define XB_XCNT(j)  (256  + 64 * (j))
#define XB_XSUB(j)  (1280 + 64 * (j))
#define XB_XGEN(j)  (2304 + 64 * (j))
#define XB_TOP      3328
#define XB_TOPGEN   3392
#define XCD_BAR_WORDS 3456
#define XB_SPIN_CAP (1u << 18)

__device__ __forceinline__ unsigned xb_ld(unsigned* p)              { return __hip_atomic_load(p, __ATOMIC_RELAXED, __HIP_MEMORY_SCOPE_AGENT); }
__device__ __forceinline__ unsigned xb_add(unsigned* p, unsigned v) { return __hip_atomic_fetch_add(p, v, __ATOMIC_RELAXED, __HIP_MEMORY_SCOPE_AGENT); }
__device__ __forceinline__ unsigned xb_xcc_id() { return (unsigned)__builtin_amdgcn_s_getreg((3 << 11) | 20) & 0xFu; }
#define XB_SPIN(cond, bar) do { unsigned _sp = 0; while (cond) { __builtin_amdgcn_s_sleep(1); \
    if ((++_sp & 255u) == 0u) { if (xb_ld(&(bar)[XB_TMO])) break; if (_sp > XB_SPIN_CAP) { atomicAdd(&(bar)[XB_TMO], 1u); break; } } } } while (0)

struct XcdBarrier {
    unsigned* bar; unsigned x;
    volatile LAS unsigned* st;
};

__device__ __forceinline__ XcdBarrier xcd_barrier_post(unsigned* bar, volatile LAS unsigned* st, bool t0  ) {
    XcdBarrier b; b.bar = bar; b.x = xb_xcc_id(); b.st = st;
    if (t0) (void)xb_add(&bar[XB_XCNT(b.x)], 1u);
    return b;
}
__device__ __forceinline__ void xcd_barrier_complete(unsigned* bar, unsigned x, unsigned& nloc, unsigned& nx) {
    const unsigned G = gridDim.x * gridDim.y * gridDim.z;
    unsigned sum, cnt, mine, sp = 0u;
    for (;;) {
        sum = 0u; cnt = 0u; mine = 0u;
#pragma unroll
        for (unsigned j = 0; j < 16; ++j) { const unsigned c = xb_ld(&bar[XB_XCNT(j)]); sum += c; cnt += (c > 0u) ? 1u : 0u; mine = (j == x) ? c : mine; }
        if (sum == G) break;
        __builtin_amdgcn_s_sleep(1);
        if ((++sp & 255u) == 0u) { if (xb_ld(&bar[XB_TMO])) break; if (sp > XB_SPIN_CAP) { atomicAdd(&bar[XB_TMO], 1u); break; } }
    }
    nloc = mine > 0u ? mine : 1u; nx = cnt > 0u ? cnt : 1u;
}

__device__ __forceinline__ void xcd_barrier(const XcdBarrier& b, bool t0  ) {
    asm volatile("s_waitcnt vmcnt(0)" ::: "memory");
    __syncthreads();
    if (t0) {
        unsigned* bar = b.bar;
        __builtin_amdgcn_s_waitcnt(0);
        unsigned nloc = b.st[0], nx = b.st[1];
        if (nloc == 0u) { xcd_barrier_complete(bar, b.x, nloc, nx); b.st[0] = nloc; b.st[1] = nx; }
        const unsigned old = xb_add(&bar[XB_XSUB(b.x)], 1u);
        const unsigned gen = old / nloc;
        if (old + 1u == (gen + 1u) * nloc) {
            __builtin_amdgcn_fence(__ATOMIC_RELEASE, "agent");
            asm volatile("s_waitcnt vmcnt(0)" ::: "memory");
            const unsigned og = xb_add(&bar[XB_TOP], 1u);
            const unsigned tg = og / nx;
            if (og + 1u == (tg + 1u) * nx) xb_add(&bar[XB_TOPGEN], 1u);
            else XB_SPIN(xb_ld(&bar[XB_TOPGEN]) == tg, bar);
#ifdef XB_L2_INV
            __builtin_amdgcn_fence(__ATOMIC_ACQUIRE, "");
#else
            __builtin_amdgcn_fence(__ATOMIC_ACQUIRE, "agent");
#endif
            xb_add(&bar[XB_XGEN(b.x)], 1u);
            asm volatile("s_waitcnt vmcnt(0)" ::: "memory");
        } else {
            XB_SPIN(xb_ld(&bar[XB_XGEN(b.x)]) == gen, bar);
            __builtin_amdgcn_fence(__ATOMIC_ACQUIRE, "agent");
            asm volatile("s_waitcnt vmcnt(0)" ::: "memory");
        }
    }
    __syncthreads();
}

struct Args { const float* in[33]; float* out; unsigned char* ws; };
enum InIdx { I_X = 0, I_MU, I_WRKV, I_WOUT, I_W0, I_W1, I_W2, I_A0, I_A1, I_A2, I_V0, I_V1, I_V2, I_G1, I_G2, I_KK, I_KA, I_RK, I_GNG, I_GNB,
             I_MK, I_MV, I_MQ, I_MO, I_FG, I_FU, I_FD, I_ROUTER, I_EG, I_EU, I_ED, I_LNG, I_LNB };
struct Frame {
    LAS unsigned char* lds; volatile LAS unsigned* MISC; gu32* ctl; unsigned char* ws;
    int tid, lane, wave, vcu, G, gw, NGW;
};
typedef float f32x2 __attribute__((ext_vector_type(2)));
typedef unsigned u32x2 __attribute__((ext_vector_type(2)));
__device__ __forceinline__ float dpp_sum16(float v) {
    v += __builtin_bit_cast(float, __builtin_amdgcn_update_dpp(0, __builtin_bit_cast(int, v), 0xB1, 0xF, 0xF, true));
    v += __builtin_bit_cast(float, __builtin_amdgcn_update_dpp(0, __builtin_bit_cast(int, v), 0x4E, 0xF, 0xF, true));
    v += __builtin_bit_cast(float, __builtin_amdgcn_update_dpp(0, __builtin_bit_cast(int, v), 0x141, 0xF, 0xF, true));
    v += __builtin_bit_cast(float, __builtin_amdgcn_update_dpp(0, __builtin_bit_cast(int, v), 0x140, 0xF, 0xF, true));
    return v;
}
__device__ __forceinline__ float wave_sum(float v, int lane) {
    v = dpp_sum16(v);
    v += __builtin_bit_cast(float, __builtin_amdgcn_ds_bpermute((lane ^ 16) << 2, __builtin_bit_cast(int, v)));
    v += __builtin_bit_cast(float, __builtin_amdgcn_ds_bpermute((lane ^ 32) << 2, __builtin_bit_cast(int, v)));
    return v;
}
__device__ __forceinline__ float sum16(float v) { return dpp_sum16(v); }
__device__ __forceinline__ float bf2f(unsigned short b) { return __uint_as_float((unsigned)b << 16); }
__device__ __forceinline__ f32x4 bf4_to_f32(u32x2 w) { f32x4 r; r.x = __uint_as_float(w.x << 16); r.y = __uint_as_float(w.x & 0xffff0000u); r.z = __uint_as_float(w.y << 16); r.w = __uint_as_float(w.y & 0xffff0000u); return r; }
__device__ __forceinline__ u32x2 f32_to_bf4(f32x4 v) { u32x2 w; w.x = pk2(v.x, v.y); w.y = pk2(v.z, v.w); return w; }

__device__ __forceinline__ void tr_item(const float* W, int ldw, int Kr, int Nr, int nblk, bf16* WT, int ldt, int row0, int mode, LAS float* scr, int item, int lane) {
    const int kb = item / nblk, nb = item - kb * nblk, k0 = 64 * kb, n0 = 32 * nb;
    const int kg = lane >> 3, n = n0 + 4 * (lane & 7), kk = k0 + 8 * kg;
    f32x4 v[8];
#pragma unroll
    for (int i = 0; i < 8; ++i) { v[i] = (f32x4){0.f, 0.f, 0.f, 0.f}; if (kk + i < Kr && n < Nr) v[i] = *(const f32x4*)(W + (size_t)(kk + i) * ldw + n); }
#pragma unroll
    for (int e = 0; e < 4; ++e) { const int nn = n + e; const int drow = mode == 0 ? row0 + nn : row0 + ((nn >> 7) << 8) + (nn & 127);
        v4u o; o.x = pk2(v[0][e], v[1][e]); o.y = pk2(v[2][e], v[3][e]); o.z = pk2(v[4][e], v[5][e]); o.w = pk2(v[6][e], v[7][e]);
        *(GAS v4u*)(WT + (size_t)drow * ldt + kk) = o; }
}
__device__ __forceinline__ void tr_item8(const float* W, int ldw, int Kr, int Nr, int nblk, unsigned char* WT, int ldt, int row0, int mode, float scale, int item, int lane) {
    const int kb = item / nblk, nb = item - kb * nblk, k0 = 64 * kb, n0 = 32 * nb;
    const int kg = lane >> 3, n = n0 + 4 * (lane & 7), kk = k0 + 8 * kg;
    f32x4 v[8];
#pragma unroll
    for (int i = 0; i < 8; ++i) { v[i] = (f32x4){0.f, 0.f, 0.f, 0.f}; if (kk + i < Kr && n < Nr) v[i] = *(const f32x4*)(W + (size_t)(kk + i) * ldw + n) * scale; }
#pragma unroll
    for (int e = 0; e < 4; ++e) { const int nn = n + e; const int drow = mode == 0 ? row0 + nn : row0 + ((nn >> 7) << 8) + (nn & 127);
        int lo = __builtin_amdgcn_cvt_pk_fp8_f32(v[0][e], v[1][e], 0, false); lo = __builtin_amdgcn_cvt_pk_fp8_f32(v[2][e], v[3][e], lo, true);
        int hi = __builtin_amdgcn_cvt_pk_fp8_f32(v[4][e], v[5][e], 0, false); hi = __builtin_amdgcn_cvt_pk_fp8_f32(v[6][e], v[7][e], hi, true);
        u32x2 o; o.x = (unsigned)lo; o.y = (unsigned)hi; *(GAS u32x2*)(WT + (size_t)drow * ldt + kk) = o; }
}
#define KIN(i) ({ const __attribute__((address_space(4))) char* k_ = (const __attribute__((address_space(4))) char*)__builtin_amdgcn_kernarg_segment_ptr(); asm volatile("" : "+s"(k_)); const GAS float* g_ = (const GAS float*)(*(const float* const __attribute__((address_space(4)))*)(k_ + 8 * (i))); asm volatile("" : "+s"(g_)); (const float*)g_; })
#define CONV_BEGIN() F.lane = fresh_lane(); F.tid = F.wave * 64 + F.lane; asm volatile("" : "+s"(F.G), "+s"(F.wave), "+s"(F.vcu), "+s"(F.gw), "+s"(F.NGW)); GAS unsigned char* cws0_ = (GAS unsigned char*)F.ws; asm volatile("" : "+s"(cws0_)); unsigned char* cws_ = (unsigned char*)cws0_; LAS float* scr_ = (LAS float*)(F.lds + RING_OFF + F.wave * 16384); int it_ = F.gw, base_ = 0
#define JOB(W, ldw, Kr, Nr, Kp, Np, WT, ldt, row0, mode) do { const int nblk_ = (Np) / 32, n_ = ((Kp) / 64) * nblk_; \
    while (it_ < base_ + n_) { tr_item((W), (ldw), (Kr), (Nr), nblk_, (WT), (ldt), (row0), (mode), scr_, it_ - base_, F.lane); it_ += F.NGW; } base_ += n_; } while (0)
#define JOB8(W, ldw, Kr, Nr, Kp, Np, WT, ldt, row0, mode, scale) do { const int nblk_ = (Np) / 32, n_ = ((Kp) / 64) * nblk_; \
    while (it_ < base_ + n_) { tr_item8((W), (ldw), (Kr), (Nr), nblk_, (WT), (ldt), (row0), (mode), (scale), it_ - base_, F.lane); it_ += F.NGW; } base_ += n_; } while (0)

__device__ __forceinline__ void conv_rwkv(Frame& F, int l) {
    CONV_BEGIN();
    cws_ += (size_t)l * RW_LSTRIDE; bf16* BT1 = (bf16*)(cws_ + WM_BT1); bf16* BT2 = (bf16*)(cws_ + WM_BT2); bf16* WO = (bf16*)(cws_ + WM_OUT);
    for (int c = 0; c < 3; ++c) JOB(KIN(I_WRKV) + (size_t)(l * 3 + c) * D * D, D, D, D, D, D, BT1, D, c * D, 0);
    JOB(KIN(I_W1) + (size_t)l * D * 64, 64, D, 64, D, 256, BT1, D, 3072, 0);
    JOB(KIN(I_A1) + (size_t)l * D * 64, 64, D, 64, D, 256, BT1, D, 3328, 0);
    JOB(KIN(I_V1), 32, D, (l == 0 ? 0 : 32), D, 256, BT1, D, 3584, 0);
    JOB(KIN(I_G1) + (size_t)l * D * 160, 160, D, 160, D, 256, BT1, D, 3840, 0);
    JOB(KIN(I_W2) + (size_t)l * 64 * D, D, 64, D, 256, D, BT2, 256, 0, 0);
    JOB(KIN(I_A2) + (size_t)l * 64 * D, D, 64, D, 256, D, BT2, 256, 1024, 0);
    JOB(KIN(I_V2), D, (l == 0 ? 0 : 32), D, 256, D, BT2, 256, 2048, 0);
    JOB(KIN(I_G2) + (size_t)l * 160 * D, D, 160, D, 256, D, BT2, 256, 3072, 0);
    JOB(KIN(I_WOUT) + (size_t)l * D * D, D, D, D, D, D, WO, D, 0, 0);
}
__device__ __forceinline__ void conv_moba(Frame& F, int j) {
    CONV_BEGIN();
    bf16* WQ = (bf16*)(cws_ + WM_QKV); bf16* WO = (bf16*)(cws_ + WM_O);
    JOB(KIN(I_MQ) + (size_t)j * D * D, D, D, D, D, D, WQ, D, 0, 0);
    if (j == 0) { JOB(KIN(I_MK), D, D, D, D, D, WQ, D, D, 0); JOB(KIN(I_MV), D, D, D, D, D, WQ, D, 2 * D, 0); }
    JOB(KIN(I_MO) + (size_t)j * D * D, D, D, D, D, D, WO, D, 0, 0);
}
__device__ __forceinline__ void conv_dense(Frame& F, int e) {
    CONV_BEGIN();
    bf16* GU = (bf16*)(cws_ + WF_GU); bf16* DN = (bf16*)(cws_ + WF_DN);
    JOB(KIN(I_FG) + (size_t)e * D * FF, FF, D, FF, D, FF, GU, D, 0, 1);
    JOB(KIN(I_FU) + (size_t)e * D * FF, FF, D, FF, D, FF, GU, D, 128, 1);
    JOB(KIN(I_FD) + (size_t)e * FF * D, D, FF, D, FF, D, DN, FF, 0, 0);
}
__device__ __forceinline__ void conv_moe(Frame& F, int e) {
    CONV_BEGIN();
    bf16* GU = (bf16*)(cws_ + WE_GU); bf16* DN = (bf16*)(cws_ + WE_DN);
    for (int x = 0; x < NE; ++x) {
        JOB8(KIN(I_EG) + (size_t)(e * NE + x) * D * FFE, FFE, D, FFE, D, FFE, (unsigned char*)GU, D, x * 2 * FFE, 1, MOE_WSCALE);
        JOB8(KIN(I_EU) + (size_t)(e * NE + x) * D * FFE, FFE, D, FFE, D, FFE, (unsigned char*)GU, D, x * 2 * FFE + 128, 1, MOE_WSCALE);
        JOB(KIN(I_ED) + (size_t)(e * NE + x) * FFE * D, D, FFE, D, FFE, D, DN, FFE, x * D, 0);
    }
}

__device__ __forceinline__ void ln_stats(const f32x4 (&v)[4], float& mean, float& rstd, int lane) {
    float s = 0.f;
#pragma unroll
    for (int j = 0; j < 4; ++j) s += (v[j].x + v[j].y) + (v[j].z + v[j].w);
    mean = wave_sum(s, lane) * (1.f / D); float s2 = 0.f;
#pragma unroll
    for (int j = 0; j < 4; ++j) { const f32x4 d = v[j] - mean; s2 += (d.x * d.x + d.y * d.y) + (d.z * d.z + d.w * d.w); }
    rstd = 1.f / sqrtf(wave_sum(s2, lane) * (1.f / D) + LN_EPS);
}
template <int SRC, bool ROUTER>
__device__ __forceinline__ void ln_phase(Frame& F, const float* PRE, const float* Hin, const float* YP, const int* tokr, const float* gln, const float* bln,
                                         float* Hout, bf16* HB, const float* router, int* toke, float* tokw, int* blkcnt) {
    LAS int* cnt = (LAS int*)(F.lds + RING_OFF + 131072 - 64);
    if (ROUTER) { if (F.tid < 8) cnt[F.tid] = 0; __syncthreads(); }
    f32x4 g4[4], b4[4];
#pragma unroll
    for (int j = 0; j < 4; ++j) { g4[j] = *(const f32x4*)(gln + 4 * F.lane + 256 * j); b4[j] = *(const f32x4*)(bln + 4 * F.lane + 256 * j); }
    const int rpb = M / F.G, rpw = rpb / NWAVES;
    for (int i = 0; i < rpw; ++i) {
        const int m = blockIdx.x * rpb + F.wave * rpw + i;
        f32x4 v[4];
        if (SRC == 0) {
#pragma unroll
            for (int j = 0; j < 4; ++j) v[j] = *(const f32x4*)(PRE + (size_t)m * D + 4 * F.lane + 256 * j);
        } else {
            const int r0 = tokr[2 * m], r1 = tokr[2 * m + 1];
#pragma unroll
            for (int j = 0; j < 4; ++j) { const int c = 4 * F.lane + 256 * j;
                f32x4 y0, y1;
                if (r0 < 32768) y0 = *(const f32x4*)(YP + (size_t)r0 * D + c); else { y0 = (f32x4){0.f, 0.f, 0.f, 0.f}; for (int s = 0; s < 7; ++s) y0 += *(const f32x4*)(PRE + ((size_t)s * 2048 + (r0 - 32768)) * D + c); }
                if (r1 < 32768) y1 = *(const f32x4*)(YP + (size_t)r1 * D + c); else { y1 = (f32x4){0.f, 0.f, 0.f, 0.f}; for (int s = 0; s < 7; ++s) y1 += *(const f32x4*)(PRE + ((size_t)s * 2048 + (r1 - 32768)) * D + c); }
                v[j] = *(const f32x4*)(Hin + (size_t)m * D + c) * ALPHA + y0 + y1; }
        }
        float mean, rstd; ln_stats(v, mean, rstd, F.lane);
#pragma unroll
        for (int j = 0; j < 4; ++j) { v[j] = (v[j] - mean) * rstd * g4[j] + b4[j];
            *(f32x4*)(Hout + (size_t)m * D + 4 * F.lane + 256 * j) = v[j];
            if (HB) *(u32x2*)(HB + (size_t)m * D + 4 * F.lane + 256 * j) = f32_to_bf4(v[j]); }
        if (ROUTER) {
            float lg[8];
#pragma unroll
            for (int e = 0; e < 8; ++e) lg[e] = 0.f;
#pragma unroll
            for (int j = 0; j < 4; ++j)
#pragma unroll
                for (int q = 0; q < 4; ++q) { const float xv = v[j][q]; const f32x4* rp = (const f32x4*)(router + (size_t)(4 * F.lane + 256 * j + q) * 8); const f32x4 ra = rp[0], rb = rp[1];
                    lg[0] += xv * ra.x; lg[1] += xv * ra.y; lg[2] += xv * ra.z; lg[3] += xv * ra.w; lg[4] += xv * rb.x; lg[5] += xv * rb.y; lg[6] += xv * rb.z; lg[7] += xv * rb.w; }
#pragma unroll
            for (int e = 0; e < 8; ++e) lg[e] = wave_sum(lg[e], F.lane);
            int e0 = 0; float l0 = lg[0];
#pragma unroll
            for (int e = 1; e < 8; ++e) if (lg[e] > l0) { l0 = lg[e]; e0 = e; }
            int e1 = -1; float l1 = -INFINITY;
#pragma unroll
            for (int e = 0; e < 8; ++e) if (e != e0 && lg[e] > l1) { l1 = lg[e]; e1 = e; }
            const float w0 = 1.f / (1.f + __expf(l1 - l0)), w1 = 1.f - w0;
            if (F.lane == 0) { toke[2 * m] = e0; toke[2 * m + 1] = e1; tokw[2 * m] = w0; tokw[2 * m + 1] = w1; atomicAdd((int*)&cnt[e0], 1); atomicAdd((int*)&cnt[e1], 1); }
        }
    }
    if (ROUTER) { __syncthreads(); if (F.tid < 8) blkcnt[blockIdx.x * 8 + F.tid] = cnt[F.tid]; }
}

__device__ __forceinline__ void mix_phase(Frame& F, const float* Hx, const float* mu, bf16* XM) {
    f32x4 mu4[6][4];
#pragma unroll
    for (int c = 0; c < 6; ++c)
#pragma unroll
        for (int j = 0; j < 4; ++j) mu4[c][j] = *(const f32x4*)(mu + c * D + 4 * F.lane + 256 * j);
    for (int m = F.gw; m < M; m += F.NGW) {
        const bool first = (m % T) == 0;
#pragma unroll
        for (int j = 0; j < 4; ++j) { const int c0 = 4 * F.lane + 256 * j;
            const f32x4 x = *(const f32x4*)(Hx + (size_t)m * D + c0);
            f32x4 xp = (f32x4){0.f, 0.f, 0.f, 0.f}; if (!first) xp = *(const f32x4*)(Hx + (size_t)(m - 1) * D + c0);
            const f32x4 xx = xp - x;
#pragma unroll
            for (int c = 0; c < 6; ++c) *(u32x2*)(XM + ((size_t)c * M + m) * D + c0) = f32_to_bf4(x + xx * mu4[c][j]); }
    }
}
__device__ __forceinline__ void prep_phase(Frame& F, int l, const bf16* RKV, const float* AA, const bf16* LH, const float* v0, const float* v2, bf16* VF, const float* k_k, const float* k_a, bf16* KP, bf16* AP, bf16* BP, bf16* VP) {
    f32x4 kk4[4], ka4[4];
#pragma unroll
    for (int j = 0; j < 4; ++j) { kk4[j] = *(const f32x4*)(k_k + 4 * F.lane + 256 * j); ka4[j] = *(const f32x4*)(k_a + 4 * F.lane + 256 * j); }
    for (int m = F.gw; m < M; m += F.NGW) {
#pragma unroll
        for (int j = 0; j < 4; ++j) { const size_t o = (size_t)m * D + 4 * F.lane + 256 * j;
            const f32x4 k = bf4_to_f32(*(const u32x2*)(RKV + (size_t)M * D + o)); const u32x2 vraw = *(const u32x2*)(RKV + (size_t)2 * M * D + o); f32x4 v = bf4_to_f32(vraw);
            const f32x4 a = *(const f32x4*)(AA + o);
            f32x4 kk = k * kk4[j]; const float ss = sum16((kk.x * kk.x + kk.y * kk.y) + (kk.z * kk.z + kk.w * kk.w));
            kk = kk * (1.0f / sqrtf(fmaxf(ss, 1e-24f)));
            const f32x4 kp = k * ((a - 1.0f) * ka4[j] + 1.0f);
            if (l == 0) *(u32x2*)(VF + o) = vraw;
            else {
                f32x4 z = *(const f32x4*)(v0 + 4 * F.lane + 256 * j);
                const bf16* lh = LH + (size_t)m * D + 512;
#pragma unroll 8
                for (int q = 0; q < 32; ++q) z += *(const f32x4*)(v2 + (size_t)q * D + 4 * F.lane + 256 * j) * bf2f(lh[q]);
                f32x4 vg; vg.x = 1.f / (1.f + __expf(-z.x)); vg.y = 1.f / (1.f + __expf(-z.y)); vg.z = 1.f / (1.f + __expf(-z.z)); vg.w = 1.f / (1.f + __expf(-z.w));
                const f32x4 vf = bf4_to_f32(*(const u32x2*)(VF + o)); v = v + (vf - v) * vg; }
            *(u32x2*)(KP + o) = f32_to_bf4(kp); *(u32x2*)(VP + o) = f32_to_bf4(v); *(u32x2*)(AP + o) = f32_to_bf4(-kk); *(u32x2*)(BP + o) = f32_to_bf4(kk * a); }
    }
}
__device__ __forceinline__ void post_phase(Frame& F, const bf16* Y, const bf16* R, const bf16* KP, const bf16* VP, const bf16* GG, const float* r_k, const float* gng, const float* gnb, bf16* YG) {
    f32x4 rk4[4], gg4[4], gb4[4];
#pragma unroll
    for (int j = 0; j < 4; ++j) { rk4[j] = *(const f32x4*)(r_k + 4 * F.lane + 256 * j); gg4[j] = *(const f32x4*)(gng + 4 * F.lane + 256 * j); gb4[j] = *(const f32x4*)(gnb + 4 * F.lane + 256 * j); }
    for (int m = F.gw; m < M; m += F.NGW) {
#pragma unroll
        for (int j = 0; j < 4; ++j) { const size_t o = (size_t)m * D + 4 * F.lane + 256 * j;
            const f32x4 y = bf4_to_f32(*(const u32x2*)(Y + o)), r = bf4_to_f32(*(const u32x2*)(R + o)), g = bf4_to_f32(*(const u32x2*)(GG + o));
            const f32x4 kp = bf4_to_f32(*(const u32x2*)(KP + o)), vp = bf4_to_f32(*(const u32x2*)(VP + o));
            const float mean = sum16((y.x + y.y) + (y.z + y.w)) * (1.f / 64.f); const f32x4 d = y - mean;
            const float var = sum16((d.x * d.x + d.y * d.y) + (d.z * d.z + d.w * d.w)) * (1.f / 64.f);
            const f32x4 rkk = r * kp * rk4[j]; const float bon = sum16((rkk.x + rkk.y) + (rkk.z + rkk.w));
            const f32x4 yn = d * (1.0f / sqrtf(var + GN_EPS)) * gg4[j] + gb4[j] + vp * bon;
            *(u32x2*)(YG + o) = f32_to_bf4(yn * g); }
    }
}
__device__ __forceinline__ float fma_s(float a, float b, float c) { float r; asm("v_fma_f32 %0, %1, %2, %3" : "=v"(r) : "v"(a), "v"(b), "v"(c)); return r; }
__device__ __forceinline__ float mul_s(float a, float b) { float r; asm("v_mul_f32_e32 %0, %1, %2" : "=v"(r) : "v"(a), "v"(b)); return r; }
__device__ __forceinline__ float add_s(float a, float b) { float r; asm("v_add_f32_e32 %0, %1, %2" : "=v"(r) : "v"(a), "v"(b)); return r; }
__device__ __forceinline__ float dot4_s(const f32x4& x, const f32x4& y) { return add_s(fma_s(x.y, y.y, mul_s(x.x, y.x)), fma_s(x.w, y.w, mul_s(x.z, y.z))); }
__device__ __forceinline__ f32x4 upd_s(const f32x4& S, const f32x4& w, const f32x4& b, float sa, const f32x4& k, float v) {
    f32x4 r; r.x = fma_s(S.x, w.x, fma_s(b.x, sa, mul_s(k.x, v))); r.y = fma_s(S.y, w.y, fma_s(b.y, sa, mul_s(k.y, v))); r.z = fma_s(S.z, w.z, fma_s(b.z, sa, mul_s(k.z, v))); r.w = fma_s(S.w, w.w, fma_s(b.w, sa, mul_s(k.w, v))); return r; }
__device__ __forceinline__ void scan_phase(Frame& F, const bf16* R, const float* DEC, const bf16* KP, const bf16* AP, const bf16* BP, const bf16* VP, bf16* Y) {
    constexpr int TS = 32, BUFB = 57600, YB_OFF = 2 * BUFB;
    const int head = F.vcu >> 3, part = F.vcu & 7, b = head >> 4, hh = head & 15;
    const size_t rowb = (size_t)b * T; const int col0 = hh * 64;
    const int tr = F.tid >> 4, pc = F.tid & 15;
    const int tr2 = (F.tid & 255) >> 3, pc2 = F.tid & 7;
    const int rr = F.lane >> 4, q = F.lane & 15, myrow = 8 * part + 4 * F.wave + rr;
    LAS unsigned char* L = F.lds + RING_OFF;
    struct Stg { f32x4 lw; u32x2 rk, ra, rb, rv, rn; v4u lr; };
    Stg g0, g1;
#define SC_LOAD(c, G) do { const int t_ = (c) * TS + tr; const size_t g_ = (rowb + t_) * D + col0 + pc * 4; G.lw = *(const f32x4*)(DEC + g_); G.rk = *(const u32x2*)(KP + g_); G.ra = *(const u32x2*)(AP + g_); \
        G.rb = *(const u32x2*)(BP + g_); G.rv = *(const u32x2*)(VP + g_); G.rn = (u32x2){0u, 0u}; if (t_ + 1 < T) G.rn = *(const u32x2*)(AP + g_ + D); \
        if (F.tid < 256) G.lr = *(const v4u*)(R + (rowb + (size_t)(c) * TS + tr2) * D + col0 + pc2 * 8); } while (0)
#define SC_STORE(bf, G) do { const f32x4 lk_ = bf4_to_f32(G.rk), la_ = bf4_to_f32(G.ra), lb_ = bf4_to_f32(G.rb), lv_ = bf4_to_f32(G.rv), ln_ = bf4_to_f32(G.rn); LAS unsigned char* d_ = L + (bf) * BUFB + tr * 256 + pc * 16; *(LAS f32x4*)(d_) = G.lw; *(LAS f32x4*)(d_ + 8192) = lk_; *(LAS f32x4*)(d_ + 16384) = la_; \
        *(LAS f32x4*)(d_ + 24576) = lb_; *(LAS f32x4*)(d_ + 32768) = lv_; *(LAS f32x4*)(d_ + 49152) = G.lw * ln_; \
        { const f32x4 pb_ = lb_ * ln_, pk_ = lk_ * ln_; const float be_ = dpp_sum16((pb_.x + pb_.y) + (pb_.z + pb_.w)), ga_ = dpp_sum16((pk_.x + pk_.y) + (pk_.z + pk_.w)); \
          if (pc == 0) { *(LAS float*)(L + (bf) * BUFB + 57344 + tr * 4) = be_; *(LAS float*)(L + (bf) * BUFB + 57472 + tr * 4) = ga_; } } \
        if (F.tid < 256) { LAS unsigned char* r_ = L + (bf) * BUFB + 40960 + tr2 * 256 + pc2 * 32; \
            *(LAS f32x4*)(r_) = (f32x4){__uint_as_float(G.lr.x << 16), __uint_as_float(G.lr.x & 0xffff0000u), __uint_as_float(G.lr.y << 16), __uint_as_float(G.lr.y & 0xffff0000u)}; \
            *(LAS f32x4*)(r_ + 16) = (f32x4){__uint_as_float(G.lr.z << 16), __uint_as_float(G.lr.z & 0xffff0000u), __uint_as_float(G.lr.w << 16), __uint_as_float(G.lr.w & 0xffff0000u)}; } } while (0)
    SC_LOAD(0, g0); SC_STORE(0, g0); SC_LOAD(1, g0); __syncthreads();
    f32x4 S = (f32x4){0.f, 0.f, 0.f, 0.f};
    constexpr int NCH = T / TS;
    for (int c2 = 0; c2 < NCH; c2 += 2) {
#pragma unroll
      for (int par = 0; par < 2; ++par) {
        const int c = c2 + par, bf = par;
        if (c + 2 < NCH) { if (par == 0) SC_LOAD(c + 2, g1); else SC_LOAD(c + 2, g0); }
        if (F.wave < 2) {
            const LAS unsigned char* B0 = L + bf * BUFB + q * 16; const LAS unsigned char* Bv = L + bf * BUFB + 32768 + myrow * 4; const LAS unsigned char* Bs = L + bf * BUFB + 57344;
            LAS unsigned short* yb = (LAS unsigned short*)(L + YB_OFF + bf * 512) + q * 8 + 4 * F.wave + rr;
            struct Rnd { f32x4 a, aw, w0, b0, k0, r0, w1, b1, k1, r1; float v0, v1, be, ga; };
#define SC_FETCH(t_, X) do { X.a = *(const LAS f32x4*)(B0 + 16384 + (t_) * 256); X.aw = *(const LAS f32x4*)(B0 + 49152 + (t_) * 256); \
            X.w0 = *(const LAS f32x4*)(B0 + (t_) * 256); X.b0 = *(const LAS f32x4*)(B0 + 24576 + (t_) * 256); X.k0 = *(const LAS f32x4*)(B0 + 8192 + (t_) * 256); X.r0 = *(const LAS f32x4*)(B0 + 40960 + (t_) * 256); \
            X.w1 = *(const LAS f32x4*)(B0 + ((t_) + 1) * 256); X.b1 = *(const LAS f32x4*)(B0 + 24576 + ((t_) + 1) * 256); X.k1 = *(const LAS f32x4*)(B0 + 8192 + ((t_) + 1) * 256); X.r1 = *(const LAS f32x4*)(B0 + 40960 + ((t_) + 1) * 256); \
            X.v0 = *(const LAS float*)(Bv + (t_) * 256); X.v1 = *(const LAS float*)(Bv + ((t_) + 1) * 256); X.be = *(const LAS float*)(Bs + (t_) * 4); X.ga = *(const LAS float*)(Bs + 128 + (t_) * 4); } while (0)
            Rnd cu; float ykeep = 0.f, yra = 0.f, yrb = 0.f;
#define RED_STEP(x, ctl) asm volatile("v_add_f32_dpp %0, %0, %0 " ctl " row_mask:0xf bank_mask:0xf bound_ctrl:1" : "+v"(x))
#define RED_STEP0(x, ctl) asm volatile("s_nop 1\n\tv_add_f32_dpp %0, %0, %0 " ctl " row_mask:0xf bank_mask:0xf bound_ctrl:1" : "+v"(x))
#define RED4(a_, b_, c_, d_) do { \
            RED_STEP0(a_, "quad_perm:[1,0,3,2]"); RED_STEP0(b_, "quad_perm:[1,0,3,2]"); RED_STEP0(c_, "quad_perm:[1,0,3,2]"); RED_STEP0(d_, "quad_perm:[1,0,3,2]"); \
            RED_STEP(a_, "quad_perm:[2,3,0,1]"); RED_STEP(b_, "quad_perm:[2,3,0,1]"); RED_STEP(c_, "quad_perm:[2,3,0,1]"); RED_STEP(d_, "quad_perm:[2,3,0,1]"); \
            RED_STEP(a_, "row_half_mirror"); RED_STEP(b_, "row_half_mirror"); RED_STEP(c_, "row_half_mirror"); RED_STEP(d_, "row_half_mirror"); \
            RED_STEP(a_, "row_mirror"); RED_STEP(b_, "row_mirror"); RED_STEP(c_, "row_mirror"); RED_STEP(d_, "row_mirror"); } while (0)
            SC_FETCH(0, cu);
#pragma unroll
            for (int t = 0; t < TS; t += 2) {
                Rnd nx = cu;
                if (t + 2 < TS) SC_FETCH(t + 2, nx);
                const f32x4 p1 = S * cu.a, p2 = S * cu.aw;
                float u1 = (p1.x + p1.y) + (p1.z + p1.w), u2 = (p2.x + p2.y) + (p2.z + p2.w);
                RED4(u1, u2, yra, yrb);
                if (t > 0) { ykeep = (q == ((t - 2) & 15)) ? yra : ykeep; ykeep = (q == ((t - 1) & 15)) ? yrb : ykeep;
                             if (((t - 1) & 15) == 15) yb[(t - 16) * 8] = (unsigned short)f2bf(ykeep); }
                const float sa0 = u1, sa1 = u2 + sa0 * cu.be + cu.v0 * cu.ga;
                S = S * cu.w0 + (cu.b0 * sa0 + cu.k0 * cu.v0);
                const f32x4 y4a = S * cu.r0;
                S = S * cu.w1 + (cu.b1 * sa1 + cu.k1 * cu.v1);
                const f32x4 y4b = S * cu.r1;
                yra = (y4a.x + y4a.y) + (y4a.z + y4a.w); yrb = (y4b.x + y4b.y) + (y4b.z + y4b.w);
                cu = nx;
            }
            { float d0_ = 0.f, d1_ = 0.f; RED4(yra, yrb, d0_, d1_);
              ykeep = (q == 14) ? yra : ykeep; ykeep = (q == 15) ? yrb : ykeep; yb[16 * 8] = (unsigned short)f2bf(ykeep); }
#undef RED4
#undef RED_STEP0
#undef RED_STEP
#undef SC_FETCH
        }
        if (c + 1 < NCH) { if (par == 0) SC_STORE(1, g0); else SC_STORE(0, g1); }
        __syncthreads();
        if (F.tid < 32) { const v4u yv = *(const LAS v4u*)(L + YB_OFF + bf * 512 + F.tid * 16);
            *(v4u*)(Y + (rowb + (size_t)c * TS + F.tid) * D + col0 + part * 8) = yv; }
      }
    }
#undef SC_LOAD
#undef SC_STORE
}

__device__ __forceinline__ void kmean_phase(Frame& F, const bf16* Kb, float* KM) {
    LAS float* red = (LAS float*)(F.lds + RING_OFF);
    for (int u = blockIdx.x; u < 2 * 32 * 4; u += F.G) {
        const int qc = u & 3, blk = (u >> 2) & 31, b = u >> 7; const int c = F.tid & 255, rh = F.tid >> 8;
        const bf16* p = Kb + ((size_t)b * T + blk * 256 + rh * 128) * D + qc * 256 + c; float s = 0.f;
#pragma unroll 8
        for (int r = 0; r < 128; ++r) s += bf2f(p[(size_t)r * D]);
        if (rh == 1) red[c] = s;
        __syncthreads();
        if (rh == 0) { const int col = qc * 256 + c; KM[(((size_t)b * H + (col >> 6)) * 32 + blk) * 64 + (col & 63)] = (s + red[c]) * (1.f / 256.f); }
        __syncthreads();
    }
}
__device__ __forceinline__ void gate_phase(Frame& F, const bf16* Q, const float* KM, unsigned* SEL) {
    LAS float* km = (LAS float*)(F.lds + RING_OFF);
    for (int u = blockIdx.x; u < M / 64; u += F.G) {
        const int m0 = u * 64, b = m0 / T, own = (m0 % T) >> 8;
        for (int i = F.tid; i < 16 * 32 * 16; i += NWAVES * 64) *(LAS f32x4*)(km + 4 * i) = *(const f32x4*)(KM + (size_t)b * 16 * 32 * 64 + 4 * i);
        __syncthreads();
        const int m = m0 + F.lane;
#pragma unroll 1
        for (int hi = 0; hi < 2; ++hi) { const int h = 2 * F.wave + hi;
            float qv[64];
#pragma unroll
            for (int i = 0; i < 8; ++i) { const v4u w = *(const v4u*)(Q + (size_t)m * D + h * 64 + 8 * i);
                qv[8 * i + 0] = __uint_as_float(w.x << 16); qv[8 * i + 1] = __uint_as_float(w.x & 0xffff0000u); qv[8 * i + 2] = __uint_as_float(w.y << 16); qv[8 * i + 3] = __uint_as_float(w.y & 0xffff0000u);
                qv[8 * i + 4] = __uint_as_float(w.z << 16); qv[8 * i + 5] = __uint_as_float(w.z & 0xffff0000u); qv[8 * i + 6] = __uint_as_float(w.w << 16); qv[8 * i + 7] = __uint_as_float(w.w & 0xffff0000u); }
            float v0 = -INFINITY, v1 = -INFINITY, v2 = -INFINITY; int i0 = -1, i1 = -1, i2 = -1;
            for (int j = 0; j < own; ++j) { const LAS f32x4* kp = (const LAS f32x4*)(km + (h * 32 + j) * 64); float s = 0.f;
#pragma unroll
                for (int i = 0; i < 16; ++i) { const f32x4 kv = kp[i]; s += qv[4 * i] * kv.x + qv[4 * i + 1] * kv.y + qv[4 * i + 2] * kv.z + qv[4 * i + 3] * kv.w; }
                if (s > v0) { v2 = v1; i2 = i1; v1 = v0; i1 = i0; v0 = s; i0 = j; } else if (s > v1) { v2 = v1; i2 = i1; v1 = s; i1 = j; } else if (s > v2) { v2 = s; i2 = j; } }
            unsigned mask = 0u; if (i0 >= 0) mask |= 1u << i0; if (i1 >= 0) mask |= 1u << i1; if (i2 >= 0) mask |= 1u << i2;
            SEL[((size_t)b * H + h) * T + (m % T)] = mask; }
        __syncthreads();
    }
}

__device__ __forceinline__ void moe_prefix(Frame& F, const int* blkcnt, LAS int* pre_mine  ) {
    LAS int* tmp = (LAS int*)(F.lds + RING_OFF);
    for (int i = F.tid; i < F.G * 8; i += NWAVES * 64) tmp[i] = blkcnt[i];
    __syncthreads();
    if (F.tid < 8) { int tot = 0, mine = 0; for (int g = 0; g < F.G; ++g) { if (g == (int)blockIdx.x) mine = tot; tot += tmp[g * 8 + F.tid]; }
        pre_mine[F.tid] = mine; pre_mine[8 + F.tid] = tot; }
    __syncthreads();
    if (F.tid == 0) { int p = 0; for (int e = 0; e < 8; ++e) { F.MISC[16 + e] = (unsigned)p; p += (pre_mine[8 + e] + 255) >> 8; } F.MISC[24] = (unsigned)p; }
    __syncthreads();
}
__device__ __forceinline__ void moe_gather_phase(Frame& F, const int* blkcnt, const int* toke, const float* tokw, int* tokr, float* gw, const float* Hs, unsigned char* XG) {
    LAS int* pm = (LAS int*)(F.lds + RING_OFF + 16384);
    LAS int* rows = (LAS int*)(F.lds + RING_OFF + 16384 + 64);
    moe_prefix(F, blkcnt, pm);
    const int rpb = M / F.G;
    if (F.wave == 0) {
        const int m = blockIdx.x * rpb + F.lane; const bool ok = F.lane < rpb;
        const int e0 = ok ? toke[2 * m] : -1, e1 = ok ? toke[2 * m + 1] : -1;
        int r0 = 0, r1 = 0;
        for (int e = 0; e < 8; ++e) { const unsigned long long b0 = __ballot(e0 == e), b1 = __ballot(e1 == e); const unsigned long long lt = (1ull << F.lane) - 1ull;
            const int base = (int)F.MISC[16 + e] * 256 + pm[e];
            if (e0 == e) r0 = base + __popcll(b0 & lt);
            if (e1 == e) r1 = base + __popcll(b0) + __popcll(b1 & lt); }
        if (ok) { tokr[2 * m] = r0; tokr[2 * m + 1] = r1; gw[r0] = tokw[2 * m]; gw[r1] = tokw[2 * m + 1]; rows[2 * F.lane] = r0; rows[2 * F.lane + 1] = r1; }
    }
    __syncthreads();
    for (int i = F.wave; i < 2 * rpb; i += NWAVES) { const int m = blockIdx.x * rpb + (i >> 1), r = rows[i];
        const f32x4* s = (const f32x4*)(Hs + (size_t)m * D + 16 * F.lane); const f32x4 a = s[0], b_ = s[1], c = s[2], d = s[3];
        v4u o; int w;
        w = __builtin_amdgcn_cvt_pk_fp8_f32(a.x, a.y, 0, false); w = __builtin_amdgcn_cvt_pk_fp8_f32(a.z, a.w, w, true); o.x = (unsigned)w;
        w = __builtin_amdgcn_cvt_pk_fp8_f32(b_.x, b_.y, 0, false); w = __builtin_amdgcn_cvt_pk_fp8_f32(b_.z, b_.w, w, true); o.y = (unsigned)w;
        w = __builtin_amdgcn_cvt_pk_fp8_f32(c.x, c.y, 0, false); w = __builtin_amdgcn_cvt_pk_fp8_f32(c.z, c.w, w, true); o.z = (unsigned)w;
        w = __builtin_amdgcn_cvt_pk_fp8_f32(d.x, d.y, 0, false); w = __builtin_amdgcn_cvt_pk_fp8_f32(d.z, d.w, w, true); o.w = (unsigned)w;
        *(v4u*)(XG + (size_t)r * D + 16 * F.lane) = o; }
    __syncthreads();
}
__device__ __forceinline__ void attn_direct_phase(Frame& F, const bf16* Q, const bf16* Kb, const bf16* Vb, const unsigned* SEL, bf16* O) {
    for (int u = F.gw; u < (M / 64) * H; u += F.NGW) {
        const int h = u & 15, m0 = (u >> 4) * 64, b = m0 / T, t0 = m0 % T, own = t0 >> 8, m = m0 + F.lane, tpos = t0 + F.lane;
        float q[64], o[64];
#pragma unroll
        for (int i = 0; i < 8; ++i) { const v4u w = *(const v4u*)(Q + (size_t)m * D + h * 64 + 8 * i);
            q[8 * i + 0] = __uint_as_float(w.x << 16); q[8 * i + 1] = __uint_as_float(w.x & 0xffff0000u); q[8 * i + 2] = __uint_as_float(w.y << 16); q[8 * i + 3] = __uint_as_float(w.y & 0xffff0000u);
            q[8 * i + 4] = __uint_as_float(w.z << 16); q[8 * i + 5] = __uint_as_float(w.z & 0xffff0000u); q[8 * i + 6] = __uint_as_float(w.w << 16); q[8 * i + 7] = __uint_as_float(w.w & 0xffff0000u); }
#pragma unroll
        for (int i = 0; i < 64; ++i) o[i] = 0.f;
        const unsigned sel = SEL[((size_t)b * H + h) * T + tpos];
        float mrun = -INFINITY, l = 0.f;
        for (int j = 0; j <= own; ++j) {
            const bool pastsel = (sel >> j) & 1u;
            if (j < own && !__any(pastsel)) continue;
            const int nk = (j < own) ? 256 : (t0 & 255) + 64;
            for (int kk = 0; kk < nk; ++kk) {
                const int kpos = j * 256 + kk; const size_t ro = ((size_t)b * T + kpos) * D + h * 64;
                float s = 0.f;
#pragma unroll
                for (int i = 0; i < 8; ++i) { const v4u w = *(const v4u*)(Kb + ro + 8 * i);
                    s += q[8 * i + 0] * __uint_as_float(w.x << 16) + q[8 * i + 1] * __uint_as_float(w.x & 0xffff0000u) + q[8 * i + 2] * __uint_as_float(w.y << 16) + q[8 * i + 3] * __uint_as_float(w.y & 0xffff0000u)
                       + q[8 * i + 4] * __uint_as_float(w.z << 16) + q[8 * i + 5] * __uint_as_float(w.z & 0xffff0000u) + q[8 * i + 6] * __uint_as_float(w.w << 16) + q[8 * i + 7] * __uint_as_float(w.w & 0xffff0000u); }
                const bool act = (j < own) ? pastsel : (kpos <= tpos);
                if (act) {
                    if (s > mrun) { const float c = exp2f(mrun - s); l *= c;
#pragma unroll
                        for (int i = 0; i < 64; ++i) o[i] *= c;
                        mrun = s; }
                    const float p = exp2f(s - mrun); l += p;
#pragma unroll
                    for (int i = 0; i < 8; ++i) { const v4u w = *(const v4u*)(Vb + ro + 8 * i);
                        o[8 * i + 0] += p * __uint_as_float(w.x << 16); o[8 * i + 1] += p * __uint_as_float(w.x & 0xffff0000u); o[8 * i + 2] += p * __uint_as_float(w.y << 16); o[8 * i + 3] += p * __uint_as_float(w.y & 0xffff0000u);
                        o[8 * i + 4] += p * __uint_as_float(w.z << 16); o[8 * i + 5] += p * __uint_as_float(w.z & 0xffff0000u); o[8 * i + 6] += p * __uint_as_float(w.w << 16); o[8 * i + 7] += p * __uint_as_float(w.w & 0xffff0000u); }
                }
            }
        }
        const float rl = 1.0f / l;
#pragma unroll
        for (int i = 0; i < 8; ++i) { v4u w; w.x = pk2(o[8 * i] * rl, o[8 * i + 1] * rl); w.y = pk2(o[8 * i + 2] * rl, o[8 * i + 3] * rl); w.z = pk2(o[8 * i + 4] * rl, o[8 * i + 5] * rl); w.w = pk2(o[8 * i + 6] * rl, o[8 * i + 7] * rl);
            *(v4u*)(O + (size_t)m * D + h * 64 + 8 * i) = w; }
    }
}
namespace moba {
using attn_body::f32x16; using attn_body::crow;
constexpr int L_K = 0, L_V = 32768, L_LIST = 65536, L_WS = 81920, L_CTL = 84992;
__device__ __forceinline__ void qkt_l(f32x16& p0, f32x16& p1, const LAS unsigned char* Kslot, const bf16x8* qr, int r32, int hi) {
    const LAS unsigned char* kb = Kslot + hi * 1024 + r32 * 16;
#pragma unroll
    for (int d0 = 0; d0 < 4; ++d0) {
        const bf16x8 b0 = *(const LAS bf16x8*)(kb + d0 * 2048), b1 = *(const LAS bf16x8*)(kb + d0 * 2048 + 512);
        if (d0 == 0) { p0 = __builtin_amdgcn_mfma_f32_32x32x16_bf16(b0, qr[0], f32x16{}, 0, 0, 0); p1 = __builtin_amdgcn_mfma_f32_32x32x16_bf16(b1, qr[0], f32x16{}, 0, 0, 0); }
        else { p0 = __builtin_amdgcn_mfma_f32_32x32x16_bf16(b0, qr[d0], p0, 0, 0, 0); p1 = __builtin_amdgcn_mfma_f32_32x32x16_bf16(b1, qr[d0], p1, 0, 0, 0); } }
}
__device__ __forceinline__ float half_max(float v) { auto rr = __builtin_amdgcn_permlane32_swap(__float_as_uint(v), __float_as_uint(v), false, false); return fmaxf(__uint_as_float(rr[0]), __uint_as_float(rr[1])); }
__device__ __forceinline__ float half_sum(float v) { auto rr = __builtin_amdgcn_permlane32_swap(__float_as_uint(v), __float_as_uint(v), false, false); return __uint_as_float(rr[0]) + __uint_as_float(rr[1]); }
}
__device__ __forceinline__ void moba_attn_phase(Frame& F, const bf16* Q, const bf16* Kb, const bf16* Vb, const unsigned* SELT, bf16* PO, float* ML, gu32* qctr) {
    using namespace moba;
    const int lane = F.lane, wid = F.wave, r32 = lane & 31, hi = lane >> 5;
    LAS unsigned char* L = F.lds + RING_OFF;
    LAS unsigned short* list = (LAS unsigned short*)(L + L_LIST);
    LAS float* wsf = (LAS float*)(L + L_WS + wid * 256); LAS int* wsd = (LAS int*)(L + L_WS + wid * 256 + 128);
    LAS int* ctl = (LAS int*)(L + L_CTL);
    const int vb0 = RING_OFF + L_V + ((lane >> 4) & 1) * 32 + (lane & 3) * 8 + (4 * hi + ((lane & 15) >> 2)) * 64;
    for (;;) {
        __syncthreads();
        if (F.tid == 0) { ctl[0] = (int)__hip_atomic_fetch_add(qctr, 1u, __ATOMIC_RELAXED, __HIP_MEMORY_SCOPE_AGENT); ctl[1] = 0; }
        __syncthreads();
        const int u = __builtin_amdgcn_readfirstlane(ctl[0]);
        if (u >= 32 * 32) break;
        const int j = u >> 5, bh = u & 31, b = bh >> 4, h = bh & 15;
        const size_t rowb = (size_t)b * T;
        { const bf16* ksrc = Kb + (rowb + 256 * j + lane) * D + h * 64 + wid * 8;
          const bf16* vsrc = Vb + (rowb + 256 * j + 16 * (wid & 3) + (lane >> 2)) * D + h * 64 + (wid >> 2) * 32 + (lane & 3) * 8;
#pragma unroll
          for (int kt = 0; kt < 4; ++kt) { attn_body::glds16(ksrc + (size_t)kt * 64 * D, (unsigned)__builtin_amdgcn_readfirstlane(RING_OFF + L_K + kt * 8192 + wid * 1024));
                                           attn_body::glds16(vsrc + (size_t)kt * 64 * D, (unsigned)__builtin_amdgcn_readfirstlane(RING_OFF + L_V + kt * 8192 + wid * 1024)); } }
        const unsigned* selrow = SELT + (size_t)bh * T;
        for (int t0 = 256 * (j + 1); t0 < T; t0 += NWAVES * 64) { const int t = t0 + F.tid; const bool in = t < T;
            const bool p = in && ((selrow[in ? t : 0] >> j) & 1u);
            const unsigned long long bal = __ballot(p); const int np = __popcll(bal);
            int base = 0; if (lane == 0 && np) base = __hip_atomic_fetch_add(&ctl[1], np, __ATOMIC_RELAXED, __HIP_MEMORY_SCOPE_WORKGROUP);
            base = __builtin_amdgcn_readfirstlane(base);
            if (p) list[base + __popcll(bal & ((1ull << lane) - 1ull))] = (unsigned short)t; }
        asm volatile("s_waitcnt vmcnt(0) lgkmcnt(0)" ::: "memory");
        __syncthreads();
        const int total = 256 + ctl[1], nb = (total + 31) >> 5;
        for (int bi = wid; bi < nb; bi += NWAVES) {
            const int item = bi * 32 + r32; const bool valid = item < total; const int it2 = valid ? item : total - 1;
            const bool ownb = bi < 8;
            const int t = it2 < 256 ? 256 * j + it2 : (int)list[it2 - 256];
            const bf16* qrow = Q + (rowb + t) * D + h * 64;
            bf16x8 qr[4];
#pragma unroll
            for (int d0 = 0; d0 < 4; ++d0) qr[d0] = *(const bf16x8*)(qrow + d0 * 16 + hi * 8);
            f32x16 P[4][2];
#pragma unroll
            for (int kt = 0; kt < 4; ++kt) qkt_l(P[kt][0], P[kt][1], L + L_K + kt * 8192, qr, r32, hi);
            if (ownb) {
#pragma unroll
                for (int kt = 0; kt < 4; ++kt) attn_body::cmask(P[kt][0], P[kt][1], kt, t - 256 * j, hi); }
            float mx = -INFINITY;
#pragma unroll
            for (int kt = 0; kt < 4; ++kt)
#pragma unroll
                for (int r = 0; r < 16; ++r) mx = fmaxf(mx, fmaxf(P[kt][0][r], P[kt][1][r]));
            mx = half_max(mx);
            float ls = 0.f;
#pragma unroll
            for (int kt = 0; kt < 4; ++kt)
#pragma unroll
                for (int r = 0; r < 16; ++r) { P[kt][0][r] = __builtin_amdgcn_exp2f(P[kt][0][r] - mx); P[kt][1][r] = __builtin_amdgcn_exp2f(P[kt][1][r] - mx); ls += P[kt][0][r] + P[kt][1][r]; }
            ls = half_sum(ls);
            f32x16 o[2]; o[0] = f32x16{}; o[1] = f32x16{};
#pragma unroll
            for (int kt = 0; kt < 4; ++kt) {
                attn_body::u32x4 w0, w1, w2, w3;
#define PKW_(P_, B_) attn_body::cvtpk_s(P_[B_], P_[B_ + 1])
                w0 = (attn_body::u32x4){PKW_(P[kt][0], 0), PKW_(P[kt][0], 2), PKW_(P[kt][0], 4), PKW_(P[kt][0], 6)}; w1 = (attn_body::u32x4){PKW_(P[kt][0], 8), PKW_(P[kt][0], 10), PKW_(P[kt][0], 12), PKW_(P[kt][0], 14)};
                w2 = (attn_body::u32x4){PKW_(P[kt][1], 0), PKW_(P[kt][1], 2), PKW_(P[kt][1], 4), PKW_(P[kt][1], 6)}; w3 = (attn_body::u32x4){PKW_(P[kt][1], 8), PKW_(P[kt][1], 10), PKW_(P[kt][1], 12), PKW_(P[kt][1], 14)};
#undef PKW_
                attn_body::pv(o, vb0 + kt * 8192, __builtin_bit_cast(bf16x8, w0), __builtin_bit_cast(bf16x8, w1), __builtin_bit_cast(bf16x8, w2), __builtin_bit_cast(bf16x8, w3)); }
            const unsigned sel = selrow[t];
            const int slot = ownb ? 3 : __popc(sel & ((1u << j) - 1u));
            const int dest = (int)(((rowb + t) * H + h) * 4 + slot);
            if (hi == 0) { wsf[r32] = 1.0f / ls; wsd[r32] = valid ? dest : -1; if (valid) { ML[(size_t)dest * 2] = mx; ML[(size_t)dest * 2 + 1] = ls; } }
            asm volatile("s_waitcnt lgkmcnt(0)" ::: "memory");
#pragma unroll
            for (int r = 0; r < 16; ++r) { const int row = crow(r, hi); const float rl = wsf[row]; const int d = wsd[row];
                if (d >= 0) { PO[(size_t)d * 64 + r32] = (bf16)f2bf(o[0][r] * rl); PO[(size_t)d * 64 + 32 + r32] = (bf16)f2bf(o[1][r] * rl); } }
            asm volatile("s_waitcnt lgkmcnt(0)" ::: "memory");
        }
    }
}
__device__ __forceinline__ void moba_combine_phase(Frame& F, const unsigned* SELT, const bf16* PO, const float* ML, bf16* O) {
    for (int m = F.gw; m < M; m += F.NGW) {
        const int b = m / T, t = m % T, h = F.lane >> 2, qd = F.lane & 3;
        const unsigned sel = SELT[((size_t)b * H + h) * T + t]; const int cnt = __popc(sel);
        const size_t base = ((size_t)m * H + h) * 4;
        float ms[4], ls[4]; float mstar = -INFINITY;
#pragma unroll
        for (int s = 0; s < 4; ++s) { const bool on = (s == 3) || (s < cnt); ms[s] = on ? ML[(base + s) * 2] : -INFINITY; ls[s] = on ? ML[(base + s) * 2 + 1] : 0.f; mstar = fmaxf(mstar, ms[s]); }
        float wsum = 0.f, w[4];
#pragma unroll
        for (int s = 0; s < 4; ++s) { w[s] = ls[s] * __builtin_amdgcn_exp2f(ms[s] - mstar); wsum += w[s]; }
        const float rw = 1.0f / wsum;
        float acc[16];
#pragma unroll
        for (int i = 0; i < 16; ++i) acc[i] = 0.f;
#pragma unroll
        for (int s = 0; s < 4; ++s) { const bool on = (s == 3) || (s < cnt);
            if (on) { const float ws_ = w[s] * rw; const v4u a = *(const v4u*)(PO + (base + s) * 64 + qd * 16), c = *(const v4u*)(PO + (base + s) * 64 + qd * 16 + 8);
                const unsigned wv[8] = {a.x, a.y, a.z, a.w, c.x, c.y, c.z, c.w};
#pragma unroll
                for (int i = 0; i < 8; ++i) { acc[2 * i] += ws_ * __uint_as_float(wv[i] << 16); acc[2 * i + 1] += ws_ * __uint_as_float(wv[i] & 0xffff0000u); } } }
        v4u o0, o1; o0.x = pk2(acc[0], acc[1]); o0.y = pk2(acc[2], acc[3]); o0.z = pk2(acc[4], acc[5]); o0.w = pk2(acc[6], acc[7]); o1.x = pk2(acc[8], acc[9]); o1.y = pk2(acc[10], acc[11]); o1.z = pk2(acc[12], acc[13]); o1.w = pk2(acc[14], acc[15]);
        *(v4u*)(O + (size_t)m * D + h * 64 + qd * 16) = o0; *(v4u*)(O + (size_t)m * D + h * 64 + qd * 16 + 8) = o1;
    }
}


#ifdef DBG_CUT
__device__ __forceinline__ void dbg_copy(Frame& F, const void* src, bool is_bf16, float* out) {
    for (size_t i = (size_t)F.gw * 64 + F.lane; i < (size_t)M * D; i += (size_t)F.NGW * 64) out[i] = is_bf16 ? bf2f(((const bf16*)src)[i]) : ((const float*)src)[i];
}
#ifndef DBG_LAYER
#define DBG_LAYER -1
#endif
#define CUT(k, off, isbf) if (DBG_CUT == (k) && (DBG_LAYER < 0 || layer == DBG_LAYER)) { unsigned char* ws = WSB(); dbg_copy(F, ws + (off), (isbf), GOUT()); return; }
#else
#define CUT(k, off, isbf)
#endif
#ifndef REP_GEMM
#define REP_GEMM 1
#endif
#ifndef REP_THIN
#define REP_THIN 1
#endif
#ifndef REP_CONV
#define REP_CONV REP_THIN
#endif
#ifndef REP_LN
#define REP_LN REP_THIN
#endif
#ifndef REP_RW
#define REP_RW REP_THIN
#endif
#ifndef REP_ATTN
#define REP_ATTN 1
#endif
#ifndef REP_BAR
#define REP_BAR 1
#endif
#define GEMM_BIG(EpiT, SchedT) for (int rg_ = 0; rg_ < REP_GEMM; ++rg_) pg8::gemm_phase<EpiT, SchedT, true, true>
#define GEMM_ONE(EpiT, SchedT) for (int rg_ = 0; rg_ < REP_GEMM; ++rg_) pg8::gemm_phase<EpiT, SchedT, false, true>
__global__ void __launch_bounds__(NWAVES * 64, 2) fwd_kernel(Args args) {
    extern __shared__ __attribute__((aligned(16))) unsigned char lds[];
    Frame F;
    F.lds = (LAS unsigned char*)lds; F.MISC = (volatile LAS unsigned*)(F.lds + MISC_OFF);
    F.wave = __builtin_amdgcn_readfirstlane((int)threadIdx.x >> 6); F.lane = fresh_lane(); F.tid = F.wave * 64 + F.lane;
    F.G = gridDim.x; { const int bx = blockIdx.x; F.vcu = (F.G % 8 == 0) ? (bx % 8) * (F.G / 8) + bx / 8 : bx; }
    F.gw = F.vcu * NWAVES + F.wave; F.NGW = F.G * NWAVES;
    F.ws = args.ws; F.ctl = (gu32*)(args.ws + WS_CTL);
#ifdef DBG_LDSZERO
    for (int u = F.tid; u < LDS_BYTES / 4; u += NWAVES * 64) ((LAS unsigned*)(F.lds))[u] = 0u;
#else
    for (int u = F.tid; u < (LDS_BYTES - LDSCTL_OFF) / 4; u += NWAVES * 64) ((LAS unsigned*)(F.lds + LDSCTL_OFF))[u] = 0u;
#endif
    __syncthreads();
    XcdBarrier bar = xcd_barrier_post((unsigned*)(F.ctl + CW_BAR), F.MISC + 8, F.tid == 0);
#define GRID_BAR() do { { GAS unsigned* b_ = (GAS unsigned*)bar.bar; asm volatile("" : "+s"(b_), "+s"(bar.x)); bar.bar = (unsigned*)b_; } for (int rb_ = 0; rb_ < REP_BAR; ++rb_) xcd_barrier(bar, F.wave == 0 && fresh_lane() == 0); } while (0)
#define WSB() ({ F.lane = fresh_lane(); F.tid = F.wave * 64 + F.lane; asm volatile("" : "+s"(F.G), "+s"(F.wave), "+s"(F.vcu), "+s"(F.gw), "+s"(F.NGW), "+s"(bx)); GAS unsigned char* p_ = (GAS unsigned char*)args.ws; asm volatile("" : "+s"(p_)); (unsigned char*)p_; })
#define GOUT() ({ GAS float* o_ = (GAS float*)args.out; asm volatile("" : "+s"(o_)); (float*)o_; })
#define INP(i) ({ const __attribute__((address_space(4))) char* k_ = (const __attribute__((address_space(4))) char*)__builtin_amdgcn_kernarg_segment_ptr(); asm volatile("" : "+s"(k_)); const GAS float* g_ = (const GAS float*)(*(const float* const __attribute__((address_space(4)))*)(k_ + 8 * (i))); asm volatile("" : "+s"(g_)); (const float*)g_; })
    LAS unsigned char* ring = F.lds + RING_OFF;
    int bx = (int)blockIdx.x;

    for (int rt_ = 0; rt_ < REP_CONV; ++rt_) conv_rwkv(F, 0); for (int rt_ = 0; rt_ < REP_CONV; ++rt_) conv_dense(F, 0);
    GRID_BAR();

#ifndef LAYER_LO
#define LAYER_LO 0
#define LAYER_HI 4
#endif
    for (int layer = LAYER_LO; layer < LAYER_HI; ++layer) {
        const bool moe = (layer & 1) != 0; const int fe = layer >> 1;
        if (layer < 2) {
            const int l = layer;
            { unsigned char* ws = WSB(); for (int rt_ = 0; rt_ < REP_RW; ++rt_) mix_phase(F, layer == 0 ? INP(I_X) : (const float*)(ws + WS_H), INP(I_MU) + (size_t)l * 6 * D, (bf16*)(ws + RS_XM)); }
            GRID_BAR();
            { unsigned char* ws = WSB(); pg8::Gemm g{D, D, D}; pg8::SchedStd S; S.init(M, 4096, F.G, bx, ws + RS_XM, D, ws + WM_BT1 + (size_t)l * RW_LSTRIDE, D, 1, (size_t)M * D * 2);
              pg8::EpiRkv E{(bf16*)(ws + RS_RKV), (long)RS_LH - (long)RS_RKV, (size_t)M * D};
              GEMM_BIG(pg8::EpiRkv, pg8::SchedStd)(ring, g, S, E, F.wave); }
            GRID_BAR();
            CUT(1, RS_RKV, true)
            { unsigned char* ws = WSB(); pg8::Gemm g{256, D, 256}; pg8::SchedStd S; S.init(M, 4096, F.G, bx, ws + RS_LH, D, ws + WM_BT2 + (size_t)l * RW_LSTRIDE, 256, 2, 0);
              pg8::EpiLoraUpAll E{{(void*)(ws + RS_DEC), INP(I_W0) + (size_t)l * D}, {(void*)(ws + RS_AB), INP(I_A0) + (size_t)l * D}, {(void*)(ws + RS_VG), INP(I_V0)}, {(void*)(ws + RS_GG), nullptr}};
              GEMM_BIG(pg8::EpiLoraUpAll, pg8::SchedStd)(ring, g, S, E, F.wave); }
            GRID_BAR();
            CUT(2, RS_DEC, false) CUT(60, RS_VG, true) CUT(61, RS_GG, true) CUT(62, RS_LH, true) CUT(63, RS_AB, false)
            { unsigned char* ws = WSB(); for (int rt_ = 0; rt_ < REP_RW; ++rt_) prep_phase(F, l, (bf16*)(ws + RS_RKV), (const float*)(ws + RS_AB), (bf16*)(ws + RS_LH), INP(I_V0), INP(I_V2), (bf16*)(ws + WS_VFIRST), INP(I_KK) + (size_t)l * D, INP(I_KA) + (size_t)l * D,
                                                   (bf16*)(ws + RS_KP), (bf16*)(ws + RS_AP), (bf16*)(ws + RS_BP), (bf16*)(ws + RS_VP)); }
            GRID_BAR();
            CUT(3, RS_KP, true) CUT(7, RS_VP, true) CUT(8, RS_BP, true) CUT(9, RS_DEC, false)
#ifndef NO_SCAN
#ifndef REP_SCAN
#define REP_SCAN 1
#endif
            for (int rep_ = 0; rep_ < REP_SCAN; ++rep_) {
              { unsigned char* ws = WSB(); scan_phase(F, (bf16*)(ws + RS_RKV), (float*)(ws + RS_DEC), (bf16*)(ws + RS_KP), (bf16*)(ws + RS_AP), (bf16*)(ws + RS_BP), (bf16*)(ws + RS_VP), (bf16*)(ws + WS_Y)); }
              if (rep_ + 1 < REP_SCAN) GRID_BAR(); }
#endif
            GRID_BAR();
            CUT(4, WS_Y, true)
            { unsigned char* ws = WSB(); for (int rt_ = 0; rt_ < REP_RW; ++rt_) post_phase(F, (bf16*)(ws + WS_Y), (bf16*)(ws + RS_RKV), (bf16*)(ws + RS_KP), (bf16*)(ws + RS_VP), (bf16*)(ws + RS_GG),
                                                   INP(I_RK) + (size_t)l * D, INP(I_GNG) + (size_t)l * D, INP(I_GNB) + (size_t)l * D, (bf16*)(ws + RS_YG)); }
            GRID_BAR();
            CUT(5, RS_YG, true)
            { unsigned char* ws = WSB(); pg8::Gemm g{D, D, D}; pg8::SchedStd S; S.init(M, D, F.G, bx, ws + RS_YG, D, ws + WM_OUT + (size_t)l * RW_LSTRIDE, D);
              pg8::EpiResF32 E{layer == 0 ? INP(I_X) : (const float*)(ws + WS_H), (float*)(ws + RS_PRE), ALPHA};
              GEMM_ONE(pg8::EpiResF32, pg8::SchedStd)(ring, g, S, E, F.wave); }
            GRID_BAR();
            CUT(6, RS_PRE, false)
        } else {
            const int j = layer - 2;
            { unsigned char* ws = WSB(); pg8::Gemm g{D, D, D}; pg8::SchedStd S; S.init(M, j == 0 ? 3 * D : D, F.G, bx, ws + WS_HB, D, ws + WM_QKV, D);
              pg8::EpiQKV E{(bf16*)(ws + BS_Q), ((long)WS_K - (long)BS_Q) / 2, ((long)WS_V - (long)BS_Q) / 2, attn_body::C2};
              GEMM_BIG(pg8::EpiQKV, pg8::SchedStd)(ring, g, S, E, F.wave); }
            GRID_BAR();
            CUT(31, BS_Q, true) CUT(32, WS_K, true) CUT(33, WS_V, true)
            if (j == 0) { unsigned char* ws = WSB(); for (int rt_ = 0; rt_ < REP_THIN; ++rt_) kmean_phase(F, (bf16*)(ws + WS_K), (float*)(ws + WS_KMEAN)); GRID_BAR(); }
#ifndef NO_GATE
            { unsigned char* ws = WSB(); for (int rt_ = 0; rt_ < REP_THIN; ++rt_) gate_phase(F, (bf16*)(ws + BS_Q), (float*)(ws + WS_KMEAN), (unsigned*)(ws + WS_SEL)); }
#endif
            GRID_BAR();
#ifdef DBG_CUT
            if (DBG_CUT == 35) { unsigned char* ws = WSB(); const unsigned* s_ = (const unsigned*)(ws + WS_SEL); for (size_t i = (size_t)F.gw * 64 + F.lane; i < (size_t)M * D; i += (size_t)F.NGW * 64) args.out[i] = (float)(s_[i & (size_t)(M * 16 - 1)] % 65521u); return; }
#endif
#ifdef ATTN_DIRECT
            { unsigned char* ws = WSB(); attn_direct_phase(F, (const bf16*)(ws + BS_Q), (const bf16*)(ws + WS_K), (const bf16*)(ws + WS_V), (const unsigned*)(ws + WS_SEL), (bf16*)(ws + BS_O)); }
            GRID_BAR();
#else
            { unsigned char* ws = WSB(); for (int ra_ = 0; ra_ < REP_ATTN; ++ra_) moba_attn_phase(F, (const bf16*)(ws + BS_Q), (const bf16*)(ws + WS_K), (const bf16*)(ws + WS_V), (const unsigned*)(ws + WS_SEL), (bf16*)(ws + BS_PO), (float*)(ws + BS_ML), F.ctl + CW_QCTR + 64 * (j + 2 * ra_)); }
            GRID_BAR();
            { unsigned char* ws = WSB(); for (int rt_ = 0; rt_ < REP_THIN; ++rt_) moba_combine_phase(F, (const unsigned*)(ws + WS_SEL), (const bf16*)(ws + BS_PO), (const float*)(ws + BS_ML), (bf16*)(ws + BS_O)); }
            GRID_BAR();
#endif
            CUT(36, BS_O, true)
#ifdef DBG_CUT
            if (DBG_CUT == 37 && (DBG_LAYER < 0 || layer == DBG_LAYER)) {
                { unsigned char* ws = WSB(); attn_direct_phase(F, (const bf16*)(ws + BS_Q), (const bf16*)(ws + WS_K), (const bf16*)(ws + WS_V), (const unsigned*)(ws + WS_SEL), (bf16*)(ws + BS_PRE)); }
                GRID_BAR();
                { unsigned char* ws = WSB(); const bf16* a_ = (const bf16*)(ws + BS_O); const bf16* b_ = (const bf16*)(ws + BS_PRE); float* o_ = GOUT();
                  for (size_t i = (size_t)F.gw * 64 + F.lane; i < (size_t)M * D; i += (size_t)F.NGW * 64) o_[i] = 1000.f * (bf2f(a_[i]) - bf2f(b_[i])); }
                return; }
#endif
            { unsigned char* ws = WSB(); pg8::Gemm g{D, D, D}; pg8::SchedStd S; S.init(M, D, F.G, bx, ws + BS_O, D, ws + WM_O, D);
              pg8::EpiResF32 E{(const float*)(ws + WS_H), (float*)(ws + BS_PRE), ALPHA};
              GEMM_ONE(pg8::EpiResF32, pg8::SchedStd)(ring, g, S, E, F.wave); }
            GRID_BAR();
        }
        { unsigned char* ws = WSB(); const float* PREm = (const float*)(ws + (layer < 2 ? RS_PRE : BS_PRE));
          const float* g0 = INP(I_LNG) + (size_t)(layer * 2) * D; const float* b0 = INP(I_LNB) + (size_t)(layer * 2) * D;
          if (moe) for (int rt_ = 0; rt_ < REP_LN; ++rt_) ln_phase<0, true>(F, PREm, nullptr, nullptr, nullptr, g0, b0, (float*)(ws + WS_H), (bf16*)(ws + WS_HB), INP(I_ROUTER) + (size_t)fe * D * NE, (int*)(ws + WS_TOKE), (float*)(ws + WS_TOKW), (int*)(ws + WS_BLKCNT));
          else for (int rt_ = 0; rt_ < REP_LN; ++rt_) ln_phase<0, false>(F, PREm, nullptr, nullptr, nullptr, g0, b0, (float*)(ws + WS_H), (bf16*)(ws + WS_HB), nullptr, nullptr, nullptr, nullptr); }
        if (layer == 0) for (int rt_ = 0; rt_ < REP_CONV; ++rt_) conv_rwkv(F, 1); else if (layer == 1) for (int rt_ = 0; rt_ < REP_CONV; ++rt_) conv_moba(F, 0); else if (layer == 2) for (int rt_ = 0; rt_ < REP_CONV; ++rt_) conv_moba(F, 1);
        GRID_BAR();
        CUT(10 + layer, WS_H, false)
        if (!moe) {
            { unsigned char* ws = WSB(); pg8::Gemm g{D, D, D}; pg8::SchedStd S; S.init(M, 2 * FF, F.G, bx, ws + WS_HB, D, ws + WF_GU, D);
              pg8::EpiSwiGLU E{(bf16*)(ws + FS_HID), FF, 1.0f};
              GEMM_BIG(pg8::EpiSwiGLU, pg8::SchedStd)(ring, g, S, E, F.wave); }
            GRID_BAR();
            { unsigned char* ws = WSB(); pg8::Gemm g{FF, FF, FF}; pg8::SchedStd S; S.init(M, D, F.G, bx, ws + FS_HID, FF, ws + WF_DN, FF);
              pg8::EpiResF32 E{(const float*)(ws + WS_H), (float*)(ws + FS_PRE), ALPHA};
              GEMM_ONE(pg8::EpiResF32, pg8::SchedStd)(ring, g, S, E, F.wave); }
            GRID_BAR();
            { unsigned char* ws = WSB(); const float* g1 = INP(I_LNG) + (size_t)(layer * 2 + 1) * D; const float* b1 = INP(I_LNB) + (size_t)(layer * 2 + 1) * D;
              for (int rt_ = 0; rt_ < REP_LN; ++rt_) ln_phase<0, false>(F, (const float*)(ws + FS_PRE), nullptr, nullptr, nullptr, g1, b1, (float*)(ws + WS_H), (bf16*)(ws + WS_HB), nullptr, nullptr, nullptr, nullptr); }
            for (int rt_ = 0; rt_ < REP_CONV; ++rt_) conv_moe(F, fe);
            GRID_BAR();
        } else {
            { unsigned char* ws = WSB(); for (int rt_ = 0; rt_ < REP_THIN; ++rt_) moe_gather_phase(F, (const int*)(ws + WS_BLKCNT), (const int*)(ws + WS_TOKE), (const float*)(ws + WS_TOKW), (int*)(ws + WS_TOKR), (float*)(ws + WS_GW), (const float*)(ws + WS_H), (unsigned char*)(ws + ES_XG)); }
            GRID_BAR();
            { unsigned char* ws = WSB(); const LAS int* pp = (const LAS int*)(F.lds + MISC_OFF + 64);
              pg8::Gemm g{D / 2, D / 2, D / 2};
              pg8::SchedMoe S{2 * FFE / 256, F.G, bx, pp, (const char*)(ws + ES_XG), (const char*)(ws + WE_GU), (size_t)256 * D, (size_t)256 * D, (size_t)2 * FFE * D, 0};
              pg8::EpiSwiGLU E{(bf16*)(ws + ES_HID), FFE, 1.0f / MOE_WSCALE};
              for (int rg_ = 0; rg_ < REP_GEMM; ++rg_) pg8::gemm_phase<pg8::EpiSwiGLU, pg8::SchedMoe, true, true, true>(ring, g, S, E, F.wave); }
            GRID_BAR();
            { unsigned char* ws = WSB(); const LAS int* pp = (const LAS int*)(F.lds + MISC_OFF + 64);
              { pg8::Gemm g{FFE, FFE, FFE}; pg8::SchedMoe S{D / 256, F.G, bx, pp, (const char*)(ws + ES_HID), (const char*)(ws + WE_DN), (size_t)256 * FFE * 2, (size_t)256 * FFE * 2, (size_t)D * FFE * 2, 2 * 256};
                pg8::EpiMoeDown E{(float*)(ws + ES_YP), (const float*)(ws + WS_GW)};
                GEMM_BIG(pg8::EpiMoeDown, pg8::SchedMoe)(ring, g, S, E, F.wave); }
              { pg8::Gemm g{512, FFE, FFE}; pg8::SchedMoeTail S{D / 256, F.G, bx, 2 * 256, 7, pp, (const char*)(ws + ES_HID), (const char*)(ws + WE_DN), (size_t)256 * FFE * 2, (size_t)256 * FFE * 2, (size_t)D * FFE * 2, (size_t)512 * 2};
                pg8::EpiMoeDownSlab E{(float*)(ws + ES_YS), (const float*)(ws + WS_GW), bx, 7};
                GEMM_ONE(pg8::EpiMoeDownSlab, pg8::SchedMoeTail)(ring, g, S, E, F.wave); } }
            GRID_BAR();
            { unsigned char* ws = WSB(); const float* g1 = INP(I_LNG) + (size_t)(layer * 2 + 1) * D; const float* b1 = INP(I_LNB) + (size_t)(layer * 2 + 1) * D;
              if (layer == 3) ln_phase<1, false>(F, (const float*)(ws + ES_YS), (const float*)(ws + WS_H), (const float*)(ws + ES_YP), (const int*)(ws + WS_TOKR), g1, b1, GOUT(), nullptr, nullptr, nullptr, nullptr, nullptr);
              else ln_phase<1, false>(F, (const float*)(ws + ES_YS), (const float*)(ws + WS_H), (const float*)(ws + ES_YP), (const int*)(ws + WS_TOKR), g1, b1, (float*)(ws + WS_H), (bf16*)(ws + WS_HB), nullptr, nullptr, nullptr, nullptr); }
            if (layer == 1) for (int rt_ = 0; rt_ < REP_CONV; ++rt_) conv_dense(F, 1);
            GRID_BAR();
        }
        CUT(20 + layer, WS_H, false)
        CUT(40 + layer, WS_HB, true)
#ifdef DBG_CUT
        if (DBG_CUT == 50 + layer) { unsigned char* ws = WSB(); const bf16* s_ = (const bf16*)(ws + WS_WMIX); float* o_ = GOUT(); for (size_t i = (size_t)F.gw * 64 + F.lane; i < (size_t)M * D; i += (size_t)F.NGW * 64) o_[i] = i < (size_t)6 * 1024 * 1024 ? bf2f(s_[i]) : 0.f; return; }
#endif
    }
}

extern "C" void kernel_launch(void* const* d_in, const int* in_sizes, int n_in, void* d_out, int out_size, void* d_ws, size_t ws_size, hipStream_t stream) {
    static int grid = 0;
    if (grid == 0) {
        if (n_in != 33 || in_sizes[0] != M * D || out_size != M * D || ws_size < WS_END) { fprintf(stderr, "kernel_launch: unexpected problem shape (n_in %d, in0 %d, out %d, ws %zu); nothing launched\n", n_in, n_in > 0 ? in_sizes[0] : -1, out_size, ws_size); grid = -1; return; }
        int dev = 0, cus = 0, per_cu = 0;
        if (hipGetDevice(&dev) != hipSuccess || hipDeviceGetAttribute(&cus, hipDeviceAttributeMultiprocessorCount, dev) != hipSuccess) { grid = -1; return; }
        if (hipFuncSetAttribute((const void*)fwd_kernel, hipFuncAttributeMaxDynamicSharedMemorySize, LDS_BYTES) != hipSuccess) { fprintf(stderr, "kernel_launch: hipFuncSetAttribute failed\n"); grid = -1; return; }
        if (hipOccupancyMaxActiveBlocksPerMultiprocessor(&per_cu, (const void*)fwd_kernel, NWAVES * 64, LDS_BYTES) != hipSuccess || per_cu < 1) { fprintf(stderr, "kernel_launch: occupancy query reports %d workgroups per CU\n", per_cu); }
        (void)hipGetLastError();
        grid = cus;
        if (grid != 256) { fprintf(stderr, "kernel_launch: built for 256 CUs, device has %d; nothing launched\n", cus); grid = -1; return; }
    }
    if (grid < 0) return;
    if (hipMemsetAsync((char*)d_ws + WS_CTL, 0, CTL_ZERO_BYTES, stream) != hipSuccess) return;
#ifdef DBG_FILL
    (void)hipMemsetAsync((char*)d_ws + CTL_ZERO_BYTES, DBG_FILL, WS_END - CTL_ZERO_BYTES, stream);
#endif
    Args a{};
    for (int i = 0; i < 33; ++i) a.in[i] = (const float*)d_in[i];
    a.out = (float*)d_out; a.ws = (unsigned char*)d_ws;
    hipLaunchKernelGGL(fwd_kernel, dim3(grid), dim3(NWAVES * 64), LDS_BYTES, stream, a);
}
```

```cpp
#include <hip/hip_runtime.h>
#include <cstdio>
#include <cstdint>
#include <hip/hip_bf16.h>
#include <cmath>
__device__ __forceinline__ int fresh_lane() { int l; asm volatile("v_mbcnt_lo_u32_b32 %0, -1, 0\n\tv_mbcnt_hi_u32_b32 %0, -1, %0" : "=v"(l)); return l; }
namespace pg8 {
#define PG8_LAS __attribute__((address_space(3)))
typedef unsigned short bf16_t;
typedef short bf16x8 __attribute__((ext_vector_type(8)));
typedef float f32x4 __attribute__((ext_vector_type(4)));
typedef unsigned u32x4 __attribute__((ext_vector_type(4)));
constexpr int BM = 256, BK = 64, HALF = 128, HTB = HALF * BK * 2  , STAGE_BYTES = 8 * HTB, NXCD = 8, WGM = 8;

__host__ __device__ __forceinline__ int lds_byte(int r, int c) { const int st = (r >> 4) * 2 + (c >> 5), rr = r & 15, cc = c & 31, ob = rr * 64 + cc * 2; return st * 1024 + (ob ^ (((ob >> 9) & 1) << 5)); }
__host__ __device__ __forceinline__ void stage_rc(int b, int& R, int& C) { const int st = b / 1024, sb = b % 1024, swz = sb ^ (((sb >> 9) & 1) << 5); R = (st >> 1) * 16 + swz / 64; C = (st & 1) * 32 + (swz % 64) / 2; }
__host__ __device__ __forceinline__ int perm32(int rho) { const int n = rho >> 4, i = rho & 15; return 8 * (i >> 2) + 4 * n + (i & 3); }

struct Unit { int pm, pn, e; };
struct Gemm { int K, lda, ldb; };

__device__ __forceinline__ unsigned cvt_pk_bf16(float lo, float hi) { unsigned r; asm volatile("v_cvt_pk_bf16_f32 %0, %1, %2" : "=v"(r) : "v"(lo), "v"(hi)); return r; }
__device__ __forceinline__ float fsigmoid(float x) { return __builtin_amdgcn_rcpf(1.0f + __expf(-x)); }
__device__ __forceinline__ float ftanh(float x) { return 1.0f - 2.0f * __builtin_amdgcn_rcpf(1.0f + __expf(2.0f * x)); }

struct SchedStd {
    int nM, nN, nwg, G, c, amode; const char* A; const char* B; size_t atile, btile, ag;
    __device__ __forceinline__ void init(int M, int N, int G_, int c_, const void* A_, size_t lda, const void* B_, size_t ldb, int amode_ = 0, size_t ag_ = 0) {
        nM = M / BM; nN = N / BM; nwg = nM * nN; G = G_; c = c_; A = (const char*)A_; B = (const char*)B_; atile = (size_t)BM * lda * 2; btile = (size_t)BM * ldb * 2; amode = amode_; ag = ag_; }
    __device__ __forceinline__ bool next(int i, Unit& u) const {
        const long L = (long)i * G + c; if (L >= nwg) return false;
        int wgid = (int)L; { const int q = nwg / NXCD, r = nwg % NXCD, xcd = wgid % NXCD, off = wgid / NXCD; wgid = (xcd < r ? xcd * (q + 1) : r * (q + 1) + (xcd - r) * q) + off; }
        const int nig = WGM * nN, gid = wgid / nig, fm = gid * WGM, gsz = (nM - fm) < WGM ? (nM - fm) : WGM;
        u.pm = fm + ((wgid % nig) % gsz); u.pn = (wgid % nig) / gsz; u.e = 0; return true;
    }
    __device__ __forceinline__ const char* abase(const Unit& u) const {
        size_t off = (size_t)u.pm * atile;
        if (amode == 1) { const int gs = u.pn < 12 ? (u.pn >> 2) : (u.pn == 12 ? 3 : (u.pn == 13 ? 4 : (u.pn == 14 ? 2 : 5))); off += (size_t)gs * ag; }
        else if (amode == 2) off += (size_t)(u.pn >> 2) * 512;
        return A + off; }
    __device__ __forceinline__ const char* bbase(const Unit& u) const { return B + (size_t)u.pn * btile; }
    __device__ __forceinline__ void a_ready(const Unit&) const {}
    __device__ __forceinline__ void done(const Unit&) const {}
};
struct SchedMoe {
    int nN, G, c; const PG8_LAS int* pp; const char* A; const char* B; size_t atile, btile, bexp; int cap;
    __device__ __forceinline__ bool next(int i, Unit& u) const {
        const int L = i * G + c; int tot = pp[8] * nN; if (cap && tot > cap) tot = cap; if (L >= tot) return false;
        const int pm = L / nN; u.pm = pm; u.pn = L - pm * nN; int e = 0;
#pragma unroll
        for (int k = 1; k < 8; ++k) e += (pm >= pp[k]) ? 1 : 0;
        u.e = __builtin_amdgcn_readfirstlane(e); return true; }
    __device__ __forceinline__ const char* abase(const Unit& u) const { return A + (size_t)u.pm * atile; }
    __device__ __forceinline__ const char* bbase(const Unit& u) const { return B + (size_t)u.e * bexp + (size_t)u.pn * btile; }
    __device__ __forceinline__ void a_ready(const Unit&) const {}
    __device__ __forceinline__ void done(const Unit&) const {}
};

struct SchedMoeTail {
    int nN, G, c, first, NS; const PG8_LAS int* pp; const char* A; const char* B; size_t atile, btile, bexp, kslice;
    __device__ __forceinline__ bool next(int i, Unit& u) const {
        if (i > 0) return false;
        const int L = first + c / NS, tot = pp[8] * nN; if (L >= tot) return false;
        const int pm = L / nN; u.pm = pm; u.pn = L - pm * nN; int e = 0;
#pragma unroll
        for (int k = 1; k < 8; ++k) e += (pm >= pp[k]) ? 1 : 0;
        u.e = __builtin_amdgcn_readfirstlane(e); return true; }
    __device__ __forceinline__ const char* abase(const Unit& u) const { return A + (size_t)u.pm * atile + (size_t)(c % NS) * kslice; }
    __device__ __forceinline__ const char* bbase(const Unit& u) const { return B + (size_t)u.e * bexp + (size_t)u.pn * btile + (size_t)(c % NS) * kslice; }
    __device__ __forceinline__ void a_ready(const Unit&) const {}
    __device__ __forceinline__ void done(const Unit&) const {}
};
#define PG8_PACK8(w, v0, v1) do { w.x = cvt_pk_bf16(v0[0], v0[1]); w.y = cvt_pk_bf16(v0[2], v0[3]); w.z = cvt_pk_bf16(v1[0], v1[1]); w.w = cvt_pk_bf16(v1[2], v1[3]); } while (0)

struct EpiQKV {
    static constexpr bool PERM = true, AFTER_DRAIN = false;
    bf16_t* O0; long d1, d2; float s0;
    __device__ __forceinline__ void operator()(const f32x4 (&acc)[2][2][4][2], const Unit& u, int wr, int wc, int fr, int fq) const {
        const int t = u.pn >> 2; bf16_t* base = O0 + (long)(t == 1) * d1 + (long)(t == 2) * d2; const float sc = t == 0 ? s0 : 1.0f;
        const int row0 = u.pm * BM + wr * 64 + fr, col0 = (u.pn & 3) * BM + wc * 32 + 8 * fq;
#pragma unroll
        for (int ai = 0; ai < 2; ++ai)
#pragma unroll
            for (int m = 0; m < 4; ++m) { bf16_t* rowp = base + (size_t)(row0 + ai * HALF + m * 16) * 1024 + col0;
#pragma unroll
                for (int bj = 0; bj < 2; ++bj) { const f32x4 v0 = acc[ai][bj][m][0] * sc, v1 = acc[ai][bj][m][1] * sc; u32x4 w; PG8_PACK8(w, v0, v1); *(u32x4*)(rowp + bj * HALF) = w; } }
    }
};
struct EpiRkv {
    static constexpr bool PERM = true, AFTER_DRAIN = false;
    bf16_t* RKV; long dLH; size_t mstride;
    __device__ __forceinline__ void operator()(const f32x4 (&acc)[2][2][4][2], const Unit& u, int wr, int wc, int fr, int fq) const {
        const int pn = u.pn; const bool lora = pn >= 12;
        bf16_t* base = (bf16_t*)((char*)RKV + (lora ? dLH : (long)((size_t)(pn >> 2) * mstride * 2))); const int colt = lora ? (pn - 12) * BM : (pn & 3) * BM;
        const int row0 = u.pm * BM + wr * 64 + fr, col0 = colt + wc * 32 + 8 * fq;
#pragma unroll
        for (int ai = 0; ai < 2; ++ai)
#pragma unroll
            for (int m = 0; m < 4; ++m) { bf16_t* rowp = base + (size_t)(row0 + ai * HALF + m * 16) * 1024 + col0;
#pragma unroll
                for (int bj = 0; bj < 2; ++bj) { f32x4 v0 = acc[ai][bj][m][0], v1 = acc[ai][bj][m][1];
                    if (pn == 12) {
#pragma unroll
                        for (int i = 0; i < 4; ++i) { v0[i] = ftanh(v0[i]); v1[i] = ftanh(v1[i]); } }
                    else if (pn == 15) {
#pragma unroll
                        for (int i = 0; i < 4; ++i) { v0[i] = fsigmoid(v0[i]); v1[i] = fsigmoid(v1[i]); } }
                    u32x4 w; PG8_PACK8(w, v0, v1); *(u32x4*)(rowp + bj * HALF) = w; } }
    }
};
template <int GRP> struct EpiLoraUp {
    static constexpr bool PERM = true, AFTER_DRAIN = false;
    void* O; const float* bias;
    __device__ __forceinline__ void operator()(const f32x4 (&acc)[2][2][4][2], const Unit& u, int wr, int wc, int fr, int fq) const {
        const int row0 = u.pm * BM + wr * 64 + fr, col0 = u.pn * BM + wc * 32 + 8 * fq;
#pragma unroll
        for (int bj = 0; bj < 2; ++bj) {
            f32x4 bv0 = (f32x4){0.f, 0.f, 0.f, 0.f}, bv1 = bv0;
            if (GRP < 3) { bv0 = *(const f32x4*)(bias + col0 + bj * HALF); bv1 = *(const f32x4*)(bias + col0 + bj * HALF + 4); }
#pragma unroll
            for (int ai = 0; ai < 2; ++ai)
#pragma unroll
                for (int m = 0; m < 4; ++m) { const size_t ro = (size_t)(row0 + ai * HALF + m * 16) * 1024 + col0 + bj * HALF;
                    f32x4 v0_ = acc[ai][bj][m][0] + bv0, v1_ = acc[ai][bj][m][1] + bv1;
                    if (GRP == 0) {
#pragma unroll
                        for (int i = 0; i < 4; ++i) { v0_[i] = __expf(-0.6065306597f * fsigmoid(v0_[i])); v1_[i] = __expf(-0.6065306597f * fsigmoid(v1_[i])); }
                    } else if (GRP < 3) {
#pragma unroll
                        for (int i = 0; i < 4; ++i) { v0_[i] = fsigmoid(v0_[i]); v1_[i] = fsigmoid(v1_[i]); }
                    }
                    if (GRP < 2) { *(f32x4*)((float*)O + ro) = v0_; *(f32x4*)((float*)O + ro + 4) = v1_; }
                    else { u32x4 w; PG8_PACK8(w, v0_, v1_); *(u32x4*)((bf16_t*)O + ro) = w; } }
        }
    }
};
struct EpiLoraUpAll {
    static constexpr bool PERM = true, AFTER_DRAIN = false;
    EpiLoraUp<0> e0; EpiLoraUp<1> e1; EpiLoraUp<2> e2; EpiLoraUp<3> e3;
    __device__ __forceinline__ void operator()(const f32x4 (&acc)[2][2][4][2], const Unit& u, int wr, int wc, int fr, int fq) const {
        Unit v = u; v.pn = u.pn & 3; const int g = u.pn >> 2;
        if (g == 0) e0(acc, v, wr, wc, fr, fq); else if (g == 1) e1(acc, v, wr, wc, fr, fq); else if (g == 2) e2(acc, v, wr, wc, fr, fq); else e3(acc, v, wr, wc, fr, fq);
    }
};
struct EpiResF32 {
    static constexpr bool PERM = false, AFTER_DRAIN = false;
    const float* base; float* out; float alpha;
    __device__ __forceinline__ void operator()(const f32x4 (&acc)[2][2][4][2], const Unit& u, int wr, int wc, int fr, int fq) const {
        const int row0 = u.pm * BM + wr * 64 + fr, col0 = u.pn * BM + wc * 32 + 4 * fq;
#pragma unroll
        for (int ai = 0; ai < 2; ++ai)
#pragma unroll
            for (int m = 0; m < 4; ++m) { const size_t ro = (size_t)(row0 + ai * HALF + m * 16) * 1024 + col0;
#pragma unroll
                for (int bj = 0; bj < 2; ++bj)
#pragma unroll
                    for (int n = 0; n < 2; ++n) { const f32x4 b = *(const f32x4*)(base + ro + bj * HALF + n * 16); *(f32x4*)(out + ro + bj * HALF + n * 16) = b * alpha + acc[ai][bj][m][n]; } }
    }
};
struct EpiSwiGLU {
    static constexpr bool PERM = true, AFTER_DRAIN = false;
    bf16_t* Hd; int ldh; float sc;
    __device__ __forceinline__ void operator()(const f32x4 (&acc)[2][2][4][2], const Unit& u, int wr, int wc, int fr, int fq) const {
        const int row0 = u.pm * BM + wr * 64 + fr, col0 = u.pn * HALF + wc * 32 + 8 * fq;
#pragma unroll
        for (int ai = 0; ai < 2; ++ai)
#pragma unroll
            for (int m = 0; m < 4; ++m) { bf16_t* rowp = Hd + (size_t)(row0 + ai * HALF + m * 16) * ldh + col0;
                f32x4 v0, v1;
#pragma unroll
                for (int i = 0; i < 4; ++i) { const float g0 = acc[ai][0][m][0][i] * sc, g1 = acc[ai][0][m][1][i] * sc;
                    v0[i] = g0 * fsigmoid(g0) * (acc[ai][1][m][0][i] * sc); v1[i] = g1 * fsigmoid(g1) * (acc[ai][1][m][1][i] * sc); }
                u32x4 w; PG8_PACK8(w, v0, v1); *(u32x4*)rowp = w; }
    }
};
struct EpiMoeDown {
    static constexpr bool PERM = false, AFTER_DRAIN = false;
    float* YP; const float* gw;
    __device__ __forceinline__ void operator()(const f32x4 (&acc)[2][2][4][2], const Unit& u, int wr, int wc, int fr, int fq) const {
        const int row0 = u.pm * BM + wr * 64 + fr, col0 = u.pn * BM + wc * 32 + 4 * fq;
#pragma unroll
        for (int ai = 0; ai < 2; ++ai)
#pragma unroll
            for (int m = 0; m < 4; ++m) { const int row = row0 + ai * HALF + m * 16; const float s = gw[row]; const size_t ro = (size_t)row * 1024 + col0;
#pragma unroll
                for (int bj = 0; bj < 2; ++bj)
#pragma unroll
                    for (int n = 0; n < 2; ++n) *(f32x4*)(YP + ro + bj * HALF + n * 16) = acc[ai][bj][m][n] * s; }
    }
};

struct EpiMoeDownSlab {
    static constexpr bool PERM = false, AFTER_DRAIN = false;
    float* YS; const float* gw; int c, NS;
    __device__ __forceinline__ void operator()(const f32x4 (&acc)[2][2][4][2], const Unit& u, int wr, int wc, int fr, int fq) const {
        const int row0 = u.pm * BM + wr * 64 + fr, col0 = u.pn * BM + wc * 32 + 4 * fq; float* slab = YS + (size_t)(c % NS) * 2048 * 1024;
#pragma unroll
        for (int ai = 0; ai < 2; ++ai)
#pragma unroll
            for (int m = 0; m < 4; ++m) { const int row = row0 + ai * HALF + m * 16; const float s = gw[row]; const size_t ro = (size_t)(row - 32768) * 1024 + col0;
#pragma unroll
                for (int bj = 0; bj < 2; ++bj)
#pragma unroll
                    for (int n = 0; n < 2; ++n) *(f32x4*)(slab + ro + bj * HALF + n * 16) = acc[ai][bj][m][n] * s; }
    }
};
template <class Epi, class Sched, bool ALIGN_EPI = false, bool SP2 = false, bool F8 = false>
__device__ __forceinline__ void gemm_phase(PG8_LAS unsigned char* lds, const Gemm g, const Sched& S, const Epi& E, int wave) {
    const int lane = fresh_lane(), wid = wave, tid = wid * 64 + lane, wr = wid >> 2, wc = wid & 3, fr = lane & 15, fq = lane >> 4;
    const int K = g.K, nt = K / BK;
    unsigned voffA[2], voffB[2];
#pragma unroll
    for (int i = 0; i < 2; ++i) { int R, C; stage_rc(tid * 16 + i * 8192, R, C); const int Rb = Epi::PERM ? ((R & ~31) + perm32(R & 31)) : R;
        voffA[i] = (unsigned)(R * g.lda + C) * 2u; voffB[i] = (unsigned)(Rb * g.ldb + C) * 2u; }
    const size_t kstep = (size_t)(BK * 2);
    const size_t hsA = (size_t)HALF * g.lda * 2, hsB = (size_t)HALF * g.ldb * 2;
    const unsigned ldsw = (unsigned)wid * 1024u;
    const int aoff = lds_byte(wr * 64 + fr, fq * 8), boff = lds_byte(wc * 32 + fr, fq * 8);
#define PG8_SA(b, h) (((b) * 2 + (h)) * HTB)
#define PG8_SB(b, h) ((4 + (b) * 2 + (h)) * HTB)
#define PG8_STAGE(bufoff, gbase, voff) do { _Pragma("unroll") for (int _i = 0; _i < 2; ++_i) \
        __builtin_amdgcn_global_load_lds((const unsigned*)((const char*)(gbase) + (voff)[_i]), (PG8_LAS unsigned*)(lds + (bufoff) + ldsw + _i * 8192), 16, 0, 0); } while (0)
#define PG8_LDA(dst, b, h) do { _Pragma("unroll") for (int m = 0; m < 4; ++m) { const i32x4_ lo_ = *(const PG8_LAS i32x4_*)(lds + PG8_SA(b, h) + aoff + m * 2048), hi_ = *(const PG8_LAS i32x4_*)(lds + PG8_SA(b, h) + aoff + m * 2048 + 1024); \
        if constexpr (F8) dst##8[m] = __builtin_shufflevector(lo_, hi_, 0, 1, 2, 3, 4, 5, 6, 7); else { dst[m][0] = __builtin_bit_cast(bf16x8, lo_); dst[m][1] = __builtin_bit_cast(bf16x8, hi_); } } } while (0)
#define PG8_LDB(dst, b, h) do { _Pragma("unroll") for (int n = 0; n < 2; ++n) { const i32x4_ lo_ = *(const PG8_LAS i32x4_*)(lds + PG8_SB(b, h) + boff + n * 2048), hi_ = *(const PG8_LAS i32x4_*)(lds + PG8_SB(b, h) + boff + n * 2048 + 1024); \
        if constexpr (F8) dst##8[n] = __builtin_shufflevector(lo_, hi_, 0, 1, 2, 3, 4, 5, 6, 7); else { dst[n][0] = __builtin_bit_cast(bf16x8, lo_); dst[n][1] = __builtin_bit_cast(bf16x8, hi_); } } } while (0)
#define PG8_MMA(ai, bj, At, Bt) do { __builtin_amdgcn_s_setprio(1); _Pragma("unroll") for (int m = 0; m < 4; ++m) _Pragma("unroll") for (int n = 0; n < 2; ++n) { \
        if constexpr (F8) asm volatile("v_mfma_scale_f32_16x16x128_f8f6f4 %0, %1, %2, %0, %3, %3 op_sel_hi:[0,0,0]" : "+v"(acc[ai][bj][m][n]) : "v"(Bt##8[n]), "v"(At##8[m]), "v"(f8scale));   \
        else { _Pragma("unroll") for (int k = 0; k < 2; ++k) acc[ai][bj][m][n] = __builtin_amdgcn_mfma_f32_16x16x32_bf16(Bt[n][k], At[m][k], acc[ai][bj][m][n], 0, 0, 0); } } \
        __builtin_amdgcn_s_setprio(0); } while (0)
#define PG8_WAIT_V(n) asm volatile("s_waitcnt vmcnt(" #n ")" ::: "memory")
#define PG8_WAIT_L(n) asm volatile("s_waitcnt lgkmcnt(" #n ")" ::: "memory")
#define PG8_BAR __builtin_amdgcn_s_barrier()
#define PG8_SCHED __builtin_amdgcn_sched_barrier(0)
    Unit cur, nxt; int ui = 0;
    if (!S.next(0, cur)) return;
    f32x4 acc[2][2][4][2];
#pragma unroll
    for (int a = 0; a < 2; ++a)
#pragma unroll
        for (int b = 0; b < 2; ++b)
#pragma unroll
            for (int m = 0; m < 4; ++m)
#pragma unroll
                for (int n = 0; n < 2; ++n) acc[a][b][m][n] = (f32x4){0.f, 0.f, 0.f, 0.f};
    typedef int i32x4_ __attribute__((ext_vector_type(4))); typedef int i32x8_ __attribute__((ext_vector_type(8)));
    int f8scale = 0x7f7f7f7f; asm volatile("" : "+v"(f8scale));
    bf16x8 At[4][2], B0[2][2], B1[2][2]; i32x8_ At8[4], B08[2], B18[2];
    const char* cA = S.abase(cur); const char* cB = S.bbase(cur);
    S.a_ready(cur);
    if constexpr (SP2) {
        PG8_STAGE(PG8_SB(0, 0), cB, voffB); PG8_STAGE(PG8_SB(0, 1), cB + hsB, voffB); PG8_STAGE(PG8_SA(0, 0), cA, voffA); PG8_STAGE(PG8_SA(0, 1), cA + hsA, voffA);
        if (wr == 1) PG8_BAR;
        PG8_WAIT_V(2); PG8_BAR;
        PG8_STAGE(PG8_SB(1, 0), cB + kstep, voffB); PG8_STAGE(PG8_SA(1, 0), cA + kstep, voffA); PG8_STAGE(PG8_SB(1, 1), cB + hsB + kstep, voffB);
        PG8_WAIT_V(6); PG8_BAR;
    } else {
        PG8_STAGE(PG8_SB(0, 0), cB, voffB); PG8_STAGE(PG8_SA(0, 0), cA, voffA); PG8_STAGE(PG8_SB(0, 1), cB + hsB, voffB); PG8_STAGE(PG8_SA(0, 1), cA + hsA, voffA);
        if (wr == 1) PG8_BAR;
        PG8_WAIT_V(4); PG8_BAR;
        PG8_STAGE(PG8_SB(1, 0), cB + kstep, voffB); PG8_STAGE(PG8_SA(1, 0), cA + kstep, voffA); PG8_STAGE(PG8_SB(1, 1), cB + hsB + kstep, voffB);
        PG8_WAIT_V(6); PG8_BAR;
    }
    for (;;) {
        const bool has_next = S.next(ui + 1, nxt);
        const char* nA = has_next ? S.abase(nxt) : cA; const char* nB = has_next ? S.bbase(nxt) : cB;
#pragma nounroll
        for (int t = 0; t < nt; t += 2) {
            const bool last = (t == nt - 2);
            const char* a1 = cA + (size_t)(t + 1) * kstep;
            const char* a2 = last ? nA : cA + (size_t)(t + 2) * kstep; const char* b2 = last ? nB : cB + (size_t)(t + 2) * kstep;
            const char* a3 = a2 + kstep; const char* b3 = b2 + kstep;
            if (last && has_next) S.a_ready(nxt);
            if constexpr (SP2) {
            PG8_LDB(B0, 0, 0); PG8_LDB(B1, 0, 1); PG8_SCHED; PG8_LDA(At, 0, 0); PG8_STAGE(PG8_SA(1, 1), a1 + hsA, voffA);
            PG8_WAIT_V(8); PG8_WAIT_L(0); PG8_BAR; PG8_MMA(0, 0, At, B0); PG8_MMA(0, 1, At, B1); PG8_BAR; PG8_SCHED;
            PG8_LDA(At, 0, 1); PG8_STAGE(PG8_SB(0, 0), b2, voffB); PG8_STAGE(PG8_SB(0, 1), b2 + hsB, voffB); PG8_STAGE(PG8_SA(0, 0), a2, voffA);
            PG8_WAIT_V(8); PG8_WAIT_L(0); PG8_BAR; PG8_MMA(1, 0, At, B0); PG8_MMA(1, 1, At, B1); PG8_BAR; PG8_SCHED;
            PG8_LDB(B0, 1, 0); PG8_LDB(B1, 1, 1); PG8_SCHED; PG8_LDA(At, 1, 0); PG8_STAGE(PG8_SA(0, 1), a2 + hsA, voffA);
            PG8_WAIT_V(8); PG8_WAIT_L(0); PG8_BAR; PG8_MMA(0, 0, At, B0); PG8_MMA(0, 1, At, B1); PG8_BAR; PG8_SCHED;
            PG8_LDA(At, 1, 1); PG8_STAGE(PG8_SB(1, 0), b3, voffB); PG8_STAGE(PG8_SB(1, 1), b3 + hsB, voffB); PG8_STAGE(PG8_SA(1, 0), a3, voffA);
            PG8_WAIT_V(8); PG8_WAIT_L(0); PG8_BAR; PG8_MMA(1, 0, At, B0); PG8_MMA(1, 1, At, B1); PG8_BAR; PG8_SCHED;
            } else {
            PG8_LDB(B0, 0, 0); PG8_SCHED; PG8_LDA(At, 0, 0); PG8_STAGE(PG8_SA(1, 1), a1 + hsA, voffA);
            PG8_WAIT_L(8); PG8_BAR; PG8_WAIT_L(0); PG8_MMA(0, 0, At, B0); PG8_BAR; PG8_SCHED;
            PG8_LDB(B1, 0, 1); PG8_STAGE(PG8_SB(0, 0), b2, voffB);
            PG8_BAR; PG8_WAIT_L(0); PG8_MMA(0, 1, At, B1); PG8_BAR;
            PG8_LDA(At, 0, 1); PG8_STAGE(PG8_SA(0, 0), a2, voffA);
            PG8_BAR; PG8_WAIT_L(0); PG8_MMA(1, 0, At, B0); PG8_BAR; PG8_SCHED;
            PG8_STAGE(PG8_SB(0, 1), b2 + hsB, voffB);
            PG8_WAIT_V(6); PG8_BAR; PG8_MMA(1, 1, At, B1); PG8_BAR;
            PG8_LDB(B0, 1, 0); PG8_SCHED; PG8_LDA(At, 1, 0); PG8_STAGE(PG8_SA(0, 1), a2 + hsA, voffA);
            PG8_WAIT_L(8); PG8_BAR; PG8_WAIT_L(0); PG8_MMA(0, 0, At, B0); PG8_BAR; PG8_SCHED;
            PG8_LDB(B1, 1, 1); PG8_STAGE(PG8_SB(1, 0), b3, voffB);
            PG8_BAR; PG8_WAIT_L(0); PG8_MMA(0, 1, At, B1); PG8_BAR;
            PG8_LDA(At, 1, 1); PG8_STAGE(PG8_SA(1, 0), a3, voffA);
            PG8_BAR; PG8_WAIT_L(0); PG8_MMA(1, 0, At, B0); PG8_BAR; PG8_SCHED;
            PG8_STAGE(PG8_SB(1, 1), b3 + hsB, voffB);
            PG8_WAIT_V(6); PG8_BAR; PG8_MMA(1, 1, At, B1); PG8_BAR;
            }
        }
        if constexpr (ALIGN_EPI) { if (wr == 0) PG8_BAR; }
        if constexpr (!Epi::AFTER_DRAIN) { E(acc, cur, wr, wc, fr, fq); S.done(cur); }
        if (!has_next) break;
#pragma unroll
        for (int a = 0; a < 2; ++a)
#pragma unroll
            for (int b = 0; b < 2; ++b)
#pragma unroll
                for (int m = 0; m < 4; ++m)
#pragma unroll
                    for (int n = 0; n < 2; ++n) acc[a][b][m][n] = (f32x4){0.f, 0.f, 0.f, 0.f};
        cur = nxt; cA = nA; cB = nB; ++ui;
        if constexpr (ALIGN_EPI) { if (wr == 1) PG8_BAR; }
    }
    PG8_WAIT_V(0);
    if constexpr (!ALIGN_EPI) { if (wr == 0) PG8_BAR; }
    PG8_BAR;
    if constexpr (Epi::AFTER_DRAIN) { E.fused(acc, cur, wr, wc, fr, fq, lds, wid, lane); S.done(cur); }
#undef PG8_SA
#undef PG8_SB
#undef PG8_STAGE
#undef PG8_LDA
#undef PG8_LDB
#undef PG8_MMA
#undef PG8_WAIT_V
#undef PG8_WAIT_L
#undef PG8_BAR
#undef PG8_SCHED
}
}

#ifndef MOBA_MASK_ON
#define MOBA_MASK_ON 1
#endif
namespace attn_body {
using bf16=__hip_bfloat16;
using bf16x8=__attribute__((ext_vector_type(8)))short;
using s16x4=__attribute__((ext_vector_type(4)))short;
using f32x16=__attribute__((ext_vector_type(16)))float;
using u32x4=__attribute__((ext_vector_type(4)))unsigned;
constexpr int BATCH=2,NHEAD=16,SEQ=8192,D=64,DM=NHEAD*D;
constexpr int NW=8,QBLK=32,QB=QBLK*NW,KVBLK=64,NQB=SEQ/QB;
constexpr int ATTN_PITCH=DM, ATTN_UNIT_ROWS=QB;
__device__ __forceinline__ int crow(int r,int hi){return (r&3)+8*(r>>2)+4*hi;}
#define SBAR() __builtin_amdgcn_sched_barrier(0)
__device__ __forceinline__ void cmask(f32x16&p0,f32x16&p1,int jb,int qrel,int hi){
  const float NEG=-INFINITY; int d=qrel-(64*jb+4*hi); asm volatile("":"+v"(d));
  #pragma unroll
  for(int r=0;r<16;++r){const int c=(r&3)+8*(r>>2); if(c>d)p0[r]=NEG; if(c+32>d)p1[r]=NEG;}
}

constexpr int NSLOT=3, SLOTB=8192;
constexpr int LDS_K=0, LDS_V=NSLOT*SLOTB, LDS_WS=2*NSLOT*SLOTB, LDS_OST=LDS_WS+NW*64*4, LDS_BYTES=LDS_OST+NW*4096;
constexpr float C2=0.125f*1.4426950408889634f;
__device__ __forceinline__ void glds16(const void*gsrc,unsigned lds_dst){unsigned keep;
  asm volatile("s_mov_b32 %0, m0\n\ts_mov_b32 m0, %2\n\ts_nop 0\n\tglobal_load_lds_dwordx4 %1, off\n\ts_mov_b32 m0, %0":"=&s"(keep):"v"(gsrc),"s"(lds_dst):"memory");}
__device__ __forceinline__ float max3f(float a,float b,float c){float r;asm("v_max3_f32 %0, %1, %2, %3":"=v"(r):"v"(a),"v"(b),"v"(c));return r;}
__device__ __forceinline__ float max2f(float a,float b){float r;asm("v_max_f32_e32 %0, %1, %2":"=v"(r):"v"(a),"v"(b));return r;}
__device__ __forceinline__ float fadd_s(float a,float b){float r;asm("v_add_f32_e32 %0, %1, %2":"=v"(r):"v"(a),"v"(b));return r;}
__device__ __forceinline__ float fsub_s(float a,float b){float r;asm("v_sub_f32_e32 %0, %1, %2":"=v"(r):"v"(a),"v"(b));return r;}
typedef float f32x2_t __attribute__((ext_vector_type(2))); typedef __bf16 bf16x2_t __attribute__((ext_vector_type(2)));
__device__ __forceinline__ unsigned cvtpk_s(float lo,float hi){f32x2_t v={lo,hi};bf16x2_t b=__builtin_convertvector(v,bf16x2_t);return __builtin_bit_cast(unsigned,b);}
#define WAIT_BAR(N) asm volatile("s_waitcnt vmcnt(" #N ") lgkmcnt(0)\n\ts_barrier":::"memory")

__device__ __forceinline__ void qkt(f32x16&p0,f32x16&p1,const char*Kslot,const bf16x8*qr,int r32,int hi){
  const char*kb=Kslot+hi*1024+r32*16;
  #pragma unroll
  for(int d0=0;d0<4;++d0){
    const bf16x8 b0=*reinterpret_cast<const bf16x8*>(kb+d0*2048);
    const bf16x8 b1=*reinterpret_cast<const bf16x8*>(kb+d0*2048+512);
    if(d0==0){p0=__builtin_amdgcn_mfma_f32_32x32x16_bf16(b0,qr[0],f32x16{},0,0,0);p1=__builtin_amdgcn_mfma_f32_32x32x16_bf16(b1,qr[0],f32x16{},0,0,0);}
    else{p0=__builtin_amdgcn_mfma_f32_32x32x16_bf16(b0,qr[d0],p0,0,0,0);p1=__builtin_amdgcn_mfma_f32_32x32x16_bf16(b1,qr[d0],p1,0,0,0);}}
}
typedef __attribute__((address_space(3))) const char* lds_cptr;
typedef short v4i16_t __attribute__((ext_vector_type(4)));
__device__ __forceinline__ void kload8(bf16x8*kf,lds_cptr kp){
  kf[0]=*(const __attribute__((address_space(3))) bf16x8*)(kp);      kf[1]=*(const __attribute__((address_space(3))) bf16x8*)(kp+512);
  kf[2]=*(const __attribute__((address_space(3))) bf16x8*)(kp+2048); kf[3]=*(const __attribute__((address_space(3))) bf16x8*)(kp+2560);
  kf[4]=*(const __attribute__((address_space(3))) bf16x8*)(kp+4096); kf[5]=*(const __attribute__((address_space(3))) bf16x8*)(kp+4608);
  kf[6]=*(const __attribute__((address_space(3))) bf16x8*)(kp+6144); kf[7]=*(const __attribute__((address_space(3))) bf16x8*)(kp+6656);
}
__device__ __forceinline__ void kload2(bf16x8*kf,lds_cptr kp,int j){ kf[2*j]=*(const __attribute__((address_space(3))) bf16x8*)(kp+j*2048); kf[2*j+1]=*(const __attribute__((address_space(3))) bf16x8*)(kp+j*2048+512); }
__device__ __forceinline__ s16x4 vtr(lds_cptr p){ return __builtin_bit_cast(s16x4,__builtin_amdgcn_ds_read_tr16_b64_v4i16((__attribute__((address_space(3))) v4i16_t*)p)); }
__device__ __forceinline__ float rowmax(const f32x16&p0,const f32x16&p1){
  float a=max3f(p0[0],p0[1],p1[0]),b=max3f(p0[2],p0[3],p1[1]);a=max3f(a,p1[2],p1[3]);
  #pragma unroll
  for(int r=4;r<16;r+=4){a=max3f(a,p0[r],p0[r+1]);b=max3f(b,p0[r+2],p0[r+3]);a=max3f(a,p1[r],p1[r+1]);b=max3f(b,p1[r+2],p1[r+3]);}
  const float m=max2f(a,b);
  auto rr=__builtin_amdgcn_permlane32_swap(__float_as_uint(m),__float_as_uint(m),false,false);
  return max2f(__uint_as_float(rr[0]),__uint_as_float(rr[1]));
}
__device__ __forceinline__ void pv(f32x16*o,int vb,bf16x8 pa0,bf16x8 pa1,bf16x8 pa2,bf16x8 pa3){
  #pragma unroll
  for(int d0=0;d0<2;++d0){s16x4 lo[4],hi[4];
    #pragma unroll
    for(int ks=0;ks<4;++ks){
      asm volatile("ds_read_b64_tr_b16 %0,%1 offset:%c2":"=&v"(lo[ks]):"v"(vb),"i"(d0*4096+ks*1024):"memory");
      asm volatile("ds_read_b64_tr_b16 %0,%1 offset:%c2":"=&v"(hi[ks]):"v"(vb),"i"(d0*4096+ks*1024+512):"memory");}
    asm volatile("s_waitcnt lgkmcnt(0)":::"memory");SBAR();
    #define PK(k) (bf16x8){lo[k][0],lo[k][1],lo[k][2],lo[k][3],hi[k][0],hi[k][1],hi[k][2],hi[k][3]}
    o[d0]=__builtin_amdgcn_mfma_f32_32x32x16_bf16(pa0,PK(0),o[d0],0,0,0);
    o[d0]=__builtin_amdgcn_mfma_f32_32x32x16_bf16(pa1,PK(1),o[d0],0,0,0);
    o[d0]=__builtin_amdgcn_mfma_f32_32x32x16_bf16(pa2,PK(2),o[d0],0,0,0);
    o[d0]=__builtin_amdgcn_mfma_f32_32x32x16_bf16(pa3,PK(3),o[d0],0,0,0);
    #undef PK
  }
}

#ifndef ATTN_STORE16
#define ATTN_STORE16(p,v) (*(u32x4*)(p)=(v))
#endif
template<int THRL> __device__ __forceinline__ void attn_unit(int b,int h,int qb,const bf16*Q,const bf16*__restrict__ K,const bf16*__restrict__ V,bf16*O,const unsigned*__restrict__ SEL,char*shm,int wave){
  const int lane=fresh_lane(),wid=wave,tid=wid*64+lane,r32=lane&31,hi=lane>>5; (void)tid;
  const long rowbase=(long)b*SEQ; const int q0=qb*QB;
  const bf16*Qw=Q+(rowbase+q0+wid*QBLK)*DM+h*D;
  const bf16*Kh=K+rowbase*DM+h*D,*Vh=V+rowbase*DM+h*D;
  const unsigned lds0=(unsigned)(uintptr_t)shm;
  float*wsf=(float*)(shm+LDS_WS)+wid*64;
  const bf16*ksrc=Kh+(long)lane*DM+wid*8;
  const bf16*vsrc=Vh+(long)(16*(wid&3)+(lane>>2))*DM+(wid>>2)*32+(lane&3)*8;
  const unsigned kdst=lds0+LDS_K+wid*1024, vdst=lds0+LDS_V+wid*1024;
  #define DMA_K(t,slot) glds16(ksrc+(long)(t)*KVBLK*DM,(unsigned)__builtin_amdgcn_readfirstlane(kdst+(slot)))
  #define DMA_V(t,slot) glds16(vsrc+(long)(t)*KVBLK*DM,(unsigned)__builtin_amdgcn_readfirstlane(vdst+(slot)))
  const int vb0=(int)(lds0+LDS_V)+((lane>>4)&1)*32+(lane&3)*8+(4*hi+((lane&15)>>2))*64;
  const char*Kbase=shm+LDS_K; bf16x8 kf[8];
  const lds_cptr shm3=(lds_cptr)shm; const lds_cptr kp0=shm3+LDS_K+hi*1024+r32*16; const lds_cptr vp0=shm3+LDS_V+((lane>>4)&1)*32+(lane&3)*8+(4*hi+((lane&15)>>2))*64;
  const int NT=(q0+QB)/KVBLK;
  DMA_K(0,0);DMA_V(0,0);DMA_K(1,SLOTB);
  bf16x8 qr[4];
  #pragma unroll
  for(int d0=0;d0<4;++d0)qr[d0]=*reinterpret_cast<const bf16x8*>(&Qw[(long)r32*DM+d0*16+hi*8]);
  float mhat=0.f,l_reg=0.f;f32x16 o[2];o[0]=f32x16{};o[1]=f32x16{};
  const int qrel=wid*QBLK+r32;
  #define SELW() ((volatile __attribute__((address_space(3))) unsigned*)(lds_cptr)((const char*)wsf)+32+r32)
  if(hi==0)*SELW()=SEL[(rowbase+q0+qrel)*NHEAD+h];
  asm volatile("s_waitcnt vmcnt(0) lgkmcnt(0)":::"memory");
  #define CMASK(P0,P1,t) do{int jb_=(t)-(NT-4); if(jb_>=0)cmask(P0,P1,jb_,qrel,hi); else if(MOBA_MASK_ON && !(((*SELW())>>((t)>>2))&1u)){ _Pragma("unroll") for(int r_=0;r_<16;++r_){P0[r_]=-INFINITY;P1[r_]=-INFINITY;} } }while(0)
  bool resc=false;
  #define START(P0,P1) do{ const float rm=rowmax(P0,P1); resc=false; \
    { const float dl=max2f(rm,-100.f); mhat=fadd_s(mhat,dl); \
      _Pragma("unroll") for(int r=0;r<16;++r){P0[r]=fsub_s(P0[r],dl);P1[r]=fsub_s(P1[r],dl);} \
      } \
    _Pragma("unroll") for(int r=0;r<16;++r)P0[r]=__builtin_amdgcn_exp2f(P0[r]); }while(0)
  #define RESC() do{ if(resc){ asm volatile("s_waitcnt lgkmcnt(0)":::"memory"); \
      _Pragma("unroll") for(int d_=0;d_<2;++d_) _Pragma("unroll") for(int r=0;r<16;++r)o[d_][r]*=wsf[crow(r,hi)]; } }while(0)
  f32x16 pA0,pA1,pB0,pB1;
  int sl_prev=0,sl_cur=0,sl_next=SLOTB;
  #define ROT() do{sl_prev=sl_cur;sl_cur=sl_next;sl_next=(sl_next==(NSLOT-1)*SLOTB)?0:sl_next+SLOTB;}while(0)
  DMA_K(2,2*SLOTB);
  WAIT_BAR(3);
  qkt(pA0,pA1,Kbase,qr,r32,hi);asm volatile("s_nop 15\n\ts_nop 7":"+v"(pA0),"+v"(pA1));CMASK(pA0,pA1,0);
  START(pA0,pA1);
  _Pragma("unroll") for(int r=0;r<16;++r)pA1[r]=__builtin_amdgcn_exp2f(pA1[r]);
  WAIT_BAR(0);
  DMA_K(3,0);DMA_V(1,SLOTB);
  ROT();
  kload8(kf,kp0+sl_cur);
  WAIT_BAR(2);
  s16x4 vlo[8],vhi[8]; u32x4 pw0,pw1,pw2,pw3;
  #define PKW(P,B) cvtpk_s(P[B],P[B+1])
  #define PAF(k) __builtin_bit_cast(bf16x8,pw##k)
  #define VFR(i) (bf16x8){vlo[i][0],vlo[i][1],vlo[i][2],vlo[i][3],vhi[i][0],vhi[i][1],vhi[i][2],vhi[i][3]}
  #define PIN(x) asm volatile("":"+v"(x))
  #define MX3(a,b,c) __builtin_fmaxf(__builtin_fmaxf((a),(b)),(c))
  #define GAPA(MF,A0,A1,A2,A3,W0,W1,PW) do{ MF; sacc+=A0; sacc+=A1; sacc+=A2; sacc+=A3; PIN(sacc); W0; W1; PIN(PW); SBAR(); }while(0)
  #define EX(v) __builtin_amdgcn_exp2f(v)
  #define GAPB(MF,X,B) do{ MF; X[B]=EX(X[B]); X[B+1]=EX(X[B+1]); X[B+2]=EX(X[B+2]); X[B+3]=EX(X[B+3]); PIN(X); SBAR(); }while(0)
  #define VRD(i) do{ vlo[i]=vtr(vp_+(((i)>>2)*4096+((i)&3)*1024)); vhi[i]=vtr(vp_+(((i)>>2)*4096+((i)&3)*1024+512)); }while(0)
  #define KRD(G,j) do{ if(G){ kload2(kf,kp0+sl_next,j); SBAR(); } }while(0)
  #define STEP(C0,C1,P0,P1,t,GK,GV,GL) do{ SBAR(); \
    const lds_cptr vp_=vp0+sl_prev; \
    VRD(0); SBAR(); float sacc=(P0[0]+P0[1]); \
    GAPA(C0=__builtin_amdgcn_mfma_f32_32x32x16_bf16(kf[0],qr[0],f32x16{},0,0,0), P0[2],P0[3],P0[4],P0[5],     pw0[0]=PKW(P0,0), pw0[1]=PKW(P0,2), pw0); \
    VRD(4); SBAR(); GAPA(C1=__builtin_amdgcn_mfma_f32_32x32x16_bf16(kf[1],qr[0],f32x16{},0,0,0), P0[6],P0[7],P0[8],P0[9],     pw0[2]=PKW(P0,4), pw0[3]=PKW(P0,6), pw0); \
    VRD(1); SBAR(); GAPA(C0=__builtin_amdgcn_mfma_f32_32x32x16_bf16(kf[2],qr[1],C0,0,0,0),   P0[10],P0[11],P0[12],P0[13], pw1[0]=PKW(P0,8), pw1[1]=PKW(P0,10), pw1); \
    VRD(5); SBAR(); GAPA(C1=__builtin_amdgcn_mfma_f32_32x32x16_bf16(kf[3],qr[1],C1,0,0,0),   P0[14],P0[15],P1[0],P1[1],   pw1[2]=PKW(P0,12),pw1[3]=PKW(P0,14), pw1); \
    VRD(2); SBAR(); GAPA(C0=__builtin_amdgcn_mfma_f32_32x32x16_bf16(kf[4],qr[2],C0,0,0,0),   P1[2],P1[3],P1[4],P1[5],     pw2[0]=PKW(P1,0), pw2[1]=PKW(P1,2), pw2); \
    VRD(6); SBAR(); GAPA(C1=__builtin_amdgcn_mfma_f32_32x32x16_bf16(kf[5],qr[2],C1,0,0,0),   P1[6],P1[7],P1[8],P1[9],     pw2[2]=PKW(P1,4), pw2[3]=PKW(P1,6), pw2); \
    VRD(3); SBAR(); GAPA(C0=__builtin_amdgcn_mfma_f32_32x32x16_bf16(kf[6],qr[3],C0,0,0,0),   P1[10],P1[11],P1[12],P1[13], pw3[0]=PKW(P1,8), pw3[1]=PKW(P1,10), pw3); \
    VRD(7); SBAR(); GAPA(C1=__builtin_amdgcn_mfma_f32_32x32x16_bf16(kf[7],qr[3],C1,0,0,0),   P1[14],P1[15],0.f,0.f,       pw3[2]=PKW(P1,12),pw3[3]=PKW(P1,14), pw3); \
    l_reg+=sacc; \
    if(GK){DMA_K((t)+3,sl_cur);} if(GV){DMA_V((t)+1,sl_next);} \
    _Pragma("unroll") for(int r=0;r<16;++r){C0[r]-=mhat;C1[r]-=mhat;} \
    CMASK(C0,C1,t); \
    { float a=MX3(C0[0],C0[1],C1[0]),b=MX3(C0[2],C0[3],C1[1]); a=MX3(a,C1[2],C1[3]); \
      _Pragma("unroll") for(int r=4;r<16;r+=4){a=MX3(a,C0[r],C0[r+1]);b=MX3(b,C0[r+2],C0[r+3]);a=MX3(a,C1[r],C1[r+1]);b=MX3(b,C1[r+2],C1[r+3]);} \
      float rm=__builtin_fmaxf(a,b); { auto rr=__builtin_amdgcn_permlane32_swap(__float_as_uint(rm),__float_as_uint(rm),false,false); rm=__builtin_fmaxf(__uint_as_float(rr[0]),__uint_as_float(rr[1])); } \
      resc=false; \
      if(__builtin_expect(__any(rm>(float)THRL),0)){ const float dl=__builtin_fmaxf(rm,0.f); mhat+=dl; \
        _Pragma("unroll") for(int r=0;r<16;++r){C0[r]-=dl;C1[r]-=dl;} \
        const float f=__builtin_amdgcn_exp2f(-dl); l_reg*=f; if(hi==0)wsf[r32]=f; resc=true; } } \
    SBAR(); \
    GAPB(o[0]=__builtin_amdgcn_mfma_f32_32x32x16_bf16(PAF(0),VFR(0),o[0],0,0,0), C0,0); \
    GAPB(o[1]=__builtin_amdgcn_mfma_f32_32x32x16_bf16(PAF(0),VFR(4),o[1],0,0,0), C0,4); \
    KRD(GL,0); GAPB(o[0]=__builtin_amdgcn_mfma_f32_32x32x16_bf16(PAF(1),VFR(1),o[0],0,0,0), C0,8); \
    KRD(GL,1); GAPB(o[1]=__builtin_amdgcn_mfma_f32_32x32x16_bf16(PAF(1),VFR(5),o[1],0,0,0), C0,12); \
    KRD(GL,2); GAPB(o[0]=__builtin_amdgcn_mfma_f32_32x32x16_bf16(PAF(2),VFR(2),o[0],0,0,0), C1,0); \
    KRD(GL,3); GAPB(o[1]=__builtin_amdgcn_mfma_f32_32x32x16_bf16(PAF(2),VFR(6),o[1],0,0,0), C1,4); \
    GAPB(o[0]=__builtin_amdgcn_mfma_f32_32x32x16_bf16(PAF(3),VFR(3),o[0],0,0,0), C1,8); \
    GAPB(o[1]=__builtin_amdgcn_mfma_f32_32x32x16_bf16(PAF(3),VFR(7),o[1],0,0,0), C1,12); \
    }while(0)
  int t=1;
  for(;t+5<NT;t+=2){
    STEP(pB0,pB1,pA0,pA1,t,true,true,true);     WAIT_BAR(2); RESC(); ROT();
    STEP(pA0,pA1,pB0,pB1,t+1,true,true,true);   WAIT_BAR(2); RESC(); ROT();
  }
  #undef CMASK
  #define CMASK(P0,P1,t) do{int jb_=(t)-(NT-4); if(jb_>=0)cmask(P0,P1,jb_,qrel,hi); else if(MOBA_MASK_ON && !(((*SELW())>>((t)>>2))&1u)){ _Pragma("unroll") for(int r_=0;r_<16;++r_){P0[r_]=-INFINITY;P1[r_]=-INFINITY;} } }while(0)
  #define ENDW(tt) do{ if((tt)+3<NT){WAIT_BAR(2);} else if((tt)+2<NT){WAIT_BAR(1);} else {WAIT_BAR(0);} }while(0)
  for(;t+1<NT;t+=2){
    STEP(pB0,pB1,pA0,pA1,t,(t+3<NT),(t+1<NT),(t+1<NT));       ENDW(t);   RESC(); ROT();
    STEP(pA0,pA1,pB0,pB1,t+1,(t+4<NT),(t+2<NT),(t+2<NT));     ENDW(t+1); RESC(); ROT();
  }
  STEP(pB0,pB1,pA0,pA1,NT-1,false,false,false); RESC();
  { float sacc=pB0[0]+pB0[1]; _Pragma("unroll") for(int r=2;r<16;++r)sacc+=pB0[r]; _Pragma("unroll") for(int r=0;r<16;++r)sacc+=pB1[r]; l_reg+=sacc;
    pw0=(u32x4){PKW(pB0,0),PKW(pB0,2),PKW(pB0,4),PKW(pB0,6)};pw1=(u32x4){PKW(pB0,8),PKW(pB0,10),PKW(pB0,12),PKW(pB0,14)};pw2=(u32x4){PKW(pB1,0),PKW(pB1,2),PKW(pB1,4),PKW(pB1,6)};pw3=(u32x4){PKW(pB1,8),PKW(pB1,10),PKW(pB1,12),PKW(pB1,14)};
    SBAR(); pv(o,vb0+sl_cur,PAF(0),PAF(1),PAF(2),PAF(3)); }
  #undef PKW
  #undef PAF
  #undef VFR
  #undef PIN
  #undef MX3
  #undef GAPA
  #undef GAPB
  #undef EX
  #undef VRD
  #undef KRD
  #undef STEP
  #undef ENDW
  {auto rr=__builtin_amdgcn_permlane32_swap(__float_as_uint(l_reg),__float_as_uint(l_reg),false,false);l_reg=__uint_as_float(rr[0])+__uint_as_float(rr[1]);}
  if(hi==0)wsf[32+r32]=l_reg;asm volatile("s_waitcnt lgkmcnt(0)":::"memory");
  float rli[16];
  #pragma unroll
  for(int r=0;r<16;++r)rli[r]=__builtin_amdgcn_rcpf(wsf[32+crow(r,hi)]);
  bf16*Ow=O+(rowbase+q0+wid*QBLK)*DM+h*D;
  { bf16*stg=(bf16*)(shm+LDS_OST)+wid*2048;
    #pragma unroll
    for(int r=0;r<16;++r){const int orow=crow(r,hi);
      #pragma unroll
      for(int d0=0;d0<2;++d0)stg[orow*64+d0*32+r32]=__float2bfloat16(o[d0][r]*rli[r]);}
    asm volatile("s_waitcnt lgkmcnt(0)":::"memory");
    #pragma unroll
    for(int i=0;i<4;++i){const int row=i*8+(lane>>3),ch=lane&7; const u32x4 v=*(const u32x4*)(stg+row*64+ch*8); ATTN_STORE16(Ow+(long)row*DM+ch*8,v);} }
  asm volatile("s_waitcnt lgkmcnt(0)\n\ts_barrier":::"memory");
  #undef SELW
  #undef DMA_K
  #undef DMA_V
  #undef CMASK
  #undef START
  #undef RESC
  #undef ROT
}
constexpr int ATTN_LDS_BYTES=LDS_BYTES;
struct AttnTensors { const bf16* Q; const bf16* K; const bf16* V; bf16* O; const unsigned* SEL; };
struct AttnUnit { int bh; int qb; };
struct StaticOrder {
  int vcu;
  __device__ __forceinline__ explicit StaticOrder(int grid,int block):vcu((block%8)*(grid/8)+block/8){}
  __device__ __forceinline__ bool next(int i,AttnUnit&u)const{ if(i>=4)return false; const int s=vcu&7; u.bh=vcu>>3; u.qb=(i==0)?s:(i==1)?15-s:(i==2)?16+s:31-s; return true; }
  __device__ __forceinline__ void a_ready(const AttnUnit&)const{}
  __device__ __forceinline__ void done(const AttnUnit&)const{}
};
template<class Sched,int THRL=8> __device__ __forceinline__ void attn_phase(char*lds,const AttnTensors&T,const Sched&S,int wave){
  AttnUnit u;
  for(int i=0;S.next(i,u);++i){ S.a_ready(u); attn_unit<THRL>(u.bh/NHEAD,u.bh%NHEAD,u.qb,T.Q,T.K,T.V,T.O,T.SEL,lds,wave); S.done(u); }
}
#undef SBAR
#undef WAIT_BAR
}

constexpr int NWAVES = 8;
constexpr int BATCH = 2, T = 8192, D = 1024, H = 16, HD = 64, M = BATCH * T;
constexpr int FF = 2816, FFE = 3584, NE = 8, MOE_ROWS = 34816  ;
constexpr float MOE_WSCALE = 64.f;
constexpr float LN_EPS = 1e-5f, GN_EPS = 64e-5f, ALPHA = 1.6817928305074292f  ;
constexpr size_t MiB = 1u << 20;
constexpr size_t WS_CTL = 0, CTL_ZERO_BYTES = 1 * MiB;
constexpr size_t WS_KMEAN = 1 * MiB;
constexpr size_t WS_SEL = 2 * MiB;
constexpr size_t WS_TOKE = 3 * MiB;
constexpr size_t WS_TOKW = WS_TOKE + 128 * 1024;
constexpr size_t WS_TOKR = WS_TOKW + 128 * 1024;
constexpr size_t WS_GW = WS_TOKR + 128 * 1024;
constexpr size_t WS_BLKCNT = WS_GW + 256 * 1024;
constexpr size_t WS_WMIX = 16 * MiB;
constexpr size_t WS_WFFN = 32 * MiB;
constexpr size_t WS_H = 200 * MiB;
constexpr size_t WS_HB = 264 * MiB;
constexpr size_t WS_K = 296 * MiB, WS_V = 328 * MiB;
constexpr size_t WS_VFIRST = WS_K;
constexpr size_t WS_Y = WS_V;
constexpr size_t WS_SCR = 360 * MiB;
constexpr size_t WS_END = 896 * MiB;
constexpr size_t RS_XM = WS_SCR;
constexpr size_t RS_KP = WS_SCR, RS_AP = WS_SCR + 32 * MiB, RS_VP = WS_SCR + 64 * MiB, RS_BP = WS_SCR + 96 * MiB;
constexpr size_t RS_RKV = WS_SCR + 192 * MiB;
constexpr size_t RS_PRE = RS_RKV;
constexpr size_t RS_LH = WS_SCR + 288 * MiB;
constexpr size_t RS_YG = RS_LH;
constexpr size_t RS_DEC = WS_SCR + 320 * MiB;
constexpr size_t RS_AB = WS_SCR + 384 * MiB;
constexpr size_t RS_REC0 = WS_SCR + 224 * MiB, RS_REC1 = WS_SCR + 384 * MiB;
constexpr size_t RS_VG = WS_SCR + 448 * MiB;
constexpr size_t RS_GG = WS_SCR + 480 * MiB;
constexpr size_t BS_Q = WS_SCR, BS_PRE = WS_SCR + 32 * MiB, BS_O = WS_SCR + 96 * MiB;
constexpr size_t BS_PO = WS_SCR + 128 * MiB, BS_ML = WS_SCR + 256 * MiB;
constexpr size_t FS_HID = WS_SCR, FS_PRE = WS_SCR + 88 * MiB;
constexpr size_t ES_XG = WS_SCR, ES_HID = WS_SCR + 68 * MiB, ES_YP = WS_SCR + 306 * MiB, ES_YS = WS_SCR + 442 * MiB;
static_assert(RS_GG + 32 * MiB <= WS_END && ES_YS + 56 * MiB <= WS_END && FS_PRE + 64 * MiB <= WS_END, "d_ws map");
constexpr size_t RW_LSTRIDE = 872 * MiB - WS_WMIX;
constexpr size_t WM_BT1 = WS_WMIX, WM_BT2 = WS_WMIX + 8 * MiB, WM_OUT = WS_WMIX + 10 * MiB;
constexpr size_t WM_QKV = WS_WMIX, WM_O = WS_WMIX + 8 * MiB;
constexpr size_t WF_GU = WS_WFFN, WF_DN = WS_WFFN + 12 * MiB;
constexpr size_t WE_GU = WS_WFFN, WE_DN = WS_WFFN + 112 * MiB;
constexpr int CW_TMO = 0, CW_CODE = 1, CW_QCTR = 2048  , CW_BAR = 4096;
constexpr int RING_OFF = 0, RING_BYTES = 131072;
constexpr int LDSCTL_OFF = RING_BYTES, MISC_OFF = LDSCTL_OFF + 320;
constexpr int LDS_BYTES = 147456;
static_assert(MISC_OFF + 128 <= LDS_BYTES, "LDS map");

#define GAS __attribute__((address_space(1)))
#define LAS __attribute__((address_space(3)))
typedef unsigned short bf16;
typedef unsigned v4u __attribute__((ext_vector_type(4)));
typedef float f32x4 __attribute__((ext_vector_type(4)));
typedef short bf16x8 __attribute__((ext_vector_type(8)));
typedef GAS unsigned gu32;
typedef GAS unsigned long long gu64;
#define RLX_AGENT __ATOMIC_RELAXED, __HIP_MEMORY_SCOPE_AGENT
#define LDS_WAIT() asm volatile("s_waitcnt lgkmcnt(0)" ::: "memory")
#define VM_WAIT() asm volatile("s_waitcnt vmcnt(0)" ::: "memory")
__device__ __forceinline__ unsigned long long rt() { return __builtin_amdgcn_s_memrealtime(); }
__device__ __forceinline__ unsigned f2bf(float f) { unsigned u = __builtin_bit_cast(unsigned, f); return (u + 0x7fffu + ((u >> 16) & 1u)) >> 16; }
__device__ __forceinline__ unsigned pk2(float lo, float hi) { return f2bf(lo) | (f2bf(hi) << 16); }

#define XB_TMO      128
#define XB_XCNT(j)  (256  + 64 * (j))
#define XB_XSUB(j)  (1280 + 64 * (j))
#define XB_XGEN(j)  (2304 + 64 * (j))
#define XB_TOP      3328
#define XB_TOPGEN   3392
#define XCD_BAR_WORDS 3456
#define XB_SPIN_CAP (1u << 18)

__device__ __forceinline__ unsigned xb_ld(unsigned* p)              { return __hip_atomic_load(p, __ATOMIC_RELAXED, __HIP_MEMORY_SCOPE_AGENT); }
__device__ __forceinline__ unsigned xb_add(unsigned* p, unsigned v) { return __hip_atomic_fetch_add(p, v, __ATOMIC_RELAXED, __HIP_MEMORY_SCOPE_AGENT); }
__device__ __forceinline__ unsigned xb_xcc_id() { return (unsigned)__builtin_amdgcn_s_getreg((3 << 11) | 20) & 0xFu; }
#define XB_SPIN(cond, bar) do { unsigned _sp = 0; while (cond) { __builtin_amdgcn_s_sleep(1); \
    if ((++_sp & 255u) == 0u) { if (xb_ld(&(bar)[XB_TMO])) break; if (_sp > XB_SPIN_CAP) { atomicAdd(&(bar)[XB_TMO], 1u); break; } } } } while (0)

struct XcdBarrier {
    unsigned* bar; unsigned x;
    volatile LAS unsigned* st;
};

__device__ __forceinline__ XcdBarrier xcd_barrier_post(unsigned* bar, volatile LAS unsigned* st, bool t0  ) {
    XcdBarrier b; b.bar = bar; b.x = xb_xcc_id(); b.st = st;
    if (t0) (void)xb_add(&bar[XB_XCNT(b.x)], 1u);
    return b;
}
__device__ __forceinline__ void xcd_barrier_complete(unsigned* bar, unsigned x, unsigned& nloc, unsigned& nx) {
    const unsigned G = gridDim.x * gridDim.y * gridDim.z;
    unsigned sum, cnt, mine, sp = 0u;
    for (;;) {
        sum = 0u; cnt = 0u; mine = 0u;
#pragma unroll
        for (unsigned j = 0; j < 16; ++j) { const unsigned c = xb_ld(&bar[XB_XCNT(j)]); sum += c; cnt += (c > 0u) ? 1u : 0u; mine = (j == x) ? c : mine; }
        if (sum == G) break;
        __builtin_amdgcn_s_sleep(1);
        if ((++sp & 255u) == 0u) { if (xb_ld(&bar[XB_TMO])) break; if (sp > XB_SPIN_CAP) { atomicAdd(&bar[XB_TMO], 1u); break; } }
    }
    nloc = mine > 0u ? mine : 1u; nx = cnt > 0u ? cnt : 1u;
}

__device__ __forceinline__ void xcd_barrier(const XcdBarrier& b, bool t0  ) {
    asm volatile("s_waitcnt vmcnt(0)" ::: "memory");
    __syncthreads();
    if (t0) {
        unsigned* bar = b.bar;
        __builtin_amdgcn_s_waitcnt(0);
        unsigned nloc = b.st[0], nx = b.st[1];
        if (nloc == 0u) { xcd_barrier_complete(bar, b.x, nloc, nx); b.st[0] = nloc; b.st[1] = nx; }
        const unsigned old = xb_add(&bar[XB_XSUB(b.x)], 1u);
        const unsigned gen = old / nloc;
        if (old + 1u == (gen + 1u) * nloc) {
            __builtin_amdgcn_fence(__ATOMIC_RELEASE, "agent");
            asm volatile("s_waitcnt vmcnt(0)" ::: "memory");
            const unsigned og = xb_add(&bar[XB_TOP], 1u);
            const unsigned tg = og / nx;
            if (og + 1u == (tg + 1u) * nx) xb_add(&bar[XB_TOPGEN], 1u);
            else XB_SPIN(xb_ld(&bar[XB_TOPGEN]) == tg, bar);
#ifdef XB_L2_INV
            __builtin_amdgcn_fence(__ATOMIC_ACQUIRE, "");
#else
            __builtin_amdgcn_fence(__ATOMIC_ACQUIRE, "agent");
#endif
            xb_add(&bar[XB_XGEN(b.x)], 1u);
            asm volatile("s_waitcnt vmcnt(0)" ::: "memory");
        } else {
            XB_SPIN(xb_ld(&bar[XB_XGEN(b.x)]) == gen, bar);
            __builtin_amdgcn_fence(__ATOMIC_ACQUIRE, "agent");
            asm volatile("s_waitcnt vmcnt(0)" ::: "memory");
        }
    }
    __syncthreads();
}

struct Args { const float* in[33]; float* out; unsigned char* ws; };
enum InIdx { I_X = 0, I_MU, I_WRKV, I_WOUT, I_W0, I_W1, I_W2, I_A0, I_A1, I_A2, I_V0, I_V1, I_V2, I_G1, I_G2, I_KK, I_KA, I_RK, I_GNG, I_GNB,
             I_MK, I_MV, I_MQ, I_MO, I_FG, I_FU, I_FD, I_ROUTER, I_EG, I_EU, I_ED, I_LNG, I_LNB };
struct Frame {
    LAS unsigned char* lds; volatile LAS unsigned* MISC; gu32* ctl; unsigned char* ws;
    int tid, lane, wave, vcu, G, gw, NGW;
};
typedef float f32x2 __attribute__((ext_vector_type(2)));
typedef unsigned u32x2 __attribute__((ext_vector_type(2)));
__device__ __forceinline__ float dpp_sum16(float v) {
    v += __builtin_bit_cast(float, __builtin_amdgcn_update_dpp(0, __builtin_bit_cast(int, v), 0xB1, 0xF, 0xF, true));
    v += __builtin_bit_cast(float, __builtin_amdgcn_update_dpp(0, __builtin_bit_cast(int, v), 0x4E, 0xF, 0xF, true));
    v += __builtin_bit_cast(float, __builtin_amdgcn_update_dpp(0, __builtin_bit_cast(int, v), 0x141, 0xF, 0xF, true));
    v += __builtin_bit_cast(float, __builtin_amdgcn_update_dpp(0, __builtin_bit_cast(int, v), 0x140, 0xF, 0xF, true));
    return v;
}
__device__ __forceinline__ float wave_sum(float v, int lane) {
    v = dpp_sum16(v);
    v += __builtin_bit_cast(float, __builtin_amdgcn_ds_bpermute((lane ^ 16) << 2, __builtin_bit_cast(int, v)));
    v += __builtin_bit_cast(float, __builtin_amdgcn_ds_bpermute((lane ^ 32) << 2, __builtin_bit_cast(int, v)));
    return v;
}
__device__ __forceinline__ float sum16(float v) { return dpp_sum16(v); }
__device__ __forceinline__ float bf2f(unsigned short b) { return __uint_as_float((unsigned)b << 16); }
__device__ __forceinline__ f32x4 bf4_to_f32(u32x2 w) { f32x4 r; r.x = __uint_as_float(w.x << 16); r.y = __uint_as_float(w.x & 0xffff0000u); r.z = __uint_as_float(w.y << 16); r.w = __uint_as_float(w.y & 0xffff0000u); return r; }
__device__ __forceinline__ u32x2 f32_to_bf4(f32x4 v) { u32x2 w; w.x = pk2(v.x, v.y); w.y = pk2(v.z, v.w); return w; }

__device__ __forceinline__ void tr_item(const float* W, int ldw, int Kr, int Nr, int nblk, bf16* WT, int ldt, int row0, int mode, LAS float* scr, int item, int lane) {
    const int kb = item / nblk, nb = item - kb * nblk, k0 = 64 * kb, n0 = 32 * nb;
    const int kg = lane >> 3, n = n0 + 4 * (lane & 7), kk = k0 + 8 * kg;
    f32x4 v[8];
#pragma unroll
    for (int i = 0; i < 8; ++i) { v[i] = (f32x4){0.f, 0.f, 0.f, 0.f}; if (kk + i < Kr && n < Nr) v[i] = *(const f32x4*)(W + (size_t)(kk + i) * ldw + n); }
#pragma unroll
    for (int e = 0; e < 4; ++e) { const int nn = n + e; const int drow = mode == 0 ? row0 + nn : row0 + ((nn >> 7) << 8) + (nn & 127);
        v4u o; o.x = pk2(v[0][e], v[1][e]); o.y = pk2(v[2][e], v[3][e]); o.z = pk2(v[4][e], v[5][e]); o.w = pk2(v[6][e], v[7][e]);
        *(GAS v4u*)(WT + (size_t)drow * ldt + kk) = o; }
}
__device__ __forceinline__ void tr_item8(const float* W, int ldw, int Kr, int Nr, int nblk, unsigned char* WT, int ldt, int row0, int mode, float scale, int item, int lane) {
    const int kb = item / nblk, nb = item - kb * nblk, k0 = 64 * kb, n0 = 32 * nb;
    const int kg = lane >> 3, n = n0 + 4 * (lane & 7), kk = k0 + 8 * kg;
    f32x4 v[8];
#pragma unroll
    for (int i = 0; i < 8; ++i) { v[i] = (f32x4){0.f, 0.f, 0.f, 0.f}; if (kk + i < Kr && n < Nr) v[i] = *(const f32x4*)(W + (size_t)(kk + i) * ldw + n) * scale; }
#pragma unroll
    for (int e = 0; e < 4; ++e) { const int nn = n + e; const int drow = mode == 0 ? row0 + nn : row0 + ((nn >> 7) << 8) + (nn & 127);
        int lo = __builtin_amdgcn_cvt_pk_fp8_f32(v[0][e], v[1][e], 0, false); lo = __builtin_amdgcn_cvt_pk_fp8_f32(v[2][e], v[3][e], lo, true);
        int hi = __builtin_amdgcn_cvt_pk_fp8_f32(v[4][e], v[5][e], 0, false); hi = __builtin_amdgcn_cvt_pk_fp8_f32(v[6][e], v[7][e], hi, true);
        u32x2 o; o.x = (unsigned)lo; o.y = (unsigned)hi; *(GAS u32x2*)(WT + (size_t)drow * ldt + kk) = o; }
}
#define KIN(i) ({ const __attribute__((address_space(4))) char* k_ = (const __attribute__((address_space(4))) char*)__builtin_amdgcn_kernarg_segment_ptr(); asm volatile("" : "+s"(k_)); const GAS float* g_ = (const GAS float*)(*(const float* const __attribute__((address_space(4)))*)(k_ + 8 * (i))); asm volatile("" : "+s"(g_)); (const float*)g_; })
#define CONV_BEGIN() F.lane = fresh_lane(); F.tid = F.wave * 64 + F.lane; asm volatile("" : "+s"(F.G), "+s"(F.wave), "+s"(F.vcu), "+s"(F.gw), "+s"(F.NGW)); GAS unsigned char* cws0_ = (GAS unsigned char*)F.ws; asm volatile("" : "+s"(cws0_)); unsigned char* cws_ = (unsigned char*)cws0_; LAS float* scr_ = (LAS float*)(F.lds + RING_OFF + F.wave * 16384); int it_ = F.gw, base_ = 0
#define JOB(W, ldw, Kr, Nr, Kp, Np, WT, ldt, row0, mode) do { const int nblk_ = (Np) / 32, n_ = ((Kp) / 64) * nblk_; \
    while (it_ < base_ + n_) { tr_item((W), (ldw), (Kr), (Nr), nblk_, (WT), (ldt), (row0), (mode), scr_, it_ - base_, F.lane); it_ += F.NGW; } base_ += n_; } while (0)
#define JOB8(W, ldw, Kr, Nr, Kp, Np, WT, ldt, row0, mode, scale) do { const int nblk_ = (Np) / 32, n_ = ((Kp) / 64) * nblk_; \
    while (it_ < base_ + n_) { tr_item8((W), (ldw), (Kr), (Nr), nblk_, (WT), (ldt), (row0), (mode), (scale), it_ - base_, F.lane); it_ += F.NGW; } base_ += n_; } while (0)

__device__ __forceinline__ void conv_rwkv(Frame& F, int l) {
    CONV_BEGIN();
    cws_ += (size_t)l * RW_LSTRIDE; bf16* BT1 = (bf16*)(cws_ + WM_BT1); bf16* BT2 = (bf16*)(cws_ + WM_BT2); bf16* WO = (bf16*)(cws_ + WM_OUT);
    for (int c = 0; c < 3; ++c) JOB(KIN(I_WRKV) + (size_t)(l * 3 + c) * D * D, D, D, D, D, D, BT1, D, c * D, 0);
    JOB(KIN(I_W1) + (size_t)l * D * 64, 64, D, 64, D, 256, BT1, D, 3072, 0);
    JOB(KIN(I_A1) + (size_t)l * D * 64, 64, D, 64, D, 256, BT1, D, 3328, 0);
    JOB(KIN(I_V1), 32, D, (l == 0 ? 0 : 32), D, 256, BT1, D, 3584, 0);
    JOB(KIN(I_G1) + (size_t)l * D * 160, 160, D, 160, D, 256, BT1, D, 3840, 0);
    JOB(KIN(I_W2) + (size_t)l * 64 * D, D, 64, D, 256, D, BT2, 256, 0, 0);
    JOB(KIN(I_A2) + (size_t)l * 64 * D, D, 64, D, 256, D, BT2, 256, 1024, 0);
    JOB(KIN(I_V2), D, (l == 0 ? 0 : 32), D, 256, D, BT2, 256, 2048, 0);
    JOB(KIN(I_G2) + (size_t)l * 160 * D, D, 160, D, 256, D, BT2, 256, 3072, 0);
    JOB(KIN(I_WOUT) + (size_t)l * D * D, D, D, D, D, D, WO, D, 0, 0);
}
__device__ __forceinline__ void conv_moba(Frame& F, int j) {
    CONV_BEGIN();
    bf16* WQ = (bf16*)(cws_ + WM_QKV); bf16* WO = (bf16*)(cws_ + WM_O);
    JOB(KIN(I_MQ) + (size_t)j * D * D, D, D, D, D, D, WQ, D, 0, 0);
    if (j == 0) { JOB(KIN(I_MK), D, D, D, D, D, WQ, D, D, 0); JOB(KIN(I_MV), D, D, D, D, D, WQ, D, 2 * D, 0); }
    JOB(KIN(I_MO) + (size_t)j * D * D, D, D, D, D, D, WO, D, 0, 0);
}
__device__ __forceinline__ void conv_dense(Frame& F, int e) {
    CONV_BEGIN();
    bf16* GU = (bf16*)(cws_ + WF_GU); bf16* DN = (bf16*)(cws_ + WF_DN);
    JOB(KIN(I_FG) + (size_t)e * D * FF, FF, D, FF, D, FF, GU, D, 0, 1);
    JOB(KIN(I_FU) + (size_t)e * D * FF, FF, D, FF, D, FF, GU, D, 128, 1);
    JOB(KIN(I_FD) + (size_t)e * FF * D, D, FF, D, FF, D, DN, FF, 0, 0);
}
__device__ __forceinline__ void conv_moe(Frame& F, int e) {
    CONV_BEGIN();
    bf16* GU = (bf16*)(cws_ + WE_GU); bf16* DN = (bf16*)(cws_ + WE_DN);
    for (int x = 0; x < NE; ++x) {
        JOB8(KIN(I_EG) + (size_t)(e * NE + x) * D * FFE, FFE, D, FFE, D, FFE, (unsigned char*)GU, D, x * 2 * FFE, 1, MOE_WSCALE);
        JOB8(KIN(I_EU) + (size_t)(e * NE + x) * D * FFE, FFE, D, FFE, D, FFE, (unsigned char*)GU, D, x * 2 * FFE + 128, 1, MOE_WSCALE);
        JOB(KIN(I_ED) + (size_t)(e * NE + x) * FFE * D, D, FFE, D, FFE, D, DN, FFE, x * D, 0);
    }
}

__device__ __forceinline__ void ln_stats(const f32x4 (&v)[4], float& mean, float& rstd, int lane) {
    float s = 0.f;
#pragma unroll
    for (int j = 0; j < 4; ++j) s += (v[j].x + v[j].y) + (v[j].z + v[j].w);
    mean = wave_sum(s, lane) * (1.f / D); float s2 = 0.f;
#pragma unroll
    for (int j = 0; j < 4; ++j) { const f32x4 d = v[j] - mean; s2 += (d.x * d.x + d.y * d.y) + (d.z * d.z + d.w * d.w); }
    rstd = 1.f / sqrtf(wave_sum(s2, lane) * (1.f / D) + LN_EPS);
}
template <int SRC, bool ROUTER>
__device__ __forceinline__ void ln_phase(Frame& F, const float* PRE, const float* Hin, const float* YP, const int* tokr, const float* gln, const float* bln,
                                         float* Hout, bf16* HB, const float* router, int* toke, float* tokw, int* blkcnt) {
    LAS int* cnt = (LAS int*)(F.lds + RING_OFF + 131072 - 64);
    if (ROUTER) { if (F.tid < 8) cnt[F.tid] = 0; __syncthreads(); }
    f32x4 g4[4], b4[4];
#pragma unroll
    for (int j = 0; j < 4; ++j) { g4[j] = *(const f32x4*)(gln + 4 * F.lane + 256 * j); b4[j] = *(const f32x4*)(bln + 4 * F.lane + 256 * j); }
    const int rpb = M / F.G, rpw = rpb / NWAVES;
    for (int i = 0; i < rpw; ++i) {
        const int m = blockIdx.x * rpb + F.wave * rpw + i;
        f32x4 v[4];
        if (SRC == 0) {
#pragma unroll
            for (int j = 0; j < 4; ++j) v[j] = *(const f32x4*)(PRE + (size_t)m * D + 4 * F.lane + 256 * j);
        } else {
            const int r0 = tokr[2 * m], r1 = tokr[2 * m + 1];
#pragma unroll
            for (int j = 0; j < 4; ++j) { const int c = 4 * F.lane + 256 * j;
                f32x4 y0, y1;
                if (r0 < 32768) y0 = *(const f32x4*)(YP + (size_t)r0 * D + c); else { y0 = (f32x4){0.f, 0.f, 0.f, 0.f}; for (int s = 0; s < 7; ++s) y0 += *(const f32x4*)(PRE + ((size_t)s * 2048 + (r0 - 32768)) * D + c); }
                if (r1 < 32768) y1 = *(const f32x4*)(YP + (size_t)r1 * D + c); else { y1 = (f32x4){0.f, 0.f, 0.f, 0.f}; for (int s = 0; s < 7; ++s) y1 += *(const f32x4*)(PRE + ((size_t)s * 2048 + (r1 - 32768)) * D + c); }
                v[j] = *(const f32x4*)(Hin + (size_t)m * D + c) * ALPHA + y0 + y1; }
        }
        float mean, rstd; ln_stats(v, mean, rstd, F.lane);
#pragma unroll
        for (int j = 0; j < 4; ++j) { v[j] = (v[j] - mean) * rstd * g4[j] + b4[j];
            *(f32x4*)(Hout + (size_t)m * D + 4 * F.lane + 256 * j) = v[j];
            if (HB) *(u32x2*)(HB + (size_t)m * D + 4 * F.lane + 256 * j) = f32_to_bf4(v[j]); }
        if (ROUTER) {
            float lg[8];
#pragma unroll
            for (int e = 0; e < 8; ++e) lg[e] = 0.f;
#pragma unroll
            for (int j = 0; j < 4; ++j)
#pragma unroll
                for (int q = 0; q < 4; ++q) { const float xv = v[j][q]; const f32x4* rp = (const f32x4*)(router + (size_t)(4 * F.lane + 256 * j + q) * 8); const f32x4 ra = rp[0], rb = rp[1];
                    lg[0] += xv * ra.x; lg[1] += xv * ra.y; lg[2] += xv * ra.z; lg[3] += xv * ra.w; lg[4] += xv * rb.x; lg[5] += xv * rb.y; lg[6] += xv * rb.z; lg[7] += xv * rb.w; }
#pragma unroll
            for (int e = 0; e < 8; ++e) lg[e] = wave_sum(lg[e], F.lane);
            int e0 = 0; float l0 = lg[0];
#pragma unroll
            for (int e = 1; e < 8; ++e) if (lg[e] > l0) { l0 = lg[e]; e0 = e; }
            int e1 = -1; float l1 = -INFINITY;
#pragma unroll
            for (int e = 0; e < 8; ++e) if (e != e0 && lg[e] > l1) { l1 = lg[e]; e1 = e; }
            const float w0 = 1.f / (1.f + __expf(l1 - l0)), w1 = 1.f - w0;
            if (F.lane == 0) { toke[2 * m] = e0; toke[2 * m + 1] = e1; tokw[2 * m] = w0; tokw[2 * m + 1] = w1; atomicAdd((int*)&cnt[e0], 1); atomicAdd((int*)&cnt[e1], 1); }
        }
    }
    if (ROUTER) { __syncthreads(); if (F.tid < 8) blkcnt[blockIdx.x * 8 + F.tid] = cnt[F.tid]; }
}

__device__ __forceinline__ void mix_phase(Frame& F, const float* Hx, const float* mu, bf16* XM) {
    f32x4 mu4[6][4];
#pragma unroll
    for (int c = 0; c < 6; ++c)
#pragma unroll
        for (int j = 0; j < 4; ++j) mu4[c][j] = *(const f32x4*)(mu + c * D + 4 * F.lane + 256 * j);
    for (int m = F.gw; m < M; m += F.NGW) {
        const bool first = (m % T) == 0;
#pragma unroll
        for (int j = 0; j < 4; ++j) { const int c0 = 4 * F.lane + 256 * j;
            const f32x4 x = *(const f32x4*)(Hx + (size_t)m * D + c0);
            f32x4 xp = (f32x4){0.f, 0.f, 0.f, 0.f}; if (!first) xp = *(const f32x4*)(Hx + (size_t)(m - 1) * D + c0);
            const f32x4 xx = xp - x;
#pragma unroll
            for (int c = 0; c < 6; ++c) *(u32x2*)(XM + ((size_t)c * M + m) * D + c0) = f32_to_bf4(x + xx * mu4[c][j]); }
    }
}
__device__ __forceinline__ void prep_phase(Frame& F, int l, const bf16* RKV, const float* AA, const bf16* LH, const float* v0, const float* v2, bf16* VF, const float* k_k, const float* k_a, bf16* KP, bf16* AP, bf16* BP, bf16* VP) {
    f32x4 kk4[4], ka4[4];
#pragma unroll
    for (int j = 0; j < 4; ++j) { kk4[j] = *(const f32x4*)(k_k + 4 * F.lane + 256 * j); ka4[j] = *(const f32x4*)(k_a + 4 * F.lane + 256 * j); }
    for (int m = F.gw; m < M; m += F.NGW) {
#pragma unroll
        for (int j = 0; j < 4; ++j) { const size_t o = (size_t)m * D + 4 * F.lane + 256 * j;
            const f32x4 k = bf4_to_f32(*(const u32x2*)(RKV + (size_t)M * D + o)); const u32x2 vraw = *(const u32x2*)(RKV + (size_t)2 * M * D + o); f32x4 v = bf4_to_f32(vraw);
            const f32x4 a = *(const f32x4*)(AA + o);
            f32x4 kk = k * kk4[j]; const float ss = sum16((kk.x * kk.x + kk.y * kk.y) + (kk.z * kk.z + kk.w * kk.w));
            kk = kk * (1.0f / sqrtf(fmaxf(ss, 1e-24f)));
            const f32x4 kp = k * ((a - 1.0f) * ka4[j] + 1.0f);
            if (l == 0) *(u32x2*)(VF + o) = vraw;
            else {
                f32x4 z = *(const f32x4*)(v0 + 4 * F.lane + 256 * j);
                const bf16* lh = LH + (size_t)m * D + 512;
#pragma unroll 8
                for (int q = 0; q < 32; ++q) z += *(const f32x4*)(v2 + (size_t)q * D + 4 * F.lane + 256 * j) * bf2f(lh[q]);
                f32x4 vg; vg.x = 1.f / (1.f + __expf(-z.x)); vg.y = 1.f / (1.f + __expf(-z.y)); vg.z = 1.f / (1.f + __expf(-z.z)); vg.w = 1.f / (1.f + __expf(-z.w));
                const f32x4 vf = bf4_to_f32(*(const u32x2*)(VF + o)); v = v + (vf - v) * vg; }
            *(u32x2*)(KP + o) = f32_to_bf4(kp); *(u32x2*)(VP + o) = f32_to_bf4(v); *(u32x2*)(AP + o) = f32_to_bf4(-kk); *(u32x2*)(BP + o) = f32_to_bf4(kk * a); }
    }
}
__device__ __forceinline__ void post_phase(Frame& F, const bf16* Y, const bf16* R, const bf16* KP, const bf16* VP, const bf16* GG, const float* r_k, const float* gng, const float* gnb, bf16* YG) {
    f32x4 rk4[4], gg4[4], gb4[4];
#pragma unroll
    for (int j = 0; j < 4; ++j) { rk4[j] = *(const f32x4*)(r_k + 4 * F.lane + 256 * j); gg4[j] = *(const f32x4*)(gng + 4 * F.lane + 256 * j); gb4[j] = *(const f32x4*)(gnb + 4 * F.lane + 256 * j); }
    for (int m = F.gw; m < M; m += F.NGW) {
#pragma unroll
        for (int j = 0; j < 4; ++j) { const size_t o = (size_t)m * D + 4 * F.lane + 256 * j;
            const f32x4 y = bf4_to_f32(*(const u32x2*)(Y + o)), r = bf4_to_f32(*(const u32x2*)(R + o)), g = bf4_to_f32(*(const u32x2*)(GG + o));
            const f32x4 kp = bf4_to_f32(*(const u32x2*)(KP + o)), vp = bf4_to_f32(*(const u32x2*)(VP + o));
            const float mean = sum16((y.x + y.y) + (y.z + y.w)) * (1.f / 64.f); const f32x4 d = y - mean;
            const float var = sum16((d.x * d.x + d.y * d.y) + (d.z * d.z + d.w * d.w)) * (1.f / 64.f);
            const f32x4 rkk = r * kp * rk4[j]; const float bon = sum16((rkk.x + rkk.y) + (rkk.z + rkk.w));
            const f32x4 yn = d * (1.0f / sqrtf(var + GN_EPS)) * gg4[j] + gb4[j] + vp * bon;
            *(u32x2*)(YG + o) = f32_to_bf4(yn * g); }
    }
}
__device__ __forceinline__ float fma_s(float a, float b, float c) { float r; asm("v_fma_f32 %0, %1, %2, %3" : "=v"(r) : "v"(a), "v"(b), "v"(c)); return r; }
__device__ __forceinline__ float mul_s(float a, float b) { float r; asm("v_mul_f32_e32 %0, %1, %2" : "=v"(r) : "v"(a), "v"(b)); return r; }
__device__ __forceinline__ float add_s(float a, float b) { float r; asm("v_add_f32_e32 %0, %1, %2" : "=v"(r) : "v"(a), "v"(b)); return r; }
__device__ __forceinline__ float dot4_s(const f32x4& x, const f32x4& y) { return add_s(fma_s(x.y, y.y, mul_s(x.x, y.x)), fma_s(x.w, y.w, mul_s(x.z, y.z))); }
__device__ __forceinline__ f32x4 upd_s(const f32x4& S, const f32x4& w, const f32x4& b, float sa, const f32x4& k, float v) {
    f32x4 r; r.x = fma_s(S.x, w.x, fma_s(b.x, sa, mul_s(k.x, v))); r.y = fma_s(S.y, w.y, fma_s(b.y, sa, mul_s(k.y, v))); r.z = fma_s(S.z, w.z, fma_s(b.z, sa, mul_s(k.z, v))); r.w = fma_s(S.w, w.w, fma_s(b.w, sa, mul_s(k.w, v))); return r; }
__device__ __forceinline__ void scan_phase(Frame& F, const bf16* R, const float* DEC, const bf16* KP, const bf16* AP, const bf16* BP, const bf16* VP, bf16* Y) {
    constexpr int TS = 32, BUFB = 57600, YB_OFF = 2 * BUFB;
    const int head = F.vcu >> 3, part = F.vcu & 7, b = head >> 4, hh = head & 15;
    const size_t rowb = (size_t)b * T; const int col0 = hh * 64;
    const int tr = F.tid >> 4, pc = F.tid & 15;
    const int tr2 = (F.tid & 255) >> 3, pc2 = F.tid & 7;
    const int rr = F.lane >> 4, q = F.lane & 15, myrow = 8 * part + 4 * F.wave + rr;
    LAS unsigned char* L = F.lds + RING_OFF;
    struct Stg { f32x4 lw; u32x2 rk, ra, rb, rv, rn; v4u lr; };
    Stg g0, g1;
#define SC_LOAD(c, G) do { const int t_ = (c) * TS + tr; const size_t g_ = (rowb + t_) * D + col0 + pc * 4; G.lw = *(const f32x4*)(DEC + g_); G.rk = *(const u32x2*)(KP + g_); G.ra = *(const u32x2*)(AP + g_); \
        G.rb = *(const u32x2*)(BP + g_); G.rv = *(const u32x2*)(VP + g_); G.rn = (u32x2){0u, 0u}; if (t_ + 1 < T) G.rn = *(const u32x2*)(AP + g_ + D); \
        if (F.tid < 256) G.lr = *(const v4u*)(R + (rowb + (size_t)(c) * TS + tr2) * D + col0 + pc2 * 8); } while (0)
#define SC_STORE(bf, G) do { const f32x4 lk_ = bf4_to_f32(G.rk), la_ = bf4_to_f32(G.ra), lb_ = bf4_to_f32(G.rb), lv_ = bf4_to_f32(G.rv), ln_ = bf4_to_f32(G.rn); LAS unsigned char* d_ = L + (bf) * BUFB + tr * 256 + pc * 16; *(LAS f32x4*)(d_) = G.lw; *(LAS f32x4*)(d_ + 8192) = lk_; *(LAS f32x4*)(d_ + 16384) = la_; \
        *(LAS f32x4*)(d_ + 24576) = lb_; *(LAS f32x4*)(d_ + 32768) = lv_; *(LAS f32x4*)(d_ + 49152) = G.lw * ln_; \
        { const f32x4 pb_ = lb_ * ln_, pk_ = lk_ * ln_; const float be_ = dpp_sum16((pb_.x + pb_.y) + (pb_.z + pb_.w)), ga_ = dpp_sum16((pk_.x + pk_.y) + (pk_.z + pk_.w)); \
          if (pc == 0) { *(LAS float*)(L + (bf) * BUFB + 57344 + tr * 4) = be_; *(LAS float*)(L + (bf) * BUFB + 57472 + tr * 4) = ga_; } } \
        if (F.tid < 256) { LAS unsigned char* r_ = L + (bf) * BUFB + 40960 + tr2 * 256 + pc2 * 32; \
            *(LAS f32x4*)(r_) = (f32x4){__uint_as_float(G.lr.x << 16), __uint_as_float(G.lr.x & 0xffff0000u), __uint_as_float(G.lr.y << 16), __uint_as_float(G.lr.y & 0xffff0000u)}; \
            *(LAS f32x4*)(r_ + 16) = (f32x4){__uint_as_float(G.lr.z << 16), __uint_as_float(G.lr.z & 0xffff0000u), __uint_as_float(G.lr.w << 16), __uint_as_float(G.lr.w & 0xffff0000u)}; } } while (0)
    SC_LOAD(0, g0); SC_STORE(0, g0); SC_LOAD(1, g0); __syncthreads();
    f32x4 S = (f32x4){0.f, 0.f, 0.f, 0.f};
    constexpr int NCH = T / TS;
    for (int c2 = 0; c2 < NCH; c2 += 2) {
#pragma unroll
      for (int par = 0; par < 2; ++par) {
        const int c = c2 + par, bf = par;
        if (c + 2 < NCH) { if (par == 0) SC_LOAD(c + 2, g1); else SC_LOAD(c + 2, g0); }
        if (F.wave < 2) {
            const LAS unsigned char* B0 = L + bf * BUFB + q * 16; const LAS unsigned char* Bv = L + bf * BUFB + 32768 + myrow * 4; const LAS unsigned char* Bs = L + bf * BUFB + 57344;
            LAS unsigned short* yb = (LAS unsigned short*)(L + YB_OFF + bf * 512) + q * 8 + 4 * F.wave + rr;
            struct Rnd { f32x4 a, aw, w0, b0, k0, r0, w1, b1, k1, r1; float v0, v1, be, ga; };
#define SC_FETCH(t_, X) do { X.a = *(const LAS f32x4*)(B0 + 16384 + (t_) * 256); X.aw = *(const LAS f32x4*)(B0 + 49152 + (t_) * 256); \
            X.w0 = *(const LAS f32x4*)(B0 + (t_) * 256); X.b0 = *(const LAS f32x4*)(B0 + 24576 + (t_) * 256); X.k0 = *(const LAS f32x4*)(B0 + 8192 + (t_) * 256); X.r0 = *(const LAS f32x4*)(B0 + 40960 + (t_) * 256); \
            X.w1 = *(const LAS f32x4*)(B0 + ((t_) + 1) * 256); X.b1 = *(const LAS f32x4*)(B0 + 24576 + ((t_) + 1) * 256); X.k1 = *(const LAS f32x4*)(B0 + 8192 + ((t_) + 1) * 256); X.r1 = *(const LAS f32x4*)(B0 + 40960 + ((t_) + 1) * 256); \
            X.v0 = *(const LAS float*)(Bv + (t_) * 256); X.v1 = *(const LAS float*)(Bv + ((t_) + 1) * 256); X.be = *(const LAS float*)(Bs + (t_) * 4); X.ga = *(const LAS float*)(Bs + 128 + (t_) * 4); } while (0)
            Rnd cu; float ykeep = 0.f, yra = 0.f, yrb = 0.f;
#define RED_STEP(x, ctl) asm volatile("v_add_f32_dpp %0, %0, %0 " ctl " row_mask:0xf bank_mask:0xf bound_ctrl:1" : "+v"(x))
#define RED_STEP0(x, ctl) asm volatile("s_nop 1\n\tv_add_f32_dpp %0, %0, %0 " ctl " row_mask:0xf bank_mask:0xf bound_ctrl:1" : "+v"(x))
#define RED4(a_, b_, c_, d_) do { \
            RED_STEP0(a_, "quad_perm:[1,0,3,2]"); RED_STEP0(b_, "quad_perm:[1,0,3,2]"); RED_STEP0(c_, "quad_perm:[1,0,3,2]"); RED_STEP0(d_, "quad_perm:[1,0,3,2]"); \
            RED_STEP(a_, "quad_perm:[2,3,0,1]"); RED_STEP(b_, "quad_perm:[2,3,0,1]"); RED_STEP(c_, "quad_perm:[2,3,0,1]"); RED_STEP(d_, "quad_perm:[2,3,0,1]"); \
            RED_STEP(a_, "row_half_mirror"); RED_STEP(b_, "row_half_mirror"); RED_STEP(c_, "row_half_mirror"); RED_STEP(d_, "row_half_mirror"); \
            RED_STEP(a_, "row_mirror"); RED_STEP(b_, "row_mirror"); RED_STEP(c_, "row_mirror"); RED_STEP(d_, "row_mirror"); } while (0)
            SC_FETCH(0, cu);
#pragma unroll
            for (int t = 0; t < TS; t += 2) {
                Rnd nx = cu;
                if (t + 2 < TS) SC_FETCH(t + 2, nx);
                const f32x4 p1 = S * cu.a, p2 = S * cu.aw;
                float u1 = (p1.x + p1.y) + (p1.z + p1.w), u2 = (p2.x + p2.y) + (p2.z + p2.w);
                RED4(u1, u2, yra, yrb);
                if (t > 0) { ykeep = (q == ((t - 2) & 15)) ? yra : ykeep; ykeep = (q == ((t - 1) & 15)) ? yrb : ykeep;
                             if (((t - 1) & 15) == 15) yb[(t - 16) * 8] = (unsigned short)f2bf(ykeep); }
                const float sa0 = u1, sa1 = u2 + sa0 * cu.be + cu.v0 * cu.ga;
                S = S * cu.w0 + (cu.b0 * sa0 + cu.k0 * cu.v0);
                const f32x4 y4a = S * cu.r0;
                S = S * cu.w1 + (cu.b1 * sa1 + cu.k1 * cu.v1);
                const f32x4 y4b = S * cu.r1;
                yra = (y4a.x + y4a.y) + (y4a.z + y4a.w); yrb = (y4b.x + y4b.y) + (y4b.z + y4b.w);
                cu = nx;
            }
            { float d0_ = 0.f, d1_ = 0.f; RED4(yra, yrb, d0_, d1_);
              ykeep = (q == 14) ? yra : ykeep; ykeep = (q == 15) ? yrb : ykeep; yb[16 * 8] = (unsigned short)f2bf(ykeep); }
#undef RED4
#undef RED_STEP0
#undef RED_STEP
#undef SC_FETCH
        }
        if (c + 1 < NCH) { if (par == 0) SC_STORE(1, g0); else SC_STORE(0, g1); }
        __syncthreads();
        if (F.tid < 32) { const v4u yv = *(const LAS v4u*)(L + YB_OFF + bf * 512 + F.tid * 16);
            *(v4u*)(Y + (rowb + (size_t)c * TS + F.tid) * D + col0 + part * 8) = yv; }
      }
    }
#undef SC_LOAD
#undef SC_STORE
}

__device__ __forceinline__ void kmean_phase(Frame& F, const bf16* Kb, float* KM) {
    LAS float* red = (LAS float*)(F.lds + RING_OFF);
    for (int u = blockIdx.x; u < 2 * 32 * 4; u += F.G) {
        const int qc = u & 3, blk = (u >> 2) & 31, b = u >> 7; const int c = F.tid & 255, rh = F.tid >> 8;
        const bf16* p = Kb + ((size_t)b * T + blk * 256 + rh * 128) * D + qc * 256 + c; float s = 0.f;
#pragma unroll 8
        for (int r = 0; r < 128; ++r) s += bf2f(p[(size_t)r * D]);
        if (rh == 1) red[c] = s;
        __syncthreads();
        if (rh == 0) { const int col = qc * 256 + c; KM[(((size_t)b * H + (col >> 6)) * 32 + blk) * 64 + (col & 63)] = (s + red[c]) * (1.f / 256.f); }
        __syncthreads();
    }
}
__device__ __forceinline__ void gate_phase(Frame& F, const bf16* Q, const float* KM, unsigned* SEL) {
    LAS float* km = (LAS float*)(F.lds + RING_OFF);
    for (int u = blockIdx.x; u < M / 64; u += F.G) {
        const int m0 = u * 64, b = m0 / T, own = (m0 % T) >> 8;
        for (int i = F.tid; i < 16 * 32 * 16; i += NWAVES * 64) *(LAS f32x4*)(km + 4 * i) = *(const f32x4*)(KM + (size_t)b * 16 * 32 * 64 + 4 * i);
        __syncthreads();
        const int m = m0 + F.lane;
#pragma unroll 1
        for (int hi = 0; hi < 2; ++hi) { const int h = 2 * F.wave + hi;
            float qv[64];
#pragma unroll
            for (int i = 0; i < 8; ++i) { const v4u w = *(const v4u*)(Q + (size_t)m * D + h * 64 + 8 * i);
                qv[8 * i + 0] = __uint_as_float(w.x << 16); qv[8 * i + 1] = __uint_as_float(w.x & 0xffff0000u); qv[8 * i + 2] = __uint_as_float(w.y << 16); qv[8 * i + 3] = __uint_as_float(w.y & 0xffff0000u);
                qv[8 * i + 4] = __uint_as_float(w.z << 16); qv[8 * i + 5] = __uint_as_float(w.z & 0xffff0000u); qv[8 * i + 6] = __uint_as_float(w.w << 16); qv[8 * i + 7] = __uint_as_float(w.w & 0xffff0000u); }
            float v0 = -INFINITY, v1 = -INFINITY, v2 = -INFINITY; int i0 = -1, i1 = -1, i2 = -1;
            for (int j = 0; j < own; ++j) { const LAS f32x4* kp = (const LAS f32x4*)(km + (h * 32 + j) * 64); float s = 0.f;
#pragma unroll
                for (int i = 0; i < 16; ++i) { const f32x4 kv = kp[i]; s += qv[4 * i] * kv.x + qv[4 * i + 1] * kv.y + qv[4 * i + 2] * kv.z + qv[4 * i + 3] * kv.w; }
                if (s > v0) { v2 = v1; i2 = i1; v1 = v0; i1 = i0; v0 = s; i0 = j; } else if (s > v1) { v2 = v1; i2 = i1; v1 = s; i1 = j; } else if (s > v2) { v2 = s; i2 = j; } }
            unsigned mask = 0u; if (i0 >= 0) mask |= 1u << i0; if (i1 >= 0) mask |= 1u << i1; if (i2 >= 0) mask |= 1u << i2;
            SEL[((size_t)b * H + h) * T + (m % T)] = mask; }
        __syncthreads();
    }
}

__device__ __forceinline__ void moe_prefix(Frame& F, const int* blkcnt, LAS int* pre_mine  ) {
    LAS int* tmp = (LAS int*)(F.lds + RING_OFF);
    for (int i = F.tid; i < F.G * 8; i += NWAVES * 64) tmp[i] = blkcnt[i];
    __syncthreads();
    if (F.tid < 8) { int tot = 0, mine = 0; for (int g = 0; g < F.G; ++g) { if (g == (int)blockIdx.x) mine = tot; tot += tmp[g * 8 + F.tid]; }
        pre_mine[F.tid] = mine; pre_mine[8 + F.tid] = tot; }
    __syncthreads();
    if (F.tid == 0) { int p = 0; for (int e = 0; e < 8; ++e) { F.MISC[16 + e] = (unsigned)p; p += (pre_mine[8 + e] + 255) >> 8; } F.MISC[24] = (unsigned)p; }
    __syncthreads();
}
__device__ __forceinline__ void moe_gather_phase(Frame& F, const int* blkcnt, const int* toke, const float* tokw, int* tokr, float* gw, const float* Hs, unsigned char* XG) {
    LAS int* pm = (LAS int*)(F.lds + RING_OFF + 16384);
    LAS int* rows = (LAS int*)(F.lds + RING_OFF + 16384 + 64);
    moe_prefix(F, blkcnt, pm);
    const int rpb = M / F.G;
    if (F.wave == 0) {
        const int m = blockIdx.x * rpb + F.lane; const bool ok = F.lane < rpb;
        const int e0 = ok ? toke[2 * m] : -1, e1 = ok ? toke[2 * m + 1] : -1;
        int r0 = 0, r1 = 0;
        for (int e = 0; e < 8; ++e) { const unsigned long long b0 = __ballot(e0 == e), b1 = __ballot(e1 == e); const unsigned long long lt = (1ull << F.lane) - 1ull;
            const int base = (int)F.MISC[16 + e] * 256 + pm[e];
            if (e0 == e) r0 = base + __popcll(b0 & lt);
            if (e1 == e) r1 = base + __popcll(b0) + __popcll(b1 & lt); }
        if (ok) { tokr[2 * m] = r0; tokr[2 * m + 1] = r1; gw[r0] = tokw[2 * m]; gw[r1] = tokw[2 * m + 1]; rows[2 * F.lane] = r0; rows[2 * F.lane + 1] = r1; }
    }
    __syncthreads();
    for (int i = F.wave; i < 2 * rpb; i += NWAVES) { const int m = blockIdx.x * rpb + (i >> 1), r = rows[i];
        const f32x4* s = (const f32x4*)(Hs + (size_t)m * D + 16 * F.lane); const f32x4 a = s[0], b_ = s[1], c = s[2], d = s[3];
        v4u o; int w;
        w = __builtin_amdgcn_cvt_pk_fp8_f32(a.x, a.y, 0, false); w = __builtin_amdgcn_cvt_pk_fp8_f32(a.z, a.w, w, true); o.x = (unsigned)w;
        w = __builtin_amdgcn_cvt_pk_fp8_f32(b_.x, b_.y, 0, false); w = __builtin_amdgcn_cvt_pk_fp8_f32(b_.z, b_.w, w, true); o.y = (unsigned)w;
        w = __builtin_amdgcn_cvt_pk_fp8_f32(c.x, c.y, 0, false); w = __builtin_amdgcn_cvt_pk_fp8_f32(c.z, c.w, w, true); o.z = (unsigned)w;
        w = __builtin_amdgcn_cvt_pk_fp8_f32(d.x, d.y, 0, false); w = __builtin_amdgcn_cvt_pk_fp8_f32(d.z, d.w, w, true); o.w = (unsigned)w;
        *(v4u*)(XG + (size_t)r * D + 16 * F.lane) = o; }
    __syncthreads();
}
__device__ __forceinline__ void attn_direct_phase(Frame& F, const bf16* Q, const bf16* Kb, const bf16* Vb, const unsigned* SEL, bf16* O) {
    for (int u = F.gw; u < (M / 64) * H; u += F.NGW) {
        const int h = u & 15, m0 = (u >> 4) * 64, b = m0 / T, t0 = m0 % T, own = t0 >> 8, m = m0 + F.lane, tpos = t0 + F.lane;
        float q[64], o[64];
#pragma unroll
        for (int i = 0; i < 8; ++i) { const v4u w = *(const v4u*)(Q + (size_t)m * D + h * 64 + 8 * i);
            q[8 * i + 0] = __uint_as_float(w.x << 16); q[8 * i + 1] = __uint_as_float(w.x & 0xffff0000u); q[8 * i + 2] = __uint_as_float(w.y << 16); q[8 * i + 3] = __uint_as_float(w.y & 0xffff0000u);
            q[8 * i + 4] = __uint_as_float(w.z << 16); q[8 * i + 5] = __uint_as_float(w.z & 0xffff0000u); q[8 * i + 6] = __uint_as_float(w.w << 16); q[8 * i + 7] = __uint_as_float(w.w & 0xffff0000u); }
#pragma unroll
        for (int i = 0; i < 64; ++i) o[i] = 0.f;
        const unsigned sel = SEL[((size_t)b * H + h) * T + tpos];
        float mrun = -INFINITY, l = 0.f;
        for (int j = 0; j <= own; ++j) {
            const bool pastsel = (sel >> j) & 1u;
            if (j < own && !__any(pastsel)) continue;
            const int nk = (j < own) ? 256 : (t0 & 255) + 64;
            for (int kk = 0; kk < nk; ++kk) {
                const int kpos = j * 256 + kk; const size_t ro = ((size_t)b * T + kpos) * D + h * 64;
                float s = 0.f;
#pragma unroll
                for (int i = 0; i < 8; ++i) { const v4u w = *(const v4u*)(Kb + ro + 8 * i);
                    s += q[8 * i + 0] * __uint_as_float(w.x << 16) + q[8 * i + 1] * __uint_as_float(w.x & 0xffff0000u) + q[8 * i + 2] * __uint_as_float(w.y << 16) + q[8 * i + 3] * __uint_as_float(w.y & 0xffff0000u)
                       + q[8 * i + 4] * __uint_as_float(w.z << 16) + q[8 * i + 5] * __uint_as_float(w.z & 0xffff0000u) + q[8 * i + 6] * __uint_as_float(w.w << 16) + q[8 * i + 7] * __uint_as_float(w.w & 0xffff0000u); }
                const bool act = (j < own) ? pastsel : (kpos <= tpos);
                if (act) {
                    if (s > mrun) { const float c = exp2f(mrun - s); l *= c;
#pragma unroll
                        for (int i = 0; i < 64; ++i) o[i] *= c;
                        mrun = s; }
                    const float p = exp2f(s - mrun); l += p;
#pragma unroll
                    for (int i = 0; i < 8; ++i) { const v4u w = *(const v4u*)(Vb + ro + 8 * i);
                        o[8 * i + 0] += p * __uint_as_float(w.x << 16); o[8 * i + 1] += p * __uint_as_float(w.x & 0xffff0000u); o[8 * i + 2] += p * __uint_as_float(w.y << 16); o[8 * i + 3] += p * __uint_as_float(w.y & 0xffff0000u);
                        o[8 * i + 4] += p * __uint_as_float(w.z << 16); o[8 * i + 5] += p * __uint_as_float(w.z & 0xffff0000u); o[8 * i + 6] += p * __uint_as_float(w.w << 16); o[8 * i + 7] += p * __uint_as_float(w.w & 0xffff0000u); }
                }
            }
        }
        const float rl = 1.0f / l;
#pragma unroll
        for (int i = 0; i < 8; ++i) { v4u w; w.x = pk2(o[8 * i] * rl, o[8 * i + 1] * rl); w.y = pk2(o[8 * i + 2] * rl, o[8 * i + 3] * rl); w.z = pk2(o[8 * i + 4] * rl, o[8 * i + 5] * rl); w.w = pk2(o[8 * i + 6] * rl, o[8 * i + 7] * rl);
            *(v4u*)(O + (size_t)m * D + h * 64 + 8 * i) = w; }
    }
}
namespace moba {
using attn_body::f32x16; using attn_body::crow;
constexpr int L_K = 0, L_V = 32768, L_LIST = 65536, L_WS = 81920, L_CTL = 84992;
__device__ __forceinline__ void qkt_l(f32x16& p0, f32x16& p1, const LAS unsigned char* Kslot, const bf16x8* qr, int r32, int hi) {
    const LAS unsigned char* kb = Kslot + hi * 1024 + r32 * 16;
#pragma unroll
    for (int d0 = 0; d0 < 4; ++d0) {
        const bf16x8 b0 = *(const LAS bf16x8*)(kb + d0 * 2048), b1 = *(const LAS bf16x8*)(kb + d0 * 2048 + 512);
        if (d0 == 0) { p0 = __builtin_amdgcn_mfma_f32_32x32x16_bf16(b0, qr[0], f32x16{}, 0, 0, 0); p1 = __builtin_amdgcn_mfma_f32_32x32x16_bf16(b1, qr[0], f32x16{}, 0, 0, 0); }
        else { p0 = __builtin_amdgcn_mfma_f32_32x32x16_bf16(b0, qr[d0], p0, 0, 0, 0); p1 = __builtin_amdgcn_mfma_f32_32x32x16_bf16(b1, qr[d0], p1, 0, 0, 0); } }
}
__device__ __forceinline__ float half_max(float v) { auto rr = __builtin_amdgcn_permlane32_swap(__float_as_uint(v), __float_as_uint(v), false, false); return fmaxf(__uint_as_float(rr[0]), __uint_as_float(rr[1])); }
__device__ __forceinline__ float half_sum(float v) { auto rr = __builtin_amdgcn_permlane32_swap(__float_as_uint(v), __float_as_uint(v), false, false); return __uint_as_float(rr[0]) + __uint_as_float(rr[1]); }
}
__device__ __forceinline__ void moba_attn_phase(Frame& F, const bf16* Q, const bf16* Kb, const bf16* Vb, const unsigned* SELT, bf16* PO, float* ML, gu32* qctr) {
    using namespace moba;
    const int lane = F.lane, wid = F.wave, r32 = lane & 31, hi = lane >> 5;
    LAS unsigned char* L = F.lds + RING_OFF;
    LAS unsigned short* list = (LAS unsigned short*)(L + L_LIST);
    LAS float* wsf = (LAS float*)(L + L_WS + wid * 256); LAS int* wsd = (LAS int*)(L + L_WS + wid * 256 + 128);
    LAS int* ctl = (LAS int*)(L + L_CTL);
    const int vb0 = RING_OFF + L_V + ((lane >> 4) & 1) * 32 + (lane & 3) * 8 + (4 * hi + ((lane & 15) >> 2)) * 64;
    for (;;) {
        __syncthreads();
        if (F.tid == 0) { ctl[0] = (int)__hip_atomic_fetch_add(qctr, 1u, __ATOMIC_RELAXED, __HIP_MEMORY_SCOPE_AGENT); ctl[1] = 0; }
        __syncthreads();
        const int u = __builtin_amdgcn_readfirstlane(ctl[0]);
        if (u >= 32 * 32) break;
        const int j = u >> 5, bh = u & 31, b = bh >> 4, h = bh & 15;
        const size_t rowb = (size_t)b * T;
        { const bf16* ksrc = Kb + (rowb + 256 * j + lane) * D + h * 64 + wid * 8;
          const bf16* vsrc = Vb + (rowb + 256 * j + 16 * (wid & 3) + (lane >> 2)) * D + h * 64 + (wid >> 2) * 32 + (lane & 3) * 8;
#pragma unroll
          for (int kt = 0; kt < 4; ++kt) { attn_body::glds16(ksrc + (size_t)kt * 64 * D, (unsigned)__builtin_amdgcn_readfirstlane(RING_OFF + L_K + kt * 8192 + wid * 1024));
                                           attn_body::glds16(vsrc + (size_t)kt * 64 * D, (unsigned)__builtin_amdgcn_readfirstlane(RING_OFF + L_V + kt * 8192 + wid * 1024)); } }
        const unsigned* selrow = SELT + (size_t)bh * T;
        for (int t0 = 256 * (j + 1); t0 < T; t0 += NWAVES * 64) { const int t = t0 + F.tid; const bool in = t < T;
            const bool p = in && ((selrow[in ? t : 0] >> j) & 1u);
            const unsigned long long bal = __ballot(p); const int np = __popcll(bal);
            int base = 0; if (lane == 0 && np) base = __hip_atomic_fetch_add(&ctl[1], np, __ATOMIC_RELAXED, __HIP_MEMORY_SCOPE_WORKGROUP);
            base = __builtin_amdgcn_readfirstlane(base);
            if (p) list[base + __popcll(bal & ((1ull << lane) - 1ull))] = (unsigned short)t; }
        asm volatile("s_waitcnt vmcnt(0) lgkmcnt(0)" ::: "memory");
        __syncthreads();
        const int total = 256 + ctl[1], nb = (total + 31) >> 5;
        for (int bi = wid; bi < nb; bi += NWAVES) {
            const int item = bi * 32 + r32; const bool valid = item < total; const int it2 = valid ? item : total - 1;
            const bool ownb = bi < 8;
            const int t = it2 < 256 ? 256 * j + it2 : (int)list[it2 - 256];
            const bf16* qrow = Q + (rowb + t) * D + h * 64;
            bf16x8 qr[4];
#pragma unroll
            for (int d0 = 0; d0 < 4; ++d0) qr[d0] = *(const bf16x8*)(qrow + d0 * 16 + hi * 8);
            f32x16 P[4][2];
#pragma unroll
            for (int kt = 0; kt < 4; ++kt) qkt_l(P[kt][0], P[kt][1], L + L_K + kt * 8192, qr, r32, hi);
            if (ownb) {
#pragma unroll
                for (int kt = 0; kt < 4; ++kt) attn_body::cmask(P[kt][0], P[kt][1], kt, t - 256 * j, hi); }
            float mx = -INFINITY;
#pragma unroll
            for (int kt = 0; kt < 4; ++kt)
#pragma unroll
                for (int r = 0; r < 16; ++r) mx = fmaxf(mx, fmaxf(P[kt][0][r], P[kt][1][r]));
            mx = half_max(mx);
            float ls = 0.f;
#pragma unroll
            for (int kt = 0; kt < 4; ++kt)
#pragma unroll
                for (int r = 0; r < 16; ++r) { P[kt][0][r] = __builtin_amdgcn_exp2f(P[kt][0][r] - mx); P[kt][1][r] = __builtin_amdgcn_exp2f(P[kt][1][r] - mx); ls += P[kt][0][r] + P[kt][1][r]; }
            ls = half_sum(ls);
            f32x16 o[2]; o[0] = f32x16{}; o[1] = f32x16{};
#pragma unroll
            for (int kt = 0; kt < 4; ++kt) {
                attn_body::u32x4 w0, w1, w2, w3;
#define PKW_(P_, B_) attn_body::cvtpk_s(P_[B_], P_[B_ + 1])
                w0 = (attn_body::u32x4){PKW_(P[kt][0], 0), PKW_(P[kt][0], 2), PKW_(P[kt][0], 4), PKW_(P[kt][0], 6)}; w1 = (attn_body::u32x4){PKW_(P[kt][0], 8), PKW_(P[kt][0], 10), PKW_(P[kt][0], 12), PKW_(P[kt][0], 14)};
                w2 = (attn_body::u32x4){PKW_(P[kt][1], 0), PKW_(P[kt][1], 2), PKW_(P[kt][1], 4), PKW_(P[kt][1], 6)}; w3 = (attn_body::u32x4){PKW_(P[kt][1], 8), PKW_(P[kt][1], 10), PKW_(P[kt][1], 12), PKW_(P[kt][1], 14)};
#undef PKW_
                attn_body::pv(o, vb0 + kt * 8192, __builtin_bit_cast(bf16x8, w0), __builtin_bit_cast(bf16x8, w1), __builtin_bit_cast(bf16x8, w2), __builtin_bit_cast(bf16x8, w3)); }
            const unsigned sel = selrow[t];
            const int slot = ownb ? 3 : __popc(sel & ((1u << j) - 1u));
            const int dest = (int)(((rowb + t) * H + h) * 4 + slot);
            if (hi == 0) { wsf[r32] = 1.0f / ls; wsd[r32] = valid ? dest : -1; if (valid) { ML[(size_t)dest * 2] = mx; ML[(size_t)dest * 2 + 1] = ls; } }
            asm volatile("s_waitcnt lgkmcnt(0)" ::: "memory");
#pragma unroll
            for (int r = 0; r < 16; ++r) { const int row = crow(r, hi); const float rl = wsf[row]; const int d = wsd[row];
                if (d >= 0) { PO[(size_t)d * 64 + r32] = (bf16)f2bf(o[0][r] * rl); PO[(size_t)d * 64 + 32 + r32] = (bf16)f2bf(o[1][r] * rl); } }
            asm volatile("s_waitcnt lgkmcnt(0)" ::: "memory");
        }
    }
}
__device__ __forceinline__ void moba_combine_phase(Frame& F, const unsigned* SELT, const bf16* PO, const float* ML, bf16* O) {
    for (int m = F.gw; m < M; m += F.NGW) {
        const int b = m / T, t = m % T, h = F.lane >> 2, qd = F.lane & 3;
        const unsigned sel = SELT[((size_t)b * H + h) * T + t]; const int cnt = __popc(sel);
        const size_t base = ((size_t)m * H + h) * 4;
        float ms[4], ls[4]; float mstar = -INFINITY;
#pragma unroll
        for (int s = 0; s < 4; ++s) { const bool on = (s == 3) || (s < cnt); ms[s] = on ? ML[(base + s) * 2] : -INFINITY; ls[s] = on ? ML[(base + s) * 2 + 1] : 0.f; mstar = fmaxf(mstar, ms[s]); }
        float wsum = 0.f, w[4];
#pragma unroll
        for (int s = 0; s < 4; ++s) { w[s] = ls[s] * __builtin_amdgcn_exp2f(ms[s] - mstar); wsum += w[s]; }
        const float rw = 1.0f / wsum;
        float acc[16];
#pragma unroll
        for (int i = 0; i < 16; ++i) acc[i] = 0.f;
#pragma unroll
        for (int s = 0; s < 4; ++s) { const bool on = (s == 3) || (s < cnt);
            if (on) { const float ws_ = w[s] * rw; const v4u a = *(const v4u*)(PO + (base + s) * 64 + qd * 16), c = *(const v4u*)(PO + (base + s) * 64 + qd * 16 + 8);
                const unsigned wv[8] = {a.x, a.y, a.z, a.w, c.x, c.y, c.z, c.w};
#pragma unroll
                for (int i = 0; i < 8; ++i) { acc[2 * i] += ws_ * __uint_as_float(wv[i] << 16); acc[2 * i + 1] += ws_ * __uint_as_float(wv[i] & 0xffff0000u); } } }
        v4u o0, o1; o0.x = pk2(acc[0], acc[1]); o0.y = pk2(acc[2], acc[3]); o0.z = pk2(acc[4], acc[5]); o0.w = pk2(acc[6], acc[7]); o1.x = pk2(acc[8], acc[9]); o1.y = pk2(acc[10], acc[11]); o1.z = pk2(acc[12], acc[13]); o1.w = pk2(acc[14], acc[15]);
        *(v4u*)(O + (size_t)m * D + h * 64 + qd * 16) = o0; *(v4u*)(O + (size_t)m * D + h * 64 + qd * 16 + 8) = o1;
    }
}
constexpr int WK_REC = 10496;
__device__ __forceinline__ void wkv_build_phase(Frame& F, const bf16* R, const float* DEC, const bf16* KP, const bf16* AP, const bf16* BP, unsigned char* REC0, unsigned char* REC1) {
    LAS unsigned char* L = F.lds + RING_OFF + F.wave * 16384;
    LAS unsigned short* tA = (LAS unsigned short*)L; LAS unsigned short* tB = tA + 1024; LAS unsigned short* tK = tA + 2048; LAS unsigned short* tR = tA + 3072;
    LAS float* fLab = (LAS float*)(L + 8192); LAS float* fLak = fLab + 256; LAS float* fT = fLab + 512;
    const int lane = F.lane, c = lane & 15, g = lane >> 4;
    for (int u = F.gw; u < 2 * H * 512; u += F.NGW) {
        const int ch = u & 511, bh = u >> 9, b = bh >> 4, h = bh & 15;
        unsigned char* rec = (b ? REC1 : REC0) + ((size_t)h * 512 + ch) * WK_REC;
        const size_t base = ((size_t)b * T + (size_t)ch * 16) * D + h * 64 + lane;
        float Af[16], Bf[16], Kf[16], Rf[16]; float gm = 1.f;
#pragma unroll
        for (int t = 0; t < 16; ++t) { const size_t o = base + (size_t)t * D;
            const float w = DEC[o], kp = bf2f(KP[o]), ap = bf2f(AP[o]), bp = bf2f(BP[o]), rr = bf2f(R[o]);
            Af[t] = ap * gm; gm *= w; const float inv = 1.0f / gm; Bf[t] = bp * inv; Kf[t] = kp * inv; Rf[t] = rr * gm;
            tA[t * 64 + lane] = (unsigned short)f2bf(Af[t]); tB[t * 64 + lane] = (unsigned short)f2bf(Bf[t]); tK[t * 64 + lane] = (unsigned short)f2bf(Kf[t]); tR[t * 64 + lane] = (unsigned short)f2bf(Rf[t]); }
        *(float*)(rec + 10240 + lane * 4) = gm;
#pragma unroll
        for (int gq = 0; gq < 4; ++gq) { v4u o; o.x = pk2(Bf[4 * gq], Bf[4 * gq + 1]); o.y = pk2(Bf[4 * gq + 2], Bf[4 * gq + 3]); o.z = pk2(Kf[4 * gq], Kf[4 * gq + 1]); o.w = pk2(Kf[4 * gq + 2], Kf[4 * gq + 3]);
            *(v4u*)(rec + 6144 + lane * 64 + gq * 16) = o; }
        LDS_WAIT(); asm volatile("" ::: "memory");
        pg8::f32x4 lab = {0.f, 0.f, 0.f, 0.f}, lak = lab, mrb = lab, mrk = lab;
#pragma unroll
        for (int s = 0; s < 2; ++s) { const int o = c * 64 + 8 * g + 32 * s;
            const bf16x8 fa = *(const LAS bf16x8*)(tA + o), fb = *(const LAS bf16x8*)(tB + o), fk = *(const LAS bf16x8*)(tK + o), fr = *(const LAS bf16x8*)(tR + o);
            lab = __builtin_amdgcn_mfma_f32_16x16x32_bf16(fa, fb, lab, 0, 0, 0); lak = __builtin_amdgcn_mfma_f32_16x16x32_bf16(fa, fk, lak, 0, 0, 0);
            mrb = __builtin_amdgcn_mfma_f32_16x16x32_bf16(fr, fb, mrb, 0, 0, 0); mrk = __builtin_amdgcn_mfma_f32_16x16x32_bf16(fr, fk, mrk, 0, 0, 0); }
#pragma unroll
        for (int r = 0; r < 4; ++r) { const int t = 4 * g + r; if (!(c < t)) { lab[r] = 0.f; lak[r] = 0.f; } if (!(c <= t)) { mrb[r] = 0.f; mrk[r] = 0.f; }
            fLab[t * 16 + c] = lab[r]; fLak[t * 16 + c] = lak[r]; }
        LDS_WAIT(); asm volatile("" ::: "memory");
        float Tc[16];
#pragma unroll
        for (int i = 0; i < 16; ++i) { float a_ = (i == c) ? 1.f : 0.f;
#pragma unroll
            for (int j = 0; j < i; ++j) a_ += fLab[i * 16 + j] * Tc[j];
            Tc[i] = a_; }
        if (g == 0) {
#pragma unroll
            for (int i = 0; i < 16; ++i) fT[i * 16 + c] = Tc[i]; }
        LDS_WAIT(); asm volatile("" ::: "memory");
        { const int kt = lane >> 4, gq = (lane >> 2) & 3, jj = lane & 3, slot = (kt >> 1) * 1024 + gq * 16 + (jj + 4 * (kt & 1)) * 2;
#pragma unroll
          for (int t = 0; t < 16; ++t) { float w_ = 0.f;
#pragma unroll
              for (int j = 0; j <= t; ++j) w_ += fT[t * 16 + j] * Af[j];
              *(unsigned short*)(rec + slot + t * 64) = (unsigned short)f2bf(w_); *(unsigned short*)(rec + 3072 + slot + t * 64) = (unsigned short)f2bf(Rf[t]); } }
        { const int gq = c >> 2, jq = c & 3;
#pragma unroll
          for (int r = 0; r < 4; ++r) { const int t = 4 * g + r; float tl = 0.f;
#pragma unroll
              for (int j = 0; j < 16; ++j) tl += fT[t * 16 + j] * fLak[j * 16 + c];
              unsigned char* p = rec + 2048 + t * 64 + gq * 16;
              *(unsigned short*)(p + jq * 2) = (unsigned short)f2bf(tl); *(unsigned short*)(p + 8 + jq * 2) = 0;
              *(unsigned short*)(p + 3072 + jq * 2) = (unsigned short)f2bf(mrb[r]); *(unsigned short*)(p + 3072 + 8 + jq * 2) = (unsigned short)f2bf(mrk[r]); } }
        LDS_WAIT(); asm volatile("" ::: "memory");
    }
}
__device__ __forceinline__ void wkv_chain_phase(Frame& F, const unsigned char* REC0, const unsigned char* REC1, const bf16* VP, bf16* Y) {
    if (F.vcu >= 32) return;
    constexpr int GC = 4, GB = GC * WK_REC  , VBOFF = GB, BUFB = GB + 8192  , YB_OFF = 2 * BUFB, NG = 512 / GC;
    const int b = F.vcu >> 4, h = F.vcu & 15, lane = F.lane, c = lane & 15, g = lane >> 4, vt = F.wave;
    const unsigned char* rbase = (b ? REC1 : REC0) + (size_t)h * 512 * WK_REC; const size_t rowb = (size_t)b * T;
    LAS unsigned char* L = F.lds + RING_OFF;
    constexpr int NP = (GB / 16 + 511) / 512;
    struct Stg { v4u p[NP]; v4u v; };
    Stg g0, g1;
#define WK_LOAD(gi, G) do { const unsigned char* s_ = rbase + (size_t)(gi) * GB; _Pragma("unroll") for (int i = 0; i < NP; ++i) { const int o_ = (F.tid + i * 512) * 16; if (o_ < GB) G.p[i] = *(const v4u*)(s_ + o_); } \
        G.v = *(const v4u*)(VP + (rowb + (size_t)(gi) * 64 + (F.tid >> 3)) * D + h * 64 + (F.tid & 7) * 8); } while (0)
#define WK_STORE(bf, G) do { _Pragma("unroll") for (int i = 0; i < NP; ++i) { const int o_ = (F.tid + i * 512) * 16; if (o_ < GB) *(LAS v4u*)(L + (bf) * BUFB + o_) = G.p[i]; } \
        { const int t_ = F.tid >> 3, v0_ = (F.tid & 7) * 8; LAS unsigned short* d_ = (LAS unsigned short*)(L + (bf) * BUFB + VBOFF) + ((((t_ >> 4) * 4) * 4 + ((t_ >> 2) & 3)) * 16) * 4 + (t_ & 3); \
          const unsigned w_[4] = {G.v.x, G.v.y, G.v.z, G.v.w}; \
          _Pragma("unroll") for (int e = 0; e < 8; ++e) { const int v_ = v0_ + e; d_[((v_ >> 4) * 64 + (v_ & 15)) * 4] = (unsigned short)((e & 1) ? (w_[e >> 1] >> 16) : (w_[e >> 1] & 0xffffu)); } } } while (0)
    WK_LOAD(0, g0); WK_STORE(0, g0); WK_LOAD(1, g0); __syncthreads();
    pg8::f32x4 Hs[4]; Hs[0] = (pg8::f32x4){0.f, 0.f, 0.f, 0.f}; Hs[1] = Hs[0]; Hs[2] = Hs[0]; Hs[3] = Hs[0];
    for (int g2 = 0; g2 < NG; g2 += 2) {
#pragma unroll
      for (int par = 0; par < 2; ++par) {
        const int gi = g2 + par, bf = par;
        if (gi + 2 < NG) { if (par == 0) WK_LOAD(gi + 2, g1); else WK_LOAD(gi + 2, g0); }
        if (F.wave < 4) {
#pragma unroll
            for (int ci = 0; ci < GC; ++ci) {
                const LAS unsigned char* rec = L + bf * BUFB + ci * WK_REC;
                const int ao = (c * 32 + g * 8) * 2;
                const u32x2 vb = *(const LAS u32x2*)(L + bf * BUFB + VBOFF + ((((ci * 4 + vt) * 4 + g) * 16 + c) * 8));
                v4u h0, h1; h0.x = attn_body::cvtpk_s(Hs[0][0], Hs[0][1]); h0.y = attn_body::cvtpk_s(Hs[0][2], Hs[0][3]); h0.z = attn_body::cvtpk_s(Hs[1][0], Hs[1][1]); h0.w = attn_body::cvtpk_s(Hs[1][2], Hs[1][3]);
                h1.x = attn_body::cvtpk_s(Hs[2][0], Hs[2][1]); h1.y = attn_body::cvtpk_s(Hs[2][2], Hs[2][3]); h1.z = attn_body::cvtpk_s(Hs[3][0], Hs[3][1]); h1.w = attn_body::cvtpk_s(Hs[3][2], Hs[3][3]);
                const bf16x8 hb0 = __builtin_bit_cast(bf16x8, h0), hb1 = __builtin_bit_cast(bf16x8, h1);
                v4u vz; vz.x = vb.x; vz.y = vb.y; vz.z = 0u; vz.w = 0u;
                pg8::f32x4 ut = {0.f, 0.f, 0.f, 0.f};
                ut = __builtin_amdgcn_mfma_f32_16x16x32_bf16(*(const LAS bf16x8*)(rec + ao), hb0, ut, 0, 0, 0);
                ut = __builtin_amdgcn_mfma_f32_16x16x32_bf16(*(const LAS bf16x8*)(rec + 1024 + ao), hb1, ut, 0, 0, 0);
                ut = __builtin_amdgcn_mfma_f32_16x16x32_bf16(*(const LAS bf16x8*)(rec + 2048 + ao), __builtin_bit_cast(bf16x8, vz), ut, 0, 0, 0);
                v4u ubw; ubw.x = attn_body::cvtpk_s(ut[0], ut[1]); ubw.y = attn_body::cvtpk_s(ut[2], ut[3]); ubw.z = vb.x; ubw.w = vb.y;
                const bf16x8 ub = __builtin_bit_cast(bf16x8, ubw);
                pg8::f32x4 yt = {0.f, 0.f, 0.f, 0.f};
                yt = __builtin_amdgcn_mfma_f32_16x16x32_bf16(*(const LAS bf16x8*)(rec + 3072 + ao), hb0, yt, 0, 0, 0);
                yt = __builtin_amdgcn_mfma_f32_16x16x32_bf16(*(const LAS bf16x8*)(rec + 4096 + ao), hb1, yt, 0, 0, 0);
                yt = __builtin_amdgcn_mfma_f32_16x16x32_bf16(*(const LAS bf16x8*)(rec + 5120 + ao), ub, yt, 0, 0, 0);
#pragma unroll
                for (int kt = 0; kt < 4; ++kt) { Hs[kt] = __builtin_amdgcn_mfma_f32_16x16x32_bf16(*(const LAS bf16x8*)(rec + 6144 + kt * 1024 + ao), ub, Hs[kt], 0, 0, 0);
                    Hs[kt] = Hs[kt] * *(const LAS pg8::f32x4*)(rec + 10240 + (16 * kt + 4 * g) * 4); }
                LAS unsigned short* yb = (LAS unsigned short*)(L + YB_OFF + bf * 8192) + (ci * 16 + 4 * g) * 64 + vt * 16 + c;
#pragma unroll
                for (int r = 0; r < 4; ++r) yb[r * 64] = (unsigned short)f2bf(yt[r]);
            }
        }
        if (gi + 1 < NG) { if (par == 0) WK_STORE(1, g0); else WK_STORE(0, g1); }
        __syncthreads();
        { const v4u yv = *(const LAS v4u*)(L + YB_OFF + bf * 8192 + F.tid * 16);
          *(v4u*)(Y + (rowb + (size_t)gi * 64 + (F.tid >> 3)) * D + h * 64 + (F.tid & 7) * 8) = yv; }
      }
    }
#undef WK_LOAD
#undef WK_STORE
}


#ifdef DBG_CUT
__device__ __forceinline__ void dbg_copy(Frame& F, const void* src, bool is_bf16, float* out) {
    for (size_t i = (size_t)F.gw * 64 + F.lane; i < (size_t)M * D; i += (size_t)F.NGW * 64) out[i] = is_bf16 ? bf2f(((const bf16*)src)[i]) : ((const float*)src)[i];
}
#ifndef DBG_LAYER
#define DBG_LAYER -1
#endif
#ifndef DBG_SCALE
#define DBG_SCALE 100.f
#define DBG_SUB 1.f
#endif
#define CUT(k, off, isbf) if (DBG_CUT == (k) && (DBG_LAYER < 0 || layer == DBG_LAYER)) { unsigned char* ws = WSB(); dbg_copy(F, ws + (off), (isbf), GOUT()); return; }
#else
#define CUT(k, off, isbf)
#endif
#ifndef REP_GEMM
#define REP_GEMM 1
#endif
#ifndef REP_THIN
#define REP_THIN 1
#endif
#ifndef REP_CONV
#define REP_CONV REP_THIN
#endif
#ifndef REP_LN
#define REP_LN REP_THIN
#endif
#ifndef REP_RW
#define REP_RW REP_THIN
#endif
#ifndef REP_ATTN
#define REP_ATTN 1
#endif
#ifndef REP_SCAN
#define REP_SCAN 1
#endif
#ifndef REP_BAR
#define REP_BAR 1
#endif
#define GEMM_BIG(EpiT, SchedT) for (int rg_ = 0; rg_ < REP_GEMM; ++rg_) pg8::gemm_phase<EpiT, SchedT, true, true>
#define GEMM_ONE(EpiT, SchedT) for (int rg_ = 0; rg_ < REP_GEMM; ++rg_) pg8::gemm_phase<EpiT, SchedT, false, true>
__global__ void __launch_bounds__(NWAVES * 64, 2) fwd_kernel(Args args) {
    extern __shared__ __attribute__((aligned(16))) unsigned char lds[];
    Frame F;
    F.lds = (LAS unsigned char*)lds; F.MISC = (volatile LAS unsigned*)(F.lds + MISC_OFF);
    F.wave = __builtin_amdgcn_readfirstlane((int)threadIdx.x >> 6); F.lane = fresh_lane(); F.tid = F.wave * 64 + F.lane;
    F.G = gridDim.x; { const int bx = blockIdx.x; F.vcu = (F.G % 8 == 0) ? (bx % 8) * (F.G / 8) + bx / 8 : bx; }
    F.gw = F.vcu * NWAVES + F.wave; F.NGW = F.G * NWAVES;
    F.ws = args.ws; F.ctl = (gu32*)(args.ws + WS_CTL);
#ifdef DBG_LDSZERO
    for (int u = F.tid; u < LDS_BYTES / 4; u += NWAVES * 64) ((LAS unsigned*)(F.lds))[u] = 0u;
#else
    for (int u = F.tid; u < (LDS_BYTES - LDSCTL_OFF) / 4; u += NWAVES * 64) ((LAS unsigned*)(F.lds + LDSCTL_OFF))[u] = 0u;
#endif
    __syncthreads();
    XcdBarrier bar = xcd_barrier_post((unsigned*)(F.ctl + CW_BAR), F.MISC + 8, F.tid == 0);
#define GRID_BAR() do { { GAS unsigned* b_ = (GAS unsigned*)bar.bar; asm volatile("" : "+s"(b_), "+s"(bar.x)); bar.bar = (unsigned*)b_; } for (int rb_ = 0; rb_ < REP_BAR; ++rb_) xcd_barrier(bar, F.wave == 0 && fresh_lane() == 0); } while (0)
#define WSB() ({ F.lane = fresh_lane(); F.tid = F.wave * 64 + F.lane; asm volatile("" : "+s"(F.G), "+s"(F.wave), "+s"(F.vcu), "+s"(F.gw), "+s"(F.NGW), "+s"(bx)); GAS unsigned char* p_ = (GAS unsigned char*)args.ws; asm volatile("" : "+s"(p_)); (unsigned char*)p_; })
#define GOUT() ({ GAS float* o_ = (GAS float*)args.out; asm volatile("" : "+s"(o_)); (float*)o_; })
#define INP(i) ({ const __attribute__((address_space(4))) char* k_ = (const __attribute__((address_space(4))) char*)__builtin_amdgcn_kernarg_segment_ptr(); asm volatile("" : "+s"(k_)); const GAS float* g_ = (const GAS float*)(*(const float* const __attribute__((address_space(4)))*)(k_ + 8 * (i))); asm volatile("" : "+s"(g_)); (const float*)g_; })
    LAS unsigned char* ring = F.lds + RING_OFF;
    int bx = (int)blockIdx.x;

    for (int rt_ = 0; rt_ < REP_CONV; ++rt_) conv_rwkv(F, 0); for (int rt_ = 0; rt_ < REP_CONV; ++rt_) conv_dense(F, 0);
    GRID_BAR();

#ifndef LAYER_LO
#define LAYER_LO 0
#define LAYER_HI 4
#endif
    for (int layer = LAYER_LO; layer < LAYER_HI; ++layer) {
        const bool moe = (layer & 1) != 0; const int fe = layer >> 1;
        if (layer < 2) {
            const int l = layer;
            { unsigned char* ws = WSB(); for (int rt_ = 0; rt_ < REP_RW; ++rt_) mix_phase(F, layer == 0 ? INP(I_X) : (const float*)(ws + WS_H), INP(I_MU) + (size_t)l * 6 * D, (bf16*)(ws + RS_XM)); }
            GRID_BAR();
            { unsigned char* ws = WSB(); pg8::Gemm g{D, D, D}; pg8::SchedStd S; S.init(M, 4096, F.G, bx, ws + RS_XM, D, ws + WM_BT1 + (size_t)l * RW_LSTRIDE, D, 1, (size_t)M * D * 2);
              pg8::EpiRkv E{(bf16*)(ws + RS_RKV), (long)RS_LH - (long)RS_RKV, (size_t)M * D};
              GEMM_BIG(pg8::EpiRkv, pg8::SchedStd)(ring, g, S, E, F.wave); }
            GRID_BAR();
            CUT(1, RS_RKV, true)
            { unsigned char* ws = WSB(); pg8::Gemm g{256, D, 256}; pg8::SchedStd S; S.init(M, 4096, F.G, bx, ws + RS_LH, D, ws + WM_BT2 + (size_t)l * RW_LSTRIDE, 256, 2, 0);
              pg8::EpiLoraUpAll E{{(void*)(ws + RS_DEC), INP(I_W0) + (size_t)l * D}, {(void*)(ws + RS_AB), INP(I_A0) + (size_t)l * D}, {(void*)(ws + RS_VG), INP(I_V0)}, {(void*)(ws + RS_GG), nullptr}};
              GEMM_BIG(pg8::EpiLoraUpAll, pg8::SchedStd)(ring, g, S, E, F.wave); }
            GRID_BAR();
            CUT(2, RS_DEC, false) CUT(60, RS_VG, true) CUT(61, RS_GG, true) CUT(62, RS_LH, true) CUT(63, RS_AB, false)
            { unsigned char* ws = WSB(); for (int rt_ = 0; rt_ < REP_RW; ++rt_) prep_phase(F, l, (bf16*)(ws + RS_RKV), (const float*)(ws + RS_AB), (bf16*)(ws + RS_LH), INP(I_V0), INP(I_V2), (bf16*)(ws + WS_VFIRST), INP(I_KK) + (size_t)l * D, INP(I_KA) + (size_t)l * D,
                                                   (bf16*)(ws + RS_KP), (bf16*)(ws + RS_AP), (bf16*)(ws + RS_BP), (bf16*)(ws + RS_VP)); }
            GRID_BAR();
            CUT(3, RS_KP, true) CUT(7, RS_VP, true) CUT(8, RS_BP, true) CUT(9, RS_DEC, false)
#ifdef WKV_SEQ
            for (int rep_ = 0; rep_ < REP_SCAN; ++rep_) {
              { unsigned char* ws = WSB(); scan_phase(F, (bf16*)(ws + RS_RKV), (float*)(ws + RS_DEC), (bf16*)(ws + RS_KP), (bf16*)(ws + RS_AP), (bf16*)(ws + RS_BP), (bf16*)(ws + RS_VP), (bf16*)(ws + WS_Y)); }
              if (rep_ + 1 < REP_SCAN) GRID_BAR(); }
            GRID_BAR();
#else
            { unsigned char* ws = WSB(); wkv_build_phase(F, (bf16*)(ws + RS_RKV), (float*)(ws + RS_DEC), (bf16*)(ws + RS_KP), (bf16*)(ws + RS_AP), (bf16*)(ws + RS_BP), ws + RS_REC0, ws + RS_REC1); }
            GRID_BAR();
#ifdef DBG_CUT
            if (DBG_CUT == 39 && (DBG_LAYER < 0 || layer == DBG_LAYER)) { unsigned char* ws = WSB(); const unsigned short* s_ = (const unsigned short*)(ws + RS_REC0); float* o_ = GOUT();
                for (size_t i = (size_t)F.gw * 64 + F.lane; i < (size_t)M * D; i += (size_t)F.NGW * 64) o_[i] = (float)s_[i]; return; }
#endif
            { unsigned char* ws = WSB(); wkv_chain_phase(F, ws + RS_REC0, ws + RS_REC1, (bf16*)(ws + RS_VP), (bf16*)(ws + WS_Y)); }
            GRID_BAR();
#endif
            CUT(4, WS_Y, true)
#ifdef DBG_CUT
            if (DBG_CUT == 38 && (DBG_LAYER < 0 || layer == DBG_LAYER)) {
                { unsigned char* ws = WSB(); scan_phase(F, (bf16*)(ws + RS_RKV), (float*)(ws + RS_DEC), (bf16*)(ws + RS_KP), (bf16*)(ws + RS_AP), (bf16*)(ws + RS_BP), (bf16*)(ws + RS_VP), (bf16*)(ws + WS_SCR + 128 * MiB)); }
                GRID_BAR();
                { unsigned char* ws = WSB(); const bf16* a_ = (const bf16*)(ws + WS_Y); const bf16* b_ = (const bf16*)(ws + WS_SCR + 128 * MiB); float* o_ = GOUT();
                  for (size_t i = (size_t)F.gw * 64 + F.lane; i < (size_t)M * D; i += (size_t)F.NGW * 64) { float d_ = DBG_SCALE * (bf2f(a_[i]) - DBG_SUB * bf2f(b_[i])); if (!(fabsf(d_) < 1e30f)) d_ = 1e6f; o_[i] = d_; } }
                return; }
#endif
            { unsigned char* ws = WSB(); for (int rt_ = 0; rt_ < REP_RW; ++rt_) post_phase(F, (bf16*)(ws + WS_Y), (bf16*)(ws + RS_RKV), (bf16*)(ws + RS_KP), (bf16*)(ws + RS_VP), (bf16*)(ws + RS_GG),
                                                   INP(I_RK) + (size_t)l * D, INP(I_GNG) + (size_t)l * D, INP(I_GNB) + (size_t)l * D, (bf16*)(ws + RS_YG)); }
            GRID_BAR();
            CUT(5, RS_YG, true)
            { unsigned char* ws = WSB(); pg8::Gemm g{D, D, D}; pg8::SchedStd S; S.init(M, D, F.G, bx, ws + RS_YG, D, ws + WM_OUT + (size_t)l * RW_LSTRIDE, D);
              pg8::EpiResF32 E{layer == 0 ? INP(I_X) : (const float*)(ws + WS_H), (float*)(ws + RS_PRE), ALPHA};
              GEMM_ONE(pg8::EpiResF32, pg8::SchedStd)(ring, g, S, E, F.wave); }
            GRID_BAR();
            CUT(6, RS_PRE, false)
        } else {
            const int j = layer - 2;
            { unsigned char* ws = WSB(); pg8::Gemm g{D, D, D}; pg8::SchedStd S; S.init(M, j == 0 ? 3 * D : D, F.G, bx, ws + WS_HB, D, ws + WM_QKV, D);
              pg8::EpiQKV E{(bf16*)(ws + BS_Q), ((long)WS_K - (long)BS_Q) / 2, ((long)WS_V - (long)BS_Q) / 2, attn_body::C2};
              GEMM_BIG(pg8::EpiQKV, pg8::SchedStd)(ring, g, S, E, F.wave); }
            GRID_BAR();
            CUT(31, BS_Q, true) CUT(32, WS_K, true) CUT(33, WS_V, true)
            if (j == 0) { unsigned char* ws = WSB(); for (int rt_ = 0; rt_ < REP_THIN; ++rt_) kmean_phase(F, (bf16*)(ws + WS_K), (float*)(ws + WS_KMEAN)); GRID_BAR(); }
#ifndef NO_GATE
            { unsigned char* ws = WSB(); for (int rt_ = 0; rt_ < REP_THIN; ++rt_) gate_phase(F, (bf16*)(ws + BS_Q), (float*)(ws + WS_KMEAN), (unsigned*)(ws + WS_SEL)); }
#endif
            GRID_BAR();
#ifdef DBG_CUT
            if (DBG_CUT == 35) { unsigned char* ws = WSB(); const unsigned* s_ = (const unsigned*)(ws + WS_SEL); for (size_t i = (size_t)F.gw * 64 + F.lane; i < (size_t)M * D; i += (size_t)F.NGW * 64) args.out[i] = (float)(s_[i & (size_t)(M * 16 - 1)] % 65521u); return; }
#endif
#ifdef ATTN_DIRECT
            { unsigned char* ws = WSB(); attn_direct_phase(F, (const bf16*)(ws + BS_Q), (const bf16*)(ws + WS_K), (const bf16*)(ws + WS_V), (const unsigned*)(ws + WS_SEL), (bf16*)(ws + BS_O)); }
            GRID_BAR();
#else
            { unsigned char* ws = WSB(); for (int ra_ = 0; ra_ < REP_ATTN; ++ra_) moba_attn_phase(F, (const bf16*)(ws + BS_Q), (const bf16*)(ws + WS_K), (const bf16*)(ws + WS_V), (const unsigned*)(ws + WS_SEL), (bf16*)(ws + BS_PO), (float*)(ws + BS_ML), F.ctl + CW_QCTR + 64 * (j + 2 * ra_)); }
            GRID_BAR();
            { unsigned char* ws = WSB(); for (int rt_ = 0; rt_ < REP_THIN; ++rt_) moba_combine_phase(F, (const unsigned*)(ws + WS_SEL), (const bf16*)(ws + BS_PO), (const float*)(ws + BS_ML), (bf16*)(ws + BS_O)); }
            GRID_BAR();
#endif
            CUT(36, BS_O, true)
#ifdef DBG_CUT
            if (DBG_CUT == 37 && (DBG_LAYER < 0 || layer == DBG_LAYER)) {
                { unsigned char* ws = WSB(); attn_direct_phase(F, (const bf16*)(ws + BS_Q), (const bf16*)(ws + WS_K), (const bf16*)(ws + WS_V), (const unsigned*)(ws + WS_SEL), (bf16*)(ws + BS_PRE)); }
                GRID_BAR();
                { unsigned char* ws = WSB(); const bf16* a_ = (const bf16*)(ws + BS_O); const bf16* b_ = (const bf16*)(ws + BS_PRE); float* o_ = GOUT();
                  for (size_t i = (size_t)F.gw * 64 + F.lane; i < (size_t)M * D; i += (size_t)F.NGW * 64) o_[i] = 1000.f * (bf2f(a_[i]) - bf2f(b_[i])); }
                return; }
#endif
            { unsigned char* ws = WSB(); pg8::Gemm g{D, D, D}; pg8::SchedStd S; S.init(M, D, F.G, bx, ws + BS_O, D, ws + WM_O, D);
              pg8::EpiResF32 E{(const float*)(ws + WS_H), (float*)(ws + BS_PRE), ALPHA};
              GEMM_ONE(pg8::EpiResF32, pg8::SchedStd)(ring, g, S, E, F.wave); }
            GRID_BAR();
        }
        { unsigned char* ws = WSB(); const float* PREm = (const float*)(ws + (layer < 2 ? RS_PRE : BS_PRE));
          const float* g0 = INP(I_LNG) + (size_t)(layer * 2) * D; const float* b0 = INP(I_LNB) + (size_t)(layer * 2) * D;
          if (moe) for (int rt_ = 0; rt_ < REP_LN; ++rt_) ln_phase<0, true>(F, PREm, nullptr, nullptr, nullptr, g0, b0, (float*)(ws + WS_H), (bf16*)(ws + WS_HB), INP(I_ROUTER) + (size_t)fe * D * NE, (int*)(ws + WS_TOKE), (float*)(ws + WS_TOKW), (int*)(ws + WS_BLKCNT));
          else for (int rt_ = 0; rt_ < REP_LN; ++rt_) ln_phase<0, false>(F, PREm, nullptr, nullptr, nullptr, g0, b0, (float*)(ws + WS_H), (bf16*)(ws + WS_HB), nullptr, nullptr, nullptr, nullptr); }
        if (layer == 0) for (int rt_ = 0; rt_ < REP_CONV; ++rt_) conv_rwkv(F, 1); else if (layer == 1) for (int rt_ = 0; rt_ < REP_CONV; ++rt_) conv_moba(F, 0); else if (layer == 2) for (int rt_ = 0; rt_ < REP_CONV; ++rt_) conv_moba(F, 1);
        GRID_BAR();
        CUT(10 + layer, WS_H, false)
        if (!moe) {
            { unsigned char* ws = WSB(); pg8::Gemm g{D, D, D}; pg8::SchedStd S; S.init(M, 2 * FF, F.G, bx, ws + WS_HB, D, ws + WF_GU, D);
              pg8::EpiSwiGLU E{(bf16*)(ws + FS_HID), FF, 1.0f};
              GEMM_BIG(pg8::EpiSwiGLU, pg8::SchedStd)(ring, g, S, E, F.wave); }
            GRID_BAR();
            { unsigned char* ws = WSB(); pg8::Gemm g{FF, FF, FF}; pg8::SchedStd S; S.init(M, D, F.G, bx, ws + FS_HID, FF, ws + WF_DN, FF);
              pg8::EpiResF32 E{(const float*)(ws + WS_H), (float*)(ws + FS_PRE), ALPHA};
              GEMM_ONE(pg8::EpiResF32, pg8::SchedStd)(ring, g, S, E, F.wave); }
            GRID_BAR();
            { unsigned char* ws = WSB(); const float* g1 = INP(I_LNG) + (size_t)(layer * 2 + 1) * D; const float* b1 = INP(I_LNB) + (size_t)(layer * 2 + 1) * D;
              for (int rt_ = 0; rt_ < REP_LN; ++rt_) ln_phase<0, false>(F, (const float*)(ws + FS_PRE), nullptr, nullptr, nullptr, g1, b1, (float*)(ws + WS_H), (bf16*)(ws + WS_HB), nullptr, nullptr, nullptr, nullptr); }
            for (int rt_ = 0; rt_ < REP_CONV; ++rt_) conv_moe(F, fe);
            GRID_BAR();
        } else {
            { unsigned char* ws = WSB(); for (int rt_ = 0; rt_ < REP_THIN; ++rt_) moe_gather_phase(F, (const int*)(ws + WS_BLKCNT), (const int*)(ws + WS_TOKE), (const float*)(ws + WS_TOKW), (int*)(ws + WS_TOKR), (float*)(ws + WS_GW), (const float*)(ws + WS_H), (unsigned char*)(ws + ES_XG)); }
            GRID_BAR();
            { unsigned char* ws = WSB(); const LAS int* pp = (const LAS int*)(F.lds + MISC_OFF + 64);
              pg8::Gemm g{D / 2, D / 2, D / 2};
              pg8::SchedMoe S{2 * FFE / 256, F.G, bx, pp, (const char*)(ws + ES_XG), (const char*)(ws + WE_GU), (size_t)256 * D, (size_t)256 * D, (size_t)2 * FFE * D, 0};
              pg8::EpiSwiGLU E{(bf16*)(ws + ES_HID), FFE, 1.0f / MOE_WSCALE};
              for (int rg_ = 0; rg_ < REP_GEMM; ++rg_) pg8::gemm_phase<pg8::EpiSwiGLU, pg8::SchedMoe, true, true, true>(ring, g, S, E, F.wave); }
            GRID_BAR();
            { unsigned char* ws = WSB(); const LAS int* pp = (const LAS int*)(F.lds + MISC_OFF + 64);
              { pg8::Gemm g{FFE, FFE, FFE}; pg8::SchedMoe S{D / 256, F.G, bx, pp, (const char*)(ws + ES_HID), (const char*)(ws + WE_DN), (size_t)256 * FFE * 2, (size_t)256 * FFE * 2, (size_t)D * FFE * 2, 2 * 256};
                pg8::EpiMoeDown E{(float*)(ws + ES_YP), (const float*)(ws + WS_GW)};
                GEMM_BIG(pg8::EpiMoeDown, pg8::SchedMoe)(ring, g, S, E, F.wave); }
              { pg8::Gemm g{512, FFE, FFE}; pg8::SchedMoeTail S{D / 256, F.G, bx, 2 * 256, 7, pp, (const char*)(ws + ES_HID), (const char*)(ws + WE_DN), (size_t)256 * FFE * 2, (size_t)256 * FFE * 2, (size_t)D * FFE * 2, (size_t)512 * 2};
                pg8::EpiMoeDownSlab E{(float*)(ws + ES_YS), (const float*)(ws + WS_GW), bx, 7};
                GEMM_ONE(pg8::EpiMoeDownSlab, pg8::SchedMoeTail)(ring, g, S, E, F.wave); } }
            GRID_BAR();
            { unsigned char* ws = WSB(); const float* g1 = INP(I_LNG) + (size_t)(layer * 2 + 1) * D; const float* b1 = INP(I_LNB) + (size_t)(layer * 2 + 1) * D;
              if (layer == 3) ln_phase<1, false>(F, (const float*)(ws + ES_YS), (const float*)(ws + WS_H), (const float*)(ws + ES_YP), (const int*)(ws + WS_TOKR), g1, b1, GOUT(), nullptr, nullptr, nullptr, nullptr, nullptr);
              else ln_phase<1, false>(F, (const float*)(ws + ES_YS), (const float*)(ws + WS_H), (const float*)(ws + ES_YP), (const int*)(ws + WS_TOKR), g1, b1, (float*)(ws + WS_H), (bf16*)(ws + WS_HB), nullptr, nullptr, nullptr, nullptr); }
            if (layer == 1) for (int rt_ = 0; rt_ < REP_CONV; ++rt_) conv_dense(F, 1);
            GRID_BAR();
        }
        CUT(20 + layer, WS_H, false)
        CUT(40 + layer, WS_HB, true)
#ifdef DBG_CUT
        if (DBG_CUT == 50 + layer) { unsigned char* ws = WSB(); const bf16* s_ = (const bf16*)(ws + WS_WMIX); float* o_ = GOUT(); for (size_t i = (size_t)F.gw * 64 + F.lane; i < (size_t)M * D; i += (size_t)F.NGW * 64) o_[i] = i < (size_t)6 * 1024 * 1024 ? bf2f(s_[i]) : 0.f; return; }
#endif
    }
}

extern "C" void kernel_launch(void* const* d_in, const int* in_sizes, int n_in, void* d_out, int out_size, void* d_ws, size_t ws_size, hipStream_t stream) {
    static int grid = 0;
    if (grid == 0) {
        if (n_in != 33 || in_sizes[0] != M * D || out_size != M * D || ws_size < WS_END) { fprintf(stderr, "kernel_launch: unexpected problem shape (n_in %d, in0 %d, out %d, ws %zu); nothing launched\n", n_in, n_in > 0 ? in_sizes[0] : -1, out_size, ws_size); grid = -1; return; }
        int dev = 0, cus = 0, per_cu = 0;
        if (hipGetDevice(&dev) != hipSuccess || hipDeviceGetAttribute(&cus, hipDeviceAttributeMultiprocessorCount, dev) != hipSuccess) { grid = -1; return; }
        if (hipFuncSetAttribute((const void*)fwd_kernel, hipFuncAttributeMaxDynamicSharedMemorySize, LDS_BYTES) != hipSuccess) { fprintf(stderr, "kernel_launch: hipFuncSetAttribute failed\n"); grid = -1; return; }
        if (hipOccupancyMaxActiveBlocksPerMultiprocessor(&per_cu, (const void*)fwd_kernel, NWAVES * 64, LDS_BYTES) != hipSuccess || per_cu < 1) { fprintf(stderr, "kernel_launch: occupancy query reports %d workgroups per CU\n", per_cu); }
        (void)hipGetLastError();
        grid = cus;
        if (grid != 256) { fprintf(stderr, "kernel_launch: built for 256 CUs, device has %d; nothing launched\n", cus); grid = -1; return; }
    }
    if (grid < 0) return;
    if (hipMemsetAsync((char*)d_ws + WS_CTL, 0, CTL_ZERO_BYTES, stream) != hipSuccess) return;
#ifdef DBG_FILL
    (void)hipMemsetAsync((char*)d_ws + CTL_ZERO_BYTES, DBG_FILL, WS_END - CTL_ZERO_BYTES, stream);
#endif
    Args a{};
    for (int i = 0; i < 33; ++i) a.in[i] = (const float*)d_in[i];
    a.out = (float*)d_out; a.ws = (unsigned char*)d_ws;
    hipLaunchKernelGGL(fwd_kernel, dim3(grid), dim3(NWAVES * 64), LDS_BYTES, stream, a);
}
```

```cpp
#include <hip/hip_runtime.h>
#include <cstdio>
#include <cstdint>
#include <hip/hip_bf16.h>
#include <cmath>
__device__ __forceinline__ int fresh_lane() { int l; asm volatile("v_mbcnt_lo_u32_b32 %0, -1, 0\n\tv_mbcnt_hi_u32_b32 %0, -1, %0" : "=v"(l)); return l; }
namespace pg8 {
#define PG8_LAS __attribute__((address_space(3)))
typedef unsigned short bf16_t;
typedef short bf16x8 __attribute__((ext_vector_type(8)));
typedef float f32x4 __attribute__((ext_vector_type(4)));
typedef unsigned u32x4 __attribute__((ext_vector_type(4)));
constexpr int BM = 256, BK = 64, HALF = 128, HTB = HALF * BK * 2  , STAGE_BYTES = 8 * HTB, NXCD = 8, WGM = 8;

__host__ __device__ __forceinline__ int lds_byte(int r, int c) { const int st = (r >> 4) * 2 + (c >> 5), rr = r & 15, cc = c & 31, ob = rr * 64 + cc * 2; return st * 1024 + (ob ^ (((ob >> 9) & 1) << 5)); }
__host__ __device__ __forceinline__ void stage_rc(int b, int& R, int& C) { const int st = b / 1024, sb = b % 1024, swz = sb ^ (((sb >> 9) & 1) << 5); R = (st >> 1) * 16 + swz / 64; C = (st & 1) * 32 + (swz % 64) / 2; }
__host__ __device__ __forceinline__ int perm32(int rho) { const int n = rho >> 4, i = rho & 15; return 8 * (i >> 2) + 4 * n + (i & 3); }

struct Unit { int pm, pn, e; };
struct Gemm { int K, lda, ldb; };

__device__ __forceinline__ unsigned cvt_pk_bf16(float lo, float hi) { unsigned r; asm volatile("v_cvt_pk_bf16_f32 %0, %1, %2" : "=v"(r) : "v"(lo), "v"(hi)); return r; }
__device__ __forceinline__ float fsigmoid(float x) { return __builtin_amdgcn_rcpf(1.0f + __expf(-x)); }
__device__ __forceinline__ float ftanh(float x) { return 1.0f - 2.0f * __builtin_amdgcn_rcpf(1.0f + __expf(2.0f * x)); }

struct SchedStd {
    int nM, nN, nwg, G, c, amode; const char* A; const char* B; size_t atile, btile, ag;
    __device__ __forceinline__ void init(int M, int N, int G_, int c_, const void* A_, size_t lda, const void* B_, size_t ldb, int amode_ = 0, size_t ag_ = 0) {
        nM = M / BM; nN = N / BM; nwg = nM * nN; G = G_; c = c_; A = (const char*)A_; B = (const char*)B_; atile = (size_t)BM * lda * 2; btile = (size_t)BM * ldb * 2; amode = amode_; ag = ag_; }
    __device__ __forceinline__ bool next(int i, Unit& u) const {
        const long L = (long)i * G + c; if (L >= nwg) return false;
        int wgid = (int)L; { const int q = nwg / NXCD, r = nwg % NXCD, xcd = wgid % NXCD, off = wgid / NXCD; wgid = (xcd < r ? xcd * (q + 1) : r * (q + 1) + (xcd - r) * q) + off; }
        const int nig = WGM * nN, gid = wgid / nig, fm = gid * WGM, gsz = (nM - fm) < WGM ? (nM - fm) : WGM;
        u.pm = fm + ((wgid % nig) % gsz); u.pn = (wgid % nig) / gsz; u.e = 0; return true;
    }
    __device__ __forceinline__ const char* abase(const Unit& u) const {
        size_t off = (size_t)u.pm * atile;
        if (amode == 1) { const int gs = u.pn < 12 ? (u.pn >> 2) : (u.pn == 12 ? 3 : (u.pn == 13 ? 4 : (u.pn == 14 ? 2 : 5))); off += (size_t)gs * ag; }
        else if (amode == 2) off += (size_t)(u.pn >> 2) * 512;
        return A + off; }
    __device__ __forceinline__ const char* bbase(const Unit& u) const { return B + (size_t)u.pn * btile; }
    __device__ __forceinline__ void a_ready(const Unit&) const {}
    __device__ __forceinline__ void done(const Unit&) const {}
};
struct SchedMoe {
    int nN, G, c; const PG8_LAS int* pp; const char* A; const char* B; size_t atile, btile, bexp; int cap;
    __device__ __forceinline__ bool next(int i, Unit& u) const {
        const int L = i * G + c; int tot = pp[8] * nN; if (cap && tot > cap) tot = cap; if (L >= tot) return false;
        const int pm = L / nN; u.pm = pm; u.pn = L - pm * nN; int e = 0;
#pragma unroll
        for (int k = 1; k < 8; ++k) e += (pm >= pp[k]) ? 1 : 0;
        u.e = __builtin_amdgcn_readfirstlane(e); return true; }
    __device__ __forceinline__ const char* abase(const Unit& u) const { return A + (size_t)u.pm * atile; }
    __device__ __forceinline__ const char* bbase(const Unit& u) const { return B + (size_t)u.e * bexp + (size_t)u.pn * btile; }
    __device__ __forceinline__ void a_ready(const Unit&) const {}
    __device__ __forceinline__ void done(const Unit&) const {}
};

struct SchedMoeTail {
    int nN, G, c, first, NS; const PG8_LAS int* pp; const char* A; const char* B; size_t atile, btile, bexp, kslice;
    __device__ __forceinline__ bool next(int i, Unit& u) const {
        if (i > 0) return false;
        const int L = first + c / NS, tot = pp[8] * nN; if (L >= tot) return false;
        const int pm = L / nN; u.pm = pm; u.pn = L - pm * nN; int e = 0;
#pragma unroll
        for (int k = 1; k < 8; ++k) e += (pm >= pp[k]) ? 1 : 0;
        u.e = __builtin_amdgcn_readfirstlane(e); return true; }
    __device__ __forceinline__ const char* abase(const Unit& u) const { return A + (size_t)u.pm * atile + (size_t)(c % NS) * kslice; }
    __device__ __forceinline__ const char* bbase(const Unit& u) const { return B + (size_t)u.e * bexp + (size_t)u.pn * btile + (size_t)(c % NS) * kslice; }
    __device__ __forceinline__ void a_ready(const Unit&) const {}
    __device__ __forceinline__ void done(const Unit&) const {}
};
#define PG8_PACK8(w, v0, v1) do { w.x = cvt_pk_bf16(v0[0], v0[1]); w.y = cvt_pk_bf16(v0[2], v0[3]); w.z = cvt_pk_bf16(v1[0], v1[1]); w.w = cvt_pk_bf16(v1[2], v1[3]); } while (0)

struct EpiQKV {
    static constexpr bool PERM = true, AFTER_DRAIN = false;
    bf16_t* O0; long d1, d2; float s0;
    __device__ __forceinline__ void operator()(const f32x4 (&acc)[2][2][4][2], const Unit& u, int wr, int wc, int fr, int fq) const {
        const int t = u.pn >> 2; bf16_t* base = O0 + (long)(t == 1) * d1 + (long)(t == 2) * d2; const float sc = t == 0 ? s0 : 1.0f;
        const int row0 = u.pm * BM + wr * 64 + fr, col0 = (u.pn & 3) * BM + wc * 32 + 8 * fq;
#pragma unroll
        for (int ai = 0; ai < 2; ++ai)
#pragma unroll
            for (int m = 0; m < 4; ++m) { bf16_t* rowp = base + (size_t)(row0 + ai * HALF + m * 16) * 1024 + col0;
#pragma unroll
                for (int bj = 0; bj < 2; ++bj) { const f32x4 v0 = acc[ai][bj][m][0] * sc, v1 = acc[ai][bj][m][1] * sc; u32x4 w; PG8_PACK8(w, v0, v1); *(u32x4*)(rowp + bj * HALF) = w; } }
    }
};
struct EpiRkv {
    static constexpr bool PERM = true, AFTER_DRAIN = false;
    bf16_t* RKV; long dLH; size_t mstride;
    __device__ __forceinline__ void operator()(const f32x4 (&acc)[2][2][4][2], const Unit& u, int wr, int wc, int fr, int fq) const {
        const int pn = u.pn; const bool lora = pn >= 12;
        bf16_t* base = (bf16_t*)((char*)RKV + (lora ? dLH : (long)((size_t)(pn >> 2) * mstride * 2))); const int colt = lora ? (pn - 12) * BM : (pn & 3) * BM;
        const int row0 = u.pm * BM + wr * 64 + fr, col0 = colt + wc * 32 + 8 * fq;
#pragma unroll
        for (int ai = 0; ai < 2; ++ai)
#pragma unroll
            for (int m = 0; m < 4; ++m) { bf16_t* rowp = base + (size_t)(row0 + ai * HALF + m * 16) * 1024 + col0;
#pragma unroll
                for (int bj = 0; bj < 2; ++bj) { f32x4 v0 = acc[ai][bj][m][0], v1 = acc[ai][bj][m][1];
                    if (pn == 12) {
#pragma unroll
                        for (int i = 0; i < 4; ++i) { v0[i] = ftanh(v0[i]); v1[i] = ftanh(v1[i]); } }
                    else if (pn == 15) {
#pragma unroll
                        for (int i = 0; i < 4; ++i) { v0[i] = fsigmoid(v0[i]); v1[i] = fsigmoid(v1[i]); } }
                    u32x4 w; PG8_PACK8(w, v0, v1); *(u32x4*)(rowp + bj * HALF) = w; } }
    }
};
template <int GRP> struct EpiLoraUp {
    static constexpr bool PERM = true, AFTER_DRAIN = false;
    void* O; const float* bias;
    __device__ __forceinline__ void operator()(const f32x4 (&acc)[2][2][4][2], const Unit& u, int wr, int wc, int fr, int fq) const {
        const int row0 = u.pm * BM + wr * 64 + fr, col0 = u.pn * BM + wc * 32 + 8 * fq;
#pragma unroll
        for (int bj = 0; bj < 2; ++bj) {
            f32x4 bv0 = (f32x4){0.f, 0.f, 0.f, 0.f}, bv1 = bv0;
            if (GRP < 3) { bv0 = *(const f32x4*)(bias + col0 + bj * HALF); bv1 = *(const f32x4*)(bias + col0 + bj * HALF + 4); }
#pragma unroll
            for (int ai = 0; ai < 2; ++ai)
#pragma unroll
                for (int m = 0; m < 4; ++m) { const size_t ro = (size_t)(row0 + ai * HALF + m * 16) * 1024 + col0 + bj * HALF;
                    f32x4 v0_ = acc[ai][bj][m][0] + bv0, v1_ = acc[ai][bj][m][1] + bv1;
                    if (GRP == 0) {
#pragma unroll
                        for (int i = 0; i < 4; ++i) { v0_[i] = __expf(-0.6065306597f * fsigmoid(v0_[i])); v1_[i] = __expf(-0.6065306597f * fsigmoid(v1_[i])); }
                    } else if (GRP < 3) {
#pragma unroll
                        for (int i = 0; i < 4; ++i) { v0_[i] = fsigmoid(v0_[i]); v1_[i] = fsigmoid(v1_[i]); }
                    }
                    if (GRP < 2) { *(f32x4*)((float*)O + ro) = v0_; *(f32x4*)((float*)O + ro + 4) = v1_; }
                    else { u32x4 w; PG8_PACK8(w, v0_, v1_); *(u32x4*)((bf16_t*)O + ro) = w; } }
        }
    }
};
struct EpiLoraUpAll {
    static constexpr bool PERM = true, AFTER_DRAIN = false;
    EpiLoraUp<0> e0; EpiLoraUp<1> e1; EpiLoraUp<2> e2; EpiLoraUp<3> e3;
    __device__ __forceinline__ void operator()(const f32x4 (&acc)[2][2][4][2], const Unit& u, int wr, int wc, int fr, int fq) const {
        Unit v = u; v.pn = u.pn & 3; const int g = u.pn >> 2;
        if (g == 0) e0(acc, v, wr, wc, fr, fq); else if (g == 1) e1(acc, v, wr, wc, fr, fq); else if (g == 2) e2(acc, v, wr, wc, fr, fq); else e3(acc, v, wr, wc, fr, fq);
    }
};
struct EpiResF32 {
    static constexpr bool PERM = false, AFTER_DRAIN = false;
    const float* base; float* out; float alpha;
    __device__ __forceinline__ void operator()(const f32x4 (&acc)[2][2][4][2], const Unit& u, int wr, int wc, int fr, int fq) const {
        const int row0 = u.pm * BM + wr * 64 + fr, col0 = u.pn * BM + wc * 32 + 4 * fq;
#pragma unroll
        for (int ai = 0; ai < 2; ++ai)
#pragma unroll
            for (int m = 0; m < 4; ++m) { const size_t ro = (size_t)(row0 + ai * HALF + m * 16) * 1024 + col0;
#pragma unroll
                for (int bj = 0; bj < 2; ++bj)
#pragma unroll
                    for (int n = 0; n < 2; ++n) { const f32x4 b = *(const f32x4*)(base + ro + bj * HALF + n * 16); *(f32x4*)(out + ro + bj * HALF + n * 16) = b * alpha + acc[ai][bj][m][n]; } }
    }
};
struct EpiSwiGLU {
    static constexpr bool PERM = true, AFTER_DRAIN = false;
    bf16_t* Hd; int ldh; float sc;
    __device__ __forceinline__ void operator()(const f32x4 (&acc)[2][2][4][2], const Unit& u, int wr, int wc, int fr, int fq) const {
        const int row0 = u.pm * BM + wr * 64 + fr, col0 = u.pn * HALF + wc * 32 + 8 * fq;
#pragma unroll
        for (int ai = 0; ai < 2; ++ai)
#pragma unroll
            for (int m = 0; m < 4; ++m) { bf16_t* rowp = Hd + (size_t)(row0 + ai * HALF + m * 16) * ldh + col0;
                f32x4 v0, v1;
#pragma unroll
                for (int i = 0; i < 4; ++i) { const float g0 = acc[ai][0][m][0][i] * sc, g1 = acc[ai][0][m][1][i] * sc;
                    v0[i] = g0 * fsigmoid(g0) * (acc[ai][1][m][0][i] * sc); v1[i] = g1 * fsigmoid(g1) * (acc[ai][1][m][1][i] * sc); }
                u32x4 w; PG8_PACK8(w, v0, v1); *(u32x4*)rowp = w; }
    }
};
struct EpiMoeDown {
    static constexpr bool PERM = false, AFTER_DRAIN = false;
    float* YP; const float* gw;
    __device__ __forceinline__ void operator()(const f32x4 (&acc)[2][2][4][2], const Unit& u, int wr, int wc, int fr, int fq) const {
        const int row0 = u.pm * BM + wr * 64 + fr, col0 = u.pn * BM + wc * 32 + 4 * fq;
#pragma unroll
        for (int ai = 0; ai < 2; ++ai)
#pragma unroll
            for (int m = 0; m < 4; ++m) { const int row = row0 + ai * HALF + m * 16; const float s = gw[row]; const size_t ro = (size_t)row * 1024 + col0;
#pragma unroll
                for (int bj = 0; bj < 2; ++bj)
#pragma unroll
                    for (int n = 0; n < 2; ++n) *(f32x4*)(YP + ro + bj * HALF + n * 16) = acc[ai][bj][m][n] * s; }
    }
};

struct EpiMoeDownSlab {
    static constexpr bool PERM = false, AFTER_DRAIN = false;
    float* YS; const float* gw; int c, NS;
    __device__ __forceinline__ void operator()(const f32x4 (&acc)[2][2][4][2], const Unit& u, int wr, int wc, int fr, int fq) const {
        const int row0 = u.pm * BM + wr * 64 + fr, col0 = u.pn * BM + wc * 32 + 4 * fq; float* slab = YS + (size_t)(c % NS) * 2048 * 1024;
#pragma unroll
        for (int ai = 0; ai < 2; ++ai)
#pragma unroll
            for (int m = 0; m < 4; ++m) { const int row = row0 + ai * HALF + m * 16; const float s = gw[row]; const size_t ro = (size_t)(row - 32768) * 1024 + col0;
#pragma unroll
                for (int bj = 0; bj < 2; ++bj)
#pragma unroll
                    for (int n = 0; n < 2; ++n) *(f32x4*)(slab + ro + bj * HALF + n * 16) = acc[ai][bj][m][n] * s; }
    }
};
template <class Epi, class Sched, bool ALIGN_EPI = false, bool SP2 = false, bool F8 = false>
__device__ __forceinline__ void gemm_phase(PG8_LAS unsigned char* lds, const Gemm g, const Sched& S, const Epi& E, int wave) {
    const int lane = fresh_lane(), wid = wave, tid = wid * 64 + lane, wr = wid >> 2, wc = wid & 3, fr = lane & 15, fq = lane >> 4;
    const int K = g.K, nt = K / BK;
    unsigned voffA[2], voffB[2];
#pragma unroll
    for (int i = 0; i < 2; ++i) { int R, C; stage_rc(tid * 16 + i * 8192, R, C); const int Rb = Epi::PERM ? ((R & ~31) + perm32(R & 31)) : R;
        voffA[i] = (unsigned)(R * g.lda + C) * 2u; voffB[i] = (unsigned)(Rb * g.ldb + C) * 2u; }
    const size_t kstep = (size_t)(BK * 2);
    const size_t hsA = (size_t)HALF * g.lda * 2, hsB = (size_t)HALF * g.ldb * 2;
    const unsigned ldsw = (unsigned)wid * 1024u;
    const int aoff = lds_byte(wr * 64 + fr, fq * 8), boff = lds_byte(wc * 32 + fr, fq * 8);
#define PG8_SA(b, h) (((b) * 2 + (h)) * HTB)
#define PG8_SB(b, h) ((4 + (b) * 2 + (h)) * HTB)
#define PG8_STAGE(bufoff, gbase, voff) do { _Pragma("unroll") for (int _i = 0; _i < 2; ++_i) \
        __builtin_amdgcn_global_load_lds((const unsigned*)((const char*)(gbase) + (voff)[_i]), (PG8_LAS unsigned*)(lds + (bufoff) + ldsw + _i * 8192), 16, 0, 0); } while (0)
#define PG8_LDA(dst, b, h) do { _Pragma("unroll") for (int m = 0; m < 4; ++m) { const i32x4_ lo_ = *(const PG8_LAS i32x4_*)(lds + PG8_SA(b, h) + aoff + m * 2048), hi_ = *(const PG8_LAS i32x4_*)(lds + PG8_SA(b, h) + aoff + m * 2048 + 1024); \
        if constexpr (F8) dst##8[m] = __builtin_shufflevector(lo_, hi_, 0, 1, 2, 3, 4, 5, 6, 7); else { dst[m][0] = __builtin_bit_cast(bf16x8, lo_); dst[m][1] = __builtin_bit_cast(bf16x8, hi_); } } } while (0)
#define PG8_LDB(dst, b, h) do { _Pragma("unroll") for (int n = 0; n < 2; ++n) { const i32x4_ lo_ = *(const PG8_LAS i32x4_*)(lds + PG8_SB(b, h) + boff + n * 2048), hi_ = *(const PG8_LAS i32x4_*)(lds + PG8_SB(b, h) + boff + n * 2048 + 1024); \
        if constexpr (F8) dst##8[n] = __builtin_shufflevector(lo_, hi_, 0, 1, 2, 3, 4, 5, 6, 7); else { dst[n][0] = __builtin_bit_cast(bf16x8, lo_); dst[n][1] = __builtin_bit_cast(bf16x8, hi_); } } } while (0)
#define PG8_MMA(ai, bj, At, Bt) do { __builtin_amdgcn_s_setprio(1); _Pragma("unroll") for (int m = 0; m < 4; ++m) _Pragma("unroll") for (int n = 0; n < 2; ++n) { \
        if constexpr (F8) asm volatile("v_mfma_scale_f32_16x16x128_f8f6f4 %0, %1, %2, %0, %3, %3 op_sel_hi:[0,0,0]" : "+v"(acc[ai][bj][m][n]) : "v"(Bt##8[n]), "v"(At##8[m]), "v"(f8scale));   \
        else { _Pragma("unroll") for (int k = 0; k < 2; ++k) acc[ai][bj][m][n] = __builtin_amdgcn_mfma_f32_16x16x32_bf16(Bt[n][k], At[m][k], acc[ai][bj][m][n], 0, 0, 0); } } \
        __builtin_amdgcn_s_setprio(0); } while (0)
#define PG8_WAIT_V(n) asm volatile("s_waitcnt vmcnt(" #n ")" ::: "memory")
#define PG8_WAIT_L(n) asm volatile("s_waitcnt lgkmcnt(" #n ")" ::: "memory")
#define PG8_BAR __builtin_amdgcn_s_barrier()
#define PG8_SCHED __builtin_amdgcn_sched_barrier(0)
    Unit cur, nxt; int ui = 0;
    if (!S.next(0, cur)) return;
    f32x4 acc[2][2][4][2];
#pragma unroll
    for (int a = 0; a < 2; ++a)
#pragma unroll
        for (int b = 0; b < 2; ++b)
#pragma unroll
            for (int m = 0; m < 4; ++m)
#pragma unroll
                for (int n = 0; n < 2; ++n) acc[a][b][m][n] = (f32x4){0.f, 0.f, 0.f, 0.f};
    typedef int i32x4_ __attribute__((ext_vector_type(4))); typedef int i32x8_ __attribute__((ext_vector_type(8)));
    int f8scale = 0x7f7f7f7f; asm volatile("" : "+v"(f8scale));
    bf16x8 At[4][2], B0[2][2], B1[2][2]; i32x8_ At8[4], B08[2], B18[2];
    const char* cA = S.abase(cur); const char* cB = S.bbase(cur);
    S.a_ready(cur);
    if constexpr (SP2) {
        PG8_STAGE(PG8_SB(0, 0), cB, voffB); PG8_STAGE(PG8_SB(0, 1), cB + hsB, voffB); PG8_STAGE(PG8_SA(0, 0), cA, voffA); PG8_STAGE(PG8_SA(0, 1), cA + hsA, voffA);
        if (wr == 1) PG8_BAR;
        PG8_WAIT_V(2); PG8_BAR;
        PG8_STAGE(PG8_SB(1, 0), cB + kstep, voffB); PG8_STAGE(PG8_SA(1, 0), cA + kstep, voffA); PG8_STAGE(PG8_SB(1, 1), cB + hsB + kstep, voffB);
        PG8_WAIT_V(6); PG8_BAR;
    } else {
        PG8_STAGE(PG8_SB(0, 0), cB, voffB); PG8_STAGE(PG8_SA(0, 0), cA, voffA); PG8_STAGE(PG8_SB(0, 1), cB + hsB, voffB); PG8_STAGE(PG8_SA(0, 1), cA + hsA, voffA);
        if (wr == 1) PG8_BAR;
        PG8_WAIT_V(4); PG8_BAR;
        PG8_STAGE(PG8_SB(1, 0), cB + kstep, voffB); PG8_STAGE(PG8_SA(1, 0), cA + kstep, voffA); PG8_STAGE(PG8_SB(1, 1), cB + hsB + kstep, voffB);
        PG8_WAIT_V(6); PG8_BAR;
    }
    for (;;) {
        const bool has_next = S.next(ui + 1, nxt);
        const char* nA = has_next ? S.abase(nxt) : cA; const char* nB = has_next ? S.bbase(nxt) : cB;
#pragma nounroll
        for (int t = 0; t < nt; t += 2) {
            const bool last = (t == nt - 2);
            const char* a1 = cA + (size_t)(t + 1) * kstep;
            const char* a2 = last ? nA : cA + (size_t)(t + 2) * kstep; const char* b2 = last ? nB : cB + (size_t)(t + 2) * kstep;
            const char* a3 = a2 + kstep; const char* b3 = b2 + kstep;
            if (last && has_next) S.a_ready(nxt);
            if constexpr (SP2) {
            PG8_LDB(B0, 0, 0); PG8_LDB(B1, 0, 1); PG8_SCHED; PG8_LDA(At, 0, 0); PG8_STAGE(PG8_SA(1, 1), a1 + hsA, voffA);
            PG8_WAIT_V(8); PG8_WAIT_L(0); PG8_BAR; PG8_MMA(0, 0, At, B0); PG8_MMA(0, 1, At, B1); PG8_BAR; PG8_SCHED;
            PG8_LDA(At, 0, 1); PG8_STAGE(PG8_SB(0, 0), b2, voffB); PG8_STAGE(PG8_SB(0, 1), b2 + hsB, voffB); PG8_STAGE(PG8_SA(0, 0), a2, voffA);
            PG8_WAIT_V(8); PG8_WAIT_L(0); PG8_BAR; PG8_MMA(1, 0, At, B0); PG8_MMA(1, 1, At, B1); PG8_BAR; PG8_SCHED;
            PG8_LDB(B0, 1, 0); PG8_LDB(B1, 1, 1); PG8_SCHED; PG8_LDA(At, 1, 0); PG8_STAGE(PG8_SA(0, 1), a2 + hsA, voffA);
            PG8_WAIT_V(8); PG8_WAIT_L(0); PG8_BAR; PG8_MMA(0, 0, At, B0); PG8_MMA(0, 1, At, B1); PG8_BAR; PG8_SCHED;
            PG8_LDA(At, 1, 1); PG8_STAGE(PG8_SB(1, 0), b3, voffB); PG8_STAGE(PG8_SB(1, 1), b3 + hsB, voffB); PG8_STAGE(PG8_SA(1, 0), a3, voffA);
            PG8_WAIT_V(8); PG8_WAIT_L(0); PG8_BAR; PG8_MMA(1, 0, At, B0); PG8_MMA(1, 1, At, B1); PG8_BAR; PG8_SCHED;
            } else {
            PG8_LDB(B0, 0, 0); PG8_SCHED; PG8_LDA(At, 0, 0); PG8_STAGE(PG8_SA(1, 1), a1 + hsA, voffA);
            PG8_WAIT_L(8); PG8_BAR; PG8_WAIT_L(0); PG8_MMA(0, 0, At, B0); PG8_BAR; PG8_SCHED;
            PG8_LDB(B1, 0, 1); PG8_STAGE(PG8_SB(0, 0), b2, voffB);
            PG8_BAR; PG8_WAIT_L(0); PG8_MMA(0, 1, At, B1); PG8_BAR;
            PG8_LDA(At, 0, 1); PG8_STAGE(PG8_SA(0, 0), a2, voffA);
            PG8_BAR; PG8_WAIT_L(0); PG8_MMA(1, 0, At, B0); PG8_BAR; PG8_SCHED;
            PG8_STAGE(PG8_SB(0, 1), b2 + hsB, voffB);
            PG8_WAIT_V(6); PG8_BAR; PG8_MMA(1, 1, At, B1); PG8_BAR;
            PG8_LDB(B0, 1, 0); PG8_SCHED; PG8_LDA(At, 1, 0); PG8_STAGE(PG8_SA(0, 1), a2 + hsA, voffA);
            PG8_WAIT_L(8); PG8_BAR; PG8_WAIT_L(0); PG8_MMA(0, 0, At, B0); PG8_BAR; PG8_SCHED;
            PG8_LDB(B1, 1, 1); PG8_STAGE(PG8_SB(1, 0), b3, voffB);
            PG8_BAR; PG8_WAIT_L(0); PG8_MMA(0, 1, At, B1); PG8_BAR;
            PG8_LDA(At, 1, 1); PG8_STAGE(PG8_SA(1, 0), a3, voffA);
            PG8_BAR; PG8_WAIT_L(0); PG8_MMA(1, 0, At, B0); PG8_BAR; PG8_SCHED;
            PG8_STAGE(PG8_SB(1, 1), b3 + hsB, voffB);
            PG8_WAIT_V(6); PG8_BAR; PG8_MMA(1, 1, At, B1); PG8_BAR;
            }
        }
        if constexpr (ALIGN_EPI) { if (wr == 0) PG8_BAR; }
        if constexpr (!Epi::AFTER_DRAIN) { E(acc, cur, wr, wc, fr, fq); S.done(cur); }
        if (!has_next) break;
#pragma unroll
        for (int a = 0; a < 2; ++a)
#pragma unroll
            for (int b = 0; b < 2; ++b)
#pragma unroll
                for (int m = 0; m < 4; ++m)
#pragma unroll
                    for (int n = 0; n < 2; ++n) acc[a][b][m][n] = (f32x4){0.f, 0.f, 0.f, 0.f};
        cur = nxt; cA = nA; cB = nB; ++ui;
        if constexpr (ALIGN_EPI) { if (wr == 1) PG8_BAR; }
    }
    PG8_WAIT_V(0);
    if constexpr (!ALIGN_EPI) { if (wr == 0) PG8_BAR; }
    PG8_BAR;
    if constexpr (Epi::AFTER_DRAIN) { E.fused(acc, cur, wr, wc, fr, fq, lds, wid, lane); S.done(cur); }
#undef PG8_SA
#undef PG8_SB
#undef PG8_STAGE
#undef PG8_LDA
#undef PG8_LDB
#undef PG8_MMA
#undef PG8_WAIT_V
#undef PG8_WAIT_L
#undef PG8_BAR
#undef PG8_SCHED
}
}

#ifndef MOBA_MASK_ON
#define MOBA_MASK_ON 1
#endif
namespace attn_body {
using bf16=__hip_bfloat16;
using bf16x8=__attribute__((ext_vector_type(8)))short;
using s16x4=__attribute__((ext_vector_type(4)))short;
using f32x16=__attribute__((ext_vector_type(16)))float;
using u32x4=__attribute__((ext_vector_type(4)))unsigned;
constexpr int BATCH=2,NHEAD=16,SEQ=8192,D=64,DM=NHEAD*D;
constexpr int NW=8,QBLK=32,QB=QBLK*NW,KVBLK=64,NQB=SEQ/QB;
constexpr int ATTN_PITCH=DM, ATTN_UNIT_ROWS=QB;
__device__ __forceinline__ int crow(int r,int hi){return (r&3)+8*(r>>2)+4*hi;}
#define SBAR() __builtin_amdgcn_sched_barrier(0)
__device__ __forceinline__ void cmask(f32x16&p0,f32x16&p1,int jb,int qrel,int hi){
  const float NEG=-INFINITY; int d=qrel-(64*jb+4*hi); asm volatile("":"+v"(d));
  #pragma unroll
  for(int r=0;r<16;++r){const int c=(r&3)+8*(r>>2); if(c>d)p0[r]=NEG; if(c+32>d)p1[r]=NEG;}
}

constexpr int NSLOT=3, SLOTB=8192;
constexpr int LDS_K=0, LDS_V=NSLOT*SLOTB, LDS_WS=2*NSLOT*SLOTB, LDS_OST=LDS_WS+NW*64*4, LDS_BYTES=LDS_OST+NW*4096;
constexpr float C2=0.125f*1.4426950408889634f;
__device__ __forceinline__ void glds16(const void*gsrc,unsigned lds_dst){unsigned keep;
  asm volatile("s_mov_b32 %0, m0\n\ts_mov_b32 m0, %2\n\ts_nop 0\n\tglobal_load_lds_dwordx4 %1, off\n\ts_mov_b32 m0, %0":"=&s"(keep):"v"(gsrc),"s"(lds_dst):"memory");}
__device__ __forceinline__ float max3f(float a,float b,float c){float r;asm("v_max3_f32 %0, %1, %2, %3":"=v"(r):"v"(a),"v"(b),"v"(c));return r;}
__device__ __forceinline__ float max2f(float a,float b){float r;asm("v_max_f32_e32 %0, %1, %2":"=v"(r):"v"(a),"v"(b));return r;}
__device__ __forceinline__ float fadd_s(float a,float b){float r;asm("v_add_f32_e32 %0, %1, %2":"=v"(r):"v"(a),"v"(b));return r;}
__device__ __forceinline__ float fsub_s(float a,float b){float r;asm("v_sub_f32_e32 %0, %1, %2":"=v"(r):"v"(a),"v"(b));return r;}
typedef float f32x2_t __attribute__((ext_vector_type(2))); typedef __bf16 bf16x2_t __attribute__((ext_vector_type(2)));
__device__ __forceinline__ unsigned cvtpk_s(float lo,float hi){f32x2_t v={lo,hi};bf16x2_t b=__builtin_convertvector(v,bf16x2_t);return __builtin_bit_cast(unsigned,b);}
#define WAIT_BAR(N) asm volatile("s_waitcnt vmcnt(" #N ") lgkmcnt(0)\n\ts_barrier":::"memory")

__device__ __forceinline__ void qkt(f32x16&p0,f32x16&p1,const char*Kslot,const bf16x8*qr,int r32,int hi){
  const char*kb=Kslot+hi*1024+r32*16;
  #pragma unroll
  for(int d0=0;d0<4;++d0){
    const bf16x8 b0=*reinterpret_cast<const bf16x8*>(kb+d0*2048);
    const bf16x8 b1=*reinterpret_cast<const bf16x8*>(kb+d0*2048+512);
    if(d0==0){p0=__builtin_amdgcn_mfma_f32_32x32x16_bf16(b0,qr[0],f32x16{},0,0,0);p1=__builtin_amdgcn_mfma_f32_32x32x16_bf16(b1,qr[0],f32x16{},0,0,0);}
    else{p0=__builtin_amdgcn_mfma_f32_32x32x16_bf16(b0,qr[d0],p0,0,0,0);p1=__builtin_amdgcn_mfma_f32_32x32x16_bf16(b1,qr[d0],p1,0,0,0);}}
}
typedef __attribute__((address_space(3))) const char* lds_cptr;
typedef short v4i16_t __attribute__((ext_vector_type(4)));
__device__ __forceinline__ void kload8(bf16x8*kf,lds_cptr kp){
  kf[0]=*(const __attribute__((address_space(3))) bf16x8*)(kp);      kf[1]=*(const __attribute__((address_space(3))) bf16x8*)(kp+512);
  kf[2]=*(const __attribute__((address_space(3))) bf16x8*)(kp+2048); kf[3]=*(const __attribute__((address_space(3))) bf16x8*)(kp+2560);
  kf[4]=*(const __attribute__((address_space(3))) bf16x8*)(kp+4096); kf[5]=*(const __attribute__((address_space(3))) bf16x8*)(kp+4608);
  kf[6]=*(const __attribute__((address_space(3))) bf16x8*)(kp+6144); kf[7]=*(const __attribute__((address_space(3))) bf16x8*)(kp+6656);
}
__device__ __forceinline__ void kload2(bf16x8*kf,lds_cptr kp,int j){ kf[2*j]=*(const __attribute__((address_space(3))) bf16x8*)(kp+j*2048); kf[2*j+1]=*(const __attribute__((address_space(3))) bf16x8*)(kp+j*2048+512); }
__device__ __forceinline__ s16x4 vtr(lds_cptr p){ return __builtin_bit_cast(s16x4,__builtin_amdgcn_ds_read_tr16_b64_v4i16((__attribute__((address_space(3))) v4i16_t*)p)); }
__device__ __forceinline__ float rowmax(const f32x16&p0,const f32x16&p1){
  float a=max3f(p0[0],p0[1],p1[0]),b=max3f(p0[2],p0[3],p1[1]);a=max3f(a,p1[2],p1[3]);
  #pragma unroll
  for(int r=4;r<16;r+=4){a=max3f(a,p0[r],p0[r+1]);b=max3f(b,p0[r+2],p0[r+3]);a=max3f(a,p1[r],p1[r+1]);b=max3f(b,p1[r+2],p1[r+3]);}
  const float m=max2f(a,b);
  auto rr=__builtin_amdgcn_permlane32_swap(__float_as_uint(m),__float_as_uint(m),false,false);
  return max2f(__uint_as_float(rr[0]),__uint_as_float(rr[1]));
}
__device__ __forceinline__ void pv(f32x16*o,int vb,bf16x8 pa0,bf16x8 pa1,bf16x8 pa2,bf16x8 pa3){
  #pragma unroll
  for(int d0=0;d0<2;++d0){s16x4 lo[4],hi[4];
    #pragma unroll
    for(int ks=0;ks<4;++ks){
      asm volatile("ds_read_b64_tr_b16 %0,%1 offset:%c2":"=&v"(lo[ks]):"v"(vb),"i"(d0*4096+ks*1024):"memory");
      asm volatile("ds_read_b64_tr_b16 %0,%1 offset:%c2":"=&v"(hi[ks]):"v"(vb),"i"(d0*4096+ks*1024+512):"memory");}
    asm volatile("s_waitcnt lgkmcnt(0)":::"memory");SBAR();
    #define PK(k) (bf16x8){lo[k][0],lo[k][1],lo[k][2],lo[k][3],hi[k][0],hi[k][1],hi[k][2],hi[k][3]}
    o[d0]=__builtin_amdgcn_mfma_f32_32x32x16_bf16(pa0,PK(0),o[d0],0,0,0);
    o[d0]=__builtin_amdgcn_mfma_f32_32x32x16_bf16(pa1,PK(1),o[d0],0,0,0);
    o[d0]=__builtin_amdgcn_mfma_f32_32x32x16_bf16(pa2,PK(2),o[d0],0,0,0);
    o[d0]=__builtin_amdgcn_mfma_f32_32x32x16_bf16(pa3,PK(3),o[d0],0,0,0);
    #undef PK
  }
}

#ifndef ATTN_STORE16
#define ATTN_STORE16(p,v) (*(u32x4*)(p)=(v))
#endif
template<int THRL> __device__ __forceinline__ void attn_unit(int b,int h,int qb,const bf16*Q,const bf16*__restrict__ K,const bf16*__restrict__ V,bf16*O,const unsigned*__restrict__ SEL,char*shm,int wave){
  const int lane=fresh_lane(),wid=wave,tid=wid*64+lane,r32=lane&31,hi=lane>>5; (void)tid;
  const long rowbase=(long)b*SEQ; const int q0=qb*QB;
  const bf16*Qw=Q+(rowbase+q0+wid*QBLK)*DM+h*D;
  const bf16*Kh=K+rowbase*DM+h*D,*Vh=V+rowbase*DM+h*D;
  const unsigned lds0=(unsigned)(uintptr_t)shm;
  float*wsf=(float*)(shm+LDS_WS)+wid*64;
  const bf16*ksrc=Kh+(long)lane*DM+wid*8;
  const bf16*vsrc=Vh+(long)(16*(wid&3)+(lane>>2))*DM+(wid>>2)*32+(lane&3)*8;
  const unsigned kdst=lds0+LDS_K+wid*1024, vdst=lds0+LDS_V+wid*1024;
  #define DMA_K(t,slot) glds16(ksrc+(long)(t)*KVBLK*DM,(unsigned)__builtin_amdgcn_readfirstlane(kdst+(slot)))
  #define DMA_V(t,slot) glds16(vsrc+(long)(t)*KVBLK*DM,(unsigned)__builtin_amdgcn_readfirstlane(vdst+(slot)))
  const int vb0=(int)(lds0+LDS_V)+((lane>>4)&1)*32+(lane&3)*8+(4*hi+((lane&15)>>2))*64;
  const char*Kbase=shm+LDS_K; bf16x8 kf[8];
  const lds_cptr shm3=(lds_cptr)shm; const lds_cptr kp0=shm3+LDS_K+hi*1024+r32*16; const lds_cptr vp0=shm3+LDS_V+((lane>>4)&1)*32+(lane&3)*8+(4*hi+((lane&15)>>2))*64;
  const int NT=(q0+QB)/KVBLK;
  DMA_K(0,0);DMA_V(0,0);DMA_K(1,SLOTB);
  bf16x8 qr[4];
  #pragma unroll
  for(int d0=0;d0<4;++d0)qr[d0]=*reinterpret_cast<const bf16x8*>(&Qw[(long)r32*DM+d0*16+hi*8]);
  float mhat=0.f,l_reg=0.f;f32x16 o[2];o[0]=f32x16{};o[1]=f32x16{};
  const int qrel=wid*QBLK+r32;
  #define SELW() ((volatile __attribute__((address_space(3))) unsigned*)(lds_cptr)((const char*)wsf)+32+r32)
  if(hi==0)*SELW()=SEL[(rowbase+q0+qrel)*NHEAD+h];
  asm volatile("s_waitcnt vmcnt(0) lgkmcnt(0)":::"memory");
  #define CMASK(P0,P1,t) do{int jb_=(t)-(NT-4); if(jb_>=0)cmask(P0,P1,jb_,qrel,hi); else if(MOBA_MASK_ON && !(((*SELW())>>((t)>>2))&1u)){ _Pragma("unroll") for(int r_=0;r_<16;++r_){P0[r_]=-INFINITY;P1[r_]=-INFINITY;} } }while(0)
  bool resc=false;
  #define START(P0,P1) do{ const float rm=rowmax(P0,P1); resc=false; \
    { const float dl=max2f(rm,-100.f); mhat=fadd_s(mhat,dl); \
      _Pragma("unroll") for(int r=0;r<16;++r){P0[r]=fsub_s(P0[r],dl);P1[r]=fsub_s(P1[r],dl);} \
      } \
    _Pragma("unroll") for(int r=0;r<16;++r)P0[r]=__builtin_amdgcn_exp2f(P0[r]); }while(0)
  #define RESC() do{ if(resc){ asm volatile("s_waitcnt lgkmcnt(0)":::"memory"); \
      _Pragma("unroll") for(int d_=0;d_<2;++d_) _Pragma("unroll") for(int r=0;r<16;++r)o[d_][r]*=wsf[crow(r,hi)]; } }while(0)
  f32x16 pA0,pA1,pB0,pB1;
  int sl_prev=0,sl_cur=0,sl_next=SLOTB;
  #define ROT() do{sl_prev=sl_cur;sl_cur=sl_next;sl_next=(sl_next==(NSLOT-1)*SLOTB)?0:sl_next+SLOTB;}while(0)
  DMA_K(2,2*SLOTB);
  WAIT_BAR(3);
  qkt(pA0,pA1,Kbase,qr,r32,hi);asm volatile("s_nop 15\n\ts_nop 7":"+v"(pA0),"+v"(pA1));CMASK(pA0,pA1,0);
  START(pA0,pA1);
  _Pragma("unroll") for(int r=0;r<16;++r)pA1[r]=__builtin_amdgcn_exp2f(pA1[r]);
  WAIT_BAR(0);
  DMA_K(3,0);DMA_V(1,SLOTB);
  ROT();
  kload8(kf,kp0+sl_cur);
  WAIT_BAR(2);
  s16x4 vlo[8],vhi[8]; u32x4 pw0,pw1,pw2,pw3;
  #define PKW(P,B) cvtpk_s(P[B],P[B+1])
  #define PAF(k) __builtin_bit_cast(bf16x8,pw##k)
  #define VFR(i) (bf16x8){vlo[i][0],vlo[i][1],vlo[i][2],vlo[i][3],vhi[i][0],vhi[i][1],vhi[i][2],vhi[i][3]}
  #define PIN(x) asm volatile("":"+v"(x))
  #define MX3(a,b,c) __builtin_fmaxf(__builtin_fmaxf((a),(b)),(c))
  #define GAPA(MF,A0,A1,A2,A3,W0,W1,PW) do{ MF; sacc+=A0; sacc+=A1; sacc+=A2; sacc+=A3; PIN(sacc); W0; W1; PIN(PW); SBAR(); }while(0)
  #define EX(v) __builtin_amdgcn_exp2f(v)
  #define GAPB(MF,X,B) do{ MF; X[B]=EX(X[B]); X[B+1]=EX(X[B+1]); X[B+2]=EX(X[B+2]); X[B+3]=EX(X[B+3]); PIN(X); SBAR(); }while(0)
  #define VRD(i) do{ vlo[i]=vtr(vp_+(((i)>>2)*4096+((i)&3)*1024)); vhi[i]=vtr(vp_+(((i)>>2)*4096+((i)&3)*1024+512)); }while(0)
  #define KRD(G,j) do{ if(G){ kload2(kf,kp0+sl_next,j); SBAR(); } }while(0)
  #define STEP(C0,C1,P0,P1,t,GK,GV,GL) do{ SBAR(); \
    const lds_cptr vp_=vp0+sl_prev; \
    VRD(0); SBAR(); float sacc=(P0[0]+P0[1]); \
    GAPA(C0=__builtin_amdgcn_mfma_f32_32x32x16_bf16(kf[0],qr[0],f32x16{},0,0,0), P0[2],P0[3],P0[4],P0[5],     pw0[0]=PKW(P0,0), pw0[1]=PKW(P0,2), pw0); \
    VRD(4); SBAR(); GAPA(C1=__builtin_amdgcn_mfma_f32_32x32x16_bf16(kf[1],qr[0],f32x16{},0,0,0), P0[6],P0[7],P0[8],P0[9],     pw0[2]=PKW(P0,4), pw0[3]=PKW(P0,6), pw0); \
    VRD(1); SBAR(); GAPA(C0=__builtin_amdgcn_mfma_f32_32x32x16_bf16(kf[2],qr[1],C0,0,0,0),   P0[10],P0[11],P0[12],P0[13], pw1[0]=PKW(P0,8), pw1[1]=PKW(P0,10), pw1); \
    VRD(5); SBAR(); GAPA(C1=__builtin_amdgcn_mfma_f32_32x32x16_bf16(kf[3],qr[1],C1,0,0,0),   P0[14],P0[15],P1[0],P1[1],   pw1[2]=PKW(P0,12),pw1[3]=PKW(P0,14), pw1); \
    VRD(2); SBAR(); GAPA(C0=__builtin_amdgcn_mfma_f32_32x32x16_bf16(kf[4],qr[2],C0,0,0,0),   P1[2],P1[3],P1[4],P1[5],     pw2[0]=PKW(P1,0), pw2[1]=PKW(P1,2), pw2); \
    VRD(6); SBAR(); GAPA(C1=__builtin_amdgcn_mfma_f32_32x32x16_bf16(kf[5],qr[2],C1,0,0,0),   P1[6],P1[7],P1[8],P1[9],     pw2[2]=PKW(P1,4), pw2[3]=PKW(P1,6), pw2); \
    VRD(3); SBAR(); GAPA(C0=__builtin_amdgcn_mfma_f32_32x32x16_bf16(kf[6],qr[3],C0,0,0,0),   P1[10],P1[11],P1[12],P1[13], pw3[0]=PKW(P1,8), pw3[1]=PKW(P1,10), pw3); \
    VRD(7); SBAR(); GAPA(C1=__builtin_amdgcn_mfma_f32_32x32x16_bf16(kf[7],qr[3],C1,0,0,0),   P1[14],P1[15],0.f,0.f,       pw3[2]=PKW(P1,12),pw3[3]=PKW(P1,14), pw3); \
    l_reg+=sacc; \
    if(GK){DMA_K((t)+3,sl_cur);} if(GV){DMA_V((t)+1,sl_next);} \
    _Pragma("unroll") for(int r=0;r<16;++r){C0[r]-=mhat;C1[r]-=mhat;} \
    CMASK(C0,C1,t); \
    { float a=MX3(C0[0],C0[1],C1[0]),b=MX3(C0[2],C0[3],C1[1]); a=MX3(a,C1[2],C1[3]); \
      _Pragma("unroll") for(int r=4;r<16;r+=4){a=MX3(a,C0[r],C0[r+1]);b=MX3(b,C0[r+2],C0[r+3]);a=MX3(a,C1[r],C1[r+1]);b=MX3(b,C1[r+2],C1[r+3]);} \
      float rm=__builtin_fmaxf(a,b); { auto rr=__builtin_amdgcn_permlane32_swap(__float_as_uint(rm),__float_as_uint(rm),false,false); rm=__builtin_fmaxf(__uint_as_float(rr[0]),__uint_as_float(rr[1])); } \
      resc=false; \
      if(__builtin_expect(__any(rm>(float)THRL),0)){ const float dl=__builtin_fmaxf(rm,0.f); mhat+=dl; \
        _Pragma("unroll") for(int r=0;r<16;++r){C0[r]-=dl;C1[r]-=dl;} \
        const float f=__builtin_amdgcn_exp2f(-dl); l_reg*=f; if(hi==0)wsf[r32]=f; resc=true; } } \
    SBAR(); \
    GAPB(o[0]=__builtin_amdgcn_mfma_f32_32x32x16_bf16(PAF(0),VFR(0),o[0],0,0,0), C0,0); \
    GAPB(o[1]=__builtin_amdgcn_mfma_f32_32x32x16_bf16(PAF(0),VFR(4),o[1],0,0,0), C0,4); \
    KRD(GL,0); GAPB(o[0]=__builtin_amdgcn_mfma_f32_32x32x16_bf16(PAF(1),VFR(1),o[0],0,0,0), C0,8); \
    KRD(GL,1); GAPB(o[1]=__builtin_amdgcn_mfma_f32_32x32x16_bf16(PAF(1),VFR(5),o[1],0,0,0), C0,12); \
    KRD(GL,2); GAPB(o[0]=__builtin_amdgcn_mfma_f32_32x32x16_bf16(PAF(2),VFR(2),o[0],0,0,0), C1,0); \
    KRD(GL,3); GAPB(o[1]=__builtin_amdgcn_mfma_f32_32x32x16_bf16(PAF(2),VFR(6),o[1],0,0,0), C1,4); \
    GAPB(o[0]=__builtin_amdgcn_mfma_f32_32x32x16_bf16(PAF(3),VFR(3),o[0],0,0,0), C1,8); \
    GAPB(o[1]=__builtin_amdgcn_mfma_f32_32x32x16_bf16(PAF(3),VFR(7),o[1],0,0,0), C1,12); \
    }while(0)
  int t=1;
  for(;t+5<NT;t+=2){
    STEP(pB0,pB1,pA0,pA1,t,true,true,true);     WAIT_BAR(2); RESC(); ROT();
    STEP(pA0,pA1,pB0,pB1,t+1,true,true,true);   WAIT_BAR(2); RESC(); ROT();
  }
  #undef CMASK
  #define CMASK(P0,P1,t) do{int jb_=(t)-(NT-4); if(jb_>=0)cmask(P0,P1,jb_,qrel,hi); else if(MOBA_MASK_ON && !(((*SELW())>>((t)>>2))&1u)){ _Pragma("unroll") for(int r_=0;r_<16;++r_){P0[r_]=-INFINITY;P1[r_]=-INFINITY;} } }while(0)
  #define ENDW(tt) do{ if((tt)+3<NT){WAIT_BAR(2);} else if((tt)+2<NT){WAIT_BAR(1);} else {WAIT_BAR(0);} }while(0)
  for(;t+1<NT;t+=2){
    STEP(pB0,pB1,pA0,pA1,t,(t+3<NT),(t+1<NT),(t+1<NT));       ENDW(t);   RESC(); ROT();
    STEP(pA0,pA1,pB0,pB1,t+1,(t+4<NT),(t+2<NT),(t+2<NT));     ENDW(t+1); RESC(); ROT();
  }
  STEP(pB0,pB1,pA0,pA1,NT-1,false,false,false); RESC();
  { float sacc=pB0[0]+pB0[1]; _Pragma("unroll") for(int r=2;r<16;++r)sacc+=pB0[r]; _Pragma("unroll") for(int r=0;r<16;++r)sacc+=pB1[r]; l_reg+=sacc;
    pw0=(u32x4){PKW(pB0,0),PKW(pB0,2),PKW(pB0,4),PKW(pB0,6)};pw1=(u32x4){PKW(pB0,8),PKW(pB0,10),PKW(pB0,12),PKW(pB0,14)};pw2=(u32x4){PKW(pB1,0),PKW(pB1,2),PKW(pB1,4),PKW(pB1,6)};pw3=(u32x4){PKW(pB1,8),PKW(pB1,10),PKW(pB1,12),PKW(pB1,14)};
    SBAR(); pv(o,vb0+sl_cur,PAF(0),PAF(1),PAF(2),PAF(3)); }
  #undef PKW
  #undef PAF
  #undef VFR
  #undef PIN
  #undef MX3
  #undef GAPA
  #undef GAPB
  #undef EX
  #undef VRD
  #undef KRD
  #undef STEP
  #undef ENDW
  {auto rr=__builtin_amdgcn_permlane32_swap(__float_as_uint(l_reg),__float_as_uint(l_reg),false,false);l_reg=__uint_as_float(rr[0])+__uint_as_float(rr[1]);}
  if(hi==0)wsf[32+r32]=l_reg;asm volatile("s_waitcnt lgkmcnt(0)":::"memory");
  float rli[16];
  #pragma unroll
  for(int r=0;r<16;++r)rli[r]=__builtin_amdgcn_rcpf(wsf[32+crow(r,hi)]);
  bf16*Ow=O+(rowbase+q0+wid*QBLK)*DM+h*D;
  { bf16*stg=(bf16*)(shm+LDS_OST)+wid*2048;
    #pragma unroll
    for(int r=0;r<16;++r){const int orow=crow(r,hi);
      #pragma unroll
      for(int d0=0;d0<2;++d0)stg[orow*64+d0*32+r32]=__float2bfloat16(o[d0][r]*rli[r]);}
    asm volatile("s_waitcnt lgkmcnt(0)":::"memory");
    #pragma unroll
    for(int i=0;i<4;++i){const int row=i*8+(lane>>3),ch=lane&7; const u32x4 v=*(const u32x4*)(stg+row*64+ch*8); ATTN_STORE16(Ow+(long)row*DM+ch*8,v);} }
  asm volatile("s_waitcnt lgkmcnt(0)\n\ts_barrier":::"memory");
  #undef SELW
  #undef DMA_K
  #undef DMA_V
  #undef CMASK
  #undef START
  #undef RESC
  #undef ROT
}
constexpr int ATTN_LDS_BYTES=LDS_BYTES;
struct AttnTensors { const bf16* Q; const bf16* K; const bf16* V; bf16* O; const unsigned* SEL; };
struct AttnUnit { int bh; int qb; };
struct StaticOrder {
  int vcu;
  __device__ __forceinline__ explicit StaticOrder(int grid,int block):vcu((block%8)*(grid/8)+block/8){}
  __device__ __forceinline__ bool next(int i,AttnUnit&u)const{ if(i>=4)return false; const int s=vcu&7; u.bh=vcu>>3; u.qb=(i==0)?s:(i==1)?15-s:(i==2)?16+s:31-s; return true; }
  __device__ __forceinline__ void a_ready(const AttnUnit&)const{}
  __device__ __forceinline__ void done(const AttnUnit&)const{}
};
template<class Sched,int THRL=8> __device__ __forceinline__ void attn_phase(char*lds,const AttnTensors&T,const Sched&S,int wave){
  AttnUnit u;
  for(int i=0;S.next(i,u);++i){ S.a_ready(u); attn_unit<THRL>(u.bh/NHEAD,u.bh%NHEAD,u.qb,T.Q,T.K,T.V,T.O,T.SEL,lds,wave); S.done(u); }
}
#undef SBAR
#undef WAIT_BAR
}

constexpr int NWAVES = 8;
constexpr int BATCH = 2, T = 8192, D = 1024, H = 16, HD = 64, M = BATCH * T;
constexpr int FF = 2816, FFE = 3584, NE = 8, MOE_ROWS = 34816  ;
constexpr float MOE_WSCALE = 64.f;
constexpr float LN_EPS = 1e-5f, GN_EPS = 64e-5f, ALPHA = 1.6817928305074292f  ;
constexpr size_t MiB = 1u << 20;
constexpr size_t WS_CTL = 0, CTL_ZERO_BYTES = 1 * MiB;
constexpr size_t WS_KMEAN = 1 * MiB;
constexpr size_t WS_SEL = 2 * MiB;
constexpr size_t WS_TOKE = 3 * MiB;
constexpr size_t WS_TOKW = WS_TOKE + 128 * 1024;
constexpr size_t WS_TOKR = WS_TOKW + 128 * 1024;
constexpr size_t WS_GW = WS_TOKR + 128 * 1024;
constexpr size_t WS_BLKCNT = WS_GW + 256 * 1024;
constexpr size_t WS_WMIX = 16 * MiB;
constexpr size_t WS_WFFN = 32 * MiB;
constexpr size_t WS_H = 200 * MiB;
constexpr size_t WS_HB = 264 * MiB;
constexpr size_t WS_K = 296 * MiB, WS_V = 328 * MiB;
constexpr size_t WS_VFIRST = WS_K;
constexpr size_t WS_Y = WS_V;
constexpr size_t WS_SCR = 360 * MiB;
constexpr size_t WS_END = 896 * MiB;
constexpr size_t RS_XM = WS_SCR;
constexpr size_t RS_KP = WS_SCR, RS_AP = WS_SCR + 32 * MiB, RS_VP = WS_SCR + 64 * MiB, RS_BP = WS_SCR + 96 * MiB;
constexpr size_t RS_RKV = WS_SCR + 192 * MiB;
constexpr size_t RS_PRE = RS_RKV;
constexpr size_t RS_LH = WS_SCR + 288 * MiB;
constexpr size_t RS_YG = RS_LH;
constexpr size_t RS_YGC = WS_SCR + 128 * MiB;
#ifdef WKV_SEQ
constexpr size_t RS_YGX = RS_YG;
#else
constexpr size_t RS_YGX = RS_YGC;
#endif
constexpr size_t RS_DEC = WS_SCR + 320 * MiB;
constexpr size_t RS_AB = WS_SCR + 384 * MiB;
constexpr size_t RS_REC0 = WS_SCR + 224 * MiB, RS_REC1 = WS_SCR + 384 * MiB;
constexpr size_t RS_VG = WS_SCR + 448 * MiB;
constexpr size_t RS_GG = WS_SCR + 480 * MiB;
constexpr size_t BS_Q = WS_SCR, BS_PRE = WS_SCR + 32 * MiB, BS_O = WS_SCR + 96 * MiB;
constexpr size_t BS_PO = WS_SCR + 128 * MiB, BS_ML = WS_SCR + 256 * MiB;
constexpr size_t FS_HID = WS_SCR, FS_PRE = WS_SCR + 88 * MiB;
constexpr size_t ES_XG = WS_SCR, ES_HID = WS_SCR + 68 * MiB, ES_YP = WS_SCR + 306 * MiB, ES_YS = WS_SCR + 442 * MiB;
static_assert(RS_GG + 32 * MiB <= WS_END && ES_YS + 56 * MiB <= WS_END && FS_PRE + 64 * MiB <= WS_END, "d_ws map");
constexpr size_t RW_LSTRIDE = 872 * MiB - WS_WMIX;
constexpr size_t WM_BT1 = WS_WMIX, WM_BT2 = WS_WMIX + 8 * MiB, WM_OUT = WS_WMIX + 10 * MiB;
constexpr size_t WM_QKV = WS_WMIX, WM_O = WS_WMIX + 8 * MiB;
constexpr size_t WF_GU = WS_WFFN + 56 * MiB, WF_DN = WS_WFFN + 68 * MiB;
constexpr size_t WE_GU = WS_WFFN, WE_DN = WS_WFFN + 112 * MiB;
constexpr int CW_TMO = 0, CW_CODE = 1, CW_QCTR = 2048  , CW_BAR = 4096;
constexpr int RING_OFF = 0, RING_BYTES = 131072;
constexpr int LDSCTL_OFF = RING_BYTES, MISC_OFF = LDSCTL_OFF + 320;
constexpr int LDS_BYTES = 147456;
static_assert(MISC_OFF + 128 <= LDS_BYTES, "LDS map");

#define GAS __attribute__((address_space(1)))
#define LAS __attribute__((address_space(3)))
typedef unsigned short bf16;
typedef unsigned v4u __attribute__((ext_vector_type(4)));
typedef float f32x4 __attribute__((ext_vector_type(4)));
typedef short bf16x8 __attribute__((ext_vector_type(8)));
typedef GAS unsigned gu32;
typedef GAS unsigned long long gu64;
#define RLX_AGENT __ATOMIC_RELAXED, __HIP_MEMORY_SCOPE_AGENT
#define LDS_WAIT() asm volatile("s_waitcnt lgkmcnt(0)" ::: "memory")
#define VM_WAIT() asm volatile("s_waitcnt vmcnt(0)" ::: "memory")
__device__ __forceinline__ unsigned long long rt() { return __builtin_amdgcn_s_memrealtime(); }
__device__ __forceinline__ unsigned f2bf(float f) { unsigned u = __builtin_bit_cast(unsigned, f); return (u + 0x7fffu + ((u >> 16) & 1u)) >> 16; }
__device__ __forceinline__ unsigned pk2(float lo, float hi) { return f2bf(lo) | (f2bf(hi) << 16); }

#define XB_TMO      128
#define XB_XCNT(j)  (256  + 64 * (j))
#define XB_XSUB(j)  (1280 + 64 * (j))
#define XB_XGEN(j)  (2304 + 64 * (j))
#define XB_TOP      3328
#define XB_TOPGEN   3392
#define XCD_BAR_WORDS 3456
#define XB_SPIN_CAP (1u << 18)

__device__ __forceinline__ unsigned xb_ld(unsigned* p)              { return __hip_atomic_load(p, __ATOMIC_RELAXED, __HIP_MEMORY_SCOPE_AGENT); }
__device__ __forceinline__ unsigned xb_add(unsigned* p, unsigned v) { return __hip_atomic_fetch_add(p, v, __ATOMIC_RELAXED, __HIP_MEMORY_SCOPE_AGENT); }
__device__ __forceinline__ unsigned xb_xcc_id() { return (unsigned)__builtin_amdgcn_s_getreg((3 << 11) | 20) & 0xFu; }
#define XB_SPIN(cond, bar) do { unsigned _sp = 0; while (cond) { __builtin_amdgcn_s_sleep(1); \
    if ((++_sp & 255u) == 0u) { if (xb_ld(&(bar)[XB_TMO])) break; if (_sp > XB_SPIN_CAP) { atomicAdd(&(bar)[XB_TMO], 1u); break; } } } } while (0)

struct XcdBarrier {
    unsigned* bar; unsigned x;
    volatile LAS unsigned* st;
};

__device__ __forceinline__ XcdBarrier xcd_barrier_post(unsigned* bar, volatile LAS unsigned* st, bool t0  ) {
    XcdBarrier b; b.bar = bar; b.x = xb_xcc_id(); b.st = st;
    if (t0) (void)xb_add(&bar[XB_XCNT(b.x)], 1u);
    return b;
}
__device__ __forceinline__ void xcd_barrier_complete(unsigned* bar, unsigned x, unsigned& nloc, unsigned& nx) {
    const unsigned G = gridDim.x * gridDim.y * gridDim.z;
    unsigned sum, cnt, mine, sp = 0u;
    for (;;) {
        sum = 0u; cnt = 0u; mine = 0u;
#pragma unroll
        for (unsigned j = 0; j < 16; ++j) { const unsigned c = xb_ld(&bar[XB_XCNT(j)]); sum += c; cnt += (c > 0u) ? 1u : 0u; mine = (j == x) ? c : mine; }
        if (sum == G) break;
        __builtin_amdgcn_s_sleep(1);
        if ((++sp & 255u) == 0u) { if (xb_ld(&bar[XB_TMO])) break; if (sp > XB_SPIN_CAP) { atomicAdd(&bar[XB_TMO], 1u); break; } }
    }
    nloc = mine > 0u ? mine : 1u; nx = cnt > 0u ? cnt : 1u;
}

__device__ __forceinline__ void xcd_barrier(const XcdBarrier& b, bool t0  ) {
    asm volatile("s_waitcnt vmcnt(0)" ::: "memory");
    __syncthreads();
    if (t0) {
        unsigned* bar = b.bar;
        __builtin_amdgcn_s_waitcnt(0);
        unsigned nloc = b.st[0], nx = b.st[1];
        if (nloc == 0u) { xcd_barrier_complete(bar, b.x, nloc, nx); b.st[0] = nloc; b.st[1] = nx; }
        const unsigned old = xb_add(&bar[XB_XSUB(b.x)], 1u);
        const unsigned gen = old / nloc;
        if (old + 1u == (gen + 1u) * nloc) {
            __builtin_amdgcn_fence(__ATOMIC_RELEASE, "agent");
            asm volatile("s_waitcnt vmcnt(0)" ::: "memory");
            const unsigned og = xb_add(&bar[XB_TOP], 1u);
            const unsigned tg = og / nx;
            if (og + 1u == (tg + 1u) * nx) xb_add(&bar[XB_TOPGEN], 1u);
            else XB_SPIN(xb_ld(&bar[XB_TOPGEN]) == tg, bar);
#ifdef XB_L2_INV
            __builtin_amdgcn_fence(__ATOMIC_ACQUIRE, "");
#else
            __builtin_amdgcn_fence(__ATOMIC_ACQUIRE, "agent");
#endif
            xb_add(&bar[XB_XGEN(b.x)], 1u);
            asm volatile("s_waitcnt vmcnt(0)" ::: "memory");
        } else {
            XB_SPIN(xb_ld(&bar[XB_XGEN(b.x)]) == gen, bar);
            __builtin_amdgcn_fence(__ATOMIC_ACQUIRE, "agent");
            asm volatile("s_waitcnt vmcnt(0)" ::: "memory");
        }
    }
    __syncthreads();
}

struct Args { const float* in[33]; float* out; unsigned char* ws; };
enum InIdx { I_X = 0, I_MU, I_WRKV, I_WOUT, I_W0, I_W1, I_W2, I_A0, I_A1, I_A2, I_V0, I_V1, I_V2, I_G1, I_G2, I_KK, I_KA, I_RK, I_GNG, I_GNB,
             I_MK, I_MV, I_MQ, I_MO, I_FG, I_FU, I_FD, I_ROUTER, I_EG, I_EU, I_ED, I_LNG, I_LNB };
struct Frame {
    LAS unsigned char* lds; volatile LAS unsigned* MISC; gu32* ctl; unsigned char* ws;
    int tid, lane, wave, vcu, G, gw, NGW;
};
typedef float f32x2 __attribute__((ext_vector_type(2)));
typedef unsigned u32x2 __attribute__((ext_vector_type(2)));
__device__ __forceinline__ float dpp_sum16(float v) {
    v += __builtin_bit_cast(float, __builtin_amdgcn_update_dpp(0, __builtin_bit_cast(int, v), 0xB1, 0xF, 0xF, true));
    v += __builtin_bit_cast(float, __builtin_amdgcn_update_dpp(0, __builtin_bit_cast(int, v), 0x4E, 0xF, 0xF, true));
    v += __builtin_bit_cast(float, __builtin_amdgcn_update_dpp(0, __builtin_bit_cast(int, v), 0x141, 0xF, 0xF, true));
    v += __builtin_bit_cast(float, __builtin_amdgcn_update_dpp(0, __builtin_bit_cast(int, v), 0x140, 0xF, 0xF, true));
    return v;
}
__device__ __forceinline__ float wave_sum(float v, int lane) {
    v = dpp_sum16(v);
    v += __builtin_bit_cast(float, __builtin_amdgcn_ds_bpermute((lane ^ 16) << 2, __builtin_bit_cast(int, v)));
    v += __builtin_bit_cast(float, __builtin_amdgcn_ds_bpermute((lane ^ 32) << 2, __builtin_bit_cast(int, v)));
    return v;
}
__device__ __forceinline__ float sum16(float v) { return dpp_sum16(v); }
__device__ __forceinline__ float bf2f(unsigned short b) { return __uint_as_float((unsigned)b << 16); }
__device__ __forceinline__ f32x4 bf4_to_f32(u32x2 w) { f32x4 r; r.x = __uint_as_float(w.x << 16); r.y = __uint_as_float(w.x & 0xffff0000u); r.z = __uint_as_float(w.y << 16); r.w = __uint_as_float(w.y & 0xffff0000u); return r; }
__device__ __forceinline__ u32x2 f32_to_bf4(f32x4 v) { u32x2 w; w.x = pk2(v.x, v.y); w.y = pk2(v.z, v.w); return w; }

__device__ __forceinline__ void tr_item(const float* W, int ldw, int Kr, int Nr, int nblk, bf16* WT, int ldt, int row0, int mode, LAS float* scr, int item, int lane) {
    const int kb = item / nblk, nb = item - kb * nblk, k0 = 64 * kb, n0 = 32 * nb;
    const int kg = lane >> 3, n = n0 + 4 * (lane & 7), kk = k0 + 8 * kg;
    f32x4 v[8];
#pragma unroll
    for (int i = 0; i < 8; ++i) { v[i] = (f32x4){0.f, 0.f, 0.f, 0.f}; if (kk + i < Kr && n < Nr) v[i] = *(const f32x4*)(W + (size_t)(kk + i) * ldw + n); }
#pragma unroll
    for (int e = 0; e < 4; ++e) { const int nn = n + e; const int drow = mode == 0 ? row0 + nn : row0 + ((nn >> 7) << 8) + (nn & 127);
        v4u o; o.x = pk2(v[0][e], v[1][e]); o.y = pk2(v[2][e], v[3][e]); o.z = pk2(v[4][e], v[5][e]); o.w = pk2(v[6][e], v[7][e]);
        *(GAS v4u*)(WT + (size_t)drow * ldt + kk) = o; }
}
__device__ __forceinline__ void tr_item8(const float* W, int ldw, int Kr, int Nr, int nblk, unsigned char* WT, int ldt, int row0, int mode, float scale, int item, int lane) {
    const int kb = item / nblk, nb = item - kb * nblk, k0 = 64 * kb, n0 = 32 * nb;
    const int kg = lane >> 3, n = n0 + 4 * (lane & 7), kk = k0 + 8 * kg;
    f32x4 v[8];
#pragma unroll
    for (int i = 0; i < 8; ++i) { v[i] = (f32x4){0.f, 0.f, 0.f, 0.f}; if (kk + i < Kr && n < Nr) v[i] = *(const f32x4*)(W + (size_t)(kk + i) * ldw + n) * scale; }
#pragma unroll
    for (int e = 0; e < 4; ++e) { const int nn = n + e; const int drow = mode == 0 ? row0 + nn : row0 + ((nn >> 7) << 8) + (nn & 127);
        int lo = __builtin_amdgcn_cvt_pk_fp8_f32(v[0][e], v[1][e], 0, false); lo = __builtin_amdgcn_cvt_pk_fp8_f32(v[2][e], v[3][e], lo, true);
        int hi = __builtin_amdgcn_cvt_pk_fp8_f32(v[4][e], v[5][e], 0, false); hi = __builtin_amdgcn_cvt_pk_fp8_f32(v[6][e], v[7][e], hi, true);
        u32x2 o; o.x = (unsigned)lo; o.y = (unsigned)hi; *(GAS u32x2*)(WT + (size_t)drow * ldt + kk) = o; }
}
#define KIN(i) ({ const __attribute__((address_space(4))) char* k_ = (const __attribute__((address_space(4))) char*)__builtin_amdgcn_kernarg_segment_ptr(); asm volatile("" : "+s"(k_)); const GAS float* g_ = (const GAS float*)(*(const float* const __attribute__((address_space(4)))*)(k_ + 8 * (i))); asm volatile("" : "+s"(g_)); (const float*)g_; })
#define CONV_BEGIN() F.lane = fresh_lane(); F.tid = F.wave * 64 + F.lane; asm volatile("" : "+s"(F.G), "+s"(F.wave), "+s"(F.vcu), "+s"(F.gw), "+s"(F.NGW)); GAS unsigned char* cws0_ = (GAS unsigned char*)F.ws; asm volatile("" : "+s"(cws0_)); unsigned char* cws_ = (unsigned char*)cws0_; LAS float* scr_ = (LAS float*)(F.lds + RING_OFF + F.wave * 16384); int it_ = F.gw, base_ = 0
#define JOB(W, ldw, Kr, Nr, Kp, Np, WT, ldt, row0, mode) do { const int nblk_ = (Np) / 32, n_ = ((Kp) / 64) * nblk_; \
    while (it_ < base_ + n_) { tr_item((W), (ldw), (Kr), (Nr), nblk_, (WT), (ldt), (row0), (mode), scr_, it_ - base_, F.lane); it_ += F.NGW; } base_ += n_; } while (0)
#define JOB8(W, ldw, Kr, Nr, Kp, Np, WT, ldt, row0, mode, scale) do { const int nblk_ = (Np) / 32, n_ = ((Kp) / 64) * nblk_; \
    while (it_ < base_ + n_) { tr_item8((W), (ldw), (Kr), (Nr), nblk_, (WT), (ldt), (row0), (mode), (scale), it_ - base_, F.lane); it_ += F.NGW; } base_ += n_; } while (0)

__device__ __forceinline__ void conv_rwkv(Frame& F, int l) {
    CONV_BEGIN();
    cws_ += (size_t)l * RW_LSTRIDE; bf16* BT1 = (bf16*)(cws_ + WM_BT1); bf16* BT2 = (bf16*)(cws_ + WM_BT2); bf16* WO = (bf16*)(cws_ + WM_OUT);
    for (int c = 0; c < 3; ++c) JOB(KIN(I_WRKV) + (size_t)(l * 3 + c) * D * D, D, D, D, D, D, BT1, D, c * D, 0);
    JOB(KIN(I_W1) + (size_t)l * D * 64, 64, D, 64, D, 256, BT1, D, 3072, 0);
    JOB(KIN(I_A1) + (size_t)l * D * 64, 64, D, 64, D, 256, BT1, D, 3328, 0);
    JOB(KIN(I_V1), 32, D, (l == 0 ? 0 : 32), D, 256, BT1, D, 3584, 0);
    JOB(KIN(I_G1) + (size_t)l * D * 160, 160, D, 160, D, 256, BT1, D, 3840, 0);
    JOB(KIN(I_W2) + (size_t)l * 64 * D, D, 64, D, 256, D, BT2, 256, 0, 0);
    JOB(KIN(I_A2) + (size_t)l * 64 * D, D, 64, D, 256, D, BT2, 256, 1024, 0);
    JOB(KIN(I_V2), D, (l == 0 ? 0 : 32), D, 256, D, BT2, 256, 2048, 0);
    JOB(KIN(I_G2) + (size_t)l * 160 * D, D, 160, D, 256, D, BT2, 256, 3072, 0);
    JOB(KIN(I_WOUT) + (size_t)l * D * D, D, D, D, D, D, WO, D, 0, 0);
}
__device__ __forceinline__ void conv_moba(Frame& F, int j) {
    CONV_BEGIN();
    bf16* WQ = (bf16*)(cws_ + WM_QKV); bf16* WO = (bf16*)(cws_ + WM_O);
    JOB(KIN(I_MQ) + (size_t)j * D * D, D, D, D, D, D, WQ, D, 0, 0);
    if (j == 0) { JOB(KIN(I_MK), D, D, D, D, D, WQ, D, D, 0); JOB(KIN(I_MV), D, D, D, D, D, WQ, D, 2 * D, 0); }
    JOB(KIN(I_MO) + (size_t)j * D * D, D, D, D, D, D, WO, D, 0, 0);
}
__device__ __forceinline__ void conv_dense(Frame& F, int e) {
    CONV_BEGIN();
    bf16* GU = (bf16*)(cws_ + WF_GU); bf16* DN = (bf16*)(cws_ + WF_DN);
    JOB(KIN(I_FG) + (size_t)e * D * FF, FF, D, FF, D, FF, GU, D, 0, 1);
    JOB(KIN(I_FU) + (size_t)e * D * FF, FF, D, FF, D, FF, GU, D, 128, 1);
    JOB(KIN(I_FD) + (size_t)e * FF * D, D, FF, D, FF, D, DN, FF, 0, 0);
}
__device__ __forceinline__ void conv_moe(Frame& F, int e) {
    CONV_BEGIN();
    bf16* GU = (bf16*)(cws_ + WE_GU); bf16* DN = (bf16*)(cws_ + WE_DN);
    for (int x = 0; x < NE; ++x) {
        JOB8(KIN(I_EG) + (size_t)(e * NE + x) * D * FFE, FFE, D, FFE, D, FFE, (unsigned char*)GU, D, x * 2 * FFE, 1, MOE_WSCALE);
        JOB8(KIN(I_EU) + (size_t)(e * NE + x) * D * FFE, FFE, D, FFE, D, FFE, (unsigned char*)GU, D, x * 2 * FFE + 128, 1, MOE_WSCALE);
        JOB(KIN(I_ED) + (size_t)(e * NE + x) * FFE * D, D, FFE, D, FFE, D, DN, FFE, x * D, 0);
    }
}

__device__ __forceinline__ void ln_stats(const f32x4 (&v)[4], float& mean, float& rstd, int lane) {
    float s = 0.f;
#pragma unroll
    for (int j = 0; j < 4; ++j) s += (v[j].x + v[j].y) + (v[j].z + v[j].w);
    mean = wave_sum(s, lane) * (1.f / D); float s2 = 0.f;
#pragma unroll
    for (int j = 0; j < 4; ++j) { const f32x4 d = v[j] - mean; s2 += (d.x * d.x + d.y * d.y) + (d.z * d.z + d.w * d.w); }
    rstd = 1.f / sqrtf(wave_sum(s2, lane) * (1.f / D) + LN_EPS);
}
template <int SRC, bool ROUTER>
__device__ __forceinline__ void ln_phase(Frame& F, const float* PRE, const float* Hin, const float* YP, const int* tokr, const float* gln, const float* bln,
                                         float* Hout, bf16* HB, const float* router, int* toke, float* tokw, int* blkcnt) {
    LAS int* cnt = (LAS int*)(F.lds + RING_OFF + 131072 - 64);
    if (ROUTER) { if (F.tid < 8) cnt[F.tid] = 0; __syncthreads(); }
    f32x4 g4[4], b4[4];
#pragma unroll
    for (int j = 0; j < 4; ++j) { g4[j] = *(const f32x4*)(gln + 4 * F.lane + 256 * j); b4[j] = *(const f32x4*)(bln + 4 * F.lane + 256 * j); }
    const int rpb = M / F.G, rpw = rpb / NWAVES;
    for (int i = 0; i < rpw; ++i) {
        const int m = blockIdx.x * rpb + F.wave * rpw + i;
        f32x4 v[4];
        if (SRC == 0) {
#pragma unroll
            for (int j = 0; j < 4; ++j) v[j] = *(const f32x4*)(PRE + (size_t)m * D + 4 * F.lane + 256 * j);
        } else {
            const int r0 = tokr[2 * m], r1 = tokr[2 * m + 1];
#pragma unroll
            for (int j = 0; j < 4; ++j) { const int c = 4 * F.lane + 256 * j;
                f32x4 y0, y1;
                if (r0 < 32768) y0 = *(const f32x4*)(YP + (size_t)r0 * D + c); else { y0 = (f32x4){0.f, 0.f, 0.f, 0.f}; for (int s = 0; s < 7; ++s) y0 += *(const f32x4*)(PRE + ((size_t)s * 2048 + (r0 - 32768)) * D + c); }
                if (r1 < 32768) y1 = *(const f32x4*)(YP + (size_t)r1 * D + c); else { y1 = (f32x4){0.f, 0.f, 0.f, 0.f}; for (int s = 0; s < 7; ++s) y1 += *(const f32x4*)(PRE + ((size_t)s * 2048 + (r1 - 32768)) * D + c); }
                v[j] = *(const f32x4*)(Hin + (size_t)m * D + c) * ALPHA + y0 + y1; }
        }
        float mean, rstd; ln_stats(v, mean, rstd, F.lane);
#pragma unroll
        for (int j = 0; j < 4; ++j) { v[j] = (v[j] - mean) * rstd * g4[j] + b4[j];
            *(f32x4*)(Hout + (size_t)m * D + 4 * F.lane + 256 * j) = v[j];
            if (HB) *(u32x2*)(HB + (size_t)m * D + 4 * F.lane + 256 * j) = f32_to_bf4(v[j]); }
        if (ROUTER) {
            float lg[8];
#pragma unroll
            for (int e = 0; e < 8; ++e) lg[e] = 0.f;
#pragma unroll
            for (int j = 0; j < 4; ++j)
#pragma unroll
                for (int q = 0; q < 4; ++q) { const float xv = v[j][q]; const f32x4* rp = (const f32x4*)(router + (size_t)(4 * F.lane + 256 * j + q) * 8); const f32x4 ra = rp[0], rb = rp[1];
                    lg[0] += xv * ra.x; lg[1] += xv * ra.y; lg[2] += xv * ra.z; lg[3] += xv * ra.w; lg[4] += xv * rb.x; lg[5] += xv * rb.y; lg[6] += xv * rb.z; lg[7] += xv * rb.w; }
#pragma unroll
            for (int e = 0; e < 8; ++e) lg[e] = wave_sum(lg[e], F.lane);
            int e0 = 0; float l0 = lg[0];
#pragma unroll
            for (int e = 1; e < 8; ++e) if (lg[e] > l0) { l0 = lg[e]; e0 = e; }
            int e1 = -1; float l1 = -INFINITY;
#pragma unroll
            for (int e = 0; e < 8; ++e) if (e != e0 && lg[e] > l1) { l1 = lg[e]; e1 = e; }
            const float w0 = 1.f / (1.f + __expf(l1 - l0)), w1 = 1.f - w0;
            if (F.lane == 0) { toke[2 * m] = e0; toke[2 * m + 1] = e1; tokw[2 * m] = w0; tokw[2 * m + 1] = w1; atomicAdd((int*)&cnt[e0], 1); atomicAdd((int*)&cnt[e1], 1); }
        }
    }
    if (ROUTER) { __syncthreads(); if (F.tid < 8) blkcnt[blockIdx.x * 8 + F.tid] = cnt[F.tid]; }
}

__device__ __forceinline__ void mix_phase(Frame& F, const float* Hx, const float* mu, bf16* XM) {
    f32x4 mu4[6][4];
#pragma unroll
    for (int c = 0; c < 6; ++c)
#pragma unroll
        for (int j = 0; j < 4; ++j) mu4[c][j] = *(const f32x4*)(mu + c * D + 4 * F.lane + 256 * j);
    for (int m = F.gw; m < M; m += F.NGW) {
        const bool first = (m % T) == 0;
#pragma unroll
        for (int j = 0; j < 4; ++j) { const int c0 = 4 * F.lane + 256 * j;
            const f32x4 x = *(const f32x4*)(Hx + (size_t)m * D + c0);
            f32x4 xp = (f32x4){0.f, 0.f, 0.f, 0.f}; if (!first) xp = *(const f32x4*)(Hx + (size_t)(m - 1) * D + c0);
            const f32x4 xx = xp - x;
#pragma unroll
            for (int c = 0; c < 6; ++c) *(u32x2*)(XM + ((size_t)c * M + m) * D + c0) = f32_to_bf4(x + xx * mu4[c][j]); }
    }
}
__device__ __forceinline__ void prep_phase(Frame& F, int l, const bf16* RKV, const float* AA, const bf16* LH, const float* v0, const float* v2, bf16* VF, const float* k_k, const float* k_a, bf16* KP, bf16* AP, bf16* BP, bf16* VP) {
    f32x4 kk4[4], ka4[4];
#pragma unroll
    for (int j = 0; j < 4; ++j) { kk4[j] = *(const f32x4*)(k_k + 4 * F.lane + 256 * j); ka4[j] = *(const f32x4*)(k_a + 4 * F.lane + 256 * j); }
    for (int m = F.gw; m < M; m += F.NGW) {
#pragma unroll
        for (int j = 0; j < 4; ++j) { const size_t o = (size_t)m * D + 4 * F.lane + 256 * j;
            const f32x4 k = bf4_to_f32(*(const u32x2*)(RKV + (size_t)M * D + o)); const u32x2 vraw = *(const u32x2*)(RKV + (size_t)2 * M * D + o); f32x4 v = bf4_to_f32(vraw);
            const f32x4 a = *(const f32x4*)(AA + o);
            f32x4 kk = k * kk4[j]; const float ss = sum16((kk.x * kk.x + kk.y * kk.y) + (kk.z * kk.z + kk.w * kk.w));
            kk = kk * (1.0f / sqrtf(fmaxf(ss, 1e-24f)));
            const f32x4 kp = k * ((a - 1.0f) * ka4[j] + 1.0f);
            if (l == 0) *(u32x2*)(VF + o) = vraw;
            else {
                f32x4 z = *(const f32x4*)(v0 + 4 * F.lane + 256 * j);
                const bf16* lh = LH + (size_t)m * D + 512;
#pragma unroll 8
                for (int q = 0; q < 32; ++q) z += *(const f32x4*)(v2 + (size_t)q * D + 4 * F.lane + 256 * j) * bf2f(lh[q]);
                f32x4 vg; vg.x = 1.f / (1.f + __expf(-z.x)); vg.y = 1.f / (1.f + __expf(-z.y)); vg.z = 1.f / (1.f + __expf(-z.z)); vg.w = 1.f / (1.f + __expf(-z.w));
                const f32x4 vf = bf4_to_f32(*(const u32x2*)(VF + o)); v = v + (vf - v) * vg; }
            *(u32x2*)(KP + o) = f32_to_bf4(kp); *(u32x2*)(VP + o) = f32_to_bf4(v); *(u32x2*)(AP + o) = f32_to_bf4(-kk); *(u32x2*)(BP + o) = f32_to_bf4(kk * a); }
    }
}
__device__ __forceinline__ void post_phase(Frame& F, const bf16* Y, const bf16* R, const bf16* KP, const bf16* VP, const bf16* GG, const float* r_k, const float* gng, const float* gnb, bf16* YG) {
    f32x4 rk4[4], gg4[4], gb4[4];
#pragma unroll
    for (int j = 0; j < 4; ++j) { rk4[j] = *(const f32x4*)(r_k + 4 * F.lane + 256 * j); gg4[j] = *(const f32x4*)(gng + 4 * F.lane + 256 * j); gb4[j] = *(const f32x4*)(gnb + 4 * F.lane + 256 * j); }
    for (int m = F.gw; m < M; m += F.NGW) {
#pragma unroll
        for (int j = 0; j < 4; ++j) { const size_t o = (size_t)m * D + 4 * F.lane + 256 * j;
            const f32x4 y = bf4_to_f32(*(const u32x2*)(Y + o)), r = bf4_to_f32(*(const u32x2*)(R + o)), g = bf4_to_f32(*(const u32x2*)(GG + o));
            const f32x4 kp = bf4_to_f32(*(const u32x2*)(KP + o)), vp = bf4_to_f32(*(const u32x2*)(VP + o));
            const float mean = sum16((y.x + y.y) + (y.z + y.w)) * (1.f / 64.f); const f32x4 d = y - mean;
            const float var = sum16((d.x * d.x + d.y * d.y) + (d.z * d.z + d.w * d.w)) * (1.f / 64.f);
            const f32x4 rkk = r * kp * rk4[j]; const float bon = sum16((rkk.x + rkk.y) + (rkk.z + rkk.w));
            const f32x4 yn = d * (1.0f / sqrtf(var + GN_EPS)) * gg4[j] + gb4[j] + vp * bon;
            *(u32x2*)(YG + o) = f32_to_bf4(yn * g); }
    }
}
__device__ __forceinline__ float fma_s(float a, float b, float c) { float r; asm("v_fma_f32 %0, %1, %2, %3" : "=v"(r) : "v"(a), "v"(b), "v"(c)); return r; }
__device__ __forceinline__ float mul_s(float a, float b) { float r; asm("v_mul_f32_e32 %0, %1, %2" : "=v"(r) : "v"(a), "v"(b)); return r; }
__device__ __forceinline__ float add_s(float a, float b) { float r; asm("v_add_f32_e32 %0, %1, %2" : "=v"(r) : "v"(a), "v"(b)); return r; }
__device__ __forceinline__ float dot4_s(const f32x4& x, const f32x4& y) { return add_s(fma_s(x.y, y.y, mul_s(x.x, y.x)), fma_s(x.w, y.w, mul_s(x.z, y.z))); }
__device__ __forceinline__ f32x4 upd_s(const f32x4& S, const f32x4& w, const f32x4& b, float sa, const f32x4& k, float v) {
    f32x4 r; r.x = fma_s(S.x, w.x, fma_s(b.x, sa, mul_s(k.x, v))); r.y = fma_s(S.y, w.y, fma_s(b.y, sa, mul_s(k.y, v))); r.z = fma_s(S.z, w.z, fma_s(b.z, sa, mul_s(k.z, v))); r.w = fma_s(S.w, w.w, fma_s(b.w, sa, mul_s(k.w, v))); return r; }
__device__ __forceinline__ void scan_phase(Frame& F, const bf16* R, const float* DEC, const bf16* KP, const bf16* AP, const bf16* BP, const bf16* VP, bf16* Y) {
    constexpr int TS = 32, BUFB = 57600, YB_OFF = 2 * BUFB;
    const int head = F.vcu >> 3, part = F.vcu & 7, b = head >> 4, hh = head & 15;
    const size_t rowb = (size_t)b * T; const int col0 = hh * 64;
    const int tr = F.tid >> 4, pc = F.tid & 15;
    const int tr2 = (F.tid & 255) >> 3, pc2 = F.tid & 7;
    const int rr = F.lane >> 4, q = F.lane & 15, myrow = 8 * part + 4 * F.wave + rr;
    LAS unsigned char* L = F.lds + RING_OFF;
    struct Stg { f32x4 lw; u32x2 rk, ra, rb, rv, rn; v4u lr; };
    Stg g0, g1;
#define SC_LOAD(c, G) do { const int t_ = (c) * TS + tr; const size_t g_ = (rowb + t_) * D + col0 + pc * 4; G.lw = *(const f32x4*)(DEC + g_); G.rk = *(const u32x2*)(KP + g_); G.ra = *(const u32x2*)(AP + g_); \
        G.rb = *(const u32x2*)(BP + g_); G.rv = *(const u32x2*)(VP + g_); G.rn = (u32x2){0u, 0u}; if (t_ + 1 < T) G.rn = *(const u32x2*)(AP + g_ + D); \
        if (F.tid < 256) G.lr = *(const v4u*)(R + (rowb + (size_t)(c) * TS + tr2) * D + col0 + pc2 * 8); } while (0)
#define SC_STORE(bf, G) do { const f32x4 lk_ = bf4_to_f32(G.rk), la_ = bf4_to_f32(G.ra), lb_ = bf4_to_f32(G.rb), lv_ = bf4_to_f32(G.rv), ln_ = bf4_to_f32(G.rn); LAS unsigned char* d_ = L + (bf) * BUFB + tr * 256 + pc * 16; *(LAS f32x4*)(d_) = G.lw; *(LAS f32x4*)(d_ + 8192) = lk_; *(LAS f32x4*)(d_ + 16384) = la_; \
        *(LAS f32x4*)(d_ + 24576) = lb_; *(LAS f32x4*)(d_ + 32768) = lv_; *(LAS f32x4*)(d_ + 49152) = G.lw * ln_; \
        { const f32x4 pb_ = lb_ * ln_, pk_ = lk_ * ln_; const float be_ = dpp_sum16((pb_.x + pb_.y) + (pb_.z + pb_.w)), ga_ = dpp_sum16((pk_.x + pk_.y) + (pk_.z + pk_.w)); \
          if (pc == 0) { *(LAS float*)(L + (bf) * BUFB + 57344 + tr * 4) = be_; *(LAS float*)(L + (bf) * BUFB + 57472 + tr * 4) = ga_; } } \
        if (F.tid < 256) { LAS unsigned char* r_ = L + (bf) * BUFB + 40960 + tr2 * 256 + pc2 * 32; \
            *(LAS f32x4*)(r_) = (f32x4){__uint_as_float(G.lr.x << 16), __uint_as_float(G.lr.x & 0xffff0000u), __uint_as_float(G.lr.y << 16), __uint_as_float(G.lr.y & 0xffff0000u)}; \
            *(LAS f32x4*)(r_ + 16) = (f32x4){__uint_as_float(G.lr.z << 16), __uint_as_float(G.lr.z & 0xffff0000u), __uint_as_float(G.lr.w << 16), __uint_as_float(G.lr.w & 0xffff0000u)}; } } while (0)
    SC_LOAD(0, g0); SC_STORE(0, g0); SC_LOAD(1, g0); __syncthreads();
    f32x4 S = (f32x4){0.f, 0.f, 0.f, 0.f};
    constexpr int NCH = T / TS;
    for (int c2 = 0; c2 < NCH; c2 += 2) {
#pragma unroll
      for (int par = 0; par < 2; ++par) {
        const int c = c2 + par, bf = par;
        if (c + 2 < NCH) { if (par == 0) SC_LOAD(c + 2, g1); else SC_LOAD(c + 2, g0); }
        if (F.wave < 2) {
            const LAS unsigned char* B0 = L + bf * BUFB + q * 16; const LAS unsigned char* Bv = L + bf * BUFB + 32768 + myrow * 4; const LAS unsigned char* Bs = L + bf * BUFB + 57344;
            LAS unsigned short* yb = (LAS unsigned short*)(L + YB_OFF + bf * 512) + q * 8 + 4 * F.wave + rr;
            struct Rnd { f32x4 a, aw, w0, b0, k0, r0, w1, b1, k1, r1; float v0, v1, be, ga; };
#define SC_FETCH(t_, X) do { X.a = *(const LAS f32x4*)(B0 + 16384 + (t_) * 256); X.aw = *(const LAS f32x4*)(B0 + 49152 + (t_) * 256); \
            X.w0 = *(const LAS f32x4*)(B0 + (t_) * 256); X.b0 = *(const LAS f32x4*)(B0 + 24576 + (t_) * 256); X.k0 = *(const LAS f32x4*)(B0 + 8192 + (t_) * 256); X.r0 = *(const LAS f32x4*)(B0 + 40960 + (t_) * 256); \
            X.w1 = *(const LAS f32x4*)(B0 + ((t_) + 1) * 256); X.b1 = *(const LAS f32x4*)(B0 + 24576 + ((t_) + 1) * 256); X.k1 = *(const LAS f32x4*)(B0 + 8192 + ((t_) + 1) * 256); X.r1 = *(const LAS f32x4*)(B0 + 40960 + ((t_) + 1) * 256); \
            X.v0 = *(const LAS float*)(Bv + (t_) * 256); X.v1 = *(const LAS float*)(Bv + ((t_) + 1) * 256); X.be = *(const LAS float*)(Bs + (t_) * 4); X.ga = *(const LAS float*)(Bs + 128 + (t_) * 4); } while (0)
            Rnd cu; float ykeep = 0.f, yra = 0.f, yrb = 0.f;
#define RED_STEP(x, ctl) asm volatile("v_add_f32_dpp %0, %0, %0 " ctl " row_mask:0xf bank_mask:0xf bound_ctrl:1" : "+v"(x))
#define RED_STEP0(x, ctl) asm volatile("s_nop 1\n\tv_add_f32_dpp %0, %0, %0 " ctl " row_mask:0xf bank_mask:0xf bound_ctrl:1" : "+v"(x))
#define RED4(a_, b_, c_, d_) do { \
            RED_STEP0(a_, "quad_perm:[1,0,3,2]"); RED_STEP0(b_, "quad_perm:[1,0,3,2]"); RED_STEP0(c_, "quad_perm:[1,0,3,2]"); RED_STEP0(d_, "quad_perm:[1,0,3,2]"); \
            RED_STEP(a_, "quad_perm:[2,3,0,1]"); RED_STEP(b_, "quad_perm:[2,3,0,1]"); RED_STEP(c_, "quad_perm:[2,3,0,1]"); RED_STEP(d_, "quad_perm:[2,3,0,1]"); \
            RED_STEP(a_, "row_half_mirror"); RED_STEP(b_, "row_half_mirror"); RED_STEP(c_, "row_half_mirror"); RED_STEP(d_, "row_half_mirror"); \
            RED_STEP(a_, "row_mirror"); RED_STEP(b_, "row_mirror"); RED_STEP(c_, "row_mirror"); RED_STEP(d_, "row_mirror"); } while (0)
            SC_FETCH(0, cu);
#pragma unroll
            for (int t = 0; t < TS; t += 2) {
                Rnd nx = cu;
                if (t + 2 < TS) SC_FETCH(t + 2, nx);
                const f32x4 p1 = S * cu.a, p2 = S * cu.aw;
                float u1 = (p1.x + p1.y) + (p1.z + p1.w), u2 = (p2.x + p2.y) + (p2.z + p2.w);
                RED4(u1, u2, yra, yrb);
                if (t > 0) { ykeep = (q == ((t - 2) & 15)) ? yra : ykeep; ykeep = (q == ((t - 1) & 15)) ? yrb : ykeep;
                             if (((t - 1) & 15) == 15) yb[(t - 16) * 8] = (unsigned short)f2bf(ykeep); }
                const float sa0 = u1, sa1 = u2 + sa0 * cu.be + cu.v0 * cu.ga;
                S = S * cu.w0 + (cu.b0 * sa0 + cu.k0 * cu.v0);
                const f32x4 y4a = S * cu.r0;
                S = S * cu.w1 + (cu.b1 * sa1 + cu.k1 * cu.v1);
                const f32x4 y4b = S * cu.r1;
                yra = (y4a.x + y4a.y) + (y4a.z + y4a.w); yrb = (y4b.x + y4b.y) + (y4b.z + y4b.w);
                cu = nx;
            }
            { float d0_ = 0.f, d1_ = 0.f; RED4(yra, yrb, d0_, d1_);
              ykeep = (q == 14) ? yra : ykeep; ykeep = (q == 15) ? yrb : ykeep; yb[16 * 8] = (unsigned short)f2bf(ykeep); }
#undef RED4
#undef RED_STEP0
#undef RED_STEP
#undef SC_FETCH
        }
        if (c + 1 < NCH) { if (par == 0) SC_STORE(1, g0); else SC_STORE(0, g1); }
        __syncthreads();
        if (F.tid < 32) { const v4u yv = *(const LAS v4u*)(L + YB_OFF + bf * 512 + F.tid * 16);
            *(v4u*)(Y + (rowb + (size_t)c * TS + F.tid) * D + col0 + part * 8) = yv; }
      }
    }
#undef SC_LOAD
#undef SC_STORE
}

__device__ __forceinline__ void kmean_phase(Frame& F, const bf16* Kb, float* KM) {
    LAS float* red = (LAS float*)(F.lds + RING_OFF);
    for (int u = blockIdx.x; u < 2 * 32 * 4; u += F.G) {
        const int qc = u & 3, blk = (u >> 2) & 31, b = u >> 7; const int c = F.tid & 255, rh = F.tid >> 8;
        const bf16* p = Kb + ((size_t)b * T + blk * 256 + rh * 128) * D + qc * 256 + c; float s = 0.f;
#pragma unroll 8
        for (int r = 0; r < 128; ++r) s += bf2f(p[(size_t)r * D]);
        if (rh == 1) red[c] = s;
        __syncthreads();
        if (rh == 0) { const int col = qc * 256 + c; KM[(((size_t)b * H + (col >> 6)) * 32 + blk) * 64 + (col & 63)] = (s + red[c]) * (1.f / 256.f); }
        __syncthreads();
    }
}
__device__ __forceinline__ void gate_phase(Frame& F, const bf16* Q, const float* KM, unsigned* SEL) {
    LAS float* km = (LAS float*)(F.lds + RING_OFF);
    for (int u = blockIdx.x; u < M / 64; u += F.G) {
        const int m0 = u * 64, b = m0 / T, own = (m0 % T) >> 8;
        for (int i = F.tid; i < 16 * 32 * 16; i += NWAVES * 64) *(LAS f32x4*)(km + 4 * i) = *(const f32x4*)(KM + (size_t)b * 16 * 32 * 64 + 4 * i);
        __syncthreads();
        const int m = m0 + F.lane;
#pragma unroll 1
        for (int hi = 0; hi < 2; ++hi) { const int h = 2 * F.wave + hi;
            float qv[64];
#pragma unroll
            for (int i = 0; i < 8; ++i) { const v4u w = *(const v4u*)(Q + (size_t)m * D + h * 64 + 8 * i);
                qv[8 * i + 0] = __uint_as_float(w.x << 16); qv[8 * i + 1] = __uint_as_float(w.x & 0xffff0000u); qv[8 * i + 2] = __uint_as_float(w.y << 16); qv[8 * i + 3] = __uint_as_float(w.y & 0xffff0000u);
                qv[8 * i + 4] = __uint_as_float(w.z << 16); qv[8 * i + 5] = __uint_as_float(w.z & 0xffff0000u); qv[8 * i + 6] = __uint_as_float(w.w << 16); qv[8 * i + 7] = __uint_as_float(w.w & 0xffff0000u); }
            float v0 = -INFINITY, v1 = -INFINITY, v2 = -INFINITY; int i0 = -1, i1 = -1, i2 = -1;
            for (int j = 0; j < own; ++j) { const LAS f32x4* kp = (const LAS f32x4*)(km + (h * 32 + j) * 64); float s = 0.f;
#pragma unroll
                for (int i = 0; i < 16; ++i) { const f32x4 kv = kp[i]; s += qv[4 * i] * kv.x + qv[4 * i + 1] * kv.y + qv[4 * i + 2] * kv.z + qv[4 * i + 3] * kv.w; }
                if (s > v0) { v2 = v1; i2 = i1; v1 = v0; i1 = i0; v0 = s; i0 = j; } else if (s > v1) { v2 = v1; i2 = i1; v1 = s; i1 = j; } else if (s > v2) { v2 = s; i2 = j; } }
            unsigned mask = 0u; if (i0 >= 0) mask |= 1u << i0; if (i1 >= 0) mask |= 1u << i1; if (i2 >= 0) mask |= 1u << i2;
            SEL[((size_t)b * H + h) * T + (m % T)] = mask; }
        __syncthreads();
    }
}

__device__ __forceinline__ void moe_prefix(Frame& F, const int* blkcnt, LAS int* pre_mine  ) {
    LAS int* tmp = (LAS int*)(F.lds + RING_OFF);
    for (int i = F.tid; i < F.G * 8; i += NWAVES * 64) tmp[i] = blkcnt[i];
    __syncthreads();
    if (F.tid < 8) { int tot = 0, mine = 0; for (int g = 0; g < F.G; ++g) { if (g == (int)blockIdx.x) mine = tot; tot += tmp[g * 8 + F.tid]; }
        pre_mine[F.tid] = mine; pre_mine[8 + F.tid] = tot; }
    __syncthreads();
    if (F.tid == 0) { int p = 0; for (int e = 0; e < 8; ++e) { F.MISC[16 + e] = (unsigned)p; p += (pre_mine[8 + e] + 255) >> 8; } F.MISC[24] = (unsigned)p; }
    __syncthreads();
}
__device__ __forceinline__ void moe_gather_phase(Frame& F, const int* blkcnt, const int* toke, const float* tokw, int* tokr, float* gw, const float* Hs, unsigned char* XG) {
    LAS int* pm = (LAS int*)(F.lds + RING_OFF + 16384);
    LAS int* rows = (LAS int*)(F.lds + RING_OFF + 16384 + 64);
    moe_prefix(F, blkcnt, pm);
    const int rpb = M / F.G;
    if (F.wave == 0) {
        const int m = blockIdx.x * rpb + F.lane; const bool ok = F.lane < rpb;
        const int e0 = ok ? toke[2 * m] : -1, e1 = ok ? toke[2 * m + 1] : -1;
        int r0 = 0, r1 = 0;
        for (int e = 0; e < 8; ++e) { const unsigned long long b0 = __ballot(e0 == e), b1 = __ballot(e1 == e); const unsigned long long lt = (1ull << F.lane) - 1ull;
            const int base = (int)F.MISC[16 + e] * 256 + pm[e];
            if (e0 == e) r0 = base + __popcll(b0 & lt);
            if (e1 == e) r1 = base + __popcll(b0) + __popcll(b1 & lt); }
        if (ok) { tokr[2 * m] = r0; tokr[2 * m + 1] = r1; gw[r0] = tokw[2 * m]; gw[r1] = tokw[2 * m + 1]; rows[2 * F.lane] = r0; rows[2 * F.lane + 1] = r1; }
    }
    __syncthreads();
    for (int i = F.wave; i < 2 * rpb; i += NWAVES) { const int m = blockIdx.x * rpb + (i >> 1), r = rows[i];
        const f32x4* s = (const f32x4*)(Hs + (size_t)m * D + 16 * F.lane); const f32x4 a = s[0], b_ = s[1], c = s[2], d = s[3];
        v4u o; int w;
        w = __builtin_amdgcn_cvt_pk_fp8_f32(a.x, a.y, 0, false); w = __builtin_amdgcn_cvt_pk_fp8_f32(a.z, a.w, w, true); o.x = (unsigned)w;
        w = __builtin_amdgcn_cvt_pk_fp8_f32(b_.x, b_.y, 0, false); w = __builtin_amdgcn_cvt_pk_fp8_f32(b_.z, b_.w, w, true); o.y = (unsigned)w;
        w = __builtin_amdgcn_cvt_pk_fp8_f32(c.x, c.y, 0, false); w = __builtin_amdgcn_cvt_pk_fp8_f32(c.z, c.w, w, true); o.z = (unsigned)w;
        w = __builtin_amdgcn_cvt_pk_fp8_f32(d.x, d.y, 0, false); w = __builtin_amdgcn_cvt_pk_fp8_f32(d.z, d.w, w, true); o.w = (unsigned)w;
        *(v4u*)(XG + (size_t)r * D + 16 * F.lane) = o; }
    __syncthreads();
}
__device__ __forceinline__ void attn_direct_phase(Frame& F, const bf16* Q, const bf16* Kb, const bf16* Vb, const unsigned* SEL, bf16* O) {
    for (int u = F.gw; u < (M / 64) * H; u += F.NGW) {
        const int h = u & 15, m0 = (u >> 4) * 64, b = m0 / T, t0 = m0 % T, own = t0 >> 8, m = m0 + F.lane, tpos = t0 + F.lane;
        float q[64], o[64];
#pragma unroll
        for (int i = 0; i < 8; ++i) { const v4u w = *(const v4u*)(Q + (size_t)m * D + h * 64 + 8 * i);
            q[8 * i + 0] = __uint_as_float(w.x << 16); q[8 * i + 1] = __uint_as_float(w.x & 0xffff0000u); q[8 * i + 2] = __uint_as_float(w.y << 16); q[8 * i + 3] = __uint_as_float(w.y & 0xffff0000u);
            q[8 * i + 4] = __uint_as_float(w.z << 16); q[8 * i + 5] = __uint_as_float(w.z & 0xffff0000u); q[8 * i + 6] = __uint_as_float(w.w << 16); q[8 * i + 7] = __uint_as_float(w.w & 0xffff0000u); }
#pragma unroll
        for (int i = 0; i < 64; ++i) o[i] = 0.f;
        const unsigned sel = SEL[((size_t)b * H + h) * T + tpos];
        float mrun = -INFINITY, l = 0.f;
        for (int j = 0; j <= own; ++j) {
            const bool pastsel = (sel >> j) & 1u;
            if (j < own && !__any(pastsel)) continue;
            const int nk = (j < own) ? 256 : (t0 & 255) + 64;
            for (int kk = 0; kk < nk; ++kk) {
                const int kpos = j * 256 + kk; const size_t ro = ((size_t)b * T + kpos) * D + h * 64;
                float s = 0.f;
#pragma unroll
                for (int i = 0; i < 8; ++i) { const v4u w = *(const v4u*)(Kb + ro + 8 * i);
                    s += q[8 * i + 0] * __uint_as_float(w.x << 16) + q[8 * i + 1] * __uint_as_float(w.x & 0xffff0000u) + q[8 * i + 2] * __uint_as_float(w.y << 16) + q[8 * i + 3] * __uint_as_float(w.y & 0xffff0000u)
                       + q[8 * i + 4] * __uint_as_float(w.z << 16) + q[8 * i + 5] * __uint_as_float(w.z & 0xffff0000u) + q[8 * i + 6] * __uint_as_float(w.w << 16) + q[8 * i + 7] * __uint_as_float(w.w & 0xffff0000u); }
                const bool act = (j < own) ? pastsel : (kpos <= tpos);
                if (act) {
                    if (s > mrun) { const float c = exp2f(mrun - s); l *= c;
#pragma unroll
                        for (int i = 0; i < 64; ++i) o[i] *= c;
                        mrun = s; }
                    const float p = exp2f(s - mrun); l += p;
#pragma unroll
                    for (int i = 0; i < 8; ++i) { const v4u w = *(const v4u*)(Vb + ro + 8 * i);
                        o[8 * i + 0] += p * __uint_as_float(w.x << 16); o[8 * i + 1] += p * __uint_as_float(w.x & 0xffff0000u); o[8 * i + 2] += p * __uint_as_float(w.y << 16); o[8 * i + 3] += p * __uint_as_float(w.y & 0xffff0000u);
                        o[8 * i + 4] += p * __uint_as_float(w.z << 16); o[8 * i + 5] += p * __uint_as_float(w.z & 0xffff0000u); o[8 * i + 6] += p * __uint_as_float(w.w << 16); o[8 * i + 7] += p * __uint_as_float(w.w & 0xffff0000u); }
                }
            }
        }
        const float rl = 1.0f / l;
#pragma unroll
        for (int i = 0; i < 8; ++i) { v4u w; w.x = pk2(o[8 * i] * rl, o[8 * i + 1] * rl); w.y = pk2(o[8 * i + 2] * rl, o[8 * i + 3] * rl); w.z = pk2(o[8 * i + 4] * rl, o[8 * i + 5] * rl); w.w = pk2(o[8 * i + 6] * rl, o[8 * i + 7] * rl);
            *(v4u*)(O + (size_t)m * D + h * 64 + 8 * i) = w; }
    }
}
namespace moba {
using attn_body::f32x16; using attn_body::crow;
constexpr int L_K = 0, L_V = 32768, L_LIST = 65536, L_WS = 81920, L_CTL = 84992;
__device__ __forceinline__ void qkt_l(f32x16& p0, f32x16& p1, const LAS unsigned char* Kslot, const bf16x8* qr, int r32, int hi) {
    const LAS unsigned char* kb = Kslot + hi * 1024 + r32 * 16;
#pragma unroll
    for (int d0 = 0; d0 < 4; ++d0) {
        const bf16x8 b0 = *(const LAS bf16x8*)(kb + d0 * 2048), b1 = *(const LAS bf16x8*)(kb + d0 * 2048 + 512);
        if (d0 == 0) { p0 = __builtin_amdgcn_mfma_f32_32x32x16_bf16(b0, qr[0], f32x16{}, 0, 0, 0); p1 = __builtin_amdgcn_mfma_f32_32x32x16_bf16(b1, qr[0], f32x16{}, 0, 0, 0); }
        else { p0 = __builtin_amdgcn_mfma_f32_32x32x16_bf16(b0, qr[d0], p0, 0, 0, 0); p1 = __builtin_amdgcn_mfma_f32_32x32x16_bf16(b1, qr[d0], p1, 0, 0, 0); } }
}
__device__ __forceinline__ float half_max(float v) { auto rr = __builtin_amdgcn_permlane32_swap(__float_as_uint(v), __float_as_uint(v), false, false); return fmaxf(__uint_as_float(rr[0]), __uint_as_float(rr[1])); }
__device__ __forceinline__ float half_sum(float v) { auto rr = __builtin_amdgcn_permlane32_swap(__float_as_uint(v), __float_as_uint(v), false, false); return __uint_as_float(rr[0]) + __uint_as_float(rr[1]); }
}
__device__ __forceinline__ void moba_attn_phase(Frame& F, const bf16* Q, const bf16* Kb, const bf16* Vb, const unsigned* SELT, bf16* PO, float* ML, gu32* qctr) {
    using namespace moba;
    const int lane = F.lane, wid = F.wave, r32 = lane & 31, hi = lane >> 5;
    LAS unsigned char* L = F.lds + RING_OFF;
    LAS unsigned short* list = (LAS unsigned short*)(L + L_LIST);
    LAS float* wsf = (LAS float*)(L + L_WS + wid * 256); LAS int* wsd = (LAS int*)(L + L_WS + wid * 256 + 128);
    LAS int* ctl = (LAS int*)(L + L_CTL);
    const int vb0 = RING_OFF + L_V + ((lane >> 4) & 1) * 32 + (lane & 3) * 8 + (4 * hi + ((lane & 15) >> 2)) * 64;
    for (;;) {
        __syncthreads();
        if (F.tid == 0) { ctl[0] = (int)__hip_atomic_fetch_add(qctr, 1u, __ATOMIC_RELAXED, __HIP_MEMORY_SCOPE_AGENT); ctl[1] = 0; }
        __syncthreads();
        const int u = __builtin_amdgcn_readfirstlane(ctl[0]);
        if (u >= 32 * 32) break;
        const int j = u >> 5, bh = u & 31, b = bh >> 4, h = bh & 15;
        const size_t rowb = (size_t)b * T;
        { const bf16* ksrc = Kb + (rowb + 256 * j + lane) * D + h * 64 + wid * 8;
          const bf16* vsrc = Vb + (rowb + 256 * j + 16 * (wid & 3) + (lane >> 2)) * D + h * 64 + (wid >> 2) * 32 + (lane & 3) * 8;
#pragma unroll
          for (int kt = 0; kt < 4; ++kt) { attn_body::glds16(ksrc + (size_t)kt * 64 * D, (unsigned)__builtin_amdgcn_readfirstlane(RING_OFF + L_K + kt * 8192 + wid * 1024));
                                           attn_body::glds16(vsrc + (size_t)kt * 64 * D, (unsigned)__builtin_amdgcn_readfirstlane(RING_OFF + L_V + kt * 8192 + wid * 1024)); } }
        const unsigned* selrow = SELT + (size_t)bh * T;
        for (int t0 = 256 * (j + 1); t0 < T; t0 += NWAVES * 64) { const int t = t0 + F.tid; const bool in = t < T;
            const bool p = in && ((selrow[in ? t : 0] >> j) & 1u);
            const unsigned long long bal = __ballot(p); const int np = __popcll(bal);
            int base = 0; if (lane == 0 && np) base = __hip_atomic_fetch_add(&ctl[1], np, __ATOMIC_RELAXED, __HIP_MEMORY_SCOPE_WORKGROUP);
            base = __builtin_amdgcn_readfirstlane(base);
            if (p) list[base + __popcll(bal & ((1ull << lane) - 1ull))] = (unsigned short)t; }
        asm volatile("s_waitcnt vmcnt(0) lgkmcnt(0)" ::: "memory");
        __syncthreads();
        const int total = 256 + ctl[1], nb = (total + 31) >> 5;
        for (int bi = wid; bi < nb; bi += NWAVES) {
            const int item = bi * 32 + r32; const bool valid = item < total; const int it2 = valid ? item : total - 1;
            const bool ownb = bi < 8;
            const int t = it2 < 256 ? 256 * j + it2 : (int)list[it2 - 256];
            const bf16* qrow = Q + (rowb + t) * D + h * 64;
            bf16x8 qr[4];
#pragma unroll
            for (int d0 = 0; d0 < 4; ++d0) qr[d0] = *(const bf16x8*)(qrow + d0 * 16 + hi * 8);
            f32x16 P[4][2];
#pragma unroll
            for (int kt = 0; kt < 4; ++kt) qkt_l(P[kt][0], P[kt][1], L + L_K + kt * 8192, qr, r32, hi);
            if (ownb) {
#pragma unroll
                for (int kt = 0; kt < 4; ++kt) attn_body::cmask(P[kt][0], P[kt][1], kt, t - 256 * j, hi); }
            float mx = -INFINITY;
#pragma unroll
            for (int kt = 0; kt < 4; ++kt)
#pragma unroll
                for (int r = 0; r < 16; ++r) mx = fmaxf(mx, fmaxf(P[kt][0][r], P[kt][1][r]));
            mx = half_max(mx);
            float ls = 0.f;
#pragma unroll
            for (int kt = 0; kt < 4; ++kt)
#pragma unroll
                for (int r = 0; r < 16; ++r) { P[kt][0][r] = __builtin_amdgcn_exp2f(P[kt][0][r] - mx); P[kt][1][r] = __builtin_amdgcn_exp2f(P[kt][1][r] - mx); ls += P[kt][0][r] + P[kt][1][r]; }
            ls = half_sum(ls);
            f32x16 o[2]; o[0] = f32x16{}; o[1] = f32x16{};
#pragma unroll
            for (int kt = 0; kt < 4; ++kt) {
                attn_body::u32x4 w0, w1, w2, w3;
#define PKW_(P_, B_) attn_body::cvtpk_s(P_[B_], P_[B_ + 1])
                w0 = (attn_body::u32x4){PKW_(P[kt][0], 0), PKW_(P[kt][0], 2), PKW_(P[kt][0], 4), PKW_(P[kt][0], 6)}; w1 = (attn_body::u32x4){PKW_(P[kt][0], 8), PKW_(P[kt][0], 10), PKW_(P[kt][0], 12), PKW_(P[kt][0], 14)};
                w2 = (attn_body::u32x4){PKW_(P[kt][1], 0), PKW_(P[kt][1], 2), PKW_(P[kt][1], 4), PKW_(P[kt][1], 6)}; w3 = (attn_body::u32x4){PKW_(P[kt][1], 8), PKW_(P[kt][1], 10), PKW_(P[kt][1], 12), PKW_(P[kt][1], 14)};
#undef PKW_
                attn_body::pv(o, vb0 + kt * 8192, __builtin_bit_cast(bf16x8, w0), __builtin_bit_cast(bf16x8, w1), __builtin_bit_cast(bf16x8, w2), __builtin_bit_cast(bf16x8, w3)); }
            const unsigned sel = selrow[t];
            const int slot = ownb ? 3 : __popc(sel & ((1u << j) - 1u));
            const int dest = (int)(((rowb + t) * H + h) * 4 + slot);
            if (hi == 0) { wsf[r32] = 1.0f / ls; wsd[r32] = valid ? dest : -1; if (valid) { ML[(size_t)dest * 2] = mx; ML[(size_t)dest * 2 + 1] = ls; } }
            asm volatile("s_waitcnt lgkmcnt(0)" ::: "memory");
#pragma unroll
            for (int r = 0; r < 16; ++r) { const int row = crow(r, hi); const float rl = wsf[row]; const int d = wsd[row];
                if (d >= 0) { PO[(size_t)d * 64 + r32] = (bf16)f2bf(o[0][r] * rl); PO[(size_t)d * 64 + 32 + r32] = (bf16)f2bf(o[1][r] * rl); } }
            asm volatile("s_waitcnt lgkmcnt(0)" ::: "memory");
        }
    }
}
__device__ __forceinline__ void moba_combine_phase(Frame& F, const unsigned* SELT, const bf16* PO, const float* ML, bf16* O) {
    for (int m = F.gw; m < M; m += F.NGW) {
        const int b = m / T, t = m % T, h = F.lane >> 2, qd = F.lane & 3;
        const unsigned sel = SELT[((size_t)b * H + h) * T + t]; const int cnt = __popc(sel);
        const size_t base = ((size_t)m * H + h) * 4;
        float ms[4], ls[4]; float mstar = -INFINITY;
#pragma unroll
        for (int s = 0; s < 4; ++s) { const bool on = (s == 3) || (s < cnt); ms[s] = on ? ML[(base + s) * 2] : -INFINITY; ls[s] = on ? ML[(base + s) * 2 + 1] : 0.f; mstar = fmaxf(mstar, ms[s]); }
        float wsum = 0.f, w[4];
#pragma unroll
        for (int s = 0; s < 4; ++s) { w[s] = ls[s] * __builtin_amdgcn_exp2f(ms[s] - mstar); wsum += w[s]; }
        const float rw = 1.0f / wsum;
        float acc[16];
#pragma unroll
        for (int i = 0; i < 16; ++i) acc[i] = 0.f;
#pragma unroll
        for (int s = 0; s < 4; ++s) { const bool on = (s == 3) || (s < cnt);
            if (on) { const float ws_ = w[s] * rw; const v4u a = *(const v4u*)(PO + (base + s) * 64 + qd * 16), c = *(const v4u*)(PO + (base + s) * 64 + qd * 16 + 8);
                const unsigned wv[8] = {a.x, a.y, a.z, a.w, c.x, c.y, c.z, c.w};
#pragma unroll
                for (int i = 0; i < 8; ++i) { acc[2 * i] += ws_ * __uint_as_float(wv[i] << 16); acc[2 * i + 1] += ws_ * __uint_as_float(wv[i] & 0xffff0000u); } } }
        v4u o0, o1; o0.x = pk2(acc[0], acc[1]); o0.y = pk2(acc[2], acc[3]); o0.z = pk2(acc[4], acc[5]); o0.w = pk2(acc[6], acc[7]); o1.x = pk2(acc[8], acc[9]); o1.y = pk2(acc[10], acc[11]); o1.z = pk2(acc[12], acc[13]); o1.w = pk2(acc[14], acc[15]);
        *(v4u*)(O + (size_t)m * D + h * 64 + qd * 16) = o0; *(v4u*)(O + (size_t)m * D + h * 64 + qd * 16 + 8) = o1;
    }
}
constexpr int WK_REC = 10496;
__device__ __forceinline__ void wkv_build_phase(Frame& F, const bf16* R, const float* DEC, const bf16* KP, const bf16* AP, const bf16* BP, unsigned char* REC0, unsigned char* REC1) {
    LAS unsigned char* L = F.lds + RING_OFF + F.wave * 16384;
    LAS unsigned short* tA = (LAS unsigned short*)L; LAS unsigned short* tB = tA + 1024; LAS unsigned short* tK = tA + 2048; LAS unsigned short* tR = tA + 3072;
    LAS float* fLab = (LAS float*)(L + 8192); LAS float* fLak = fLab + 256; LAS float* fT = fLab + 512;
    const int lane = F.lane, c = lane & 15, g = lane >> 4;
    for (int u = F.gw; u < 2 * H * 512; u += F.NGW) {
        const int ch = u & 511, bh = u >> 9, b = bh >> 4, h = bh & 15;
        unsigned char* rec = (b ? REC1 : REC0) + ((size_t)h * 512 + ch) * WK_REC;
        const size_t base = ((size_t)b * T + (size_t)ch * 16) * D + h * 64 + lane;
        float Af[16], Bf[16], Kf[16], Rf[16]; float gm = 1.f;
#pragma unroll
        for (int t = 0; t < 16; ++t) { const size_t o = base + (size_t)t * D;
            const float w = DEC[o], kp = bf2f(KP[o]), ap = bf2f(AP[o]), bp = bf2f(BP[o]), rr = bf2f(R[o]);
            Af[t] = ap * gm; gm *= w; const float inv = 1.0f / gm; Bf[t] = bp * inv; Kf[t] = kp * inv; Rf[t] = rr * gm;
            tA[t * 64 + lane] = (unsigned short)f2bf(Af[t]); tB[t * 64 + lane] = (unsigned short)f2bf(Bf[t]); tK[t * 64 + lane] = (unsigned short)f2bf(Kf[t]); tR[t * 64 + lane] = (unsigned short)f2bf(Rf[t]); }
        *(float*)(rec + 10240 + lane * 4) = gm;
#pragma unroll
        for (int gq = 0; gq < 4; ++gq) { v4u o; o.x = pk2(Bf[4 * gq], Bf[4 * gq + 1]); o.y = pk2(Bf[4 * gq + 2], Bf[4 * gq + 3]); o.z = pk2(Kf[4 * gq], Kf[4 * gq + 1]); o.w = pk2(Kf[4 * gq + 2], Kf[4 * gq + 3]);
            *(v4u*)(rec + 6144 + lane * 64 + gq * 16) = o; }
        LDS_WAIT(); asm volatile("" ::: "memory");
        pg8::f32x4 lab = {0.f, 0.f, 0.f, 0.f}, lak = lab, mrb = lab, mrk = lab;
#pragma unroll
        for (int s = 0; s < 2; ++s) { const int o = c * 64 + 8 * g + 32 * s;
            const bf16x8 fa = *(const LAS bf16x8*)(tA + o), fb = *(const LAS bf16x8*)(tB + o), fk = *(const LAS bf16x8*)(tK + o), fr = *(const LAS bf16x8*)(tR + o);
            lab = __builtin_amdgcn_mfma_f32_16x16x32_bf16(fa, fb, lab, 0, 0, 0); lak = __builtin_amdgcn_mfma_f32_16x16x32_bf16(fa, fk, lak, 0, 0, 0);
            mrb = __builtin_amdgcn_mfma_f32_16x16x32_bf16(fr, fb, mrb, 0, 0, 0); mrk = __builtin_amdgcn_mfma_f32_16x16x32_bf16(fr, fk, mrk, 0, 0, 0); }
#pragma unroll
        for (int r = 0; r < 4; ++r) { const int t = 4 * g + r; if (!(c < t)) { lab[r] = 0.f; lak[r] = 0.f; } if (!(c <= t)) { mrb[r] = 0.f; mrk[r] = 0.f; }
            fLab[t * 16 + c] = lab[r]; fLak[t * 16 + c] = lak[r]; }
        LDS_WAIT(); asm volatile("" ::: "memory");
        float Tc[16];
#pragma unroll
        for (int i = 0; i < 16; ++i) { float a_ = (i == c) ? 1.f : 0.f;
#pragma unroll
            for (int j = 0; j < i; ++j) a_ += fLab[i * 16 + j] * Tc[j];
            Tc[i] = a_; }
        if (g == 0) {
#pragma unroll
            for (int i = 0; i < 16; ++i) fT[i * 16 + c] = Tc[i]; }
        LDS_WAIT(); asm volatile("" ::: "memory");
        { const int kt = lane >> 4, gq = (lane >> 2) & 3, jj = lane & 3, slot = (kt >> 1) * 1024 + gq * 16 + (jj + 4 * (kt & 1)) * 2;
#pragma unroll
          for (int t = 0; t < 16; ++t) { float w_ = 0.f;
#pragma unroll
              for (int j = 0; j <= t; ++j) w_ += fT[t * 16 + j] * Af[j];
              *(unsigned short*)(rec + slot + t * 64) = (unsigned short)f2bf(w_); *(unsigned short*)(rec + 3072 + slot + t * 64) = (unsigned short)f2bf(Rf[t]); } }
        { const int gq = c >> 2, jq = c & 3;
#pragma unroll
          for (int r = 0; r < 4; ++r) { const int t = 4 * g + r; float tl = 0.f;
#pragma unroll
              for (int j = 0; j < 16; ++j) tl += fT[t * 16 + j] * fLak[j * 16 + c];
              unsigned char* p = rec + 2048 + t * 64 + gq * 16;
              *(unsigned short*)(p + jq * 2) = (unsigned short)f2bf(tl); *(unsigned short*)(p + 8 + jq * 2) = 0;
              *(unsigned short*)(p + 3072 + jq * 2) = (unsigned short)f2bf(mrb[r]); *(unsigned short*)(p + 3072 + 8 + jq * 2) = (unsigned short)f2bf(mrk[r]); } }
        LDS_WAIT(); asm volatile("" ::: "memory");
    }
}
__device__ __forceinline__ void wkv_chain_phase(Frame& F, const unsigned char* REC0, const unsigned char* REC1, const bf16* VP, bf16* Y) {
    if (F.vcu >= 32) return;
    constexpr int GC = 4, GB = GC * WK_REC  , VBOFF = GB, BUFB = GB + 8192  , YB_OFF = 2 * BUFB, NG = 512 / GC;
    const int b = F.vcu >> 4, h = F.vcu & 15, lane = F.lane, c = lane & 15, g = lane >> 4, vt = F.wave;
    const unsigned char* rbase = (b ? REC1 : REC0) + (size_t)h * 512 * WK_REC; const size_t rowb = (size_t)b * T;
    LAS unsigned char* L = F.lds + RING_OFF;
    constexpr int NP = (GB / 16 + 511) / 512;
    struct Stg { v4u p[NP]; v4u v; };
    Stg g0, g1;
#define WK_LOAD(gi, G) do { const unsigned char* s_ = rbase + (size_t)(gi) * GB; _Pragma("unroll") for (int i = 0; i < NP; ++i) { const int o_ = (F.tid + i * 512) * 16; if (o_ < GB) G.p[i] = *(const v4u*)(s_ + o_); } \
        G.v = *(const v4u*)(VP + (rowb + (size_t)(gi) * 64 + (F.tid >> 3)) * D + h * 64 + (F.tid & 7) * 8); } while (0)
#define WK_STORE(bf, G) do { _Pragma("unroll") for (int i = 0; i < NP; ++i) { const int o_ = (F.tid + i * 512) * 16; if (o_ < GB) *(LAS v4u*)(L + (bf) * BUFB + o_) = G.p[i]; } \
        { const int t_ = F.tid >> 3, v0_ = (F.tid & 7) * 8; LAS unsigned short* d_ = (LAS unsigned short*)(L + (bf) * BUFB + VBOFF) + ((((t_ >> 4) * 4) * 4 + ((t_ >> 2) & 3)) * 16) * 4 + (t_ & 3); \
          const unsigned w_[4] = {G.v.x, G.v.y, G.v.z, G.v.w}; \
          _Pragma("unroll") for (int e = 0; e < 8; ++e) { const int v_ = v0_ + e; d_[((v_ >> 4) * 64 + (v_ & 15)) * 4] = (unsigned short)((e & 1) ? (w_[e >> 1] >> 16) : (w_[e >> 1] & 0xffffu)); } } } while (0)
    WK_LOAD(0, g0); WK_STORE(0, g0); WK_LOAD(1, g0); __syncthreads();
    pg8::f32x4 Hs[4]; Hs[0] = (pg8::f32x4){0.f, 0.f, 0.f, 0.f}; Hs[1] = Hs[0]; Hs[2] = Hs[0]; Hs[3] = Hs[0];
    for (int g2 = 0; g2 < NG; g2 += 2) {
#pragma unroll
      for (int par = 0; par < 2; ++par) {
        const int gi = g2 + par, bf = par;
        if (gi + 2 < NG) { if (par == 0) WK_LOAD(gi + 2, g1); else WK_LOAD(gi + 2, g0); }
        if (F.wave < 4) {
            struct Ops { bf16x8 au0, au1, au2, ay0, ay1, ay2, bk0, bk1, bk2, bk3; pg8::f32x4 ga0, ga1, ga2, ga3; u32x2 vb; };
            const int ao = (c * 32 + g * 8) * 2;
#define WK_FETCH(ci_, X) do { const LAS unsigned char* rec_ = L + bf * BUFB + (ci_) * WK_REC; \
                X.au0 = *(const LAS bf16x8*)(rec_ + ao); X.au1 = *(const LAS bf16x8*)(rec_ + 1024 + ao); X.au2 = *(const LAS bf16x8*)(rec_ + 2048 + ao); \
                X.ay0 = *(const LAS bf16x8*)(rec_ + 3072 + ao); X.ay1 = *(const LAS bf16x8*)(rec_ + 4096 + ao); X.ay2 = *(const LAS bf16x8*)(rec_ + 5120 + ao); \
                X.bk0 = *(const LAS bf16x8*)(rec_ + 6144 + ao); X.bk1 = *(const LAS bf16x8*)(rec_ + 7168 + ao); X.bk2 = *(const LAS bf16x8*)(rec_ + 8192 + ao); X.bk3 = *(const LAS bf16x8*)(rec_ + 9216 + ao); \
                X.ga0 = *(const LAS pg8::f32x4*)(rec_ + 10240 + (4 * g) * 4); X.ga1 = *(const LAS pg8::f32x4*)(rec_ + 10240 + (16 + 4 * g) * 4); X.ga2 = *(const LAS pg8::f32x4*)(rec_ + 10240 + (32 + 4 * g) * 4); X.ga3 = *(const LAS pg8::f32x4*)(rec_ + 10240 + (48 + 4 * g) * 4); \
                X.vb = *(const LAS u32x2*)(L + bf * BUFB + VBOFF + (((((ci_) * 4 + vt) * 4 + g) * 16 + c) * 8)); } while (0)
            Ops cu; WK_FETCH(0, cu);
#pragma unroll
            for (int ci = 0; ci < GC; ++ci) {
                Ops nx = cu;
                if (ci + 1 < GC) WK_FETCH(ci + 1, nx);
                v4u h0, h1; h0.x = attn_body::cvtpk_s(Hs[0][0], Hs[0][1]); h0.y = attn_body::cvtpk_s(Hs[0][2], Hs[0][3]); h0.z = attn_body::cvtpk_s(Hs[1][0], Hs[1][1]); h0.w = attn_body::cvtpk_s(Hs[1][2], Hs[1][3]);
                h1.x = attn_body::cvtpk_s(Hs[2][0], Hs[2][1]); h1.y = attn_body::cvtpk_s(Hs[2][2], Hs[2][3]); h1.z = attn_body::cvtpk_s(Hs[3][0], Hs[3][1]); h1.w = attn_body::cvtpk_s(Hs[3][2], Hs[3][3]);
                const bf16x8 hb0 = __builtin_bit_cast(bf16x8, h0), hb1 = __builtin_bit_cast(bf16x8, h1);
                v4u vz; vz.x = cu.vb.x; vz.y = cu.vb.y; vz.z = 0u; vz.w = 0u;
                const pg8::f32x4 z4 = {0.f, 0.f, 0.f, 0.f};
                const pg8::f32x4 ua = __builtin_amdgcn_mfma_f32_16x16x32_bf16(cu.au0, hb0, z4, 0, 0, 0), ub_ = __builtin_amdgcn_mfma_f32_16x16x32_bf16(cu.au1, hb1, z4, 0, 0, 0),
                                 uc = __builtin_amdgcn_mfma_f32_16x16x32_bf16(cu.au2, __builtin_bit_cast(bf16x8, vz), z4, 0, 0, 0);
                pg8::f32x4 yt = __builtin_amdgcn_mfma_f32_16x16x32_bf16(cu.ay0, hb0, z4, 0, 0, 0);
                yt = __builtin_amdgcn_mfma_f32_16x16x32_bf16(cu.ay1, hb1, yt, 0, 0, 0);
                const pg8::f32x4 ut = (ua + ub_) + uc;
                v4u ubw; ubw.x = attn_body::cvtpk_s(ut[0], ut[1]); ubw.y = attn_body::cvtpk_s(ut[2], ut[3]); ubw.z = cu.vb.x; ubw.w = cu.vb.y;
                const bf16x8 ub = __builtin_bit_cast(bf16x8, ubw);
                Hs[0] = __builtin_amdgcn_mfma_f32_16x16x32_bf16(cu.bk0, ub, Hs[0], 0, 0, 0); Hs[1] = __builtin_amdgcn_mfma_f32_16x16x32_bf16(cu.bk1, ub, Hs[1], 0, 0, 0);
                Hs[2] = __builtin_amdgcn_mfma_f32_16x16x32_bf16(cu.bk2, ub, Hs[2], 0, 0, 0); Hs[3] = __builtin_amdgcn_mfma_f32_16x16x32_bf16(cu.bk3, ub, Hs[3], 0, 0, 0);
                yt = __builtin_amdgcn_mfma_f32_16x16x32_bf16(cu.ay2, ub, yt, 0, 0, 0);
                Hs[0] = Hs[0] * cu.ga0; Hs[1] = Hs[1] * cu.ga1; Hs[2] = Hs[2] * cu.ga2; Hs[3] = Hs[3] * cu.ga3;
                LAS unsigned short* yb = (LAS unsigned short*)(L + YB_OFF + bf * 8192) + (ci * 16 + 4 * g) * 64 + vt * 16 + c;
#pragma unroll
                for (int r = 0; r < 4; ++r) yb[r * 64] = (unsigned short)f2bf(yt[r]);
                cu = nx;
            }
#undef WK_FETCH
        }
        if (gi + 1 < NG) { if (par == 0) WK_STORE(1, g0); else WK_STORE(0, g1); }
        __syncthreads();
        { const v4u yv = *(const LAS v4u*)(L + YB_OFF + bf * 8192 + F.tid * 16);
          *(v4u*)(Y + (rowb + (size_t)gi * 64 + (F.tid >> 3)) * D + h * 64 + (F.tid & 7) * 8) = yv; }
      }
    }
#undef WK_LOAD
#undef WK_STORE
}


#ifdef DBG_CUT
__device__ __forceinline__ void dbg_copy(Frame& F, const void* src, bool is_bf16, float* out) {
    for (size_t i = (size_t)F.gw * 64 + F.lane; i < (size_t)M * D; i += (size_t)F.NGW * 64) out[i] = is_bf16 ? bf2f(((const bf16*)src)[i]) : ((const float*)src)[i];
}
#ifndef DBG_LAYER
#define DBG_LAYER -1
#endif
#ifndef DBG_SCALE
#define DBG_SCALE 100.f
#define DBG_SUB 1.f
#endif
#define CUT(k, off, isbf) if (DBG_CUT == (k) && (DBG_LAYER < 0 || layer == DBG_LAYER)) { unsigned char* ws = WSB(); dbg_copy(F, ws + (off), (isbf), GOUT()); return; }
#else
#define CUT(k, off, isbf)
#endif
#ifndef REP_GEMM
#define REP_GEMM 1
#endif
#ifndef REP_THIN
#define REP_THIN 1
#endif
#ifndef REP_CONV
#define REP_CONV REP_THIN
#endif
#ifndef REP_LN
#define REP_LN REP_THIN
#endif
#ifndef REP_RW
#define REP_RW REP_THIN
#endif
#ifndef REP_ATTN
#define REP_ATTN 1
#endif
#ifndef REP_SCAN
#define REP_SCAN 1
#endif
#ifndef REP_WKB
#define REP_WKB 1
#endif
#ifndef REP_WKC
#define REP_WKC 1
#endif
#ifndef REP_BAR
#define REP_BAR 1
#endif
#define GEMM_BIG(EpiT, SchedT) for (int rg_ = 0; rg_ < REP_GEMM; ++rg_) pg8::gemm_phase<EpiT, SchedT, true, true>
#define GEMM_ONE(EpiT, SchedT) for (int rg_ = 0; rg_ < REP_GEMM; ++rg_) pg8::gemm_phase<EpiT, SchedT, false, true>
__global__ void __launch_bounds__(NWAVES * 64, 2) fwd_kernel(Args args) {
    extern __shared__ __attribute__((aligned(16))) unsigned char lds[];
    Frame F;
    F.lds = (LAS unsigned char*)lds; F.MISC = (volatile LAS unsigned*)(F.lds + MISC_OFF);
    F.wave = __builtin_amdgcn_readfirstlane((int)threadIdx.x >> 6); F.lane = fresh_lane(); F.tid = F.wave * 64 + F.lane;
    F.G = gridDim.x; { const int bx = blockIdx.x; F.vcu = (F.G % 8 == 0) ? (bx % 8) * (F.G / 8) + bx / 8 : bx; }
    F.gw = F.vcu * NWAVES + F.wave; F.NGW = F.G * NWAVES;
    F.ws = args.ws; F.ctl = (gu32*)(args.ws + WS_CTL);
#ifdef DBG_LDSZERO
    for (int u = F.tid; u < LDS_BYTES / 4; u += NWAVES * 64) ((LAS unsigned*)(F.lds))[u] = 0u;
#else
    for (int u = F.tid; u < (LDS_BYTES - LDSCTL_OFF) / 4; u += NWAVES * 64) ((LAS unsigned*)(F.lds + LDSCTL_OFF))[u] = 0u;
#endif
    __syncthreads();
    XcdBarrier bar = xcd_barrier_post((unsigned*)(F.ctl + CW_BAR), F.MISC + 8, F.tid == 0);
#define GRID_BAR() do { { GAS unsigned* b_ = (GAS unsigned*)bar.bar; asm volatile("" : "+s"(b_), "+s"(bar.x)); bar.bar = (unsigned*)b_; } for (int rb_ = 0; rb_ < REP_BAR; ++rb_) xcd_barrier(bar, F.wave == 0 && fresh_lane() == 0); } while (0)
#define WSB() ({ F.lane = fresh_lane(); F.tid = F.wave * 64 + F.lane; asm volatile("" : "+s"(F.G), "+s"(F.wave), "+s"(F.vcu), "+s"(F.gw), "+s"(F.NGW), "+s"(bx)); GAS unsigned char* p_ = (GAS unsigned char*)args.ws; asm volatile("" : "+s"(p_)); (unsigned char*)p_; })
#define GOUT() ({ GAS float* o_ = (GAS float*)args.out; asm volatile("" : "+s"(o_)); (float*)o_; })
#define INP(i) ({ const __attribute__((address_space(4))) char* k_ = (const __attribute__((address_space(4))) char*)__builtin_amdgcn_kernarg_segment_ptr(); asm volatile("" : "+s"(k_)); const GAS float* g_ = (const GAS float*)(*(const float* const __attribute__((address_space(4)))*)(k_ + 8 * (i))); asm volatile("" : "+s"(g_)); (const float*)g_; })
    LAS unsigned char* ring = F.lds + RING_OFF;
    int bx = (int)blockIdx.x;

    for (int rt_ = 0; rt_ < REP_CONV; ++rt_) conv_rwkv(F, 0); for (int rt_ = 0; rt_ < REP_CONV; ++rt_) conv_dense(F, 0);
    GRID_BAR();

#ifndef LAYER_LO
#define LAYER_LO 0
#define LAYER_HI 4
#endif
    for (int layer = LAYER_LO; layer < LAYER_HI; ++layer) {
        const bool moe = (layer & 1) != 0; const int fe = layer >> 1;
        if (layer < 2) {
            const int l = layer;
            { unsigned char* ws = WSB(); for (int rt_ = 0; rt_ < REP_RW; ++rt_) mix_phase(F, layer == 0 ? INP(I_X) : (const float*)(ws + WS_H), INP(I_MU) + (size_t)l * 6 * D, (bf16*)(ws + RS_XM)); }
            GRID_BAR();
            { unsigned char* ws = WSB(); pg8::Gemm g{D, D, D}; pg8::SchedStd S; S.init(M, 4096, F.G, bx, ws + RS_XM, D, ws + WM_BT1 + (size_t)l * RW_LSTRIDE, D, 1, (size_t)M * D * 2);
              pg8::EpiRkv E{(bf16*)(ws + RS_RKV), (long)RS_LH - (long)RS_RKV, (size_t)M * D};
              GEMM_BIG(pg8::EpiRkv, pg8::SchedStd)(ring, g, S, E, F.wave); }
            GRID_BAR();
            CUT(1, RS_RKV, true)
            { unsigned char* ws = WSB(); pg8::Gemm g{256, D, 256}; pg8::SchedStd S; S.init(M, 4096, F.G, bx, ws + RS_LH, D, ws + WM_BT2 + (size_t)l * RW_LSTRIDE, 256, 2, 0);
              pg8::EpiLoraUpAll E{{(void*)(ws + RS_DEC), INP(I_W0) + (size_t)l * D}, {(void*)(ws + RS_AB), INP(I_A0) + (size_t)l * D}, {(void*)(ws + RS_VG), INP(I_V0)}, {(void*)(ws + RS_GG), nullptr}};
              GEMM_BIG(pg8::EpiLoraUpAll, pg8::SchedStd)(ring, g, S, E, F.wave); }
            GRID_BAR();
            CUT(2, RS_DEC, false) CUT(60, RS_VG, true) CUT(61, RS_GG, true) CUT(62, RS_LH, true) CUT(63, RS_AB, false)
            { unsigned char* ws = WSB(); for (int rt_ = 0; rt_ < REP_RW; ++rt_) prep_phase(F, l, (bf16*)(ws + RS_RKV), (const float*)(ws + RS_AB), (bf16*)(ws + RS_LH), INP(I_V0), INP(I_V2), (bf16*)(ws + WS_VFIRST), INP(I_KK) + (size_t)l * D, INP(I_KA) + (size_t)l * D,
                                                   (bf16*)(ws + RS_KP), (bf16*)(ws + RS_AP), (bf16*)(ws + RS_BP), (bf16*)(ws + RS_VP)); }
            GRID_BAR();
            CUT(3, RS_KP, true) CUT(7, RS_VP, true) CUT(8, RS_BP, true) CUT(9, RS_DEC, false)
#ifdef WKV_SEQ
            for (int rep_ = 0; rep_ < REP_SCAN; ++rep_) {
              { unsigned char* ws = WSB(); scan_phase(F, (bf16*)(ws + RS_RKV), (float*)(ws + RS_DEC), (bf16*)(ws + RS_KP), (bf16*)(ws + RS_AP), (bf16*)(ws + RS_BP), (bf16*)(ws + RS_VP), (bf16*)(ws + WS_Y)); }
              if (rep_ + 1 < REP_SCAN) GRID_BAR(); }
            GRID_BAR();
#else
            { unsigned char* ws = WSB(); for (int rq_ = 0; rq_ < REP_WKB; ++rq_) wkv_build_phase(F, (bf16*)(ws + RS_RKV), (float*)(ws + RS_DEC), (bf16*)(ws + RS_KP), (bf16*)(ws + RS_AP), (bf16*)(ws + RS_BP), ws + RS_REC0, ws + RS_REC1); }
            GRID_BAR();
#ifdef DBG_CUT
            if (DBG_CUT == 39 && (DBG_LAYER < 0 || layer == DBG_LAYER)) { unsigned char* ws = WSB(); const unsigned short* s_ = (const unsigned short*)(ws + RS_REC0); float* o_ = GOUT();
                for (size_t i = (size_t)F.gw * 64 + F.lane; i < (size_t)M * D; i += (size_t)F.NGW * 64) o_[i] = (float)s_[i]; return; }
#endif
            { unsigned char* ws = WSB(); for (int rq_ = 0; rq_ < REP_WKC; ++rq_) wkv_chain_phase(F, ws + RS_REC0, ws + RS_REC1, (bf16*)(ws + RS_VP), (bf16*)(ws + WS_Y)); }
            if (F.vcu >= 32) {
                const int gw_ = F.gw, ngw_ = F.NGW; F.gw = (F.vcu - 32) * NWAVES + F.wave; F.NGW = (F.G - 32) * NWAVES;
                for (int rt_ = 0; rt_ < REP_CONV; ++rt_) { if (l == 0) conv_moe(F, 0); else { conv_dense(F, 1); conv_moba(F, 0); } }
                F.gw = gw_; F.NGW = ngw_; }
            GRID_BAR();
#endif
            CUT(4, WS_Y, true)
#ifdef DBG_CUT
            if (DBG_CUT == 38 && (DBG_LAYER < 0 || layer == DBG_LAYER)) {
                { unsigned char* ws = WSB(); scan_phase(F, (bf16*)(ws + RS_RKV), (float*)(ws + RS_DEC), (bf16*)(ws + RS_KP), (bf16*)(ws + RS_AP), (bf16*)(ws + RS_BP), (bf16*)(ws + RS_VP), (bf16*)(ws + WS_SCR + 128 * MiB)); }
                GRID_BAR();
                { unsigned char* ws = WSB(); const bf16* a_ = (const bf16*)(ws + WS_Y); const bf16* b_ = (const bf16*)(ws + WS_SCR + 128 * MiB); float* o_ = GOUT();
                  for (size_t i = (size_t)F.gw * 64 + F.lane; i < (size_t)M * D; i += (size_t)F.NGW * 64) { float d_ = DBG_SCALE * (bf2f(a_[i]) - DBG_SUB * bf2f(b_[i])); if (!(fabsf(d_) < 1e30f)) d_ = 1e6f; o_[i] = d_; } }
                return; }
#endif
            { unsigned char* ws = WSB(); for (int rt_ = 0; rt_ < REP_RW; ++rt_) post_phase(F, (bf16*)(ws + WS_Y), (bf16*)(ws + RS_RKV), (bf16*)(ws + RS_KP), (bf16*)(ws + RS_VP), (bf16*)(ws + RS_GG),
                                                   INP(I_RK) + (size_t)l * D, INP(I_GNG) + (size_t)l * D, INP(I_GNB) + (size_t)l * D, (bf16*)(ws + RS_YG)); }
            GRID_BAR();
            CUT(5, RS_YG, true)
            { unsigned char* ws = WSB(); pg8::Gemm g{D, D, D}; pg8::SchedStd S; S.init(M, D, F.G, bx, ws + RS_YG, D, ws + WM_OUT + (size_t)l * RW_LSTRIDE, D);
              pg8::EpiResF32 E{layer == 0 ? INP(I_X) : (const float*)(ws + WS_H), (float*)(ws + RS_PRE), ALPHA};
              GEMM_ONE(pg8::EpiResF32, pg8::SchedStd)(ring, g, S, E, F.wave); }
            GRID_BAR();
            CUT(6, RS_PRE, false)
        } else {
            const int j = layer - 2;
            { unsigned char* ws = WSB(); pg8::Gemm g{D, D, D}; pg8::SchedStd S; S.init(M, j == 0 ? 3 * D : D, F.G, bx, ws + WS_HB, D, ws + WM_QKV, D);
              pg8::EpiQKV E{(bf16*)(ws + BS_Q), ((long)WS_K - (long)BS_Q) / 2, ((long)WS_V - (long)BS_Q) / 2, attn_body::C2};
              GEMM_BIG(pg8::EpiQKV, pg8::SchedStd)(ring, g, S, E, F.wave); }
            GRID_BAR();
            CUT(31, BS_Q, true) CUT(32, WS_K, true) CUT(33, WS_V, true)
            if (j == 0) { unsigned char* ws = WSB(); for (int rt_ = 0; rt_ < REP_THIN; ++rt_) kmean_phase(F, (bf16*)(ws + WS_K), (float*)(ws + WS_KMEAN)); GRID_BAR(); }
#ifndef NO_GATE
            { unsigned char* ws = WSB(); for (int rt_ = 0; rt_ < REP_THIN; ++rt_) gate_phase(F, (bf16*)(ws + BS_Q), (float*)(ws + WS_KMEAN), (unsigned*)(ws + WS_SEL)); }
#endif
            GRID_BAR();
#ifdef DBG_CUT
            if (DBG_CUT == 35) { unsigned char* ws = WSB(); const unsigned* s_ = (const unsigned*)(ws + WS_SEL); for (size_t i = (size_t)F.gw * 64 + F.lane; i < (size_t)M * D; i += (size_t)F.NGW * 64) args.out[i] = (float)(s_[i & (size_t)(M * 16 - 1)] % 65521u); return; }
#endif
#ifdef ATTN_DIRECT
            { unsigned char* ws = WSB(); attn_direct_phase(F, (const bf16*)(ws + BS_Q), (const bf16*)(ws + WS_K), (const bf16*)(ws + WS_V), (const unsigned*)(ws + WS_SEL), (bf16*)(ws + BS_O)); }
            GRID_BAR();
#else
            { unsigned char* ws = WSB(); for (int ra_ = 0; ra_ < REP_ATTN; ++ra_) moba_attn_phase(F, (const bf16*)(ws + BS_Q), (const bf16*)(ws + WS_K), (const bf16*)(ws + WS_V), (const unsigned*)(ws + WS_SEL), (bf16*)(ws + BS_PO), (float*)(ws + BS_ML), F.ctl + CW_QCTR + 64 * (j + 2 * ra_)); }
            GRID_BAR();
            { unsigned char* ws = WSB(); for (int rt_ = 0; rt_ < REP_THIN; ++rt_) moba_combine_phase(F, (const unsigned*)(ws + WS_SEL), (const bf16*)(ws + BS_PO), (const float*)(ws + BS_ML), (bf16*)(ws + BS_O)); }
            GRID_BAR();
#endif
            CUT(36, BS_O, true)
#ifdef DBG_CUT
            if (DBG_CUT == 37 && (DBG_LAYER < 0 || layer == DBG_LAYER)) {
                { unsigned char* ws = WSB(); attn_direct_phase(F, (const bf16*)(ws + BS_Q), (const bf16*)(ws + WS_K), (const bf16*)(ws + WS_V), (const unsigned*)(ws + WS_SEL), (bf16*)(ws + BS_PRE)); }
                GRID_BAR();
                { unsigned char* ws = WSB(); const bf16* a_ = (const bf16*)(ws + BS_O); const bf16* b_ = (const bf16*)(ws + BS_PRE); float* o_ = GOUT();
                  for (size_t i = (size_t)F.gw * 64 + F.lane; i < (size_t)M * D; i += (size_t)F.NGW * 64) o_[i] = 1000.f * (bf2f(a_[i]) - bf2f(b_[i])); }
                return; }
#endif
            { unsigned char* ws = WSB(); pg8::Gemm g{D, D, D}; pg8::SchedStd S; S.init(M, D, F.G, bx, ws + BS_O, D, ws + WM_O, D);
              pg8::EpiResF32 E{(const float*)(ws + WS_H), (float*)(ws + BS_PRE), ALPHA};
              GEMM_ONE(pg8::EpiResF32, pg8::SchedStd)(ring, g, S, E, F.wave); }
            GRID_BAR();
        }
        { unsigned char* ws = WSB(); const float* PREm = (const float*)(ws + (layer < 2 ? RS_PRE : BS_PRE));
          const float* g0 = INP(I_LNG) + (size_t)(layer * 2) * D; const float* b0 = INP(I_LNB) + (size_t)(layer * 2) * D;
          if (moe) for (int rt_ = 0; rt_ < REP_LN; ++rt_) ln_phase<0, true>(F, PREm, nullptr, nullptr, nullptr, g0, b0, (float*)(ws + WS_H), (bf16*)(ws + WS_HB), INP(I_ROUTER) + (size_t)fe * D * NE, (int*)(ws + WS_TOKE), (float*)(ws + WS_TOKW), (int*)(ws + WS_BLKCNT));
          else for (int rt_ = 0; rt_ < REP_LN; ++rt_) ln_phase<0, false>(F, PREm, nullptr, nullptr, nullptr, g0, b0, (float*)(ws + WS_H), (bf16*)(ws + WS_HB), nullptr, nullptr, nullptr, nullptr); }
        if (layer == 0) for (int rt_ = 0; rt_ < REP_CONV; ++rt_) conv_rwkv(F, 1); else if (layer == 2) for (int rt_ = 0; rt_ < REP_CONV; ++rt_) conv_moba(F, 1);
        GRID_BAR();
        CUT(10 + layer, WS_H, false)
        if (!moe) {
            { unsigned char* ws = WSB(); pg8::Gemm g{D, D, D}; pg8::SchedStd S; S.init(M, 2 * FF, F.G, bx, ws + WS_HB, D, ws + WF_GU, D);
              pg8::EpiSwiGLU E{(bf16*)(ws + FS_HID), FF, 1.0f};
              GEMM_BIG(pg8::EpiSwiGLU, pg8::SchedStd)(ring, g, S, E, F.wave); }
            GRID_BAR();
            { unsigned char* ws = WSB(); pg8::Gemm g{FF, FF, FF}; pg8::SchedStd S; S.init(M, D, F.G, bx, ws + FS_HID, FF, ws + WF_DN, FF);
              pg8::EpiResF32 E{(const float*)(ws + WS_H), (float*)(ws + FS_PRE), ALPHA};
              GEMM_ONE(pg8::EpiResF32, pg8::SchedStd)(ring, g, S, E, F.wave); }
            GRID_BAR();
            { unsigned char* ws = WSB(); const float* g1 = INP(I_LNG) + (size_t)(layer * 2 + 1) * D; const float* b1 = INP(I_LNB) + (size_t)(layer * 2 + 1) * D;
              for (int rt_ = 0; rt_ < REP_LN; ++rt_) ln_phase<0, false>(F, (const float*)(ws + FS_PRE), nullptr, nullptr, nullptr, g1, b1, (float*)(ws + WS_H), (bf16*)(ws + WS_HB), nullptr, nullptr, nullptr, nullptr); }
            if (layer == 2) for (int rt_ = 0; rt_ < REP_CONV; ++rt_) conv_moe(F, 1);
            GRID_BAR();
        } else {
            { unsigned char* ws = WSB(); for (int rt_ = 0; rt_ < REP_THIN; ++rt_) moe_gather_phase(F, (const int*)(ws + WS_BLKCNT), (const int*)(ws + WS_TOKE), (const float*)(ws + WS_TOKW), (int*)(ws + WS_TOKR), (float*)(ws + WS_GW), (const float*)(ws + WS_H), (unsigned char*)(ws + ES_XG)); }
            GRID_BAR();
            { unsigned char* ws = WSB(); const LAS int* pp = (const LAS int*)(F.lds + MISC_OFF + 64);
              pg8::Gemm g{D / 2, D / 2, D / 2};
              pg8::SchedMoe S{2 * FFE / 256, F.G, bx, pp, (const char*)(ws + ES_XG), (const char*)(ws + WE_GU), (size_t)256 * D, (size_t)256 * D, (size_t)2 * FFE * D, 0};
              pg8::EpiSwiGLU E{(bf16*)(ws + ES_HID), FFE, 1.0f / MOE_WSCALE};
              for (int rg_ = 0; rg_ < REP_GEMM; ++rg_) pg8::gemm_phase<pg8::EpiSwiGLU, pg8::SchedMoe, true, true, true>(ring, g, S, E, F.wave); }
            GRID_BAR();
            { unsigned char* ws = WSB(); const LAS int* pp = (const LAS int*)(F.lds + MISC_OFF + 64);
              { pg8::Gemm g{FFE, FFE, FFE}; pg8::SchedMoe S{D / 256, F.G, bx, pp, (const char*)(ws + ES_HID), (const char*)(ws + WE_DN), (size_t)256 * FFE * 2, (size_t)256 * FFE * 2, (size_t)D * FFE * 2, 2 * 256};
                pg8::EpiMoeDown E{(float*)(ws + ES_YP), (const float*)(ws + WS_GW)};
                GEMM_BIG(pg8::EpiMoeDown, pg8::SchedMoe)(ring, g, S, E, F.wave); }
              { pg8::Gemm g{512, FFE, FFE}; pg8::SchedMoeTail S{D / 256, F.G, bx, 2 * 256, 7, pp, (const char*)(ws + ES_HID), (const char*)(ws + WE_DN), (size_t)256 * FFE * 2, (size_t)256 * FFE * 2, (size_t)D * FFE * 2, (size_t)512 * 2};
                pg8::EpiMoeDownSlab E{(float*)(ws + ES_YS), (const float*)(ws + WS_GW), bx, 7};
                GEMM_ONE(pg8::EpiMoeDownSlab, pg8::SchedMoeTail)(ring, g, S, E, F.wave); } }
            GRID_BAR();
            { unsigned char* ws = WSB(); const float* g1 = INP(I_LNG) + (size_t)(layer * 2 + 1) * D; const float* b1 = INP(I_LNB) + (size_t)(layer * 2 + 1) * D;
              if (layer == 3) ln_phase<1, false>(F, (const float*)(ws + ES_YS), (const float*)(ws + WS_H), (const float*)(ws + ES_YP), (const int*)(ws + WS_TOKR), g1, b1, GOUT(), nullptr, nullptr, nullptr, nullptr, nullptr);
              else ln_phase<1, false>(F, (const float*)(ws + ES_YS), (const float*)(ws + WS_H), (const float*)(ws + ES_YP), (const int*)(ws + WS_TOKR), g1, b1, (float*)(ws + WS_H), (bf16*)(ws + WS_HB), nullptr, nullptr, nullptr, nullptr); }
            GRID_BAR();
        }
        CUT(20 + layer, WS_H, false)
        CUT(40 + layer, WS_HB, true)
#ifdef DBG_CUT
        if (DBG_CUT == 50 + layer) { unsigned char* ws = WSB(); const bf16* s_ = (const bf16*)(ws + WS_WMIX); float* o_ = GOUT(); for (size_t i = (size_t)F.gw * 64 + F.lane; i < (size_t)M * D; i += (size_t)F.NGW * 64) o_[i] = i < (size_t)6 * 1024 * 1024 ? bf2f(s_[i]) : 0.f; return; }
#endif
    }
}

extern "C" void kernel_launch(void* const* d_in, const int* in_sizes, int n_in, void* d_out, int out_size, void* d_ws, size_t ws_size, hipStream_t stream) {
    static int grid = 0;
    if (grid == 0) {
        if (n_in != 33 || in_sizes[0] != M * D || out_size != M * D || ws_size < WS_END) { fprintf(stderr, "kernel_launch: unexpected problem shape (n_in %d, in0 %d, out %d, ws %zu); nothing launched\n", n_in, n_in > 0 ? in_sizes[0] : -1, out_size, ws_size); grid = -1; return; }
        int dev = 0, cus = 0, per_cu = 0;
        if (hipGetDevice(&dev) != hipSuccess || hipDeviceGetAttribute(&cus, hipDeviceAttributeMultiprocessorCount, dev) != hipSuccess) { grid = -1; return; }
        if (hipFuncSetAttribute((const void*)fwd_kernel, hipFuncAttributeMaxDynamicSharedMemorySize, LDS_BYTES) != hipSuccess) { fprintf(stderr, "kernel_launch: hipFuncSetAttribute failed\n"); grid = -1; return; }
        if (hipOccupancyMaxActiveBlocksPerMultiprocessor(&per_cu, (const void*)fwd_kernel, NWAVES * 64, LDS_BYTES) != hipSuccess || per_cu < 1) { fprintf(stderr, "kernel_launch: occupancy query reports %d workgroups per CU\n", per_cu); }
        (void)hipGetLastError();
        grid = cus;
        if (grid != 256) { fprintf(stderr, "kernel_launch: built for 256 CUs, device has %d; nothing launched\n", cus); grid = -1; return; }
    }
    if (grid < 0) return;
    if (hipMemsetAsync((char*)d_ws + WS_CTL, 0, CTL_ZERO_BYTES, stream) != hipSuccess) return;
#ifdef DBG_FILL
    (void)hipMemsetAsync((char*)d_ws + CTL_ZERO_BYTES, DBG_FILL, WS_END - CTL_ZERO_BYTES, stream);
#endif
    Args a{};
    for (int i = 0; i < 33; ++i) a.in[i] = (const float*)d_in[i];
    a.out = (float*)d_out; a.ws = (unsigned char*)d_ws;
    hipLaunchKernelGGL(fwd_kernel, dim3(grid), dim3(NWAVES * 64), LDS_BYTES, stream, a);
}
```

```cpp
#include <hip/hip_runtime.h>
#include <cstdio>
#include <cstdint>
#include <hip/hip_bf16.h>
#include <cmath>
__device__ __forceinline__ int fresh_lane() { int l; asm volatile("v_mbcnt_lo_u32_b32 %0, -1, 0\n\tv_mbcnt_hi_u32_b32 %0, -1, %0" : "=v"(l)); return l; }
namespace pg8 {
#define PG8_LAS __attribute__((address_space(3)))
typedef unsigned short bf16_t;
typedef short bf16x8 __attribute__((ext_vector_type(8)));
typedef float f32x4 __attribute__((ext_vector_type(4)));
typedef unsigned u32x4 __attribute__((ext_vector_type(4)));
constexpr int BM = 256, BK = 64, HALF = 128, HTB = HALF * BK * 2  , STAGE_BYTES = 8 * HTB, NXCD = 8, WGM = 8;

__host__ __device__ __forceinline__ int lds_byte(int r, int c) { const int st = (r >> 4) * 2 + (c >> 5), rr = r & 15, cc = c & 31, ob = rr * 64 + cc * 2; return st * 1024 + (ob ^ (((ob >> 9) & 1) << 5)); }
__host__ __device__ __forceinline__ void stage_rc(int b, int& R, int& C) { const int st = b / 1024, sb = b % 1024, swz = sb ^ (((sb >> 9) & 1) << 5); R = (st >> 1) * 16 + swz / 64; C = (st & 1) * 32 + (swz % 64) / 2; }
__host__ __device__ __forceinline__ int perm32(int rho) { const int n = rho >> 4, i = rho & 15; return 8 * (i >> 2) + 4 * n + (i & 3); }

struct Unit { int pm, pn, e; };
struct Gemm { int K, lda, ldb; };

__device__ __forceinline__ unsigned cvt_pk_bf16(float lo, float hi) { unsigned r; asm volatile("v_cvt_pk_bf16_f32 %0, %1, %2" : "=v"(r) : "v"(lo), "v"(hi)); return r; }
__device__ __forceinline__ float fsigmoid(float x) { return __builtin_amdgcn_rcpf(1.0f + __expf(-x)); }
__device__ __forceinline__ float ftanh(float x) { return 1.0f - 2.0f * __builtin_amdgcn_rcpf(1.0f + __expf(2.0f * x)); }

struct SchedStd {
    int nM, nN, nwg, G, c, amode; const char* A; const char* B; size_t atile, btile, ag;
    __device__ __forceinline__ void init(int M, int N, int G_, int c_, const void* A_, size_t lda, const void* B_, size_t ldb, int amode_ = 0, size_t ag_ = 0) {
        nM = M / BM; nN = N / BM; nwg = nM * nN; G = G_; c = c_; A = (const char*)A_; B = (const char*)B_; atile = (size_t)BM * lda * 2; btile = (size_t)BM * ldb * 2; amode = amode_; ag = ag_; }
    __device__ __forceinline__ bool next(int i, Unit& u) const {
        const long L = (long)i * G + c; if (L >= nwg) return false;
        int wgid = (int)L; { const int q = nwg / NXCD, r = nwg % NXCD, xcd = wgid % NXCD, off = wgid / NXCD; wgid = (xcd < r ? xcd * (q + 1) : r * (q + 1) + (xcd - r) * q) + off; }
        const int nig = WGM * nN, gid = wgid / nig, fm = gid * WGM, gsz = (nM - fm) < WGM ? (nM - fm) : WGM;
        u.pm = fm + ((wgid % nig) % gsz); u.pn = (wgid % nig) / gsz; u.e = 0; return true;
    }
    __device__ __forceinline__ const char* abase(const Unit& u) const {
        size_t off = (size_t)u.pm * atile;
        if (amode == 1) { const int gs = u.pn < 12 ? (u.pn >> 2) : (u.pn == 12 ? 3 : (u.pn == 13 ? 4 : (u.pn == 14 ? 2 : 5))); off += (size_t)gs * ag; }
        else if (amode == 2) off += (size_t)(u.pn >> 2) * 512;
        return A + off; }
    __device__ __forceinline__ const char* bbase(const Unit& u) const { return B + (size_t)u.pn * btile; }
    __device__ __forceinline__ void a_ready(const Unit&) const {}
    __device__ __forceinline__ void done(const Unit&) const {}
};
struct SchedMoe {
    int nN, G, c; const PG8_LAS int* pp; const char* A; const char* B; size_t atile, btile, bexp; int cap;
    __device__ __forceinline__ bool next(int i, Unit& u) const {
        const int L = i * G + c; int tot = pp[8] * nN; if (cap && tot > cap) tot = cap; if (L >= tot) return false;
        const int pm = L / nN; u.pm = pm; u.pn = L - pm * nN; int e = 0;
#pragma unroll
        for (int k = 1; k < 8; ++k) e += (pm >= pp[k]) ? 1 : 0;
        u.e = __builtin_amdgcn_readfirstlane(e); return true; }
    __device__ __forceinline__ const char* abase(const Unit& u) const { return A + (size_t)u.pm * atile; }
    __device__ __forceinline__ const char* bbase(const Unit& u) const { return B + (size_t)u.e * bexp + (size_t)u.pn * btile; }
    __device__ __forceinline__ void a_ready(const Unit&) const {}
    __device__ __forceinline__ void done(const Unit&) const {}
};

struct SchedMoeTail {
    int nN, G, c, first, NS; const PG8_LAS int* pp; const char* A; const char* B; size_t atile, btile, bexp, kslice;
    __device__ __forceinline__ bool next(int i, Unit& u) const {
        if (i > 0) return false;
        const int L = first + c / NS, tot = pp[8] * nN; if (L >= tot) return false;
        const int pm = L / nN; u.pm = pm; u.pn = L - pm * nN; int e = 0;
#pragma unroll
        for (int k = 1; k < 8; ++k) e += (pm >= pp[k]) ? 1 : 0;
        u.e = __builtin_amdgcn_readfirstlane(e); return true; }
    __device__ __forceinline__ const char* abase(const Unit& u) const { return A + (size_t)u.pm * atile + (size_t)(c % NS) * kslice; }
    __device__ __forceinline__ const char* bbase(const Unit& u) const { return B + (size_t)u.e * bexp + (size_t)u.pn * btile + (size_t)(c % NS) * kslice; }
    __device__ __forceinline__ void a_ready(const Unit&) const {}
    __device__ __forceinline__ void done(const Unit&) const {}
};
#define PG8_PACK8(w, v0, v1) do { w.x = cvt_pk_bf16(v0[0], v0[1]); w.y = cvt_pk_bf16(v0[2], v0[3]); w.z = cvt_pk_bf16(v1[0], v1[1]); w.w = cvt_pk_bf16(v1[2], v1[3]); } while (0)

struct EpiQKV {
    static constexpr bool PERM = true, AFTER_DRAIN = false;
    bf16_t* O0; long d1, d2; float s0;
    __device__ __forceinline__ void operator()(const f32x4 (&acc)[2][2][4][2], const Unit& u, int wr, int wc, int fr, int fq) const {
        const int t = u.pn >> 2; bf16_t* base = O0 + (long)(t == 1) * d1 + (long)(t == 2) * d2; const float sc = t == 0 ? s0 : 1.0f;
        const int row0 = u.pm * BM + wr * 64 + fr, col0 = (u.pn & 3) * BM + wc * 32 + 8 * fq;
#pragma unroll
        for (int ai = 0; ai < 2; ++ai)
#pragma unroll
            for (int m = 0; m < 4; ++m) { bf16_t* rowp = base + (size_t)(row0 + ai * HALF + m * 16) * 1024 + col0;
#pragma unroll
                for (int bj = 0; bj < 2; ++bj) { const f32x4 v0 = acc[ai][bj][m][0] * sc, v1 = acc[ai][bj][m][1] * sc; u32x4 w; PG8_PACK8(w, v0, v1); *(u32x4*)(rowp + bj * HALF) = w; } }
    }
};
struct EpiRkv {
    static constexpr bool PERM = true, AFTER_DRAIN = false;
    bf16_t* RKV; long dLH; size_t mstride;
    __device__ __forceinline__ void operator()(const f32x4 (&acc)[2][2][4][2], const Unit& u, int wr, int wc, int fr, int fq) const {
        const int pn = u.pn; const bool lora = pn >= 12;
        bf16_t* base = (bf16_t*)((char*)RKV + (lora ? dLH : (long)((size_t)(pn >> 2) * mstride * 2))); const int colt = lora ? (pn - 12) * BM : (pn & 3) * BM;
        const int row0 = u.pm * BM + wr * 64 + fr, col0 = colt + wc * 32 + 8 * fq;
#pragma unroll
        for (int ai = 0; ai < 2; ++ai)
#pragma unroll
            for (int m = 0; m < 4; ++m) { bf16_t* rowp = base + (size_t)(row0 + ai * HALF + m * 16) * 1024 + col0;
#pragma unroll
                for (int bj = 0; bj < 2; ++bj) { f32x4 v0 = acc[ai][bj][m][0], v1 = acc[ai][bj][m][1];
                    if (pn == 12) {
#pragma unroll
                        for (int i = 0; i < 4; ++i) { v0[i] = ftanh(v0[i]); v1[i] = ftanh(v1[i]); } }
                    else if (pn == 15) {
#pragma unroll
                        for (int i = 0; i < 4; ++i) { v0[i] = fsigmoid(v0[i]); v1[i] = fsigmoid(v1[i]); } }
                    u32x4 w; PG8_PACK8(w, v0, v1); *(u32x4*)(rowp + bj * HALF) = w; } }
    }
};
template <int GRP> struct EpiLoraUp {
    static constexpr bool PERM = true, AFTER_DRAIN = false;
    void* O; const float* bias;
    __device__ __forceinline__ void operator()(const f32x4 (&acc)[2][2][4][2], const Unit& u, int wr, int wc, int fr, int fq) const {
        const int row0 = u.pm * BM + wr * 64 + fr, col0 = u.pn * BM + wc * 32 + 8 * fq;
#pragma unroll
        for (int bj = 0; bj < 2; ++bj) {
            f32x4 bv0 = (f32x4){0.f, 0.f, 0.f, 0.f}, bv1 = bv0;
            if (GRP < 3) { bv0 = *(const f32x4*)(bias + col0 + bj * HALF); bv1 = *(const f32x4*)(bias + col0 + bj * HALF + 4); }
#pragma unroll
            for (int ai = 0; ai < 2; ++ai)
#pragma unroll
                for (int m = 0; m < 4; ++m) { const size_t ro = (size_t)(row0 + ai * HALF + m * 16) * 1024 + col0 + bj * HALF;
                    f32x4 v0_ = acc[ai][bj][m][0] + bv0, v1_ = acc[ai][bj][m][1] + bv1;
                    if (GRP == 0) {
#pragma unroll
                        for (int i = 0; i < 4; ++i) { v0_[i] = __expf(-0.6065306597f * fsigmoid(v0_[i])); v1_[i] = __expf(-0.6065306597f * fsigmoid(v1_[i])); }
                    } else if (GRP < 3) {
#pragma unroll
                        for (int i = 0; i < 4; ++i) { v0_[i] = fsigmoid(v0_[i]); v1_[i] = fsigmoid(v1_[i]); }
                    }
                    if (GRP < 2) { *(f32x4*)((float*)O + ro) = v0_; *(f32x4*)((float*)O + ro + 4) = v1_; }
                    else { u32x4 w; PG8_PACK8(w, v0_, v1_); *(u32x4*)((bf16_t*)O + ro) = w; } }
        }
    }
};
struct EpiLoraUpAll {
    static constexpr bool PERM = true, AFTER_DRAIN = false;
    EpiLoraUp<0> e0; EpiLoraUp<1> e1; EpiLoraUp<2> e2; EpiLoraUp<3> e3;
    __device__ __forceinline__ void operator()(const f32x4 (&acc)[2][2][4][2], const Unit& u, int wr, int wc, int fr, int fq) const {
        Unit v = u; v.pn = u.pn & 3; const int g = u.pn >> 2;
        if (g == 0) e0(acc, v, wr, wc, fr, fq); else if (g == 1) e1(acc, v, wr, wc, fr, fq); else if (g == 2) e2(acc, v, wr, wc, fr, fq); else e3(acc, v, wr, wc, fr, fq);
    }
};
struct EpiResF32 {
    static constexpr bool PERM = false, AFTER_DRAIN = false;
    const float* base; float* out; float alpha;
    __device__ __forceinline__ void operator()(const f32x4 (&acc)[2][2][4][2], const Unit& u, int wr, int wc, int fr, int fq) const {
        const int row0 = u.pm * BM + wr * 64 + fr, col0 = u.pn * BM + wc * 32 + 4 * fq;
#pragma unroll
        for (int ai = 0; ai < 2; ++ai)
#pragma unroll
            for (int m = 0; m < 4; ++m) { const size_t ro = (size_t)(row0 + ai * HALF + m * 16) * 1024 + col0;
#pragma unroll
                for (int bj = 0; bj < 2; ++bj)
#pragma unroll
                    for (int n = 0; n < 2; ++n) { const f32x4 b = *(const f32x4*)(base + ro + bj * HALF + n * 16); *(f32x4*)(out + ro + bj * HALF + n * 16) = b * alpha + acc[ai][bj][m][n]; } }
    }
};
template <bool F8OUT> struct EpiSwiGLUT {
    static constexpr bool PERM = true, AFTER_DRAIN = false;
    void* Hd; int ldh; float sc, oscale;
    __device__ __forceinline__ void operator()(const f32x4 (&acc)[2][2][4][2], const Unit& u, int wr, int wc, int fr, int fq) const {
        const int row0 = u.pm * BM + wr * 64 + fr, col0 = u.pn * HALF + wc * 32 + 8 * fq;
#pragma unroll
        for (int ai = 0; ai < 2; ++ai)
#pragma unroll
            for (int m = 0; m < 4; ++m) { const size_t eo = (size_t)(row0 + ai * HALF + m * 16) * ldh + col0;
                f32x4 v0, v1;
#pragma unroll
                for (int i = 0; i < 4; ++i) { const float g0 = acc[ai][0][m][0][i] * sc, g1 = acc[ai][0][m][1][i] * sc;
                    v0[i] = g0 * fsigmoid(g0) * (acc[ai][1][m][0][i] * sc); v1[i] = g1 * fsigmoid(g1) * (acc[ai][1][m][1][i] * sc); }
                if constexpr (F8OUT) { v0 = v0 * oscale; v1 = v1 * oscale; typedef unsigned u32x2_ __attribute__((ext_vector_type(2)));
                    int lo = __builtin_amdgcn_cvt_pk_fp8_f32(v0[0], v0[1], 0, false); lo = __builtin_amdgcn_cvt_pk_fp8_f32(v0[2], v0[3], lo, true);
                    int hi = __builtin_amdgcn_cvt_pk_fp8_f32(v1[0], v1[1], 0, false); hi = __builtin_amdgcn_cvt_pk_fp8_f32(v1[2], v1[3], hi, true);
                    u32x2_ w; w.x = (unsigned)lo; w.y = (unsigned)hi; *(u32x2_*)((unsigned char*)Hd + eo) = w; }
                else { u32x4 w; PG8_PACK8(w, v0, v1); *(u32x4*)((bf16_t*)Hd + eo) = w; } }
    }
};
typedef EpiSwiGLUT<false> EpiSwiGLU;
struct EpiMoeDown {
    static constexpr bool PERM = false, AFTER_DRAIN = false;
    float* YP; const float* gw; float sc;
    __device__ __forceinline__ void operator()(const f32x4 (&acc)[2][2][4][2], const Unit& u, int wr, int wc, int fr, int fq) const {
        const int row0 = u.pm * BM + wr * 64 + fr, col0 = u.pn * BM + wc * 32 + 4 * fq;
#pragma unroll
        for (int ai = 0; ai < 2; ++ai)
#pragma unroll
            for (int m = 0; m < 4; ++m) { const int row = row0 + ai * HALF + m * 16; const float s = gw[row] * sc; const size_t ro = (size_t)row * 1024 + col0;
#pragma unroll
                for (int bj = 0; bj < 2; ++bj)
#pragma unroll
                    for (int n = 0; n < 2; ++n) *(f32x4*)(YP + ro + bj * HALF + n * 16) = acc[ai][bj][m][n] * s; }
    }
};

struct EpiMoeDownSlab {
    static constexpr bool PERM = false, AFTER_DRAIN = false;
    float* YS; const float* gw; int c, NS; float sc;
    __device__ __forceinline__ void operator()(const f32x4 (&acc)[2][2][4][2], const Unit& u, int wr, int wc, int fr, int fq) const {
        const int row0 = u.pm * BM + wr * 64 + fr, col0 = u.pn * BM + wc * 32 + 4 * fq; float* slab = YS + (size_t)(c % NS) * 2048 * 1024;
#pragma unroll
        for (int ai = 0; ai < 2; ++ai)
#pragma unroll
            for (int m = 0; m < 4; ++m) { const int row = row0 + ai * HALF + m * 16; const float s = gw[row] * sc; const size_t ro = (size_t)(row - 32768) * 1024 + col0;
#pragma unroll
                for (int bj = 0; bj < 2; ++bj)
#pragma unroll
                    for (int n = 0; n < 2; ++n) *(f32x4*)(slab + ro + bj * HALF + n * 16) = acc[ai][bj][m][n] * s; }
    }
};
template <class Epi, class Sched, bool ALIGN_EPI = false, bool SP2 = false, bool F8 = false>
__device__ __forceinline__ void gemm_phase(PG8_LAS unsigned char* lds, const Gemm g, const Sched& S, const Epi& E, int wave) {
    const int lane = fresh_lane(), wid = wave, tid = wid * 64 + lane, wr = wid >> 2, wc = wid & 3, fr = lane & 15, fq = lane >> 4;
    const int K = g.K, nt = K / BK;
    unsigned voffA[2], voffB[2];
#pragma unroll
    for (int i = 0; i < 2; ++i) { int R, C; stage_rc(tid * 16 + i * 8192, R, C); const int Rb = Epi::PERM ? ((R & ~31) + perm32(R & 31)) : R;
        voffA[i] = (unsigned)(R * g.lda + C) * 2u; voffB[i] = (unsigned)(Rb * g.ldb + C) * 2u; }
    const size_t kstep = (size_t)(BK * 2);
    const size_t hsA = (size_t)HALF * g.lda * 2, hsB = (size_t)HALF * g.ldb * 2;
    const unsigned ldsw = (unsigned)wid * 1024u;
    const int aoff = lds_byte(wr * 64 + fr, fq * 8), boff = lds_byte(wc * 32 + fr, fq * 8);
#define PG8_SA(b, h) (((b) * 2 + (h)) * HTB)
#define PG8_SB(b, h) ((4 + (b) * 2 + (h)) * HTB)
#define PG8_STAGE(bufoff, gbase, voff) do { _Pragma("unroll") for (int _i = 0; _i < 2; ++_i) \
        __builtin_amdgcn_global_load_lds((const unsigned*)((const char*)(gbase) + (voff)[_i]), (PG8_LAS unsigned*)(lds + (bufoff) + ldsw + _i * 8192), 16, 0, 0); } while (0)
#define PG8_LDA(dst, b, h) do { _Pragma("unroll") for (int m = 0; m < 4; ++m) { const i32x4_ lo_ = *(const PG8_LAS i32x4_*)(lds + PG8_SA(b, h) + aoff + m * 2048), hi_ = *(const PG8_LAS i32x4_*)(lds + PG8_SA(b, h) + aoff + m * 2048 + 1024); \
        if constexpr (F8) dst##8[m] = __builtin_shufflevector(lo_, hi_, 0, 1, 2, 3, 4, 5, 6, 7); else { dst[m][0] = __builtin_bit_cast(bf16x8, lo_); dst[m][1] = __builtin_bit_cast(bf16x8, hi_); } } } while (0)
#define PG8_LDB(dst, b, h) do { _Pragma("unroll") for (int n = 0; n < 2; ++n) { const i32x4_ lo_ = *(const PG8_LAS i32x4_*)(lds + PG8_SB(b, h) + boff + n * 2048), hi_ = *(const PG8_LAS i32x4_*)(lds + PG8_SB(b, h) + boff + n * 2048 + 1024); \
        if constexpr (F8) dst##8[n] = __builtin_shufflevector(lo_, hi_, 0, 1, 2, 3, 4, 5, 6, 7); else { dst[n][0] = __builtin_bit_cast(bf16x8, lo_); dst[n][1] = __builtin_bit_cast(bf16x8, hi_); } } } while (0)
#define PG8_MMA(ai, bj, At, Bt) do { __builtin_amdgcn_s_setprio(1); _Pragma("unroll") for (int m = 0; m < 4; ++m) _Pragma("unroll") for (int n = 0; n < 2; ++n) { \
        if constexpr (F8) asm volatile("v_mfma_scale_f32_16x16x128_f8f6f4 %0, %1, %2, %0, %3, %3 op_sel_hi:[0,0,0]" : "+v"(acc[ai][bj][m][n]) : "v"(Bt##8[n]), "v"(At##8[m]), "v"(f8scale));   \
        else { _Pragma("unroll") for (int k = 0; k < 2; ++k) acc[ai][bj][m][n] = __builtin_amdgcn_mfma_f32_16x16x32_bf16(Bt[n][k], At[m][k], acc[ai][bj][m][n], 0, 0, 0); } } \
        __builtin_amdgcn_s_setprio(0); } while (0)
#define PG8_WAIT_V(n) asm volatile("s_waitcnt vmcnt(" #n ")" ::: "memory")
#define PG8_WAIT_L(n) asm volatile("s_waitcnt lgkmcnt(" #n ")" ::: "memory")
#define PG8_BAR __builtin_amdgcn_s_barrier()
#define PG8_SCHED __builtin_amdgcn_sched_barrier(0)
    Unit cur, nxt; int ui = 0;
    if (!S.next(0, cur)) return;
    f32x4 acc[2][2][4][2];
#pragma unroll
    for (int a = 0; a < 2; ++a)
#pragma unroll
        for (int b = 0; b < 2; ++b)
#pragma unroll
            for (int m = 0; m < 4; ++m)
#pragma unroll
                for (int n = 0; n < 2; ++n) acc[a][b][m][n] = (f32x4){0.f, 0.f, 0.f, 0.f};
    typedef int i32x4_ __attribute__((ext_vector_type(4))); typedef int i32x8_ __attribute__((ext_vector_type(8)));
    int f8scale = 0x7f7f7f7f; asm volatile("" : "+v"(f8scale));
    bf16x8 At[4][2], B0[2][2], B1[2][2]; i32x8_ At8[4], B08[2], B18[2];
    const char* cA = S.abase(cur); const char* cB = S.bbase(cur);
    S.a_ready(cur);
    if constexpr (SP2) {
        PG8_STAGE(PG8_SB(0, 0), cB, voffB); PG8_STAGE(PG8_SB(0, 1), cB + hsB, voffB); PG8_STAGE(PG8_SA(0, 0), cA, voffA); PG8_STAGE(PG8_SA(0, 1), cA + hsA, voffA);
        if (wr == 1) PG8_BAR;
        PG8_WAIT_V(2); PG8_BAR;
        PG8_STAGE(PG8_SB(1, 0), cB + kstep, voffB); PG8_STAGE(PG8_SA(1, 0), cA + kstep, voffA); PG8_STAGE(PG8_SB(1, 1), cB + hsB + kstep, voffB);
        PG8_WAIT_V(6); PG8_BAR;
    } else {
        PG8_STAGE(PG8_SB(0, 0), cB, voffB); PG8_STAGE(PG8_SA(0, 0), cA, voffA); PG8_STAGE(PG8_SB(0, 1), cB + hsB, voffB); PG8_STAGE(PG8_SA(0, 1), cA + hsA, voffA);
        if (wr == 1) PG8_BAR;
        PG8_WAIT_V(4); PG8_BAR;
        PG8_STAGE(PG8_SB(1, 0), cB + kstep, voffB); PG8_STAGE(PG8_SA(1, 0), cA + kstep, voffA); PG8_STAGE(PG8_SB(1, 1), cB + hsB + kstep, voffB);
        PG8_WAIT_V(6); PG8_BAR;
    }
    for (;;) {
        const bool has_next = S.next(ui + 1, nxt);
        const char* nA = has_next ? S.abase(nxt) : cA; const char* nB = has_next ? S.bbase(nxt) : cB;
#pragma nounroll
        for (int t = 0; t < nt; t += 2) {
            const bool last = (t == nt - 2);
            const char* a1 = cA + (size_t)(t + 1) * kstep;
            const char* a2 = last ? nA : cA + (size_t)(t + 2) * kstep; const char* b2 = last ? nB : cB + (size_t)(t + 2) * kstep;
            const char* a3 = a2 + kstep; const char* b3 = b2 + kstep;
            if (last && has_next) S.a_ready(nxt);
            if constexpr (SP2) {
            PG8_LDB(B0, 0, 0); PG8_LDB(B1, 0, 1); PG8_SCHED; PG8_LDA(At, 0, 0); PG8_STAGE(PG8_SA(1, 1), a1 + hsA, voffA);
            PG8_WAIT_V(8); PG8_WAIT_L(0); PG8_BAR; PG8_MMA(0, 0, At, B0); PG8_MMA(0, 1, At, B1); PG8_BAR; PG8_SCHED;
            PG8_LDA(At, 0, 1); PG8_STAGE(PG8_SB(0, 0), b2, voffB); PG8_STAGE(PG8_SB(0, 1), b2 + hsB, voffB); PG8_STAGE(PG8_SA(0, 0), a2, voffA);
            PG8_WAIT_V(8); PG8_WAIT_L(0); PG8_BAR; PG8_MMA(1, 0, At, B0); PG8_MMA(1, 1, At, B1); PG8_BAR; PG8_SCHED;
            PG8_LDB(B0, 1, 0); PG8_LDB(B1, 1, 1); PG8_SCHED; PG8_LDA(At, 1, 0); PG8_STAGE(PG8_SA(0, 1), a2 + hsA, voffA);
            PG8_WAIT_V(8); PG8_WAIT_L(0); PG8_BAR; PG8_MMA(0, 0, At, B0); PG8_MMA(0, 1, At, B1); PG8_BAR; PG8_SCHED;
            PG8_LDA(At, 1, 1); PG8_STAGE(PG8_SB(1, 0), b3, voffB); PG8_STAGE(PG8_SB(1, 1), b3 + hsB, voffB); PG8_STAGE(PG8_SA(1, 0), a3, voffA);
            PG8_WAIT_V(8); PG8_WAIT_L(0); PG8_BAR; PG8_MMA(1, 0, At, B0); PG8_MMA(1, 1, At, B1); PG8_BAR; PG8_SCHED;
            } else {
            PG8_LDB(B0, 0, 0); PG8_SCHED; PG8_LDA(At, 0, 0); PG8_STAGE(PG8_SA(1, 1), a1 + hsA, voffA);
            PG8_WAIT_L(8); PG8_BAR; PG8_WAIT_L(0); PG8_MMA(0, 0, At, B0); PG8_BAR; PG8_SCHED;
            PG8_LDB(B1, 0, 1); PG8_STAGE(PG8_SB(0, 0), b2, voffB);
            PG8_BAR; PG8_WAIT_L(0); PG8_MMA(0, 1, At, B1); PG8_BAR;
            PG8_LDA(At, 0, 1); PG8_STAGE(PG8_SA(0, 0), a2, voffA);
            PG8_BAR; PG8_WAIT_L(0); PG8_MMA(1, 0, At, B0); PG8_BAR; PG8_SCHED;
            PG8_STAGE(PG8_SB(0, 1), b2 + hsB, voffB);
            PG8_WAIT_V(6); PG8_BAR; PG8_MMA(1, 1, At, B1); PG8_BAR;
            PG8_LDB(B0, 1, 0); PG8_SCHED; PG8_LDA(At, 1, 0); PG8_STAGE(PG8_SA(0, 1), a2 + hsA, voffA);
            PG8_WAIT_L(8); PG8_BAR; PG8_WAIT_L(0); PG8_MMA(0, 0, At, B0); PG8_BAR; PG8_SCHED;
            PG8_LDB(B1, 1, 1); PG8_STAGE(PG8_SB(1, 0), b3, voffB);
            PG8_BAR; PG8_WAIT_L(0); PG8_MMA(0, 1, At, B1); PG8_BAR;
            PG8_LDA(At, 1, 1); PG8_STAGE(PG8_SA(1, 0), a3, voffA);
            PG8_BAR; PG8_WAIT_L(0); PG8_MMA(1, 0, At, B0); PG8_BAR; PG8_SCHED;
            PG8_STAGE(PG8_SB(1, 1), b3 + hsB, voffB);
            PG8_WAIT_V(6); PG8_BAR; PG8_MMA(1, 1, At, B1); PG8_BAR;
            }
        }
        if constexpr (ALIGN_EPI) { if (wr == 0) PG8_BAR; }
        if constexpr (!Epi::AFTER_DRAIN) { E(acc, cur, wr, wc, fr, fq); S.done(cur); }
        if (!has_next) break;
#pragma unroll
        for (int a = 0; a < 2; ++a)
#pragma unroll
            for (int b = 0; b < 2; ++b)
#pragma unroll
                for (int m = 0; m < 4; ++m)
#pragma unroll
                    for (int n = 0; n < 2; ++n) acc[a][b][m][n] = (f32x4){0.f, 0.f, 0.f, 0.f};
        cur = nxt; cA = nA; cB = nB; ++ui;
        if constexpr (ALIGN_EPI) { if (wr == 1) PG8_BAR; }
    }
    PG8_WAIT_V(0);
    if constexpr (!ALIGN_EPI) { if (wr == 0) PG8_BAR; }
    PG8_BAR;
    if constexpr (Epi::AFTER_DRAIN) { E.fused(acc, cur, wr, wc, fr, fq, lds, wid, lane); S.done(cur); }
#undef PG8_SA
#undef PG8_SB
#undef PG8_STAGE
#undef PG8_LDA
#undef PG8_LDB
#undef PG8_MMA
#undef PG8_WAIT_V
#undef PG8_WAIT_L
#undef PG8_BAR
#undef PG8_SCHED
}
}

#ifndef MOBA_MASK_ON
#define MOBA_MASK_ON 1
#endif
namespace attn_body {
using bf16=__hip_bfloat16;
using bf16x8=__attribute__((ext_vector_type(8)))short;
using s16x4=__attribute__((ext_vector_type(4)))short;
using f32x16=__attribute__((ext_vector_type(16)))float;
using u32x4=__attribute__((ext_vector_type(4)))unsigned;
constexpr int BATCH=2,NHEAD=16,SEQ=8192,D=64,DM=NHEAD*D;
constexpr int NW=8,QBLK=32,QB=QBLK*NW,KVBLK=64,NQB=SEQ/QB;
constexpr int ATTN_PITCH=DM, ATTN_UNIT_ROWS=QB;
__device__ __forceinline__ int crow(int r,int hi){return (r&3)+8*(r>>2)+4*hi;}
#define SBAR() __builtin_amdgcn_sched_barrier(0)
__device__ __forceinline__ void cmask(f32x16&p0,f32x16&p1,int jb,int qrel,int hi){
  const float NEG=-INFINITY; int d=qrel-(64*jb+4*hi); asm volatile("":"+v"(d));
  #pragma unroll
  for(int r=0;r<16;++r){const int c=(r&3)+8*(r>>2); if(c>d)p0[r]=NEG; if(c+32>d)p1[r]=NEG;}
}

constexpr int NSLOT=3, SLOTB=8192;
constexpr int LDS_K=0, LDS_V=NSLOT*SLOTB, LDS_WS=2*NSLOT*SLOTB, LDS_OST=LDS_WS+NW*64*4, LDS_BYTES=LDS_OST+NW*4096;
constexpr float C2=0.125f*1.4426950408889634f;
__device__ __forceinline__ void glds16(const void*gsrc,unsigned lds_dst){unsigned keep;
  asm volatile("s_mov_b32 %0, m0\n\ts_mov_b32 m0, %2\n\ts_nop 0\n\tglobal_load_lds_dwordx4 %1, off\n\ts_mov_b32 m0, %0":"=&s"(keep):"v"(gsrc),"s"(lds_dst):"memory");}
__device__ __forceinline__ float max3f(float a,float b,float c){float r;asm("v_max3_f32 %0, %1, %2, %3":"=v"(r):"v"(a),"v"(b),"v"(c));return r;}
__device__ __forceinline__ float max2f(float a,float b){float r;asm("v_max_f32_e32 %0, %1, %2":"=v"(r):"v"(a),"v"(b));return r;}
__device__ __forceinline__ float fadd_s(float a,float b){float r;asm("v_add_f32_e32 %0, %1, %2":"=v"(r):"v"(a),"v"(b));return r;}
__device__ __forceinline__ float fsub_s(float a,float b){float r;asm("v_sub_f32_e32 %0, %1, %2":"=v"(r):"v"(a),"v"(b));return r;}
typedef float f32x2_t __attribute__((ext_vector_type(2))); typedef __bf16 bf16x2_t __attribute__((ext_vector_type(2)));
__device__ __forceinline__ unsigned cvtpk_s(float lo,float hi){f32x2_t v={lo,hi};bf16x2_t b=__builtin_convertvector(v,bf16x2_t);return __builtin_bit_cast(unsigned,b);}
#define WAIT_BAR(N) asm volatile("s_waitcnt vmcnt(" #N ") lgkmcnt(0)\n\ts_barrier":::"memory")

__device__ __forceinline__ void qkt(f32x16&p0,f32x16&p1,const char*Kslot,const bf16x8*qr,int r32,int hi){
  const char*kb=Kslot+hi*1024+r32*16;
  #pragma unroll
  for(int d0=0;d0<4;++d0){
    const bf16x8 b0=*reinterpret_cast<const bf16x8*>(kb+d0*2048);
    const bf16x8 b1=*reinterpret_cast<const bf16x8*>(kb+d0*2048+512);
    if(d0==0){p0=__builtin_amdgcn_mfma_f32_32x32x16_bf16(b0,qr[0],f32x16{},0,0,0);p1=__builtin_amdgcn_mfma_f32_32x32x16_bf16(b1,qr[0],f32x16{},0,0,0);}
    else{p0=__builtin_amdgcn_mfma_f32_32x32x16_bf16(b0,qr[d0],p0,0,0,0);p1=__builtin_amdgcn_mfma_f32_32x32x16_bf16(b1,qr[d0],p1,0,0,0);}}
}
typedef __attribute__((address_space(3))) const char* lds_cptr;
typedef short v4i16_t __attribute__((ext_vector_type(4)));
__device__ __forceinline__ void kload8(bf16x8*kf,lds_cptr kp){
  kf[0]=*(const __attribute__((address_space(3))) bf16x8*)(kp);      kf[1]=*(const __attribute__((address_space(3))) bf16x8*)(kp+512);
  kf[2]=*(const __attribute__((address_space(3))) bf16x8*)(kp+2048); kf[3]=*(const __attribute__((address_space(3))) bf16x8*)(kp+2560);
  kf[4]=*(const __attribute__((address_space(3))) bf16x8*)(kp+4096); kf[5]=*(const __attribute__((address_space(3))) bf16x8*)(kp+4608);
  kf[6]=*(const __attribute__((address_space(3))) bf16x8*)(kp+6144); kf[7]=*(const __attribute__((address_space(3))) bf16x8*)(kp+6656);
}
__device__ __forceinline__ void kload2(bf16x8*kf,lds_cptr kp,int j){ kf[2*j]=*(const __attribute__((address_space(3))) bf16x8*)(kp+j*2048); kf[2*j+1]=*(const __attribute__((address_space(3))) bf16x8*)(kp+j*2048+512); }
__device__ __forceinline__ s16x4 vtr(lds_cptr p){ return __builtin_bit_cast(s16x4,__builtin_amdgcn_ds_read_tr16_b64_v4i16((__attribute__((address_space(3))) v4i16_t*)p)); }
__device__ __forceinline__ float rowmax(const f32x16&p0,const f32x16&p1){
  float a=max3f(p0[0],p0[1],p1[0]),b=max3f(p0[2],p0[3],p1[1]);a=max3f(a,p1[2],p1[3]);
  #pragma unroll
  for(int r=4;r<16;r+=4){a=max3f(a,p0[r],p0[r+1]);b=max3f(b,p0[r+2],p0[r+3]);a=max3f(a,p1[r],p1[r+1]);b=max3f(b,p1[r+2],p1[r+3]);}
  const float m=max2f(a,b);
  auto rr=__builtin_amdgcn_permlane32_swap(__float_as_uint(m),__float_as_uint(m),false,false);
  return max2f(__uint_as_float(rr[0]),__uint_as_float(rr[1]));
}
__device__ __forceinline__ void pv(f32x16*o,int vb,bf16x8 pa0,bf16x8 pa1,bf16x8 pa2,bf16x8 pa3){
  #pragma unroll
  for(int d0=0;d0<2;++d0){s16x4 lo[4],hi[4];
    #pragma unroll
    for(int ks=0;ks<4;++ks){
      asm volatile("ds_read_b64_tr_b16 %0,%1 offset:%c2":"=&v"(lo[ks]):"v"(vb),"i"(d0*4096+ks*1024):"memory");
      asm volatile("ds_read_b64_tr_b16 %0,%1 offset:%c2":"=&v"(hi[ks]):"v"(vb),"i"(d0*4096+ks*1024+512):"memory");}
    asm volatile("s_waitcnt lgkmcnt(0)":::"memory");SBAR();
    #define PK(k) (bf16x8){lo[k][0],lo[k][1],lo[k][2],lo[k][3],hi[k][0],hi[k][1],hi[k][2],hi[k][3]}
    o[d0]=__builtin_amdgcn_mfma_f32_32x32x16_bf16(pa0,PK(0),o[d0],0,0,0);
    o[d0]=__builtin_amdgcn_mfma_f32_32x32x16_bf16(pa1,PK(1),o[d0],0,0,0);
    o[d0]=__builtin_amdgcn_mfma_f32_32x32x16_bf16(pa2,PK(2),o[d0],0,0,0);
    o[d0]=__builtin_amdgcn_mfma_f32_32x32x16_bf16(pa3,PK(3),o[d0],0,0,0);
    #undef PK
  }
}

#ifndef ATTN_STORE16
#define ATTN_STORE16(p,v) (*(u32x4*)(p)=(v))
#endif
template<int THRL> __device__ __forceinline__ void attn_unit(int b,int h,int qb,const bf16*Q,const bf16*__restrict__ K,const bf16*__restrict__ V,bf16*O,const unsigned*__restrict__ SEL,char*shm,int wave){
  const int lane=fresh_lane(),wid=wave,tid=wid*64+lane,r32=lane&31,hi=lane>>5; (void)tid;
  const long rowbase=(long)b*SEQ; const int q0=qb*QB;
  const bf16*Qw=Q+(rowbase+q0+wid*QBLK)*DM+h*D;
  const bf16*Kh=K+rowbase*DM+h*D,*Vh=V+rowbase*DM+h*D;
  const unsigned lds0=(unsigned)(uintptr_t)shm;
  float*wsf=(float*)(shm+LDS_WS)+wid*64;
  const bf16*ksrc=Kh+(long)lane*DM+wid*8;
  const bf16*vsrc=Vh+(long)(16*(wid&3)+(lane>>2))*DM+(wid>>2)*32+(lane&3)*8;
  const unsigned kdst=lds0+LDS_K+wid*1024, vdst=lds0+LDS_V+wid*1024;
  #define DMA_K(t,slot) glds16(ksrc+(long)(t)*KVBLK*DM,(unsigned)__builtin_amdgcn_readfirstlane(kdst+(slot)))
  #define DMA_V(t,slot) glds16(vsrc+(long)(t)*KVBLK*DM,(unsigned)__builtin_amdgcn_readfirstlane(vdst+(slot)))
  const int vb0=(int)(lds0+LDS_V)+((lane>>4)&1)*32+(lane&3)*8+(4*hi+((lane&15)>>2))*64;
  const char*Kbase=shm+LDS_K; bf16x8 kf[8];
  const lds_cptr shm3=(lds_cptr)shm; const lds_cptr kp0=shm3+LDS_K+hi*1024+r32*16; const lds_cptr vp0=shm3+LDS_V+((lane>>4)&1)*32+(lane&3)*8+(4*hi+((lane&15)>>2))*64;
  const int NT=(q0+QB)/KVBLK;
  DMA_K(0,0);DMA_V(0,0);DMA_K(1,SLOTB);
  bf16x8 qr[4];
  #pragma unroll
  for(int d0=0;d0<4;++d0)qr[d0]=*reinterpret_cast<const bf16x8*>(&Qw[(long)r32*DM+d0*16+hi*8]);
  float mhat=0.f,l_reg=0.f;f32x16 o[2];o[0]=f32x16{};o[1]=f32x16{};
  const int qrel=wid*QBLK+r32;
  #define SELW() ((volatile __attribute__((address_space(3))) unsigned*)(lds_cptr)((const char*)wsf)+32+r32)
  if(hi==0)*SELW()=SEL[(rowbase+q0+qrel)*NHEAD+h];
  asm volatile("s_waitcnt vmcnt(0) lgkmcnt(0)":::"memory");
  #define CMASK(P0,P1,t) do{int jb_=(t)-(NT-4); if(jb_>=0)cmask(P0,P1,jb_,qrel,hi); else if(MOBA_MASK_ON && !(((*SELW())>>((t)>>2))&1u)){ _Pragma("unroll") for(int r_=0;r_<16;++r_){P0[r_]=-INFINITY;P1[r_]=-INFINITY;} } }while(0)
  bool resc=false;
  #define START(P0,P1) do{ const float rm=rowmax(P0,P1); resc=false; \
    { const float dl=max2f(rm,-100.f); mhat=fadd_s(mhat,dl); \
      _Pragma("unroll") for(int r=0;r<16;++r){P0[r]=fsub_s(P0[r],dl);P1[r]=fsub_s(P1[r],dl);} \
      } \
    _Pragma("unroll") for(int r=0;r<16;++r)P0[r]=__builtin_amdgcn_exp2f(P0[r]); }while(0)
  #define RESC() do{ if(resc){ asm volatile("s_waitcnt lgkmcnt(0)":::"memory"); \
      _Pragma("unroll") for(int d_=0;d_<2;++d_) _Pragma("unroll") for(int r=0;r<16;++r)o[d_][r]*=wsf[crow(r,hi)]; } }while(0)
  f32x16 pA0,pA1,pB0,pB1;
  int sl_prev=0,sl_cur=0,sl_next=SLOTB;
  #define ROT() do{sl_prev=sl_cur;sl_cur=sl_next;sl_next=(sl_next==(NSLOT-1)*SLOTB)?0:sl_next+SLOTB;}while(0)
  DMA_K(2,2*SLOTB);
  WAIT_BAR(3);
  qkt(pA0,pA1,Kbase,qr,r32,hi);asm volatile("s_nop 15\n\ts_nop 7":"+v"(pA0),"+v"(pA1));CMASK(pA0,pA1,0);
  START(pA0,pA1);
  _Pragma("unroll") for(int r=0;r<16;++r)pA1[r]=__builtin_amdgcn_exp2f(pA1[r]);
  WAIT_BAR(0);
  DMA_K(3,0);DMA_V(1,SLOTB);
  ROT();
  kload8(kf,kp0+sl_cur);
  WAIT_BAR(2);
  s16x4 vlo[8],vhi[8]; u32x4 pw0,pw1,pw2,pw3;
  #define PKW(P,B) cvtpk_s(P[B],P[B+1])
  #define PAF(k) __builtin_bit_cast(bf16x8,pw##k)
  #define VFR(i) (bf16x8){vlo[i][0],vlo[i][1],vlo[i][2],vlo[i][3],vhi[i][0],vhi[i][1],vhi[i][2],vhi[i][3]}
  #define PIN(x) asm volatile("":"+v"(x))
  #define MX3(a,b,c) __builtin_fmaxf(__builtin_fmaxf((a),(b)),(c))
  #define GAPA(MF,A0,A1,A2,A3,W0,W1,PW) do{ MF; sacc+=A0; sacc+=A1; sacc+=A2; sacc+=A3; PIN(sacc); W0; W1; PIN(PW); SBAR(); }while(0)
  #define EX(v) __builtin_amdgcn_exp2f(v)
  #define GAPB(MF,X,B) do{ MF; X[B]=EX(X[B]); X[B+1]=EX(X[B+1]); X[B+2]=EX(X[B+2]); X[B+3]=EX(X[B+3]); PIN(X); SBAR(); }while(0)
  #define VRD(i) do{ vlo[i]=vtr(vp_+(((i)>>2)*4096+((i)&3)*1024)); vhi[i]=vtr(vp_+(((i)>>2)*4096+((i)&3)*1024+512)); }while(0)
  #define KRD(G,j) do{ if(G){ kload2(kf,kp0+sl_next,j); SBAR(); } }while(0)
  #define STEP(C0,C1,P0,P1,t,GK,GV,GL) do{ SBAR(); \
    const lds_cptr vp_=vp0+sl_prev; \
    VRD(0); SBAR(); float sacc=(P0[0]+P0[1]); \
    GAPA(C0=__builtin_amdgcn_mfma_f32_32x32x16_bf16(kf[0],qr[0],f32x16{},0,0,0), P0[2],P0[3],P0[4],P0[5],     pw0[0]=PKW(P0,0), pw0[1]=PKW(P0,2), pw0); \
    VRD(4); SBAR(); GAPA(C1=__builtin_amdgcn_mfma_f32_32x32x16_bf16(kf[1],qr[0],f32x16{},0,0,0), P0[6],P0[7],P0[8],P0[9],     pw0[2]=PKW(P0,4), pw0[3]=PKW(P0,6), pw0); \
    VRD(1); SBAR(); GAPA(C0=__builtin_amdgcn_mfma_f32_32x32x16_bf16(kf[2],qr[1],C0,0,0,0),   P0[10],P0[11],P0[12],P0[13], pw1[0]=PKW(P0,8), pw1[1]=PKW(P0,10), pw1); \
    VRD(5); SBAR(); GAPA(C1=__builtin_amdgcn_mfma_f32_32x32x16_bf16(kf[3],qr[1],C1,0,0,0),   P0[14],P0[15],P1[0],P1[1],   pw1[2]=PKW(P0,12),pw1[3]=PKW(P0,14), pw1); \
    VRD(2); SBAR(); GAPA(C0=__builtin_amdgcn_mfma_f32_32x32x16_bf16(kf[4],qr[2],C0,0,0,0),   P1[2],P1[3],P1[4],P1[5],     pw2[0]=PKW(P1,0), pw2[1]=PKW(P1,2), pw2); \
    VRD(6); SBAR(); GAPA(C1=__builtin_amdgcn_mfma_f32_32x32x16_bf16(kf[5],qr[2],C1,0,0,0),   P1[6],P1[7],P1[8],P1[9],     pw2[2]=PKW(P1,4), pw2[3]=PKW(P1,6), pw2); \
    VRD(3); SBAR(); GAPA(C0=__builtin_amdgcn_mfma_f32_32x32x16_bf16(kf[6],qr[3],C0,0,0,0),   P1[10],P1[11],P1[12],P1[13], pw3[0]=PKW(P1,8), pw3[1]=PKW(P1,10), pw3); \
    VRD(7); SBAR(); GAPA(C1=__builtin_amdgcn_mfma_f32_32x32x16_bf16(kf[7],qr[3],C1,0,0,0),   P1[14],P1[15],0.f,0.f,       pw3[2]=PKW(P1,12),pw3[3]=PKW(P1,14), pw3); \
    l_reg+=sacc; \
    if(GK){DMA_K((t)+3,sl_cur);} if(GV){DMA_V((t)+1,sl_next);} \
    _Pragma("unroll") for(int r=0;r<16;++r){C0[r]-=mhat;C1[r]-=mhat;} \
    CMASK(C0,C1,t); \
    { float a=MX3(C0[0],C0[1],C1[0]),b=MX3(C0[2],C0[3],C1[1]); a=MX3(a,C1[2],C1[3]); \
      _Pragma("unroll") for(int r=4;r<16;r+=4){a=MX3(a,C0[r],C0[r+1]);b=MX3(b,C0[r+2],C0[r+3]);a=MX3(a,C1[r],C1[r+1]);b=MX3(b,C1[r+2],C1[r+3]);} \
      float rm=__builtin_fmaxf(a,b); { auto rr=__builtin_amdgcn_permlane32_swap(__float_as_uint(rm),__float_as_uint(rm),false,false); rm=__builtin_fmaxf(__uint_as_float(rr[0]),__uint_as_float(rr[1])); } \
      resc=false; \
      if(__builtin_expect(__any(rm>(float)THRL),0)){ const float dl=__builtin_fmaxf(rm,0.f); mhat+=dl; \
        _Pragma("unroll") for(int r=0;r<16;++r){C0[r]-=dl;C1[r]-=dl;} \
        const float f=__builtin_amdgcn_exp2f(-dl); l_reg*=f; if(hi==0)wsf[r32]=f; resc=true; } } \
    SBAR(); \
    GAPB(o[0]=__builtin_amdgcn_mfma_f32_32x32x16_bf16(PAF(0),VFR(0),o[0],0,0,0), C0,0); \
    GAPB(o[1]=__builtin_amdgcn_mfma_f32_32x32x16_bf16(PAF(0),VFR(4),o[1],0,0,0), C0,4); \
    KRD(GL,0); GAPB(o[0]=__builtin_amdgcn_mfma_f32_32x32x16_bf16(PAF(1),VFR(1),o[0],0,0,0), C0,8); \
    KRD(GL,1); GAPB(o[1]=__builtin_amdgcn_mfma_f32_32x32x16_bf16(PAF(1),VFR(5),o[1],0,0,0), C0,12); \
    KRD(GL,2); GAPB(o[0]=__builtin_amdgcn_mfma_f32_32x32x16_bf16(PAF(2),VFR(2),o[0],0,0,0), C1,0); \
    KRD(GL,3); GAPB(o[1]=__builtin_amdgcn_mfma_f32_32x32x16_bf16(PAF(2),VFR(6),o[1],0,0,0), C1,4); \
    GAPB(o[0]=__builtin_amdgcn_mfma_f32_32x32x16_bf16(PAF(3),VFR(3),o[0],0,0,0), C1,8); \
    GAPB(o[1]=__builtin_amdgcn_mfma_f32_32x32x16_bf16(PAF(3),VFR(7),o[1],0,0,0), C1,12); \
    }while(0)
  int t=1;
  for(;t+5<NT;t+=2){
    STEP(pB0,pB1,pA0,pA1,t,true,true,true);     WAIT_BAR(2); RESC(); ROT();
    STEP(pA0,pA1,pB0,pB1,t+1,true,true,true);   WAIT_BAR(2); RESC(); ROT();
  }
  #undef CMASK
  #define CMASK(P0,P1,t) do{int jb_=(t)-(NT-4); if(jb_>=0)cmask(P0,P1,jb_,qrel,hi); else if(MOBA_MASK_ON && !(((*SELW())>>((t)>>2))&1u)){ _Pragma("unroll") for(int r_=0;r_<16;++r_){P0[r_]=-INFINITY;P1[r_]=-INFINITY;} } }while(0)
  #define ENDW(tt) do{ if((tt)+3<NT){WAIT_BAR(2);} else if((tt)+2<NT){WAIT_BAR(1);} else {WAIT_BAR(0);} }while(0)
  for(;t+1<NT;t+=2){
    STEP(pB0,pB1,pA0,pA1,t,(t+3<NT),(t+1<NT),(t+1<NT));       ENDW(t);   RESC(); ROT();
    STEP(pA0,pA1,pB0,pB1,t+1,(t+4<NT),(t+2<NT),(t+2<NT));     ENDW(t+1); RESC(); ROT();
  }
  STEP(pB0,pB1,pA0,pA1,NT-1,false,false,false); RESC();
  { float sacc=pB0[0]+pB0[1]; _Pragma("unroll") for(int r=2;r<16;++r)sacc+=pB0[r]; _Pragma("unroll") for(int r=0;r<16;++r)sacc+=pB1[r]; l_reg+=sacc;
    pw0=(u32x4){PKW(pB0,0),PKW(pB0,2),PKW(pB0,4),PKW(pB0,6)};pw1=(u32x4){PKW(pB0,8),PKW(pB0,10),PKW(pB0,12),PKW(pB0,14)};pw2=(u32x4){PKW(pB1,0),PKW(pB1,2),PKW(pB1,4),PKW(pB1,6)};pw3=(u32x4){PKW(pB1,8),PKW(pB1,10),PKW(pB1,12),PKW(pB1,14)};
    SBAR(); pv(o,vb0+sl_cur,PAF(0),PAF(1),PAF(2),PAF(3)); }
  #undef PKW
  #undef PAF
  #undef VFR
  #undef PIN
  #undef MX3
  #undef GAPA
  #undef GAPB
  #undef EX
  #undef VRD
  #undef KRD
  #undef STEP
  #undef ENDW
  {auto rr=__builtin_amdgcn_permlane32_swap(__float_as_uint(l_reg),__float_as_uint(l_reg),false,false);l_reg=__uint_as_float(rr[0])+__uint_as_float(rr[1]);}
  if(hi==0)wsf[32+r32]=l_reg;asm volatile("s_waitcnt lgkmcnt(0)":::"memory");
  float rli[16];
  #pragma unroll
  for(int r=0;r<16;++r)rli[r]=__builtin_amdgcn_rcpf(wsf[32+crow(r,hi)]);
  bf16*Ow=O+(rowbase+q0+wid*QBLK)*DM+h*D;
  { bf16*stg=(bf16*)(shm+LDS_OST)+wid*2048;
    #pragma unroll
    for(int r=0;r<16;++r){const int orow=crow(r,hi);
      #pragma unroll
      for(int d0=0;d0<2;++d0)stg[orow*64+d0*32+r32]=__float2bfloat16(o[d0][r]*rli[r]);}
    asm volatile("s_waitcnt lgkmcnt(0)":::"memory");
    #pragma unroll
    for(int i=0;i<4;++i){const int row=i*8+(lane>>3),ch=lane&7; const u32x4 v=*(const u32x4*)(stg+row*64+ch*8); ATTN_STORE16(Ow+(long)row*DM+ch*8,v);} }
  asm volatile("s_waitcnt lgkmcnt(0)\n\ts_barrier":::"memory");
  #undef SELW
  #undef DMA_K
  #undef DMA_V
  #undef CMASK
  #undef START
  #undef RESC
  #undef ROT
}
constexpr int ATTN_LDS_BYTES=LDS_BYTES;
struct AttnTensors { const bf16* Q; const bf16* K; const bf16* V; bf16* O; const unsigned* SEL; };
struct AttnUnit { int bh; int qb; };
struct StaticOrder {
  int vcu;
  __device__ __forceinline__ explicit StaticOrder(int grid,int block):vcu((block%8)*(grid/8)+block/8){}
  __device__ __forceinline__ bool next(int i,AttnUnit&u)const{ if(i>=4)return false; const int s=vcu&7; u.bh=vcu>>3; u.qb=(i==0)?s:(i==1)?15-s:(i==2)?16+s:31-s; return true; }
  __device__ __forceinline__ void a_ready(const AttnUnit&)const{}
  __device__ __forceinline__ void done(const AttnUnit&)const{}
};
template<class Sched,int THRL=8> __device__ __forceinline__ void attn_phase(char*lds,const AttnTensors&T,const Sched&S,int wave){
  AttnUnit u;
  for(int i=0;S.next(i,u);++i){ S.a_ready(u); attn_unit<THRL>(u.bh/NHEAD,u.bh%NHEAD,u.qb,T.Q,T.K,T.V,T.O,T.SEL,lds,wave); S.done(u); }
}
#undef SBAR
#undef WAIT_BAR
}

constexpr int NWAVES = 8;
constexpr int BATCH = 2, T = 8192, D = 1024, H = 16, HD = 64, M = BATCH * T;
constexpr int FF = 2816, FFE = 3584, NE = 8, MOE_ROWS = 34816  ;
#ifndef MOE_DOWN_F8
#define MOE_DOWN_F8 1
#endif
constexpr float MOE_HSCALE = 16.f, MOE_DSCALE = 256.f;
constexpr float MOE_WSCALE = 64.f;
constexpr float LN_EPS = 1e-5f, GN_EPS = 64e-5f, ALPHA = 1.6817928305074292f  ;
constexpr size_t MiB = 1u << 20;
constexpr size_t WS_CTL = 0, CTL_ZERO_BYTES = 1 * MiB;
constexpr size_t WS_KMEAN = 1 * MiB;
constexpr size_t WS_SEL = 2 * MiB;
constexpr size_t WS_TOKE = 3 * MiB;
constexpr size_t WS_TOKW = WS_TOKE + 128 * 1024;
constexpr size_t WS_TOKR = WS_TOKW + 128 * 1024;
constexpr size_t WS_GW = WS_TOKR + 128 * 1024;
constexpr size_t WS_BLKCNT = WS_GW + 256 * 1024;
constexpr size_t WS_WMIX = 16 * MiB;
constexpr size_t WS_WFFN = 32 * MiB;
constexpr size_t WS_H = 200 * MiB;
constexpr size_t WS_HB = 264 * MiB;
constexpr size_t WS_K = 296 * MiB, WS_V = 328 * MiB;
constexpr size_t WS_VFIRST = WS_K;
constexpr size_t WS_Y = WS_V;
constexpr size_t WS_SCR = 360 * MiB;
constexpr size_t WS_END = 896 * MiB;
constexpr size_t RS_XM = WS_SCR;
constexpr size_t RS_KP = WS_SCR, RS_AP = WS_SCR + 32 * MiB, RS_VP = WS_SCR + 64 * MiB, RS_BP = WS_SCR + 96 * MiB;
constexpr size_t RS_RKV = WS_SCR + 192 * MiB;
constexpr size_t RS_PRE = RS_RKV;
constexpr size_t RS_LH = WS_SCR + 288 * MiB;
constexpr size_t RS_YG = RS_LH;
constexpr size_t RS_YGC = WS_SCR + 128 * MiB;
#ifdef WKV_SEQ
constexpr size_t RS_YGX = RS_YG;
#else
constexpr size_t RS_YGX = RS_YGC;
#endif
constexpr size_t RS_DEC = WS_SCR + 320 * MiB;
constexpr size_t RS_AB = WS_SCR + 384 * MiB;
constexpr size_t RS_REC0 = WS_SCR + 224 * MiB, RS_REC1 = WS_SCR + 384 * MiB;
constexpr size_t RS_VG = WS_SCR + 448 * MiB;
constexpr size_t RS_GG = WS_SCR + 480 * MiB;
constexpr size_t BS_Q = WS_SCR, BS_PRE = WS_SCR + 32 * MiB, BS_O = WS_SCR + 96 * MiB;
constexpr size_t BS_PO = WS_SCR + 128 * MiB, BS_ML = WS_SCR + 256 * MiB;
constexpr size_t FS_HID = WS_SCR, FS_PRE = WS_SCR + 88 * MiB;
constexpr size_t ES_XG = WS_SCR, ES_HID = WS_SCR + 68 * MiB, ES_YP = WS_SCR + 306 * MiB, ES_YS = WS_SCR + 442 * MiB;
static_assert(RS_GG + 32 * MiB <= WS_END && ES_YS + 56 * MiB <= WS_END && FS_PRE + 64 * MiB <= WS_END, "d_ws map");
constexpr size_t RW_LSTRIDE = 872 * MiB - WS_WMIX;
constexpr size_t WM_BT1 = WS_WMIX, WM_BT2 = WS_WMIX + 8 * MiB, WM_OUT = WS_WMIX + 10 * MiB;
constexpr size_t WM_QKV = WS_WMIX, WM_O = WS_WMIX + 8 * MiB;
constexpr size_t WF_GU = WS_WFFN + 56 * MiB, WF_DN = WS_WFFN + 68 * MiB;
constexpr size_t WE_GU = WS_WFFN, WE_DN = WS_WFFN + 112 * MiB;
constexpr int CW_TMO = 0, CW_CODE = 1, CW_QCTR = 2048  , CW_BAR = 4096;
constexpr int RING_OFF = 0, RING_BYTES = 131072;
constexpr int LDSCTL_OFF = RING_BYTES, MISC_OFF = LDSCTL_OFF + 320;
constexpr int LDS_BYTES = 147456;
static_assert(MISC_OFF + 128 <= LDS_BYTES, "LDS map");

#define GAS __attribute__((address_space(1)))
#define LAS __attribute__((address_space(3)))
typedef unsigned short bf16;
typedef unsigned v4u __attribute__((ext_vector_type(4)));
typedef float f32x4 __attribute__((ext_vector_type(4)));
typedef short bf16x8 __attribute__((ext_vector_type(8)));
typedef GAS unsigned gu32;
typedef GAS unsigned long long gu64;
#define RLX_AGENT __ATOMIC_RELAXED, __HIP_MEMORY_SCOPE_AGENT
#define LDS_WAIT() asm volatile("s_waitcnt lgkmcnt(0)" ::: "memory")
#define VM_WAIT() asm volatile("s_waitcnt vmcnt(0)" ::: "memory")
__device__ __forceinline__ unsigned long long rt() { return __builtin_amdgcn_s_memrealtime(); }
__device__ __forceinline__ unsigned f2bf(float f) { unsigned u = __builtin_bit_cast(unsigned, f); return (u + 0x7fffu + ((u >> 16) & 1u)) >> 16; }
__device__ __forceinline__ unsigned pk2(float lo, float hi) { return f2bf(lo) | (f2bf(hi) << 16); }

#define XB_TMO      128
#define XB_XCNT(j)  (256  + 64 * (j))
#define XB_XSUB(j)  (1280 + 64 * (j))
#define XB_XGEN(j)  (2304 + 64 * (j))
#define XB_TOP      3328
#define XB_TOPGEN   3392
#define XCD_BAR_WORDS 3456
#define XB_SPIN_CAP (1u << 18)

__device__ __forceinline__ unsigned xb_ld(unsigned* p)              { return __hip_atomic_load(p, __ATOMIC_RELAXED, __HIP_MEMORY_SCOPE_AGENT); }
__device__ __forceinline__ unsigned xb_add(unsigned* p, unsigned v) { return __hip_atomic_fetch_add(p, v, __ATOMIC_RELAXED, __HIP_MEMORY_SCOPE_AGENT); }
__device__ __forceinline__ unsigned xb_xcc_id() { return (unsigned)__builtin_amdgcn_s_getreg((3 << 11) | 20) & 0xFu; }
#define XB_SPIN(cond, bar) do { unsigned _sp = 0; while (cond) { __builtin_amdgcn_s_sleep(1); \
    if ((++_sp & 255u) == 0u) { if (xb_ld(&(bar)[XB_TMO])) break; if (_sp > XB_SPIN_CAP) { atomicAdd(&(bar)[XB_TMO], 1u); break; } } } } while (0)

struct XcdBarrier {
    unsigned* bar; unsigned x;
    volatile LAS unsigned* st;
};

__device__ __forceinline__ XcdBarrier xcd_barrier_post(unsigned* bar, volatile LAS unsigned* st, bool t0  ) {
    XcdBarrier b; b.bar = bar; b.x = xb_xcc_id(); b.st = st;
    if (t0) (void)xb_add(&bar[XB_XCNT(b.x)], 1u);
    return b;
}
__device__ __forceinline__ void xcd_barrier_complete(unsigned* bar, unsigned x, unsigned& nloc, unsigned& nx) {
    const unsigned G = gridDim.x * gridDim.y * gridDim.z;
    unsigned sum, cnt, mine, sp = 0u;
    for (;;) {
        sum = 0u; cnt = 0u; mine = 0u;
#pragma unroll
        for (unsigned j = 0; j < 16; ++j) { const unsigned c = xb_ld(&bar[XB_XCNT(j)]); sum += c; cnt += (c > 0u) ? 1u : 0u; mine = (j == x) ? c : mine; }
        if (sum == G) break;
        __builtin_amdgcn_s_sleep(1);
        if ((++sp & 255u) == 0u) { if (xb_ld(&bar[XB_TMO])) break; if (sp > XB_SPIN_CAP) { atomicAdd(&bar[XB_TMO], 1u); break; } }
    }
    nloc = mine > 0u ? mine : 1u; nx = cnt > 0u ? cnt : 1u;
}

__device__ __forceinline__ void xcd_barrier(const XcdBarrier& b, bool t0  ) {
    asm volatile("s_waitcnt vmcnt(0)" ::: "memory");
    __syncthreads();
    if (t0) {
        unsigned* bar = b.bar;
        __builtin_amdgcn_s_waitcnt(0);
        unsigned nloc = b.st[0], nx = b.st[1];
        if (nloc == 0u) { xcd_barrier_complete(bar, b.x, nloc, nx); b.st[0] = nloc; b.st[1] = nx; }
        const unsigned old = xb_add(&bar[XB_XSUB(b.x)], 1u);
        const unsigned gen = old / nloc;
        if (old + 1u == (gen + 1u) * nloc) {
            __builtin_amdgcn_fence(__ATOMIC_RELEASE, "agent");
            asm volatile("s_waitcnt vmcnt(0)" ::: "memory");
            const unsigned og = xb_add(&bar[XB_TOP], 1u);
            const unsigned tg = og / nx;
            if (og + 1u == (tg + 1u) * nx) xb_add(&bar[XB_TOPGEN], 1u);
            else XB_SPIN(xb_ld(&bar[XB_TOPGEN]) == tg, bar);
#ifdef XB_L2_INV
            __builtin_amdgcn_fence(__ATOMIC_ACQUIRE, "");
#else
            __builtin_amdgcn_fence(__ATOMIC_ACQUIRE, "agent");
#endif
            xb_add(&bar[XB_XGEN(b.x)], 1u);
            asm volatile("s_waitcnt vmcnt(0)" ::: "memory");
        } else {
            XB_SPIN(xb_ld(&bar[XB_XGEN(b.x)]) == gen, bar);
            __builtin_amdgcn_fence(__ATOMIC_ACQUIRE, "agent");
            asm volatile("s_waitcnt vmcnt(0)" ::: "memory");
        }
    }
    __syncthreads();
}

struct Args { const float* in[33]; float* out; unsigned char* ws; };
enum InIdx { I_X = 0, I_MU, I_WRKV, I_WOUT, I_W0, I_W1, I_W2, I_A0, I_A1, I_A2, I_V0, I_V1, I_V2, I_G1, I_G2, I_KK, I_KA, I_RK, I_GNG, I_GNB,
             I_MK, I_MV, I_MQ, I_MO, I_FG, I_FU, I_FD, I_ROUTER, I_EG, I_EU, I_ED, I_LNG, I_LNB };
struct Frame {
    LAS unsigned char* lds; volatile LAS unsigned* MISC; gu32* ctl; unsigned char* ws;
    int tid, lane, wave, vcu, G, gw, NGW;
};
typedef float f32x2 __attribute__((ext_vector_type(2)));
typedef unsigned u32x2 __attribute__((ext_vector_type(2)));
__device__ __forceinline__ float dpp_sum16(float v) {
    v += __builtin_bit_cast(float, __builtin_amdgcn_update_dpp(0, __builtin_bit_cast(int, v), 0xB1, 0xF, 0xF, true));
    v += __builtin_bit_cast(float, __builtin_amdgcn_update_dpp(0, __builtin_bit_cast(int, v), 0x4E, 0xF, 0xF, true));
    v += __builtin_bit_cast(float, __builtin_amdgcn_update_dpp(0, __builtin_bit_cast(int, v), 0x141, 0xF, 0xF, true));
    v += __builtin_bit_cast(float, __builtin_amdgcn_update_dpp(0, __builtin_bit_cast(int, v), 0x140, 0xF, 0xF, true));
    return v;
}
__device__ __forceinline__ float wave_sum(float v, int lane) {
    v = dpp_sum16(v);
    v += __builtin_bit_cast(float, __builtin_amdgcn_ds_bpermute((lane ^ 16) << 2, __builtin_bit_cast(int, v)));
    v += __builtin_bit_cast(float, __builtin_amdgcn_ds_bpermute((lane ^ 32) << 2, __builtin_bit_cast(int, v)));
    return v;
}
__device__ __forceinline__ float sum16(float v) { return dpp_sum16(v); }
__device__ __forceinline__ float bf2f(unsigned short b) { return __uint_as_float((unsigned)b << 16); }
__device__ __forceinline__ f32x4 bf4_to_f32(u32x2 w) { f32x4 r; r.x = __uint_as_float(w.x << 16); r.y = __uint_as_float(w.x & 0xffff0000u); r.z = __uint_as_float(w.y << 16); r.w = __uint_as_float(w.y & 0xffff0000u); return r; }
__device__ __forceinline__ u32x2 f32_to_bf4(f32x4 v) { u32x2 w; w.x = pk2(v.x, v.y); w.y = pk2(v.z, v.w); return w; }

__device__ __forceinline__ void tr_item(const float* W, int ldw, int Kr, int Nr, int nblk, bf16* WT, int ldt, int row0, int mode, LAS float* scr, int item, int lane) {
    const int kb = item / nblk, nb = item - kb * nblk, k0 = 64 * kb, n0 = 32 * nb;
    const int kg = lane >> 3, n = n0 + 4 * (lane & 7), kk = k0 + 8 * kg;
    f32x4 v[8];
#pragma unroll
    for (int i = 0; i < 8; ++i) { v[i] = (f32x4){0.f, 0.f, 0.f, 0.f}; if (kk + i < Kr && n < Nr) v[i] = *(const f32x4*)(W + (size_t)(kk + i) * ldw + n); }
#pragma unroll
    for (int e = 0; e < 4; ++e) { const int nn = n + e; const int drow = mode == 0 ? row0 + nn : row0 + ((nn >> 7) << 8) + (nn & 127);
        v4u o; o.x = pk2(v[0][e], v[1][e]); o.y = pk2(v[2][e], v[3][e]); o.z = pk2(v[4][e], v[5][e]); o.w = pk2(v[6][e], v[7][e]);
        *(GAS v4u*)(WT + (size_t)drow * ldt + kk) = o; }
}
__device__ __forceinline__ void tr_item8(const float* W, int ldw, int Kr, int Nr, int nblk, unsigned char* WT, int ldt, int row0, int mode, float scale, int item, int lane) {
    const int kb = item / nblk, nb = item - kb * nblk, k0 = 64 * kb, n0 = 32 * nb;
    const int kg = lane >> 3, n = n0 + 4 * (lane & 7), kk = k0 + 8 * kg;
    f32x4 v[8];
#pragma unroll
    for (int i = 0; i < 8; ++i) { v[i] = (f32x4){0.f, 0.f, 0.f, 0.f}; if (kk + i < Kr && n < Nr) v[i] = *(const f32x4*)(W + (size_t)(kk + i) * ldw + n) * scale; }
#pragma unroll
    for (int e = 0; e < 4; ++e) { const int nn = n + e; const int drow = mode == 0 ? row0 + nn : row0 + ((nn >> 7) << 8) + (nn & 127);
        int lo = __builtin_amdgcn_cvt_pk_fp8_f32(v[0][e], v[1][e], 0, false); lo = __builtin_amdgcn_cvt_pk_fp8_f32(v[2][e], v[3][e], lo, true);
        int hi = __builtin_amdgcn_cvt_pk_fp8_f32(v[4][e], v[5][e], 0, false); hi = __builtin_amdgcn_cvt_pk_fp8_f32(v[6][e], v[7][e], hi, true);
        u32x2 o; o.x = (unsigned)lo; o.y = (unsigned)hi; *(GAS u32x2*)(WT + (size_t)drow * ldt + kk) = o; }
}
#define KIN(i) ({ const __attribute__((address_space(4))) char* k_ = (const __attribute__((address_space(4))) char*)__builtin_amdgcn_kernarg_segment_ptr(); asm volatile("" : "+s"(k_)); const GAS float* g_ = (const GAS float*)(*(const float* const __attribute__((address_space(4)))*)(k_ + 8 * (i))); asm volatile("" : "+s"(g_)); (const float*)g_; })
#define CONV_BEGIN() F.lane = fresh_lane(); F.tid = F.wave * 64 + F.lane; asm volatile("" : "+s"(F.G), "+s"(F.wave), "+s"(F.vcu), "+s"(F.gw), "+s"(F.NGW)); GAS unsigned char* cws0_ = (GAS unsigned char*)F.ws; asm volatile("" : "+s"(cws0_)); unsigned char* cws_ = (unsigned char*)cws0_; LAS float* scr_ = (LAS float*)(F.lds + RING_OFF + F.wave * 16384); int it_ = F.gw, base_ = 0
#define JOB(W, ldw, Kr, Nr, Kp, Np, WT, ldt, row0, mode) do { const int nblk_ = (Np) / 32, n_ = ((Kp) / 64) * nblk_; \
    while (it_ < base_ + n_) { tr_item((W), (ldw), (Kr), (Nr), nblk_, (WT), (ldt), (row0), (mode), scr_, it_ - base_, F.lane); it_ += F.NGW; } base_ += n_; } while (0)
#define JOB8(W, ldw, Kr, Nr, Kp, Np, WT, ldt, row0, mode, scale) do { const int nblk_ = (Np) / 32, n_ = ((Kp) / 64) * nblk_; \
    while (it_ < base_ + n_) { tr_item8((W), (ldw), (Kr), (Nr), nblk_, (WT), (ldt), (row0), (mode), (scale), it_ - base_, F.lane); it_ += F.NGW; } base_ += n_; } while (0)

__device__ __forceinline__ void conv_rwkv(Frame& F, int l) {
    CONV_BEGIN();
    cws_ += (size_t)l * RW_LSTRIDE; bf16* BT1 = (bf16*)(cws_ + WM_BT1); bf16* BT2 = (bf16*)(cws_ + WM_BT2); bf16* WO = (bf16*)(cws_ + WM_OUT);
    for (int c = 0; c < 3; ++c) JOB(KIN(I_WRKV) + (size_t)(l * 3 + c) * D * D, D, D, D, D, D, BT1, D, c * D, 0);
    JOB(KIN(I_W1) + (size_t)l * D * 64, 64, D, 64, D, 256, BT1, D, 3072, 0);
    JOB(KIN(I_A1) + (size_t)l * D * 64, 64, D, 64, D, 256, BT1, D, 3328, 0);
    JOB(KIN(I_V1), 32, D, (l == 0 ? 0 : 32), D, 256, BT1, D, 3584, 0);
    JOB(KIN(I_G1) + (size_t)l * D * 160, 160, D, 160, D, 256, BT1, D, 3840, 0);
    JOB(KIN(I_W2) + (size_t)l * 64 * D, D, 64, D, 256, D, BT2, 256, 0, 0);
    JOB(KIN(I_A2) + (size_t)l * 64 * D, D, 64, D, 256, D, BT2, 256, 1024, 0);
    JOB(KIN(I_V2), D, (l == 0 ? 0 : 32), D, 256, D, BT2, 256, 2048, 0);
    JOB(KIN(I_G2) + (size_t)l * 160 * D, D, 160, D, 256, D, BT2, 256, 3072, 0);
    JOB(KIN(I_WOUT) + (size_t)l * D * D, D, D, D, D, D, WO, D, 0, 0);
}
__device__ __forceinline__ void conv_moba(Frame& F, int j) {
    CONV_BEGIN();
    bf16* WQ = (bf16*)(cws_ + WM_QKV); bf16* WO = (bf16*)(cws_ + WM_O);
    JOB(KIN(I_MQ) + (size_t)j * D * D, D, D, D, D, D, WQ, D, 0, 0);
    if (j == 0) { JOB(KIN(I_MK), D, D, D, D, D, WQ, D, D, 0); JOB(KIN(I_MV), D, D, D, D, D, WQ, D, 2 * D, 0); }
    JOB(KIN(I_MO) + (size_t)j * D * D, D, D, D, D, D, WO, D, 0, 0);
}
__device__ __forceinline__ void conv_dense(Frame& F, int e) {
    CONV_BEGIN();
    bf16* GU = (bf16*)(cws_ + WF_GU); bf16* DN = (bf16*)(cws_ + WF_DN);
    JOB(KIN(I_FG) + (size_t)e * D * FF, FF, D, FF, D, FF, GU, D, 0, 1);
    JOB(KIN(I_FU) + (size_t)e * D * FF, FF, D, FF, D, FF, GU, D, 128, 1);
    JOB(KIN(I_FD) + (size_t)e * FF * D, D, FF, D, FF, D, DN, FF, 0, 0);
}
__device__ __forceinline__ void conv_moe(Frame& F, int e) {
    CONV_BEGIN();
    bf16* GU = (bf16*)(cws_ + WE_GU); bf16* DN = (bf16*)(cws_ + WE_DN);
    for (int x = 0; x < NE; ++x) {
        JOB8(KIN(I_EG) + (size_t)(e * NE + x) * D * FFE, FFE, D, FFE, D, FFE, (unsigned char*)GU, D, x * 2 * FFE, 1, MOE_WSCALE);
        JOB8(KIN(I_EU) + (size_t)(e * NE + x) * D * FFE, FFE, D, FFE, D, FFE, (unsigned char*)GU, D, x * 2 * FFE + 128, 1, MOE_WSCALE);
        if (MOE_DOWN_F8) JOB8(KIN(I_ED) + (size_t)(e * NE + x) * FFE * D, D, FFE, D, FFE, D, (unsigned char*)DN, FFE, x * D, 0, MOE_DSCALE);
        else JOB(KIN(I_ED) + (size_t)(e * NE + x) * FFE * D, D, FFE, D, FFE, D, DN, FFE, x * D, 0);
    }
}

__device__ __forceinline__ void ln_stats(const f32x4 (&v)[4], float& mean, float& rstd, int lane) {
    float s = 0.f;
#pragma unroll
    for (int j = 0; j < 4; ++j) s += (v[j].x + v[j].y) + (v[j].z + v[j].w);
    mean = wave_sum(s, lane) * (1.f / D); float s2 = 0.f;
#pragma unroll
    for (int j = 0; j < 4; ++j) { const f32x4 d = v[j] - mean; s2 += (d.x * d.x + d.y * d.y) + (d.z * d.z + d.w * d.w); }
    rstd = 1.f / sqrtf(wave_sum(s2, lane) * (1.f / D) + LN_EPS);
}
template <int SRC, bool ROUTER>
__device__ __forceinline__ void ln_phase(Frame& F, const float* PRE, const float* Hin, const float* YP, const int* tokr, const float* gln, const float* bln,
                                         float* Hout, bf16* HB, const float* router, int* toke, float* tokw, int* blkcnt) {
    LAS int* cnt = (LAS int*)(F.lds + RING_OFF + 131072 - 64);
    if (ROUTER) { if (F.tid < 8) cnt[F.tid] = 0; __syncthreads(); }
    f32x4 g4[4], b4[4];
#pragma unroll
    for (int j = 0; j < 4; ++j) { g4[j] = *(const f32x4*)(gln + 4 * F.lane + 256 * j); b4[j] = *(const f32x4*)(bln + 4 * F.lane + 256 * j); }
    const int rpb = M / F.G, rpw = rpb / NWAVES;
    for (int i = 0; i < rpw; ++i) {
        const int m = blockIdx.x * rpb + F.wave * rpw + i;
        f32x4 v[4];
        if (SRC == 0) {
#pragma unroll
            for (int j = 0; j < 4; ++j) v[j] = *(const f32x4*)(PRE + (size_t)m * D + 4 * F.lane + 256 * j);
        } else {
            const int r0 = tokr[2 * m], r1 = tokr[2 * m + 1];
#pragma unroll
            for (int j = 0; j < 4; ++j) { const int c = 4 * F.lane + 256 * j;
                f32x4 y0, y1;
                if (r0 < 32768) y0 = *(const f32x4*)(YP + (size_t)r0 * D + c); else { y0 = (f32x4){0.f, 0.f, 0.f, 0.f}; for (int s = 0; s < 7; ++s) y0 += *(const f32x4*)(PRE + ((size_t)s * 2048 + (r0 - 32768)) * D + c); }
                if (r1 < 32768) y1 = *(const f32x4*)(YP + (size_t)r1 * D + c); else { y1 = (f32x4){0.f, 0.f, 0.f, 0.f}; for (int s = 0; s < 7; ++s) y1 += *(const f32x4*)(PRE + ((size_t)s * 2048 + (r1 - 32768)) * D + c); }
                v[j] = *(const f32x4*)(Hin + (size_t)m * D + c) * ALPHA + y0 + y1; }
        }
        float mean, rstd; ln_stats(v, mean, rstd, F.lane);
#pragma unroll
        for (int j = 0; j < 4; ++j) { v[j] = (v[j] - mean) * rstd * g4[j] + b4[j];
            *(f32x4*)(Hout + (size_t)m * D + 4 * F.lane + 256 * j) = v[j];
            if (HB) *(u32x2*)(HB + (size_t)m * D + 4 * F.lane + 256 * j) = f32_to_bf4(v[j]); }
        if (ROUTER) {
            float lg[8];
#pragma unroll
            for (int e = 0; e < 8; ++e) lg[e] = 0.f;
#pragma unroll
            for (int j = 0; j < 4; ++j)
#pragma unroll
                for (int q = 0; q < 4; ++q) { const float xv = v[j][q]; const f32x4* rp = (const f32x4*)(router + (size_t)(4 * F.lane + 256 * j + q) * 8); const f32x4 ra = rp[0], rb = rp[1];
                    lg[0] += xv * ra.x; lg[1] += xv * ra.y; lg[2] += xv * ra.z; lg[3] += xv * ra.w; lg[4] += xv * rb.x; lg[5] += xv * rb.y; lg[6] += xv * rb.z; lg[7] += xv * rb.w; }
#pragma unroll
            for (int e = 0; e < 8; ++e) lg[e] = wave_sum(lg[e], F.lane);
            int e0 = 0; float l0 = lg[0];
#pragma unroll
            for (int e = 1; e < 8; ++e) if (lg[e] > l0) { l0 = lg[e]; e0 = e; }
            int e1 = -1; float l1 = -INFINITY;
#pragma unroll
            for (int e = 0; e < 8; ++e) if (e != e0 && lg[e] > l1) { l1 = lg[e]; e1 = e; }
            const float w0 = 1.f / (1.f + __expf(l1 - l0)), w1 = 1.f - w0;
            if (F.lane == 0) { toke[2 * m] = e0; toke[2 * m + 1] = e1; tokw[2 * m] = w0; tokw[2 * m + 1] = w1; atomicAdd((int*)&cnt[e0], 1); atomicAdd((int*)&cnt[e1], 1); }
        }
    }
    if (ROUTER) { __syncthreads(); if (F.tid < 8) blkcnt[blockIdx.x * 8 + F.tid] = cnt[F.tid]; }
}

__device__ __forceinline__ void mix_phase(Frame& F, const float* Hx, const float* mu, bf16* XM) {
    f32x4 mu4[6][4];
#pragma unroll
    for (int c = 0; c < 6; ++c)
#pragma unroll
        for (int j = 0; j < 4; ++j) mu4[c][j] = *(const f32x4*)(mu + c * D + 4 * F.lane + 256 * j);
    for (int m = F.gw; m < M; m += F.NGW) {
        const bool first = (m % T) == 0;
#pragma unroll
        for (int j = 0; j < 4; ++j) { const int c0 = 4 * F.lane + 256 * j;
            const f32x4 x = *(const f32x4*)(Hx + (size_t)m * D + c0);
            f32x4 xp = (f32x4){0.f, 0.f, 0.f, 0.f}; if (!first) xp = *(const f32x4*)(Hx + (size_t)(m - 1) * D + c0);
            const f32x4 xx = xp - x;
#pragma unroll
            for (int c = 0; c < 6; ++c) *(u32x2*)(XM + ((size_t)c * M + m) * D + c0) = f32_to_bf4(x + xx * mu4[c][j]); }
    }
}
__device__ __forceinline__ void prep_phase(Frame& F, int l, const bf16* RKV, const float* AA, const bf16* LH, const float* v0, const float* v2, bf16* VF, const float* k_k, const float* k_a, bf16* KP, bf16* AP, bf16* BP, bf16* VP) {
    f32x4 kk4[4], ka4[4];
#pragma unroll
    for (int j = 0; j < 4; ++j) { kk4[j] = *(const f32x4*)(k_k + 4 * F.lane + 256 * j); ka4[j] = *(const f32x4*)(k_a + 4 * F.lane + 256 * j); }
    for (int m = F.gw; m < M; m += F.NGW) {
#pragma unroll
        for (int j = 0; j < 4; ++j) { const size_t o = (size_t)m * D + 4 * F.lane + 256 * j;
            const f32x4 k = bf4_to_f32(*(const u32x2*)(RKV + (size_t)M * D + o)); const u32x2 vraw = *(const u32x2*)(RKV + (size_t)2 * M * D + o); f32x4 v = bf4_to_f32(vraw);
            const f32x4 a = *(const f32x4*)(AA + o);
            f32x4 kk = k * kk4[j]; const float ss = sum16((kk.x * kk.x + kk.y * kk.y) + (kk.z * kk.z + kk.w * kk.w));
            kk = kk * (1.0f / sqrtf(fmaxf(ss, 1e-24f)));
            const f32x4 kp = k * ((a - 1.0f) * ka4[j] + 1.0f);
            if (l == 0) *(u32x2*)(VF + o) = vraw;
            else {
                f32x4 z = *(const f32x4*)(v0 + 4 * F.lane + 256 * j);
                const bf16* lh = LH + (size_t)m * D + 512;
#pragma unroll 8
                for (int q = 0; q < 32; ++q) z += *(const f32x4*)(v2 + (size_t)q * D + 4 * F.lane + 256 * j) * bf2f(lh[q]);
                f32x4 vg; vg.x = 1.f / (1.f + __expf(-z.x)); vg.y = 1.f / (1.f + __expf(-z.y)); vg.z = 1.f / (1.f + __expf(-z.z)); vg.w = 1.f / (1.f + __expf(-z.w));
                const f32x4 vf = bf4_to_f32(*(const u32x2*)(VF + o)); v = v + (vf - v) * vg; }
            *(u32x2*)(KP + o) = f32_to_bf4(kp); *(u32x2*)(VP + o) = f32_to_bf4(v); *(u32x2*)(AP + o) = f32_to_bf4(-kk); *(u32x2*)(BP + o) = f32_to_bf4(kk * a); }
    }
}
__device__ __forceinline__ void post_phase(Frame& F, const bf16* Y, const bf16* R, const bf16* KP, const bf16* VP, const bf16* GG, const float* r_k, const float* gng, const float* gnb, bf16* YG) {
    f32x4 rk4[4], gg4[4], gb4[4];
#pragma unroll
    for (int j = 0; j < 4; ++j) { rk4[j] = *(const f32x4*)(r_k + 4 * F.lane + 256 * j); gg4[j] = *(const f32x4*)(gng + 4 * F.lane + 256 * j); gb4[j] = *(const f32x4*)(gnb + 4 * F.lane + 256 * j); }
    for (int m = F.gw; m < M; m += F.NGW) {
#pragma unroll
        for (int j = 0; j < 4; ++j) { const size_t o = (size_t)m * D + 4 * F.lane + 256 * j;
            const f32x4 y = bf4_to_f32(*(const u32x2*)(Y + o)), r = bf4_to_f32(*(const u32x2*)(R + o)), g = bf4_to_f32(*(const u32x2*)(GG + o));
            const f32x4 kp = bf4_to_f32(*(const u32x2*)(KP + o)), vp = bf4_to_f32(*(const u32x2*)(VP + o));
            const float mean = sum16((y.x + y.y) + (y.z + y.w)) * (1.f / 64.f); const f32x4 d = y - mean;
            const float var = sum16((d.x * d.x + d.y * d.y) + (d.z * d.z + d.w * d.w)) * (1.f / 64.f);
            const f32x4 rkk = r * kp * rk4[j]; const float bon = sum16((rkk.x + rkk.y) + (rkk.z + rkk.w));
            const f32x4 yn = d * (1.0f / sqrtf(var + GN_EPS)) * gg4[j] + gb4[j] + vp * bon;
            *(u32x2*)(YG + o) = f32_to_bf4(yn * g); }
    }
}
__device__ __forceinline__ float fma_s(float a, float b, float c) { float r; asm("v_fma_f32 %0, %1, %2, %3" : "=v"(r) : "v"(a), "v"(b), "v"(c)); return r; }
__device__ __forceinline__ float mul_s(float a, float b) { float r; asm("v_mul_f32_e32 %0, %1, %2" : "=v"(r) : "v"(a), "v"(b)); return r; }
__device__ __forceinline__ float add_s(float a, float b) { float r; asm("v_add_f32_e32 %0, %1, %2" : "=v"(r) : "v"(a), "v"(b)); return r; }
__device__ __forceinline__ float dot4_s(const f32x4& x, const f32x4& y) { return add_s(fma_s(x.y, y.y, mul_s(x.x, y.x)), fma_s(x.w, y.w, mul_s(x.z, y.z))); }
__device__ __forceinline__ f32x4 upd_s(const f32x4& S, const f32x4& w, const f32x4& b, float sa, const f32x4& k, float v) {
    f32x4 r; r.x = fma_s(S.x, w.x, fma_s(b.x, sa, mul_s(k.x, v))); r.y = fma_s(S.y, w.y, fma_s(b.y, sa, mul_s(k.y, v))); r.z = fma_s(S.z, w.z, fma_s(b.z, sa, mul_s(k.z, v))); r.w = fma_s(S.w, w.w, fma_s(b.w, sa, mul_s(k.w, v))); return r; }
__device__ __forceinline__ void scan_phase(Frame& F, const bf16* R, const float* DEC, const bf16* KP, const bf16* AP, const bf16* BP, const bf16* VP, bf16* Y) {
    constexpr int TS = 32, BUFB = 57600, YB_OFF = 2 * BUFB;
    const int head = F.vcu >> 3, part = F.vcu & 7, b = head >> 4, hh = head & 15;
    const size_t rowb = (size_t)b * T; const int col0 = hh * 64;
    const int tr = F.tid >> 4, pc = F.tid & 15;
    const int tr2 = (F.tid & 255) >> 3, pc2 = F.tid & 7;
    const int rr = F.lane >> 4, q = F.lane & 15, myrow = 8 * part + 4 * F.wave + rr;
    LAS unsigned char* L = F.lds + RING_OFF;
    struct Stg { f32x4 lw; u32x2 rk, ra, rb, rv, rn; v4u lr; };
    Stg g0, g1;
#define SC_LOAD(c, G) do { const int t_ = (c) * TS + tr; const size_t g_ = (rowb + t_) * D + col0 + pc * 4; G.lw = *(const f32x4*)(DEC + g_); G.rk = *(const u32x2*)(KP + g_); G.ra = *(const u32x2*)(AP + g_); \
        G.rb = *(const u32x2*)(BP + g_); G.rv = *(const u32x2*)(VP + g_); G.rn = (u32x2){0u, 0u}; if (t_ + 1 < T) G.rn = *(const u32x2*)(AP + g_ + D); \
        if (F.tid < 256) G.lr = *(const v4u*)(R + (rowb + (size_t)(c) * TS + tr2) * D + col0 + pc2 * 8); } while (0)
#define SC_STORE(bf, G) do { const f32x4 lk_ = bf4_to_f32(G.rk), la_ = bf4_to_f32(G.ra), lb_ = bf4_to_f32(G.rb), lv_ = bf4_to_f32(G.rv), ln_ = bf4_to_f32(G.rn); LAS unsigned char* d_ = L + (bf) * BUFB + tr * 256 + pc * 16; *(LAS f32x4*)(d_) = G.lw; *(LAS f32x4*)(d_ + 8192) = lk_; *(LAS f32x4*)(d_ + 16384) = la_; \
        *(LAS f32x4*)(d_ + 24576) = lb_; *(LAS f32x4*)(d_ + 32768) = lv_; *(LAS f32x4*)(d_ + 49152) = G.lw * ln_; \
        { const f32x4 pb_ = lb_ * ln_, pk_ = lk_ * ln_; const float be_ = dpp_sum16((pb_.x + pb_.y) + (pb_.z + pb_.w)), ga_ = dpp_sum16((pk_.x + pk_.y) + (pk_.z + pk_.w)); \
          if (pc == 0) { *(LAS float*)(L + (bf) * BUFB + 57344 + tr * 4) = be_; *(LAS float*)(L + (bf) * BUFB + 57472 + tr * 4) = ga_; } } \
        if (F.tid < 256) { LAS unsigned char* r_ = L + (bf) * BUFB + 40960 + tr2 * 256 + pc2 * 32; \
            *(LAS f32x4*)(r_) = (f32x4){__uint_as_float(G.lr.x << 16), __uint_as_float(G.lr.x & 0xffff0000u), __uint_as_float(G.lr.y << 16), __uint_as_float(G.lr.y & 0xffff0000u)}; \
            *(LAS f32x4*)(r_ + 16) = (f32x4){__uint_as_float(G.lr.z << 16), __uint_as_float(G.lr.z & 0xffff0000u), __uint_as_float(G.lr.w << 16), __uint_as_float(G.lr.w & 0xffff0000u)}; } } while (0)
    SC_LOAD(0, g0); SC_STORE(0, g0); SC_LOAD(1, g0); __syncthreads();
    f32x4 S = (f32x4){0.f, 0.f, 0.f, 0.f};
    constexpr int NCH = T / TS;
    for (int c2 = 0; c2 < NCH; c2 += 2) {
#pragma unroll
      for (int par = 0; par < 2; ++par) {
        const int c = c2 + par, bf = par;
        if (c + 2 < NCH) { if (par == 0) SC_LOAD(c + 2, g1); else SC_LOAD(c + 2, g0); }
        if (F.wave < 2) {
            const LAS unsigned char* B0 = L + bf * BUFB + q * 16; const LAS unsigned char* Bv = L + bf * BUFB + 32768 + myrow * 4; const LAS unsigned char* Bs = L + bf * BUFB + 57344;
            LAS unsigned short* yb = (LAS unsigned short*)(L + YB_OFF + bf * 512) + q * 8 + 4 * F.wave + rr;
            struct Rnd { f32x4 a, aw, w0, b0, k0, r0, w1, b1, k1, r1; float v0, v1, be, ga; };
#define SC_FETCH(t_, X) do { X.a = *(const LAS f32x4*)(B0 + 16384 + (t_) * 256); X.aw = *(const LAS f32x4*)(B0 + 49152 + (t_) * 256); \
            X.w0 = *(const LAS f32x4*)(B0 + (t_) * 256); X.b0 = *(const LAS f32x4*)(B0 + 24576 + (t_) * 256); X.k0 = *(const LAS f32x4*)(B0 + 8192 + (t_) * 256); X.r0 = *(const LAS f32x4*)(B0 + 40960 + (t_) * 256); \
            X.w1 = *(const LAS f32x4*)(B0 + ((t_) + 1) * 256); X.b1 = *(const LAS f32x4*)(B0 + 24576 + ((t_) + 1) * 256); X.k1 = *(const LAS f32x4*)(B0 + 8192 + ((t_) + 1) * 256); X.r1 = *(const LAS f32x4*)(B0 + 40960 + ((t_) + 1) * 256); \
            X.v0 = *(const LAS float*)(Bv + (t_) * 256); X.v1 = *(const LAS float*)(Bv + ((t_) + 1) * 256); X.be = *(const LAS float*)(Bs + (t_) * 4); X.ga = *(const LAS float*)(Bs + 128 + (t_) * 4); } while (0)
            Rnd cu; float ykeep = 0.f, yra = 0.f, yrb = 0.f;
#define RED_STEP(x, ctl) asm volatile("v_add_f32_dpp %0, %0, %0 " ctl " row_mask:0xf bank_mask:0xf bound_ctrl:1" : "+v"(x))
#define RED_STEP0(x, ctl) asm volatile("s_nop 1\n\tv_add_f32_dpp %0, %0, %0 " ctl " row_mask:0xf bank_mask:0xf bound_ctrl:1" : "+v"(x))
#define RED4(a_, b_, c_, d_) do { \
            RED_STEP0(a_, "quad_perm:[1,0,3,2]"); RED_STEP0(b_, "quad_perm:[1,0,3,2]"); RED_STEP0(c_, "quad_perm:[1,0,3,2]"); RED_STEP0(d_, "quad_perm:[1,0,3,2]"); \
            RED_STEP(a_, "quad_perm:[2,3,0,1]"); RED_STEP(b_, "quad_perm:[2,3,0,1]"); RED_STEP(c_, "quad_perm:[2,3,0,1]"); RED_STEP(d_, "quad_perm:[2,3,0,1]"); \
            RED_STEP(a_, "row_half_mirror"); RED_STEP(b_, "row_half_mirror"); RED_STEP(c_, "row_half_mirror"); RED_STEP(d_, "row_half_mirror"); \
            RED_STEP(a_, "row_mirror"); RED_STEP(b_, "row_mirror"); RED_STEP(c_, "row_mirror"); RED_STEP(d_, "row_mirror"); } while (0)
            SC_FETCH(0, cu);
#pragma unroll
            for (int t = 0; t < TS; t += 2) {
                Rnd nx = cu;
                if (t + 2 < TS) SC_FETCH(t + 2, nx);
                const f32x4 p1 = S * cu.a, p2 = S * cu.aw;
                float u1 = (p1.x + p1.y) + (p1.z + p1.w), u2 = (p2.x + p2.y) + (p2.z + p2.w);
                RED4(u1, u2, yra, yrb);
                if (t > 0) { ykeep = (q == ((t - 2) & 15)) ? yra : ykeep; ykeep = (q == ((t - 1) & 15)) ? yrb : ykeep;
                             if (((t - 1) & 15) == 15) yb[(t - 16) * 8] = (unsigned short)f2bf(ykeep); }
                const float sa0 = u1, sa1 = u2 + sa0 * cu.be + cu.v0 * cu.ga;
                S = S * cu.w0 + (cu.b0 * sa0 + cu.k0 * cu.v0);
                const f32x4 y4a = S * cu.r0;
                S = S * cu.w1 + (cu.b1 * sa1 + cu.k1 * cu.v1);
                const f32x4 y4b = S * cu.r1;
                yra = (y4a.x + y4a.y) + (y4a.z + y4a.w); yrb = (y4b.x + y4b.y) + (y4b.z + y4b.w);
                cu = nx;
            }
            { float d0_ = 0.f, d1_ = 0.f; RED4(yra, yrb, d0_, d1_);
              ykeep = (q == 14) ? yra : ykeep; ykeep = (q == 15) ? yrb : ykeep; yb[16 * 8] = (unsigned short)f2bf(ykeep); }
#undef RED4
#undef RED_STEP0
#undef RED_STEP
#undef SC_FETCH
        }
        if (c + 1 < NCH) { if (par == 0) SC_STORE(1, g0); else SC_STORE(0, g1); }
        __syncthreads();
        if (F.tid < 32) { const v4u yv = *(const LAS v4u*)(L + YB_OFF + bf * 512 + F.tid * 16);
            *(v4u*)(Y + (rowb + (size_t)c * TS + F.tid) * D + col0 + part * 8) = yv; }
      }
    }
#undef SC_LOAD
#undef SC_STORE
}

__device__ __forceinline__ void kmean_phase(Frame& F, const bf16* Kb, float* KM) {
    LAS float* red = (LAS float*)(F.lds + RING_OFF);
    for (int u = blockIdx.x; u < 2 * 32 * 4; u += F.G) {
        const int qc = u & 3, blk = (u >> 2) & 31, b = u >> 7; const int c = F.tid & 255, rh = F.tid >> 8;
        const bf16* p = Kb + ((size_t)b * T + blk * 256 + rh * 128) * D + qc * 256 + c; float s = 0.f;
#pragma unroll 8
        for (int r = 0; r < 128; ++r) s += bf2f(p[(size_t)r * D]);
        if (rh == 1) red[c] = s;
        __syncthreads();
        if (rh == 0) { const int col = qc * 256 + c; KM[(((size_t)b * H + (col >> 6)) * 32 + blk) * 64 + (col & 63)] = (s + red[c]) * (1.f / 256.f); }
        __syncthreads();
    }
}
__device__ __forceinline__ void gate_phase(Frame& F, const bf16* Q, const float* KM, unsigned* SEL) {
    LAS float* km = (LAS float*)(F.lds + RING_OFF);
    for (int u = blockIdx.x; u < M / 64; u += F.G) {
        const int m0 = u * 64, b = m0 / T, own = (m0 % T) >> 8;
        for (int i = F.tid; i < 16 * 32 * 16; i += NWAVES * 64) *(LAS f32x4*)(km + 4 * i) = *(const f32x4*)(KM + (size_t)b * 16 * 32 * 64 + 4 * i);
        __syncthreads();
        const int m = m0 + F.lane;
#pragma unroll 1
        for (int hi = 0; hi < 2; ++hi) { const int h = 2 * F.wave + hi;
            float qv[64];
#pragma unroll
            for (int i = 0; i < 8; ++i) { const v4u w = *(const v4u*)(Q + (size_t)m * D + h * 64 + 8 * i);
                qv[8 * i + 0] = __uint_as_float(w.x << 16); qv[8 * i + 1] = __uint_as_float(w.x & 0xffff0000u); qv[8 * i + 2] = __uint_as_float(w.y << 16); qv[8 * i + 3] = __uint_as_float(w.y & 0xffff0000u);
                qv[8 * i + 4] = __uint_as_float(w.z << 16); qv[8 * i + 5] = __uint_as_float(w.z & 0xffff0000u); qv[8 * i + 6] = __uint_as_float(w.w << 16); qv[8 * i + 7] = __uint_as_float(w.w & 0xffff0000u); }
            float v0 = -INFINITY, v1 = -INFINITY, v2 = -INFINITY; int i0 = -1, i1 = -1, i2 = -1;
            for (int j = 0; j < own; ++j) { const LAS f32x4* kp = (const LAS f32x4*)(km + (h * 32 + j) * 64); float s = 0.f;
#pragma unroll
                for (int i = 0; i < 16; ++i) { const f32x4 kv = kp[i]; s += qv[4 * i] * kv.x + qv[4 * i + 1] * kv.y + qv[4 * i + 2] * kv.z + qv[4 * i + 3] * kv.w; }
                if (s > v0) { v2 = v1; i2 = i1; v1 = v0; i1 = i0; v0 = s; i0 = j; } else if (s > v1) { v2 = v1; i2 = i1; v1 = s; i1 = j; } else if (s > v2) { v2 = s; i2 = j; } }
            unsigned mask = 0u; if (i0 >= 0) mask |= 1u << i0; if (i1 >= 0) mask |= 1u << i1; if (i2 >= 0) mask |= 1u << i2;
            SEL[((size_t)b * H + h) * T + (m % T)] = mask; }
        __syncthreads();
    }
}

__device__ __forceinline__ void moe_prefix(Frame& F, const int* blkcnt, LAS int* pre_mine  ) {
    LAS int* tmp = (LAS int*)(F.lds + RING_OFF);
    for (int i = F.tid; i < F.G * 8; i += NWAVES * 64) tmp[i] = blkcnt[i];
    __syncthreads();
    if (F.tid < 8) { int tot = 0, mine = 0; for (int g = 0; g < F.G; ++g) { if (g == (int)blockIdx.x) mine = tot; tot += tmp[g * 8 + F.tid]; }
        pre_mine[F.tid] = mine; pre_mine[8 + F.tid] = tot; }
    __syncthreads();
    if (F.tid == 0) { int p = 0; for (int e = 0; e < 8; ++e) { F.MISC[16 + e] = (unsigned)p; p += (pre_mine[8 + e] + 255) >> 8; } F.MISC[24] = (unsigned)p; }
    __syncthreads();
}
__device__ __forceinline__ void moe_gather_phase(Frame& F, const int* blkcnt, const int* toke, const float* tokw, int* tokr, float* gw, const float* Hs, unsigned char* XG) {
    LAS int* pm = (LAS int*)(F.lds + RING_OFF + 16384);
    LAS int* rows = (LAS int*)(F.lds + RING_OFF + 16384 + 64);
    moe_prefix(F, blkcnt, pm);
    const int rpb = M / F.G;
    if (F.wave == 0) {
        const int m = blockIdx.x * rpb + F.lane; const bool ok = F.lane < rpb;
        const int e0 = ok ? toke[2 * m] : -1, e1 = ok ? toke[2 * m + 1] : -1;
        int r0 = 0, r1 = 0;
        for (int e = 0; e < 8; ++e) { const unsigned long long b0 = __ballot(e0 == e), b1 = __ballot(e1 == e); const unsigned long long lt = (1ull << F.lane) - 1ull;
            const int base = (int)F.MISC[16 + e] * 256 + pm[e];
            if (e0 == e) r0 = base + __popcll(b0 & lt);
            if (e1 == e) r1 = base + __popcll(b0) + __popcll(b1 & lt); }
        if (ok) { tokr[2 * m] = r0; tokr[2 * m + 1] = r1; gw[r0] = tokw[2 * m]; gw[r1] = tokw[2 * m + 1]; rows[2 * F.lane] = r0; rows[2 * F.lane + 1] = r1; }
    }
    __syncthreads();
    for (int i = F.wave; i < 2 * rpb; i += NWAVES) { const int m = blockIdx.x * rpb + (i >> 1), r = rows[i];
        const f32x4* s = (const f32x4*)(Hs + (size_t)m * D + 16 * F.lane); const f32x4 a = s[0], b_ = s[1], c = s[2], d = s[3];
        v4u o; int w;
        w = __builtin_amdgcn_cvt_pk_fp8_f32(a.x, a.y, 0, false); w = __builtin_amdgcn_cvt_pk_fp8_f32(a.z, a.w, w, true); o.x = (unsigned)w;
        w = __builtin_amdgcn_cvt_pk_fp8_f32(b_.x, b_.y, 0, false); w = __builtin_amdgcn_cvt_pk_fp8_f32(b_.z, b_.w, w, true); o.y = (unsigned)w;
        w = __builtin_amdgcn_cvt_pk_fp8_f32(c.x, c.y, 0, false); w = __builtin_amdgcn_cvt_pk_fp8_f32(c.z, c.w, w, true); o.z = (unsigned)w;
        w = __builtin_amdgcn_cvt_pk_fp8_f32(d.x, d.y, 0, false); w = __builtin_amdgcn_cvt_pk_fp8_f32(d.z, d.w, w, true); o.w = (unsigned)w;
        *(v4u*)(XG + (size_t)r * D + 16 * F.lane) = o; }
    __syncthreads();
}
__device__ __forceinline__ void attn_direct_phase(Frame& F, const bf16* Q, const bf16* Kb, const bf16* Vb, const unsigned* SEL, bf16* O) {
    for (int u = F.gw; u < (M / 64) * H; u += F.NGW) {
        const int h = u & 15, m0 = (u >> 4) * 64, b = m0 / T, t0 = m0 % T, own = t0 >> 8, m = m0 + F.lane, tpos = t0 + F.lane;
        float q[64], o[64];
#pragma unroll
        for (int i = 0; i < 8; ++i) { const v4u w = *(const v4u*)(Q + (size_t)m * D + h * 64 + 8 * i);
            q[8 * i + 0] = __uint_as_float(w.x << 16); q[8 * i + 1] = __uint_as_float(w.x & 0xffff0000u); q[8 * i + 2] = __uint_as_float(w.y << 16); q[8 * i + 3] = __uint_as_float(w.y & 0xffff0000u);
            q[8 * i + 4] = __uint_as_float(w.z << 16); q[8 * i + 5] = __uint_as_float(w.z & 0xffff0000u); q[8 * i + 6] = __uint_as_float(w.w << 16); q[8 * i + 7] = __uint_as_float(w.w & 0xffff0000u); }
#pragma unroll
        for (int i = 0; i < 64; ++i) o[i] = 0.f;
        const unsigned sel = SEL[((size_t)b * H + h) * T + tpos];
        float mrun = -INFINITY, l = 0.f;
        for (int j = 0; j <= own; ++j) {
            const bool pastsel = (sel >> j) & 1u;
            if (j < own && !__any(pastsel)) continue;
            const int nk = (j < own) ? 256 : (t0 & 255) + 64;
            for (int kk = 0; kk < nk; ++kk) {
                const int kpos = j * 256 + kk; const size_t ro = ((size_t)b * T + kpos) * D + h * 64;
                float s = 0.f;
#pragma unroll
                for (int i = 0; i < 8; ++i) { const v4u w = *(const v4u*)(Kb + ro + 8 * i);
                    s += q[8 * i + 0] * __uint_as_float(w.x << 16) + q[8 * i + 1] * __uint_as_float(w.x & 0xffff0000u) + q[8 * i + 2] * __uint_as_float(w.y << 16) + q[8 * i + 3] * __uint_as_float(w.y & 0xffff0000u)
                       + q[8 * i + 4] * __uint_as_float(w.z << 16) + q[8 * i + 5] * __uint_as_float(w.z & 0xffff0000u) + q[8 * i + 6] * __uint_as_float(w.w << 16) + q[8 * i + 7] * __uint_as_float(w.w & 0xffff0000u); }
                const bool act = (j < own) ? pastsel : (kpos <= tpos);
                if (act) {
                    if (s > mrun) { const float c = exp2f(mrun - s); l *= c;
#pragma unroll
                        for (int i = 0; i < 64; ++i) o[i] *= c;
                        mrun = s; }
                    const float p = exp2f(s - mrun); l += p;
#pragma unroll
                    for (int i = 0; i < 8; ++i) { const v4u w = *(const v4u*)(Vb + ro + 8 * i);
                        o[8 * i + 0] += p * __uint_as_float(w.x << 16); o[8 * i + 1] += p * __uint_as_float(w.x & 0xffff0000u); o[8 * i + 2] += p * __uint_as_float(w.y << 16); o[8 * i + 3] += p * __uint_as_float(w.y & 0xffff0000u);
                        o[8 * i + 4] += p * __uint_as_float(w.z << 16); o[8 * i + 5] += p * __uint_as_float(w.z & 0xffff0000u); o[8 * i + 6] += p * __uint_as_float(w.w << 16); o[8 * i + 7] += p * __uint_as_float(w.w & 0xffff0000u); }
                }
            }
        }
        const float rl = 1.0f / l;
#pragma unroll
        for (int i = 0; i < 8; ++i) { v4u w; w.x = pk2(o[8 * i] * rl, o[8 * i + 1] * rl); w.y = pk2(o[8 * i + 2] * rl, o[8 * i + 3] * rl); w.z = pk2(o[8 * i + 4] * rl, o[8 * i + 5] * rl); w.w = pk2(o[8 * i + 6] * rl, o[8 * i + 7] * rl);
            *(v4u*)(O + (size_t)m * D + h * 64 + 8 * i) = w; }
    }
}
namespace moba {
using attn_body::f32x16; using attn_body::crow;
constexpr int L_K = 0, L_V = 32768, L_LIST = 65536, L_WS = 81920, L_CTL = 84992;
__device__ __forceinline__ void qkt_l(f32x16& p0, f32x16& p1, const LAS unsigned char* Kslot, const bf16x8* qr, int r32, int hi) {
    const LAS unsigned char* kb = Kslot + hi * 1024 + r32 * 16;
#pragma unroll
    for (int d0 = 0; d0 < 4; ++d0) {
        const bf16x8 b0 = *(const LAS bf16x8*)(kb + d0 * 2048), b1 = *(const LAS bf16x8*)(kb + d0 * 2048 + 512);
        if (d0 == 0) { p0 = __builtin_amdgcn_mfma_f32_32x32x16_bf16(b0, qr[0], f32x16{}, 0, 0, 0); p1 = __builtin_amdgcn_mfma_f32_32x32x16_bf16(b1, qr[0], f32x16{}, 0, 0, 0); }
        else { p0 = __builtin_amdgcn_mfma_f32_32x32x16_bf16(b0, qr[d0], p0, 0, 0, 0); p1 = __builtin_amdgcn_mfma_f32_32x32x16_bf16(b1, qr[d0], p1, 0, 0, 0); } }
}
__device__ __forceinline__ float half_max(float v) { auto rr = __builtin_amdgcn_permlane32_swap(__float_as_uint(v), __float_as_uint(v), false, false); return fmaxf(__uint_as_float(rr[0]), __uint_as_float(rr[1])); }
__device__ __forceinline__ float half_sum(float v) { auto rr = __builtin_amdgcn_permlane32_swap(__float_as_uint(v), __float_as_uint(v), false, false); return __uint_as_float(rr[0]) + __uint_as_float(rr[1]); }
}
__device__ __forceinline__ void moba_attn_phase(Frame& F, const bf16* Q, const bf16* Kb, const bf16* Vb, const unsigned* SELT, bf16* PO, float* ML, gu32* qctr) {
    using namespace moba;
    const int lane = F.lane, wid = F.wave, r32 = lane & 31, hi = lane >> 5;
    LAS unsigned char* L = F.lds + RING_OFF;
    LAS unsigned short* list = (LAS unsigned short*)(L + L_LIST);
    LAS float* wsf = (LAS float*)(L + L_WS + wid * 256); LAS int* wsd = (LAS int*)(L + L_WS + wid * 256 + 128);
    LAS int* ctl = (LAS int*)(L + L_CTL);
    const int vb0 = RING_OFF + L_V + ((lane >> 4) & 1) * 32 + (lane & 3) * 8 + (4 * hi + ((lane & 15) >> 2)) * 64;
    for (;;) {
        __syncthreads();
        if (F.tid == 0) { ctl[0] = (int)__hip_atomic_fetch_add(qctr, 1u, __ATOMIC_RELAXED, __HIP_MEMORY_SCOPE_AGENT); ctl[1] = 0; }
        __syncthreads();
        const int u = __builtin_amdgcn_readfirstlane(ctl[0]);
        if (u >= 32 * 32) break;
        const int j = u >> 5, bh = u & 31, b = bh >> 4, h = bh & 15;
        const size_t rowb = (size_t)b * T;
        { const bf16* ksrc = Kb + (rowb + 256 * j + lane) * D + h * 64 + wid * 8;
          const bf16* vsrc = Vb + (rowb + 256 * j + 16 * (wid & 3) + (lane >> 2)) * D + h * 64 + (wid >> 2) * 32 + (lane & 3) * 8;
#pragma unroll
          for (int kt = 0; kt < 4; ++kt) { attn_body::glds16(ksrc + (size_t)kt * 64 * D, (unsigned)__builtin_amdgcn_readfirstlane(RING_OFF + L_K + kt * 8192 + wid * 1024));
                                           attn_body::glds16(vsrc + (size_t)kt * 64 * D, (unsigned)__builtin_amdgcn_readfirstlane(RING_OFF + L_V + kt * 8192 + wid * 1024)); } }
        const unsigned* selrow = SELT + (size_t)bh * T;
        for (int t0 = 256 * (j + 1); t0 < T; t0 += NWAVES * 64) { const int t = t0 + F.tid; const bool in = t < T;
            const bool p = in && ((selrow[in ? t : 0] >> j) & 1u);
            const unsigned long long bal = __ballot(p); const int np = __popcll(bal);
            int base = 0; if (lane == 0 && np) base = __hip_atomic_fetch_add(&ctl[1], np, __ATOMIC_RELAXED, __HIP_MEMORY_SCOPE_WORKGROUP);
            base = __builtin_amdgcn_readfirstlane(base);
            if (p) list[base + __popcll(bal & ((1ull << lane) - 1ull))] = (unsigned short)t; }
        asm volatile("s_waitcnt vmcnt(0) lgkmcnt(0)" ::: "memory");
        __syncthreads();
        const int total = 256 + ctl[1], nb = (total + 31) >> 5;
        for (int bi = wid; bi < nb; bi += NWAVES) {
            const int item = bi * 32 + r32; const bool valid = item < total; const int it2 = valid ? item : total - 1;
            const bool ownb = bi < 8;
            const int t = it2 < 256 ? 256 * j + it2 : (int)list[it2 - 256];
            const bf16* qrow = Q + (rowb + t) * D + h * 64;
            bf16x8 qr[4];
#pragma unroll
            for (int d0 = 0; d0 < 4; ++d0) qr[d0] = *(const bf16x8*)(qrow + d0 * 16 + hi * 8);
            f32x16 P[4][2];
#pragma unroll
            for (int kt = 0; kt < 4; ++kt) qkt_l(P[kt][0], P[kt][1], L + L_K + kt * 8192, qr, r32, hi);
            if (ownb) {
#pragma unroll
                for (int kt = 0; kt < 4; ++kt) attn_body::cmask(P[kt][0], P[kt][1], kt, t - 256 * j, hi); }
            float mx = -INFINITY;
#pragma unroll
            for (int kt = 0; kt < 4; ++kt)
#pragma unroll
                for (int r = 0; r < 16; ++r) mx = fmaxf(mx, fmaxf(P[kt][0][r], P[kt][1][r]));
            mx = half_max(mx);
            float ls = 0.f;
#pragma unroll
            for (int kt = 0; kt < 4; ++kt)
#pragma unroll
                for (int r = 0; r < 16; ++r) { P[kt][0][r] = __builtin_amdgcn_exp2f(P[kt][0][r] - mx); P[kt][1][r] = __builtin_amdgcn_exp2f(P[kt][1][r] - mx); ls += P[kt][0][r] + P[kt][1][r]; }
            ls = half_sum(ls);
            f32x16 o[2]; o[0] = f32x16{}; o[1] = f32x16{};
#pragma unroll
            for (int kt = 0; kt < 4; ++kt) {
                attn_body::u32x4 w0, w1, w2, w3;
#define PKW_(P_, B_) attn_body::cvtpk_s(P_[B_], P_[B_ + 1])
                w0 = (attn_body::u32x4){PKW_(P[kt][0], 0), PKW_(P[kt][0], 2), PKW_(P[kt][0], 4), PKW_(P[kt][0], 6)}; w1 = (attn_body::u32x4){PKW_(P[kt][0], 8), PKW_(P[kt][0], 10), PKW_(P[kt][0], 12), PKW_(P[kt][0], 14)};
                w2 = (attn_body::u32x4){PKW_(P[kt][1], 0), PKW_(P[kt][1], 2), PKW_(P[kt][1], 4), PKW_(P[kt][1], 6)}; w3 = (attn_body::u32x4){PKW_(P[kt][1], 8), PKW_(P[kt][1], 10), PKW_(P[kt][1], 12), PKW_(P[kt][1], 14)};
#undef PKW_
                attn_body::pv(o, vb0 + kt * 8192, __builtin_bit_cast(bf16x8, w0), __builtin_bit_cast(bf16x8, w1), __builtin_bit_cast(bf16x8, w2), __builtin_bit_cast(bf16x8, w3)); }
            const unsigned sel = selrow[t];
            const int slot = ownb ? 3 : __popc(sel & ((1u << j) - 1u));
            const int dest = (int)(((rowb + t) * H + h) * 4 + slot);
            if (hi == 0) { wsf[r32] = 1.0f / ls; wsd[r32] = valid ? dest : -1; if (valid) { ML[(size_t)dest * 2] = mx; ML[(size_t)dest * 2 + 1] = ls; } }
            asm volatile("s_waitcnt lgkmcnt(0)" ::: "memory");
#pragma unroll
            for (int r = 0; r < 16; ++r) { const int row = crow(r, hi); const float rl = wsf[row]; const int d = wsd[row];
                if (d >= 0) { PO[(size_t)d * 64 + r32] = (bf16)f2bf(o[0][r] * rl); PO[(size_t)d * 64 + 32 + r32] = (bf16)f2bf(o[1][r] * rl); } }
            asm volatile("s_waitcnt lgkmcnt(0)" ::: "memory");
        }
    }
}
__device__ __forceinline__ void moba_combine_phase(Frame& F, const unsigned* SELT, const bf16* PO, const float* ML, bf16* O) {
    for (int m = F.gw; m < M; m += F.NGW) {
        const int b = m / T, t = m % T, h = F.lane >> 2, qd = F.lane & 3;
        const unsigned sel = SELT[((size_t)b * H + h) * T + t]; const int cnt = __popc(sel);
        const size_t base = ((size_t)m * H + h) * 4;
        float ms[4], ls[4]; float mstar = -INFINITY;
#pragma unroll
        for (int s = 0; s < 4; ++s) { const bool on = (s == 3) || (s < cnt); ms[s] = on ? ML[(base + s) * 2] : -INFINITY; ls[s] = on ? ML[(base + s) * 2 + 1] : 0.f; mstar = fmaxf(mstar, ms[s]); }
        float wsum = 0.f, w[4];
#pragma unroll
        for (int s = 0; s < 4; ++s) { w[s] = ls[s] * __builtin_amdgcn_exp2f(ms[s] - mstar); wsum += w[s]; }
        const float rw = 1.0f / wsum;
        float acc[16];
#pragma unroll
        for (int i = 0; i < 16; ++i) acc[i] = 0.f;
#pragma unroll
        for (int s = 0; s < 4; ++s) { const bool on = (s == 3) || (s < cnt);
            if (on) { const float ws_ = w[s] * rw; const v4u a = *(const v4u*)(PO + (base + s) * 64 + qd * 16), c = *(const v4u*)(PO + (base + s) * 64 + qd * 16 + 8);
                const unsigned wv[8] = {a.x, a.y, a.z, a.w, c.x, c.y, c.z, c.w};
#pragma unroll
                for (int i = 0; i < 8; ++i) { acc[2 * i] += ws_ * __uint_as_float(wv[i] << 16); acc[2 * i + 1] += ws_ * __uint_as_float(wv[i] & 0xffff0000u); } } }
        v4u o0, o1; o0.x = pk2(acc[0], acc[1]); o0.y = pk2(acc[2], acc[3]); o0.z = pk2(acc[4], acc[5]); o0.w = pk2(acc[6], acc[7]); o1.x = pk2(acc[8], acc[9]); o1.y = pk2(acc[10], acc[11]); o1.z = pk2(acc[12], acc[13]); o1.w = pk2(acc[14], acc[15]);
        *(v4u*)(O + (size_t)m * D + h * 64 + qd * 16) = o0; *(v4u*)(O + (size_t)m * D + h * 64 + qd * 16 + 8) = o1;
    }
}
constexpr int WK_REC = 10496;
__device__ __forceinline__ void wkv_build_phase(Frame& F, const bf16* R, const float* DEC, const bf16* KP, const bf16* AP, const bf16* BP, unsigned char* REC0, unsigned char* REC1) {
    LAS unsigned char* L = F.lds + RING_OFF + F.wave * 16384;
    LAS unsigned short* tA = (LAS unsigned short*)L; LAS unsigned short* tB = tA + 1024; LAS unsigned short* tK = tA + 2048; LAS unsigned short* tR = tA + 3072;
    LAS float* fLab = (LAS float*)(L + 8192); LAS float* fLak = fLab + 256; LAS float* fT = fLab + 512;
    const int lane = F.lane, c = lane & 15, g = lane >> 4;
    float rw[16]; unsigned short rk[16], ra[16], rb[16], rr_[16];
#define WB_LOAD(u_) do { const int ch_ = (u_) & 511, bh_ = (u_) >> 9; const size_t base_ = ((size_t)(bh_ >> 4) * T + (size_t)ch_ * 16) * D + (bh_ & 15) * 64 + lane; \
        _Pragma("unroll") for (int t = 0; t < 16; ++t) { const size_t o = base_ + (size_t)t * D; rw[t] = DEC[o]; rk[t] = KP[o]; ra[t] = AP[o]; rb[t] = BP[o]; rr_[t] = R[o]; } } while (0)
    if (F.gw < 2 * H * 512) WB_LOAD(F.gw);
    for (int u = F.gw; u < 2 * H * 512; u += F.NGW) {
        const int ch = u & 511, bh = u >> 9, b = bh >> 4, h = bh & 15;
        unsigned char* rec = (b ? REC1 : REC0) + ((size_t)h * 512 + ch) * WK_REC;
        float Af[16], Bf[16], Kf[16], Rf[16]; float gm = 1.f;
#pragma unroll
        for (int t = 0; t < 16; ++t) {
            const float w = rw[t], kp = bf2f(rk[t]), ap = bf2f(ra[t]), bp = bf2f(rb[t]), rr = bf2f(rr_[t]);
            Af[t] = ap * gm; gm *= w; const float inv = __builtin_amdgcn_rcpf(gm); Bf[t] = bp * inv; Kf[t] = kp * inv; Rf[t] = rr * gm;
            tA[t * 64 + lane] = (unsigned short)f2bf(Af[t]); tB[t * 64 + lane] = (unsigned short)f2bf(Bf[t]); tK[t * 64 + lane] = (unsigned short)f2bf(Kf[t]); tR[t * 64 + lane] = (unsigned short)f2bf(Rf[t]); }
        if (u + F.NGW < 2 * H * 512) WB_LOAD(u + F.NGW);
        *(float*)(rec + 10240 + lane * 4) = gm;
#pragma unroll
        for (int gq = 0; gq < 4; ++gq) { v4u o; o.x = pk2(Bf[4 * gq], Bf[4 * gq + 1]); o.y = pk2(Bf[4 * gq + 2], Bf[4 * gq + 3]); o.z = pk2(Kf[4 * gq], Kf[4 * gq + 1]); o.w = pk2(Kf[4 * gq + 2], Kf[4 * gq + 3]);
            *(v4u*)(rec + 6144 + lane * 64 + gq * 16) = o; }
        LDS_WAIT(); asm volatile("" ::: "memory");
        pg8::f32x4 lab = {0.f, 0.f, 0.f, 0.f}, lak = lab, mrb = lab, mrk = lab;
#pragma unroll
        for (int s = 0; s < 2; ++s) { const int o = c * 64 + 8 * g + 32 * s;
            const bf16x8 fa = *(const LAS bf16x8*)(tA + o), fb = *(const LAS bf16x8*)(tB + o), fk = *(const LAS bf16x8*)(tK + o), fr = *(const LAS bf16x8*)(tR + o);
            lab = __builtin_amdgcn_mfma_f32_16x16x32_bf16(fa, fb, lab, 0, 0, 0); lak = __builtin_amdgcn_mfma_f32_16x16x32_bf16(fa, fk, lak, 0, 0, 0);
            mrb = __builtin_amdgcn_mfma_f32_16x16x32_bf16(fr, fb, mrb, 0, 0, 0); mrk = __builtin_amdgcn_mfma_f32_16x16x32_bf16(fr, fk, mrk, 0, 0, 0); }
#pragma unroll
        for (int r = 0; r < 4; ++r) { const int t = 4 * g + r; if (!(c < t)) { lab[r] = 0.f; lak[r] = 0.f; } if (!(c <= t)) { mrb[r] = 0.f; mrk[r] = 0.f; }
            fLab[t * 16 + c] = lab[r]; fLak[t * 16 + c] = lak[r]; }
        LDS_WAIT(); asm volatile("" ::: "memory");
        float Tc[16];
#pragma unroll
        for (int i = 0; i < 16; ++i) { float a_ = (i == c) ? 1.f : 0.f;
#pragma unroll
            for (int j = 0; j < i; ++j) a_ += fLab[i * 16 + j] * Tc[j];
            Tc[i] = a_; }
        if (g == 0) {
#pragma unroll
            for (int i = 0; i < 16; ++i) fT[i * 16 + c] = Tc[i]; }
        LDS_WAIT(); asm volatile("" ::: "memory");
        { const int kt = lane >> 4, gq = (lane >> 2) & 3, jj = lane & 3, slot = (kt >> 1) * 1024 + gq * 16 + (jj + 4 * (kt & 1)) * 2;
#pragma unroll
          for (int t = 0; t < 16; ++t) { float w_ = 0.f;
#pragma unroll
              for (int j = 0; j <= t; ++j) w_ += fT[t * 16 + j] * Af[j];
              *(unsigned short*)(rec + slot + t * 64) = (unsigned short)f2bf(w_); *(unsigned short*)(rec + 3072 + slot + t * 64) = (unsigned short)f2bf(Rf[t]); } }
        { const int gq = c >> 2, jq = c & 3;
#pragma unroll
          for (int r = 0; r < 4; ++r) { const int t = 4 * g + r; float tl = 0.f;
#pragma unroll
              for (int j = 0; j < 16; ++j) tl += fT[t * 16 + j] * fLak[j * 16 + c];
              unsigned char* p = rec + 2048 + t * 64 + gq * 16;
              *(unsigned short*)(p + jq * 2) = (unsigned short)f2bf(tl); *(unsigned short*)(p + 8 + jq * 2) = 0;
              *(unsigned short*)(p + 3072 + jq * 2) = (unsigned short)f2bf(mrb[r]); *(unsigned short*)(p + 3072 + 8 + jq * 2) = (unsigned short)f2bf(mrk[r]); } }
        LDS_WAIT(); asm volatile("" ::: "memory");
    }
#undef WB_LOAD
}
__device__ __forceinline__ void wkv_chain_phase(Frame& F, const unsigned char* REC0, const unsigned char* REC1, const bf16* VP, bf16* Y) {
    if (F.vcu >= 32) return;
    constexpr int GC = 4, GB = GC * WK_REC  , VBOFF = GB, BUFB = GB + 8192  , YB_OFF = 2 * BUFB, NG = 512 / GC;
    const int b = F.vcu >> 4, h = F.vcu & 15, lane = F.lane, c = lane & 15, g = lane >> 4, vt = F.wave;
    const unsigned char* rbase = (b ? REC1 : REC0) + (size_t)h * 512 * WK_REC; const size_t rowb = (size_t)b * T;
    LAS unsigned char* L = F.lds + RING_OFF;
    constexpr int NP = (GB / 16 + 511) / 512;
    struct Stg { v4u p[NP]; v4u v; };
    Stg g0, g1;
#define WK_LOAD(gi, G) do { const unsigned char* s_ = rbase + (size_t)(gi) * GB; _Pragma("unroll") for (int i = 0; i < NP; ++i) { const int o_ = (F.tid + i * 512) * 16; if (o_ < GB) G.p[i] = *(const v4u*)(s_ + o_); } \
        G.v = *(const v4u*)(VP + (rowb + (size_t)(gi) * 64 + (F.tid >> 3)) * D + h * 64 + (F.tid & 7) * 8); } while (0)
#define WK_STORE(bf, G) do { _Pragma("unroll") for (int i = 0; i < NP; ++i) { const int o_ = (F.tid + i * 512) * 16; if (o_ < GB) *(LAS v4u*)(L + (bf) * BUFB + o_) = G.p[i]; } \
        { const int t_ = F.tid >> 3, v0_ = (F.tid & 7) * 8; LAS unsigned short* d_ = (LAS unsigned short*)(L + (bf) * BUFB + VBOFF) + ((((t_ >> 4) * 4) * 4 + ((t_ >> 2) & 3)) * 16) * 4 + (t_ & 3); \
          const unsigned w_[4] = {G.v.x, G.v.y, G.v.z, G.v.w}; \
          _Pragma("unroll") for (int e = 0; e < 8; ++e) { const int v_ = v0_ + e; d_[((v_ >> 4) * 64 + (v_ & 15)) * 4] = (unsigned short)((e & 1) ? (w_[e >> 1] >> 16) : (w_[e >> 1] & 0xffffu)); } } } while (0)
    WK_LOAD(0, g0); WK_STORE(0, g0); WK_LOAD(1, g0); __syncthreads();
    pg8::f32x4 Hs[4]; Hs[0] = (pg8::f32x4){0.f, 0.f, 0.f, 0.f}; Hs[1] = Hs[0]; Hs[2] = Hs[0]; Hs[3] = Hs[0];
    for (int g2 = 0; g2 < NG; g2 += 2) {
#pragma unroll
      for (int par = 0; par < 2; ++par) {
        const int gi = g2 + par, bf = par;
        if (gi + 2 < NG) { if (par == 0) WK_LOAD(gi + 2, g1); else WK_LOAD(gi + 2, g0); }
        if (F.wave < 4) {
            struct Ops { bf16x8 au0, au1, au2, ay0, ay1, ay2, bk0, bk1, bk2, bk3; pg8::f32x4 ga0, ga1, ga2, ga3; u32x2 vb; };
            const int ao = (c * 32 + g * 8) * 2;
#define WK_FETCH(ci_, X) do { const LAS unsigned char* rec_ = L + bf * BUFB + (ci_) * WK_REC; \
                X.au0 = *(const LAS bf16x8*)(rec_ + ao); X.au1 = *(const LAS bf16x8*)(rec_ + 1024 + ao); X.au2 = *(const LAS bf16x8*)(rec_ + 2048 + ao); \
                X.ay0 = *(const LAS bf16x8*)(rec_ + 3072 + ao); X.ay1 = *(const LAS bf16x8*)(rec_ + 4096 + ao); X.ay2 = *(const LAS bf16x8*)(rec_ + 5120 + ao); \
                X.bk0 = *(const LAS bf16x8*)(rec_ + 6144 + ao); X.bk1 = *(const LAS bf16x8*)(rec_ + 7168 + ao); X.bk2 = *(const LAS bf16x8*)(rec_ + 8192 + ao); X.bk3 = *(const LAS bf16x8*)(rec_ + 9216 + ao); \
                X.ga0 = *(const LAS pg8::f32x4*)(rec_ + 10240 + (4 * g) * 4); X.ga1 = *(const LAS pg8::f32x4*)(rec_ + 10240 + (16 + 4 * g) * 4); X.ga2 = *(const LAS pg8::f32x4*)(rec_ + 10240 + (32 + 4 * g) * 4); X.ga3 = *(const LAS pg8::f32x4*)(rec_ + 10240 + (48 + 4 * g) * 4); \
                X.vb = *(const LAS u32x2*)(L + bf * BUFB + VBOFF + (((((ci_) * 4 + vt) * 4 + g) * 16 + c) * 8)); } while (0)
            Ops cu; WK_FETCH(0, cu);
#pragma unroll
            for (int ci = 0; ci < GC; ++ci) {
                Ops nx = cu;
                if (ci + 1 < GC) WK_FETCH(ci + 1, nx);
                v4u h0, h1; h0.x = attn_body::cvtpk_s(Hs[0][0], Hs[0][1]); h0.y = attn_body::cvtpk_s(Hs[0][2], Hs[0][3]); h0.z = attn_body::cvtpk_s(Hs[1][0], Hs[1][1]); h0.w = attn_body::cvtpk_s(Hs[1][2], Hs[1][3]);
                h1.x = attn_body::cvtpk_s(Hs[2][0], Hs[2][1]); h1.y = attn_body::cvtpk_s(Hs[2][2], Hs[2][3]); h1.z = attn_body::cvtpk_s(Hs[3][0], Hs[3][1]); h1.w = attn_body::cvtpk_s(Hs[3][2], Hs[3][3]);
                const bf16x8 hb0 = __builtin_bit_cast(bf16x8, h0), hb1 = __builtin_bit_cast(bf16x8, h1);
                v4u vz; vz.x = cu.vb.x; vz.y = cu.vb.y; vz.z = 0u; vz.w = 0u;
                const pg8::f32x4 z4 = {0.f, 0.f, 0.f, 0.f};
                const pg8::f32x4 ua = __builtin_amdgcn_mfma_f32_16x16x32_bf16(cu.au0, hb0, z4, 0, 0, 0), ub_ = __builtin_amdgcn_mfma_f32_16x16x32_bf16(cu.au1, hb1, z4, 0, 0, 0),
                                 uc = __builtin_amdgcn_mfma_f32_16x16x32_bf16(cu.au2, __builtin_bit_cast(bf16x8, vz), z4, 0, 0, 0);
                pg8::f32x4 yt = __builtin_amdgcn_mfma_f32_16x16x32_bf16(cu.ay0, hb0, z4, 0, 0, 0);
                yt = __builtin_amdgcn_mfma_f32_16x16x32_bf16(cu.ay1, hb1, yt, 0, 0, 0);
                const pg8::f32x4 ut = (ua + ub_) + uc;
                v4u ubw; ubw.x = attn_body::cvtpk_s(ut[0], ut[1]); ubw.y = attn_body::cvtpk_s(ut[2], ut[3]); ubw.z = cu.vb.x; ubw.w = cu.vb.y;
                const bf16x8 ub = __builtin_bit_cast(bf16x8, ubw);
                Hs[0] = __builtin_amdgcn_mfma_f32_16x16x32_bf16(cu.bk0, ub, Hs[0], 0, 0, 0); Hs[1] = __builtin_amdgcn_mfma_f32_16x16x32_bf16(cu.bk1, ub, Hs[1], 0, 0, 0);
                Hs[2] = __builtin_amdgcn_mfma_f32_16x16x32_bf16(cu.bk2, ub, Hs[2], 0, 0, 0); Hs[3] = __builtin_amdgcn_mfma_f32_16x16x32_bf16(cu.bk3, ub, Hs[3], 0, 0, 0);
                yt = __builtin_amdgcn_mfma_f32_16x16x32_bf16(cu.ay2, ub, yt, 0, 0, 0);
                Hs[0] = Hs[0] * cu.ga0; Hs[1] = Hs[1] * cu.ga1; Hs[2] = Hs[2] * cu.ga2; Hs[3] = Hs[3] * cu.ga3;
                LAS unsigned short* yb = (LAS unsigned short*)(L + YB_OFF + bf * 8192) + (ci * 16 + 4 * g) * 64 + vt * 16 + c;
#pragma unroll
                for (int r = 0; r < 4; ++r) yb[r * 64] = (unsigned short)f2bf(yt[r]);
                cu = nx;
            }
#undef WK_FETCH
        }
        if (gi + 1 < NG) { if (par == 0) WK_STORE(1, g0); else WK_STORE(0, g1); }
        __syncthreads();
        { const v4u yv = *(const LAS v4u*)(L + YB_OFF + bf * 8192 + F.tid * 16);
          *(v4u*)(Y + (rowb + (size_t)gi * 64 + (F.tid >> 3)) * D + h * 64 + (F.tid & 7) * 8) = yv; }
      }
    }
#undef WK_LOAD
#undef WK_STORE
}


#ifdef DBG_CUT
__device__ __forceinline__ void dbg_copy(Frame& F, const void* src, bool is_bf16, float* out) {
    for (size_t i = (size_t)F.gw * 64 + F.lane; i < (size_t)M * D; i += (size_t)F.NGW * 64) out[i] = is_bf16 ? bf2f(((const bf16*)src)[i]) : ((const float*)src)[i];
}
#ifndef DBG_LAYER
#define DBG_LAYER -1
#endif
#ifndef DBG_SCALE
#define DBG_SCALE 100.f
#define DBG_SUB 1.f
#endif
#define CUT(k, off, isbf) if (DBG_CUT == (k) && (DBG_LAYER < 0 || layer == DBG_LAYER)) { unsigned char* ws = WSB(); dbg_copy(F, ws + (off), (isbf), GOUT()); return; }
#else
#define CUT(k, off, isbf)
#endif
#ifndef REP_GEMM
#define REP_GEMM 1
#endif
#ifndef REP_THIN
#define REP_THIN 1
#endif
#ifndef REP_CONV
#define REP_CONV REP_THIN
#endif
#ifndef REP_LN
#define REP_LN REP_THIN
#endif
#ifndef REP_RW
#define REP_RW REP_THIN
#endif
#ifndef REP_ATTN
#define REP_ATTN 1
#endif
#ifndef REP_SCAN
#define REP_SCAN 1
#endif
#ifndef REP_WKB
#define REP_WKB 1
#endif
#ifndef REP_WKC
#define REP_WKC 1
#endif
#ifndef REP_BAR
#define REP_BAR 1
#endif
#define GEMM_BIG(EpiT, SchedT) for (int rg_ = 0; rg_ < REP_GEMM; ++rg_) pg8::gemm_phase<EpiT, SchedT, true, true>
#define GEMM_ONE(EpiT, SchedT) for (int rg_ = 0; rg_ < REP_GEMM; ++rg_) pg8::gemm_phase<EpiT, SchedT, false, true>
__global__ void __launch_bounds__(NWAVES * 64, 2) fwd_kernel(Args args) {
    extern __shared__ __attribute__((aligned(16))) unsigned char lds[];
    Frame F;
    F.lds = (LAS unsigned char*)lds; F.MISC = (volatile LAS unsigned*)(F.lds + MISC_OFF);
    F.wave = __builtin_amdgcn_readfirstlane((int)threadIdx.x >> 6); F.lane = fresh_lane(); F.tid = F.wave * 64 + F.lane;
    F.G = gridDim.x; { const int bx = blockIdx.x; F.vcu = (F.G % 8 == 0) ? (bx % 8) * (F.G / 8) + bx / 8 : bx; }
    F.gw = F.vcu * NWAVES + F.wave; F.NGW = F.G * NWAVES;
    F.ws = args.ws; F.ctl = (gu32*)(args.ws + WS_CTL);
#ifdef DBG_LDSZERO
    for (int u = F.tid; u < LDS_BYTES / 4; u += NWAVES * 64) ((LAS unsigned*)(F.lds))[u] = 0u;
#else
    for (int u = F.tid; u < (LDS_BYTES - LDSCTL_OFF) / 4; u += NWAVES * 64) ((LAS unsigned*)(F.lds + LDSCTL_OFF))[u] = 0u;
#endif
    __syncthreads();
    XcdBarrier bar = xcd_barrier_post((unsigned*)(F.ctl + CW_BAR), F.MISC + 8, F.tid == 0);
#define GRID_BAR() do { { GAS unsigned* b_ = (GAS unsigned*)bar.bar; asm volatile("" : "+s"(b_), "+s"(bar.x)); bar.bar = (unsigned*)b_; } for (int rb_ = 0; rb_ < REP_BAR; ++rb_) xcd_barrier(bar, F.wave == 0 && fresh_lane() == 0); } while (0)
#define WSB() ({ F.lane = fresh_lane(); F.tid = F.wave * 64 + F.lane; asm volatile("" : "+s"(F.G), "+s"(F.wave), "+s"(F.vcu), "+s"(F.gw), "+s"(F.NGW), "+s"(bx)); GAS unsigned char* p_ = (GAS unsigned char*)args.ws; asm volatile("" : "+s"(p_)); (unsigned char*)p_; })
#define GOUT() ({ GAS float* o_ = (GAS float*)args.out; asm volatile("" : "+s"(o_)); (float*)o_; })
#define INP(i) ({ const __attribute__((address_space(4))) char* k_ = (const __attribute__((address_space(4))) char*)__builtin_amdgcn_kernarg_segment_ptr(); asm volatile("" : "+s"(k_)); const GAS float* g_ = (const GAS float*)(*(const float* const __attribute__((address_space(4)))*)(k_ + 8 * (i))); asm volatile("" : "+s"(g_)); (const float*)g_; })
    LAS unsigned char* ring = F.lds + RING_OFF;
    int bx = (int)blockIdx.x;

    for (int rt_ = 0; rt_ < REP_CONV; ++rt_) conv_rwkv(F, 0); for (int rt_ = 0; rt_ < REP_CONV; ++rt_) conv_dense(F, 0);
    GRID_BAR();

#ifndef LAYER_LO
#define LAYER_LO 0
#define LAYER_HI 4
#endif
    for (int layer = LAYER_LO; layer < LAYER_HI; ++layer) {
        const bool moe = (layer & 1) != 0; const int fe = layer >> 1;
        if (layer < 2) {
            const int l = layer;
            { unsigned char* ws = WSB(); for (int rt_ = 0; rt_ < REP_RW; ++rt_) mix_phase(F, layer == 0 ? INP(I_X) : (const float*)(ws + WS_H), INP(I_MU) + (size_t)l * 6 * D, (bf16*)(ws + RS_XM)); }
            GRID_BAR();
            { unsigned char* ws = WSB(); pg8::Gemm g{D, D, D}; pg8::SchedStd S; S.init(M, 4096, F.G, bx, ws + RS_XM, D, ws + WM_BT1 + (size_t)l * RW_LSTRIDE, D, 1, (size_t)M * D * 2);
              pg8::EpiRkv E{(bf16*)(ws + RS_RKV), (long)RS_LH - (long)RS_RKV, (size_t)M * D};
              GEMM_BIG(pg8::EpiRkv, pg8::SchedStd)(ring, g, S, E, F.wave); }
            GRID_BAR();
            CUT(1, RS_RKV, true)
            { unsigned char* ws = WSB(); pg8::Gemm g{256, D, 256}; pg8::SchedStd S; S.init(M, 4096, F.G, bx, ws + RS_LH, D, ws + WM_BT2 + (size_t)l * RW_LSTRIDE, 256, 2, 0);
              pg8::EpiLoraUpAll E{{(void*)(ws + RS_DEC), INP(I_W0) + (size_t)l * D}, {(void*)(ws + RS_AB), INP(I_A0) + (size_t)l * D}, {(void*)(ws + RS_VG), INP(I_V0)}, {(void*)(ws + RS_GG), nullptr}};
              GEMM_BIG(pg8::EpiLoraUpAll, pg8::SchedStd)(ring, g, S, E, F.wave); }
            GRID_BAR();
            CUT(2, RS_DEC, false) CUT(60, RS_VG, true) CUT(61, RS_GG, true) CUT(62, RS_LH, true) CUT(63, RS_AB, false)
            { unsigned char* ws = WSB(); for (int rt_ = 0; rt_ < REP_RW; ++rt_) prep_phase(F, l, (bf16*)(ws + RS_RKV), (const float*)(ws + RS_AB), (bf16*)(ws + RS_LH), INP(I_V0), INP(I_V2), (bf16*)(ws + WS_VFIRST), INP(I_KK) + (size_t)l * D, INP(I_KA) + (size_t)l * D,
                                                   (bf16*)(ws + RS_KP), (bf16*)(ws + RS_AP), (bf16*)(ws + RS_BP), (bf16*)(ws + RS_VP)); }
            GRID_BAR();
            CUT(3, RS_KP, true) CUT(7, RS_VP, true) CUT(8, RS_BP, true) CUT(9, RS_DEC, false)
#ifdef WKV_SEQ
            for (int rep_ = 0; rep_ < REP_SCAN; ++rep_) {
              { unsigned char* ws = WSB(); scan_phase(F, (bf16*)(ws + RS_RKV), (float*)(ws + RS_DEC), (bf16*)(ws + RS_KP), (bf16*)(ws + RS_AP), (bf16*)(ws + RS_BP), (bf16*)(ws + RS_VP), (bf16*)(ws + WS_Y)); }
              if (rep_ + 1 < REP_SCAN) GRID_BAR(); }
            GRID_BAR();
#else
            { unsigned char* ws = WSB(); for (int rq_ = 0; rq_ < REP_WKB; ++rq_) wkv_build_phase(F, (bf16*)(ws + RS_RKV), (float*)(ws + RS_DEC), (bf16*)(ws + RS_KP), (bf16*)(ws + RS_AP), (bf16*)(ws + RS_BP), ws + RS_REC0, ws + RS_REC1); }
            GRID_BAR();
#ifdef DBG_CUT
            if (DBG_CUT == 39 && (DBG_LAYER < 0 || layer == DBG_LAYER)) { unsigned char* ws = WSB(); const unsigned short* s_ = (const unsigned short*)(ws + RS_REC0); float* o_ = GOUT();
                for (size_t i = (size_t)F.gw * 64 + F.lane; i < (size_t)M * D; i += (size_t)F.NGW * 64) o_[i] = (float)s_[i]; return; }
#endif
            { unsigned char* ws = WSB(); for (int rq_ = 0; rq_ < REP_WKC; ++rq_) wkv_chain_phase(F, ws + RS_REC0, ws + RS_REC1, (bf16*)(ws + RS_VP), (bf16*)(ws + WS_Y)); }
            if (F.vcu >= 32) {
                const int gw_ = F.gw, ngw_ = F.NGW; F.gw = (F.vcu - 32) * NWAVES + F.wave; F.NGW = (F.G - 32) * NWAVES;
                for (int rt_ = 0; rt_ < REP_CONV; ++rt_) { if (l == 0) conv_moe(F, 0); else { conv_dense(F, 1); conv_moba(F, 0); } }
                F.gw = gw_; F.NGW = ngw_; }
            GRID_BAR();
#endif
            CUT(4, WS_Y, true)
#ifdef DBG_CUT
            if (DBG_CUT == 38 && (DBG_LAYER < 0 || layer == DBG_LAYER)) {
                { unsigned char* ws = WSB(); scan_phase(F, (bf16*)(ws + RS_RKV), (float*)(ws + RS_DEC), (bf16*)(ws + RS_KP), (bf16*)(ws + RS_AP), (bf16*)(ws + RS_BP), (bf16*)(ws + RS_VP), (bf16*)(ws + WS_SCR + 128 * MiB)); }
                GRID_BAR();
                { unsigned char* ws = WSB(); const bf16* a_ = (const bf16*)(ws + WS_Y); const bf16* b_ = (const bf16*)(ws + WS_SCR + 128 * MiB); float* o_ = GOUT();
                  for (size_t i = (size_t)F.gw * 64 + F.lane; i < (size_t)M * D; i += (size_t)F.NGW * 64) { float d_ = DBG_SCALE * (bf2f(a_[i]) - DBG_SUB * bf2f(b_[i])); if (!(fabsf(d_) < 1e30f)) d_ = 1e6f; o_[i] = d_; } }
                return; }
#endif
            { unsigned char* ws = WSB(); for (int rt_ = 0; rt_ < REP_RW; ++rt_) post_phase(F, (bf16*)(ws + WS_Y), (bf16*)(ws + RS_RKV), (bf16*)(ws + RS_KP), (bf16*)(ws + RS_VP), (bf16*)(ws + RS_GG),
                                                   INP(I_RK) + (size_t)l * D, INP(I_GNG) + (size_t)l * D, INP(I_GNB) + (size_t)l * D, (bf16*)(ws + RS_YG)); }
            GRID_BAR();
            CUT(5, RS_YG, true)
            { unsigned char* ws = WSB(); pg8::Gemm g{D, D, D}; pg8::SchedStd S; S.init(M, D, F.G, bx, ws + RS_YG, D, ws + WM_OUT + (size_t)l * RW_LSTRIDE, D);
              pg8::EpiResF32 E{layer == 0 ? INP(I_X) : (const float*)(ws + WS_H), (float*)(ws + RS_PRE), ALPHA};
              GEMM_ONE(pg8::EpiResF32, pg8::SchedStd)(ring, g, S, E, F.wave); }
            GRID_BAR();
            CUT(6, RS_PRE, false)
        } else {
            const int j = layer - 2;
            { unsigned char* ws = WSB(); pg8::Gemm g{D, D, D}; pg8::SchedStd S; S.init(M, j == 0 ? 3 * D : D, F.G, bx, ws + WS_HB, D, ws + WM_QKV, D);
              pg8::EpiQKV E{(bf16*)(ws + BS_Q), ((long)WS_K - (long)BS_Q) / 2, ((long)WS_V - (long)BS_Q) / 2, attn_body::C2};
              GEMM_BIG(pg8::EpiQKV, pg8::SchedStd)(ring, g, S, E, F.wave); }
            GRID_BAR();
            CUT(31, BS_Q, true) CUT(32, WS_K, true) CUT(33, WS_V, true)
            if (j == 0) { unsigned char* ws = WSB(); for (int rt_ = 0; rt_ < REP_THIN; ++rt_) kmean_phase(F, (bf16*)(ws + WS_K), (float*)(ws + WS_KMEAN)); GRID_BAR(); }
#ifndef NO_GATE
            { unsigned char* ws = WSB(); for (int rt_ = 0; rt_ < REP_THIN; ++rt_) gate_phase(F, (bf16*)(ws + BS_Q), (float*)(ws + WS_KMEAN), (unsigned*)(ws + WS_SEL)); }
#endif
            GRID_BAR();
#ifdef DBG_CUT
            if (DBG_CUT == 35) { unsigned char* ws = WSB(); const unsigned* s_ = (const unsigned*)(ws + WS_SEL); for (size_t i = (size_t)F.gw * 64 + F.lane; i < (size_t)M * D; i += (size_t)F.NGW * 64) args.out[i] = (float)(s_[i & (size_t)(M * 16 - 1)] % 65521u); return; }
#endif
#ifdef ATTN_DIRECT
            { unsigned char* ws = WSB(); attn_direct_phase(F, (const bf16*)(ws + BS_Q), (const bf16*)(ws + WS_K), (const bf16*)(ws + WS_V), (const unsigned*)(ws + WS_SEL), (bf16*)(ws + BS_O)); }
            GRID_BAR();
#else
            { unsigned char* ws = WSB(); for (int ra_ = 0; ra_ < REP_ATTN; ++ra_) moba_attn_phase(F, (const bf16*)(ws + BS_Q), (const bf16*)(ws + WS_K), (const bf16*)(ws + WS_V), (const unsigned*)(ws + WS_SEL), (bf16*)(ws + BS_PO), (float*)(ws + BS_ML), F.ctl + CW_QCTR + 64 * (j + 2 * ra_)); }
            GRID_BAR();
            { unsigned char* ws = WSB(); for (int rt_ = 0; rt_ < REP_THIN; ++rt_) moba_combine_phase(F, (const unsigned*)(ws + WS_SEL), (const bf16*)(ws + BS_PO), (const float*)(ws + BS_ML), (bf16*)(ws + BS_O)); }
            GRID_BAR();
#endif
            CUT(36, BS_O, true)
#ifdef DBG_CUT
            if (DBG_CUT == 37 && (DBG_LAYER < 0 || layer == DBG_LAYER)) {
                { unsigned char* ws = WSB(); attn_direct_phase(F, (const bf16*)(ws + BS_Q), (const bf16*)(ws + WS_K), (const bf16*)(ws + WS_V), (const unsigned*)(ws + WS_SEL), (bf16*)(ws + BS_PRE)); }
                GRID_BAR();
                { unsigned char* ws = WSB(); const bf16* a_ = (const bf16*)(ws + BS_O); const bf16* b_ = (const bf16*)(ws + BS_PRE); float* o_ = GOUT();
                  for (size_t i = (size_t)F.gw * 64 + F.lane; i < (size_t)M * D; i += (size_t)F.NGW * 64) o_[i] = 1000.f * (bf2f(a_[i]) - bf2f(b_[i])); }
                return; }
#endif
            { unsigned char* ws = WSB(); pg8::Gemm g{D, D, D}; pg8::SchedStd S; S.init(M, D, F.G, bx, ws + BS_O, D, ws + WM_O, D);
              pg8::EpiResF32 E{(const float*)(ws + WS_H), (float*)(ws + BS_PRE), ALPHA};
              GEMM_ONE(pg8::EpiResF32, pg8::SchedStd)(ring, g, S, E, F.wave); }
            GRID_BAR();
        }
        { unsigned char* ws = WSB(); const float* PREm = (const float*)(ws + (layer < 2 ? RS_PRE : BS_PRE));
          const float* g0 = INP(I_LNG) + (size_t)(layer * 2) * D; const float* b0 = INP(I_LNB) + (size_t)(layer * 2) * D;
          if (moe) for (int rt_ = 0; rt_ < REP_LN; ++rt_) ln_phase<0, true>(F, PREm, nullptr, nullptr, nullptr, g0, b0, (float*)(ws + WS_H), (bf16*)(ws + WS_HB), INP(I_ROUTER) + (size_t)fe * D * NE, (int*)(ws + WS_TOKE), (float*)(ws + WS_TOKW), (int*)(ws + WS_BLKCNT));
          else for (int rt_ = 0; rt_ < REP_LN; ++rt_) ln_phase<0, false>(F, PREm, nullptr, nullptr, nullptr, g0, b0, (float*)(ws + WS_H), (bf16*)(ws + WS_HB), nullptr, nullptr, nullptr, nullptr); }
        if (layer == 0) for (int rt_ = 0; rt_ < REP_CONV; ++rt_) conv_rwkv(F, 1); else if (layer == 2) for (int rt_ = 0; rt_ < REP_CONV; ++rt_) conv_moba(F, 1);
        GRID_BAR();
        CUT(10 + layer, WS_H, false)
        if (!moe) {
            { unsigned char* ws = WSB(); pg8::Gemm g{D, D, D}; pg8::SchedStd S; S.init(M, 2 * FF, F.G, bx, ws + WS_HB, D, ws + WF_GU, D);
              pg8::EpiSwiGLU E{(void*)(ws + FS_HID), FF, 1.0f, 1.0f};
              GEMM_BIG(pg8::EpiSwiGLU, pg8::SchedStd)(ring, g, S, E, F.wave); }
            GRID_BAR();
            { unsigned char* ws = WSB(); pg8::Gemm g{FF, FF, FF}; pg8::SchedStd S; S.init(M, D, F.G, bx, ws + FS_HID, FF, ws + WF_DN, FF);
              pg8::EpiResF32 E{(const float*)(ws + WS_H), (float*)(ws + FS_PRE), ALPHA};
              GEMM_ONE(pg8::EpiResF32, pg8::SchedStd)(ring, g, S, E, F.wave); }
            GRID_BAR();
            { unsigned char* ws = WSB(); const float* g1 = INP(I_LNG) + (size_t)(layer * 2 + 1) * D; const float* b1 = INP(I_LNB) + (size_t)(layer * 2 + 1) * D;
              for (int rt_ = 0; rt_ < REP_LN; ++rt_) ln_phase<0, false>(F, (const float*)(ws + FS_PRE), nullptr, nullptr, nullptr, g1, b1, (float*)(ws + WS_H), (bf16*)(ws + WS_HB), nullptr, nullptr, nullptr, nullptr); }
            if (layer == 2) for (int rt_ = 0; rt_ < REP_CONV; ++rt_) conv_moe(F, 1);
            GRID_BAR();
        } else {
            { unsigned char* ws = WSB(); for (int rt_ = 0; rt_ < REP_THIN; ++rt_) moe_gather_phase(F, (const int*)(ws + WS_BLKCNT), (const int*)(ws + WS_TOKE), (const float*)(ws + WS_TOKW), (int*)(ws + WS_TOKR), (float*)(ws + WS_GW), (const float*)(ws + WS_H), (unsigned char*)(ws + ES_XG)); }
            GRID_BAR();
            { unsigned char* ws = WSB(); const LAS int* pp = (const LAS int*)(F.lds + MISC_OFF + 64);
              pg8::Gemm g{D / 2, D / 2, D / 2};
              pg8::SchedMoe S{2 * FFE / 256, F.G, bx, pp, (const char*)(ws + ES_XG), (const char*)(ws + WE_GU), (size_t)256 * D, (size_t)256 * D, (size_t)2 * FFE * D, 0};
              pg8::EpiSwiGLUT<MOE_DOWN_F8 != 0> E{(void*)(ws + ES_HID), FFE, 1.0f / MOE_WSCALE, MOE_HSCALE};
              for (int rg_ = 0; rg_ < REP_GEMM; ++rg_) pg8::gemm_phase<pg8::EpiSwiGLUT<MOE_DOWN_F8 != 0>, pg8::SchedMoe, true, true, true>(ring, g, S, E, F.wave); }
            GRID_BAR();
            { unsigned char* ws = WSB(); const LAS int* pp = (const LAS int*)(F.lds + MISC_OFF + 64);
#if MOE_DOWN_F8
              { pg8::Gemm g{FFE / 2, FFE / 2, FFE / 2}; pg8::SchedMoe S{D / 256, F.G, bx, pp, (const char*)(ws + ES_HID), (const char*)(ws + WE_DN), (size_t)256 * FFE, (size_t)256 * FFE, (size_t)D * FFE, 2 * 256};
                pg8::EpiMoeDown E{(float*)(ws + ES_YP), (const float*)(ws + WS_GW), 1.0f / (MOE_HSCALE * MOE_DSCALE)};
                for (int rg_ = 0; rg_ < REP_GEMM; ++rg_) pg8::gemm_phase<pg8::EpiMoeDown, pg8::SchedMoe, true, true, true>(ring, g, S, E, F.wave); }
              { pg8::Gemm g{256, FFE / 2, FFE / 2}; pg8::SchedMoeTail S{D / 256, F.G, bx, 2 * 256, 7, pp, (const char*)(ws + ES_HID), (const char*)(ws + WE_DN), (size_t)256 * FFE, (size_t)256 * FFE, (size_t)D * FFE, (size_t)512};
                pg8::EpiMoeDownSlab E{(float*)(ws + ES_YS), (const float*)(ws + WS_GW), bx, 7, 1.0f / (MOE_HSCALE * MOE_DSCALE)};
                for (int rg_ = 0; rg_ < REP_GEMM; ++rg_) pg8::gemm_phase<pg8::EpiMoeDownSlab, pg8::SchedMoeTail, false, true, true>(ring, g, S, E, F.wave); } }
#else
              { pg8::Gemm g{FFE, FFE, FFE}; pg8::SchedMoe S{D / 256, F.G, bx, pp, (const char*)(ws + ES_HID), (const char*)(ws + WE_DN), (size_t)256 * FFE * 2, (size_t)256 * FFE * 2, (size_t)D * FFE * 2, 2 * 256};
                pg8::EpiMoeDown E{(float*)(ws + ES_YP), (const float*)(ws + WS_GW), 1.0f};
                GEMM_BIG(pg8::EpiMoeDown, pg8::SchedMoe)(ring, g, S, E, F.wave); }
              { pg8::Gemm g{512, FFE, FFE}; pg8::SchedMoeTail S{D / 256, F.G, bx, 2 * 256, 7, pp, (const char*)(ws + ES_HID), (const char*)(ws + WE_DN), (size_t)256 * FFE * 2, (size_t)256 * FFE * 2, (size_t)D * FFE * 2, (size_t)512 * 2};
                pg8::EpiMoeDownSlab E{(float*)(ws + ES_YS), (const float*)(ws + WS_GW), bx, 7, 1.0f};
                GEMM_ONE(pg8::EpiMoeDownSlab, pg8::SchedMoeTail)(ring, g, S, E, F.wave); } }
#endif
            GRID_BAR();
            { unsigned char* ws = WSB(); const float* g1 = INP(I_LNG) + (size_t)(layer * 2 + 1) * D; const float* b1 = INP(I_LNB) + (size_t)(layer * 2 + 1) * D;
              if (layer == 3) ln_phase<1, false>(F, (const float*)(ws + ES_YS), (const float*)(ws + WS_H), (const float*)(ws + ES_YP), (const int*)(ws + WS_TOKR), g1, b1, GOUT(), nullptr, nullptr, nullptr, nullptr, nullptr);
              else ln_phase<1, false>(F, (const float*)(ws + ES_YS), (const float*)(ws + WS_H), (const float*)(ws + ES_YP), (const int*)(ws + WS_TOKR), g1, b1, (float*)(ws + WS_H), (bf16*)(ws + WS_HB), nullptr, nullptr, nullptr, nullptr); }
            GRID_BAR();
        }
        CUT(20 + layer, WS_H, false)
        CUT(40 + layer, WS_HB, true)
#ifdef DBG_CUT
        if (DBG_CUT == 50 + layer) { unsigned char* ws = WSB(); const bf16* s_ = (const bf16*)(ws + WS_WMIX); float* o_ = GOUT(); for (size_t i = (size_t)F.gw * 64 + F.lane; i < (size_t)M * D; i += (size_t)F.NGW * 64) o_[i] = i < (size_t)6 * 1024 * 1024 ? bf2f(s_[i]) : 0.f; return; }
#endif
    }
}

extern "C" void kernel_launch(void* const* d_in, const int* in_sizes, int n_in, void* d_out, int out_size, void* d_ws, size_t ws_size, hipStream_t stream) {
    static int grid = 0;
    if (grid == 0) {
        if (n_in != 33 || in_sizes[0] != M * D || out_size != M * D || ws_size < WS_END) { fprintf(stderr, "kernel_launch: unexpected problem shape (n_in %d, in0 %d, out %d, ws %zu); nothing launched\n", n_in, n_in > 0 ? in_sizes[0] : -1, out_size, ws_size); grid = -1; return; }
        int dev = 0, cus = 0, per_cu = 0;
        if (hipGetDevice(&dev) != hipSuccess || hipDeviceGetAttribute(&cus, hipDeviceAttributeMultiprocessorCount, dev) != hipSuccess) { grid = -1; return; }
        if (hipFuncSetAttribute((const void*)fwd_kernel, hipFuncAttributeMaxDynamicSharedMemorySize, LDS_BYTES) != hipSuccess) { fprintf(stderr, "kernel_launch: hipFuncSetAttribute failed\n"); grid = -1; return; }
        if (hipOccupancyMaxActiveBlocksPerMultiprocessor(&per_cu, (const void*)fwd_kernel, NWAVES * 64, LDS_BYTES) != hipSuccess || per_cu < 1) { fprintf(stderr, "kernel_launch: occupancy query reports %d workgroups per CU\n", per_cu); }
        (void)hipGetLastError();
        grid = cus;
        if (grid != 256) { fprintf(stderr, "kernel_launch: built for 256 CUs, device has %d; nothing launched\n", cus); grid = -1; return; }
    }
    if (grid < 0) return;
    if (hipMemsetAsync((char*)d_ws + WS_CTL, 0, CTL_ZERO_BYTES, stream) != hipSuccess) return;
#ifdef DBG_FILL
    (void)hipMemsetAsync((char*)d_ws + CTL_ZERO_BYTES, DBG_FILL, WS_END - CTL_ZERO_BYTES, stream);
#endif
    Args a{};
    for (int i = 0; i < 33; ++i) a.in[i] = (const float*)d_in[i];
    a.out = (float*)d_out; a.ws = (unsigned char*)d_ws;
    hipLaunchKernelGGL(fwd_kernel, dim3(grid), dim3(NWAVES * 64), LDS_BYTES, stream, a);
}
```

```cpp
#include <hip/hip_runtime.h>
#include <cstdio>
#include <cstdint>
#include <hip/hip_bf16.h>
#include <cmath>
__device__ __forceinline__ int fresh_lane() { int l; asm volatile("v_mbcnt_lo_u32_b32 %0, -1, 0\n\tv_mbcnt_hi_u32_b32 %0, -1, %0" : "=v"(l)); return l; }
namespace pg8 {
#define PG8_LAS __attribute__((address_space(3)))
typedef unsigned short bf16_t;
typedef short bf16x8 __attribute__((ext_vector_type(8)));
typedef float f32x4 __attribute__((ext_vector_type(4)));
typedef unsigned u32x4 __attribute__((ext_vector_type(4)));
constexpr int BM = 256, BK = 64, HALF = 128, HTB = HALF * BK * 2  , STAGE_BYTES = 8 * HTB, NXCD = 8, WGM = 8;

__host__ __device__ __forceinline__ int lds_byte(int r, int c) { const int st = (r >> 4) * 2 + (c >> 5), rr = r & 15, cc = c & 31, ob = rr * 64 + cc * 2; return st * 1024 + (ob ^ (((ob >> 9) & 1) << 5)); }
__host__ __device__ __forceinline__ void stage_rc(int b, int& R, int& C) { const int st = b / 1024, sb = b % 1024, swz = sb ^ (((sb >> 9) & 1) << 5); R = (st >> 1) * 16 + swz / 64; C = (st & 1) * 32 + (swz % 64) / 2; }
__host__ __device__ __forceinline__ int perm32(int rho) { const int n = rho >> 4, i = rho & 15; return 8 * (i >> 2) + 4 * n + (i & 3); }

struct Unit { int pm, pn, e; };
struct Gemm { int K, lda, ldb; };

__device__ __forceinline__ unsigned cvt_pk_bf16(float lo, float hi) { unsigned r; asm volatile("v_cvt_pk_bf16_f32 %0, %1, %2" : "=v"(r) : "v"(lo), "v"(hi)); return r; }
__device__ __forceinline__ float fsigmoid(float x) { return __builtin_amdgcn_rcpf(1.0f + __expf(-x)); }
__device__ __forceinline__ float ftanh(float x) { return 1.0f - 2.0f * __builtin_amdgcn_rcpf(1.0f + __expf(2.0f * x)); }

struct SchedStd {
    int nM, nN, nwg, G, c, amode; const char* A; const char* B; size_t atile, btile, ag;
    __device__ __forceinline__ void init(int M, int N, int G_, int c_, const void* A_, size_t lda, const void* B_, size_t ldb, int amode_ = 0, size_t ag_ = 0) {
        nM = M / BM; nN = N / BM; nwg = nM * nN; G = G_; c = c_; A = (const char*)A_; B = (const char*)B_; atile = (size_t)BM * lda * 2; btile = (size_t)BM * ldb * 2; amode = amode_; ag = ag_; }
    __device__ __forceinline__ bool next(int i, Unit& u) const {
        const long L = (long)i * G + c; if (L >= nwg) return false;
        int wgid = (int)L; { const int q = nwg / NXCD, r = nwg % NXCD, xcd = wgid % NXCD, off = wgid / NXCD; wgid = (xcd < r ? xcd * (q + 1) : r * (q + 1) + (xcd - r) * q) + off; }
        const int nig = WGM * nN, gid = wgid / nig, fm = gid * WGM, gsz = (nM - fm) < WGM ? (nM - fm) : WGM;
        u.pm = fm + ((wgid % nig) % gsz); u.pn = (wgid % nig) / gsz; u.e = 0; return true;
    }
    __device__ __forceinline__ const char* abase(const Unit& u) const {
        size_t off = (size_t)u.pm * atile;
        if (amode == 1) { const int gs = u.pn < 12 ? (u.pn >> 2) : (u.pn == 12 ? 3 : (u.pn == 13 ? 4 : (u.pn == 14 ? 2 : 5))); off += (size_t)gs * ag; }
        else if (amode == 2) off += (size_t)(u.pn >> 2) * 512;
        return A + off; }
    __device__ __forceinline__ const char* bbase(const Unit& u) const { return B + (size_t)u.pn * btile; }
    __device__ __forceinline__ void a_ready(const Unit&) const {}
    __device__ __forceinline__ void done(const Unit&) const {}
};
struct SchedMoe {
    int nN, G, c; const PG8_LAS int* pp; const char* A; const char* B; size_t atile, btile, bexp; int cap;
    __device__ __forceinline__ bool next(int i, Unit& u) const {
        const int L = i * G + c; int tot = pp[8] * nN; if (cap && tot > cap) tot = cap; if (L >= tot) return false;
        const int pm = L / nN; u.pm = pm; u.pn = L - pm * nN; int e = 0;
#pragma unroll
        for (int k = 1; k < 8; ++k) e += (pm >= pp[k]) ? 1 : 0;
        u.e = __builtin_amdgcn_readfirstlane(e); return true; }
    __device__ __forceinline__ const char* abase(const Unit& u) const { return A + (size_t)u.pm * atile; }
    __device__ __forceinline__ const char* bbase(const Unit& u) const { return B + (size_t)u.e * bexp + (size_t)u.pn * btile; }
    __device__ __forceinline__ void a_ready(const Unit&) const {}
    __device__ __forceinline__ void done(const Unit&) const {}
};

struct SchedMoeTail {
    int nN, G, c, first, NS; const PG8_LAS int* pp; const char* A; const char* B; size_t atile, btile, bexp, kslice;
    __device__ __forceinline__ bool next(int i, Unit& u) const {
        if (i > 0) return false;
        const int L = first + c / NS, tot = pp[8] * nN; if (L >= tot) return false;
        const int pm = L / nN; u.pm = pm; u.pn = L - pm * nN; int e = 0;
#pragma unroll
        for (int k = 1; k < 8; ++k) e += (pm >= pp[k]) ? 1 : 0;
        u.e = __builtin_amdgcn_readfirstlane(e); return true; }
    __device__ __forceinline__ const char* abase(const Unit& u) const { return A + (size_t)u.pm * atile + (size_t)(c % NS) * kslice; }
    __device__ __forceinline__ const char* bbase(const Unit& u) const { return B + (size_t)u.e * bexp + (size_t)u.pn * btile + (size_t)(c % NS) * kslice; }
    __device__ __forceinline__ void a_ready(const Unit&) const {}
    __device__ __forceinline__ void done(const Unit&) const {}
};
#define PG8_PACK8(w, v0, v1) do { w.x = cvt_pk_bf16(v0[0], v0[1]); w.y = cvt_pk_bf16(v0[2], v0[3]); w.z = cvt_pk_bf16(v1[0], v1[1]); w.w = cvt_pk_bf16(v1[2], v1[3]); } while (0)

struct EpiQKV {
    static constexpr bool PERM = true, AFTER_DRAIN = false;
    bf16_t* O0; long d1, d2; float s0;
    __device__ __forceinline__ void operator()(const f32x4 (&acc)[2][2][4][2], const Unit& u, int wr, int wc, int fr, int fq) const {
        const int t = u.pn >> 2; bf16_t* base = O0 + (long)(t == 1) * d1 + (long)(t == 2) * d2; const float sc = t == 0 ? s0 : 1.0f;
        const int row0 = u.pm * BM + wr * 64 + fr, col0 = (u.pn & 3) * BM + wc * 32 + 8 * fq;
#pragma unroll
        for (int ai = 0; ai < 2; ++ai)
#pragma unroll
            for (int m = 0; m < 4; ++m) { bf16_t* rowp = base + (size_t)(row0 + ai * HALF + m * 16) * 1024 + col0;
#pragma unroll
                for (int bj = 0; bj < 2; ++bj) { const f32x4 v0 = acc[ai][bj][m][0] * sc, v1 = acc[ai][bj][m][1] * sc; u32x4 w; PG8_PACK8(w, v0, v1); *(u32x4*)(rowp + bj * HALF) = w; } }
    }
};
struct EpiRkv {
    static constexpr bool PERM = true, AFTER_DRAIN = false;
    bf16_t* RKV; long dLH; size_t mstride;
    __device__ __forceinline__ void operator()(const f32x4 (&acc)[2][2][4][2], const Unit& u, int wr, int wc, int fr, int fq) const {
        const int pn = u.pn; const bool lora = pn >= 12;
        bf16_t* base = (bf16_t*)((char*)RKV + (lora ? dLH : (long)((size_t)(pn >> 2) * mstride * 2))); const int colt = lora ? (pn - 12) * BM : (pn & 3) * BM;
        const int row0 = u.pm * BM + wr * 64 + fr, col0 = colt + wc * 32 + 8 * fq;
#pragma unroll
        for (int ai = 0; ai < 2; ++ai)
#pragma unroll
            for (int m = 0; m < 4; ++m) { bf16_t* rowp = base + (size_t)(row0 + ai * HALF + m * 16) * 1024 + col0;
#pragma unroll
                for (int bj = 0; bj < 2; ++bj) { f32x4 v0 = acc[ai][bj][m][0], v1 = acc[ai][bj][m][1];
                    if (pn == 12) {
#pragma unroll
                        for (int i = 0; i < 4; ++i) { v0[i] = ftanh(v0[i]); v1[i] = ftanh(v1[i]); } }
                    else if (pn == 15) {
#pragma unroll
                        for (int i = 0; i < 4; ++i) { v0[i] = fsigmoid(v0[i]); v1[i] = fsigmoid(v1[i]); } }
                    u32x4 w; PG8_PACK8(w, v0, v1); *(u32x4*)(rowp + bj * HALF) = w; } }
    }
};
template <int GRP> struct EpiLoraUp {
    static constexpr bool PERM = true, AFTER_DRAIN = false;
    void* O; const float* bias;
    __device__ __forceinline__ void operator()(const f32x4 (&acc)[2][2][4][2], const Unit& u, int wr, int wc, int fr, int fq) const {
        const int row0 = u.pm * BM + wr * 64 + fr, col0 = u.pn * BM + wc * 32 + 8 * fq;
#pragma unroll
        for (int bj = 0; bj < 2; ++bj) {
            f32x4 bv0 = (f32x4){0.f, 0.f, 0.f, 0.f}, bv1 = bv0;
            if (GRP < 3) { bv0 = *(const f32x4*)(bias + col0 + bj * HALF); bv1 = *(const f32x4*)(bias + col0 + bj * HALF + 4); }
#pragma unroll
            for (int ai = 0; ai < 2; ++ai)
#pragma unroll
                for (int m = 0; m < 4; ++m) { const size_t ro = (size_t)(row0 + ai * HALF + m * 16) * 1024 + col0 + bj * HALF;
                    f32x4 v0_ = acc[ai][bj][m][0] + bv0, v1_ = acc[ai][bj][m][1] + bv1;
                    if (GRP == 0) {
#pragma unroll
                        for (int i = 0; i < 4; ++i) { v0_[i] = __expf(-0.6065306597f * fsigmoid(v0_[i])); v1_[i] = __expf(-0.6065306597f * fsigmoid(v1_[i])); }
                    } else if (GRP < 3) {
#pragma unroll
                        for (int i = 0; i < 4; ++i) { v0_[i] = fsigmoid(v0_[i]); v1_[i] = fsigmoid(v1_[i]); }
                    }
                    if (GRP < 2) { *(f32x4*)((float*)O + ro) = v0_; *(f32x4*)((float*)O + ro + 4) = v1_; }
                    else { u32x4 w; PG8_PACK8(w, v0_, v1_); *(u32x4*)((bf16_t*)O + ro) = w; } }
        }
    }
};
struct EpiLoraUpAll {
    static constexpr bool PERM = true, AFTER_DRAIN = false;
    EpiLoraUp<0> e0; EpiLoraUp<1> e1; EpiLoraUp<2> e2; EpiLoraUp<3> e3;
    __device__ __forceinline__ void operator()(const f32x4 (&acc)[2][2][4][2], const Unit& u, int wr, int wc, int fr, int fq) const {
        Unit v = u; v.pn = u.pn & 3; const int g = u.pn >> 2;
        if (g == 0) e0(acc, v, wr, wc, fr, fq); else if (g == 1) e1(acc, v, wr, wc, fr, fq); else if (g == 2) e2(acc, v, wr, wc, fr, fq); else e3(acc, v, wr, wc, fr, fq);
    }
};
struct EpiResF32 {
    static constexpr bool PERM = false, AFTER_DRAIN = false;
    const float* base; float* out; float alpha;
    __device__ __forceinline__ void operator()(const f32x4 (&acc)[2][2][4][2], const Unit& u, int wr, int wc, int fr, int fq) const {
        const int row0 = u.pm * BM + wr * 64 + fr, col0 = u.pn * BM + wc * 32 + 4 * fq;
#pragma unroll
        for (int ai = 0; ai < 2; ++ai)
#pragma unroll
            for (int m = 0; m < 4; ++m) { const size_t ro = (size_t)(row0 + ai * HALF + m * 16) * 1024 + col0;
#pragma unroll
                for (int bj = 0; bj < 2; ++bj)
#pragma unroll
                    for (int n = 0; n < 2; ++n) { const f32x4 b = *(const f32x4*)(base + ro + bj * HALF + n * 16); *(f32x4*)(out + ro + bj * HALF + n * 16) = b * alpha + acc[ai][bj][m][n]; } }
    }
};
template <bool F8OUT> struct EpiSwiGLUT {
    static constexpr bool PERM = true, AFTER_DRAIN = false;
    void* Hd; int ldh; float sc, oscale;
    __device__ __forceinline__ void operator()(const f32x4 (&acc)[2][2][4][2], const Unit& u, int wr, int wc, int fr, int fq) const {
        const int row0 = u.pm * BM + wr * 64 + fr, col0 = u.pn * HALF + wc * 32 + 8 * fq;
#pragma unroll
        for (int ai = 0; ai < 2; ++ai)
#pragma unroll
            for (int m = 0; m < 4; ++m) { const size_t eo = (size_t)(row0 + ai * HALF + m * 16) * ldh + col0;
                f32x4 v0, v1;
#pragma unroll
                for (int i = 0; i < 4; ++i) { const float g0 = acc[ai][0][m][0][i] * sc, g1 = acc[ai][0][m][1][i] * sc;
                    v0[i] = g0 * fsigmoid(g0) * (acc[ai][1][m][0][i] * sc); v1[i] = g1 * fsigmoid(g1) * (acc[ai][1][m][1][i] * sc); }
                if constexpr (F8OUT) { v0 = v0 * oscale; v1 = v1 * oscale; typedef unsigned u32x2_ __attribute__((ext_vector_type(2)));
                    int lo = __builtin_amdgcn_cvt_pk_fp8_f32(v0[0], v0[1], 0, false); lo = __builtin_amdgcn_cvt_pk_fp8_f32(v0[2], v0[3], lo, true);
                    int hi = __builtin_amdgcn_cvt_pk_fp8_f32(v1[0], v1[1], 0, false); hi = __builtin_amdgcn_cvt_pk_fp8_f32(v1[2], v1[3], hi, true);
                    u32x2_ w; w.x = (unsigned)lo; w.y = (unsigned)hi; *(u32x2_*)((unsigned char*)Hd + eo) = w; }
                else { u32x4 w; PG8_PACK8(w, v0, v1); *(u32x4*)((bf16_t*)Hd + eo) = w; } }
    }
};
typedef EpiSwiGLUT<false> EpiSwiGLU;
struct EpiMoeDown {
    static constexpr bool PERM = false, AFTER_DRAIN = false;
    float* YP; const float* gw; float sc;
    __device__ __forceinline__ void operator()(const f32x4 (&acc)[2][2][4][2], const Unit& u, int wr, int wc, int fr, int fq) const {
        const int row0 = u.pm * BM + wr * 64 + fr, col0 = u.pn * BM + wc * 32 + 4 * fq;
#pragma unroll
        for (int ai = 0; ai < 2; ++ai)
#pragma unroll
            for (int m = 0; m < 4; ++m) { const int row = row0 + ai * HALF + m * 16; const float s = gw[row] * sc; const size_t ro = (size_t)row * 1024 + col0;
#pragma unroll
                for (int bj = 0; bj < 2; ++bj)
#pragma unroll
                    for (int n = 0; n < 2; ++n) *(f32x4*)(YP + ro + bj * HALF + n * 16) = acc[ai][bj][m][n] * s; }
    }
};

struct EpiMoeDownSlab {
    static constexpr bool PERM = false, AFTER_DRAIN = false;
    float* YS; const float* gw; int c, NS; float sc;
    __device__ __forceinline__ void operator()(const f32x4 (&acc)[2][2][4][2], const Unit& u, int wr, int wc, int fr, int fq) const {
        const int row0 = u.pm * BM + wr * 64 + fr, col0 = u.pn * BM + wc * 32 + 4 * fq; float* slab = YS + (size_t)(c % NS) * 2048 * 1024;
#pragma unroll
        for (int ai = 0; ai < 2; ++ai)
#pragma unroll
            for (int m = 0; m < 4; ++m) { const int row = row0 + ai * HALF + m * 16; const float s = gw[row] * sc; const size_t ro = (size_t)(row - 32768) * 1024 + col0;
#pragma unroll
                for (int bj = 0; bj < 2; ++bj)
#pragma unroll
                    for (int n = 0; n < 2; ++n) *(f32x4*)(slab + ro + bj * HALF + n * 16) = acc[ai][bj][m][n] * s; }
    }
};
template <class Epi, class Sched, bool ALIGN_EPI = false, bool SP2 = false, bool F8 = false>
__device__ __forceinline__ void gemm_phase(PG8_LAS unsigned char* lds, const Gemm g, const Sched& S, const Epi& E, int wave) {
    const int lane = fresh_lane(), wid = wave, tid = wid * 64 + lane, wr = wid >> 2, wc = wid & 3, fr = lane & 15, fq = lane >> 4;
    const int K = g.K, nt = K / BK;
    unsigned voffA[2], voffB[2];
#pragma unroll
    for (int i = 0; i < 2; ++i) { int R, C; stage_rc(tid * 16 + i * 8192, R, C); const int Rb = Epi::PERM ? ((R & ~31) + perm32(R & 31)) : R;
        voffA[i] = (unsigned)(R * g.lda + C) * 2u; voffB[i] = (unsigned)(Rb * g.ldb + C) * 2u; }
    const size_t kstep = (size_t)(BK * 2);
    const size_t hsA = (size_t)HALF * g.lda * 2, hsB = (size_t)HALF * g.ldb * 2;
    const unsigned ldsw = (unsigned)wid * 1024u;
    const int aoff = lds_byte(wr * 64 + fr, fq * 8), boff = lds_byte(wc * 32 + fr, fq * 8);
#define PG8_SA(b, h) (((b) * 2 + (h)) * HTB)
#define PG8_SB(b, h) ((4 + (b) * 2 + (h)) * HTB)
#define PG8_STAGE(bufoff, gbase, voff) do { _Pragma("unroll") for (int _i = 0; _i < 2; ++_i) \
        __builtin_amdgcn_global_load_lds((const unsigned*)((const char*)(gbase) + (voff)[_i]), (PG8_LAS unsigned*)(lds + (bufoff) + ldsw + _i * 8192), 16, 0, 0); } while (0)
#define PG8_LDA(dst, b, h) do { _Pragma("unroll") for (int m = 0; m < 4; ++m) { const i32x4_ lo_ = *(const PG8_LAS i32x4_*)(lds + PG8_SA(b, h) + aoff + m * 2048), hi_ = *(const PG8_LAS i32x4_*)(lds + PG8_SA(b, h) + aoff + m * 2048 + 1024); \
        if constexpr (F8) dst##8[m] = __builtin_shufflevector(lo_, hi_, 0, 1, 2, 3, 4, 5, 6, 7); else { dst[m][0] = __builtin_bit_cast(bf16x8, lo_); dst[m][1] = __builtin_bit_cast(bf16x8, hi_); } } } while (0)
#define PG8_LDB(dst, b, h) do { _Pragma("unroll") for (int n = 0; n < 2; ++n) { const i32x4_ lo_ = *(const PG8_LAS i32x4_*)(lds + PG8_SB(b, h) + boff + n * 2048), hi_ = *(const PG8_LAS i32x4_*)(lds + PG8_SB(b, h) + boff + n * 2048 + 1024); \
        if constexpr (F8) dst##8[n] = __builtin_shufflevector(lo_, hi_, 0, 1, 2, 3, 4, 5, 6, 7); else { dst[n][0] = __builtin_bit_cast(bf16x8, lo_); dst[n][1] = __builtin_bit_cast(bf16x8, hi_); } } } while (0)
#define PG8_MMA(ai, bj, At, Bt) do { __builtin_amdgcn_s_setprio(1); _Pragma("unroll") for (int m = 0; m < 4; ++m) _Pragma("unroll") for (int n = 0; n < 2; ++n) { \
        if constexpr (F8) asm volatile("v_mfma_scale_f32_16x16x128_f8f6f4 %0, %1, %2, %0, %3, %3 op_sel_hi:[0,0,0]" : "+v"(acc[ai][bj][m][n]) : "v"(Bt##8[n]), "v"(At##8[m]), "v"(f8scale));   \
        else { _Pragma("unroll") for (int k = 0; k < 2; ++k) acc[ai][bj][m][n] = __builtin_amdgcn_mfma_f32_16x16x32_bf16(Bt[n][k], At[m][k], acc[ai][bj][m][n], 0, 0, 0); } } \
        __builtin_amdgcn_s_setprio(0); } while (0)
#define PG8_WAIT_V(n) asm volatile("s_waitcnt vmcnt(" #n ")" ::: "memory")
#define PG8_WAIT_L(n) asm volatile("s_waitcnt lgkmcnt(" #n ")" ::: "memory")
#define PG8_BAR __builtin_amdgcn_s_barrier()
#define PG8_SCHED __builtin_amdgcn_sched_barrier(0)
    Unit cur, nxt; int ui = 0;
    if (!S.next(0, cur)) return;
    f32x4 acc[2][2][4][2];
#pragma unroll
    for (int a = 0; a < 2; ++a)
#pragma unroll
        for (int b = 0; b < 2; ++b)
#pragma unroll
            for (int m = 0; m < 4; ++m)
#pragma unroll
                for (int n = 0; n < 2; ++n) acc[a][b][m][n] = (f32x4){0.f, 0.f, 0.f, 0.f};
    typedef int i32x4_ __attribute__((ext_vector_type(4))); typedef int i32x8_ __attribute__((ext_vector_type(8)));
    int f8scale = 0x7f7f7f7f; asm volatile("" : "+v"(f8scale));
    bf16x8 At[4][2], B0[2][2], B1[2][2]; i32x8_ At8[4], B08[2], B18[2];
    const char* cA = S.abase(cur); const char* cB = S.bbase(cur);
    S.a_ready(cur);
    if constexpr (SP2) {
        PG8_STAGE(PG8_SB(0, 0), cB, voffB); PG8_STAGE(PG8_SB(0, 1), cB + hsB, voffB); PG8_STAGE(PG8_SA(0, 0), cA, voffA); PG8_STAGE(PG8_SA(0, 1), cA + hsA, voffA);
        if (wr == 1) PG8_BAR;
        PG8_WAIT_V(2); PG8_BAR;
        PG8_STAGE(PG8_SB(1, 0), cB + kstep, voffB); PG8_STAGE(PG8_SA(1, 0), cA + kstep, voffA); PG8_STAGE(PG8_SB(1, 1), cB + hsB + kstep, voffB);
        PG8_WAIT_V(6); PG8_BAR;
    } else {
        PG8_STAGE(PG8_SB(0, 0), cB, voffB); PG8_STAGE(PG8_SA(0, 0), cA, voffA); PG8_STAGE(PG8_SB(0, 1), cB + hsB, voffB); PG8_STAGE(PG8_SA(0, 1), cA + hsA, voffA);
        if (wr == 1) PG8_BAR;
        PG8_WAIT_V(4); PG8_BAR;
        PG8_STAGE(PG8_SB(1, 0), cB + kstep, voffB); PG8_STAGE(PG8_SA(1, 0), cA + kstep, voffA); PG8_STAGE(PG8_SB(1, 1), cB + hsB + kstep, voffB);
        PG8_WAIT_V(6); PG8_BAR;
    }
    for (;;) {
        const bool has_next = S.next(ui + 1, nxt);
        const char* nA = has_next ? S.abase(nxt) : cA; const char* nB = has_next ? S.bbase(nxt) : cB;
#pragma nounroll
        for (int t = 0; t < nt; t += 2) {
            const bool last = (t == nt - 2);
            const char* a1 = cA + (size_t)(t + 1) * kstep;
            const char* a2 = last ? nA : cA + (size_t)(t + 2) * kstep; const char* b2 = last ? nB : cB + (size_t)(t + 2) * kstep;
            const char* a3 = a2 + kstep; const char* b3 = b2 + kstep;
            if (last && has_next) S.a_ready(nxt);
            if constexpr (SP2) {
            PG8_LDB(B0, 0, 0); PG8_LDB(B1, 0, 1); PG8_SCHED; PG8_LDA(At, 0, 0); PG8_STAGE(PG8_SA(1, 1), a1 + hsA, voffA);
            PG8_WAIT_V(8); PG8_WAIT_L(0); PG8_BAR; PG8_MMA(0, 0, At, B0); PG8_MMA(0, 1, At, B1); PG8_BAR; PG8_SCHED;
            PG8_LDA(At, 0, 1); PG8_STAGE(PG8_SB(0, 0), b2, voffB); PG8_STAGE(PG8_SB(0, 1), b2 + hsB, voffB); PG8_STAGE(PG8_SA(0, 0), a2, voffA);
            PG8_WAIT_V(8); PG8_WAIT_L(0); PG8_BAR; PG8_MMA(1, 0, At, B0); PG8_MMA(1, 1, At, B1); PG8_BAR; PG8_SCHED;
            PG8_LDB(B0, 1, 0); PG8_LDB(B1, 1, 1); PG8_SCHED; PG8_LDA(At, 1, 0); PG8_STAGE(PG8_SA(0, 1), a2 + hsA, voffA);
            PG8_WAIT_V(8); PG8_WAIT_L(0); PG8_BAR; PG8_MMA(0, 0, At, B0); PG8_MMA(0, 1, At, B1); PG8_BAR; PG8_SCHED;
            PG8_LDA(At, 1, 1); PG8_STAGE(PG8_SB(1, 0), b3, voffB); PG8_STAGE(PG8_SB(1, 1), b3 + hsB, voffB); PG8_STAGE(PG8_SA(1, 0), a3, voffA);
            PG8_WAIT_V(8); PG8_WAIT_L(0); PG8_BAR; PG8_MMA(1, 0, At, B0); PG8_MMA(1, 1, At, B1); PG8_BAR; PG8_SCHED;
            } else {
            PG8_LDB(B0, 0, 0); PG8_SCHED; PG8_LDA(At, 0, 0); PG8_STAGE(PG8_SA(1, 1), a1 + hsA, voffA);
            PG8_WAIT_L(8); PG8_BAR; PG8_WAIT_L(0); PG8_MMA(0, 0, At, B0); PG8_BAR; PG8_SCHED;
            PG8_LDB(B1, 0, 1); PG8_STAGE(PG8_SB(0, 0), b2, voffB);
            PG8_BAR; PG8_WAIT_L(0); PG8_MMA(0, 1, At, B1); PG8_BAR;
            PG8_LDA(At, 0, 1); PG8_STAGE(PG8_SA(0, 0), a2, voffA);
            PG8_BAR; PG8_WAIT_L(0); PG8_MMA(1, 0, At, B0); PG8_BAR; PG8_SCHED;
            PG8_STAGE(PG8_SB(0, 1), b2 + hsB, voffB);
            PG8_WAIT_V(6); PG8_BAR; PG8_MMA(1, 1, At, B1); PG8_BAR;
            PG8_LDB(B0, 1, 0); PG8_SCHED; PG8_LDA(At, 1, 0); PG8_STAGE(PG8_SA(0, 1), a2 + hsA, voffA);
            PG8_WAIT_L(8); PG8_BAR; PG8_WAIT_L(0); PG8_MMA(0, 0, At, B0); PG8_BAR; PG8_SCHED;
            PG8_LDB(B1, 1, 1); PG8_STAGE(PG8_SB(1, 0), b3, voffB);
            PG8_BAR; PG8_WAIT_L(0); PG8_MMA(0, 1, At, B1); PG8_BAR;
            PG8_LDA(At, 1, 1); PG8_STAGE(PG8_SA(1, 0), a3, voffA);
            PG8_BAR; PG8_WAIT_L(0); PG8_MMA(1, 0, At, B0); PG8_BAR; PG8_SCHED;
            PG8_STAGE(PG8_SB(1, 1), b3 + hsB, voffB);
            PG8_WAIT_V(6); PG8_BAR; PG8_MMA(1, 1, At, B1); PG8_BAR;
            }
        }
        if constexpr (ALIGN_EPI) { if (wr == 0) PG8_BAR; }
        if constexpr (!Epi::AFTER_DRAIN) { E(acc, cur, wr, wc, fr, fq); S.done(cur); }
        if (!has_next) break;
#pragma unroll
        for (int a = 0; a < 2; ++a)
#pragma unroll
            for (int b = 0; b < 2; ++b)
#pragma unroll
                for (int m = 0; m < 4; ++m)
#pragma unroll
                    for (int n = 0; n < 2; ++n) acc[a][b][m][n] = (f32x4){0.f, 0.f, 0.f, 0.f};
        cur = nxt; cA = nA; cB = nB; ++ui;
        if constexpr (ALIGN_EPI) { if (wr == 1) PG8_BAR; }
    }
    PG8_WAIT_V(0);
    if constexpr (!ALIGN_EPI) { if (wr == 0) PG8_BAR; }
    PG8_BAR;
    if constexpr (Epi::AFTER_DRAIN) { E.fused(acc, cur, wr, wc, fr, fq, lds, wid, lane); S.done(cur); }
#undef PG8_SA
#undef PG8_SB
#undef PG8_STAGE
#undef PG8_LDA
#undef PG8_LDB
#undef PG8_MMA
#undef PG8_WAIT_V
#undef PG8_WAIT_L
#undef PG8_BAR
#undef PG8_SCHED
}
}

#ifndef MOBA_MASK_ON
#define MOBA_MASK_ON 1
#endif
namespace attn_body {
using bf16=__hip_bfloat16;
using bf16x8=__attribute__((ext_vector_type(8)))short;
using s16x4=__attribute__((ext_vector_type(4)))short;
using f32x16=__attribute__((ext_vector_type(16)))float;
using u32x4=__attribute__((ext_vector_type(4)))unsigned;
constexpr int BATCH=2,NHEAD=16,SEQ=8192,D=64,DM=NHEAD*D;
constexpr int NW=8,QBLK=32,QB=QBLK*NW,KVBLK=64,NQB=SEQ/QB;
constexpr int ATTN_PITCH=DM, ATTN_UNIT_ROWS=QB;
__device__ __forceinline__ int crow(int r,int hi){return (r&3)+8*(r>>2)+4*hi;}
#define SBAR() __builtin_amdgcn_sched_barrier(0)
__device__ __forceinline__ void cmask(f32x16&p0,f32x16&p1,int jb,int qrel,int hi){
  const float NEG=-INFINITY; int d=qrel-(64*jb+4*hi); asm volatile("":"+v"(d));
  #pragma unroll
  for(int r=0;r<16;++r){const int c=(r&3)+8*(r>>2); if(c>d)p0[r]=NEG; if(c+32>d)p1[r]=NEG;}
}

constexpr int NSLOT=3, SLOTB=8192;
constexpr int LDS_K=0, LDS_V=NSLOT*SLOTB, LDS_WS=2*NSLOT*SLOTB, LDS_OST=LDS_WS+NW*64*4, LDS_BYTES=LDS_OST+NW*4096;
constexpr float C2=0.125f*1.4426950408889634f;
__device__ __forceinline__ void glds16(const void*gsrc,unsigned lds_dst){unsigned keep;
  asm volatile("s_mov_b32 %0, m0\n\ts_mov_b32 m0, %2\n\ts_nop 0\n\tglobal_load_lds_dwordx4 %1, off\n\ts_mov_b32 m0, %0":"=&s"(keep):"v"(gsrc),"s"(lds_dst):"memory");}
__device__ __forceinline__ float max3f(float a,float b,float c){float r;asm("v_max3_f32 %0, %1, %2, %3":"=v"(r):"v"(a),"v"(b),"v"(c));return r;}
__device__ __forceinline__ float max2f(float a,float b){float r;asm("v_max_f32_e32 %0, %1, %2":"=v"(r):"v"(a),"v"(b));return r;}
__device__ __forceinline__ float fadd_s(float a,float b){float r;asm("v_add_f32_e32 %0, %1, %2":"=v"(r):"v"(a),"v"(b));return r;}
__device__ __forceinline__ float fsub_s(float a,float b){float r;asm("v_sub_f32_e32 %0, %1, %2":"=v"(r):"v"(a),"v"(b));return r;}
typedef float f32x2_t __attribute__((ext_vector_type(2))); typedef __bf16 bf16x2_t __attribute__((ext_vector_type(2)));
__device__ __forceinline__ unsigned cvtpk_s(float lo,float hi){f32x2_t v={lo,hi};bf16x2_t b=__builtin_convertvector(v,bf16x2_t);return __builtin_bit_cast(unsigned,b);}
#define WAIT_BAR(N) asm volatile("s_waitcnt vmcnt(" #N ") lgkmcnt(0)\n\ts_barrier":::"memory")

__device__ __forceinline__ void qkt(f32x16&p0,f32x16&p1,const char*Kslot,const bf16x8*qr,int r32,int hi){
  const char*kb=Kslot+hi*1024+r32*16;
  #pragma unroll
  for(int d0=0;d0<4;++d0){
    const bf16x8 b0=*reinterpret_cast<const bf16x8*>(kb+d0*2048);
    const bf16x8 b1=*reinterpret_cast<const bf16x8*>(kb+d0*2048+512);
    if(d0==0){p0=__builtin_amdgcn_mfma_f32_32x32x16_bf16(b0,qr[0],f32x16{},0,0,0);p1=__builtin_amdgcn_mfma_f32_32x32x16_bf16(b1,qr[0],f32x16{},0,0,0);}
    else{p0=__builtin_amdgcn_mfma_f32_32x32x16_bf16(b0,qr[d0],p0,0,0,0);p1=__builtin_amdgcn_mfma_f32_32x32x16_bf16(b1,qr[d0],p1,0,0,0);}}
}
typedef __attribute__((address_space(3))) const char* lds_cptr;
typedef short v4i16_t __attribute__((ext_vector_type(4)));
__device__ __forceinline__ void kload8(bf16x8*kf,lds_cptr kp){
  kf[0]=*(const __attribute__((address_space(3))) bf16x8*)(kp);      kf[1]=*(const __attribute__((address_space(3))) bf16x8*)(kp+512);
  kf[2]=*(const __attribute__((address_space(3))) bf16x8*)(kp+2048); kf[3]=*(const __attribute__((address_space(3))) bf16x8*)(kp+2560);
  kf[4]=*(const __attribute__((address_space(3))) bf16x8*)(kp+4096); kf[5]=*(const __attribute__((address_space(3))) bf16x8*)(kp+4608);
  kf[6]=*(const __attribute__((address_space(3))) bf16x8*)(kp+6144); kf[7]=*(const __attribute__((address_space(3))) bf16x8*)(kp+6656);
}
__device__ __forceinline__ void kload2(bf16x8*kf,lds_cptr kp,int j){ kf[2*j]=*(const __attribute__((address_space(3))) bf16x8*)(kp+j*2048); kf[2*j+1]=*(const __attribute__((address_space(3))) bf16x8*)(kp+j*2048+512); }
__device__ __forceinline__ s16x4 vtr(lds_cptr p){ return __builtin_bit_cast(s16x4,__builtin_amdgcn_ds_read_tr16_b64_v4i16((__attribute__((address_space(3))) v4i16_t*)p)); }
__device__ __forceinline__ float rowmax(const f32x16&p0,const f32x16&p1){
  float a=max3f(p0[0],p0[1],p1[0]),b=max3f(p0[2],p0[3],p1[1]);a=max3f(a,p1[2],p1[3]);
  #pragma unroll
  for(int r=4;r<16;r+=4){a=max3f(a,p0[r],p0[r+1]);b=max3f(b,p0[r+2],p0[r+3]);a=max3f(a,p1[r],p1[r+1]);b=max3f(b,p1[r+2],p1[r+3]);}
  const float m=max2f(a,b);
  auto rr=__builtin_amdgcn_permlane32_swap(__float_as_uint(m),__float_as_uint(m),false,false);
  return max2f(__uint_as_float(rr[0]),__uint_as_float(rr[1]));
}
__device__ __forceinline__ void pv(f32x16*o,int vb,bf16x8 pa0,bf16x8 pa1,bf16x8 pa2,bf16x8 pa3){
  #pragma unroll
  for(int d0=0;d0<2;++d0){s16x4 lo[4],hi[4];
    #pragma unroll
    for(int ks=0;ks<4;++ks){
      asm volatile("ds_read_b64_tr_b16 %0,%1 offset:%c2":"=&v"(lo[ks]):"v"(vb),"i"(d0*4096+ks*1024):"memory");
      asm volatile("ds_read_b64_tr_b16 %0,%1 offset:%c2":"=&v"(hi[ks]):"v"(vb),"i"(d0*4096+ks*1024+512):"memory");}
    asm volatile("s_waitcnt lgkmcnt(0)":::"memory");SBAR();
    #define PK(k) (bf16x8){lo[k][0],lo[k][1],lo[k][2],lo[k][3],hi[k][0],hi[k][1],hi[k][2],hi[k][3]}
    o[d0]=__builtin_amdgcn_mfma_f32_32x32x16_bf16(pa0,PK(0),o[d0],0,0,0);
    o[d0]=__builtin_amdgcn_mfma_f32_32x32x16_bf16(pa1,PK(1),o[d0],0,0,0);
    o[d0]=__builtin_amdgcn_mfma_f32_32x32x16_bf16(pa2,PK(2),o[d0],0,0,0);
    o[d0]=__builtin_amdgcn_mfma_f32_32x32x16_bf16(pa3,PK(3),o[d0],0,0,0);
    #undef PK
  }
}

#ifndef ATTN_STORE16
#define ATTN_STORE16(p,v) (*(u32x4*)(p)=(v))
#endif
template<int THRL> __device__ __forceinline__ void attn_unit(int b,int h,int qb,const bf16*Q,const bf16*__restrict__ K,const bf16*__restrict__ V,bf16*O,const unsigned*__restrict__ SEL,char*shm,int wave){
  const int lane=fresh_lane(),wid=wave,tid=wid*64+lane,r32=lane&31,hi=lane>>5; (void)tid;
  const long rowbase=(long)b*SEQ; const int q0=qb*QB;
  const bf16*Qw=Q+(rowbase+q0+wid*QBLK)*DM+h*D;
  const bf16*Kh=K+rowbase*DM+h*D,*Vh=V+rowbase*DM+h*D;
  const unsigned lds0=(unsigned)(uintptr_t)shm;
  float*wsf=(float*)(shm+LDS_WS)+wid*64;
  const bf16*ksrc=Kh+(long)lane*DM+wid*8;
  const bf16*vsrc=Vh+(long)(16*(wid&3)+(lane>>2))*DM+(wid>>2)*32+(lane&3)*8;
  const unsigned kdst=lds0+LDS_K+wid*1024, vdst=lds0+LDS_V+wid*1024;
  #define DMA_K(t,slot) glds16(ksrc+(long)(t)*KVBLK*DM,(unsigned)__builtin_amdgcn_readfirstlane(kdst+(slot)))
  #define DMA_V(t,slot) glds16(vsrc+(long)(t)*KVBLK*DM,(unsigned)__builtin_amdgcn_readfirstlane(vdst+(slot)))
  const int vb0=(int)(lds0+LDS_V)+((lane>>4)&1)*32+(lane&3)*8+(4*hi+((lane&15)>>2))*64;
  const char*Kbase=shm+LDS_K; bf16x8 kf[8];
  const lds_cptr shm3=(lds_cptr)shm; const lds_cptr kp0=shm3+LDS_K+hi*1024+r32*16; const lds_cptr vp0=shm3+LDS_V+((lane>>4)&1)*32+(lane&3)*8+(4*hi+((lane&15)>>2))*64;
  const int NT=(q0+QB)/KVBLK;
  DMA_K(0,0);DMA_V(0,0);DMA_K(1,SLOTB);
  bf16x8 qr[4];
  #pragma unroll
  for(int d0=0;d0<4;++d0)qr[d0]=*reinterpret_cast<const bf16x8*>(&Qw[(long)r32*DM+d0*16+hi*8]);
  float mhat=0.f,l_reg=0.f;f32x16 o[2];o[0]=f32x16{};o[1]=f32x16{};
  const int qrel=wid*QBLK+r32;
  #define SELW() ((volatile __attribute__((address_space(3))) unsigned*)(lds_cptr)((const char*)wsf)+32+r32)
  if(hi==0)*SELW()=SEL[(rowbase+q0+qrel)*NHEAD+h];
  asm volatile("s_waitcnt vmcnt(0) lgkmcnt(0)":::"memory");
  #define CMASK(P0,P1,t) do{int jb_=(t)-(NT-4); if(jb_>=0)cmask(P0,P1,jb_,qrel,hi); else if(MOBA_MASK_ON && !(((*SELW())>>((t)>>2))&1u)){ _Pragma("unroll") for(int r_=0;r_<16;++r_){P0[r_]=-INFINITY;P1[r_]=-INFINITY;} } }while(0)
  bool resc=false;
  #define START(P0,P1) do{ const float rm=rowmax(P0,P1); resc=false; \
    { const float dl=max2f(rm,-100.f); mhat=fadd_s(mhat,dl); \
      _Pragma("unroll") for(int r=0;r<16;++r){P0[r]=fsub_s(P0[r],dl);P1[r]=fsub_s(P1[r],dl);} \
      } \
    _Pragma("unroll") for(int r=0;r<16;++r)P0[r]=__builtin_amdgcn_exp2f(P0[r]); }while(0)
  #define RESC() do{ if(resc){ asm volatile("s_waitcnt lgkmcnt(0)":::"memory"); \
      _Pragma("unroll") for(int d_=0;d_<2;++d_) _Pragma("unroll") for(int r=0;r<16;++r)o[d_][r]*=wsf[crow(r,hi)]; } }while(0)
  f32x16 pA0,pA1,pB0,pB1;
  int sl_prev=0,sl_cur=0,sl_next=SLOTB;
  #define ROT() do{sl_prev=sl_cur;sl_cur=sl_next;sl_next=(sl_next==(NSLOT-1)*SLOTB)?0:sl_next+SLOTB;}while(0)
  DMA_K(2,2*SLOTB);
  WAIT_BAR(3);
  qkt(pA0,pA1,Kbase,qr,r32,hi);asm volatile("s_nop 15\n\ts_nop 7":"+v"(pA0),"+v"(pA1));CMASK(pA0,pA1,0);
  START(pA0,pA1);
  _Pragma("unroll") for(int r=0;r<16;++r)pA1[r]=__builtin_amdgcn_exp2f(pA1[r]);
  WAIT_BAR(0);
  DMA_K(3,0);DMA_V(1,SLOTB);
  ROT();
  kload8(kf,kp0+sl_cur);
  WAIT_BAR(2);
  s16x4 vlo[8],vhi[8]; u32x4 pw0,pw1,pw2,pw3;
  #define PKW(P,B) cvtpk_s(P[B],P[B+1])
  #define PAF(k) __builtin_bit_cast(bf16x8,pw##k)
  #define VFR(i) (bf16x8){vlo[i][0],vlo[i][1],vlo[i][2],vlo[i][3],vhi[i][0],vhi[i][1],vhi[i][2],vhi[i][3]}
  #define PIN(x) asm volatile("":"+v"(x))
  #define MX3(a,b,c) __builtin_fmaxf(__builtin_fmaxf((a),(b)),(c))
  #define GAPA(MF,A0,A1,A2,A3,W0,W1,PW) do{ MF; sacc+=A0; sacc+=A1; sacc+=A2; sacc+=A3; PIN(sacc); W0; W1; PIN(PW); SBAR(); }while(0)
  #define EX(v) __builtin_amdgcn_exp2f(v)
  #define GAPB(MF,X,B) do{ MF; X[B]=EX(X[B]); X[B+1]=EX(X[B+1]); X[B+2]=EX(X[B+2]); X[B+3]=EX(X[B+3]); PIN(X); SBAR(); }while(0)
  #define VRD(i) do{ vlo[i]=vtr(vp_+(((i)>>2)*4096+((i)&3)*1024)); vhi[i]=vtr(vp_+(((i)>>2)*4096+((i)&3)*1024+512)); }while(0)
  #define KRD(G,j) do{ if(G){ kload2(kf,kp0+sl_next,j); SBAR(); } }while(0)
  #define STEP(C0,C1,P0,P1,t,GK,GV,GL) do{ SBAR(); \
    const lds_cptr vp_=vp0+sl_prev; \
    VRD(0); SBAR(); float sacc=(P0[0]+P0[1]); \
    GAPA(C0=__builtin_amdgcn_mfma_f32_32x32x16_bf16(kf[0],qr[0],f32x16{},0,0,0), P0[2],P0[3],P0[4],P0[5],     pw0[0]=PKW(P0,0), pw0[1]=PKW(P0,2), pw0); \
    VRD(4); SBAR(); GAPA(C1=__builtin_amdgcn_mfma_f32_32x32x16_bf16(kf[1],qr[0],f32x16{},0,0,0), P0[6],P0[7],P0[8],P0[9],     pw0[2]=PKW(P0,4), pw0[3]=PKW(P0,6), pw0); \
    VRD(1); SBAR(); GAPA(C0=__builtin_amdgcn_mfma_f32_32x32x16_bf16(kf[2],qr[1],C0,0,0,0),   P0[10],P0[11],P0[12],P0[13], pw1[0]=PKW(P0,8), pw1[1]=PKW(P0,10), pw1); \
    VRD(5); SBAR(); GAPA(C1=__builtin_amdgcn_mfma_f32_32x32x16_bf16(kf[3],qr[1],C1,0,0,0),   P0[14],P0[15],P1[0],P1[1],   pw1[2]=PKW(P0,12),pw1[3]=PKW(P0,14), pw1); \
    VRD(2); SBAR(); GAPA(C0=__builtin_amdgcn_mfma_f32_32x32x16_bf16(kf[4],qr[2],C0,0,0,0),   P1[2],P1[3],P1[4],P1[5],     pw2[0]=PKW(P1,0), pw2[1]=PKW(P1,2), pw2); \
    VRD(6); SBAR(); GAPA(C1=__builtin_amdgcn_mfma_f32_32x32x16_bf16(kf[5],qr[2],C1,0,0,0),   P1[6],P1[7],P1[8],P1[9],     pw2[2]=PKW(P1,4), pw2[3]=PKW(P1,6), pw2); \
    VRD(3); SBAR(); GAPA(C0=__builtin_amdgcn_mfma_f32_32x32x16_bf16(kf[6],qr[3],C0,0,0,0),   P1[10],P1[11],P1[12],P1[13], pw3[0]=PKW(P1,8), pw3[1]=PKW(P1,10), pw3); \
    VRD(7); SBAR(); GAPA(C1=__builtin_amdgcn_mfma_f32_32x32x16_bf16(kf[7],qr[3],C1,0,0,0),   P1[14],P1[15],0.f,0.f,       pw3[2]=PKW(P1,12),pw3[3]=PKW(P1,14), pw3); \
    l_reg+=sacc; \
    if(GK){DMA_K((t)+3,sl_cur);} if(GV){DMA_V((t)+1,sl_next);} \
    _Pragma("unroll") for(int r=0;r<16;++r){C0[r]-=mhat;C1[r]-=mhat;} \
    CMASK(C0,C1,t); \
    { float a=MX3(C0[0],C0[1],C1[0]),b=MX3(C0[2],C0[3],C1[1]); a=MX3(a,C1[2],C1[3]); \
      _Pragma("unroll") for(int r=4;r<16;r+=4){a=MX3(a,C0[r],C0[r+1]);b=MX3(b,C0[r+2],C0[r+3]);a=MX3(a,C1[r],C1[r+1]);b=MX3(b,C1[r+2],C1[r+3]);} \
      float rm=__builtin_fmaxf(a,b); { auto rr=__builtin_amdgcn_permlane32_swap(__float_as_uint(rm),__float_as_uint(rm),false,false); rm=__builtin_fmaxf(__uint_as_float(rr[0]),__uint_as_float(rr[1])); } \
      resc=false; \
      if(__builtin_expect(__any(rm>(float)THRL),0)){ const float dl=__builtin_fmaxf(rm,0.f); mhat+=dl; \
        _Pragma("unroll") for(int r=0;r<16;++r){C0[r]-=dl;C1[r]-=dl;} \
        const float f=__builtin_amdgcn_exp2f(-dl); l_reg*=f; if(hi==0)wsf[r32]=f; resc=true; } } \
    SBAR(); \
    GAPB(o[0]=__builtin_amdgcn_mfma_f32_32x32x16_bf16(PAF(0),VFR(0),o[0],0,0,0), C0,0); \
    GAPB(o[1]=__builtin_amdgcn_mfma_f32_32x32x16_bf16(PAF(0),VFR(4),o[1],0,0,0), C0,4); \
    KRD(GL,0); GAPB(o[0]=__builtin_amdgcn_mfma_f32_32x32x16_bf16(PAF(1),VFR(1),o[0],0,0,0), C0,8); \
    KRD(GL,1); GAPB(o[1]=__builtin_amdgcn_mfma_f32_32x32x16_bf16(PAF(1),VFR(5),o[1],0,0,0), C0,12); \
    KRD(GL,2); GAPB(o[0]=__builtin_amdgcn_mfma_f32_32x32x16_bf16(PAF(2),VFR(2),o[0],0,0,0), C1,0); \
    KRD(GL,3); GAPB(o[1]=__builtin_amdgcn_mfma_f32_32x32x16_bf16(PAF(2),VFR(6),o[1],0,0,0), C1,4); \
    GAPB(o[0]=__builtin_amdgcn_mfma_f32_32x32x16_bf16(PAF(3),VFR(3),o[0],0,0,0), C1,8); \
    GAPB(o[1]=__builtin_amdgcn_mfma_f32_32x32x16_bf16(PAF(3),VFR(7),o[1],0,0,0), C1,12); \
    }while(0)
  int t=1;
  for(;t+5<NT;t+=2){
    STEP(pB0,pB1,pA0,pA1,t,true,true,true);     WAIT_BAR(2); RESC(); ROT();
    STEP(pA0,pA1,pB0,pB1,t+1,true,true,true);   WAIT_BAR(2); RESC(); ROT();
  }
  #undef CMASK
  #define CMASK(P0,P1,t) do{int jb_=(t)-(NT-4); if(jb_>=0)cmask(P0,P1,jb_,qrel,hi); else if(MOBA_MASK_ON && !(((*SELW())>>((t)>>2))&1u)){ _Pragma("unroll") for(int r_=0;r_<16;++r_){P0[r_]=-INFINITY;P1[r_]=-INFINITY;} } }while(0)
  #define ENDW(tt) do{ if((tt)+3<NT){WAIT_BAR(2);} else if((tt)+2<NT){WAIT_BAR(1);} else {WAIT_BAR(0);} }while(0)
  for(;t+1<NT;t+=2){
    STEP(pB0,pB1,pA0,pA1,t,(t+3<NT),(t+1<NT),(t+1<NT));       ENDW(t);   RESC(); ROT();
    STEP(pA0,pA1,pB0,pB1,t+1,(t+4<NT),(t+2<NT),(t+2<NT));     ENDW(t+1); RESC(); ROT();
  }
  STEP(pB0,pB1,pA0,pA1,NT-1,false,false,false); RESC();
  { float sacc=pB0[0]+pB0[1]; _Pragma("unroll") for(int r=2;r<16;++r)sacc+=pB0[r]; _Pragma("unroll") for(int r=0;r<16;++r)sacc+=pB1[r]; l_reg+=sacc;
    pw0=(u32x4){PKW(pB0,0),PKW(pB0,2),PKW(pB0,4),PKW(pB0,6)};pw1=(u32x4){PKW(pB0,8),PKW(pB0,10),PKW(pB0,12),PKW(pB0,14)};pw2=(u32x4){PKW(pB1,0),PKW(pB1,2),PKW(pB1,4),PKW(pB1,6)};pw3=(u32x4){PKW(pB1,8),PKW(pB1,10),PKW(pB1,12),PKW(pB1,14)};
    SBAR(); pv(o,vb0+sl_cur,PAF(0),PAF(1),PAF(2),PAF(3)); }
  #undef PKW
  #undef PAF
  #undef VFR
  #undef PIN
  #undef MX3
  #undef GAPA
  #undef GAPB
  #undef EX
  #undef VRD
  #undef KRD
  #undef STEP
  #undef ENDW
  {auto rr=__builtin_amdgcn_permlane32_swap(__float_as_uint(l_reg),__float_as_uint(l_reg),false,false);l_reg=__uint_as_float(rr[0])+__uint_as_float(rr[1]);}
  if(hi==0)wsf[32+r32]=l_reg;asm volatile("s_waitcnt lgkmcnt(0)":::"memory");
  float rli[16];
  #pragma unroll
  for(int r=0;r<16;++r)rli[r]=__builtin_amdgcn_rcpf(wsf[32+crow(r,hi)]);
  bf16*Ow=O+(rowbase+q0+wid*QBLK)*DM+h*D;
  { bf16*stg=(bf16*)(shm+LDS_OST)+wid*2048;
    #pragma unroll
    for(int r=0;r<16;++r){const int orow=crow(r,hi);
      #pragma unroll
      for(int d0=0;d0<2;++d0)stg[orow*64+d0*32+r32]=__float2bfloat16(o[d0][r]*rli[r]);}
    asm volatile("s_waitcnt lgkmcnt(0)":::"memory");
    #pragma unroll
    for(int i=0;i<4;++i){const int row=i*8+(lane>>3),ch=lane&7; const u32x4 v=*(const u32x4*)(stg+row*64+ch*8); ATTN_STORE16(Ow+(long)row*DM+ch*8,v);} }
  asm volatile("s_waitcnt lgkmcnt(0)\n\ts_barrier":::"memory");
  #undef SELW
  #undef DMA_K
  #undef DMA_V
  #undef CMASK
  #undef START
  #undef RESC
  #undef ROT
}
constexpr int ATTN_LDS_BYTES=LDS_BYTES;
struct AttnTensors { const bf16* Q; const bf16* K; const bf16* V; bf16* O; const unsigned* SEL; };
struct AttnUnit { int bh; int qb; };
struct StaticOrder {
  int vcu;
  __device__ __forceinline__ explicit StaticOrder(int grid,int block):vcu((block%8)*(grid/8)+block/8){}
  __device__ __forceinline__ bool next(int i,AttnUnit&u)const{ if(i>=4)return false; const int s=vcu&7; u.bh=vcu>>3; u.qb=(i==0)?s:(i==1)?15-s:(i==2)?16+s:31-s; return true; }
  __device__ __forceinline__ void a_ready(const AttnUnit&)const{}
  __device__ __forceinline__ void done(const AttnUnit&)const{}
};
template<class Sched,int THRL=8> __device__ __forceinline__ void attn_phase(char*lds,const AttnTensors&T,const Sched&S,int wave){
  AttnUnit u;
  for(int i=0;S.next(i,u);++i){ S.a_ready(u); attn_unit<THRL>(u.bh/NHEAD,u.bh%NHEAD,u.qb,T.Q,T.K,T.V,T.O,T.SEL,lds,wave); S.done(u); }
}
#undef SBAR
#undef WAIT_BAR
}

constexpr int NWAVES = 8;
constexpr int BATCH = 2, T = 8192, D = 1024, H = 16, HD = 64, M = BATCH * T;
constexpr int FF = 2816, FFE = 3584, NE = 8, MOE_ROWS = 34816  ;
#ifndef MOE_DOWN_F8
#define MOE_DOWN_F8 1
#endif
constexpr float MOE_HSCALE = 16.f, MOE_DSCALE = 256.f;
constexpr float MOE_WSCALE = 64.f;
constexpr float LN_EPS = 1e-5f, GN_EPS = 64e-5f, ALPHA = 1.6817928305074292f  ;
constexpr size_t MiB = 1u << 20;
constexpr size_t WS_CTL = 0, CTL_ZERO_BYTES = 1 * MiB;
constexpr size_t WS_KMEAN = 1 * MiB;
constexpr size_t WS_SEL = 2 * MiB;
constexpr size_t WS_TOKE = 3 * MiB;
constexpr size_t WS_TOKW = WS_TOKE + 128 * 1024;
constexpr size_t WS_TOKR = WS_TOKW + 128 * 1024;
constexpr size_t WS_GW = WS_TOKR + 128 * 1024;
constexpr size_t WS_BLKCNT = WS_GW + 256 * 1024;
constexpr size_t WS_WMIX = 16 * MiB;
constexpr size_t WS_WFFN = 32 * MiB;
constexpr size_t WS_H = 200 * MiB;
constexpr size_t WS_HB = 264 * MiB;
constexpr size_t WS_K = 296 * MiB, WS_V = 328 * MiB;
constexpr size_t WS_VFIRST = WS_K;
constexpr size_t WS_Y = WS_V;
constexpr size_t WS_SCR = 360 * MiB;
constexpr size_t WS_END = 896 * MiB;
constexpr size_t RS_XM = WS_SCR;
constexpr size_t RS_KP = WS_SCR, RS_AP = WS_SCR + 32 * MiB, RS_VP = WS_SCR + 64 * MiB, RS_BP = WS_SCR + 96 * MiB;
constexpr size_t RS_RKV = WS_SCR + 192 * MiB;
constexpr size_t RS_PRE = RS_RKV;
constexpr size_t RS_LH = WS_SCR + 288 * MiB;
constexpr size_t RS_YG = RS_LH;
constexpr size_t RS_YGC = WS_SCR + 128 * MiB;
#ifdef WKV_SEQ
constexpr size_t RS_YGX = RS_YG;
#else
constexpr size_t RS_YGX = RS_YGC;
#endif
constexpr size_t RS_DEC = WS_SCR + 320 * MiB;
constexpr size_t RS_AB = WS_SCR + 384 * MiB;
constexpr size_t RS_REC0 = WS_SCR + 224 * MiB, RS_REC1 = WS_SCR + 384 * MiB;
constexpr size_t RS_VG = WS_SCR + 448 * MiB;
constexpr size_t RS_GG = WS_SCR + 480 * MiB;
constexpr size_t BS_Q = WS_SCR, BS_PRE = WS_SCR + 32 * MiB, BS_O = WS_SCR + 96 * MiB;
constexpr size_t BS_PO = WS_SCR + 128 * MiB, BS_ML = WS_SCR + 256 * MiB;
constexpr size_t FS_HID = WS_SCR, FS_PRE = WS_SCR + 88 * MiB;
constexpr size_t ES_XG = WS_SCR, ES_HID = WS_SCR + 68 * MiB, ES_YP = WS_SCR + 306 * MiB, ES_YS = WS_SCR + 442 * MiB;
static_assert(RS_GG + 32 * MiB <= WS_END && ES_YS + 56 * MiB <= WS_END && FS_PRE + 64 * MiB <= WS_END, "d_ws map");
constexpr size_t RW_LSTRIDE = 872 * MiB - WS_WMIX;
constexpr size_t WM_BT1 = WS_WMIX, WM_BT2 = WS_WMIX + 8 * MiB, WM_OUT = WS_WMIX + 10 * MiB;
constexpr size_t WM_QKV = WS_WMIX, WM_O = WS_WMIX + 8 * MiB;
constexpr size_t WF_GU = 4 * MiB, WF_DN = 884 * MiB;
constexpr size_t WE_SET = 84 * MiB, WE_GU = WS_WFFN, WE_DN = WS_WFFN + 56 * MiB;
static_assert(MOE_DOWN_F8 == 1, "the two-set MoE weight map assumes the fp8 down projection");
constexpr size_t WM_Q3 = WS_WMIX + 12 * MiB, WM_O3 = WS_WMIX + 14 * MiB;
constexpr int CW_TMO = 0, CW_CODE = 1, CW_QCTR = 2048  , CW_BAR = 4096;
constexpr int RING_OFF = 0, RING_BYTES = 131072;
constexpr int LDSCTL_OFF = RING_BYTES, MISC_OFF = LDSCTL_OFF + 320;
constexpr int LDS_BYTES = 147456;
static_assert(MISC_OFF + 128 <= LDS_BYTES, "LDS map");

#define GAS __attribute__((address_space(1)))
#define LAS __attribute__((address_space(3)))
typedef unsigned short bf16;
typedef unsigned v4u __attribute__((ext_vector_type(4)));
typedef float f32x4 __attribute__((ext_vector_type(4)));
typedef short bf16x8 __attribute__((ext_vector_type(8)));
typedef GAS unsigned gu32;
typedef GAS unsigned long long gu64;
#define RLX_AGENT __ATOMIC_RELAXED, __HIP_MEMORY_SCOPE_AGENT
#define LDS_WAIT() asm volatile("s_waitcnt lgkmcnt(0)" ::: "memory")
#define VM_WAIT() asm volatile("s_waitcnt vmcnt(0)" ::: "memory")
__device__ __forceinline__ unsigned long long rt() { return __builtin_amdgcn_s_memrealtime(); }
__device__ __forceinline__ unsigned f2bf(float f) { unsigned u = __builtin_bit_cast(unsigned, f); return (u + 0x7fffu + ((u >> 16) & 1u)) >> 16; }
__device__ __forceinline__ unsigned pk2(float lo, float hi) { return f2bf(lo) | (f2bf(hi) << 16); }

#define XB_TMO      128
#define XB_XCNT(j)  (256  + 64 * (j))
#define XB_XSUB(j)  (1280 + 64 * (j))
#define XB_XGEN(j)  (2304 + 64 * (j))
#define XB_TOP      3328
#define XB_TOPGEN   3392
#define XCD_BAR_WORDS 3456
#define XB_SPIN_CAP (1u << 18)

__device__ __forceinline__ unsigned xb_ld(unsigned* p)              { return __hip_atomic_load(p, __ATOMIC_RELAXED, __HIP_MEMORY_SCOPE_AGENT); }
__device__ __forceinline__ unsigned xb_add(unsigned* p, unsigned v) { return __hip_atomic_fetch_add(p, v, __ATOMIC_RELAXED, __HIP_MEMORY_SCOPE_AGENT); }
__device__ __forceinline__ unsigned xb_xcc_id() { return (unsigned)__builtin_amdgcn_s_getreg((3 << 11) | 20) & 0xFu; }
#define XB_SPIN(cond, bar) do { unsigned _sp = 0; while (cond) { __builtin_amdgcn_s_sleep(1); \
    if ((++_sp & 255u) == 0u) { if (xb_ld(&(bar)[XB_TMO])) break; if (_sp > XB_SPIN_CAP) { atomicAdd(&(bar)[XB_TMO], 1u); break; } } } } while (0)

struct XcdBarrier {
    unsigned* bar; unsigned x;
    volatile LAS unsigned* st;
};

__device__ __forceinline__ XcdBarrier xcd_barrier_post(unsigned* bar, volatile LAS unsigned* st, bool t0  ) {
    XcdBarrier b; b.bar = bar; b.x = xb_xcc_id(); b.st = st;
    if (t0) (void)xb_add(&bar[XB_XCNT(b.x)], 1u);
    return b;
}
__device__ __forceinline__ void xcd_barrier_complete(unsigned* bar, unsigned x, unsigned& nloc, unsigned& nx) {
    const unsigned G = gridDim.x * gridDim.y * gridDim.z;
    unsigned sum, cnt, mine, sp = 0u;
    for (;;) {
        sum = 0u; cnt = 0u; mine = 0u;
#pragma unroll
        for (unsigned j = 0; j < 16; ++j) { const unsigned c = xb_ld(&bar[XB_XCNT(j)]); sum += c; cnt += (c > 0u) ? 1u : 0u; mine = (j == x) ? c : mine; }
        if (sum == G) break;
        __builtin_amdgcn_s_sleep(1);
        if ((++sp & 255u) == 0u) { if (xb_ld(&bar[XB_TMO])) break; if (sp > XB_SPIN_CAP) { atomicAdd(&bar[XB_TMO], 1u); break; } }
    }
    nloc = mine > 0u ? mine : 1u; nx = cnt > 0u ? cnt : 1u;
}

__device__ __forceinline__ void xcd_barrier(const XcdBarrier& b, bool t0  ) {
    asm volatile("s_waitcnt vmcnt(0)" ::: "memory");
    __syncthreads();
    if (t0) {
        unsigned* bar = b.bar;
        __builtin_amdgcn_s_waitcnt(0);
        unsigned nloc = b.st[0], nx = b.st[1];
        if (nloc == 0u) { xcd_barrier_complete(bar, b.x, nloc, nx); b.st[0] = nloc; b.st[1] = nx; }
        const unsigned old = xb_add(&bar[XB_XSUB(b.x)], 1u);
        const unsigned gen = old / nloc;
        if (old + 1u == (gen + 1u) * nloc) {
            __builtin_amdgcn_fence(__ATOMIC_RELEASE, "agent");
            asm volatile("s_waitcnt vmcnt(0)" ::: "memory");
            const unsigned og = xb_add(&bar[XB_TOP], 1u);
            const unsigned tg = og / nx;
            if (og + 1u == (tg + 1u) * nx) xb_add(&bar[XB_TOPGEN], 1u);
            else XB_SPIN(xb_ld(&bar[XB_TOPGEN]) == tg, bar);
#ifdef XB_L2_INV
            __builtin_amdgcn_fence(__ATOMIC_ACQUIRE, "");
#else
            __builtin_amdgcn_fence(__ATOMIC_ACQUIRE, "agent");
#endif
            xb_add(&bar[XB_XGEN(b.x)], 1u);
            asm volatile("s_waitcnt vmcnt(0)" ::: "memory");
        } else {
            XB_SPIN(xb_ld(&bar[XB_XGEN(b.x)]) == gen, bar);
            __builtin_amdgcn_fence(__ATOMIC_ACQUIRE, "agent");
            asm volatile("s_waitcnt vmcnt(0)" ::: "memory");
        }
    }
    __syncthreads();
}

struct Args { const float* in[33]; float* out; unsigned char* ws; };
enum InIdx { I_X = 0, I_MU, I_WRKV, I_WOUT, I_W0, I_W1, I_W2, I_A0, I_A1, I_A2, I_V0, I_V1, I_V2, I_G1, I_G2, I_KK, I_KA, I_RK, I_GNG, I_GNB,
             I_MK, I_MV, I_MQ, I_MO, I_FG, I_FU, I_FD, I_ROUTER, I_EG, I_EU, I_ED, I_LNG, I_LNB };
struct Frame {
    LAS unsigned char* lds; volatile LAS unsigned* MISC; gu32* ctl; unsigned char* ws;
    int tid, lane, wave, vcu, G, gw, NGW;
};
typedef float f32x2 __attribute__((ext_vector_type(2)));
typedef unsigned u32x2 __attribute__((ext_vector_type(2)));
__device__ __forceinline__ float dpp_sum16(float v) {
    v += __builtin_bit_cast(float, __builtin_amdgcn_update_dpp(0, __builtin_bit_cast(int, v), 0xB1, 0xF, 0xF, true));
    v += __builtin_bit_cast(float, __builtin_amdgcn_update_dpp(0, __builtin_bit_cast(int, v), 0x4E, 0xF, 0xF, true));
    v += __builtin_bit_cast(float, __builtin_amdgcn_update_dpp(0, __builtin_bit_cast(int, v), 0x141, 0xF, 0xF, true));
    v += __builtin_bit_cast(float, __builtin_amdgcn_update_dpp(0, __builtin_bit_cast(int, v), 0x140, 0xF, 0xF, true));
    return v;
}
__device__ __forceinline__ float wave_sum(float v, int lane) {
    v = dpp_sum16(v);
    v += __builtin_bit_cast(float, __builtin_amdgcn_ds_bpermute((lane ^ 16) << 2, __builtin_bit_cast(int, v)));
    v += __builtin_bit_cast(float, __builtin_amdgcn_ds_bpermute((lane ^ 32) << 2, __builtin_bit_cast(int, v)));
    return v;
}
__device__ __forceinline__ float sum16(float v) { return dpp_sum16(v); }
__device__ __forceinline__ float bf2f(unsigned short b) { return __uint_as_float((unsigned)b << 16); }
__device__ __forceinline__ f32x4 bf4_to_f32(u32x2 w) { f32x4 r; r.x = __uint_as_float(w.x << 16); r.y = __uint_as_float(w.x & 0xffff0000u); r.z = __uint_as_float(w.y << 16); r.w = __uint_as_float(w.y & 0xffff0000u); return r; }
__device__ __forceinline__ u32x2 f32_to_bf4(f32x4 v) { u32x2 w; w.x = pk2(v.x, v.y); w.y = pk2(v.z, v.w); return w; }

__device__ __forceinline__ void tr_item(const float* W, int ldw, int Kr, int Nr, int nblk, bf16* WT, int ldt, int row0, int mode, LAS float* scr, int item, int lane) {
    const int kb = item / nblk, nb = item - kb * nblk, k0 = 64 * kb, n0 = 32 * nb;
    const int kg = lane >> 3, n = n0 + 4 * (lane & 7), kk = k0 + 8 * kg;
    f32x4 v[8];
#pragma unroll
    for (int i = 0; i < 8; ++i) { v[i] = (f32x4){0.f, 0.f, 0.f, 0.f}; if (kk + i < Kr && n < Nr) v[i] = *(const f32x4*)(W + (size_t)(kk + i) * ldw + n); }
#pragma unroll
    for (int e = 0; e < 4; ++e) { const int nn = n + e; const int drow = mode == 0 ? row0 + nn : row0 + ((nn >> 7) << 8) + (nn & 127);
        v4u o; o.x = pk2(v[0][e], v[1][e]); o.y = pk2(v[2][e], v[3][e]); o.z = pk2(v[4][e], v[5][e]); o.w = pk2(v[6][e], v[7][e]);
        *(GAS v4u*)(WT + (size_t)drow * ldt + kk) = o; }
}
__device__ __forceinline__ void tr_item8(const float* W, int ldw, int Kr, int Nr, int nblk, unsigned char* WT, int ldt, int row0, int mode, float scale, int item, int lane) {
    const int kb = item / nblk, nb = item - kb * nblk, k0 = 64 * kb, n0 = 32 * nb;
    const int kg = lane >> 3, n = n0 + 4 * (lane & 7), kk = k0 + 8 * kg;
    f32x4 v[8];
#pragma unroll
    for (int i = 0; i < 8; ++i) { v[i] = (f32x4){0.f, 0.f, 0.f, 0.f}; if (kk + i < Kr && n < Nr) v[i] = *(const f32x4*)(W + (size_t)(kk + i) * ldw + n) * scale; }
#pragma unroll
    for (int e = 0; e < 4; ++e) { const int nn = n + e; const int drow = mode == 0 ? row0 + nn : row0 + ((nn >> 7) << 8) + (nn & 127);
        int lo = __builtin_amdgcn_cvt_pk_fp8_f32(v[0][e], v[1][e], 0, false); lo = __builtin_amdgcn_cvt_pk_fp8_f32(v[2][e], v[3][e], lo, true);
        int hi = __builtin_amdgcn_cvt_pk_fp8_f32(v[4][e], v[5][e], 0, false); hi = __builtin_amdgcn_cvt_pk_fp8_f32(v[6][e], v[7][e], hi, true);
        u32x2 o; o.x = (unsigned)lo; o.y = (unsigned)hi; *(GAS u32x2*)(WT + (size_t)drow * ldt + kk) = o; }
}
#define KIN(i) ({ const __attribute__((address_space(4))) char* k_ = (const __attribute__((address_space(4))) char*)__builtin_amdgcn_kernarg_segment_ptr(); asm volatile("" : "+s"(k_)); const GAS float* g_ = (const GAS float*)(*(const float* const __attribute__((address_space(4)))*)(k_ + 8 * (i))); asm volatile("" : "+s"(g_)); (const float*)g_; })
#define CONV_BEGIN() F.lane = fresh_lane(); F.tid = F.wave * 64 + F.lane; asm volatile("" : "+s"(F.G), "+s"(F.wave), "+s"(F.vcu), "+s"(F.gw), "+s"(F.NGW)); GAS unsigned char* cws0_ = (GAS unsigned char*)F.ws; asm volatile("" : "+s"(cws0_)); unsigned char* cws_ = (unsigned char*)cws0_; LAS float* scr_ = (LAS float*)(F.lds + RING_OFF + F.wave * 16384); int it_ = F.gw, base_ = 0
#define JOB(W, ldw, Kr, Nr, Kp, Np, WT, ldt, row0, mode) do { const int nblk_ = (Np) / 32, n_ = ((Kp) / 64) * nblk_; \
    while (it_ < base_ + n_) { tr_item((W), (ldw), (Kr), (Nr), nblk_, (WT), (ldt), (row0), (mode), scr_, it_ - base_, F.lane); it_ += F.NGW; } base_ += n_; } while (0)
#define JOB8(W, ldw, Kr, Nr, Kp, Np, WT, ldt, row0, mode, scale) do { const int nblk_ = (Np) / 32, n_ = ((Kp) / 64) * nblk_; \
    while (it_ < base_ + n_) { tr_item8((W), (ldw), (Kr), (Nr), nblk_, (WT), (ldt), (row0), (mode), (scale), it_ - base_, F.lane); it_ += F.NGW; } base_ += n_; } while (0)

__device__ __forceinline__ void conv_rwkv(Frame& F, int l) {
    CONV_BEGIN();
    cws_ += (size_t)l * RW_LSTRIDE; bf16* BT1 = (bf16*)(cws_ + WM_BT1); bf16* BT2 = (bf16*)(cws_ + WM_BT2); bf16* WO = (bf16*)(cws_ + WM_OUT);
    for (int c = 0; c < 3; ++c) JOB(KIN(I_WRKV) + (size_t)(l * 3 + c) * D * D, D, D, D, D, D, BT1, D, c * D, 0);
    JOB(KIN(I_W1) + (size_t)l * D * 64, 64, D, 64, D, 256, BT1, D, 3072, 0);
    JOB(KIN(I_A1) + (size_t)l * D * 64, 64, D, 64, D, 256, BT1, D, 3328, 0);
    JOB(KIN(I_V1), 32, D, (l == 0 ? 0 : 32), D, 256, BT1, D, 3584, 0);
    JOB(KIN(I_G1) + (size_t)l * D * 160, 160, D, 160, D, 256, BT1, D, 3840, 0);
    JOB(KIN(I_W2) + (size_t)l * 64 * D, D, 64, D, 256, D, BT2, 256, 0, 0);
    JOB(KIN(I_A2) + (size_t)l * 64 * D, D, 64, D, 256, D, BT2, 256, 1024, 0);
    JOB(KIN(I_V2), D, (l == 0 ? 0 : 32), D, 256, D, BT2, 256, 2048, 0);
    JOB(KIN(I_G2) + (size_t)l * 160 * D, D, 160, D, 256, D, BT2, 256, 3072, 0);
    JOB(KIN(I_WOUT) + (size_t)l * D * D, D, D, D, D, D, WO, D, 0, 0);
}
__device__ __forceinline__ void conv_moba(Frame& F, int j) {
    CONV_BEGIN();
    bf16* WQ = (bf16*)(cws_ + (j == 0 ? WM_QKV : WM_Q3)); bf16* WO = (bf16*)(cws_ + (j == 0 ? WM_O : WM_O3));
    JOB(KIN(I_MQ) + (size_t)j * D * D, D, D, D, D, D, WQ, D, 0, 0);
    if (j == 0) { JOB(KIN(I_MK), D, D, D, D, D, WQ, D, D, 0); JOB(KIN(I_MV), D, D, D, D, D, WQ, D, 2 * D, 0); }
    JOB(KIN(I_MO) + (size_t)j * D * D, D, D, D, D, D, WO, D, 0, 0);
}
__device__ __forceinline__ void conv_dense(Frame& F, int e) {
    CONV_BEGIN();
    bf16* GU = (bf16*)(cws_ + WF_GU); bf16* DN = (bf16*)(cws_ + WF_DN);
    JOB(KIN(I_FG) + (size_t)e * D * FF, FF, D, FF, D, FF, GU, D, 0, 1);
    JOB(KIN(I_FU) + (size_t)e * D * FF, FF, D, FF, D, FF, GU, D, 128, 1);
    JOB(KIN(I_FD) + (size_t)e * FF * D, D, FF, D, FF, D, DN, FF, 0, 0);
}
__device__ __forceinline__ void conv_moe(Frame& F, int e) {
    CONV_BEGIN();
    bf16* GU = (bf16*)(cws_ + WE_GU + (size_t)e * WE_SET); bf16* DN = (bf16*)(cws_ + WE_DN + (size_t)e * WE_SET);
    for (int x = 0; x < NE; ++x) {
        JOB8(KIN(I_EG) + (size_t)(e * NE + x) * D * FFE, FFE, D, FFE, D, FFE, (unsigned char*)GU, D, x * 2 * FFE, 1, MOE_WSCALE);
        JOB8(KIN(I_EU) + (size_t)(e * NE + x) * D * FFE, FFE, D, FFE, D, FFE, (unsigned char*)GU, D, x * 2 * FFE + 128, 1, MOE_WSCALE);
        if (MOE_DOWN_F8) JOB8(KIN(I_ED) + (size_t)(e * NE + x) * FFE * D, D, FFE, D, FFE, D, (unsigned char*)DN, FFE, x * D, 0, MOE_DSCALE);
        else JOB(KIN(I_ED) + (size_t)(e * NE + x) * FFE * D, D, FFE, D, FFE, D, DN, FFE, x * D, 0);
    }
}

__device__ __forceinline__ void ln_stats(const f32x4 (&v)[4], float& mean, float& rstd, int lane) {
    float s = 0.f;
#pragma unroll
    for (int j = 0; j < 4; ++j) s += (v[j].x + v[j].y) + (v[j].z + v[j].w);
    mean = wave_sum(s, lane) * (1.f / D); float s2 = 0.f;
#pragma unroll
    for (int j = 0; j < 4; ++j) { const f32x4 d = v[j] - mean; s2 += (d.x * d.x + d.y * d.y) + (d.z * d.z + d.w * d.w); }
    rstd = 1.f / sqrtf(wave_sum(s2, lane) * (1.f / D) + LN_EPS);
}
template <int SRC, bool ROUTER>
__device__ __forceinline__ void ln_phase(Frame& F, const float* PRE, const float* Hin, const float* YP, const int* tokr, const float* gln, const float* bln,
                                         float* Hout, bf16* HB, const float* router, int* toke, float* tokw, int* blkcnt) {
    LAS int* cnt = (LAS int*)(F.lds + RING_OFF + 131072 - 64);
    if (ROUTER) { if (F.tid < 8) cnt[F.tid] = 0; __syncthreads(); }
    f32x4 g4[4], b4[4];
#pragma unroll
    for (int j = 0; j < 4; ++j) { g4[j] = *(const f32x4*)(gln + 4 * F.lane + 256 * j); b4[j] = *(const f32x4*)(bln + 4 * F.lane + 256 * j); }
    const int rpb = M / F.G, rpw = rpb / NWAVES;
    for (int i = 0; i < rpw; ++i) {
        const int m = blockIdx.x * rpb + F.wave * rpw + i;
        f32x4 v[4];
        if (SRC == 0) {
#pragma unroll
            for (int j = 0; j < 4; ++j) v[j] = *(const f32x4*)(PRE + (size_t)m * D + 4 * F.lane + 256 * j);
        } else {
            const int r0 = tokr[2 * m], r1 = tokr[2 * m + 1];
#pragma unroll
            for (int j = 0; j < 4; ++j) { const int c = 4 * F.lane + 256 * j;
                f32x4 y0, y1;
                if (r0 < 32768) y0 = *(const f32x4*)(YP + (size_t)r0 * D + c); else { y0 = (f32x4){0.f, 0.f, 0.f, 0.f}; for (int s = 0; s < 7; ++s) y0 += *(const f32x4*)(PRE + ((size_t)s * 2048 + (r0 - 32768)) * D + c); }
                if (r1 < 32768) y1 = *(const f32x4*)(YP + (size_t)r1 * D + c); else { y1 = (f32x4){0.f, 0.f, 0.f, 0.f}; for (int s = 0; s < 7; ++s) y1 += *(const f32x4*)(PRE + ((size_t)s * 2048 + (r1 - 32768)) * D + c); }
                v[j] = *(const f32x4*)(Hin + (size_t)m * D + c) * ALPHA + y0 + y1; }
        }
        float mean, rstd; ln_stats(v, mean, rstd, F.lane);
#pragma unroll
        for (int j = 0; j < 4; ++j) { v[j] = (v[j] - mean) * rstd * g4[j] + b4[j];
            *(f32x4*)(Hout + (size_t)m * D + 4 * F.lane + 256 * j) = v[j];
            if (HB) *(u32x2*)(HB + (size_t)m * D + 4 * F.lane + 256 * j) = f32_to_bf4(v[j]); }
        if (ROUTER) {
            float lg[8];
#pragma unroll
            for (int e = 0; e < 8; ++e) lg[e] = 0.f;
#pragma unroll
            for (int j = 0; j < 4; ++j)
#pragma unroll
                for (int q = 0; q < 4; ++q) { const float xv = v[j][q]; const f32x4* rp = (const f32x4*)(router + (size_t)(4 * F.lane + 256 * j + q) * 8); const f32x4 ra = rp[0], rb = rp[1];
                    lg[0] += xv * ra.x; lg[1] += xv * ra.y; lg[2] += xv * ra.z; lg[3] += xv * ra.w; lg[4] += xv * rb.x; lg[5] += xv * rb.y; lg[6] += xv * rb.z; lg[7] += xv * rb.w; }
#pragma unroll
            for (int e = 0; e < 8; ++e) lg[e] = wave_sum(lg[e], F.lane);
            int e0 = 0; float l0 = lg[0];
#pragma unroll
            for (int e = 1; e < 8; ++e) if (lg[e] > l0) { l0 = lg[e]; e0 = e; }
            int e1 = -1; float l1 = -INFINITY;
#pragma unroll
            for (int e = 0; e < 8; ++e) if (e != e0 && lg[e] > l1) { l1 = lg[e]; e1 = e; }
            const float w0 = 1.f / (1.f + __expf(l1 - l0)), w1 = 1.f - w0;
            if (F.lane == 0) { toke[2 * m] = e0; toke[2 * m + 1] = e1; tokw[2 * m] = w0; tokw[2 * m + 1] = w1; atomicAdd((int*)&cnt[e0], 1); atomicAdd((int*)&cnt[e1], 1); }
        }
    }
    if (ROUTER) { __syncthreads(); if (F.tid < 8) blkcnt[blockIdx.x * 8 + F.tid] = cnt[F.tid]; }
}

__device__ __forceinline__ void mix_phase(Frame& F, const float* Hx, const float* mu, bf16* XM) {
    f32x4 mu4[6][4];
#pragma unroll
    for (int c = 0; c < 6; ++c)
#pragma unroll
        for (int j = 0; j < 4; ++j) mu4[c][j] = *(const f32x4*)(mu + c * D + 4 * F.lane + 256 * j);
    for (int m = F.gw; m < M; m += F.NGW) {
        const bool first = (m % T) == 0;
#pragma unroll
        for (int j = 0; j < 4; ++j) { const int c0 = 4 * F.lane + 256 * j;
            const f32x4 x = *(const f32x4*)(Hx + (size_t)m * D + c0);
            f32x4 xp = (f32x4){0.f, 0.f, 0.f, 0.f}; if (!first) xp = *(const f32x4*)(Hx + (size_t)(m - 1) * D + c0);
            const f32x4 xx = xp - x;
#pragma unroll
            for (int c = 0; c < 6; ++c) *(u32x2*)(XM + ((size_t)c * M + m) * D + c0) = f32_to_bf4(x + xx * mu4[c][j]); }
    }
}
__device__ __forceinline__ void prep_phase(Frame& F, int l, const bf16* RKV, const float* AA, const bf16* LH, const float* v0, const float* v2, bf16* VF, const float* k_k, const float* k_a, bf16* KP, bf16* AP, bf16* BP, bf16* VP) {
    f32x4 kk4[4], ka4[4];
#pragma unroll
    for (int j = 0; j < 4; ++j) { kk4[j] = *(const f32x4*)(k_k + 4 * F.lane + 256 * j); ka4[j] = *(const f32x4*)(k_a + 4 * F.lane + 256 * j); }
    for (int m = F.gw; m < M; m += F.NGW) {
#pragma unroll
        for (int j = 0; j < 4; ++j) { const size_t o = (size_t)m * D + 4 * F.lane + 256 * j;
            const f32x4 k = bf4_to_f32(*(const u32x2*)(RKV + (size_t)M * D + o)); const u32x2 vraw = *(const u32x2*)(RKV + (size_t)2 * M * D + o); f32x4 v = bf4_to_f32(vraw);
            const f32x4 a = *(const f32x4*)(AA + o);
            f32x4 kk = k * kk4[j]; const float ss = sum16((kk.x * kk.x + kk.y * kk.y) + (kk.z * kk.z + kk.w * kk.w));
            kk = kk * (1.0f / sqrtf(fmaxf(ss, 1e-24f)));
            const f32x4 kp = k * ((a - 1.0f) * ka4[j] + 1.0f);
            if (l == 0) *(u32x2*)(VF + o) = vraw;
            else {
                f32x4 z = *(const f32x4*)(v0 + 4 * F.lane + 256 * j);
                const bf16* lh = LH + (size_t)m * D + 512;
#pragma unroll 8
                for (int q = 0; q < 32; ++q) z += *(const f32x4*)(v2 + (size_t)q * D + 4 * F.lane + 256 * j) * bf2f(lh[q]);
                f32x4 vg; vg.x = 1.f / (1.f + __expf(-z.x)); vg.y = 1.f / (1.f + __expf(-z.y)); vg.z = 1.f / (1.f + __expf(-z.z)); vg.w = 1.f / (1.f + __expf(-z.w));
                const f32x4 vf = bf4_to_f32(*(const u32x2*)(VF + o)); v = v + (vf - v) * vg; }
            *(u32x2*)(KP + o) = f32_to_bf4(kp); *(u32x2*)(VP + o) = f32_to_bf4(v); *(u32x2*)(AP + o) = f32_to_bf4(-kk); *(u32x2*)(BP + o) = f32_to_bf4(kk * a); }
    }
}
__device__ __forceinline__ void post_phase(Frame& F, const bf16* Y, const bf16* R, const bf16* KP, const bf16* VP, const bf16* GG, const float* r_k, const float* gng, const float* gnb, bf16* YG) {
    f32x4 rk4[4], gg4[4], gb4[4];
#pragma unroll
    for (int j = 0; j < 4; ++j) { rk4[j] = *(const f32x4*)(r_k + 4 * F.lane + 256 * j); gg4[j] = *(const f32x4*)(gng + 4 * F.lane + 256 * j); gb4[j] = *(const f32x4*)(gnb + 4 * F.lane + 256 * j); }
    for (int m = F.gw; m < M; m += F.NGW) {
#pragma unroll
        for (int j = 0; j < 4; ++j) { const size_t o = (size_t)m * D + 4 * F.lane + 256 * j;
            const f32x4 y = bf4_to_f32(*(const u32x2*)(Y + o)), r = bf4_to_f32(*(const u32x2*)(R + o)), g = bf4_to_f32(*(const u32x2*)(GG + o));
            const f32x4 kp = bf4_to_f32(*(const u32x2*)(KP + o)), vp = bf4_to_f32(*(const u32x2*)(VP + o));
            const float mean = sum16((y.x + y.y) + (y.z + y.w)) * (1.f / 64.f); const f32x4 d = y - mean;
            const float var = sum16((d.x * d.x + d.y * d.y) + (d.z * d.z + d.w * d.w)) * (1.f / 64.f);
            const f32x4 rkk = r * kp * rk4[j]; const float bon = sum16((rkk.x + rkk.y) + (rkk.z + rkk.w));
            const f32x4 yn = d * (1.0f / sqrtf(var + GN_EPS)) * gg4[j] + gb4[j] + vp * bon;
            *(u32x2*)(YG + o) = f32_to_bf4(yn * g); }
    }
}
__device__ __forceinline__ float fma_s(float a, float b, float c) { float r; asm("v_fma_f32 %0, %1, %2, %3" : "=v"(r) : "v"(a), "v"(b), "v"(c)); return r; }
__device__ __forceinline__ float mul_s(float a, float b) { float r; asm("v_mul_f32_e32 %0, %1, %2" : "=v"(r) : "v"(a), "v"(b)); return r; }
__device__ __forceinline__ float add_s(float a, float b) { float r; asm("v_add_f32_e32 %0, %1, %2" : "=v"(r) : "v"(a), "v"(b)); return r; }
__device__ __forceinline__ float dot4_s(const f32x4& x, const f32x4& y) { return add_s(fma_s(x.y, y.y, mul_s(x.x, y.x)), fma_s(x.w, y.w, mul_s(x.z, y.z))); }
__device__ __forceinline__ f32x4 upd_s(const f32x4& S, const f32x4& w, const f32x4& b, float sa, const f32x4& k, float v) {
    f32x4 r; r.x = fma_s(S.x, w.x, fma_s(b.x, sa, mul_s(k.x, v))); r.y = fma_s(S.y, w.y, fma_s(b.y, sa, mul_s(k.y, v))); r.z = fma_s(S.z, w.z, fma_s(b.z, sa, mul_s(k.z, v))); r.w = fma_s(S.w, w.w, fma_s(b.w, sa, mul_s(k.w, v))); return r; }
__device__ __forceinline__ void scan_phase(Frame& F, const bf16* R, const float* DEC, const bf16* KP, const bf16* AP, const bf16* BP, const bf16* VP, bf16* Y) {
    constexpr int TS = 32, BUFB = 57600, YB_OFF = 2 * BUFB;
    const int head = F.vcu >> 3, part = F.vcu & 7, b = head >> 4, hh = head & 15;
    const size_t rowb = (size_t)b * T; const int col0 = hh * 64;
    const int tr = F.tid >> 4, pc = F.tid & 15;
    const int tr2 = (F.tid & 255) >> 3, pc2 = F.tid & 7;
    const int rr = F.lane >> 4, q = F.lane & 15, myrow = 8 * part + 4 * F.wave + rr;
    LAS unsigned char* L = F.lds + RING_OFF;
    struct Stg { f32x4 lw; u32x2 rk, ra, rb, rv, rn; v4u lr; };
    Stg g0, g1;
#define SC_LOAD(c, G) do { const int t_ = (c) * TS + tr; const size_t g_ = (rowb + t_) * D + col0 + pc * 4; G.lw = *(const f32x4*)(DEC + g_); G.rk = *(const u32x2*)(KP + g_); G.ra = *(const u32x2*)(AP + g_); \
        G.rb = *(const u32x2*)(BP + g_); G.rv = *(const u32x2*)(VP + g_); G.rn = (u32x2){0u, 0u}; if (t_ + 1 < T) G.rn = *(const u32x2*)(AP + g_ + D); \
        if (F.tid < 256) G.lr = *(const v4u*)(R + (rowb + (size_t)(c) * TS + tr2) * D + col0 + pc2 * 8); } while (0)
#define SC_STORE(bf, G) do { const f32x4 lk_ = bf4_to_f32(G.rk), la_ = bf4_to_f32(G.ra), lb_ = bf4_to_f32(G.rb), lv_ = bf4_to_f32(G.rv), ln_ = bf4_to_f32(G.rn); LAS unsigned char* d_ = L + (bf) * BUFB + tr * 256 + pc * 16; *(LAS f32x4*)(d_) = G.lw; *(LAS f32x4*)(d_ + 8192) = lk_; *(LAS f32x4*)(d_ + 16384) = la_; \
        *(LAS f32x4*)(d_ + 24576) = lb_; *(LAS f32x4*)(d_ + 32768) = lv_; *(LAS f32x4*)(d_ + 49152) = G.lw * ln_; \
        { const f32x4 pb_ = lb_ * ln_, pk_ = lk_ * ln_; const float be_ = dpp_sum16((pb_.x + pb_.y) + (pb_.z + pb_.w)), ga_ = dpp_sum16((pk_.x + pk_.y) + (pk_.z + pk_.w)); \
          if (pc == 0) { *(LAS float*)(L + (bf) * BUFB + 57344 + tr * 4) = be_; *(LAS float*)(L + (bf) * BUFB + 57472 + tr * 4) = ga_; } } \
        if (F.tid < 256) { LAS unsigned char* r_ = L + (bf) * BUFB + 40960 + tr2 * 256 + pc2 * 32; \
            *(LAS f32x4*)(r_) = (f32x4){__uint_as_float(G.lr.x << 16), __uint_as_float(G.lr.x & 0xffff0000u), __uint_as_float(G.lr.y << 16), __uint_as_float(G.lr.y & 0xffff0000u)}; \
            *(LAS f32x4*)(r_ + 16) = (f32x4){__uint_as_float(G.lr.z << 16), __uint_as_float(G.lr.z & 0xffff0000u), __uint_as_float(G.lr.w << 16), __uint_as_float(G.lr.w & 0xffff0000u)}; } } while (0)
    SC_LOAD(0, g0); SC_STORE(0, g0); SC_LOAD(1, g0); __syncthreads();
    f32x4 S = (f32x4){0.f, 0.f, 0.f, 0.f};
    constexpr int NCH = T / TS;
    for (int c2 = 0; c2 < NCH; c2 += 2) {
#pragma unroll
      for (int par = 0; par < 2; ++par) {
        const int c = c2 + par, bf = par;
        if (c + 2 < NCH) { if (par == 0) SC_LOAD(c + 2, g1); else SC_LOAD(c + 2, g0); }
        if (F.wave < 2) {
            const LAS unsigned char* B0 = L + bf * BUFB + q * 16; const LAS unsigned char* Bv = L + bf * BUFB + 32768 + myrow * 4; const LAS unsigned char* Bs = L + bf * BUFB + 57344;
            LAS unsigned short* yb = (LAS unsigned short*)(L + YB_OFF + bf * 512) + q * 8 + 4 * F.wave + rr;
            struct Rnd { f32x4 a, aw, w0, b0, k0, r0, w1, b1, k1, r1; float v0, v1, be, ga; };
#define SC_FETCH(t_, X) do { X.a = *(const LAS f32x4*)(B0 + 16384 + (t_) * 256); X.aw = *(const LAS f32x4*)(B0 + 49152 + (t_) * 256); \
            X.w0 = *(const LAS f32x4*)(B0 + (t_) * 256); X.b0 = *(const LAS f32x4*)(B0 + 24576 + (t_) * 256); X.k0 = *(const LAS f32x4*)(B0 + 8192 + (t_) * 256); X.r0 = *(const LAS f32x4*)(B0 + 40960 + (t_) * 256); \
            X.w1 = *(const LAS f32x4*)(B0 + ((t_) + 1) * 256); X.b1 = *(const LAS f32x4*)(B0 + 24576 + ((t_) + 1) * 256); X.k1 = *(const LAS f32x4*)(B0 + 8192 + ((t_) + 1) * 256); X.r1 = *(const LAS f32x4*)(B0 + 40960 + ((t_) + 1) * 256); \
            X.v0 = *(const LAS float*)(Bv + (t_) * 256); X.v1 = *(const LAS float*)(Bv + ((t_) + 1) * 256); X.be = *(const LAS float*)(Bs + (t_) * 4); X.ga = *(const LAS float*)(Bs + 128 + (t_) * 4); } while (0)
            Rnd cu; float ykeep = 0.f, yra = 0.f, yrb = 0.f;
#define RED_STEP(x, ctl) asm volatile("v_add_f32_dpp %0, %0, %0 " ctl " row_mask:0xf bank_mask:0xf bound_ctrl:1" : "+v"(x))
#define RED_STEP0(x, ctl) asm volatile("s_nop 1\n\tv_add_f32_dpp %0, %0, %0 " ctl " row_mask:0xf bank_mask:0xf bound_ctrl:1" : "+v"(x))
#define RED4(a_, b_, c_, d_) do { \
            RED_STEP0(a_, "quad_perm:[1,0,3,2]"); RED_STEP0(b_, "quad_perm:[1,0,3,2]"); RED_STEP0(c_, "quad_perm:[1,0,3,2]"); RED_STEP0(d_, "quad_perm:[1,0,3,2]"); \
            RED_STEP(a_, "quad_perm:[2,3,0,1]"); RED_STEP(b_, "quad_perm:[2,3,0,1]"); RED_STEP(c_, "quad_perm:[2,3,0,1]"); RED_STEP(d_, "quad_perm:[2,3,0,1]"); \
            RED_STEP(a_, "row_half_mirror"); RED_STEP(b_, "row_half_mirror"); RED_STEP(c_, "row_half_mirror"); RED_STEP(d_, "row_half_mirror"); \
            RED_STEP(a_, "row_mirror"); RED_STEP(b_, "row_mirror"); RED_STEP(c_, "row_mirror"); RED_STEP(d_, "row_mirror"); } while (0)
            SC_FETCH(0, cu);
#pragma unroll
            for (int t = 0; t < TS; t += 2) {
                Rnd nx = cu;
                if (t + 2 < TS) SC_FETCH(t + 2, nx);
                const f32x4 p1 = S * cu.a, p2 = S * cu.aw;
                float u1 = (p1.x + p1.y) + (p1.z + p1.w), u2 = (p2.x + p2.y) + (p2.z + p2.w);
                RED4(u1, u2, yra, yrb);
                if (t > 0) { ykeep = (q == ((t - 2) & 15)) ? yra : ykeep; ykeep = (q == ((t - 1) & 15)) ? yrb : ykeep;
                             if (((t - 1) & 15) == 15) yb[(t - 16) * 8] = (unsigned short)f2bf(ykeep); }
                const float sa0 = u1, sa1 = u2 + sa0 * cu.be + cu.v0 * cu.ga;
                S = S * cu.w0 + (cu.b0 * sa0 + cu.k0 * cu.v0);
                const f32x4 y4a = S * cu.r0;
                S = S * cu.w1 + (cu.b1 * sa1 + cu.k1 * cu.v1);
                const f32x4 y4b = S * cu.r1;
                yra = (y4a.x + y4a.y) + (y4a.z + y4a.w); yrb = (y4b.x + y4b.y) + (y4b.z + y4b.w);
                cu = nx;
            }
            { float d0_ = 0.f, d1_ = 0.f; RED4(yra, yrb, d0_, d1_);
              ykeep = (q == 14) ? yra : ykeep; ykeep = (q == 15) ? yrb : ykeep; yb[16 * 8] = (unsigned short)f2bf(ykeep); }
#undef RED4
#undef RED_STEP0
#undef RED_STEP
#undef SC_FETCH
        }
        if (c + 1 < NCH) { if (par == 0) SC_STORE(1, g0); else SC_STORE(0, g1); }
        __syncthreads();
        if (F.tid < 32) { const v4u yv = *(const LAS v4u*)(L + YB_OFF + bf * 512 + F.tid * 16);
            *(v4u*)(Y + (rowb + (size_t)c * TS + F.tid) * D + col0 + part * 8) = yv; }
      }
    }
#undef SC_LOAD
#undef SC_STORE
}

__device__ __forceinline__ void kmean_phase(Frame& F, const bf16* Kb, float* KM) {
    LAS float* red = (LAS float*)(F.lds + RING_OFF);
    for (int u = blockIdx.x; u < 2 * 32 * 4; u += F.G) {
        const int qc = u & 3, blk = (u >> 2) & 31, b = u >> 7; const int c = F.tid & 255, rh = F.tid >> 8;
        const bf16* p = Kb + ((size_t)b * T + blk * 256 + rh * 128) * D + qc * 256 + c; float s = 0.f;
#pragma unroll 8
        for (int r = 0; r < 128; ++r) s += bf2f(p[(size_t)r * D]);
        if (rh == 1) red[c] = s;
        __syncthreads();
        if (rh == 0) { const int col = qc * 256 + c; KM[(((size_t)b * H + (col >> 6)) * 32 + blk) * 64 + (col & 63)] = (s + red[c]) * (1.f / 256.f); }
        __syncthreads();
    }
}
__device__ __forceinline__ void gate_phase(Frame& F, const bf16* Q, const float* KM, unsigned* SEL) {
    LAS float* km = (LAS float*)(F.lds + RING_OFF);
    for (int u = blockIdx.x; u < M / 64; u += F.G) {
        const int m0 = u * 64, b = m0 / T, own = (m0 % T) >> 8;
        for (int i = F.tid; i < 16 * 32 * 16; i += NWAVES * 64) *(LAS f32x4*)(km + 4 * i) = *(const f32x4*)(KM + (size_t)b * 16 * 32 * 64 + 4 * i);
        __syncthreads();
        const int m = m0 + F.lane;
#pragma unroll 1
        for (int hi = 0; hi < 2; ++hi) { const int h = 2 * F.wave + hi;
            float qv[64];
#pragma unroll
            for (int i = 0; i < 8; ++i) { const v4u w = *(const v4u*)(Q + (size_t)m * D + h * 64 + 8 * i);
                qv[8 * i + 0] = __uint_as_float(w.x << 16); qv[8 * i + 1] = __uint_as_float(w.x & 0xffff0000u); qv[8 * i + 2] = __uint_as_float(w.y << 16); qv[8 * i + 3] = __uint_as_float(w.y & 0xffff0000u);
                qv[8 * i + 4] = __uint_as_float(w.z << 16); qv[8 * i + 5] = __uint_as_float(w.z & 0xffff0000u); qv[8 * i + 6] = __uint_as_float(w.w << 16); qv[8 * i + 7] = __uint_as_float(w.w & 0xffff0000u); }
            float v0 = -INFINITY, v1 = -INFINITY, v2 = -INFINITY; int i0 = -1, i1 = -1, i2 = -1;
            for (int j = 0; j < own; ++j) { const LAS f32x4* kp = (const LAS f32x4*)(km + (h * 32 + j) * 64); float s = 0.f;
#pragma unroll
                for (int i = 0; i < 16; ++i) { const f32x4 kv = kp[i]; s += qv[4 * i] * kv.x + qv[4 * i + 1] * kv.y + qv[4 * i + 2] * kv.z + qv[4 * i + 3] * kv.w; }
                if (s > v0) { v2 = v1; i2 = i1; v1 = v0; i1 = i0; v0 = s; i0 = j; } else if (s > v1) { v2 = v1; i2 = i1; v1 = s; i1 = j; } else if (s > v2) { v2 = s; i2 = j; } }
            unsigned mask = 0u; if (i0 >= 0) mask |= 1u << i0; if (i1 >= 0) mask |= 1u << i1; if (i2 >= 0) mask |= 1u << i2;
            SEL[((size_t)b * H + h) * T + (m % T)] = mask; }
        __syncthreads();
    }
}

__device__ __forceinline__ void moe_prefix(Frame& F, const int* blkcnt, LAS int* pre_mine  ) {
    LAS int* tmp = (LAS int*)(F.lds + RING_OFF);
    for (int i = F.tid; i < F.G * 8; i += NWAVES * 64) tmp[i] = blkcnt[i];
    __syncthreads();
    if (F.tid < 8) { int tot = 0, mine = 0; for (int g = 0; g < F.G; ++g) { if (g == (int)blockIdx.x) mine = tot; tot += tmp[g * 8 + F.tid]; }
        pre_mine[F.tid] = mine; pre_mine[8 + F.tid] = tot; }
    __syncthreads();
    if (F.tid == 0) { int p = 0; for (int e = 0; e < 8; ++e) { F.MISC[16 + e] = (unsigned)p; p += (pre_mine[8 + e] + 255) >> 8; } F.MISC[24] = (unsigned)p; }
    __syncthreads();
}
__device__ __forceinline__ void moe_gather_phase(Frame& F, const int* blkcnt, const int* toke, const float* tokw, int* tokr, float* gw, const float* Hs, unsigned char* XG) {
    LAS int* pm = (LAS int*)(F.lds + RING_OFF + 16384);
    LAS int* rows = (LAS int*)(F.lds + RING_OFF + 16384 + 64);
    moe_prefix(F, blkcnt, pm);
    const int rpb = M / F.G;
    if (F.wave == 0) {
        const int m = blockIdx.x * rpb + F.lane; const bool ok = F.lane < rpb;
        const int e0 = ok ? toke[2 * m] : -1, e1 = ok ? toke[2 * m + 1] : -1;
        int r0 = 0, r1 = 0;
        for (int e = 0; e < 8; ++e) { const unsigned long long b0 = __ballot(e0 == e), b1 = __ballot(e1 == e); const unsigned long long lt = (1ull << F.lane) - 1ull;
            const int base = (int)F.MISC[16 + e] * 256 + pm[e];
            if (e0 == e) r0 = base + __popcll(b0 & lt);
            if (e1 == e) r1 = base + __popcll(b0) + __popcll(b1 & lt); }
        if (ok) { tokr[2 * m] = r0; tokr[2 * m + 1] = r1; gw[r0] = tokw[2 * m]; gw[r1] = tokw[2 * m + 1]; rows[2 * F.lane] = r0; rows[2 * F.lane + 1] = r1; }
    }
    __syncthreads();
    for (int i = F.wave; i < 2 * rpb; i += NWAVES) { const int m = blockIdx.x * rpb + (i >> 1), r = rows[i];
        const f32x4* s = (const f32x4*)(Hs + (size_t)m * D + 16 * F.lane); const f32x4 a = s[0], b_ = s[1], c = s[2], d = s[3];
        v4u o; int w;
        w = __builtin_amdgcn_cvt_pk_fp8_f32(a.x, a.y, 0, false); w = __builtin_amdgcn_cvt_pk_fp8_f32(a.z, a.w, w, true); o.x = (unsigned)w;
        w = __builtin_amdgcn_cvt_pk_fp8_f32(b_.x, b_.y, 0, false); w = __builtin_amdgcn_cvt_pk_fp8_f32(b_.z, b_.w, w, true); o.y = (unsigned)w;
        w = __builtin_amdgcn_cvt_pk_fp8_f32(c.x, c.y, 0, false); w = __builtin_amdgcn_cvt_pk_fp8_f32(c.z, c.w, w, true); o.z = (unsigned)w;
        w = __builtin_amdgcn_cvt_pk_fp8_f32(d.x, d.y, 0, false); w = __builtin_amdgcn_cvt_pk_fp8_f32(d.z, d.w, w, true); o.w = (unsigned)w;
        *(v4u*)(XG + (size_t)r * D + 16 * F.lane) = o; }
    __syncthreads();
}
__device__ __forceinline__ void attn_direct_phase(Frame& F, const bf16* Q, const bf16* Kb, const bf16* Vb, const unsigned* SEL, bf16* O) {
    for (int u = F.gw; u < (M / 64) * H; u += F.NGW) {
        const int h = u & 15, m0 = (u >> 4) * 64, b = m0 / T, t0 = m0 % T, own = t0 >> 8, m = m0 + F.lane, tpos = t0 + F.lane;
        float q[64], o[64];
#pragma unroll
        for (int i = 0; i < 8; ++i) { const v4u w = *(const v4u*)(Q + (size_t)m * D + h * 64 + 8 * i);
            q[8 * i + 0] = __uint_as_float(w.x << 16); q[8 * i + 1] = __uint_as_float(w.x & 0xffff0000u); q[8 * i + 2] = __uint_as_float(w.y << 16); q[8 * i + 3] = __uint_as_float(w.y & 0xffff0000u);
            q[8 * i + 4] = __uint_as_float(w.z << 16); q[8 * i + 5] = __uint_as_float(w.z & 0xffff0000u); q[8 * i + 6] = __uint_as_float(w.w << 16); q[8 * i + 7] = __uint_as_float(w.w & 0xffff0000u); }
#pragma unroll
        for (int i = 0; i < 64; ++i) o[i] = 0.f;
        const unsigned sel = SEL[((size_t)b * H + h) * T + tpos];
        float mrun = -INFINITY, l = 0.f;
        for (int j = 0; j <= own; ++j) {
            const bool pastsel = (sel >> j) & 1u;
            if (j < own && !__any(pastsel)) continue;
            const int nk = (j < own) ? 256 : (t0 & 255) + 64;
            for (int kk = 0; kk < nk; ++kk) {
                const int kpos = j * 256 + kk; const size_t ro = ((size_t)b * T + kpos) * D + h * 64;
                float s = 0.f;
#pragma unroll
                for (int i = 0; i < 8; ++i) { const v4u w = *(const v4u*)(Kb + ro + 8 * i);
                    s += q[8 * i + 0] * __uint_as_float(w.x << 16) + q[8 * i + 1] * __uint_as_float(w.x & 0xffff0000u) + q[8 * i + 2] * __uint_as_float(w.y << 16) + q[8 * i + 3] * __uint_as_float(w.y & 0xffff0000u)
                       + q[8 * i + 4] * __uint_as_float(w.z << 16) + q[8 * i + 5] * __uint_as_float(w.z & 0xffff0000u) + q[8 * i + 6] * __uint_as_float(w.w << 16) + q[8 * i + 7] * __uint_as_float(w.w & 0xffff0000u); }
                const bool act = (j < own) ? pastsel : (kpos <= tpos);
                if (act) {
                    if (s > mrun) { const float c = exp2f(mrun - s); l *= c;
#pragma unroll
                        for (int i = 0; i < 64; ++i) o[i] *= c;
                        mrun = s; }
                    const float p = exp2f(s - mrun); l += p;
#pragma unroll
                    for (int i = 0; i < 8; ++i) { const v4u w = *(const v4u*)(Vb + ro + 8 * i);
                        o[8 * i + 0] += p * __uint_as_float(w.x << 16); o[8 * i + 1] += p * __uint_as_float(w.x & 0xffff0000u); o[8 * i + 2] += p * __uint_as_float(w.y << 16); o[8 * i + 3] += p * __uint_as_float(w.y & 0xffff0000u);
                        o[8 * i + 4] += p * __uint_as_float(w.z << 16); o[8 * i + 5] += p * __uint_as_float(w.z & 0xffff0000u); o[8 * i + 6] += p * __uint_as_float(w.w << 16); o[8 * i + 7] += p * __uint_as_float(w.w & 0xffff0000u); }
                }
            }
        }
        const float rl = 1.0f / l;
#pragma unroll
        for (int i = 0; i < 8; ++i) { v4u w; w.x = pk2(o[8 * i] * rl, o[8 * i + 1] * rl); w.y = pk2(o[8 * i + 2] * rl, o[8 * i + 3] * rl); w.z = pk2(o[8 * i + 4] * rl, o[8 * i + 5] * rl); w.w = pk2(o[8 * i + 6] * rl, o[8 * i + 7] * rl);
            *(v4u*)(O + (size_t)m * D + h * 64 + 8 * i) = w; }
    }
}
namespace moba {
using attn_body::f32x16; using attn_body::crow;
constexpr int L_K = 0, L_V = 32768, L_LIST = 65536, L_WS = 81920, L_CTL = 84992;
__device__ __forceinline__ void qkt_l(f32x16& p0, f32x16& p1, const LAS unsigned char* Kslot, const bf16x8* qr, int r32, int hi) {
    const LAS unsigned char* kb = Kslot + hi * 1024 + r32 * 16;
#pragma unroll
    for (int d0 = 0; d0 < 4; ++d0) {
        const bf16x8 b0 = *(const LAS bf16x8*)(kb + d0 * 2048), b1 = *(const LAS bf16x8*)(kb + d0 * 2048 + 512);
        if (d0 == 0) { p0 = __builtin_amdgcn_mfma_f32_32x32x16_bf16(b0, qr[0], f32x16{}, 0, 0, 0); p1 = __builtin_amdgcn_mfma_f32_32x32x16_bf16(b1, qr[0], f32x16{}, 0, 0, 0); }
        else { p0 = __builtin_amdgcn_mfma_f32_32x32x16_bf16(b0, qr[d0], p0, 0, 0, 0); p1 = __builtin_amdgcn_mfma_f32_32x32x16_bf16(b1, qr[d0], p1, 0, 0, 0); } }
}
__device__ __forceinline__ float half_max(float v) { auto rr = __builtin_amdgcn_permlane32_swap(__float_as_uint(v), __float_as_uint(v), false, false); return fmaxf(__uint_as_float(rr[0]), __uint_as_float(rr[1])); }
__device__ __forceinline__ float half_sum(float v) { auto rr = __builtin_amdgcn_permlane32_swap(__float_as_uint(v), __float_as_uint(v), false, false); return __uint_as_float(rr[0]) + __uint_as_float(rr[1]); }
}
__device__ __forceinline__ void moba_attn_phase(Frame& F, const bf16* Q, const bf16* Kb, const bf16* Vb, const unsigned* SELT, bf16* PO, float* ML, gu32* qctr) {
    using namespace moba;
    const int lane = F.lane, wid = F.wave, r32 = lane & 31, hi = lane >> 5;
    LAS unsigned char* L = F.lds + RING_OFF;
    LAS unsigned short* list = (LAS unsigned short*)(L + L_LIST);
    LAS float* wsf = (LAS float*)(L + L_WS + wid * 256); LAS int* wsd = (LAS int*)(L + L_WS + wid * 256 + 128);
    LAS int* ctl = (LAS int*)(L + L_CTL);
    const int vb0 = RING_OFF + L_V + ((lane >> 4) & 1) * 32 + (lane & 3) * 8 + (4 * hi + ((lane & 15) >> 2)) * 64;
    for (;;) {
        __syncthreads();
        if (F.tid == 0) { ctl[0] = (int)__hip_atomic_fetch_add(qctr, 1u, __ATOMIC_RELAXED, __HIP_MEMORY_SCOPE_AGENT); ctl[1] = 0; }
        __syncthreads();
        const int u = __builtin_amdgcn_readfirstlane(ctl[0]);
        if (u >= 32 * 32) break;
        const int j = u >> 5, bh = u & 31, b = bh >> 4, h = bh & 15;
        const size_t rowb = (size_t)b * T;
        { const bf16* ksrc = Kb + (rowb + 256 * j + lane) * D + h * 64 + wid * 8;
          const bf16* vsrc = Vb + (rowb + 256 * j + 16 * (wid & 3) + (lane >> 2)) * D + h * 64 + (wid >> 2) * 32 + (lane & 3) * 8;
#pragma unroll
          for (int kt = 0; kt < 4; ++kt) { attn_body::glds16(ksrc + (size_t)kt * 64 * D, (unsigned)__builtin_amdgcn_readfirstlane(RING_OFF + L_K + kt * 8192 + wid * 1024));
                                           attn_body::glds16(vsrc + (size_t)kt * 64 * D, (unsigned)__builtin_amdgcn_readfirstlane(RING_OFF + L_V + kt * 8192 + wid * 1024)); } }
        const unsigned* selrow = SELT + (size_t)bh * T;
        for (int t0 = 256 * (j + 1); t0 < T; t0 += NWAVES * 64) { const int t = t0 + F.tid; const bool in = t < T;
            const bool p = in && ((selrow[in ? t : 0] >> j) & 1u);
            const unsigned long long bal = __ballot(p); const int np = __popcll(bal);
            int base = 0; if (lane == 0 && np) base = __hip_atomic_fetch_add(&ctl[1], np, __ATOMIC_RELAXED, __HIP_MEMORY_SCOPE_WORKGROUP);
            base = __builtin_amdgcn_readfirstlane(base);
            if (p) list[base + __popcll(bal & ((1ull << lane) - 1ull))] = (unsigned short)t; }
        asm volatile("s_waitcnt vmcnt(0) lgkmcnt(0)" ::: "memory");
        __syncthreads();
        const int total = 256 + ctl[1], nb = (total + 31) >> 5;
        for (int bi = wid; bi < nb; bi += NWAVES) {
            const int item = bi * 32 + r32; const bool valid = item < total; const int it2 = valid ? item : total - 1;
            const bool ownb = bi < 8;
            const int t = it2 < 256 ? 256 * j + it2 : (int)list[it2 - 256];
            const bf16* qrow = Q + (rowb + t) * D + h * 64;
            bf16x8 qr[4];
#pragma unroll
            for (int d0 = 0; d0 < 4; ++d0) qr[d0] = *(const bf16x8*)(qrow + d0 * 16 + hi * 8);
            f32x16 P[4][2];
#pragma unroll
            for (int kt = 0; kt < 4; ++kt) qkt_l(P[kt][0], P[kt][1], L + L_K + kt * 8192, qr, r32, hi);
            if (ownb) {
#pragma unroll
                for (int kt = 0; kt < 4; ++kt) attn_body::cmask(P[kt][0], P[kt][1], kt, t - 256 * j, hi); }
            float mx = -INFINITY;
#pragma unroll
            for (int kt = 0; kt < 4; ++kt)
#pragma unroll
                for (int r = 0; r < 16; ++r) mx = fmaxf(mx, fmaxf(P[kt][0][r], P[kt][1][r]));
            mx = half_max(mx);
            float ls = 0.f;
#pragma unroll
            for (int kt = 0; kt < 4; ++kt)
#pragma unroll
                for (int r = 0; r < 16; ++r) { P[kt][0][r] = __builtin_amdgcn_exp2f(P[kt][0][r] - mx); P[kt][1][r] = __builtin_amdgcn_exp2f(P[kt][1][r] - mx); ls += P[kt][0][r] + P[kt][1][r]; }
            ls = half_sum(ls);
            f32x16 o[2]; o[0] = f32x16{}; o[1] = f32x16{};
#pragma unroll
            for (int kt = 0; kt < 4; ++kt) {
                attn_body::u32x4 w0, w1, w2, w3;
#define PKW_(P_, B_) attn_body::cvtpk_s(P_[B_], P_[B_ + 1])
                w0 = (attn_body::u32x4){PKW_(P[kt][0], 0), PKW_(P[kt][0], 2), PKW_(P[kt][0], 4), PKW_(P[kt][0], 6)}; w1 = (attn_body::u32x4){PKW_(P[kt][0], 8), PKW_(P[kt][0], 10), PKW_(P[kt][0], 12), PKW_(P[kt][0], 14)};
                w2 = (attn_body::u32x4){PKW_(P[kt][1], 0), PKW_(P[kt][1], 2), PKW_(P[kt][1], 4), PKW_(P[kt][1], 6)}; w3 = (attn_body::u32x4){PKW_(P[kt][1], 8), PKW_(P[kt][1], 10), PKW_(P[kt][1], 12), PKW_(P[kt][1], 14)};
#undef PKW_
                attn_body::pv(o, vb0 + kt * 8192, __builtin_bit_cast(bf16x8, w0), __builtin_bit_cast(bf16x8, w1), __builtin_bit_cast(bf16x8, w2), __builtin_bit_cast(bf16x8, w3)); }
            const unsigned sel = selrow[t];
            const int slot = ownb ? 3 : __popc(sel & ((1u << j) - 1u));
            const int dest = (int)(((rowb + t) * H + h) * 4 + slot);
            if (hi == 0) { wsf[r32] = 1.0f / ls; wsd[r32] = valid ? dest : -1; if (valid) { ML[(size_t)dest * 2] = mx; ML[(size_t)dest * 2 + 1] = ls; } }
            asm volatile("s_waitcnt lgkmcnt(0)" ::: "memory");
#pragma unroll
            for (int r = 0; r < 16; ++r) { const int row = crow(r, hi); const float rl = wsf[row]; const int d = wsd[row];
                if (d >= 0) { PO[(size_t)d * 64 + r32] = (bf16)f2bf(o[0][r] * rl); PO[(size_t)d * 64 + 32 + r32] = (bf16)f2bf(o[1][r] * rl); } }
            asm volatile("s_waitcnt lgkmcnt(0)" ::: "memory");
        }
    }
}
__device__ __forceinline__ void moba_combine_phase(Frame& F, const unsigned* SELT, const bf16* PO, const float* ML, bf16* O) {
    for (int m = F.gw; m < M; m += F.NGW) {
        const int b = m / T, t = m % T, h = F.lane >> 2, qd = F.lane & 3;
        const unsigned sel = SELT[((size_t)b * H + h) * T + t]; const int cnt = __popc(sel);
        const size_t base = ((size_t)m * H + h) * 4;
        float ms[4], ls[4]; float mstar = -INFINITY;
#pragma unroll
        for (int s = 0; s < 4; ++s) { const bool on = (s == 3) || (s < cnt); ms[s] = on ? ML[(base + s) * 2] : -INFINITY; ls[s] = on ? ML[(base + s) * 2 + 1] : 0.f; mstar = fmaxf(mstar, ms[s]); }
        float wsum = 0.f, w[4];
#pragma unroll
        for (int s = 0; s < 4; ++s) { w[s] = ls[s] * __builtin_amdgcn_exp2f(ms[s] - mstar); wsum += w[s]; }
        const float rw = 1.0f / wsum;
        float acc[16];
#pragma unroll
        for (int i = 0; i < 16; ++i) acc[i] = 0.f;
#pragma unroll
        for (int s = 0; s < 4; ++s) { const bool on = (s == 3) || (s < cnt);
            if (on) { const float ws_ = w[s] * rw; const v4u a = *(const v4u*)(PO + (base + s) * 64 + qd * 16), c = *(const v4u*)(PO + (base + s) * 64 + qd * 16 + 8);
                const unsigned wv[8] = {a.x, a.y, a.z, a.w, c.x, c.y, c.z, c.w};
#pragma unroll
                for (int i = 0; i < 8; ++i) { acc[2 * i] += ws_ * __uint_as_float(wv[i] << 16); acc[2 * i + 1] += ws_ * __uint_as_float(wv[i] & 0xffff0000u); } } }
        v4u o0, o1; o0.x = pk2(acc[0], acc[1]); o0.y = pk2(acc[2], acc[3]); o0.z = pk2(acc[4], acc[5]); o0.w = pk2(acc[6], acc[7]); o1.x = pk2(acc[8], acc[9]); o1.y = pk2(acc[10], acc[11]); o1.z = pk2(acc[12], acc[13]); o1.w = pk2(acc[14], acc[15]);
        *(v4u*)(O + (size_t)m * D + h * 64 + qd * 16) = o0; *(v4u*)(O + (size_t)m * D + h * 64 + qd * 16 + 8) = o1;
    }
}
constexpr int WK_REC = 10496;
__device__ __forceinline__ void wkv_build_phase(Frame& F, const bf16* R, const float* DEC, const bf16* KP, const bf16* AP, const bf16* BP, unsigned char* REC0, unsigned char* REC1) {
    LAS unsigned char* L = F.lds + RING_OFF + F.wave * 16384;
    LAS unsigned short* tA = (LAS unsigned short*)L; LAS unsigned short* tB = tA + 1024; LAS unsigned short* tK = tA + 2048; LAS unsigned short* tR = tA + 3072;
    LAS float* fLab = (LAS float*)(L + 8192); LAS float* fLak = fLab + 256; LAS float* fT = fLab + 512;
    const int lane = F.lane, c = lane & 15, g = lane >> 4;
    float rw[16]; unsigned short rk[16], ra[16], rb[16], rr_[16];
#define WB_LOAD(u_) do { const int ch_ = (u_) & 511, bh_ = (u_) >> 9; const size_t base_ = ((size_t)(bh_ >> 4) * T + (size_t)ch_ * 16) * D + (bh_ & 15) * 64 + lane; \
        _Pragma("unroll") for (int t = 0; t < 16; ++t) { const size_t o = base_ + (size_t)t * D; rw[t] = DEC[o]; rk[t] = KP[o]; ra[t] = AP[o]; rb[t] = BP[o]; rr_[t] = R[o]; } } while (0)
    if (F.gw < 2 * H * 512) WB_LOAD(F.gw);
    for (int u = F.gw; u < 2 * H * 512; u += F.NGW) {
        const int ch = u & 511, bh = u >> 9, b = bh >> 4, h = bh & 15;
        unsigned char* rec = (b ? REC1 : REC0) + ((size_t)h * 512 + ch) * WK_REC;
        float Af[16], Bf[16], Kf[16], Rf[16]; float gm = 1.f;
#pragma unroll
        for (int t = 0; t < 16; ++t) {
            const float w = rw[t], kp = bf2f(rk[t]), ap = bf2f(ra[t]), bp = bf2f(rb[t]), rr = bf2f(rr_[t]);
            Af[t] = ap * gm; gm *= w; const float inv = __builtin_amdgcn_rcpf(gm); Bf[t] = bp * inv; Kf[t] = kp * inv; Rf[t] = rr * gm;
            tA[t * 64 + lane] = (unsigned short)f2bf(Af[t]); tB[t * 64 + lane] = (unsigned short)f2bf(Bf[t]); tK[t * 64 + lane] = (unsigned short)f2bf(Kf[t]); tR[t * 64 + lane] = (unsigned short)f2bf(Rf[t]); }
        if (u + F.NGW < 2 * H * 512) WB_LOAD(u + F.NGW);
        *(float*)(rec + 10240 + lane * 4) = gm;
#pragma unroll
        for (int gq = 0; gq < 4; ++gq) { v4u o; o.x = pk2(Bf[4 * gq], Bf[4 * gq + 1]); o.y = pk2(Bf[4 * gq + 2], Bf[4 * gq + 3]); o.z = pk2(Kf[4 * gq], Kf[4 * gq + 1]); o.w = pk2(Kf[4 * gq + 2], Kf[4 * gq + 3]);
            *(v4u*)(rec + 6144 + lane * 64 + gq * 16) = o; }
        LDS_WAIT(); asm volatile("" ::: "memory");
        pg8::f32x4 lab = {0.f, 0.f, 0.f, 0.f}, lak = lab, mrb = lab, mrk = lab;
#pragma unroll
        for (int s = 0; s < 2; ++s) { const int o = c * 64 + 8 * g + 32 * s;
            const bf16x8 fa = *(const LAS bf16x8*)(tA + o), fb = *(const LAS bf16x8*)(tB + o), fk = *(const LAS bf16x8*)(tK + o), fr = *(const LAS bf16x8*)(tR + o);
            lab = __builtin_amdgcn_mfma_f32_16x16x32_bf16(fa, fb, lab, 0, 0, 0); lak = __builtin_amdgcn_mfma_f32_16x16x32_bf16(fa, fk, lak, 0, 0, 0);
            mrb = __builtin_amdgcn_mfma_f32_16x16x32_bf16(fr, fb, mrb, 0, 0, 0); mrk = __builtin_amdgcn_mfma_f32_16x16x32_bf16(fr, fk, mrk, 0, 0, 0); }
#pragma unroll
        for (int r = 0; r < 4; ++r) { const int t = 4 * g + r; if (!(c < t)) { lab[r] = 0.f; lak[r] = 0.f; } if (!(c <= t)) { mrb[r] = 0.f; mrk[r] = 0.f; }
            fLab[t * 16 + c] = lab[r]; fLak[t * 16 + c] = lak[r]; }
        LDS_WAIT(); asm volatile("" ::: "memory");
        float Tc[16];
#pragma unroll
        for (int i = 0; i < 16; ++i) { float a_ = (i == c) ? 1.f : 0.f;
#pragma unroll
            for (int j = 0; j < i; ++j) a_ += fLab[i * 16 + j] * Tc[j];
            Tc[i] = a_; }
        if (g == 0) {
#pragma unroll
            for (int i = 0; i < 16; ++i) fT[i * 16 + c] = Tc[i]; }
        LDS_WAIT(); asm volatile("" ::: "memory");
        { const int kt = lane >> 4, gq = (lane >> 2) & 3, jj = lane & 3, slot = (kt >> 1) * 1024 + gq * 16 + (jj + 4 * (kt & 1)) * 2;
#pragma unroll
          for (int t = 0; t < 16; ++t) { float w_ = 0.f;
#pragma unroll
              for (int j = 0; j <= t; ++j) w_ += fT[t * 16 + j] * Af[j];
              *(unsigned short*)(rec + slot + t * 64) = (unsigned short)f2bf(w_); *(unsigned short*)(rec + 3072 + slot + t * 64) = (unsigned short)f2bf(Rf[t]); } }
        { const int gq = c >> 2, jq = c & 3;
#pragma unroll
          for (int r = 0; r < 4; ++r) { const int t = 4 * g + r; float tl = 0.f;
#pragma unroll
              for (int j = 0; j < 16; ++j) tl += fT[t * 16 + j] * fLak[j * 16 + c];
              unsigned char* p = rec + 2048 + t * 64 + gq * 16;
              *(unsigned short*)(p + jq * 2) = (unsigned short)f2bf(tl); *(unsigned short*)(p + 8 + jq * 2) = 0;
              *(unsigned short*)(p + 3072 + jq * 2) = (unsigned short)f2bf(mrb[r]); *(unsigned short*)(p + 3072 + 8 + jq * 2) = (unsigned short)f2bf(mrk[r]); } }
        LDS_WAIT(); asm volatile("" ::: "memory");
    }
#undef WB_LOAD
}
__device__ __forceinline__ void wkv_chain_phase(Frame& F, const unsigned char* REC0, const unsigned char* REC1, const bf16* VP, bf16* Y) {
    if (F.vcu >= 32) return;
    constexpr int GC = 4, GB = GC * WK_REC  , VBOFF = GB, BUFB = GB + 8192  , YB_OFF = 2 * BUFB, NG = 512 / GC;
    const int b = F.vcu >> 4, h = F.vcu & 15, lane = F.lane, c = lane & 15, g = lane >> 4, vt = F.wave;
    const unsigned char* rbase = (b ? REC1 : REC0) + (size_t)h * 512 * WK_REC; const size_t rowb = (size_t)b * T;
    LAS unsigned char* L = F.lds + RING_OFF;
    constexpr int NP = (GB / 16 + 511) / 512;
    struct Stg { v4u p[NP]; v4u v; };
    Stg g0, g1;
#define WK_LOAD(gi, G) do { const unsigned char* s_ = rbase + (size_t)(gi) * GB; _Pragma("unroll") for (int i = 0; i < NP; ++i) { const int o_ = (F.tid + i * 512) * 16; if (o_ < GB) G.p[i] = *(const v4u*)(s_ + o_); } \
        G.v = *(const v4u*)(VP + (rowb + (size_t)(gi) * 64 + (F.tid >> 3)) * D + h * 64 + (F.tid & 7) * 8); } while (0)
#define WK_STORE(bf, G) do { _Pragma("unroll") for (int i = 0; i < NP; ++i) { const int o_ = (F.tid + i * 512) * 16; if (o_ < GB) *(LAS v4u*)(L + (bf) * BUFB + o_) = G.p[i]; } \
        { const int t_ = F.tid >> 3, v0_ = (F.tid & 7) * 8; LAS unsigned short* d_ = (LAS unsigned short*)(L + (bf) * BUFB + VBOFF) + ((((t_ >> 4) * 4) * 4 + ((t_ >> 2) & 3)) * 16) * 4 + (t_ & 3); \
          const unsigned w_[4] = {G.v.x, G.v.y, G.v.z, G.v.w}; \
          _Pragma("unroll") for (int e = 0; e < 8; ++e) { const int v_ = v0_ + e; d_[((v_ >> 4) * 64 + (v_ & 15)) * 4] = (unsigned short)((e & 1) ? (w_[e >> 1] >> 16) : (w_[e >> 1] & 0xffffu)); } } } while (0)
    WK_LOAD(0, g0); WK_STORE(0, g0); WK_LOAD(1, g0); __syncthreads();
    pg8::f32x4 Hs[4]; Hs[0] = (pg8::f32x4){0.f, 0.f, 0.f, 0.f}; Hs[1] = Hs[0]; Hs[2] = Hs[0]; Hs[3] = Hs[0];
    for (int g2 = 0; g2 < NG; g2 += 2) {
#pragma unroll
      for (int par = 0; par < 2; ++par) {
        const int gi = g2 + par, bf = par;
        if (gi + 2 < NG) { if (par == 0) WK_LOAD(gi + 2, g1); else WK_LOAD(gi + 2, g0); }
        if (F.wave < 4) {
            struct Ops { bf16x8 au0, au1, au2, ay0, ay1, ay2, bk0, bk1, bk2, bk3; pg8::f32x4 ga0, ga1, ga2, ga3; u32x2 vb; };
            const int ao = (c * 32 + g * 8) * 2;
#define WK_FETCH(ci_, X) do { const LAS unsigned char* rec_ = L + bf * BUFB + (ci_) * WK_REC; \
                X.au0 = *(const LAS bf16x8*)(rec_ + ao); X.au1 = *(const LAS bf16x8*)(rec_ + 1024 + ao); X.au2 = *(const LAS bf16x8*)(rec_ + 2048 + ao); \
                X.ay0 = *(const LAS bf16x8*)(rec_ + 3072 + ao); X.ay1 = *(const LAS bf16x8*)(rec_ + 4096 + ao); X.ay2 = *(const LAS bf16x8*)(rec_ + 5120 + ao); \
                X.bk0 = *(const LAS bf16x8*)(rec_ + 6144 + ao); X.bk1 = *(const LAS bf16x8*)(rec_ + 7168 + ao); X.bk2 = *(const LAS bf16x8*)(rec_ + 8192 + ao); X.bk3 = *(const LAS bf16x8*)(rec_ + 9216 + ao); \
                X.ga0 = *(const LAS pg8::f32x4*)(rec_ + 10240 + (4 * g) * 4); X.ga1 = *(const LAS pg8::f32x4*)(rec_ + 10240 + (16 + 4 * g) * 4); X.ga2 = *(const LAS pg8::f32x4*)(rec_ + 10240 + (32 + 4 * g) * 4); X.ga3 = *(const LAS pg8::f32x4*)(rec_ + 10240 + (48 + 4 * g) * 4); \
                X.vb = *(const LAS u32x2*)(L + bf * BUFB + VBOFF + (((((ci_) * 4 + vt) * 4 + g) * 16 + c) * 8)); } while (0)
            Ops cu; WK_FETCH(0, cu);
#pragma unroll
            for (int ci = 0; ci < GC; ++ci) {
                Ops nx = cu;
                if (ci + 1 < GC) WK_FETCH(ci + 1, nx);
                v4u h0, h1; h0.x = attn_body::cvtpk_s(Hs[0][0], Hs[0][1]); h0.y = attn_body::cvtpk_s(Hs[0][2], Hs[0][3]); h0.z = attn_body::cvtpk_s(Hs[1][0], Hs[1][1]); h0.w = attn_body::cvtpk_s(Hs[1][2], Hs[1][3]);
                h1.x = attn_body::cvtpk_s(Hs[2][0], Hs[2][1]); h1.y = attn_body::cvtpk_s(Hs[2][2], Hs[2][3]); h1.z = attn_body::cvtpk_s(Hs[3][0], Hs[3][1]); h1.w = attn_body::cvtpk_s(Hs[3][2], Hs[3][3]);
                const bf16x8 hb0 = __builtin_bit_cast(bf16x8, h0), hb1 = __builtin_bit_cast(bf16x8, h1);
                v4u vz; vz.x = cu.vb.x; vz.y = cu.vb.y; vz.z = 0u; vz.w = 0u;
                const pg8::f32x4 z4 = {0.f, 0.f, 0.f, 0.f};
                const pg8::f32x4 ua = __builtin_amdgcn_mfma_f32_16x16x32_bf16(cu.au0, hb0, z4, 0, 0, 0), ub_ = __builtin_amdgcn_mfma_f32_16x16x32_bf16(cu.au1, hb1, z4, 0, 0, 0),
                                 uc = __builtin_amdgcn_mfma_f32_16x16x32_bf16(cu.au2, __builtin_bit_cast(bf16x8, vz), z4, 0, 0, 0);
                pg8::f32x4 yt = __builtin_amdgcn_mfma_f32_16x16x32_bf16(cu.ay0, hb0, z4, 0, 0, 0);
                yt = __builtin_amdgcn_mfma_f32_16x16x32_bf16(cu.ay1, hb1, yt, 0, 0, 0);
                const pg8::f32x4 ut = (ua + ub_) + uc;
                v4u ubw; ubw.x = attn_body::cvtpk_s(ut[0], ut[1]); ubw.y = attn_body::cvtpk_s(ut[2], ut[3]); ubw.z = cu.vb.x; ubw.w = cu.vb.y;
                const bf16x8 ub = __builtin_bit_cast(bf16x8, ubw);
                Hs[0] = __builtin_amdgcn_mfma_f32_16x16x32_bf16(cu.bk0, ub, Hs[0], 0, 0, 0); Hs[1] = __builtin_amdgcn_mfma_f32_16x16x32_bf16(cu.bk1, ub, Hs[1], 0, 0, 0);
                Hs[2] = __builtin_amdgcn_mfma_f32_16x16x32_bf16(cu.bk2, ub, Hs[2], 0, 0, 0); Hs[3] = __builtin_amdgcn_mfma_f32_16x16x32_bf16(cu.bk3, ub, Hs[3], 0, 0, 0);
                yt = __builtin_amdgcn_mfma_f32_16x16x32_bf16(cu.ay2, ub, yt, 0, 0, 0);
                Hs[0] = Hs[0] * cu.ga0; Hs[1] = Hs[1] * cu.ga1; Hs[2] = Hs[2] * cu.ga2; Hs[3] = Hs[3] * cu.ga3;
                LAS unsigned short* yb = (LAS unsigned short*)(L + YB_OFF + bf * 8192) + (ci * 16 + 4 * g) * 64 + vt * 16 + c;
#pragma unroll
                for (int r = 0; r < 4; ++r) yb[r * 64] = (unsigned short)f2bf(yt[r]);
                cu = nx;
            }
#undef WK_FETCH
        }
        if (gi + 1 < NG) { if (par == 0) WK_STORE(1, g0); else WK_STORE(0, g1); }
        __syncthreads();
        { const v4u yv = *(const LAS v4u*)(L + YB_OFF + bf * 8192 + F.tid * 16);
          *(v4u*)(Y + (rowb + (size_t)gi * 64 + (F.tid >> 3)) * D + h * 64 + (F.tid & 7) * 8) = yv; }
      }
    }
#undef WK_LOAD
#undef WK_STORE
}


#ifdef DBG_CUT
__device__ __forceinline__ void dbg_copy(Frame& F, const void* src, bool is_bf16, float* out) {
    for (size_t i = (size_t)F.gw * 64 + F.lane; i < (size_t)M * D; i += (size_t)F.NGW * 64) out[i] = is_bf16 ? bf2f(((const bf16*)src)[i]) : ((const float*)src)[i];
}
#ifndef DBG_LAYER
#define DBG_LAYER -1
#endif
#ifndef DBG_SCALE
#define DBG_SCALE 100.f
#define DBG_SUB 1.f
#endif
#define CUT(k, off, isbf) if (DBG_CUT == (k) && (DBG_LAYER < 0 || layer == DBG_LAYER)) { unsigned char* ws = WSB(); dbg_copy(F, ws + (off), (isbf), GOUT()); return; }
#else
#define CUT(k, off, isbf)
#endif
#ifndef REP_GEMM
#define REP_GEMM 1
#endif
#ifndef REP_THIN
#define REP_THIN 1
#endif
#ifndef REP_CONV
#define REP_CONV REP_THIN
#endif
#ifndef REP_LN
#define REP_LN REP_THIN
#endif
#ifndef REP_RW
#define REP_RW REP_THIN
#endif
#ifndef REP_ATTN
#define REP_ATTN 1
#endif
#ifndef REP_SCAN
#define REP_SCAN 1
#endif
#ifndef REP_WKB
#define REP_WKB 1
#endif
#ifndef REP_WKC
#define REP_WKC 1
#endif
#ifndef REP_BAR
#define REP_BAR 1
#endif
#define GEMM_BIG(EpiT, SchedT) for (int rg_ = 0; rg_ < REP_GEMM; ++rg_) pg8::gemm_phase<EpiT, SchedT, true, true>
#define GEMM_ONE(EpiT, SchedT) for (int rg_ = 0; rg_ < REP_GEMM; ++rg_) pg8::gemm_phase<EpiT, SchedT, false, true>
__global__ void __launch_bounds__(NWAVES * 64, 2) fwd_kernel(Args args) {
    extern __shared__ __attribute__((aligned(16))) unsigned char lds[];
    Frame F;
    F.lds = (LAS unsigned char*)lds; F.MISC = (volatile LAS unsigned*)(F.lds + MISC_OFF);
    F.wave = __builtin_amdgcn_readfirstlane((int)threadIdx.x >> 6); F.lane = fresh_lane(); F.tid = F.wave * 64 + F.lane;
    F.G = gridDim.x; { const int bx = blockIdx.x; F.vcu = (F.G % 8 == 0) ? (bx % 8) * (F.G / 8) + bx / 8 : bx; }
    F.gw = F.vcu * NWAVES + F.wave; F.NGW = F.G * NWAVES;
    F.ws = args.ws; F.ctl = (gu32*)(args.ws + WS_CTL);
#ifdef DBG_LDSZERO
    for (int u = F.tid; u < LDS_BYTES / 4; u += NWAVES * 64) ((LAS unsigned*)(F.lds))[u] = 0u;
#else
    for (int u = F.tid; u < (LDS_BYTES - LDSCTL_OFF) / 4; u += NWAVES * 64) ((LAS unsigned*)(F.lds + LDSCTL_OFF))[u] = 0u;
#endif
    __syncthreads();
    XcdBarrier bar = xcd_barrier_post((unsigned*)(F.ctl + CW_BAR), F.MISC + 8, F.tid == 0);
#define GRID_BAR() do { { GAS unsigned* b_ = (GAS unsigned*)bar.bar; asm volatile("" : "+s"(b_), "+s"(bar.x)); bar.bar = (unsigned*)b_; } for (int rb_ = 0; rb_ < REP_BAR; ++rb_) xcd_barrier(bar, F.wave == 0 && fresh_lane() == 0); } while (0)
#define WSB() ({ F.lane = fresh_lane(); F.tid = F.wave * 64 + F.lane; asm volatile("" : "+s"(F.G), "+s"(F.wave), "+s"(F.vcu), "+s"(F.gw), "+s"(F.NGW), "+s"(bx)); GAS unsigned char* p_ = (GAS unsigned char*)args.ws; asm volatile("" : "+s"(p_)); (unsigned char*)p_; })
#define GOUT() ({ GAS float* o_ = (GAS float*)args.out; asm volatile("" : "+s"(o_)); (float*)o_; })
#define INP(i) ({ const __attribute__((address_space(4))) char* k_ = (const __attribute__((address_space(4))) char*)__builtin_amdgcn_kernarg_segment_ptr(); asm volatile("" : "+s"(k_)); const GAS float* g_ = (const GAS float*)(*(const float* const __attribute__((address_space(4)))*)(k_ + 8 * (i))); asm volatile("" : "+s"(g_)); (const float*)g_; })
    LAS unsigned char* ring = F.lds + RING_OFF;
    int bx = (int)blockIdx.x;

    for (int rt_ = 0; rt_ < REP_CONV; ++rt_) conv_rwkv(F, 0); for (int rt_ = 0; rt_ < REP_CONV; ++rt_) conv_dense(F, 0);
    { unsigned char* ws = WSB(); for (int rt_ = 0; rt_ < REP_RW; ++rt_) mix_phase(F, INP(I_X), INP(I_MU), (bf16*)(ws + RS_XM)); }
    GRID_BAR();

#ifndef LAYER_LO
#define LAYER_LO 0
#define LAYER_HI 4
#endif
    for (int layer = LAYER_LO; layer < LAYER_HI; ++layer) {
        const bool moe = (layer & 1) != 0; const int fe = layer >> 1;
        if (layer < 2) {
            const int l = layer;
            if (l > 0) { { unsigned char* ws = WSB(); for (int rt_ = 0; rt_ < REP_RW; ++rt_) mix_phase(F, (const float*)(ws + WS_H), INP(I_MU) + (size_t)l * 6 * D, (bf16*)(ws + RS_XM)); }
              GRID_BAR(); }
            { unsigned char* ws = WSB(); pg8::Gemm g{D, D, D}; pg8::SchedStd S; S.init(M, 4096, F.G, bx, ws + RS_XM, D, ws + WM_BT1 + (size_t)l * RW_LSTRIDE, D, 1, (size_t)M * D * 2);
              pg8::EpiRkv E{(bf16*)(ws + RS_RKV), (long)RS_LH - (long)RS_RKV, (size_t)M * D};
              GEMM_BIG(pg8::EpiRkv, pg8::SchedStd)(ring, g, S, E, F.wave); }
            GRID_BAR();
            CUT(1, RS_RKV, true)
            { unsigned char* ws = WSB(); pg8::Gemm g{256, D, 256}; pg8::SchedStd S; S.init(M, 4096, F.G, bx, ws + RS_LH, D, ws + WM_BT2 + (size_t)l * RW_LSTRIDE, 256, 2, 0);
              pg8::EpiLoraUpAll E{{(void*)(ws + RS_DEC), INP(I_W0) + (size_t)l * D}, {(void*)(ws + RS_AB), INP(I_A0) + (size_t)l * D}, {(void*)(ws + RS_VG), INP(I_V0)}, {(void*)(ws + RS_GG), nullptr}};
              GEMM_BIG(pg8::EpiLoraUpAll, pg8::SchedStd)(ring, g, S, E, F.wave); }
            GRID_BAR();
            CUT(2, RS_DEC, false) CUT(60, RS_VG, true) CUT(61, RS_GG, true) CUT(62, RS_LH, true) CUT(63, RS_AB, false)
            { unsigned char* ws = WSB(); for (int rt_ = 0; rt_ < REP_RW; ++rt_) prep_phase(F, l, (bf16*)(ws + RS_RKV), (const float*)(ws + RS_AB), (bf16*)(ws + RS_LH), INP(I_V0), INP(I_V2), (bf16*)(ws + WS_VFIRST), INP(I_KK) + (size_t)l * D, INP(I_KA) + (size_t)l * D,
                                                   (bf16*)(ws + RS_KP), (bf16*)(ws + RS_AP), (bf16*)(ws + RS_BP), (bf16*)(ws + RS_VP)); }
            GRID_BAR();
            CUT(3, RS_KP, true) CUT(7, RS_VP, true) CUT(8, RS_BP, true) CUT(9, RS_DEC, false)
#ifdef WKV_SEQ
            for (int rep_ = 0; rep_ < REP_SCAN; ++rep_) {
              { unsigned char* ws = WSB(); scan_phase(F, (bf16*)(ws + RS_RKV), (float*)(ws + RS_DEC), (bf16*)(ws + RS_KP), (bf16*)(ws + RS_AP), (bf16*)(ws + RS_BP), (bf16*)(ws + RS_VP), (bf16*)(ws + WS_Y)); }
              if (rep_ + 1 < REP_SCAN) GRID_BAR(); }
            GRID_BAR();
#else
            { unsigned char* ws = WSB(); for (int rq_ = 0; rq_ < REP_WKB; ++rq_) wkv_build_phase(F, (bf16*)(ws + RS_RKV), (float*)(ws + RS_DEC), (bf16*)(ws + RS_KP), (bf16*)(ws + RS_AP), (bf16*)(ws + RS_BP), ws + RS_REC0, ws + RS_REC1); }
            GRID_BAR();
#ifdef DBG_CUT
            if (DBG_CUT == 39 && (DBG_LAYER < 0 || layer == DBG_LAYER)) { unsigned char* ws = WSB(); const unsigned short* s_ = (const unsigned short*)(ws + RS_REC0); float* o_ = GOUT();
                for (size_t i = (size_t)F.gw * 64 + F.lane; i < (size_t)M * D; i += (size_t)F.NGW * 64) o_[i] = (float)s_[i]; return; }
#endif
            { unsigned char* ws = WSB(); for (int rq_ = 0; rq_ < REP_WKC; ++rq_) wkv_chain_phase(F, ws + RS_REC0, ws + RS_REC1, (bf16*)(ws + RS_VP), (bf16*)(ws + WS_Y)); }
            if (F.vcu >= 32) {
                const int gw_ = F.gw, ngw_ = F.NGW; F.gw = (F.vcu - 32) * NWAVES + F.wave; F.NGW = (F.G - 32) * NWAVES;
                for (int rt_ = 0; rt_ < REP_CONV; ++rt_) { if (l == 0) { conv_rwkv(F, 1); conv_moe(F, 0); } else { conv_moe(F, 1); conv_dense(F, 1); conv_moba(F, 0); conv_moba(F, 1); } }
                F.gw = gw_; F.NGW = ngw_; }
            GRID_BAR();
#endif
            CUT(4, WS_Y, true)
#ifdef DBG_CUT
            if (DBG_CUT == 38 && (DBG_LAYER < 0 || layer == DBG_LAYER)) {
                { unsigned char* ws = WSB(); scan_phase(F, (bf16*)(ws + RS_RKV), (float*)(ws + RS_DEC), (bf16*)(ws + RS_KP), (bf16*)(ws + RS_AP), (bf16*)(ws + RS_BP), (bf16*)(ws + RS_VP), (bf16*)(ws + WS_SCR + 128 * MiB)); }
                GRID_BAR();
                { unsigned char* ws = WSB(); const bf16* a_ = (const bf16*)(ws + WS_Y); const bf16* b_ = (const bf16*)(ws + WS_SCR + 128 * MiB); float* o_ = GOUT();
                  for (size_t i = (size_t)F.gw * 64 + F.lane; i < (size_t)M * D; i += (size_t)F.NGW * 64) { float d_ = DBG_SCALE * (bf2f(a_[i]) - DBG_SUB * bf2f(b_[i])); if (!(fabsf(d_) < 1e30f)) d_ = 1e6f; o_[i] = d_; } }
                return; }
#endif
            { unsigned char* ws = WSB(); for (int rt_ = 0; rt_ < REP_RW; ++rt_) post_phase(F, (bf16*)(ws + WS_Y), (bf16*)(ws + RS_RKV), (bf16*)(ws + RS_KP), (bf16*)(ws + RS_VP), (bf16*)(ws + RS_GG),
                                                   INP(I_RK) + (size_t)l * D, INP(I_GNG) + (size_t)l * D, INP(I_GNB) + (size_t)l * D, (bf16*)(ws + RS_YG)); }
            GRID_BAR();
            CUT(5, RS_YG, true)
            { unsigned char* ws = WSB(); pg8::Gemm g{D, D, D}; pg8::SchedStd S; S.init(M, D, F.G, bx, ws + RS_YG, D, ws + WM_OUT + (size_t)l * RW_LSTRIDE, D);
              pg8::EpiResF32 E{layer == 0 ? INP(I_X) : (const float*)(ws + WS_H), (float*)(ws + RS_PRE), ALPHA};
              GEMM_ONE(pg8::EpiResF32, pg8::SchedStd)(ring, g, S, E, F.wave); }
            GRID_BAR();
            CUT(6, RS_PRE, false)
        } else {
            const int j = layer - 2;
            { unsigned char* ws = WSB(); pg8::Gemm g{D, D, D}; pg8::SchedStd S; S.init(M, j == 0 ? 3 * D : D, F.G, bx, ws + WS_HB, D, ws + (j == 0 ? WM_QKV : WM_Q3), D);
              pg8::EpiQKV E{(bf16*)(ws + BS_Q), ((long)WS_K - (long)BS_Q) / 2, ((long)WS_V - (long)BS_Q) / 2, attn_body::C2};
              GEMM_BIG(pg8::EpiQKV, pg8::SchedStd)(ring, g, S, E, F.wave); }
            GRID_BAR();
            CUT(31, BS_Q, true) CUT(32, WS_K, true) CUT(33, WS_V, true)
            if (j == 0) { unsigned char* ws = WSB(); for (int rt_ = 0; rt_ < REP_THIN; ++rt_) kmean_phase(F, (bf16*)(ws + WS_K), (float*)(ws + WS_KMEAN)); GRID_BAR(); }
#ifndef NO_GATE
            { unsigned char* ws = WSB(); for (int rt_ = 0; rt_ < REP_THIN; ++rt_) gate_phase(F, (bf16*)(ws + BS_Q), (float*)(ws + WS_KMEAN), (unsigned*)(ws + WS_SEL)); }
#endif
            GRID_BAR();
#ifdef DBG_CUT
            if (DBG_CUT == 35) { unsigned char* ws = WSB(); const unsigned* s_ = (const unsigned*)(ws + WS_SEL); for (size_t i = (size_t)F.gw * 64 + F.lane; i < (size_t)M * D; i += (size_t)F.NGW * 64) args.out[i] = (float)(s_[i & (size_t)(M * 16 - 1)] % 65521u); return; }
#endif
#ifdef ATTN_DIRECT
            { unsigned char* ws = WSB(); attn_direct_phase(F, (const bf16*)(ws + BS_Q), (const bf16*)(ws + WS_K), (const bf16*)(ws + WS_V), (const unsigned*)(ws + WS_SEL), (bf16*)(ws + BS_O)); }
            GRID_BAR();
#else
            { unsigned char* ws = WSB(); for (int ra_ = 0; ra_ < REP_ATTN; ++ra_) moba_attn_phase(F, (const bf16*)(ws + BS_Q), (const bf16*)(ws + WS_K), (const bf16*)(ws + WS_V), (const unsigned*)(ws + WS_SEL), (bf16*)(ws + BS_PO), (float*)(ws + BS_ML), F.ctl + CW_QCTR + 64 * (j + 2 * ra_)); }
            GRID_BAR();
            { unsigned char* ws = WSB(); for (int rt_ = 0; rt_ < REP_THIN; ++rt_) moba_combine_phase(F, (const unsigned*)(ws + WS_SEL), (const bf16*)(ws + BS_PO), (const float*)(ws + BS_ML), (bf16*)(ws + BS_O)); }
            GRID_BAR();
#endif
            CUT(36, BS_O, true)
#ifdef DBG_CUT
            if (DBG_CUT == 37 && (DBG_LAYER < 0 || layer == DBG_LAYER)) {
                { unsigned char* ws = WSB(); attn_direct_phase(F, (const bf16*)(ws + BS_Q), (const bf16*)(ws + WS_K), (const bf16*)(ws + WS_V), (const unsigned*)(ws + WS_SEL), (bf16*)(ws + BS_PRE)); }
                GRID_BAR();
                { unsigned char* ws = WSB(); const bf16* a_ = (const bf16*)(ws + BS_O); const bf16* b_ = (const bf16*)(ws + BS_PRE); float* o_ = GOUT();
                  for (size_t i = (size_t)F.gw * 64 + F.lane; i < (size_t)M * D; i += (size_t)F.NGW * 64) o_[i] = 1000.f * (bf2f(a_[i]) - bf2f(b_[i])); }
                return; }
#endif
            { unsigned char* ws = WSB(); pg8::Gemm g{D, D, D}; pg8::SchedStd S; S.init(M, D, F.G, bx, ws + BS_O, D, ws + (j == 0 ? WM_O : WM_O3), D);
              pg8::EpiResF32 E{(const float*)(ws + WS_H), (float*)(ws + BS_PRE), ALPHA};
              GEMM_ONE(pg8::EpiResF32, pg8::SchedStd)(ring, g, S, E, F.wave); }
            GRID_BAR();
        }
        { unsigned char* ws = WSB(); const float* PREm = (const float*)(ws + (layer < 2 ? RS_PRE : BS_PRE));
          const float* g0 = INP(I_LNG) + (size_t)(layer * 2) * D; const float* b0 = INP(I_LNB) + (size_t)(layer * 2) * D;
          if (moe) for (int rt_ = 0; rt_ < REP_LN; ++rt_) ln_phase<0, true>(F, PREm, nullptr, nullptr, nullptr, g0, b0, (float*)(ws + WS_H), (bf16*)(ws + WS_HB), INP(I_ROUTER) + (size_t)fe * D * NE, (int*)(ws + WS_TOKE), (float*)(ws + WS_TOKW), (int*)(ws + WS_BLKCNT));
          else for (int rt_ = 0; rt_ < REP_LN; ++rt_) ln_phase<0, false>(F, PREm, nullptr, nullptr, nullptr, g0, b0, (float*)(ws + WS_H), (bf16*)(ws + WS_HB), nullptr, nullptr, nullptr, nullptr); }
        GRID_BAR();
        CUT(10 + layer, WS_H, false)
        if (!moe) {
            { unsigned char* ws = WSB(); pg8::Gemm g{D, D, D}; pg8::SchedStd S; S.init(M, 2 * FF, F.G, bx, ws + WS_HB, D, ws + WF_GU, D);
              pg8::EpiSwiGLU E{(void*)(ws + FS_HID), FF, 1.0f, 1.0f};
              GEMM_BIG(pg8::EpiSwiGLU, pg8::SchedStd)(ring, g, S, E, F.wave); }
            GRID_BAR();
            { unsigned char* ws = WSB(); pg8::Gemm g{FF, FF, FF}; pg8::SchedStd S; S.init(M, D, F.G, bx, ws + FS_HID, FF, ws + WF_DN, FF);
              pg8::EpiResF32 E{(const float*)(ws + WS_H), (float*)(ws + FS_PRE), ALPHA};
              GEMM_ONE(pg8::EpiResF32, pg8::SchedStd)(ring, g, S, E, F.wave); }
            GRID_BAR();
            { unsigned char* ws = WSB(); const float* g1 = INP(I_LNG) + (size_t)(layer * 2 + 1) * D; const float* b1 = INP(I_LNB) + (size_t)(layer * 2 + 1) * D;
              for (int rt_ = 0; rt_ < REP_LN; ++rt_) ln_phase<0, false>(F, (const float*)(ws + FS_PRE), nullptr, nullptr, nullptr, g1, b1, (float*)(ws + WS_H), (bf16*)(ws + WS_HB), nullptr, nullptr, nullptr, nullptr); }
            GRID_BAR();
        } else {
            { unsigned char* ws = WSB(); for (int rt_ = 0; rt_ < REP_THIN; ++rt_) moe_gather_phase(F, (const int*)(ws + WS_BLKCNT), (const int*)(ws + WS_TOKE), (const float*)(ws + WS_TOKW), (int*)(ws + WS_TOKR), (float*)(ws + WS_GW), (const float*)(ws + WS_H), (unsigned char*)(ws + ES_XG)); }
            GRID_BAR();
            { unsigned char* ws = WSB(); const LAS int* pp = (const LAS int*)(F.lds + MISC_OFF + 64);
              pg8::Gemm g{D / 2, D / 2, D / 2};
              pg8::SchedMoe S{2 * FFE / 256, F.G, bx, pp, (const char*)(ws + ES_XG), (const char*)(ws + WE_GU + (size_t)fe * WE_SET), (size_t)256 * D, (size_t)256 * D, (size_t)2 * FFE * D, 0};
              pg8::EpiSwiGLUT<MOE_DOWN_F8 != 0> E{(void*)(ws + ES_HID), FFE, 1.0f / MOE_WSCALE, MOE_HSCALE};
              for (int rg_ = 0; rg_ < REP_GEMM; ++rg_) pg8::gemm_phase<pg8::EpiSwiGLUT<MOE_DOWN_F8 != 0>, pg8::SchedMoe, true, true, true>(ring, g, S, E, F.wave); }
            GRID_BAR();
            { unsigned char* ws = WSB(); const LAS int* pp = (const LAS int*)(F.lds + MISC_OFF + 64);
#if MOE_DOWN_F8
              { pg8::Gemm g{FFE / 2, FFE / 2, FFE / 2}; pg8::SchedMoe S{D / 256, F.G, bx, pp, (const char*)(ws + ES_HID), (const char*)(ws + WE_DN + (size_t)fe * WE_SET), (size_t)256 * FFE, (size_t)256 * FFE, (size_t)D * FFE, 2 * 256};
                pg8::EpiMoeDown E{(float*)(ws + ES_YP), (const float*)(ws + WS_GW), 1.0f / (MOE_HSCALE * MOE_DSCALE)};
                for (int rg_ = 0; rg_ < REP_GEMM; ++rg_) pg8::gemm_phase<pg8::EpiMoeDown, pg8::SchedMoe, true, true, true>(ring, g, S, E, F.wave); }
              { pg8::Gemm g{256, FFE / 2, FFE / 2}; pg8::SchedMoeTail S{D / 256, F.G, bx, 2 * 256, 7, pp, (const char*)(ws + ES_HID), (const char*)(ws + WE_DN + (size_t)fe * WE_SET), (size_t)256 * FFE, (size_t)256 * FFE, (size_t)D * FFE, (size_t)512};
                pg8::EpiMoeDownSlab E{(float*)(ws + ES_YS), (const float*)(ws + WS_GW), bx, 7, 1.0f / (MOE_HSCALE * MOE_DSCALE)};
                for (int rg_ = 0; rg_ < REP_GEMM; ++rg_) pg8::gemm_phase<pg8::EpiMoeDownSlab, pg8::SchedMoeTail, false, true, true>(ring, g, S, E, F.wave); } }
#else
              { pg8::Gemm g{FFE, FFE, FFE}; pg8::SchedMoe S{D / 256, F.G, bx, pp, (const char*)(ws + ES_HID), (const char*)(ws + WE_DN + (size_t)fe * WE_SET), (size_t)256 * FFE * 2, (size_t)256 * FFE * 2, (size_t)D * FFE * 2, 2 * 256};
                pg8::EpiMoeDown E{(float*)(ws + ES_YP), (const float*)(ws + WS_GW), 1.0f};
                GEMM_BIG(pg8::EpiMoeDown, pg8::SchedMoe)(ring, g, S, E, F.wave); }
              { pg8::Gemm g{512, FFE, FFE}; pg8::SchedMoeTail S{D / 256, F.G, bx, 2 * 256, 7, pp, (const char*)(ws + ES_HID), (const char*)(ws + WE_DN + (size_t)fe * WE_SET), (size_t)256 * FFE * 2, (size_t)256 * FFE * 2, (size_t)D * FFE * 2, (size_t)512 * 2};
                pg8::EpiMoeDownSlab E{(float*)(ws + ES_YS), (const float*)(ws + WS_GW), bx, 7, 1.0f};
                GEMM_ONE(pg8::EpiMoeDownSlab, pg8::SchedMoeTail)(ring, g, S, E, F.wave); } }
#endif
            GRID_BAR();
            { unsigned char* ws = WSB(); const float* g1 = INP(I_LNG) + (size_t)(layer * 2 + 1) * D; const float* b1 = INP(I_LNB) + (size_t)(layer * 2 + 1) * D;
              if (layer == 3) ln_phase<1, false>(F, (const float*)(ws + ES_YS), (const float*)(ws + WS_H), (const float*)(ws + ES_YP), (const int*)(ws + WS_TOKR), g1, b1, GOUT(), nullptr, nullptr, nullptr, nullptr, nullptr);
              else ln_phase<1, false>(F, (const float*)(ws + ES_YS), (const float*)(ws + WS_H), (const float*)(ws + ES_YP), (const int*)(ws + WS_TOKR), g1, b1, (float*)(ws + WS_H), (bf16*)(ws + WS_HB), nullptr, nullptr, nullptr, nullptr); }
            GRID_BAR();
        }
        CUT(20 + layer, WS_H, false)
        CUT(40 + layer, WS_HB, true)
#ifdef DBG_CUT
        if (DBG_CUT == 50 + layer) { unsigned char* ws = WSB(); const bf16* s_ = (const bf16*)(ws + WS_WMIX); float* o_ = GOUT(); for (size_t i = (size_t)F.gw * 64 + F.lane; i < (size_t)M * D; i += (size_t)F.NGW * 64) o_[i] = i < (size_t)6 * 1024 * 1024 ? bf2f(s_[i]) : 0.f; return; }
#endif
    }
}

extern "C" void kernel_launch(void* const* d_in, const int* in_sizes, int n_in, void* d_out, int out_size, void* d_ws, size_t ws_size, hipStream_t stream) {
    static int grid = 0;
    if (grid == 0) {
        if (n_in != 33 || in_sizes[0] != M * D || out_size != M * D || ws_size < WS_END) { fprintf(stderr, "kernel_launch: unexpected problem shape (n_in %d, in0 %d, out %d, ws %zu); nothing launched\n", n_in, n_in > 0 ? in_sizes[0] : -1, out_size, ws_size); grid = -1; return; }
        int dev = 0, cus = 0, per_cu = 0;
        if (hipGetDevice(&dev) != hipSuccess || hipDeviceGetAttribute(&cus, hipDeviceAttributeMultiprocessorCount, dev) != hipSuccess) { grid = -1; return; }
        if (hipFuncSetAttribute((const void*)fwd_kernel, hipFuncAttributeMaxDynamicSharedMemorySize, LDS_BYTES) != hipSuccess) { fprintf(stderr, "kernel_launch: hipFuncSetAttribute failed\n"); grid = -1; return; }
        if (hipOccupancyMaxActiveBlocksPerMultiprocessor(&per_cu, (const void*)fwd_kernel, NWAVES * 64, LDS_BYTES) != hipSuccess || per_cu < 1) { fprintf(stderr, "kernel_launch: occupancy query reports %d workgroups per CU\n", per_cu); }
        (void)hipGetLastError();
        grid = cus;
        if (grid != 256) { fprintf(stderr, "kernel_launch: built for 256 CUs, device has %d; nothing launched\n", cus); grid = -1; return; }
    }
    if (grid < 0) return;
    if (hipMemsetAsync((char*)d_ws + WS_CTL, 0, CTL_ZERO_BYTES, stream) != hipSuccess) return;
#ifdef DBG_FILL
    (void)hipMemsetAsync((char*)d_ws + CTL_ZERO_BYTES, DBG_FILL, WS_END - CTL_ZERO_BYTES, stream);
#endif
    Args a{};
    for (int i = 0; i < 33; ++i) a.in[i] = (const float*)d_in[i];
    a.out = (float*)d_out; a.ws = (unsigned char*)d_ws;
    hipLaunchKernelGGL(fwd_kernel, dim3(grid), dim3(NWAVES * 64), LDS_BYTES, stream, a);
}
```

```cpp
#include <hip/hip_runtime.h>
#include <cstdio>
#include <cstdint>
#include <hip/hip_bf16.h>
#include <cmath>
__device__ __forceinline__ int fresh_lane() { int l; asm volatile("v_mbcnt_lo_u32_b32 %0, -1, 0\n\tv_mbcnt_hi_u32_b32 %0, -1, %0" : "=v"(l)); return l; }
namespace pg8 {
#define PG8_LAS __attribute__((address_space(3)))
typedef unsigned short bf16_t;
typedef short bf16x8 __attribute__((ext_vector_type(8)));
typedef float f32x4 __attribute__((ext_vector_type(4)));
typedef unsigned u32x4 __attribute__((ext_vector_type(4)));
constexpr int BM = 256, BK = 64, HALF = 128, HTB = HALF * BK * 2  , STAGE_BYTES = 8 * HTB, NXCD = 8, WGM = 8;

__host__ __device__ __forceinline__ int lds_byte(int r, int c) { const int st = (r >> 4) * 2 + (c >> 5), rr = r & 15, cc = c & 31, ob = rr * 64 + cc * 2; return st * 1024 + (ob ^ (((ob >> 9) & 1) << 5)); }
__host__ __device__ __forceinline__ void stage_rc(int b, int& R, int& C) { const int st = b / 1024, sb = b % 1024, swz = sb ^ (((sb >> 9) & 1) << 5); R = (st >> 1) * 16 + swz / 64; C = (st & 1) * 32 + (swz % 64) / 2; }
__host__ __device__ __forceinline__ int perm32(int rho) { const int n = rho >> 4, i = rho & 15; return 8 * (i >> 2) + 4 * n + (i & 3); }

struct Unit { int pm, pn, e; };
struct Gemm { int K, lda, ldb; };

__device__ __forceinline__ unsigned cvt_pk_bf16(float lo, float hi) { unsigned r; asm volatile("v_cvt_pk_bf16_f32 %0, %1, %2" : "=v"(r) : "v"(lo), "v"(hi)); return r; }
__device__ __forceinline__ float fsigmoid(float x) { return __builtin_amdgcn_rcpf(1.0f + __expf(-x)); }
__device__ __forceinline__ float ftanh(float x) { return 1.0f - 2.0f * __builtin_amdgcn_rcpf(1.0f + __expf(2.0f * x)); }

struct SchedStd {
    int nM, nN, nwg, G, c, amode; const char* A; const char* B; size_t atile, btile, ag;
    __device__ __forceinline__ void init(int M, int N, int G_, int c_, const void* A_, size_t lda, const void* B_, size_t ldb, int amode_ = 0, size_t ag_ = 0) {
        nM = M / BM; nN = N / BM; nwg = nM * nN; G = G_; c = c_; A = (const char*)A_; B = (const char*)B_; atile = (size_t)BM * lda * 2; btile = (size_t)BM * ldb * 2; amode = amode_; ag = ag_; }
    __device__ __forceinline__ bool next(int i, Unit& u) const {
        const long L = (long)i * G + c; if (L >= nwg) return false;
        int wgid = (int)L; { const int q = nwg / NXCD, r = nwg % NXCD, xcd = wgid % NXCD, off = wgid / NXCD; wgid = (xcd < r ? xcd * (q + 1) : r * (q + 1) + (xcd - r) * q) + off; }
        const int nig = WGM * nN, gid = wgid / nig, fm = gid * WGM, gsz = (nM - fm) < WGM ? (nM - fm) : WGM;
        u.pm = fm + ((wgid % nig) % gsz); u.pn = (wgid % nig) / gsz; u.e = 0;
        if (amode == 2 && u.pn >= 8) u.pn += 4;
        return true;
    }
    __device__ __forceinline__ const char* abase(const Unit& u) const {
        size_t off = (size_t)u.pm * atile;
        if (amode == 1) { const int gs = u.pn < 12 ? (u.pn >> 2) : (u.pn == 12 ? 3 : (u.pn == 13 ? 4 : (u.pn == 14 ? 2 : 5))); off += (size_t)gs * ag; }
        else if (amode == 2) off += (size_t)(u.pn >> 2) * 512;
        return A + off; }
    __device__ __forceinline__ const char* bbase(const Unit& u) const { return B + (size_t)u.pn * btile; }
    __device__ __forceinline__ void a_ready(const Unit&) const {}
    __device__ __forceinline__ void done(const Unit&) const {}
};
struct SchedMoe {
    int nN, G, c; const PG8_LAS int* pp; const char* A; const char* B; size_t atile, btile, bexp; int cap;
    __device__ __forceinline__ bool next(int i, Unit& u) const {
        const int L = i * G + c; int P = pp[8]; if (cap && P * nN > cap) P = cap / nN;
        const int tot = P * nN; if (L >= tot) return false;
        int pm, pn;
        {
            int wgid = L; { const int q = tot / NXCD, r = tot % NXCD, xcd = wgid % NXCD, off = wgid / NXCD; wgid = (xcd < r ? xcd * (q + 1) : r * (q + 1) + (xcd - r) * q) + off; }
            const int nig = WGM * nN, gid = wgid / nig, fm = gid * WGM, gsz = (P - fm) < WGM ? (P - fm) : WGM;
            pm = fm + ((wgid % nig) % gsz); pn = (wgid % nig) / gsz; }
        u.pm = pm; u.pn = pn; int e = 0;
#pragma unroll
        for (int k = 1; k < 8; ++k) e += (pm >= pp[k]) ? 1 : 0;
        u.e = __builtin_amdgcn_readfirstlane(e); return true; }
    __device__ __forceinline__ const char* abase(const Unit& u) const { return A + (size_t)u.pm * atile; }
    __device__ __forceinline__ const char* bbase(const Unit& u) const { return B + (size_t)u.e * bexp + (size_t)u.pn * btile; }
    __device__ __forceinline__ void a_ready(const Unit&) const {}
    __device__ __forceinline__ void done(const Unit&) const {}
};

struct SchedMoeTail {
    int nN, G, c, first, NS; const PG8_LAS int* pp; const char* A; const char* B; size_t atile, btile, bexp, kslice;
    __device__ __forceinline__ bool next(int i, Unit& u) const {
        if (i > 0) return false;
        const int L = first + c / NS, tot = pp[8] * nN; if (L >= tot) return false;
        const int pm = L / nN; u.pm = pm; u.pn = L - pm * nN; int e = 0;
#pragma unroll
        for (int k = 1; k < 8; ++k) e += (pm >= pp[k]) ? 1 : 0;
        u.e = __builtin_amdgcn_readfirstlane(e); return true; }
    __device__ __forceinline__ const char* abase(const Unit& u) const { return A + (size_t)u.pm * atile + (size_t)(c % NS) * kslice; }
    __device__ __forceinline__ const char* bbase(const Unit& u) const { return B + (size_t)u.e * bexp + (size_t)u.pn * btile + (size_t)(c % NS) * kslice; }
    __device__ __forceinline__ void a_ready(const Unit&) const {}
    __device__ __forceinline__ void done(const Unit&) const {}
};
#define PG8_PACK8(w, v0, v1) do { w.x = cvt_pk_bf16(v0[0], v0[1]); w.y = cvt_pk_bf16(v0[2], v0[3]); w.z = cvt_pk_bf16(v1[0], v1[1]); w.w = cvt_pk_bf16(v1[2], v1[3]); } while (0)

struct EpiQKV {
    static constexpr bool PERM = true, AFTER_DRAIN = false;
    bf16_t* O0; long d1, d2; float s0;
    __device__ __forceinline__ void operator()(const f32x4 (&acc)[2][2][4][2], const Unit& u, int wr, int wc, int fr, int fq) const {
        const int t = u.pn >> 2; bf16_t* base = O0 + (long)(t == 1) * d1 + (long)(t == 2) * d2; const float sc = t == 0 ? s0 : 1.0f;
        const int row0 = u.pm * BM + wr * 64 + fr, col0 = (u.pn & 3) * BM + wc * 32 + 8 * fq;
#pragma unroll
        for (int ai = 0; ai < 2; ++ai)
#pragma unroll
            for (int m = 0; m < 4; ++m) { bf16_t* rowp = base + (size_t)(row0 + ai * HALF + m * 16) * 1024 + col0;
#pragma unroll
                for (int bj = 0; bj < 2; ++bj) { const f32x4 v0 = acc[ai][bj][m][0] * sc, v1 = acc[ai][bj][m][1] * sc; u32x4 w; PG8_PACK8(w, v0, v1); *(u32x4*)(rowp + bj * HALF) = w; } }
    }
};
struct EpiRkv {
    static constexpr bool PERM = true, AFTER_DRAIN = false;
    bf16_t* RKV; long dLH; size_t mstride;
    __device__ __forceinline__ void operator()(const f32x4 (&acc)[2][2][4][2], const Unit& u, int wr, int wc, int fr, int fq) const {
        const int pn = u.pn; const bool lora = pn >= 12;
        bf16_t* base = (bf16_t*)((char*)RKV + (lora ? dLH : (long)((size_t)(pn >> 2) * mstride * 2))); const int colt = lora ? (pn - 12) * BM : (pn & 3) * BM;
        const int row0 = u.pm * BM + wr * 64 + fr, col0 = colt + wc * 32 + 8 * fq;
#pragma unroll
        for (int ai = 0; ai < 2; ++ai)
#pragma unroll
            for (int m = 0; m < 4; ++m) { bf16_t* rowp = base + (size_t)(row0 + ai * HALF + m * 16) * 1024 + col0;
#pragma unroll
                for (int bj = 0; bj < 2; ++bj) { f32x4 v0 = acc[ai][bj][m][0], v1 = acc[ai][bj][m][1];
                    if (pn == 12) {
#pragma unroll
                        for (int i = 0; i < 4; ++i) { v0[i] = ftanh(v0[i]); v1[i] = ftanh(v1[i]); } }
                    else if (pn == 15) {
#pragma unroll
                        for (int i = 0; i < 4; ++i) { v0[i] = fsigmoid(v0[i]); v1[i] = fsigmoid(v1[i]); } }
                    u32x4 w; PG8_PACK8(w, v0, v1); *(u32x4*)(rowp + bj * HALF) = w; } }
    }
};
template <int GRP> struct EpiLoraUp {
    static constexpr bool PERM = true, AFTER_DRAIN = false;
    void* O; const float* bias;
    __device__ __forceinline__ void operator()(const f32x4 (&acc)[2][2][4][2], const Unit& u, int wr, int wc, int fr, int fq) const {
        const int row0 = u.pm * BM + wr * 64 + fr, col0 = u.pn * BM + wc * 32 + 8 * fq;
#pragma unroll
        for (int bj = 0; bj < 2; ++bj) {
            f32x4 bv0 = (f32x4){0.f, 0.f, 0.f, 0.f}, bv1 = bv0;
            if (GRP < 3) { bv0 = *(const f32x4*)(bias + col0 + bj * HALF); bv1 = *(const f32x4*)(bias + col0 + bj * HALF + 4); }
#pragma unroll
            for (int ai = 0; ai < 2; ++ai)
#pragma unroll
                for (int m = 0; m < 4; ++m) { const size_t ro = (size_t)(row0 + ai * HALF + m * 16) * 1024 + col0 + bj * HALF;
                    f32x4 v0_ = acc[ai][bj][m][0] + bv0, v1_ = acc[ai][bj][m][1] + bv1;
                    if (GRP == 0) {
#pragma unroll
                        for (int i = 0; i < 4; ++i) { v0_[i] = __expf(-0.6065306597f * fsigmoid(v0_[i])); v1_[i] = __expf(-0.6065306597f * fsigmoid(v1_[i])); }
                    } else if (GRP < 3) {
#pragma unroll
                        for (int i = 0; i < 4; ++i) { v0_[i] = fsigmoid(v0_[i]); v1_[i] = fsigmoid(v1_[i]); }
                    }
                    if (GRP < 2) { *(f32x4*)((float*)O + ro) = v0_; *(f32x4*)((float*)O + ro + 4) = v1_; }
                    else { u32x4 w; PG8_PACK8(w, v0_, v1_); *(u32x4*)((bf16_t*)O + ro) = w; } }
        }
    }
};
struct EpiLoraUpAll {
    static constexpr bool PERM = true, AFTER_DRAIN = false;
    EpiLoraUp<0> e0; EpiLoraUp<1> e1; EpiLoraUp<2> e2; EpiLoraUp<3> e3;
    __device__ __forceinline__ void operator()(const f32x4 (&acc)[2][2][4][2], const Unit& u, int wr, int wc, int fr, int fq) const {
        Unit v = u; v.pn = u.pn & 3; const int g = u.pn >> 2;
        if (g == 0) e0(acc, v, wr, wc, fr, fq); else if (g == 1) e1(acc, v, wr, wc, fr, fq); else if (g == 2) e2(acc, v, wr, wc, fr, fq); else e3(acc, v, wr, wc, fr, fq);
    }
};
struct EpiResF32 {
    static constexpr bool PERM = false, AFTER_DRAIN = false;
    const float* base; float* out; float alpha;
    __device__ __forceinline__ void operator()(const f32x4 (&acc)[2][2][4][2], const Unit& u, int wr, int wc, int fr, int fq) const {
        const int row0 = u.pm * BM + wr * 64 + fr, col0 = u.pn * BM + wc * 32 + 4 * fq;
#pragma unroll
        for (int ai = 0; ai < 2; ++ai)
#pragma unroll
            for (int m = 0; m < 4; ++m) { const size_t ro = (size_t)(row0 + ai * HALF + m * 16) * 1024 + col0;
#pragma unroll
                for (int bj = 0; bj < 2; ++bj)
#pragma unroll
                    for (int n = 0; n < 2; ++n) { const f32x4 b = *(const f32x4*)(base + ro + bj * HALF + n * 16); *(f32x4*)(out + ro + bj * HALF + n * 16) = b * alpha + acc[ai][bj][m][n]; } }
    }
};
template <bool F8OUT> struct EpiSwiGLUT {
    static constexpr bool PERM = true, AFTER_DRAIN = false;
    void* Hd; int ldh; float sc, oscale;
    __device__ __forceinline__ void operator()(const f32x4 (&acc)[2][2][4][2], const Unit& u, int wr, int wc, int fr, int fq) const {
        const int row0 = u.pm * BM + wr * 64 + fr, col0 = u.pn * HALF + wc * 32 + 8 * fq;
#pragma unroll
        for (int ai = 0; ai < 2; ++ai)
#pragma unroll
            for (int m = 0; m < 4; ++m) { const size_t eo = (size_t)(row0 + ai * HALF + m * 16) * ldh + col0;
                f32x4 v0, v1;
#pragma unroll
                for (int i = 0; i < 4; ++i) { const float g0 = acc[ai][0][m][0][i] * sc, g1 = acc[ai][0][m][1][i] * sc;
                    v0[i] = g0 * fsigmoid(g0) * (acc[ai][1][m][0][i] * sc); v1[i] = g1 * fsigmoid(g1) * (acc[ai][1][m][1][i] * sc); }
                if constexpr (F8OUT) { v0 = v0 * oscale; v1 = v1 * oscale; typedef unsigned u32x2_ __attribute__((ext_vector_type(2)));
                    int lo = __builtin_amdgcn_cvt_pk_fp8_f32(v0[0], v0[1], 0, false); lo = __builtin_amdgcn_cvt_pk_fp8_f32(v0[2], v0[3], lo, true);
                    int hi = __builtin_amdgcn_cvt_pk_fp8_f32(v1[0], v1[1], 0, false); hi = __builtin_amdgcn_cvt_pk_fp8_f32(v1[2], v1[3], hi, true);
                    u32x2_ w; w.x = (unsigned)lo; w.y = (unsigned)hi; *(u32x2_*)((unsigned char*)Hd + eo) = w; }
                else { u32x4 w; PG8_PACK8(w, v0, v1); *(u32x4*)((bf16_t*)Hd + eo) = w; } }
    }
};
typedef EpiSwiGLUT<false> EpiSwiGLU;
struct EpiMoeDown {
    static constexpr bool PERM = false, AFTER_DRAIN = false;
    bf16_t* YP; const float* gw; float sc;
    __device__ __forceinline__ void operator()(const f32x4 (&acc)[2][2][4][2], const Unit& u, int wr, int wc, int fr, int fq) const {
        typedef unsigned u32x2_ __attribute__((ext_vector_type(2)));
        const int row0 = u.pm * BM + wr * 64 + fr, col0 = u.pn * BM + wc * 32 + 4 * fq;
#pragma unroll
        for (int ai = 0; ai < 2; ++ai)
#pragma unroll
            for (int m = 0; m < 4; ++m) { const int row = row0 + ai * HALF + m * 16; const float s = gw[row] * sc; const size_t ro = (size_t)row * 1024 + col0;
#pragma unroll
                for (int bj = 0; bj < 2; ++bj)
#pragma unroll
                    for (int n = 0; n < 2; ++n) { const f32x4 v = acc[ai][bj][m][n] * s; u32x2_ w; w.x = cvt_pk_bf16(v[0], v[1]); w.y = cvt_pk_bf16(v[2], v[3]); *(u32x2_*)(YP + ro + bj * HALF + n * 16) = w; } }
    }
};
struct EpiMoeDownSlab {
    static constexpr bool PERM = false, AFTER_DRAIN = false;
    float* YS; const float* gw; int c, NS; float sc;
    __device__ __forceinline__ void operator()(const f32x4 (&acc)[2][2][4][2], const Unit& u, int wr, int wc, int fr, int fq) const {
        const int row0 = u.pm * BM + wr * 64 + fr, col0 = u.pn * BM + wc * 32 + 4 * fq; float* slab = YS + (size_t)(c % NS) * 2048 * 1024;
#pragma unroll
        for (int ai = 0; ai < 2; ++ai)
#pragma unroll
            for (int m = 0; m < 4; ++m) { const int row = row0 + ai * HALF + m * 16; const float s = gw[row] * sc; const size_t ro = (size_t)(row - 32768) * 1024 + col0;
#pragma unroll
                for (int bj = 0; bj < 2; ++bj)
#pragma unroll
                    for (int n = 0; n < 2; ++n) *(f32x4*)(slab + ro + bj * HALF + n * 16) = acc[ai][bj][m][n] * s; }
    }
};
template <class Epi, class Sched, bool ALIGN_EPI = false, bool SP2 = false, bool F8 = false>
__device__ __forceinline__ void gemm_phase(PG8_LAS unsigned char* lds, const Gemm g, const Sched& S, const Epi& E, int wave) {
    const int lane = fresh_lane(), wid = wave, tid = wid * 64 + lane, wr = wid >> 2, wc = wid & 3, fr = lane & 15, fq = lane >> 4;
    const int K = g.K, nt = K / BK;
    unsigned voffA[2], voffB[2];
#pragma unroll
    for (int i = 0; i < 2; ++i) { int R, C; stage_rc(tid * 16 + i * 8192, R, C); const int Rb = Epi::PERM ? ((R & ~31) + perm32(R & 31)) : R;
        voffA[i] = (unsigned)(R * g.lda + C) * 2u; voffB[i] = (unsigned)(Rb * g.ldb + C) * 2u; }
    const size_t kstep = (size_t)(BK * 2);
    const size_t hsA = (size_t)HALF * g.lda * 2, hsB = (size_t)HALF * g.ldb * 2;
    const unsigned ldsw = (unsigned)wid * 1024u;
    const int aoff = lds_byte(wr * 64 + fr, fq * 8), boff = lds_byte(wc * 32 + fr, fq * 8);
#define PG8_SA(b, h) (((b) * 2 + (h)) * HTB)
#define PG8_SB(b, h) ((4 + (b) * 2 + (h)) * HTB)
#define PG8_STAGE(bufoff, gbase, voff) do { _Pragma("unroll") for (int _i = 0; _i < 2; ++_i) \
        __builtin_amdgcn_global_load_lds((const unsigned*)((const char*)(gbase) + (voff)[_i]), (PG8_LAS unsigned*)(lds + (bufoff) + ldsw + _i * 8192), 16, 0, 0); } while (0)
#define PG8_LDA(dst, b, h) do { _Pragma("unroll") for (int m = 0; m < 4; ++m) { const i32x4_ lo_ = *(const PG8_LAS i32x4_*)(lds + PG8_SA(b, h) + aoff + m * 2048), hi_ = *(const PG8_LAS i32x4_*)(lds + PG8_SA(b, h) + aoff + m * 2048 + 1024); \
        if constexpr (F8) dst##8[m] = __builtin_shufflevector(lo_, hi_, 0, 1, 2, 3, 4, 5, 6, 7); else { dst[m][0] = __builtin_bit_cast(bf16x8, lo_); dst[m][1] = __builtin_bit_cast(bf16x8, hi_); } } } while (0)
#define PG8_LDB(dst, b, h) do { _Pragma("unroll") for (int n = 0; n < 2; ++n) { const i32x4_ lo_ = *(const PG8_LAS i32x4_*)(lds + PG8_SB(b, h) + boff + n * 2048), hi_ = *(const PG8_LAS i32x4_*)(lds + PG8_SB(b, h) + boff + n * 2048 + 1024); \
        if constexpr (F8) dst##8[n] = __builtin_shufflevector(lo_, hi_, 0, 1, 2, 3, 4, 5, 6, 7); else { dst[n][0] = __builtin_bit_cast(bf16x8, lo_); dst[n][1] = __builtin_bit_cast(bf16x8, hi_); } } } while (0)
#define PG8_MMA(ai, bj, At, Bt) do { __builtin_amdgcn_s_setprio(1); _Pragma("unroll") for (int m = 0; m < 4; ++m) _Pragma("unroll") for (int n = 0; n < 2; ++n) { \
        if constexpr (F8) asm volatile("v_mfma_scale_f32_16x16x128_f8f6f4 %0, %1, %2, %0, %3, %3 op_sel_hi:[0,0,0]" : "+v"(acc[ai][bj][m][n]) : "v"(Bt##8[n]), "v"(At##8[m]), "v"(f8scale));   \
        else { _Pragma("unroll") for (int k = 0; k < 2; ++k) acc[ai][bj][m][n] = __builtin_amdgcn_mfma_f32_16x16x32_bf16(Bt[n][k], At[m][k], acc[ai][bj][m][n], 0, 0, 0); } } \
        __builtin_amdgcn_s_setprio(0); } while (0)
#define PG8_WAIT_V(n) asm volatile("s_waitcnt vmcnt(" #n ")" ::: "memory")
#define PG8_WAIT_L(n) asm volatile("s_waitcnt lgkmcnt(" #n ")" ::: "memory")
#define PG8_BAR __builtin_amdgcn_s_barrier()
#define PG8_SCHED __builtin_amdgcn_sched_barrier(0)
    Unit cur, nxt; int ui = 0;
    if (!S.next(0, cur)) return;
    f32x4 acc[2][2][4][2];
#pragma unroll
    for (int a = 0; a < 2; ++a)
#pragma unroll
        for (int b = 0; b < 2; ++b)
#pragma unroll
            for (int m = 0; m < 4; ++m)
#pragma unroll
                for (int n = 0; n < 2; ++n) acc[a][b][m][n] = (f32x4){0.f, 0.f, 0.f, 0.f};
    typedef int i32x4_ __attribute__((ext_vector_type(4))); typedef int i32x8_ __attribute__((ext_vector_type(8)));
    int f8scale = 0x7f7f7f7f; asm volatile("" : "+v"(f8scale));
    bf16x8 At[4][2], B0[2][2], B1[2][2]; i32x8_ At8[4], B08[2], B18[2];
    const char* cA = S.abase(cur); const char* cB = S.bbase(cur);
    S.a_ready(cur);
    if constexpr (SP2) {
        PG8_STAGE(PG8_SB(0, 0), cB, voffB); PG8_STAGE(PG8_SB(0, 1), cB + hsB, voffB); PG8_STAGE(PG8_SA(0, 0), cA, voffA); PG8_STAGE(PG8_SA(0, 1), cA + hsA, voffA);
        if (wr == 1) PG8_BAR;
        PG8_WAIT_V(2); PG8_BAR;
        PG8_STAGE(PG8_SB(1, 0), cB + kstep, voffB); PG8_STAGE(PG8_SA(1, 0), cA + kstep, voffA); PG8_STAGE(PG8_SB(1, 1), cB + hsB + kstep, voffB);
        PG8_WAIT_V(6); PG8_BAR;
    } else {
        PG8_STAGE(PG8_SB(0, 0), cB, voffB); PG8_STAGE(PG8_SA(0, 0), cA, voffA); PG8_STAGE(PG8_SB(0, 1), cB + hsB, voffB); PG8_STAGE(PG8_SA(0, 1), cA + hsA, voffA);
        if (wr == 1) PG8_BAR;
        PG8_WAIT_V(4); PG8_BAR;
        PG8_STAGE(PG8_SB(1, 0), cB + kstep, voffB); PG8_STAGE(PG8_SA(1, 0), cA + kstep, voffA); PG8_STAGE(PG8_SB(1, 1), cB + hsB + kstep, voffB);
        PG8_WAIT_V(6); PG8_BAR;
    }
    for (;;) {
        const bool has_next = S.next(ui + 1, nxt);
        const char* nA = has_next ? S.abase(nxt) : cA; const char* nB = has_next ? S.bbase(nxt) : cB;
#pragma nounroll
        for (int t = 0; t < nt; t += 2) {
            const bool last = (t == nt - 2);
            const char* a1 = cA + (size_t)(t + 1) * kstep;
            const char* a2 = last ? nA : cA + (size_t)(t + 2) * kstep; const char* b2 = last ? nB : cB + (size_t)(t + 2) * kstep;
            const char* a3 = a2 + kstep; const char* b3 = b2 + kstep;
            if (last && has_next) S.a_ready(nxt);
            if constexpr (SP2) {
            PG8_LDB(B0, 0, 0); PG8_LDB(B1, 0, 1); PG8_SCHED; PG8_LDA(At, 0, 0); PG8_STAGE(PG8_SA(1, 1), a1 + hsA, voffA);
            PG8_WAIT_V(8); PG8_WAIT_L(0); PG8_BAR; PG8_MMA(0, 0, At, B0); PG8_MMA(0, 1, At, B1); PG8_BAR; PG8_SCHED;
            PG8_LDA(At, 0, 1); PG8_STAGE(PG8_SB(0, 0), b2, voffB); PG8_STAGE(PG8_SB(0, 1), b2 + hsB, voffB); PG8_STAGE(PG8_SA(0, 0), a2, voffA);
            PG8_WAIT_V(8); PG8_WAIT_L(0); PG8_BAR; PG8_MMA(1, 0, At, B0); PG8_MMA(1, 1, At, B1); PG8_BAR; PG8_SCHED;
            PG8_LDB(B0, 1, 0); PG8_LDB(B1, 1, 1); PG8_SCHED; PG8_LDA(At, 1, 0); PG8_STAGE(PG8_SA(0, 1), a2 + hsA, voffA);
            PG8_WAIT_V(8); PG8_WAIT_L(0); PG8_BAR; PG8_MMA(0, 0, At, B0); PG8_MMA(0, 1, At, B1); PG8_BAR; PG8_SCHED;
            PG8_LDA(At, 1, 1); PG8_STAGE(PG8_SB(1, 0), b3, voffB); PG8_STAGE(PG8_SB(1, 1), b3 + hsB, voffB); PG8_STAGE(PG8_SA(1, 0), a3, voffA);
            PG8_WAIT_V(8); PG8_WAIT_L(0); PG8_BAR; PG8_MMA(1, 0, At, B0); PG8_MMA(1, 1, At, B1); PG8_BAR; PG8_SCHED;
            } else {
            PG8_LDB(B0, 0, 0); PG8_SCHED; PG8_LDA(At, 0, 0); PG8_STAGE(PG8_SA(1, 1), a1 + hsA, voffA);
            PG8_WAIT_L(8); PG8_BAR; PG8_WAIT_L(0); PG8_MMA(0, 0, At, B0); PG8_BAR; PG8_SCHED;
            PG8_LDB(B1, 0, 1); PG8_STAGE(PG8_SB(0, 0), b2, voffB);
            PG8_BAR; PG8_WAIT_L(0); PG8_MMA(0, 1, At, B1); PG8_BAR;
            PG8_LDA(At, 0, 1); PG8_STAGE(PG8_SA(0, 0), a2, voffA);
            PG8_BAR; PG8_WAIT_L(0); PG8_MMA(1, 0, At, B0); PG8_BAR; PG8_SCHED;
            PG8_STAGE(PG8_SB(0, 1), b2 + hsB, voffB);
            PG8_WAIT_V(6); PG8_BAR; PG8_MMA(1, 1, At, B1); PG8_BAR;
            PG8_LDB(B0, 1, 0); PG8_SCHED; PG8_LDA(At, 1, 0); PG8_STAGE(PG8_SA(0, 1), a2 + hsA, voffA);
            PG8_WAIT_L(8); PG8_BAR; PG8_WAIT_L(0); PG8_MMA(0, 0, At, B0); PG8_BAR; PG8_SCHED;
            PG8_LDB(B1, 1, 1); PG8_STAGE(PG8_SB(1, 0), b3, voffB);
            PG8_BAR; PG8_WAIT_L(0); PG8_MMA(0, 1, At, B1); PG8_BAR;
            PG8_LDA(At, 1, 1); PG8_STAGE(PG8_SA(1, 0), a3, voffA);
            PG8_BAR; PG8_WAIT_L(0); PG8_MMA(1, 0, At, B0); PG8_BAR; PG8_SCHED;
            PG8_STAGE(PG8_SB(1, 1), b3 + hsB, voffB);
            PG8_WAIT_V(6); PG8_BAR; PG8_MMA(1, 1, At, B1); PG8_BAR;
            }
        }
        if constexpr (ALIGN_EPI) { if (wr == 0) PG8_BAR; }
        if constexpr (!Epi::AFTER_DRAIN) { E(acc, cur, wr, wc, fr, fq); S.done(cur); }
        if (!has_next) break;
#pragma unroll
        for (int a = 0; a < 2; ++a)
#pragma unroll
            for (int b = 0; b < 2; ++b)
#pragma unroll
                for (int m = 0; m < 4; ++m)
#pragma unroll
                    for (int n = 0; n < 2; ++n) acc[a][b][m][n] = (f32x4){0.f, 0.f, 0.f, 0.f};
        cur = nxt; cA = nA; cB = nB; ++ui;
        if constexpr (ALIGN_EPI) { if (wr == 1) PG8_BAR; }
    }
    PG8_WAIT_V(0);
    if constexpr (!ALIGN_EPI) { if (wr == 0) PG8_BAR; }
    PG8_BAR;
    if constexpr (Epi::AFTER_DRAIN) { E.fused(acc, cur, wr, wc, fr, fq, lds, wid, lane); S.done(cur); }
#undef PG8_SA
#undef PG8_SB
#undef PG8_STAGE
#undef PG8_LDA
#undef PG8_LDB
#undef PG8_MMA
#undef PG8_WAIT_V
#undef PG8_WAIT_L
#undef PG8_BAR
#undef PG8_SCHED
}
}

#ifndef MOBA_MASK_ON
#define MOBA_MASK_ON 1
#endif
namespace attn_body {
using bf16=__hip_bfloat16;
using bf16x8=__attribute__((ext_vector_type(8)))short;
using s16x4=__attribute__((ext_vector_type(4)))short;
using f32x16=__attribute__((ext_vector_type(16)))float;
using u32x4=__attribute__((ext_vector_type(4)))unsigned;
constexpr int BATCH=2,NHEAD=16,SEQ=8192,D=64,DM=NHEAD*D;
constexpr int NW=8,QBLK=32,QB=QBLK*NW,KVBLK=64,NQB=SEQ/QB;
constexpr int ATTN_PITCH=DM, ATTN_UNIT_ROWS=QB;
__device__ __forceinline__ int crow(int r,int hi){return (r&3)+8*(r>>2)+4*hi;}
#define SBAR() __builtin_amdgcn_sched_barrier(0)
__device__ __forceinline__ void cmask(f32x16&p0,f32x16&p1,int jb,int qrel,int hi){
  const float NEG=-INFINITY; int d=qrel-(64*jb+4*hi); asm volatile("":"+v"(d));
  #pragma unroll
  for(int r=0;r<16;++r){const int c=(r&3)+8*(r>>2); if(c>d)p0[r]=NEG; if(c+32>d)p1[r]=NEG;}
}

constexpr int NSLOT=3, SLOTB=8192;
constexpr int LDS_K=0, LDS_V=NSLOT*SLOTB, LDS_WS=2*NSLOT*SLOTB, LDS_OST=LDS_WS+NW*64*4, LDS_BYTES=LDS_OST+NW*4096;
constexpr float C2=0.125f*1.4426950408889634f;
__device__ __forceinline__ void glds16(const void*gsrc,unsigned lds_dst){unsigned keep;
  asm volatile("s_mov_b32 %0, m0\n\ts_mov_b32 m0, %2\n\ts_nop 0\n\tglobal_load_lds_dwordx4 %1, off\n\ts_mov_b32 m0, %0":"=&s"(keep):"v"(gsrc),"s"(lds_dst):"memory");}
__device__ __forceinline__ float max3f(float a,float b,float c){float r;asm("v_max3_f32 %0, %1, %2, %3":"=v"(r):"v"(a),"v"(b),"v"(c));return r;}
__device__ __forceinline__ float max2f(float a,float b){float r;asm("v_max_f32_e32 %0, %1, %2":"=v"(r):"v"(a),"v"(b));return r;}
__device__ __forceinline__ float fadd_s(float a,float b){float r;asm("v_add_f32_e32 %0, %1, %2":"=v"(r):"v"(a),"v"(b));return r;}
__device__ __forceinline__ float fsub_s(float a,float b){float r;asm("v_sub_f32_e32 %0, %1, %2":"=v"(r):"v"(a),"v"(b));return r;}
typedef float f32x2_t __attribute__((ext_vector_type(2))); typedef __bf16 bf16x2_t __attribute__((ext_vector_type(2)));
__device__ __forceinline__ unsigned cvtpk_s(float lo,float hi){f32x2_t v={lo,hi};bf16x2_t b=__builtin_convertvector(v,bf16x2_t);return __builtin_bit_cast(unsigned,b);}
#define WAIT_BAR(N) asm volatile("s_waitcnt vmcnt(" #N ") lgkmcnt(0)\n\ts_barrier":::"memory")

__device__ __forceinline__ void qkt(f32x16&p0,f32x16&p1,const char*Kslot,const bf16x8*qr,int r32,int hi){
  const char*kb=Kslot+hi*1024+r32*16;
  #pragma unroll
  for(int d0=0;d0<4;++d0){
    const bf16x8 b0=*reinterpret_cast<const bf16x8*>(kb+d0*2048);
    const bf16x8 b1=*reinterpret_cast<const bf16x8*>(kb+d0*2048+512);
    if(d0==0){p0=__builtin_amdgcn_mfma_f32_32x32x16_bf16(b0,qr[0],f32x16{},0,0,0);p1=__builtin_amdgcn_mfma_f32_32x32x16_bf16(b1,qr[0],f32x16{},0,0,0);}
    else{p0=__builtin_amdgcn_mfma_f32_32x32x16_bf16(b0,qr[d0],p0,0,0,0);p1=__builtin_amdgcn_mfma_f32_32x32x16_bf16(b1,qr[d0],p1,0,0,0);}}
}
typedef __attribute__((address_space(3))) const char* lds_cptr;
typedef short v4i16_t __attribute__((ext_vector_type(4)));
__device__ __forceinline__ void kload8(bf16x8*kf,lds_cptr kp){
  kf[0]=*(const __attribute__((address_space(3))) bf16x8*)(kp);      kf[1]=*(const __attribute__((address_space(3))) bf16x8*)(kp+512);
  kf[2]=*(const __attribute__((address_space(3))) bf16x8*)(kp+2048); kf[3]=*(const __attribute__((address_space(3))) bf16x8*)(kp+2560);
  kf[4]=*(const __attribute__((address_space(3))) bf16x8*)(kp+4096); kf[5]=*(const __attribute__((address_space(3))) bf16x8*)(kp+4608);
  kf[6]=*(const __attribute__((address_space(3))) bf16x8*)(kp+6144); kf[7]=*(const __attribute__((address_space(3))) bf16x8*)(kp+6656);
}
__device__ __forceinline__ void kload2(bf16x8*kf,lds_cptr kp,int j){ kf[2*j]=*(const __attribute__((address_space(3))) bf16x8*)(kp+j*2048); kf[2*j+1]=*(const __attribute__((address_space(3))) bf16x8*)(kp+j*2048+512); }
__device__ __forceinline__ s16x4 vtr(lds_cptr p){ return __builtin_bit_cast(s16x4,__builtin_amdgcn_ds_read_tr16_b64_v4i16((__attribute__((address_space(3))) v4i16_t*)p)); }
__device__ __forceinline__ float rowmax(const f32x16&p0,const f32x16&p1){
  float a=max3f(p0[0],p0[1],p1[0]),b=max3f(p0[2],p0[3],p1[1]);a=max3f(a,p1[2],p1[3]);
  #pragma unroll
  for(int r=4;r<16;r+=4){a=max3f(a,p0[r],p0[r+1]);b=max3f(b,p0[r+2],p0[r+3]);a=max3f(a,p1[r],p1[r+1]);b=max3f(b,p1[r+2],p1[r+3]);}
  const float m=max2f(a,b);
  auto rr=__builtin_amdgcn_permlane32_swap(__float_as_uint(m),__float_as_uint(m),false,false);
  return max2f(__uint_as_float(rr[0]),__uint_as_float(rr[1]));
}
__device__ __forceinline__ void pv(f32x16*o,int vb,bf16x8 pa0,bf16x8 pa1,bf16x8 pa2,bf16x8 pa3){
  #pragma unroll
  for(int d0=0;d0<2;++d0){s16x4 lo[4],hi[4];
    #pragma unroll
    for(int ks=0;ks<4;++ks){
      asm volatile("ds_read_b64_tr_b16 %0,%1 offset:%c2":"=&v"(lo[ks]):"v"(vb),"i"(d0*4096+ks*1024):"memory");
      asm volatile("ds_read_b64_tr_b16 %0,%1 offset:%c2":"=&v"(hi[ks]):"v"(vb),"i"(d0*4096+ks*1024+512):"memory");}
    asm volatile("s_waitcnt lgkmcnt(0)":::"memory");SBAR();
    #define PK(k) (bf16x8){lo[k][0],lo[k][1],lo[k][2],lo[k][3],hi[k][0],hi[k][1],hi[k][2],hi[k][3]}
    o[d0]=__builtin_amdgcn_mfma_f32_32x32x16_bf16(pa0,PK(0),o[d0],0,0,0);
    o[d0]=__builtin_amdgcn_mfma_f32_32x32x16_bf16(pa1,PK(1),o[d0],0,0,0);
    o[d0]=__builtin_amdgcn_mfma_f32_32x32x16_bf16(pa2,PK(2),o[d0],0,0,0);
    o[d0]=__builtin_amdgcn_mfma_f32_32x32x16_bf16(pa3,PK(3),o[d0],0,0,0);
    #undef PK
  }
}

#ifndef ATTN_STORE16
#define ATTN_STORE16(p,v) (*(u32x4*)(p)=(v))
#endif
template<int THRL> __device__ __forceinline__ void attn_unit(int b,int h,int qb,const bf16*Q,const bf16*__restrict__ K,const bf16*__restrict__ V,bf16*O,const unsigned*__restrict__ SEL,char*shm,int wave){
  const int lane=fresh_lane(),wid=wave,tid=wid*64+lane,r32=lane&31,hi=lane>>5; (void)tid;
  const long rowbase=(long)b*SEQ; const int q0=qb*QB;
  const bf16*Qw=Q+(rowbase+q0+wid*QBLK)*DM+h*D;
  const bf16*Kh=K+rowbase*DM+h*D,*Vh=V+rowbase*DM+h*D;
  const unsigned lds0=(unsigned)(uintptr_t)shm;
  float*wsf=(float*)(shm+LDS_WS)+wid*64;
  const bf16*ksrc=Kh+(long)lane*DM+wid*8;
  const bf16*vsrc=Vh+(long)(16*(wid&3)+(lane>>2))*DM+(wid>>2)*32+(lane&3)*8;
  const unsigned kdst=lds0+LDS_K+wid*1024, vdst=lds0+LDS_V+wid*1024;
  #define DMA_K(t,slot) glds16(ksrc+(long)(t)*KVBLK*DM,(unsigned)__builtin_amdgcn_readfirstlane(kdst+(slot)))
  #define DMA_V(t,slot) glds16(vsrc+(long)(t)*KVBLK*DM,(unsigned)__builtin_amdgcn_readfirstlane(vdst+(slot)))
  const int vb0=(int)(lds0+LDS_V)+((lane>>4)&1)*32+(lane&3)*8+(4*hi+((lane&15)>>2))*64;
  const char*Kbase=shm+LDS_K; bf16x8 kf[8];
  const lds_cptr shm3=(lds_cptr)shm; const lds_cptr kp0=shm3+LDS_K+hi*1024+r32*16; const lds_cptr vp0=shm3+LDS_V+((lane>>4)&1)*32+(lane&3)*8+(4*hi+((lane&15)>>2))*64;
  const int NT=(q0+QB)/KVBLK;
  DMA_K(0,0);DMA_V(0,0);DMA_K(1,SLOTB);
  bf16x8 qr[4];
  #pragma unroll
  for(int d0=0;d0<4;++d0)qr[d0]=*reinterpret_cast<const bf16x8*>(&Qw[(long)r32*DM+d0*16+hi*8]);
  float mhat=0.f,l_reg=0.f;f32x16 o[2];o[0]=f32x16{};o[1]=f32x16{};
  const int qrel=wid*QBLK+r32;
  #define SELW() ((volatile __attribute__((address_space(3))) unsigned*)(lds_cptr)((const char*)wsf)+32+r32)
  if(hi==0)*SELW()=SEL[(rowbase+q0+qrel)*NHEAD+h];
  asm volatile("s_waitcnt vmcnt(0) lgkmcnt(0)":::"memory");
  #define CMASK(P0,P1,t) do{int jb_=(t)-(NT-4); if(jb_>=0)cmask(P0,P1,jb_,qrel,hi); else if(MOBA_MASK_ON && !(((*SELW())>>((t)>>2))&1u)){ _Pragma("unroll") for(int r_=0;r_<16;++r_){P0[r_]=-INFINITY;P1[r_]=-INFINITY;} } }while(0)
  bool resc=false;
  #define START(P0,P1) do{ const float rm=rowmax(P0,P1); resc=false; \
    { const float dl=max2f(rm,-100.f); mhat=fadd_s(mhat,dl); \
      _Pragma("unroll") for(int r=0;r<16;++r){P0[r]=fsub_s(P0[r],dl);P1[r]=fsub_s(P1[r],dl);} \
      } \
    _Pragma("unroll") for(int r=0;r<16;++r)P0[r]=__builtin_amdgcn_exp2f(P0[r]); }while(0)
  #define RESC() do{ if(resc){ asm volatile("s_waitcnt lgkmcnt(0)":::"memory"); \
      _Pragma("unroll") for(int d_=0;d_<2;++d_) _Pragma("unroll") for(int r=0;r<16;++r)o[d_][r]*=wsf[crow(r,hi)]; } }while(0)
  f32x16 pA0,pA1,pB0,pB1;
  int sl_prev=0,sl_cur=0,sl_next=SLOTB;
  #define ROT() do{sl_prev=sl_cur;sl_cur=sl_next;sl_next=(sl_next==(NSLOT-1)*SLOTB)?0:sl_next+SLOTB;}while(0)
  DMA_K(2,2*SLOTB);
  WAIT_BAR(3);
  qkt(pA0,pA1,Kbase,qr,r32,hi);asm volatile("s_nop 15\n\ts_nop 7":"+v"(pA0),"+v"(pA1));CMASK(pA0,pA1,0);
  START(pA0,pA1);
  _Pragma("unroll") for(int r=0;r<16;++r)pA1[r]=__builtin_amdgcn_exp2f(pA1[r]);
  WAIT_BAR(0);
  DMA_K(3,0);DMA_V(1,SLOTB);
  ROT();
  kload8(kf,kp0+sl_cur);
  WAIT_BAR(2);
  s16x4 vlo[8],vhi[8]; u32x4 pw0,pw1,pw2,pw3;
  #define PKW(P,B) cvtpk_s(P[B],P[B+1])
  #define PAF(k) __builtin_bit_cast(bf16x8,pw##k)
  #define VFR(i) (bf16x8){vlo[i][0],vlo[i][1],vlo[i][2],vlo[i][3],vhi[i][0],vhi[i][1],vhi[i][2],vhi[i][3]}
  #define PIN(x) asm volatile("":"+v"(x))
  #define MX3(a,b,c) __builtin_fmaxf(__builtin_fmaxf((a),(b)),(c))
  #define GAPA(MF,A0,A1,A2,A3,W0,W1,PW) do{ MF; sacc+=A0; sacc+=A1; sacc+=A2; sacc+=A3; PIN(sacc); W0; W1; PIN(PW); SBAR(); }while(0)
  #define EX(v) __builtin_amdgcn_exp2f(v)
  #define GAPB(MF,X,B) do{ MF; X[B]=EX(X[B]); X[B+1]=EX(X[B+1]); X[B+2]=EX(X[B+2]); X[B+3]=EX(X[B+3]); PIN(X); SBAR(); }while(0)
  #define VRD(i) do{ vlo[i]=vtr(vp_+(((i)>>2)*4096+((i)&3)*1024)); vhi[i]=vtr(vp_+(((i)>>2)*4096+((i)&3)*1024+512)); }while(0)
  #define KRD(G,j) do{ if(G){ kload2(kf,kp0+sl_next,j); SBAR(); } }while(0)
  #define STEP(C0,C1,P0,P1,t,GK,GV,GL) do{ SBAR(); \
    const lds_cptr vp_=vp0+sl_prev; \
    VRD(0); SBAR(); float sacc=(P0[0]+P0[1]); \
    GAPA(C0=__builtin_amdgcn_mfma_f32_32x32x16_bf16(kf[0],qr[0],f32x16{},0,0,0), P0[2],P0[3],P0[4],P0[5],     pw0[0]=PKW(P0,0), pw0[1]=PKW(P0,2), pw0); \
    VRD(4); SBAR(); GAPA(C1=__builtin_amdgcn_mfma_f32_32x32x16_bf16(kf[1],qr[0],f32x16{},0,0,0), P0[6],P0[7],P0[8],P0[9],     pw0[2]=PKW(P0,4), pw0[3]=PKW(P0,6), pw0); \
    VRD(1); SBAR(); GAPA(C0=__builtin_amdgcn_mfma_f32_32x32x16_bf16(kf[2],qr[1],C0,0,0,0),   P0[10],P0[11],P0[12],P0[13], pw1[0]=PKW(P0,8), pw1[1]=PKW(P0,10), pw1); \
    VRD(5); SBAR(); GAPA(C1=__builtin_amdgcn_mfma_f32_32x32x16_bf16(kf[3],qr[1],C1,0,0,0),   P0[14],P0[15],P1[0],P1[1],   pw1[2]=PKW(P0,12),pw1[3]=PKW(P0,14), pw1); \
    VRD(2); SBAR(); GAPA(C0=__builtin_amdgcn_mfma_f32_32x32x16_bf16(kf[4],qr[2],C0,0,0,0),   P1[2],P1[3],P1[4],P1[5],     pw2[0]=PKW(P1,0), pw2[1]=PKW(P1,2), pw2); \
    VRD(6); SBAR(); GAPA(C1=__builtin_amdgcn_mfma_f32_32x32x16_bf16(kf[5],qr[2],C1,0,0,0),   P1[6],P1[7],P1[8],P1[9],     pw2[2]=PKW(P1,4), pw2[3]=PKW(P1,6), pw2); \
    VRD(3); SBAR(); GAPA(C0=__builtin_amdgcn_mfma_f32_32x32x16_bf16(kf[6],qr[3],C0,0,0,0),   P1[10],P1[11],P1[12],P1[13], pw3[0]=PKW(P1,8), pw3[1]=PKW(P1,10), pw3); \
    VRD(7); SBAR(); GAPA(C1=__builtin_amdgcn_mfma_f32_32x32x16_bf16(kf[7],qr[3],C1,0,0,0),   P1[14],P1[15],0.f,0.f,       pw3[2]=PKW(P1,12),pw3[3]=PKW(P1,14), pw3); \
    l_reg+=sacc; \
    if(GK){DMA_K((t)+3,sl_cur);} if(GV){DMA_V((t)+1,sl_next);} \
    _Pragma("unroll") for(int r=0;r<16;++r){C0[r]-=mhat;C1[r]-=mhat;} \
    CMASK(C0,C1,t); \
    { float a=MX3(C0[0],C0[1],C1[0]),b=MX3(C0[2],C0[3],C1[1]); a=MX3(a,C1[2],C1[3]); \
      _Pragma("unroll") for(int r=4;r<16;r+=4){a=MX3(a,C0[r],C0[r+1]);b=MX3(b,C0[r+2],C0[r+3]);a=MX3(a,C1[r],C1[r+1]);b=MX3(b,C1[r+2],C1[r+3]);} \
      float rm=__builtin_fmaxf(a,b); { auto rr=__builtin_amdgcn_permlane32_swap(__float_as_uint(rm),__float_as_uint(rm),false,false); rm=__builtin_fmaxf(__uint_as_float(rr[0]),__uint_as_float(rr[1])); } \
      resc=false; \
      if(__builtin_expect(__any(rm>(float)THRL),0)){ const float dl=__builtin_fmaxf(rm,0.f); mhat+=dl; \
        _Pragma("unroll") for(int r=0;r<16;++r){C0[r]-=dl;C1[r]-=dl;} \
        const float f=__builtin_amdgcn_exp2f(-dl); l_reg*=f; if(hi==0)wsf[r32]=f; resc=true; } } \
    SBAR(); \
    GAPB(o[0]=__builtin_amdgcn_mfma_f32_32x32x16_bf16(PAF(0),VFR(0),o[0],0,0,0), C0,0); \
    GAPB(o[1]=__builtin_amdgcn_mfma_f32_32x32x16_bf16(PAF(0),VFR(4),o[1],0,0,0), C0,4); \
    KRD(GL,0); GAPB(o[0]=__builtin_amdgcn_mfma_f32_32x32x16_bf16(PAF(1),VFR(1),o[0],0,0,0), C0,8); \
    KRD(GL,1); GAPB(o[1]=__builtin_amdgcn_mfma_f32_32x32x16_bf16(PAF(1),VFR(5),o[1],0,0,0), C0,12); \
    KRD(GL,2); GAPB(o[0]=__builtin_amdgcn_mfma_f32_32x32x16_bf16(PAF(2),VFR(2),o[0],0,0,0), C1,0); \
    KRD(GL,3); GAPB(o[1]=__builtin_amdgcn_mfma_f32_32x32x16_bf16(PAF(2),VFR(6),o[1],0,0,0), C1,4); \
    GAPB(o[0]=__builtin_amdgcn_mfma_f32_32x32x16_bf16(PAF(3),VFR(3),o[0],0,0,0), C1,8); \
    GAPB(o[1]=__builtin_amdgcn_mfma_f32_32x32x16_bf16(PAF(3),VFR(7),o[1],0,0,0), C1,12); \
    }while(0)
  int t=1;
  for(;t+5<NT;t+=2){
    STEP(pB0,pB1,pA0,pA1,t,true,true,true);     WAIT_BAR(2); RESC(); ROT();
    STEP(pA0,pA1,pB0,pB1,t+1,true,true,true);   WAIT_BAR(2); RESC(); ROT();
  }
  #undef CMASK
  #define CMASK(P0,P1,t) do{int jb_=(t)-(NT-4); if(jb_>=0)cmask(P0,P1,jb_,qrel,hi); else if(MOBA_MASK_ON && !(((*SELW())>>((t)>>2))&1u)){ _Pragma("unroll") for(int r_=0;r_<16;++r_){P0[r_]=-INFINITY;P1[r_]=-INFINITY;} } }while(0)
  #define ENDW(tt) do{ if((tt)+3<NT){WAIT_BAR(2);} else if((tt)+2<NT){WAIT_BAR(1);} else {WAIT_BAR(0);} }while(0)
  for(;t+1<NT;t+=2){
    STEP(pB0,pB1,pA0,pA1,t,(t+3<NT),(t+1<NT),(t+1<NT));       ENDW(t);   RESC(); ROT();
    STEP(pA0,pA1,pB0,pB1,t+1,(t+4<NT),(t+2<NT),(t+2<NT));     ENDW(t+1); RESC(); ROT();
  }
  STEP(pB0,pB1,pA0,pA1,NT-1,false,false,false); RESC();
  { float sacc=pB0[0]+pB0[1]; _Pragma("unroll") for(int r=2;r<16;++r)sacc+=pB0[r]; _Pragma("unroll") for(int r=0;r<16;++r)sacc+=pB1[r]; l_reg+=sacc;
    pw0=(u32x4){PKW(pB0,0),PKW(pB0,2),PKW(pB0,4),PKW(pB0,6)};pw1=(u32x4){PKW(pB0,8),PKW(pB0,10),PKW(pB0,12),PKW(pB0,14)};pw2=(u32x4){PKW(pB1,0),PKW(pB1,2),PKW(pB1,4),PKW(pB1,6)};pw3=(u32x4){PKW(pB1,8),PKW(pB1,10),PKW(pB1,12),PKW(pB1,14)};
    SBAR(); pv(o,vb0+sl_cur,PAF(0),PAF(1),PAF(2),PAF(3)); }
  #undef PKW
  #undef PAF
  #undef VFR
  #undef PIN
  #undef MX3
  #undef GAPA
  #undef GAPB
  #undef EX
  #undef VRD
  #undef KRD
  #undef STEP
  #undef ENDW
  {auto rr=__builtin_amdgcn_permlane32_swap(__float_as_uint(l_reg),__float_as_uint(l_reg),false,false);l_reg=__uint_as_float(rr[0])+__uint_as_float(rr[1]);}
  if(hi==0)wsf[32+r32]=l_reg;asm volatile("s_waitcnt lgkmcnt(0)":::"memory");
  float rli[16];
  #pragma unroll
  for(int r=0;r<16;++r)rli[r]=__builtin_amdgcn_rcpf(wsf[32+crow(r,hi)]);
  bf16*Ow=O+(rowbase+q0+wid*QBLK)*DM+h*D;
  { bf16*stg=(bf16*)(shm+LDS_OST)+wid*2048;
    #pragma unroll
    for(int r=0;r<16;++r){const int orow=crow(r,hi);
      #pragma unroll
      for(int d0=0;d0<2;++d0)stg[orow*64+d0*32+r32]=__float2bfloat16(o[d0][r]*rli[r]);}
    asm volatile("s_waitcnt lgkmcnt(0)":::"memory");
    #pragma unroll
    for(int i=0;i<4;++i){const int row=i*8+(lane>>3),ch=lane&7; const u32x4 v=*(const u32x4*)(stg+row*64+ch*8); ATTN_STORE16(Ow+(long)row*DM+ch*8,v);} }
  asm volatile("s_waitcnt lgkmcnt(0)\n\ts_barrier":::"memory");
  #undef SELW
  #undef DMA_K
  #undef DMA_V
  #undef CMASK
  #undef START
  #undef RESC
  #undef ROT
}
constexpr int ATTN_LDS_BYTES=LDS_BYTES;
struct AttnTensors { const bf16* Q; const bf16* K; const bf16* V; bf16* O; const unsigned* SEL; };
struct AttnUnit { int bh; int qb; };
struct StaticOrder {
  int vcu;
  __device__ __forceinline__ explicit StaticOrder(int grid,int block):vcu((block%8)*(grid/8)+block/8){}
  __device__ __forceinline__ bool next(int i,AttnUnit&u)const{ if(i>=4)return false; const int s=vcu&7; u.bh=vcu>>3; u.qb=(i==0)?s:(i==1)?15-s:(i==2)?16+s:31-s; return true; }
  __device__ __forceinline__ void a_ready(const AttnUnit&)const{}
  __device__ __forceinline__ void done(const AttnUnit&)const{}
};
template<class Sched,int THRL=8> __device__ __forceinline__ void attn_phase(char*lds,const AttnTensors&T,const Sched&S,int wave){
  AttnUnit u;
  for(int i=0;S.next(i,u);++i){ S.a_ready(u); attn_unit<THRL>(u.bh/NHEAD,u.bh%NHEAD,u.qb,T.Q,T.K,T.V,T.O,T.SEL,lds,wave); S.done(u); }
}
#undef SBAR
#undef WAIT_BAR
}

constexpr int NWAVES = 8;
constexpr int BATCH = 2, T = 8192, D = 1024, H = 16, HD = 64, M = BATCH * T;
constexpr int FF = 2816, FFE = 3584, NE = 8, MOE_ROWS = 34816  ;
#ifndef MOE_DOWN_F8
#define MOE_DOWN_F8 1
#endif
constexpr float MOE_HSCALE = 16.f, MOE_DSCALE = 256.f;
constexpr float MOE_WSCALE = 64.f;
constexpr float LN_EPS = 1e-5f, GN_EPS = 64e-5f, ALPHA = 1.6817928305074292f  ;
constexpr size_t MiB = 1u << 20;
constexpr size_t WS_CTL = 0, CTL_ZERO_BYTES = 1 * MiB;
constexpr size_t WS_KMEAN = 1 * MiB;
constexpr size_t WS_SEL = 2 * MiB;
constexpr size_t WS_TOKE = 3 * MiB;
constexpr size_t WS_TOKW = WS_TOKE + 128 * 1024;
constexpr size_t WS_TOKR = WS_TOKW + 128 * 1024;
constexpr size_t WS_GW = WS_TOKR + 128 * 1024;
constexpr size_t WS_BLKCNT = WS_GW + 256 * 1024;
constexpr size_t WS_WMIX = 16 * MiB;
constexpr size_t WS_WFFN = 32 * MiB;
constexpr size_t WS_H = 200 * MiB;
constexpr size_t WS_HB = 264 * MiB;
constexpr size_t WS_K = 296 * MiB, WS_V = 328 * MiB;
constexpr size_t WS_VFIRST = WS_K;
constexpr size_t WS_Y = WS_V;
constexpr size_t WS_SCR = 360 * MiB;
constexpr size_t WS_END = 896 * MiB;
constexpr size_t RS_XM = WS_SCR;
constexpr size_t RS_KP = WS_SCR, RS_AP = WS_SCR + 32 * MiB, RS_VP = WS_SCR + 64 * MiB, RS_BP = WS_SCR + 96 * MiB;
constexpr size_t RS_RKV = WS_SCR + 192 * MiB;
constexpr size_t RS_PRE = RS_RKV;
constexpr size_t RS_LH = WS_SCR + 288 * MiB;
constexpr size_t RS_YG = RS_LH;
constexpr size_t RS_YGC = WS_SCR + 128 * MiB;
#ifdef WKV_SEQ
constexpr size_t RS_YGX = RS_YG;
#else
constexpr size_t RS_YGX = RS_YGC;
#endif
constexpr size_t RS_DEC = WS_SCR + 320 * MiB;
constexpr size_t RS_AB = WS_SCR + 384 * MiB;
constexpr size_t RS_REC0 = WS_SCR + 224 * MiB, RS_REC1 = WS_SCR + 384 * MiB;
constexpr size_t RS_VG = WS_SCR + 448 * MiB;
constexpr size_t RS_GG = WS_SCR + 480 * MiB;
constexpr size_t BS_Q = WS_SCR, BS_PRE = WS_SCR + 32 * MiB, BS_O = WS_SCR + 96 * MiB;
constexpr size_t BS_PO = WS_SCR + 128 * MiB, BS_ML = WS_SCR + 256 * MiB;
constexpr size_t FS_HID = WS_SCR, FS_PRE = WS_SCR + 88 * MiB;
constexpr size_t ES_XG = WS_SCR, ES_HID = WS_SCR + 68 * MiB, ES_YP = WS_SCR + 306 * MiB, ES_YS = WS_SCR + 442 * MiB;
static_assert(RS_GG + 32 * MiB <= WS_END && ES_YS + 56 * MiB <= WS_END && FS_PRE + 64 * MiB <= WS_END, "d_ws map");
constexpr size_t RW_LSTRIDE = 872 * MiB - WS_WMIX;
constexpr size_t WM_BT1 = WS_WMIX, WM_BT2 = WS_WMIX + 8 * MiB, WM_OUT = WS_WMIX + 10 * MiB;
constexpr size_t WM_QKV = WS_WMIX, WM_O = WS_WMIX + 8 * MiB;
constexpr size_t WF_GU = 4 * MiB, WF_DN = 884 * MiB;
constexpr size_t WE_SET = 84 * MiB, WE_GU = WS_WFFN, WE_DN = WS_WFFN + 56 * MiB;
static_assert(MOE_DOWN_F8 == 1, "the two-set MoE weight map assumes the fp8 down projection");
constexpr size_t WM_Q3 = WS_WMIX + 12 * MiB, WM_O3 = WS_WMIX + 14 * MiB;
constexpr int CW_TMO = 0, CW_CODE = 1, CW_QCTR = 2048  , CW_BAR = 4096;
constexpr int RING_OFF = 0, RING_BYTES = 131072;
constexpr int LDSCTL_OFF = RING_BYTES, MISC_OFF = LDSCTL_OFF + 320;
constexpr int LDS_BYTES = 147456;
static_assert(MISC_OFF + 128 <= LDS_BYTES, "LDS map");

#define GAS __attribute__((address_space(1)))
#define LAS __attribute__((address_space(3)))
typedef unsigned short bf16;
typedef unsigned v4u __attribute__((ext_vector_type(4)));
typedef float f32x4 __attribute__((ext_vector_type(4)));
typedef short bf16x8 __attribute__((ext_vector_type(8)));
typedef GAS unsigned gu32;
typedef GAS unsigned long long gu64;
#define RLX_AGENT __ATOMIC_RELAXED, __HIP_MEMORY_SCOPE_AGENT
#define LDS_WAIT() asm volatile("s_waitcnt lgkmcnt(0)" ::: "memory")
#define VM_WAIT() asm volatile("s_waitcnt vmcnt(0)" ::: "memory")
__device__ __forceinline__ unsigned long long rt() { return __builtin_amdgcn_s_memrealtime(); }
__device__ __forceinline__ unsigned f2bf(float f) { unsigned u = __builtin_bit_cast(unsigned, f); return (u + 0x7fffu + ((u >> 16) & 1u)) >> 16; }
__device__ __forceinline__ unsigned pk2(float lo, float hi) { return f2bf(lo) | (f2bf(hi) << 16); }

#define XB_TMO      128
#define XB_XCNT(j)  (256  + 64 * (j))
#define XB_XSUB(j)  (1280 + 64 * (j))
#define XB_XGEN(j)  (2304 + 64 * (j))
#define XB_TOP      3328
#define XB_TOPGEN   3392
#define XCD_BAR_WORDS 3456
#define XB_SPIN_CAP (1u << 18)

__device__ __forceinline__ unsigned xb_ld(unsigned* p)              { return __hip_atomic_load(p, __ATOMIC_RELAXED, __HIP_MEMORY_SCOPE_AGENT); }
__device__ __forceinline__ unsigned xb_add(unsigned* p, unsigned v) { return __hip_atomic_fetch_add(p, v, __ATOMIC_RELAXED, __HIP_MEMORY_SCOPE_AGENT); }
__device__ __forceinline__ unsigned xb_xcc_id() { return (unsigned)__builtin_amdgcn_s_getreg((3 << 11) | 20) & 0xFu; }
#define XB_SPIN(cond, bar) do { unsigned _sp = 0; while (cond) { __builtin_amdgcn_s_sleep(1); \
    if ((++_sp & 255u) == 0u) { if (xb_ld(&(bar)[XB_TMO])) break; if (_sp > XB_SPIN_CAP) { atomicAdd(&(bar)[XB_TMO], 1u); break; } } } } while (0)

struct XcdBarrier {
    unsigned* bar; unsigned x;
    volatile LAS unsigned* st;
};

__device__ __forceinline__ XcdBarrier xcd_barrier_post(unsigned* bar, volatile LAS unsigned* st, bool t0  ) {
    XcdBarrier b; b.bar = bar; b.x = xb_xcc_id(); b.st = st;
    if (t0) (void)xb_add(&bar[XB_XCNT(b.x)], 1u);
    return b;
}
__device__ __forceinline__ void xcd_barrier_complete(unsigned* bar, unsigned x, unsigned& nloc, unsigned& nx) {
    const unsigned G = gridDim.x * gridDim.y * gridDim.z;
    unsigned sum, cnt, mine, sp = 0u;
    for (;;) {
        sum = 0u; cnt = 0u; mine = 0u;
#pragma unroll
        for (unsigned j = 0; j < 16; ++j) { const unsigned c = xb_ld(&bar[XB_XCNT(j)]); sum += c; cnt += (c > 0u) ? 1u : 0u; mine = (j == x) ? c : mine; }
        if (sum == G) break;
        __builtin_amdgcn_s_sleep(1);
        if ((++sp & 255u) == 0u) { if (xb_ld(&bar[XB_TMO])) break; if (sp > XB_SPIN_CAP) { atomicAdd(&bar[XB_TMO], 1u); break; } }
    }
    nloc = mine > 0u ? mine : 1u; nx = cnt > 0u ? cnt : 1u;
}

__device__ __forceinline__ void xcd_barrier(const XcdBarrier& b, bool t0  ) {
    asm volatile("s_waitcnt vmcnt(0)" ::: "memory");
    __syncthreads();
    if (t0) {
        unsigned* bar = b.bar;
        __builtin_amdgcn_s_waitcnt(0);
        unsigned nloc = b.st[0], nx = b.st[1];
        if (nloc == 0u) { xcd_barrier_complete(bar, b.x, nloc, nx); b.st[0] = nloc; b.st[1] = nx; }
        const unsigned old = xb_add(&bar[XB_XSUB(b.x)], 1u);
        const unsigned gen = old / nloc;
        if (old + 1u == (gen + 1u) * nloc) {
            __builtin_amdgcn_fence(__ATOMIC_RELEASE, "agent");
            asm volatile("s_waitcnt vmcnt(0)" ::: "memory");
            const unsigned og = xb_add(&bar[XB_TOP], 1u);
            const unsigned tg = og / nx;
            if (og + 1u == (tg + 1u) * nx) xb_add(&bar[XB_TOPGEN], 1u);
            else XB_SPIN(xb_ld(&bar[XB_TOPGEN]) == tg, bar);
#ifdef XB_L2_INV
            __builtin_amdgcn_fence(__ATOMIC_ACQUIRE, "");
#else
            __builtin_amdgcn_fence(__ATOMIC_ACQUIRE, "agent");
#endif
            xb_add(&bar[XB_XGEN(b.x)], 1u);
            asm volatile("s_waitcnt vmcnt(0)" ::: "memory");
        } else {
            XB_SPIN(xb_ld(&bar[XB_XGEN(b.x)]) == gen, bar);
            __builtin_amdgcn_fence(__ATOMIC_ACQUIRE, "agent");
            asm volatile("s_waitcnt vmcnt(0)" ::: "memory");
        }
    }
    __syncthreads();
}

struct Args { const float* in[33]; float* out; unsigned char* ws; };
enum InIdx { I_X = 0, I_MU, I_WRKV, I_WOUT, I_W0, I_W1, I_W2, I_A0, I_A1, I_A2, I_V0, I_V1, I_V2, I_G1, I_G2, I_KK, I_KA, I_RK, I_GNG, I_GNB,
             I_MK, I_MV, I_MQ, I_MO, I_FG, I_FU, I_FD, I_ROUTER, I_EG, I_EU, I_ED, I_LNG, I_LNB };
struct Frame {
    LAS unsigned char* lds; volatile LAS unsigned* MISC; gu32* ctl; unsigned char* ws;
    int tid, lane, wave, vcu, G, gw, NGW;
};
typedef float f32x2 __attribute__((ext_vector_type(2)));
typedef unsigned u32x2 __attribute__((ext_vector_type(2)));
__device__ __forceinline__ float dpp_sum16(float v) {
    v += __builtin_bit_cast(float, __builtin_amdgcn_update_dpp(0, __builtin_bit_cast(int, v), 0xB1, 0xF, 0xF, true));
    v += __builtin_bit_cast(float, __builtin_amdgcn_update_dpp(0, __builtin_bit_cast(int, v), 0x4E, 0xF, 0xF, true));
    v += __builtin_bit_cast(float, __builtin_amdgcn_update_dpp(0, __builtin_bit_cast(int, v), 0x141, 0xF, 0xF, true));
    v += __builtin_bit_cast(float, __builtin_amdgcn_update_dpp(0, __builtin_bit_cast(int, v), 0x140, 0xF, 0xF, true));
    return v;
}
__device__ __forceinline__ float wave_sum(float v, int lane) {
    v = dpp_sum16(v);
    v += __builtin_bit_cast(float, __builtin_amdgcn_ds_bpermute((lane ^ 16) << 2, __builtin_bit_cast(int, v)));
    v += __builtin_bit_cast(float, __builtin_amdgcn_ds_bpermute((lane ^ 32) << 2, __builtin_bit_cast(int, v)));
    return v;
}
__device__ __forceinline__ float sum16(float v) { return dpp_sum16(v); }
__device__ __forceinline__ float bf2f(unsigned short b) { return __uint_as_float((unsigned)b << 16); }
__device__ __forceinline__ f32x4 bf4_to_f32(u32x2 w) { f32x4 r; r.x = __uint_as_float(w.x << 16); r.y = __uint_as_float(w.x & 0xffff0000u); r.z = __uint_as_float(w.y << 16); r.w = __uint_as_float(w.y & 0xffff0000u); return r; }
__device__ __forceinline__ u32x2 f32_to_bf4(f32x4 v) { u32x2 w; w.x = pk2(v.x, v.y); w.y = pk2(v.z, v.w); return w; }

__device__ __forceinline__ void tr_item(const float* W, int ldw, int Kr, int Nr, int nblk, bf16* WT, int ldt, int row0, int mode, LAS float* scr, int item, int lane) {
    const int kb = item / nblk, nb = item - kb * nblk, k0 = 64 * kb, n0 = 32 * nb;
    const int kg = lane >> 3, n = n0 + 4 * (lane & 7), kk = k0 + 8 * kg;
    f32x4 v[8];
#pragma unroll
    for (int i = 0; i < 8; ++i) { v[i] = (f32x4){0.f, 0.f, 0.f, 0.f}; if (kk + i < Kr && n < Nr) v[i] = *(const f32x4*)(W + (size_t)(kk + i) * ldw + n); }
#pragma unroll
    for (int e = 0; e < 4; ++e) { const int nn = n + e; const int drow = mode == 0 ? row0 + nn : row0 + ((nn >> 7) << 8) + (nn & 127);
        v4u o; o.x = pk2(v[0][e], v[1][e]); o.y = pk2(v[2][e], v[3][e]); o.z = pk2(v[4][e], v[5][e]); o.w = pk2(v[6][e], v[7][e]);
        *(GAS v4u*)(WT + (size_t)drow * ldt + kk) = o; }
}
__device__ __forceinline__ void tr_item8(const float* W, int ldw, int Kr, int Nr, int nblk, unsigned char* WT, int ldt, int row0, int mode, float scale, int item, int lane) {
    const int kb = item / nblk, nb = item - kb * nblk, k0 = 64 * kb, n0 = 32 * nb;
    const int kg = lane >> 3, n = n0 + 4 * (lane & 7), kk = k0 + 8 * kg;
    f32x4 v[8];
#pragma unroll
    for (int i = 0; i < 8; ++i) { v[i] = (f32x4){0.f, 0.f, 0.f, 0.f}; if (kk + i < Kr && n < Nr) v[i] = *(const f32x4*)(W + (size_t)(kk + i) * ldw + n) * scale; }
#pragma unroll
    for (int e = 0; e < 4; ++e) { const int nn = n + e; const int drow = mode == 0 ? row0 + nn : row0 + ((nn >> 7) << 8) + (nn & 127);
        int lo = __builtin_amdgcn_cvt_pk_fp8_f32(v[0][e], v[1][e], 0, false); lo = __builtin_amdgcn_cvt_pk_fp8_f32(v[2][e], v[3][e], lo, true);
        int hi = __builtin_amdgcn_cvt_pk_fp8_f32(v[4][e], v[5][e], 0, false); hi = __builtin_amdgcn_cvt_pk_fp8_f32(v[6][e], v[7][e], hi, true);
        u32x2 o; o.x = (unsigned)lo; o.y = (unsigned)hi; *(GAS u32x2*)(WT + (size_t)drow * ldt + kk) = o; }
}
#define KIN(i) ({ const __attribute__((address_space(4))) char* k_ = (const __attribute__((address_space(4))) char*)__builtin_amdgcn_kernarg_segment_ptr(); asm volatile("" : "+s"(k_)); const GAS float* g_ = (const GAS float*)(*(const float* const __attribute__((address_space(4)))*)(k_ + 8 * (i))); asm volatile("" : "+s"(g_)); (const float*)g_; })
#define CONV_BEGIN() F.lane = fresh_lane(); F.tid = F.wave * 64 + F.lane; asm volatile("" : "+s"(F.G), "+s"(F.wave), "+s"(F.vcu), "+s"(F.gw), "+s"(F.NGW)); GAS unsigned char* cws0_ = (GAS unsigned char*)F.ws; asm volatile("" : "+s"(cws0_)); unsigned char* cws_ = (unsigned char*)cws0_; LAS float* scr_ = (LAS float*)(F.lds + RING_OFF + F.wave * 16384); int it_ = F.gw, base_ = 0
#define JOB(W, ldw, Kr, Nr, Kp, Np, WT, ldt, row0, mode) do { const int nblk_ = (Np) / 32, n_ = ((Kp) / 64) * nblk_; \
    while (it_ < base_ + n_) { tr_item((W), (ldw), (Kr), (Nr), nblk_, (WT), (ldt), (row0), (mode), scr_, it_ - base_, F.lane); it_ += F.NGW; } base_ += n_; } while (0)
#define JOB8(W, ldw, Kr, Nr, Kp, Np, WT, ldt, row0, mode, scale) do { const int nblk_ = (Np) / 32, n_ = ((Kp) / 64) * nblk_; \
    while (it_ < base_ + n_) { tr_item8((W), (ldw), (Kr), (Nr), nblk_, (WT), (ldt), (row0), (mode), (scale), it_ - base_, F.lane); it_ += F.NGW; } base_ += n_; } while (0)

__device__ __forceinline__ void conv_rwkv(Frame& F, int l) {
    CONV_BEGIN();
    cws_ += (size_t)l * RW_LSTRIDE; bf16* BT1 = (bf16*)(cws_ + WM_BT1); bf16* BT2 = (bf16*)(cws_ + WM_BT2); bf16* WO = (bf16*)(cws_ + WM_OUT);
    for (int c = 0; c < 3; ++c) JOB(KIN(I_WRKV) + (size_t)(l * 3 + c) * D * D, D, D, D, D, D, BT1, D, c * D, 0);
    JOB(KIN(I_W1) + (size_t)l * D * 64, 64, D, 64, D, 256, BT1, D, 3072, 0);
    JOB(KIN(I_A1) + (size_t)l * D * 64, 64, D, 64, D, 256, BT1, D, 3328, 0);
    JOB(KIN(I_V1), 32, D, (l == 0 ? 0 : 32), D, 256, BT1, D, 3584, 0);
    JOB(KIN(I_G1) + (size_t)l * D * 160, 160, D, 160, D, 256, BT1, D, 3840, 0);
    JOB(KIN(I_W2) + (size_t)l * 64 * D, D, 64, D, 256, D, BT2, 256, 0, 0);
    JOB(KIN(I_A2) + (size_t)l * 64 * D, D, 64, D, 256, D, BT2, 256, 1024, 0);
    JOB(KIN(I_V2), D, (l == 0 ? 0 : 32), D, 256, D, BT2, 256, 2048, 0);
    JOB(KIN(I_G2) + (size_t)l * 160 * D, D, 160, D, 256, D, BT2, 256, 3072, 0);
    JOB(KIN(I_WOUT) + (size_t)l * D * D, D, D, D, D, D, WO, D, 0, 0);
}
__device__ __forceinline__ void conv_moba(Frame& F, int j) {
    CONV_BEGIN();
    bf16* WQ = (bf16*)(cws_ + (j == 0 ? WM_QKV : WM_Q3)); bf16* WO = (bf16*)(cws_ + (j == 0 ? WM_O : WM_O3));
    JOB(KIN(I_MQ) + (size_t)j * D * D, D, D, D, D, D, WQ, D, 0, 0);
    if (j == 0) { JOB(KIN(I_MK), D, D, D, D, D, WQ, D, D, 0); JOB(KIN(I_MV), D, D, D, D, D, WQ, D, 2 * D, 0); }
    JOB(KIN(I_MO) + (size_t)j * D * D, D, D, D, D, D, WO, D, 0, 0);
}
__device__ __forceinline__ void conv_dense(Frame& F, int e) {
    CONV_BEGIN();
    bf16* GU = (bf16*)(cws_ + WF_GU); bf16* DN = (bf16*)(cws_ + WF_DN);
    JOB(KIN(I_FG) + (size_t)e * D * FF, FF, D, FF, D, FF, GU, D, 0, 1);
    JOB(KIN(I_FU) + (size_t)e * D * FF, FF, D, FF, D, FF, GU, D, 128, 1);
    JOB(KIN(I_FD) + (size_t)e * FF * D, D, FF, D, FF, D, DN, FF, 0, 0);
}
__device__ __forceinline__ void conv_moe(Frame& F, int e) {
    CONV_BEGIN();
    bf16* GU = (bf16*)(cws_ + WE_GU + (size_t)e * WE_SET); bf16* DN = (bf16*)(cws_ + WE_DN + (size_t)e * WE_SET);
    for (int x = 0; x < NE; ++x) {
        JOB8(KIN(I_EG) + (size_t)(e * NE + x) * D * FFE, FFE, D, FFE, D, FFE, (unsigned char*)GU, D, x * 2 * FFE, 1, MOE_WSCALE);
        JOB8(KIN(I_EU) + (size_t)(e * NE + x) * D * FFE, FFE, D, FFE, D, FFE, (unsigned char*)GU, D, x * 2 * FFE + 128, 1, MOE_WSCALE);
        if (MOE_DOWN_F8) JOB8(KIN(I_ED) + (size_t)(e * NE + x) * FFE * D, D, FFE, D, FFE, D, (unsigned char*)DN, FFE, x * D, 0, MOE_DSCALE);
        else JOB(KIN(I_ED) + (size_t)(e * NE + x) * FFE * D, D, FFE, D, FFE, D, DN, FFE, x * D, 0);
    }
}

__device__ __forceinline__ void ln_stats(const f32x4 (&v)[4], float& mean, float& rstd, int lane) {
    float s = 0.f;
#pragma unroll
    for (int j = 0; j < 4; ++j) s += (v[j].x + v[j].y) + (v[j].z + v[j].w);
    mean = wave_sum(s, lane) * (1.f / D); float s2 = 0.f;
#pragma unroll
    for (int j = 0; j < 4; ++j) { const f32x4 d = v[j] - mean; s2 += (d.x * d.x + d.y * d.y) + (d.z * d.z + d.w * d.w); }
    rstd = 1.f / sqrtf(wave_sum(s2, lane) * (1.f / D) + LN_EPS);
}
template <int SRC, bool ROUTER>
__device__ __forceinline__ void ln_phase(Frame& F, const float* PRE, const float* Hin, const bf16* YP, const int* tokr, const float* gln, const float* bln,
                                         float* Hout, bf16* HB, const float* router, int* toke, float* tokw, int* blkcnt) {
    LAS int* cnt = (LAS int*)(F.lds + RING_OFF + 131072 - 64);
    if (ROUTER) { if (F.tid < 8) cnt[F.tid] = 0; __syncthreads(); }
    f32x4 g4[4], b4[4];
#pragma unroll
    for (int j = 0; j < 4; ++j) { g4[j] = *(const f32x4*)(gln + 4 * F.lane + 256 * j); b4[j] = *(const f32x4*)(bln + 4 * F.lane + 256 * j); }
    const int rpb = M / F.G, rpw = rpb / NWAVES;
    for (int i = 0; i < rpw; ++i) {
        const int m = blockIdx.x * rpb + F.wave * rpw + i;
        f32x4 v[4];
        if (SRC == 0) {
#pragma unroll
            for (int j = 0; j < 4; ++j) v[j] = *(const f32x4*)(PRE + (size_t)m * D + 4 * F.lane + 256 * j);
        } else {
            const int r0 = tokr[2 * m], r1 = tokr[2 * m + 1];
#pragma unroll
            for (int j = 0; j < 4; ++j) { const int c = 4 * F.lane + 256 * j;
                f32x4 y0, y1;
                if (r0 < 32768) y0 = bf4_to_f32(*(const u32x2*)(YP + (size_t)r0 * D + c)); else { y0 = (f32x4){0.f, 0.f, 0.f, 0.f}; for (int s = 0; s < 7; ++s) y0 += *(const f32x4*)(PRE + ((size_t)s * 2048 + (r0 - 32768)) * D + c); }
                if (r1 < 32768) y1 = bf4_to_f32(*(const u32x2*)(YP + (size_t)r1 * D + c)); else { y1 = (f32x4){0.f, 0.f, 0.f, 0.f}; for (int s = 0; s < 7; ++s) y1 += *(const f32x4*)(PRE + ((size_t)s * 2048 + (r1 - 32768)) * D + c); }
                v[j] = *(const f32x4*)(Hin + (size_t)m * D + c) * ALPHA + y0 + y1; }
        }
        float mean, rstd; ln_stats(v, mean, rstd, F.lane);
#pragma unroll
        for (int j = 0; j < 4; ++j) { v[j] = (v[j] - mean) * rstd * g4[j] + b4[j];
            *(f32x4*)(Hout + (size_t)m * D + 4 * F.lane + 256 * j) = v[j];
            if (HB) *(u32x2*)(HB + (size_t)m * D + 4 * F.lane + 256 * j) = f32_to_bf4(v[j]); }
        if (ROUTER) {
            float lg[8];
#pragma unroll
            for (int e = 0; e < 8; ++e) lg[e] = 0.f;
#pragma unroll
            for (int j = 0; j < 4; ++j)
#pragma unroll
                for (int q = 0; q < 4; ++q) { const float xv = v[j][q]; const f32x4* rp = (const f32x4*)(router + (size_t)(4 * F.lane + 256 * j + q) * 8); const f32x4 ra = rp[0], rb = rp[1];
                    lg[0] += xv * ra.x; lg[1] += xv * ra.y; lg[2] += xv * ra.z; lg[3] += xv * ra.w; lg[4] += xv * rb.x; lg[5] += xv * rb.y; lg[6] += xv * rb.z; lg[7] += xv * rb.w; }
#pragma unroll
            for (int e = 0; e < 8; ++e) lg[e] = wave_sum(lg[e], F.lane);
            int e0 = 0; float l0 = lg[0];
#pragma unroll
            for (int e = 1; e < 8; ++e) if (lg[e] > l0) { l0 = lg[e]; e0 = e; }
            int e1 = -1; float l1 = -INFINITY;
#pragma unroll
            for (int e = 0; e < 8; ++e) if (e != e0 && lg[e] > l1) { l1 = lg[e]; e1 = e; }
            const float w0 = 1.f / (1.f + __expf(l1 - l0)), w1 = 1.f - w0;
            if (F.lane == 0) { toke[2 * m] = e0; toke[2 * m + 1] = e1; tokw[2 * m] = w0; tokw[2 * m + 1] = w1; atomicAdd((int*)&cnt[e0], 1); atomicAdd((int*)&cnt[e1], 1); }
        }
    }
    if (ROUTER) { __syncthreads(); if (F.tid < 8) blkcnt[blockIdx.x * 8 + F.tid] = cnt[F.tid]; }
}

__device__ __forceinline__ void mix_phase(Frame& F, const float* Hx, const float* mu, bf16* XM) {
    f32x4 mu4[6][4];
#pragma unroll
    for (int c = 0; c < 6; ++c)
#pragma unroll
        for (int j = 0; j < 4; ++j) mu4[c][j] = *(const f32x4*)(mu + c * D + 4 * F.lane + 256 * j);
    for (int m = F.gw; m < M; m += F.NGW) {
        const bool first = (m % T) == 0;
#pragma unroll
        for (int j = 0; j < 4; ++j) { const int c0 = 4 * F.lane + 256 * j;
            const f32x4 x = *(const f32x4*)(Hx + (size_t)m * D + c0);
            f32x4 xp = (f32x4){0.f, 0.f, 0.f, 0.f}; if (!first) xp = *(const f32x4*)(Hx + (size_t)(m - 1) * D + c0);
            const f32x4 xx = xp - x;
#pragma unroll
            for (int c = 0; c < 6; ++c) *(u32x2*)(XM + ((size_t)c * M + m) * D + c0) = f32_to_bf4(x + xx * mu4[c][j]); }
    }
}
__device__ __forceinline__ void prep_phase(Frame& F, int l, const bf16* RKV, const float* AA, const bf16* LH, const float* v0, const float* v2, bf16* VF, const float* k_k, const float* k_a, bf16* KP, bf16* AP, bf16* BP, bf16* VP) {
    f32x4 kk4[4], ka4[4];
#pragma unroll
    for (int j = 0; j < 4; ++j) { kk4[j] = *(const f32x4*)(k_k + 4 * F.lane + 256 * j); ka4[j] = *(const f32x4*)(k_a + 4 * F.lane + 256 * j); }
    for (int m = F.gw; m < M; m += F.NGW) {
#pragma unroll
        for (int j = 0; j < 4; ++j) { const size_t o = (size_t)m * D + 4 * F.lane + 256 * j;
            const f32x4 k = bf4_to_f32(*(const u32x2*)(RKV + (size_t)M * D + o)); const u32x2 vraw = *(const u32x2*)(RKV + (size_t)2 * M * D + o); f32x4 v = bf4_to_f32(vraw);
            const f32x4 a = *(const f32x4*)(AA + o);
            f32x4 kk = k * kk4[j]; const float ss = sum16((kk.x * kk.x + kk.y * kk.y) + (kk.z * kk.z + kk.w * kk.w));
            kk = kk * (1.0f / sqrtf(fmaxf(ss, 1e-24f)));
            const f32x4 kp = k * ((a - 1.0f) * ka4[j] + 1.0f);
            if (l == 0) *(u32x2*)(VF + o) = vraw;
            else {
                f32x4 z = *(const f32x4*)(v0 + 4 * F.lane + 256 * j);
                const bf16* lh = LH + (size_t)m * D + 512;
#pragma unroll 8
                for (int q = 0; q < 32; ++q) z += *(const f32x4*)(v2 + (size_t)q * D + 4 * F.lane + 256 * j) * bf2f(lh[q]);
                f32x4 vg; vg.x = 1.f / (1.f + __expf(-z.x)); vg.y = 1.f / (1.f + __expf(-z.y)); vg.z = 1.f / (1.f + __expf(-z.z)); vg.w = 1.f / (1.f + __expf(-z.w));
                const f32x4 vf = bf4_to_f32(*(const u32x2*)(VF + o)); v = v + (vf - v) * vg; }
            *(u32x2*)(KP + o) = f32_to_bf4(kp); *(u32x2*)(VP + o) = f32_to_bf4(v); *(u32x2*)(AP + o) = f32_to_bf4(-kk); *(u32x2*)(BP + o) = f32_to_bf4(kk * a); }
    }
}
__device__ __forceinline__ void post_phase(Frame& F, const bf16* Y, const bf16* R, const bf16* KP, const bf16* VP, const bf16* GG, const float* r_k, const float* gng, const float* gnb, bf16* YG) {
    f32x4 rk4[4], gg4[4], gb4[4];
#pragma unroll
    for (int j = 0; j < 4; ++j) { rk4[j] = *(const f32x4*)(r_k + 4 * F.lane + 256 * j); gg4[j] = *(const f32x4*)(gng + 4 * F.lane + 256 * j); gb4[j] = *(const f32x4*)(gnb + 4 * F.lane + 256 * j); }
    for (int m = F.gw; m < M; m += F.NGW) {
#pragma unroll
        for (int j = 0; j < 4; ++j) { const size_t o = (size_t)m * D + 4 * F.lane + 256 * j;
            const f32x4 y = bf4_to_f32(*(const u32x2*)(Y + o)), r = bf4_to_f32(*(const u32x2*)(R + o)), g = bf4_to_f32(*(const u32x2*)(GG + o));
            const f32x4 kp = bf4_to_f32(*(const u32x2*)(KP + o)), vp = bf4_to_f32(*(const u32x2*)(VP + o));
            const float mean = sum16((y.x + y.y) + (y.z + y.w)) * (1.f / 64.f); const f32x4 d = y - mean;
            const float var = sum16((d.x * d.x + d.y * d.y) + (d.z * d.z + d.w * d.w)) * (1.f / 64.f);
            const f32x4 rkk = r * kp * rk4[j]; const float bon = sum16((rkk.x + rkk.y) + (rkk.z + rkk.w));
            const f32x4 yn = d * (1.0f / sqrtf(var + GN_EPS)) * gg4[j] + gb4[j] + vp * bon;
            *(u32x2*)(YG + o) = f32_to_bf4(yn * g); }
    }
}
__device__ __forceinline__ float fma_s(float a, float b, float c) { float r; asm("v_fma_f32 %0, %1, %2, %3" : "=v"(r) : "v"(a), "v"(b), "v"(c)); return r; }
__device__ __forceinline__ float mul_s(float a, float b) { float r; asm("v_mul_f32_e32 %0, %1, %2" : "=v"(r) : "v"(a), "v"(b)); return r; }
__device__ __forceinline__ float add_s(float a, float b) { float r; asm("v_add_f32_e32 %0, %1, %2" : "=v"(r) : "v"(a), "v"(b)); return r; }
__device__ __forceinline__ float dot4_s(const f32x4& x, const f32x4& y) { return add_s(fma_s(x.y, y.y, mul_s(x.x, y.x)), fma_s(x.w, y.w, mul_s(x.z, y.z))); }
__device__ __forceinline__ f32x4 upd_s(const f32x4& S, const f32x4& w, const f32x4& b, float sa, const f32x4& k, float v) {
    f32x4 r; r.x = fma_s(S.x, w.x, fma_s(b.x, sa, mul_s(k.x, v))); r.y = fma_s(S.y, w.y, fma_s(b.y, sa, mul_s(k.y, v))); r.z = fma_s(S.z, w.z, fma_s(b.z, sa, mul_s(k.z, v))); r.w = fma_s(S.w, w.w, fma_s(b.w, sa, mul_s(k.w, v))); return r; }
__device__ __forceinline__ void scan_phase(Frame& F, const bf16* R, const float* DEC, const bf16* KP, const bf16* AP, const bf16* BP, const bf16* VP, bf16* Y) {
    constexpr int TS = 32, BUFB = 57600, YB_OFF = 2 * BUFB;
    const int head = F.vcu >> 3, part = F.vcu & 7, b = head >> 4, hh = head & 15;
    const size_t rowb = (size_t)b * T; const int col0 = hh * 64;
    const int tr = F.tid >> 4, pc = F.tid & 15;
    const int tr2 = (F.tid & 255) >> 3, pc2 = F.tid & 7;
    const int rr = F.lane >> 4, q = F.lane & 15, myrow = 8 * part + 4 * F.wave + rr;
    LAS unsigned char* L = F.lds + RING_OFF;
    struct Stg { f32x4 lw; u32x2 rk, ra, rb, rv, rn; v4u lr; };
    Stg g0, g1;
#define SC_LOAD(c, G) do { const int t_ = (c) * TS + tr; const size_t g_ = (rowb + t_) * D + col0 + pc * 4; G.lw = *(const f32x4*)(DEC + g_); G.rk = *(const u32x2*)(KP + g_); G.ra = *(const u32x2*)(AP + g_); \
        G.rb = *(const u32x2*)(BP + g_); G.rv = *(const u32x2*)(VP + g_); G.rn = (u32x2){0u, 0u}; if (t_ + 1 < T) G.rn = *(const u32x2*)(AP + g_ + D); \
        if (F.tid < 256) G.lr = *(const v4u*)(R + (rowb + (size_t)(c) * TS + tr2) * D + col0 + pc2 * 8); } while (0)
#define SC_STORE(bf, G) do { const f32x4 lk_ = bf4_to_f32(G.rk), la_ = bf4_to_f32(G.ra), lb_ = bf4_to_f32(G.rb), lv_ = bf4_to_f32(G.rv), ln_ = bf4_to_f32(G.rn); LAS unsigned char* d_ = L + (bf) * BUFB + tr * 256 + pc * 16; *(LAS f32x4*)(d_) = G.lw; *(LAS f32x4*)(d_ + 8192) = lk_; *(LAS f32x4*)(d_ + 16384) = la_; \
        *(LAS f32x4*)(d_ + 24576) = lb_; *(LAS f32x4*)(d_ + 32768) = lv_; *(LAS f32x4*)(d_ + 49152) = G.lw * ln_; \
        { const f32x4 pb_ = lb_ * ln_, pk_ = lk_ * ln_; const float be_ = dpp_sum16((pb_.x + pb_.y) + (pb_.z + pb_.w)), ga_ = dpp_sum16((pk_.x + pk_.y) + (pk_.z + pk_.w)); \
          if (pc == 0) { *(LAS float*)(L + (bf) * BUFB + 57344 + tr * 4) = be_; *(LAS float*)(L + (bf) * BUFB + 57472 + tr * 4) = ga_; } } \
        if (F.tid < 256) { LAS unsigned char* r_ = L + (bf) * BUFB + 40960 + tr2 * 256 + pc2 * 32; \
            *(LAS f32x4*)(r_) = (f32x4){__uint_as_float(G.lr.x << 16), __uint_as_float(G.lr.x & 0xffff0000u), __uint_as_float(G.lr.y << 16), __uint_as_float(G.lr.y & 0xffff0000u)}; \
            *(LAS f32x4*)(r_ + 16) = (f32x4){__uint_as_float(G.lr.z << 16), __uint_as_float(G.lr.z & 0xffff0000u), __uint_as_float(G.lr.w << 16), __uint_as_float(G.lr.w & 0xffff0000u)}; } } while (0)
    SC_LOAD(0, g0); SC_STORE(0, g0); SC_LOAD(1, g0); __syncthreads();
    f32x4 S = (f32x4){0.f, 0.f, 0.f, 0.f};
    constexpr int NCH = T / TS;
    for (int c2 = 0; c2 < NCH; c2 += 2) {
#pragma unroll
      for (int par = 0; par < 2; ++par) {
        const int c = c2 + par, bf = par;
        if (c + 2 < NCH) { if (par == 0) SC_LOAD(c + 2, g1); else SC_LOAD(c + 2, g0); }
        if (F.wave < 2) {
            const LAS unsigned char* B0 = L + bf * BUFB + q * 16; const LAS unsigned char* Bv = L + bf * BUFB + 32768 + myrow * 4; const LAS unsigned char* Bs = L + bf * BUFB + 57344;
            LAS unsigned short* yb = (LAS unsigned short*)(L + YB_OFF + bf * 512) + q * 8 + 4 * F.wave + rr;
            struct Rnd { f32x4 a, aw, w0, b0, k0, r0, w1, b1, k1, r1; float v0, v1, be, ga; };
#define SC_FETCH(t_, X) do { X.a = *(const LAS f32x4*)(B0 + 16384 + (t_) * 256); X.aw = *(const LAS f32x4*)(B0 + 49152 + (t_) * 256); \
            X.w0 = *(const LAS f32x4*)(B0 + (t_) * 256); X.b0 = *(const LAS f32x4*)(B0 + 24576 + (t_) * 256); X.k0 = *(const LAS f32x4*)(B0 + 8192 + (t_) * 256); X.r0 = *(const LAS f32x4*)(B0 + 40960 + (t_) * 256); \
            X.w1 = *(const LAS f32x4*)(B0 + ((t_) + 1) * 256); X.b1 = *(const LAS f32x4*)(B0 + 24576 + ((t_) + 1) * 256); X.k1 = *(const LAS f32x4*)(B0 + 8192 + ((t_) + 1) * 256); X.r1 = *(const LAS f32x4*)(B0 + 40960 + ((t_) + 1) * 256); \
            X.v0 = *(const LAS float*)(Bv + (t_) * 256); X.v1 = *(const LAS float*)(Bv + ((t_) + 1) * 256); X.be = *(const LAS float*)(Bs + (t_) * 4); X.ga = *(const LAS float*)(Bs + 128 + (t_) * 4); } while (0)
            Rnd cu; float ykeep = 0.f, yra = 0.f, yrb = 0.f;
#define RED_STEP(x, ctl) asm volatile("v_add_f32_dpp %0, %0, %0 " ctl " row_mask:0xf bank_mask:0xf bound_ctrl:1" : "+v"(x))
#define RED_STEP0(x, ctl) asm volatile("s_nop 1\n\tv_add_f32_dpp %0, %0, %0 " ctl " row_mask:0xf bank_mask:0xf bound_ctrl:1" : "+v"(x))
#define RED4(a_, b_, c_, d_) do { \
            RED_STEP0(a_, "quad_perm:[1,0,3,2]"); RED_STEP0(b_, "quad_perm:[1,0,3,2]"); RED_STEP0(c_, "quad_perm:[1,0,3,2]"); RED_STEP0(d_, "quad_perm:[1,0,3,2]"); \
            RED_STEP(a_, "quad_perm:[2,3,0,1]"); RED_STEP(b_, "quad_perm:[2,3,0,1]"); RED_STEP(c_, "quad_perm:[2,3,0,1]"); RED_STEP(d_, "quad_perm:[2,3,0,1]"); \
            RED_STEP(a_, "row_half_mirror"); RED_STEP(b_, "row_half_mirror"); RED_STEP(c_, "row_half_mirror"); RED_STEP(d_, "row_half_mirror"); \
            RED_STEP(a_, "row_mirror"); RED_STEP(b_, "row_mirror"); RED_STEP(c_, "row_mirror"); RED_STEP(d_, "row_mirror"); } while (0)
            SC_FETCH(0, cu);
#pragma unroll
            for (int t = 0; t < TS; t += 2) {
                Rnd nx = cu;
                if (t + 2 < TS) SC_FETCH(t + 2, nx);
                const f32x4 p1 = S * cu.a, p2 = S * cu.aw;
                float u1 = (p1.x + p1.y) + (p1.z + p1.w), u2 = (p2.x + p2.y) + (p2.z + p2.w);
                RED4(u1, u2, yra, yrb);
                if (t > 0) { ykeep = (q == ((t - 2) & 15)) ? yra : ykeep; ykeep = (q == ((t - 1) & 15)) ? yrb : ykeep;
                             if (((t - 1) & 15) == 15) yb[(t - 16) * 8] = (unsigned short)f2bf(ykeep); }
                const float sa0 = u1, sa1 = u2 + sa0 * cu.be + cu.v0 * cu.ga;
                S = S * cu.w0 + (cu.b0 * sa0 + cu.k0 * cu.v0);
                const f32x4 y4a = S * cu.r0;
                S = S * cu.w1 + (cu.b1 * sa1 + cu.k1 * cu.v1);
                const f32x4 y4b = S * cu.r1;
                yra = (y4a.x + y4a.y) + (y4a.z + y4a.w); yrb = (y4b.x + y4b.y) + (y4b.z + y4b.w);
                cu = nx;
            }
            { float d0_ = 0.f, d1_ = 0.f; RED4(yra, yrb, d0_, d1_);
              ykeep = (q == 14) ? yra : ykeep; ykeep = (q == 15) ? yrb : ykeep; yb[16 * 8] = (unsigned short)f2bf(ykeep); }
#undef RED4
#undef RED_STEP0
#undef RED_STEP
#undef SC_FETCH
        }
        if (c + 1 < NCH) { if (par == 0) SC_STORE(1, g0); else SC_STORE(0, g1); }
        __syncthreads();
        if (F.tid < 32) { const v4u yv = *(const LAS v4u*)(L + YB_OFF + bf * 512 + F.tid * 16);
            *(v4u*)(Y + (rowb + (size_t)c * TS + F.tid) * D + col0 + part * 8) = yv; }
      }
    }
#undef SC_LOAD
#undef SC_STORE
}

__device__ __forceinline__ void kmean_phase(Frame& F, const bf16* Kb, float* KM) {
    LAS float* red = (LAS float*)(F.lds + RING_OFF);
    for (int u = blockIdx.x; u < 2 * 32 * 4; u += F.G) {
        const int qc = u & 3, blk = (u >> 2) & 31, b = u >> 7; const int c = F.tid & 255, rh = F.tid >> 8;
        const bf16* p = Kb + ((size_t)b * T + blk * 256 + rh * 128) * D + qc * 256 + c; float s = 0.f;
#pragma unroll 8
        for (int r = 0; r < 128; ++r) s += bf2f(p[(size_t)r * D]);
        if (rh == 1) red[c] = s;
        __syncthreads();
        if (rh == 0) { const int col = qc * 256 + c; KM[(((size_t)b * H + (col >> 6)) * 32 + blk) * 64 + (col & 63)] = (s + red[c]) * (1.f / 256.f); }
        __syncthreads();
    }
}
__device__ __forceinline__ void gate_phase(Frame& F, const bf16* Q, const float* KM, unsigned* SEL) {
    LAS float* km = (LAS float*)(F.lds + RING_OFF);
    for (int u = blockIdx.x; u < M / 64; u += F.G) {
        const int m0 = u * 64, b = m0 / T, own = (m0 % T) >> 8;
        for (int i = F.tid; i < 16 * 32 * 16; i += NWAVES * 64) *(LAS f32x4*)(km + 4 * i) = *(const f32x4*)(KM + (size_t)b * 16 * 32 * 64 + 4 * i);
        __syncthreads();
        const int m = m0 + F.lane;
#pragma unroll 1
        for (int hi = 0; hi < 2; ++hi) { const int h = 2 * F.wave + hi;
            float qv[64];
#pragma unroll
            for (int i = 0; i < 8; ++i) { const v4u w = *(const v4u*)(Q + (size_t)m * D + h * 64 + 8 * i);
                qv[8 * i + 0] = __uint_as_float(w.x << 16); qv[8 * i + 1] = __uint_as_float(w.x & 0xffff0000u); qv[8 * i + 2] = __uint_as_float(w.y << 16); qv[8 * i + 3] = __uint_as_float(w.y & 0xffff0000u);
                qv[8 * i + 4] = __uint_as_float(w.z << 16); qv[8 * i + 5] = __uint_as_float(w.z & 0xffff0000u); qv[8 * i + 6] = __uint_as_float(w.w << 16); qv[8 * i + 7] = __uint_as_float(w.w & 0xffff0000u); }
            float v0 = -INFINITY, v1 = -INFINITY, v2 = -INFINITY; int i0 = -1, i1 = -1, i2 = -1;
            for (int j = 0; j < own; ++j) { const LAS f32x4* kp = (const LAS f32x4*)(km + (h * 32 + j) * 64); float s = 0.f;
#pragma unroll
                for (int i = 0; i < 16; ++i) { const f32x4 kv = kp[i]; s += qv[4 * i] * kv.x + qv[4 * i + 1] * kv.y + qv[4 * i + 2] * kv.z + qv[4 * i + 3] * kv.w; }
                if (s > v0) { v2 = v1; i2 = i1; v1 = v0; i1 = i0; v0 = s; i0 = j; } else if (s > v1) { v2 = v1; i2 = i1; v1 = s; i1 = j; } else if (s > v2) { v2 = s; i2 = j; } }
            unsigned mask = 0u; if (i0 >= 0) mask |= 1u << i0; if (i1 >= 0) mask |= 1u << i1; if (i2 >= 0) mask |= 1u << i2;
            SEL[((size_t)b * H + h) * T + (m % T)] = mask; }
        __syncthreads();
    }
}

__device__ __forceinline__ void moe_prefix(Frame& F, const int* blkcnt, LAS int* pre_mine  ) {
    LAS int* tmp = (LAS int*)(F.lds + RING_OFF);
    for (int i = F.tid; i < F.G * 8; i += NWAVES * 64) tmp[i] = blkcnt[i];
    __syncthreads();
    if (F.tid < 8) { int tot = 0, mine = 0; for (int g = 0; g < F.G; ++g) { if (g == (int)blockIdx.x) mine = tot; tot += tmp[g * 8 + F.tid]; }
        pre_mine[F.tid] = mine; pre_mine[8 + F.tid] = tot; }
    __syncthreads();
    if (F.tid == 0) { int p = 0; for (int e = 0; e < 8; ++e) { F.MISC[16 + e] = (unsigned)p; p += (pre_mine[8 + e] + 255) >> 8; } F.MISC[24] = (unsigned)p; }
    __syncthreads();
}
__device__ __forceinline__ void moe_gather_phase(Frame& F, const int* blkcnt, const int* toke, const float* tokw, int* tokr, float* gw, const float* Hs, unsigned char* XG) {
    LAS int* pm = (LAS int*)(F.lds + RING_OFF + 16384);
    LAS int* rows = (LAS int*)(F.lds + RING_OFF + 16384 + 64);
    moe_prefix(F, blkcnt, pm);
    const int rpb = M / F.G;
    if (F.wave == 0) {
        const int m = blockIdx.x * rpb + F.lane; const bool ok = F.lane < rpb;
        const int e0 = ok ? toke[2 * m] : -1, e1 = ok ? toke[2 * m + 1] : -1;
        int r0 = 0, r1 = 0;
        for (int e = 0; e < 8; ++e) { const unsigned long long b0 = __ballot(e0 == e), b1 = __ballot(e1 == e); const unsigned long long lt = (1ull << F.lane) - 1ull;
            const int base = (int)F.MISC[16 + e] * 256 + pm[e];
            if (e0 == e) r0 = base + __popcll(b0 & lt);
            if (e1 == e) r1 = base + __popcll(b0) + __popcll(b1 & lt); }
        if (ok) { tokr[2 * m] = r0; tokr[2 * m + 1] = r1; gw[r0] = tokw[2 * m]; gw[r1] = tokw[2 * m + 1]; rows[2 * F.lane] = r0; rows[2 * F.lane + 1] = r1; }
    }
    __syncthreads();
    for (int i = F.wave; i < 2 * rpb; i += NWAVES) { const int m = blockIdx.x * rpb + (i >> 1), r = rows[i];
        const f32x4* s = (const f32x4*)(Hs + (size_t)m * D + 16 * F.lane); const f32x4 a = s[0], b_ = s[1], c = s[2], d = s[3];
        v4u o; int w;
        w = __builtin_amdgcn_cvt_pk_fp8_f32(a.x, a.y, 0, false); w = __builtin_amdgcn_cvt_pk_fp8_f32(a.z, a.w, w, true); o.x = (unsigned)w;
        w = __builtin_amdgcn_cvt_pk_fp8_f32(b_.x, b_.y, 0, false); w = __builtin_amdgcn_cvt_pk_fp8_f32(b_.z, b_.w, w, true); o.y = (unsigned)w;
        w = __builtin_amdgcn_cvt_pk_fp8_f32(c.x, c.y, 0, false); w = __builtin_amdgcn_cvt_pk_fp8_f32(c.z, c.w, w, true); o.z = (unsigned)w;
        w = __builtin_amdgcn_cvt_pk_fp8_f32(d.x, d.y, 0, false); w = __builtin_amdgcn_cvt_pk_fp8_f32(d.z, d.w, w, true); o.w = (unsigned)w;
        *(v4u*)(XG + (size_t)r * D + 16 * F.lane) = o; }
    __syncthreads();
}
__device__ __forceinline__ void attn_direct_phase(Frame& F, const bf16* Q, const bf16* Kb, const bf16* Vb, const unsigned* SEL, bf16* O) {
    for (int u = F.gw; u < (M / 64) * H; u += F.NGW) {
        const int h = u & 15, m0 = (u >> 4) * 64, b = m0 / T, t0 = m0 % T, own = t0 >> 8, m = m0 + F.lane, tpos = t0 + F.lane;
        float q[64], o[64];
#pragma unroll
        for (int i = 0; i < 8; ++i) { const v4u w = *(const v4u*)(Q + (size_t)m * D + h * 64 + 8 * i);
            q[8 * i + 0] = __uint_as_float(w.x << 16); q[8 * i + 1] = __uint_as_float(w.x & 0xffff0000u); q[8 * i + 2] = __uint_as_float(w.y << 16); q[8 * i + 3] = __uint_as_float(w.y & 0xffff0000u);
            q[8 * i + 4] = __uint_as_float(w.z << 16); q[8 * i + 5] = __uint_as_float(w.z & 0xffff0000u); q[8 * i + 6] = __uint_as_float(w.w << 16); q[8 * i + 7] = __uint_as_float(w.w & 0xffff0000u); }
#pragma unroll
        for (int i = 0; i < 64; ++i) o[i] = 0.f;
        const unsigned sel = SEL[((size_t)b * H + h) * T + tpos];
        float mrun = -INFINITY, l = 0.f;
        for (int j = 0; j <= own; ++j) {
            const bool pastsel = (sel >> j) & 1u;
            if (j < own && !__any(pastsel)) continue;
            const int nk = (j < own) ? 256 : (t0 & 255) + 64;
            for (int kk = 0; kk < nk; ++kk) {
                const int kpos = j * 256 + kk; const size_t ro = ((size_t)b * T + kpos) * D + h * 64;
                float s = 0.f;
#pragma unroll
                for (int i = 0; i < 8; ++i) { const v4u w = *(const v4u*)(Kb + ro + 8 * i);
                    s += q[8 * i + 0] * __uint_as_float(w.x << 16) + q[8 * i + 1] * __uint_as_float(w.x & 0xffff0000u) + q[8 * i + 2] * __uint_as_float(w.y << 16) + q[8 * i + 3] * __uint_as_float(w.y & 0xffff0000u)
                       + q[8 * i + 4] * __uint_as_float(w.z << 16) + q[8 * i + 5] * __uint_as_float(w.z & 0xffff0000u) + q[8 * i + 6] * __uint_as_float(w.w << 16) + q[8 * i + 7] * __uint_as_float(w.w & 0xffff0000u); }
                const bool act = (j < own) ? pastsel : (kpos <= tpos);
                if (act) {
                    if (s > mrun) { const float c = exp2f(mrun - s); l *= c;
#pragma unroll
                        for (int i = 0; i < 64; ++i) o[i] *= c;
                        mrun = s; }
                    const float p = exp2f(s - mrun); l += p;
#pragma unroll
                    for (int i = 0; i < 8; ++i) { const v4u w = *(const v4u*)(Vb + ro + 8 * i);
                        o[8 * i + 0] += p * __uint_as_float(w.x << 16); o[8 * i + 1] += p * __uint_as_float(w.x & 0xffff0000u); o[8 * i + 2] += p * __uint_as_float(w.y << 16); o[8 * i + 3] += p * __uint_as_float(w.y & 0xffff0000u);
                        o[8 * i + 4] += p * __uint_as_float(w.z << 16); o[8 * i + 5] += p * __uint_as_float(w.z & 0xffff0000u); o[8 * i + 6] += p * __uint_as_float(w.w << 16); o[8 * i + 7] += p * __uint_as_float(w.w & 0xffff0000u); }
                }
            }
        }
        const float rl = 1.0f / l;
#pragma unroll
        for (int i = 0; i < 8; ++i) { v4u w; w.x = pk2(o[8 * i] * rl, o[8 * i + 1] * rl); w.y = pk2(o[8 * i + 2] * rl, o[8 * i + 3] * rl); w.z = pk2(o[8 * i + 4] * rl, o[8 * i + 5] * rl); w.w = pk2(o[8 * i + 6] * rl, o[8 * i + 7] * rl);
            *(v4u*)(O + (size_t)m * D + h * 64 + 8 * i) = w; }
    }
}
namespace moba {
using attn_body::f32x16; using attn_body::crow;
constexpr int L_K = 0, L_V = 32768, L_LIST = 65536, L_WS = 81920, L_CTL = 84992;
__device__ __forceinline__ void qkt_l(f32x16& p0, f32x16& p1, const LAS unsigned char* Kslot, const bf16x8* qr, int r32, int hi) {
    const LAS unsigned char* kb = Kslot + hi * 1024 + r32 * 16;
#pragma unroll
    for (int d0 = 0; d0 < 4; ++d0) {
        const bf16x8 b0 = *(const LAS bf16x8*)(kb + d0 * 2048), b1 = *(const LAS bf16x8*)(kb + d0 * 2048 + 512);
        if (d0 == 0) { p0 = __builtin_amdgcn_mfma_f32_32x32x16_bf16(b0, qr[0], f32x16{}, 0, 0, 0); p1 = __builtin_amdgcn_mfma_f32_32x32x16_bf16(b1, qr[0], f32x16{}, 0, 0, 0); }
        else { p0 = __builtin_amdgcn_mfma_f32_32x32x16_bf16(b0, qr[d0], p0, 0, 0, 0); p1 = __builtin_amdgcn_mfma_f32_32x32x16_bf16(b1, qr[d0], p1, 0, 0, 0); } }
}
__device__ __forceinline__ float half_max(float v) { auto rr = __builtin_amdgcn_permlane32_swap(__float_as_uint(v), __float_as_uint(v), false, false); return fmaxf(__uint_as_float(rr[0]), __uint_as_float(rr[1])); }
__device__ __forceinline__ float half_sum(float v) { auto rr = __builtin_amdgcn_permlane32_swap(__float_as_uint(v), __float_as_uint(v), false, false); return __uint_as_float(rr[0]) + __uint_as_float(rr[1]); }
}
__device__ __forceinline__ void moba_attn_phase(Frame& F, const bf16* Q, const bf16* Kb, const bf16* Vb, const unsigned* SELT, bf16* PO, float* ML, gu32* qctr) {
    using namespace moba;
    const int lane = F.lane, wid = F.wave, r32 = lane & 31, hi = lane >> 5;
    LAS unsigned char* L = F.lds + RING_OFF;
    LAS unsigned short* list = (LAS unsigned short*)(L + L_LIST);
    LAS float* wsf = (LAS float*)(L + L_WS + wid * 256); LAS int* wsd = (LAS int*)(L + L_WS + wid * 256 + 128);
    LAS int* ctl = (LAS int*)(L + L_CTL);
    const int vb0 = RING_OFF + L_V + ((lane >> 4) & 1) * 32 + (lane & 3) * 8 + (4 * hi + ((lane & 15) >> 2)) * 64;
    for (;;) {
        __syncthreads();
        if (F.tid == 0) { ctl[0] = (int)__hip_atomic_fetch_add(qctr, 1u, __ATOMIC_RELAXED, __HIP_MEMORY_SCOPE_AGENT); ctl[1] = 0; }
        __syncthreads();
        const int u = __builtin_amdgcn_readfirstlane(ctl[0]);
        if (u >= 32 * 32) break;
        const int j = u >> 5, bh = u & 31, b = bh >> 4, h = bh & 15;
        const size_t rowb = (size_t)b * T;
        { const bf16* ksrc = Kb + (rowb + 256 * j + lane) * D + h * 64 + wid * 8;
          const bf16* vsrc = Vb + (rowb + 256 * j + 16 * (wid & 3) + (lane >> 2)) * D + h * 64 + (wid >> 2) * 32 + (lane & 3) * 8;
#pragma unroll
          for (int kt = 0; kt < 4; ++kt) { attn_body::glds16(ksrc + (size_t)kt * 64 * D, (unsigned)__builtin_amdgcn_readfirstlane(RING_OFF + L_K + kt * 8192 + wid * 1024));
                                           attn_body::glds16(vsrc + (size_t)kt * 64 * D, (unsigned)__builtin_amdgcn_readfirstlane(RING_OFF + L_V + kt * 8192 + wid * 1024)); } }
        const unsigned* selrow = SELT + (size_t)bh * T;
        for (int t0 = 256 * (j + 1); t0 < T; t0 += NWAVES * 64) { const int t = t0 + F.tid; const bool in = t < T;
            const bool p = in && ((selrow[in ? t : 0] >> j) & 1u);
            const unsigned long long bal = __ballot(p); const int np = __popcll(bal);
            int base = 0; if (lane == 0 && np) base = __hip_atomic_fetch_add(&ctl[1], np, __ATOMIC_RELAXED, __HIP_MEMORY_SCOPE_WORKGROUP);
            base = __builtin_amdgcn_readfirstlane(base);
            if (p) list[base + __popcll(bal & ((1ull << lane) - 1ull))] = (unsigned short)t; }
        asm volatile("s_waitcnt vmcnt(0) lgkmcnt(0)" ::: "memory");
        __syncthreads();
        const int total = 256 + ctl[1], nb = (total + 31) >> 5;
        for (int bi = wid; bi < nb; bi += NWAVES) {
            const int item = bi * 32 + r32; const bool valid = item < total; const int it2 = valid ? item : total - 1;
            const bool ownb = bi < 8;
            const int t = it2 < 256 ? 256 * j + it2 : (int)list[it2 - 256];
            const bf16* qrow = Q + (rowb + t) * D + h * 64;
            bf16x8 qr[4];
#pragma unroll
            for (int d0 = 0; d0 < 4; ++d0) qr[d0] = *(const bf16x8*)(qrow + d0 * 16 + hi * 8);
            f32x16 P[4][2];
#pragma unroll
            for (int kt = 0; kt < 4; ++kt) qkt_l(P[kt][0], P[kt][1], L + L_K + kt * 8192, qr, r32, hi);
            if (ownb) {
#pragma unroll
                for (int kt = 0; kt < 4; ++kt) attn_body::cmask(P[kt][0], P[kt][1], kt, t - 256 * j, hi); }
            float mx = -INFINITY;
#pragma unroll
            for (int kt = 0; kt < 4; ++kt)
#pragma unroll
                for (int r = 0; r < 16; ++r) mx = fmaxf(mx, fmaxf(P[kt][0][r], P[kt][1][r]));
            mx = half_max(mx);
            float ls = 0.f;
#pragma unroll
            for (int kt = 0; kt < 4; ++kt)
#pragma unroll
                for (int r = 0; r < 16; ++r) { P[kt][0][r] = __builtin_amdgcn_exp2f(P[kt][0][r] - mx); P[kt][1][r] = __builtin_amdgcn_exp2f(P[kt][1][r] - mx); ls += P[kt][0][r] + P[kt][1][r]; }
            ls = half_sum(ls);
            f32x16 o[2]; o[0] = f32x16{}; o[1] = f32x16{};
#pragma unroll
            for (int kt = 0; kt < 4; ++kt) {
                attn_body::u32x4 w0, w1, w2, w3;
#define PKW_(P_, B_) attn_body::cvtpk_s(P_[B_], P_[B_ + 1])
                w0 = (attn_body::u32x4){PKW_(P[kt][0], 0), PKW_(P[kt][0], 2), PKW_(P[kt][0], 4), PKW_(P[kt][0], 6)}; w1 = (attn_body::u32x4){PKW_(P[kt][0], 8), PKW_(P[kt][0], 10), PKW_(P[kt][0], 12), PKW_(P[kt][0], 14)};
                w2 = (attn_body::u32x4){PKW_(P[kt][1], 0), PKW_(P[kt][1], 2), PKW_(P[kt][1], 4), PKW_(P[kt][1], 6)}; w3 = (attn_body::u32x4){PKW_(P[kt][1], 8), PKW_(P[kt][1], 10), PKW_(P[kt][1], 12), PKW_(P[kt][1], 14)};
#undef PKW_
                attn_body::pv(o, vb0 + kt * 8192, __builtin_bit_cast(bf16x8, w0), __builtin_bit_cast(bf16x8, w1), __builtin_bit_cast(bf16x8, w2), __builtin_bit_cast(bf16x8, w3)); }
            const unsigned sel = selrow[t];
            const int slot = ownb ? 3 : __popc(sel & ((1u << j) - 1u));
            const int dest = (int)(((rowb + t) * H + h) * 4 + slot);
            if (hi == 0) { wsf[r32] = 1.0f / ls; wsd[r32] = valid ? dest : -1; if (valid) { ML[(size_t)dest * 2] = mx; ML[(size_t)dest * 2 + 1] = ls; } }
            asm volatile("s_waitcnt lgkmcnt(0)" ::: "memory");
#pragma unroll
            for (int r = 0; r < 16; ++r) { const int row = crow(r, hi); const float rl = wsf[row]; const int d = wsd[row];
                if (d >= 0) { PO[(size_t)d * 64 + r32] = (bf16)f2bf(o[0][r] * rl); PO[(size_t)d * 64 + 32 + r32] = (bf16)f2bf(o[1][r] * rl); } }
            asm volatile("s_waitcnt lgkmcnt(0)" ::: "memory");
        }
    }
}
__device__ __forceinline__ void moba_combine_phase(Frame& F, const unsigned* SELT, const bf16* PO, const float* ML, bf16* O) {
    for (int m = F.gw; m < M; m += F.NGW) {
        const int b = m / T, t = m % T, h = F.lane >> 2, qd = F.lane & 3;
        const unsigned sel = SELT[((size_t)b * H + h) * T + t]; const int cnt = __popc(sel);
        const size_t base = ((size_t)m * H + h) * 4;
        float ms[4], ls[4]; float mstar = -INFINITY;
#pragma unroll
        for (int s = 0; s < 4; ++s) { const bool on = (s == 3) || (s < cnt); ms[s] = on ? ML[(base + s) * 2] : -INFINITY; ls[s] = on ? ML[(base + s) * 2 + 1] : 0.f; mstar = fmaxf(mstar, ms[s]); }
        float wsum = 0.f, w[4];
#pragma unroll
        for (int s = 0; s < 4; ++s) { w[s] = ls[s] * __builtin_amdgcn_exp2f(ms[s] - mstar); wsum += w[s]; }
        const float rw = 1.0f / wsum;
        float acc[16];
#pragma unroll
        for (int i = 0; i < 16; ++i) acc[i] = 0.f;
#pragma unroll
        for (int s = 0; s < 4; ++s) { const bool on = (s == 3) || (s < cnt);
            if (on) { const float ws_ = w[s] * rw; const v4u a = *(const v4u*)(PO + (base + s) * 64 + qd * 16), c = *(const v4u*)(PO + (base + s) * 64 + qd * 16 + 8);
                const unsigned wv[8] = {a.x, a.y, a.z, a.w, c.x, c.y, c.z, c.w};
#pragma unroll
                for (int i = 0; i < 8; ++i) { acc[2 * i] += ws_ * __uint_as_float(wv[i] << 16); acc[2 * i + 1] += ws_ * __uint_as_float(wv[i] & 0xffff0000u); } } }
        v4u o0, o1; o0.x = pk2(acc[0], acc[1]); o0.y = pk2(acc[2], acc[3]); o0.z = pk2(acc[4], acc[5]); o0.w = pk2(acc[6], acc[7]); o1.x = pk2(acc[8], acc[9]); o1.y = pk2(acc[10], acc[11]); o1.z = pk2(acc[12], acc[13]); o1.w = pk2(acc[14], acc[15]);
        *(v4u*)(O + (size_t)m * D + h * 64 + qd * 16) = o0; *(v4u*)(O + (size_t)m * D + h * 64 + qd * 16 + 8) = o1;
    }
}
constexpr int WK_REC = 10496;
__device__ __forceinline__ void wkv_build_phase(Frame& F, const bf16* R, const float* DEC, const bf16* KP, const bf16* AP, const bf16* BP, unsigned char* REC0, unsigned char* REC1) {
    LAS unsigned char* L = F.lds + RING_OFF + F.wave * 16384;
    LAS unsigned short* tA = (LAS unsigned short*)L; LAS unsigned short* tB = tA + 1024; LAS unsigned short* tK = tA + 2048; LAS unsigned short* tR = tA + 3072;
    LAS float* fLab = (LAS float*)(L + 8192); LAS float* fLak = fLab + 256; LAS float* fT = fLab + 512;
    const int lane = F.lane, c = lane & 15, g = lane >> 4;
    float rw[16]; unsigned short rk[16], ra[16], rb[16], rr_[16];
#define WB_LOAD(u_) do { const int ch_ = (u_) & 511, bh_ = (u_) >> 9; const size_t base_ = ((size_t)(bh_ >> 4) * T + (size_t)ch_ * 16) * D + (bh_ & 15) * 64 + lane; \
        _Pragma("unroll") for (int t = 0; t < 16; ++t) { const size_t o = base_ + (size_t)t * D; rw[t] = DEC[o]; rk[t] = KP[o]; ra[t] = AP[o]; rb[t] = BP[o]; rr_[t] = R[o]; } } while (0)
    if (F.gw < 2 * H * 512) WB_LOAD(F.gw);
    for (int u = F.gw; u < 2 * H * 512; u += F.NGW) {
        const int ch = u & 511, bh = u >> 9, b = bh >> 4, h = bh & 15;
        unsigned char* rec = (b ? REC1 : REC0) + ((size_t)h * 512 + ch) * WK_REC;
        float Af[16], Bf[16], Kf[16], Rf[16]; float gm = 1.f;
#pragma unroll
        for (int t = 0; t < 16; ++t) {
            const float w = rw[t], kp = bf2f(rk[t]), ap = bf2f(ra[t]), bp = bf2f(rb[t]), rr = bf2f(rr_[t]);
            Af[t] = ap * gm; gm *= w; const float inv = __builtin_amdgcn_rcpf(gm); Bf[t] = bp * inv; Kf[t] = kp * inv; Rf[t] = rr * gm;
            tA[t * 64 + lane] = (unsigned short)f2bf(Af[t]); tB[t * 64 + lane] = (unsigned short)f2bf(Bf[t]); tK[t * 64 + lane] = (unsigned short)f2bf(Kf[t]); tR[t * 64 + lane] = (unsigned short)f2bf(Rf[t]); }
        if (u + F.NGW < 2 * H * 512) WB_LOAD(u + F.NGW);
        *(float*)(rec + 10240 + lane * 4) = gm;
#pragma unroll
        for (int gq = 0; gq < 4; ++gq) { v4u o; o.x = pk2(Bf[4 * gq], Bf[4 * gq + 1]); o.y = pk2(Bf[4 * gq + 2], Bf[4 * gq + 3]); o.z = pk2(Kf[4 * gq], Kf[4 * gq + 1]); o.w = pk2(Kf[4 * gq + 2], Kf[4 * gq + 3]);
            *(v4u*)(rec + 6144 + lane * 64 + gq * 16) = o; }
        LDS_WAIT(); asm volatile("" ::: "memory");
        pg8::f32x4 lab = {0.f, 0.f, 0.f, 0.f}, lak = lab, mrb = lab, mrk = lab;
#pragma unroll
        for (int s = 0; s < 2; ++s) { const int o = c * 64 + 8 * g + 32 * s;
            const bf16x8 fa = *(const LAS bf16x8*)(tA + o), fb = *(const LAS bf16x8*)(tB + o), fk = *(const LAS bf16x8*)(tK + o), fr = *(const LAS bf16x8*)(tR + o);
            lab = __builtin_amdgcn_mfma_f32_16x16x32_bf16(fa, fb, lab, 0, 0, 0); lak = __builtin_amdgcn_mfma_f32_16x16x32_bf16(fa, fk, lak, 0, 0, 0);
            mrb = __builtin_amdgcn_mfma_f32_16x16x32_bf16(fr, fb, mrb, 0, 0, 0); mrk = __builtin_amdgcn_mfma_f32_16x16x32_bf16(fr, fk, mrk, 0, 0, 0); }
#pragma unroll
        for (int r = 0; r < 4; ++r) { const int t = 4 * g + r; if (!(c < t)) { lab[r] = 0.f; lak[r] = 0.f; } if (!(c <= t)) { mrb[r] = 0.f; mrk[r] = 0.f; }
            fLab[t * 16 + c] = lab[r]; fLak[t * 16 + c] = lak[r]; }
        LDS_WAIT(); asm volatile("" ::: "memory");
        float Tc[16];
#pragma unroll
        for (int i = 0; i < 16; ++i) { float a_ = (i == c) ? 1.f : 0.f;
#pragma unroll
            for (int j = 0; j < i; ++j) a_ += fLab[i * 16 + j] * Tc[j];
            Tc[i] = a_; }
        if (g == 0) {
#pragma unroll
            for (int i = 0; i < 16; ++i) fT[i * 16 + c] = Tc[i]; }
        LDS_WAIT(); asm volatile("" ::: "memory");
        { const int kt = lane >> 4, gq = (lane >> 2) & 3, jj = lane & 3, slot = (kt >> 1) * 1024 + gq * 16 + (jj + 4 * (kt & 1)) * 2;
#pragma unroll
          for (int t = 0; t < 16; ++t) { float w_ = 0.f;
#pragma unroll
              for (int j = 0; j <= t; ++j) w_ += fT[t * 16 + j] * Af[j];
              *(unsigned short*)(rec + slot + t * 64) = (unsigned short)f2bf(w_); *(unsigned short*)(rec + 3072 + slot + t * 64) = (unsigned short)f2bf(Rf[t]); } }
        { const int gq = c >> 2, jq = c & 3;
#pragma unroll
          for (int r = 0; r < 4; ++r) { const int t = 4 * g + r; float tl = 0.f;
#pragma unroll
              for (int j = 0; j < 16; ++j) tl += fT[t * 16 + j] * fLak[j * 16 + c];
              unsigned char* p = rec + 2048 + t * 64 + gq * 16;
              *(unsigned short*)(p + jq * 2) = (unsigned short)f2bf(tl); *(unsigned short*)(p + 8 + jq * 2) = 0;
              *(unsigned short*)(p + 3072 + jq * 2) = (unsigned short)f2bf(mrb[r]); *(unsigned short*)(p + 3072 + 8 + jq * 2) = (unsigned short)f2bf(mrk[r]); } }
        LDS_WAIT(); asm volatile("" ::: "memory");
    }
#undef WB_LOAD
}
__device__ __forceinline__ void wkv_chain_phase(Frame& F, const unsigned char* REC0, const unsigned char* REC1, const bf16* VP, bf16* Y) {
    if (F.vcu >= 32) return;
    constexpr int GC = 4, GB = GC * WK_REC  , VBOFF = GB, BUFB = GB + 8192  , YB_OFF = 2 * BUFB, NG = 512 / GC;
    const int b = F.vcu >> 4, h = F.vcu & 15, lane = F.lane, c = lane & 15, g = lane >> 4, vt = F.wave;
    const unsigned char* rbase = (b ? REC1 : REC0) + (size_t)h * 512 * WK_REC; const size_t rowb = (size_t)b * T;
    LAS unsigned char* L = F.lds + RING_OFF;
    constexpr int NP = (GB / 16 + 511) / 512;
    struct Stg { v4u p[NP]; v4u v; };
    Stg g0, g1;
#define WK_LOAD(gi, G) do { const unsigned char* s_ = rbase + (size_t)(gi) * GB; _Pragma("unroll") for (int i = 0; i < NP; ++i) { const int o_ = (F.tid + i * 512) * 16; if (o_ < GB) G.p[i] = *(const v4u*)(s_ + o_); } \
        G.v = *(const v4u*)(VP + (rowb + (size_t)(gi) * 64 + (F.tid >> 3)) * D + h * 64 + (F.tid & 7) * 8); } while (0)
#define WK_STORE(bf, G) do { _Pragma("unroll") for (int i = 0; i < NP; ++i) { const int o_ = (F.tid + i * 512) * 16; if (o_ < GB) *(LAS v4u*)(L + (bf) * BUFB + o_) = G.p[i]; } \
        { const int t_ = F.tid >> 3, v0_ = (F.tid & 7) * 8; LAS unsigned short* d_ = (LAS unsigned short*)(L + (bf) * BUFB + VBOFF) + ((((t_ >> 4) * 4) * 4 + ((t_ >> 2) & 3)) * 16) * 4 + (t_ & 3); \
          const unsigned w_[4] = {G.v.x, G.v.y, G.v.z, G.v.w}; \
          _Pragma("unroll") for (int e = 0; e < 8; ++e) { const int v_ = v0_ + e; d_[((v_ >> 4) * 64 + (v_ & 15)) * 4] = (unsigned short)((e & 1) ? (w_[e >> 1] >> 16) : (w_[e >> 1] & 0xffffu)); } } } while (0)
    WK_LOAD(0, g0); WK_STORE(0, g0); WK_LOAD(1, g0); __syncthreads();
    pg8::f32x4 Hs[4]; Hs[0] = (pg8::f32x4){0.f, 0.f, 0.f, 0.f}; Hs[1] = Hs[0]; Hs[2] = Hs[0]; Hs[3] = Hs[0];
    for (int g2 = 0; g2 < NG; g2 += 2) {
#pragma unroll
      for (int par = 0; par < 2; ++par) {
        const int gi = g2 + par, bf = par;
        if (gi + 2 < NG) { if (par == 0) WK_LOAD(gi + 2, g1); else WK_LOAD(gi + 2, g0); }
        if (F.wave < 4) {
            struct Ops { bf16x8 au0, au1, au2, ay0, ay1, ay2, bk0, bk1, bk2, bk3; pg8::f32x4 ga0, ga1, ga2, ga3; u32x2 vb; };
            const int ao = (c * 32 + g * 8) * 2;
#define WK_FETCH(ci_, X) do { const LAS unsigned char* rec_ = L + bf * BUFB + (ci_) * WK_REC; \
                X.au0 = *(const LAS bf16x8*)(rec_ + ao); X.au1 = *(const LAS bf16x8*)(rec_ + 1024 + ao); X.au2 = *(const LAS bf16x8*)(rec_ + 2048 + ao); \
                X.ay0 = *(const LAS bf16x8*)(rec_ + 3072 + ao); X.ay1 = *(const LAS bf16x8*)(rec_ + 4096 + ao); X.ay2 = *(const LAS bf16x8*)(rec_ + 5120 + ao); \
                X.bk0 = *(const LAS bf16x8*)(rec_ + 6144 + ao); X.bk1 = *(const LAS bf16x8*)(rec_ + 7168 + ao); X.bk2 = *(const LAS bf16x8*)(rec_ + 8192 + ao); X.bk3 = *(const LAS bf16x8*)(rec_ + 9216 + ao); \
                X.ga0 = *(const LAS pg8::f32x4*)(rec_ + 10240 + (4 * g) * 4); X.ga1 = *(const LAS pg8::f32x4*)(rec_ + 10240 + (16 + 4 * g) * 4); X.ga2 = *(const LAS pg8::f32x4*)(rec_ + 10240 + (32 + 4 * g) * 4); X.ga3 = *(const LAS pg8::f32x4*)(rec_ + 10240 + (48 + 4 * g) * 4); \
                X.vb = *(const LAS u32x2*)(L + bf * BUFB + VBOFF + (((((ci_) * 4 + vt) * 4 + g) * 16 + c) * 8)); } while (0)
            Ops cu; WK_FETCH(0, cu);
#pragma unroll
            for (int ci = 0; ci < GC; ++ci) {
                Ops nx = cu;
                if (ci + 1 < GC) WK_FETCH(ci + 1, nx);
                v4u h0, h1; h0.x = attn_body::cvtpk_s(Hs[0][0], Hs[0][1]); h0.y = attn_body::cvtpk_s(Hs[0][2], Hs[0][3]); h0.z = attn_body::cvtpk_s(Hs[1][0], Hs[1][1]); h0.w = attn_body::cvtpk_s(Hs[1][2], Hs[1][3]);
                h1.x = attn_body::cvtpk_s(Hs[2][0], Hs[2][1]); h1.y = attn_body::cvtpk_s(Hs[2][2], Hs[2][3]); h1.z = attn_body::cvtpk_s(Hs[3][0], Hs[3][1]); h1.w = attn_body::cvtpk_s(Hs[3][2], Hs[3][3]);
                const bf16x8 hb0 = __builtin_bit_cast(bf16x8, h0), hb1 = __builtin_bit_cast(bf16x8, h1);
                v4u vz; vz.x = cu.vb.x; vz.y = cu.vb.y; vz.z = 0u; vz.w = 0u;
                const pg8::f32x4 z4 = {0.f, 0.f, 0.f, 0.f};
                const pg8::f32x4 ua = __builtin_amdgcn_mfma_f32_16x16x32_bf16(cu.au0, hb0, z4, 0, 0, 0), ub_ = __builtin_amdgcn_mfma_f32_16x16x32_bf16(cu.au1, hb1, z4, 0, 0, 0),
                                 uc = __builtin_amdgcn_mfma_f32_16x16x32_bf16(cu.au2, __builtin_bit_cast(bf16x8, vz), z4, 0, 0, 0);
                pg8::f32x4 yt = __builtin_amdgcn_mfma_f32_16x16x32_bf16(cu.ay0, hb0, z4, 0, 0, 0);
                yt = __builtin_amdgcn_mfma_f32_16x16x32_bf16(cu.ay1, hb1, yt, 0, 0, 0);
                const pg8::f32x4 ut = (ua + ub_) + uc;
                v4u ubw; ubw.x = attn_body::cvtpk_s(ut[0], ut[1]); ubw.y = attn_body::cvtpk_s(ut[2], ut[3]); ubw.z = cu.vb.x; ubw.w = cu.vb.y;
                const bf16x8 ub = __builtin_bit_cast(bf16x8, ubw);
                Hs[0] = __builtin_amdgcn_mfma_f32_16x16x32_bf16(cu.bk0, ub, Hs[0], 0, 0, 0); Hs[1] = __builtin_amdgcn_mfma_f32_16x16x32_bf16(cu.bk1, ub, Hs[1], 0, 0, 0);
                Hs[2] = __builtin_amdgcn_mfma_f32_16x16x32_bf16(cu.bk2, ub, Hs[2], 0, 0, 0); Hs[3] = __builtin_amdgcn_mfma_f32_16x16x32_bf16(cu.bk3, ub, Hs[3], 0, 0, 0);
                yt = __builtin_amdgcn_mfma_f32_16x16x32_bf16(cu.ay2, ub, yt, 0, 0, 0);
                Hs[0] = Hs[0] * cu.ga0; Hs[1] = Hs[1] * cu.ga1; Hs[2] = Hs[2] * cu.ga2; Hs[3] = Hs[3] * cu.ga3;
                LAS unsigned short* yb = (LAS unsigned short*)(L + YB_OFF + bf * 8192) + (ci * 16 + 4 * g) * 64 + vt * 16 + c;
#pragma unroll
                for (int r = 0; r < 4; ++r) yb[r * 64] = (unsigned short)f2bf(yt[r]);
                cu = nx;
            }
#undef WK_FETCH
        }
        if (gi + 1 < NG) { if (par == 0) WK_STORE(1, g0); else WK_STORE(0, g1); }
        __syncthreads();
        { const v4u yv = *(const LAS v4u*)(L + YB_OFF + bf * 8192 + F.tid * 16);
          *(v4u*)(Y + (rowb + (size_t)gi * 64 + (F.tid >> 3)) * D + h * 64 + (F.tid & 7) * 8) = yv; }
      }
    }
#undef WK_LOAD
#undef WK_STORE
}


#ifdef DBG_CUT
__device__ __forceinline__ void dbg_copy(Frame& F, const void* src, bool is_bf16, float* out) {
    for (size_t i = (size_t)F.gw * 64 + F.lane; i < (size_t)M * D; i += (size_t)F.NGW * 64) out[i] = is_bf16 ? bf2f(((const bf16*)src)[i]) : ((const float*)src)[i];
}
#ifndef DBG_LAYER
#define DBG_LAYER -1
#endif
#ifndef DBG_SCALE
#define DBG_SCALE 100.f
#define DBG_SUB 1.f
#endif
#define CUT(k, off, isbf) if (DBG_CUT == (k) && (DBG_LAYER < 0 || layer == DBG_LAYER)) { unsigned char* ws = WSB(); dbg_copy(F, ws + (off), (isbf), GOUT()); return; }
#else
#define CUT(k, off, isbf)
#endif
#ifndef REP_GEMM
#define REP_GEMM 1
#endif
#ifndef REP_THIN
#define REP_THIN 1
#endif
#ifndef REP_CONV
#define REP_CONV REP_THIN
#endif
#ifndef REP_LN
#define REP_LN REP_THIN
#endif
#ifndef REP_RW
#define REP_RW REP_THIN
#endif
#ifndef REP_ATTN
#define REP_ATTN 1
#endif
#ifndef REP_SCAN
#define REP_SCAN 1
#endif
#ifndef REP_WKB
#define REP_WKB 1
#endif
#ifndef REP_WKC
#define REP_WKC 1
#endif
#ifndef REP_BAR
#define REP_BAR 1
#endif
#define GEMM_BIG(EpiT, SchedT) for (int rg_ = 0; rg_ < REP_GEMM; ++rg_) pg8::gemm_phase<EpiT, SchedT, true, true>
#define GEMM_ONE(EpiT, SchedT) for (int rg_ = 0; rg_ < REP_GEMM; ++rg_) pg8::gemm_phase<EpiT, SchedT, false, true>
__global__ void __launch_bounds__(NWAVES * 64, 2) fwd_kernel(Args args) {
    extern __shared__ __attribute__((aligned(16))) unsigned char lds[];
    Frame F;
    F.lds = (LAS unsigned char*)lds; F.MISC = (volatile LAS unsigned*)(F.lds + MISC_OFF);
    F.wave = __builtin_amdgcn_readfirstlane((int)threadIdx.x >> 6); F.lane = fresh_lane(); F.tid = F.wave * 64 + F.lane;
    F.G = gridDim.x; { const int bx = blockIdx.x; F.vcu = (F.G % 8 == 0) ? (bx % 8) * (F.G / 8) + bx / 8 : bx; }
    F.gw = F.vcu * NWAVES + F.wave; F.NGW = F.G * NWAVES;
    F.ws = args.ws; F.ctl = (gu32*)(args.ws + WS_CTL);
#ifdef DBG_LDSZERO
    for (int u = F.tid; u < LDS_BYTES / 4; u += NWAVES * 64) ((LAS unsigned*)(F.lds))[u] = 0u;
#else
    for (int u = F.tid; u < (LDS_BYTES - LDSCTL_OFF) / 4; u += NWAVES * 64) ((LAS unsigned*)(F.lds + LDSCTL_OFF))[u] = 0u;
#endif
    __syncthreads();
    XcdBarrier bar = xcd_barrier_post((unsigned*)(F.ctl + CW_BAR), F.MISC + 8, F.tid == 0);
#define GRID_BAR() do { { GAS unsigned* b_ = (GAS unsigned*)bar.bar; asm volatile("" : "+s"(b_), "+s"(bar.x)); bar.bar = (unsigned*)b_; } for (int rb_ = 0; rb_ < REP_BAR; ++rb_) xcd_barrier(bar, F.wave == 0 && fresh_lane() == 0); } while (0)
#define WSB() ({ F.lane = fresh_lane(); F.tid = F.wave * 64 + F.lane; asm volatile("" : "+s"(F.G), "+s"(F.wave), "+s"(F.vcu), "+s"(F.gw), "+s"(F.NGW), "+s"(bx)); GAS unsigned char* p_ = (GAS unsigned char*)args.ws; asm volatile("" : "+s"(p_)); (unsigned char*)p_; })
#define GOUT() ({ GAS float* o_ = (GAS float*)args.out; asm volatile("" : "+s"(o_)); (float*)o_; })
#define INP(i) ({ const __attribute__((address_space(4))) char* k_ = (const __attribute__((address_space(4))) char*)__builtin_amdgcn_kernarg_segment_ptr(); asm volatile("" : "+s"(k_)); const GAS float* g_ = (const GAS float*)(*(const float* const __attribute__((address_space(4)))*)(k_ + 8 * (i))); asm volatile("" : "+s"(g_)); (const float*)g_; })
    LAS unsigned char* ring = F.lds + RING_OFF;
    int bx = (int)blockIdx.x;

    for (int rt_ = 0; rt_ < REP_CONV; ++rt_) conv_rwkv(F, 0); for (int rt_ = 0; rt_ < REP_CONV; ++rt_) conv_dense(F, 0);
    { unsigned char* ws = WSB(); for (int rt_ = 0; rt_ < REP_RW; ++rt_) mix_phase(F, INP(I_X), INP(I_MU), (bf16*)(ws + RS_XM)); }
    GRID_BAR();

#ifndef LAYER_LO
#define LAYER_LO 0
#define LAYER_HI 4
#endif
    for (int layer = LAYER_LO; layer < LAYER_HI; ++layer) {
        const bool moe = (layer & 1) != 0; const int fe = layer >> 1;
        if (layer < 2) {
            const int l = layer;
            if (l > 0) { { unsigned char* ws = WSB(); for (int rt_ = 0; rt_ < REP_RW; ++rt_) mix_phase(F, (const float*)(ws + WS_H), INP(I_MU) + (size_t)l * 6 * D, (bf16*)(ws + RS_XM)); }
              GRID_BAR(); }
            { unsigned char* ws = WSB(); pg8::Gemm g{D, D, D}; pg8::SchedStd S; S.init(M, 4096, F.G, bx, ws + RS_XM, D, ws + WM_BT1 + (size_t)l * RW_LSTRIDE, D, 1, (size_t)M * D * 2);
              pg8::EpiRkv E{(bf16*)(ws + RS_RKV), (long)RS_LH - (long)RS_RKV, (size_t)M * D};
              GEMM_BIG(pg8::EpiRkv, pg8::SchedStd)(ring, g, S, E, F.wave); }
            GRID_BAR();
            CUT(1, RS_RKV, true)
            { unsigned char* ws = WSB(); pg8::Gemm g{256, D, 256}; pg8::SchedStd S; S.init(M, 3072, F.G, bx, ws + RS_LH, D, ws + WM_BT2 + (size_t)l * RW_LSTRIDE, 256, 2, 0);
              pg8::EpiLoraUpAll E{{(void*)(ws + RS_DEC), INP(I_W0) + (size_t)l * D}, {(void*)(ws + RS_AB), INP(I_A0) + (size_t)l * D}, {(void*)(ws + RS_VG), INP(I_V0)}, {(void*)(ws + RS_GG), nullptr}};
              GEMM_BIG(pg8::EpiLoraUpAll, pg8::SchedStd)(ring, g, S, E, F.wave); }
            GRID_BAR();
            CUT(2, RS_DEC, false) CUT(60, RS_VG, true) CUT(61, RS_GG, true) CUT(62, RS_LH, true) CUT(63, RS_AB, false)
            { unsigned char* ws = WSB(); for (int rt_ = 0; rt_ < REP_RW; ++rt_) prep_phase(F, l, (bf16*)(ws + RS_RKV), (const float*)(ws + RS_AB), (bf16*)(ws + RS_LH), INP(I_V0), INP(I_V2), (bf16*)(ws + WS_VFIRST), INP(I_KK) + (size_t)l * D, INP(I_KA) + (size_t)l * D,
                                                   (bf16*)(ws + RS_KP), (bf16*)(ws + RS_AP), (bf16*)(ws + RS_BP), (bf16*)(ws + RS_VP)); }
            GRID_BAR();
            CUT(3, RS_KP, true) CUT(7, RS_VP, true) CUT(8, RS_BP, true) CUT(9, RS_DEC, false)
#ifdef WKV_SEQ
            for (int rep_ = 0; rep_ < REP_SCAN; ++rep_) {
              { unsigned char* ws = WSB(); scan_phase(F, (bf16*)(ws + RS_RKV), (float*)(ws + RS_DEC), (bf16*)(ws + RS_KP), (bf16*)(ws + RS_AP), (bf16*)(ws + RS_BP), (bf16*)(ws + RS_VP), (bf16*)(ws + WS_Y)); }
              if (rep_ + 1 < REP_SCAN) GRID_BAR(); }
            GRID_BAR();
#else
            { unsigned char* ws = WSB(); for (int rq_ = 0; rq_ < REP_WKB; ++rq_) wkv_build_phase(F, (bf16*)(ws + RS_RKV), (float*)(ws + RS_DEC), (bf16*)(ws + RS_KP), (bf16*)(ws + RS_AP), (bf16*)(ws + RS_BP), ws + RS_REC0, ws + RS_REC1); }
            GRID_BAR();
#ifdef DBG_CUT
            if (DBG_CUT == 39 && (DBG_LAYER < 0 || layer == DBG_LAYER)) { unsigned char* ws = WSB(); const unsigned short* s_ = (const unsigned short*)(ws + RS_REC0); float* o_ = GOUT();
                for (size_t i = (size_t)F.gw * 64 + F.lane; i < (size_t)M * D; i += (size_t)F.NGW * 64) o_[i] = (float)s_[i]; return; }
#endif
            { unsigned char* ws = WSB(); for (int rq_ = 0; rq_ < REP_WKC; ++rq_) wkv_chain_phase(F, ws + RS_REC0, ws + RS_REC1, (bf16*)(ws + RS_VP), (bf16*)(ws + WS_Y)); }
            if (F.vcu >= 32) {
                const int gw_ = F.gw, ngw_ = F.NGW; F.gw = (F.vcu - 32) * NWAVES + F.wave; F.NGW = (F.G - 32) * NWAVES;
                for (int rt_ = 0; rt_ < REP_CONV; ++rt_) { if (l == 0) { conv_rwkv(F, 1); conv_moe(F, 0); } else { conv_moe(F, 1); conv_dense(F, 1); conv_moba(F, 0); conv_moba(F, 1); } }
                F.gw = gw_; F.NGW = ngw_; }
            GRID_BAR();
#endif
            CUT(4, WS_Y, true)
#ifdef DBG_CUT
            if (DBG_CUT == 38 && (DBG_LAYER < 0 || layer == DBG_LAYER)) {
                { unsigned char* ws = WSB(); scan_phase(F, (bf16*)(ws + RS_RKV), (float*)(ws + RS_DEC), (bf16*)(ws + RS_KP), (bf16*)(ws + RS_AP), (bf16*)(ws + RS_BP), (bf16*)(ws + RS_VP), (bf16*)(ws + WS_SCR + 128 * MiB)); }
                GRID_BAR();
                { unsigned char* ws = WSB(); const bf16* a_ = (const bf16*)(ws + WS_Y); const bf16* b_ = (const bf16*)(ws + WS_SCR + 128 * MiB); float* o_ = GOUT();
                  for (size_t i = (size_t)F.gw * 64 + F.lane; i < (size_t)M * D; i += (size_t)F.NGW * 64) { float d_ = DBG_SCALE * (bf2f(a_[i]) - DBG_SUB * bf2f(b_[i])); if (!(fabsf(d_) < 1e30f)) d_ = 1e6f; o_[i] = d_; } }
                return; }
#endif
            { unsigned char* ws = WSB(); for (int rt_ = 0; rt_ < REP_RW; ++rt_) post_phase(F, (bf16*)(ws + WS_Y), (bf16*)(ws + RS_RKV), (bf16*)(ws + RS_KP), (bf16*)(ws + RS_VP), (bf16*)(ws + RS_GG),
                                                   INP(I_RK) + (size_t)l * D, INP(I_GNG) + (size_t)l * D, INP(I_GNB) + (size_t)l * D, (bf16*)(ws + RS_YG)); }
            GRID_BAR();
            CUT(5, RS_YG, true)
            { unsigned char* ws = WSB(); pg8::Gemm g{D, D, D}; pg8::SchedStd S; S.init(M, D, F.G, bx, ws + RS_YG, D, ws + WM_OUT + (size_t)l * RW_LSTRIDE, D);
              pg8::EpiResF32 E{layer == 0 ? INP(I_X) : (const float*)(ws + WS_H), (float*)(ws + RS_PRE), ALPHA};
              GEMM_ONE(pg8::EpiResF32, pg8::SchedStd)(ring, g, S, E, F.wave); }
            GRID_BAR();
            CUT(6, RS_PRE, false)
        } else {
            const int j = layer - 2;
            { unsigned char* ws = WSB(); pg8::Gemm g{D, D, D}; pg8::SchedStd S; S.init(M, j == 0 ? 3 * D : D, F.G, bx, ws + WS_HB, D, ws + (j == 0 ? WM_QKV : WM_Q3), D);
              pg8::EpiQKV E{(bf16*)(ws + BS_Q), ((long)WS_K - (long)BS_Q) / 2, ((long)WS_V - (long)BS_Q) / 2, attn_body::C2};
              GEMM_BIG(pg8::EpiQKV, pg8::SchedStd)(ring, g, S, E, F.wave); }
            GRID_BAR();
            CUT(31, BS_Q, true) CUT(32, WS_K, true) CUT(33, WS_V, true)
            if (j == 0) { unsigned char* ws = WSB(); for (int rt_ = 0; rt_ < REP_THIN; ++rt_) kmean_phase(F, (bf16*)(ws + WS_K), (float*)(ws + WS_KMEAN)); GRID_BAR(); }
#ifndef NO_GATE
            { unsigned char* ws = WSB(); for (int rt_ = 0; rt_ < REP_THIN; ++rt_) gate_phase(F, (bf16*)(ws + BS_Q), (float*)(ws + WS_KMEAN), (unsigned*)(ws + WS_SEL)); }
#endif
            GRID_BAR();
#ifdef DBG_CUT
            if (DBG_CUT == 35) { unsigned char* ws = WSB(); const unsigned* s_ = (const unsigned*)(ws + WS_SEL); for (size_t i = (size_t)F.gw * 64 + F.lane; i < (size_t)M * D; i += (size_t)F.NGW * 64) args.out[i] = (float)(s_[i & (size_t)(M * 16 - 1)] % 65521u); return; }
#endif
#ifdef ATTN_DIRECT
            { unsigned char* ws = WSB(); attn_direct_phase(F, (const bf16*)(ws + BS_Q), (const bf16*)(ws + WS_K), (const bf16*)(ws + WS_V), (const unsigned*)(ws + WS_SEL), (bf16*)(ws + BS_O)); }
            GRID_BAR();
#else
            { unsigned char* ws = WSB(); for (int ra_ = 0; ra_ < REP_ATTN; ++ra_) moba_attn_phase(F, (const bf16*)(ws + BS_Q), (const bf16*)(ws + WS_K), (const bf16*)(ws + WS_V), (const unsigned*)(ws + WS_SEL), (bf16*)(ws + BS_PO), (float*)(ws + BS_ML), F.ctl + CW_QCTR + 64 * (j + 2 * ra_)); }
            GRID_BAR();
            { unsigned char* ws = WSB(); for (int rt_ = 0; rt_ < REP_THIN; ++rt_) moba_combine_phase(F, (const unsigned*)(ws + WS_SEL), (const bf16*)(ws + BS_PO), (const float*)(ws + BS_ML), (bf16*)(ws + BS_O)); }
            GRID_BAR();
#endif
            CUT(36, BS_O, true)
#ifdef DBG_CUT
            if (DBG_CUT == 37 && (DBG_LAYER < 0 || layer == DBG_LAYER)) {
                { unsigned char* ws = WSB(); attn_direct_phase(F, (const bf16*)(ws + BS_Q), (const bf16*)(ws + WS_K), (const bf16*)(ws + WS_V), (const unsigned*)(ws + WS_SEL), (bf16*)(ws + BS_PRE)); }
                GRID_BAR();
                { unsigned char* ws = WSB(); const bf16* a_ = (const bf16*)(ws + BS_O); const bf16* b_ = (const bf16*)(ws + BS_PRE); float* o_ = GOUT();
                  for (size_t i = (size_t)F.gw * 64 + F.lane; i < (size_t)M * D; i += (size_t)F.NGW * 64) o_[i] = 1000.f * (bf2f(a_[i]) - bf2f(b_[i])); }
                return; }
#endif
            { unsigned char* ws = WSB(); pg8::Gemm g{D, D, D}; pg8::SchedStd S; S.init(M, D, F.G, bx, ws + BS_O, D, ws + (j == 0 ? WM_O : WM_O3), D);
              pg8::EpiResF32 E{(const float*)(ws + WS_H), (float*)(ws + BS_PRE), ALPHA};
              GEMM_ONE(pg8::EpiResF32, pg8::SchedStd)(ring, g, S, E, F.wave); }
            GRID_BAR();
        }
        { unsigned char* ws = WSB(); const float* PREm = (const float*)(ws + (layer < 2 ? RS_PRE : BS_PRE));
          const float* g0 = INP(I_LNG) + (size_t)(layer * 2) * D; const float* b0 = INP(I_LNB) + (size_t)(layer * 2) * D;
          if (moe) for (int rt_ = 0; rt_ < REP_LN; ++rt_) ln_phase<0, true>(F, PREm, nullptr, nullptr, nullptr, g0, b0, (float*)(ws + WS_H), (bf16*)(ws + WS_HB), INP(I_ROUTER) + (size_t)fe * D * NE, (int*)(ws + WS_TOKE), (float*)(ws + WS_TOKW), (int*)(ws + WS_BLKCNT));
          else for (int rt_ = 0; rt_ < REP_LN; ++rt_) ln_phase<0, false>(F, PREm, nullptr, nullptr, nullptr, g0, b0, (float*)(ws + WS_H), (bf16*)(ws + WS_HB), nullptr, nullptr, nullptr, nullptr); }
        GRID_BAR();
        CUT(10 + layer, WS_H, false)
        if (!moe) {
            { unsigned char* ws = WSB(); pg8::Gemm g{D, D, D}; pg8::SchedStd S; S.init(M, 2 * FF, F.G, bx, ws + WS_HB, D, ws + WF_GU, D);
              pg8::EpiSwiGLU E{(void*)(ws + FS_HID), FF, 1.0f, 1.0f};
              GEMM_BIG(pg8::EpiSwiGLU, pg8::SchedStd)(ring, g, S, E, F.wave); }
            GRID_BAR();
            { unsigned char* ws = WSB(); pg8::Gemm g{FF, FF, FF}; pg8::SchedStd S; S.init(M, D, F.G, bx, ws + FS_HID, FF, ws + WF_DN, FF);
              pg8::EpiResF32 E{(const float*)(ws + WS_H), (float*)(ws + FS_PRE), ALPHA};
              GEMM_ONE(pg8::EpiResF32, pg8::SchedStd)(ring, g, S, E, F.wave); }
            GRID_BAR();
            { unsigned char* ws = WSB(); const float* g1 = INP(I_LNG) + (size_t)(layer * 2 + 1) * D; const float* b1 = INP(I_LNB) + (size_t)(layer * 2 + 1) * D;
              for (int rt_ = 0; rt_ < REP_LN; ++rt_) ln_phase<0, false>(F, (const float*)(ws + FS_PRE), nullptr, nullptr, nullptr, g1, b1, (float*)(ws + WS_H), (bf16*)(ws + WS_HB), nullptr, nullptr, nullptr, nullptr); }
            GRID_BAR();
        } else {
            { unsigned char* ws = WSB(); for (int rt_ = 0; rt_ < REP_THIN; ++rt_) moe_gather_phase(F, (const int*)(ws + WS_BLKCNT), (const int*)(ws + WS_TOKE), (const float*)(ws + WS_TOKW), (int*)(ws + WS_TOKR), (float*)(ws + WS_GW), (const float*)(ws + WS_H), (unsigned char*)(ws + ES_XG)); }
            GRID_BAR();
            { unsigned char* ws = WSB(); const LAS int* pp = (const LAS int*)(F.lds + MISC_OFF + 64);
              pg8::Gemm g{D / 2, D / 2, D / 2};
              pg8::SchedMoe S{2 * FFE / 256, F.G, bx, pp, (const char*)(ws + ES_XG), (const char*)(ws + WE_GU + (size_t)fe * WE_SET), (size_t)256 * D, (size_t)256 * D, (size_t)2 * FFE * D, 0};
              pg8::EpiSwiGLUT<MOE_DOWN_F8 != 0> E{(void*)(ws + ES_HID), FFE, 1.0f / MOE_WSCALE, MOE_HSCALE};
              for (int rg_ = 0; rg_ < REP_GEMM; ++rg_) pg8::gemm_phase<pg8::EpiSwiGLUT<MOE_DOWN_F8 != 0>, pg8::SchedMoe, true, true, true>(ring, g, S, E, F.wave); }
            GRID_BAR();
            { unsigned char* ws = WSB(); const LAS int* pp = (const LAS int*)(F.lds + MISC_OFF + 64);
#if MOE_DOWN_F8
              { pg8::Gemm g{FFE / 2, FFE / 2, FFE / 2}; pg8::SchedMoe S{D / 256, F.G, bx, pp, (const char*)(ws + ES_HID), (const char*)(ws + WE_DN + (size_t)fe * WE_SET), (size_t)256 * FFE, (size_t)256 * FFE, (size_t)D * FFE, 2 * 256};
                pg8::EpiMoeDown E{(pg8::bf16_t*)(ws + ES_YP), (const float*)(ws + WS_GW), 1.0f / (MOE_HSCALE * MOE_DSCALE)};
                for (int rg_ = 0; rg_ < REP_GEMM; ++rg_) pg8::gemm_phase<pg8::EpiMoeDown, pg8::SchedMoe, true, true, true>(ring, g, S, E, F.wave); }
              { pg8::Gemm g{256, FFE / 2, FFE / 2}; pg8::SchedMoeTail S{D / 256, F.G, bx, 2 * 256, 7, pp, (const char*)(ws + ES_HID), (const char*)(ws + WE_DN + (size_t)fe * WE_SET), (size_t)256 * FFE, (size_t)256 * FFE, (size_t)D * FFE, (size_t)512};
                pg8::EpiMoeDownSlab E{(float*)(ws + ES_YS), (const float*)(ws + WS_GW), bx, 7, 1.0f / (MOE_HSCALE * MOE_DSCALE)};
                for (int rg_ = 0; rg_ < REP_GEMM; ++rg_) pg8::gemm_phase<pg8::EpiMoeDownSlab, pg8::SchedMoeTail, false, true, true>(ring, g, S, E, F.wave); } }
#else
              { pg8::Gemm g{FFE, FFE, FFE}; pg8::SchedMoe S{D / 256, F.G, bx, pp, (const char*)(ws + ES_HID), (const char*)(ws + WE_DN + (size_t)fe * WE_SET), (size_t)256 * FFE * 2, (size_t)256 * FFE * 2, (size_t)D * FFE * 2, 2 * 256};
                pg8::EpiMoeDown E{(pg8::bf16_t*)(ws + ES_YP), (const float*)(ws + WS_GW), 1.0f};
                GEMM_BIG(pg8::EpiMoeDown, pg8::SchedMoe)(ring, g, S, E, F.wave); }
              { pg8::Gemm g{512, FFE, FFE}; pg8::SchedMoeTail S{D / 256, F.G, bx, 2 * 256, 7, pp, (const char*)(ws + ES_HID), (const char*)(ws + WE_DN + (size_t)fe * WE_SET), (size_t)256 * FFE * 2, (size_t)256 * FFE * 2, (size_t)D * FFE * 2, (size_t)512 * 2};
                pg8::EpiMoeDownSlab E{(float*)(ws + ES_YS), (const float*)(ws + WS_GW), bx, 7, 1.0f};
                GEMM_ONE(pg8::EpiMoeDownSlab, pg8::SchedMoeTail)(ring, g, S, E, F.wave); } }
#endif
            GRID_BAR();
            { unsigned char* ws = WSB(); const float* g1 = INP(I_LNG) + (size_t)(layer * 2 + 1) * D; const float* b1 = INP(I_LNB) + (size_t)(layer * 2 + 1) * D;
              if (layer == 3) ln_phase<1, false>(F, (const float*)(ws + ES_YS), (const float*)(ws + WS_H), (const bf16*)(ws + ES_YP), (const int*)(ws + WS_TOKR), g1, b1, GOUT(), nullptr, nullptr, nullptr, nullptr, nullptr);
              else ln_phase<1, false>(F, (const float*)(ws + ES_YS), (const float*)(ws + WS_H), (const bf16*)(ws + ES_YP), (const int*)(ws + WS_TOKR), g1, b1, (float*)(ws + WS_H), (bf16*)(ws + WS_HB), nullptr, nullptr, nullptr, nullptr); }
            GRID_BAR();
        }
        CUT(20 + layer, WS_H, false)
        CUT(40 + layer, WS_HB, true)
#ifdef DBG_CUT
        if (DBG_CUT == 50 + layer) { unsigned char* ws = WSB(); const bf16* s_ = (const bf16*)(ws + WS_WMIX); float* o_ = GOUT(); for (size_t i = (size_t)F.gw * 64 + F.lane; i < (size_t)M * D; i += (size_t)F.NGW * 64) o_[i] = i < (size_t)6 * 1024 * 1024 ? bf2f(s_[i]) : 0.f; return; }
#endif
    }
}

extern "C" void kernel_launch(void* const* d_in, const int* in_sizes, int n_in, void* d_out, int out_size, void* d_ws, size_t ws_size, hipStream_t stream) {
    static int grid = 0;
    if (grid == 0) {
        if (n_in != 33 || in_sizes[0] != M * D || out_size != M * D || ws_size < WS_END) { fprintf(stderr, "kernel_launch: unexpected problem shape (n_in %d, in0 %d, out %d, ws %zu); nothing launched\n", n_in, n_in > 0 ? in_sizes[0] : -1, out_size, ws_size); grid = -1; return; }
        int dev = 0, cus = 0, per_cu = 0;
        if (hipGetDevice(&dev) != hipSuccess || hipDeviceGetAttribute(&cus, hipDeviceAttributeMultiprocessorCount, dev) != hipSuccess) { grid = -1; return; }
        if (hipFuncSetAttribute((const void*)fwd_kernel, hipFuncAttributeMaxDynamicSharedMemorySize, LDS_BYTES) != hipSuccess) { fprintf(stderr, "kernel_launch: hipFuncSetAttribute failed\n"); grid = -1; return; }
        if (hipOccupancyMaxActiveBlocksPerMultiprocessor(&per_cu, (const void*)fwd_kernel, NWAVES * 64, LDS_BYTES) != hipSuccess || per_cu < 1) { fprintf(stderr, "kernel_launch: occupancy query reports %d workgroups per CU\n", per_cu); }
        (void)hipGetLastError();
        grid = cus;
        if (grid != 256) { fprintf(stderr, "kernel_launch: built for 256 CUs, device has %d; nothing launched\n", cus); grid = -1; return; }
    }
    if (grid < 0) return;
    if (hipMemsetAsync((char*)d_ws + WS_CTL, 0, CTL_ZERO_BYTES, stream) != hipSuccess) return;
#ifdef DBG_FILL
    (void)hipMemsetAsync((char*)d_ws + CTL_ZERO_BYTES, DBG_FILL, WS_END - CTL_ZERO_BYTES, stream);
#endif
    Args a{};
    for (int i = 0; i < 33; ++i) a.in[i] = (const float*)d_in[i];
    a.out = (float*)d_out; a.ws = (unsigned char*)d_ws;
    hipLaunchKernelGGL(fwd_kernel, dim3(grid), dim3(NWAVES * 64), LDS_BYTES, stream, a);
}
```

```cpp
#include <hip/hip_runtime.h>
#include <cstdio>
#include <cstdint>
#include <hip/hip_bf16.h>
#include <cmath>
__device__ __forceinline__ int fresh_lane() { int l; asm volatile("v_mbcnt_lo_u32_b32 %0, -1, 0\n\tv_mbcnt_hi_u32_b32 %0, -1, %0" : "=v"(l)); return l; }
namespace pg8 {
#define PG8_LAS __attribute__((address_space(3)))
typedef unsigned short bf16_t;
typedef short bf16x8 __attribute__((ext_vector_type(8)));
typedef float f32x4 __attribute__((ext_vector_type(4)));
typedef unsigned u32x4 __attribute__((ext_vector_type(4)));
constexpr int BM = 256, BK = 64, HALF = 128, HTB = HALF * BK * 2  , STAGE_BYTES = 8 * HTB, NXCD = 8, WGM = 8;

__host__ __device__ __forceinline__ int lds_byte(int r, int c) { const int st = (r >> 4) * 2 + (c >> 5), rr = r & 15, cc = c & 31, ob = rr * 64 + cc * 2; return st * 1024 + (ob ^ (((ob >> 9) & 1) << 5)); }
__host__ __device__ __forceinline__ void stage_rc(int b, int& R, int& C) { const int st = b / 1024, sb = b % 1024, swz = sb ^ (((sb >> 9) & 1) << 5); R = (st >> 1) * 16 + swz / 64; C = (st & 1) * 32 + (swz % 64) / 2; }
__host__ __device__ __forceinline__ int perm32(int rho) { const int n = rho >> 4, i = rho & 15; return 8 * (i >> 2) + 4 * n + (i & 3); }

struct Unit { int pm, pn, e; };
struct Gemm { int K, lda, ldb; };

__device__ __forceinline__ unsigned cvt_pk_bf16(float lo, float hi) { unsigned r; asm volatile("v_cvt_pk_bf16_f32 %0, %1, %2" : "=v"(r) : "v"(lo), "v"(hi)); return r; }
__device__ __forceinline__ float fsigmoid(float x) { return __builtin_amdgcn_rcpf(1.0f + __expf(-x)); }
__device__ __forceinline__ float ftanh(float x) { return 1.0f - 2.0f * __builtin_amdgcn_rcpf(1.0f + __expf(2.0f * x)); }

struct SchedStd {
    int nM, nN, nwg, G, c, amode; const char* A; const char* B; size_t atile, btile, ag;
    __device__ __forceinline__ void init(int M, int N, int G_, int c_, const void* A_, size_t lda, const void* B_, size_t ldb, int amode_ = 0, size_t ag_ = 0) {
        nM = M / BM; nN = N / BM; nwg = nM * nN; G = G_; c = c_; A = (const char*)A_; B = (const char*)B_; atile = (size_t)BM * lda * 2; btile = (size_t)BM * ldb * 2; amode = amode_; ag = ag_; }
    __device__ __forceinline__ bool next(int i, Unit& u) const {
        const long L = (long)i * G + c; if (L >= nwg) return false;
        int wgid = (int)L; { const int q = nwg / NXCD, r = nwg % NXCD, xcd = wgid % NXCD, off = wgid / NXCD; wgid = (xcd < r ? xcd * (q + 1) : r * (q + 1) + (xcd - r) * q) + off; }
        const int nig = WGM * nN, gid = wgid / nig, fm = gid * WGM, gsz = (nM - fm) < WGM ? (nM - fm) : WGM;
        u.pm = fm + ((wgid % nig) % gsz); u.pn = (wgid % nig) / gsz; u.e = 0;
        if (amode == 2 && u.pn >= 8) u.pn += 4;
        return true;
    }
    __device__ __forceinline__ const char* abase(const Unit& u) const {
        size_t off = (size_t)u.pm * atile;
        if (amode == 1) { const int gs = u.pn < 12 ? (u.pn >> 2) : (u.pn == 12 ? 3 : (u.pn == 13 ? 4 : (u.pn == 14 ? 2 : 5))); off += (size_t)gs * ag; }
        else if (amode == 2) off += (size_t)(u.pn >> 2) * 512;
        return A + off; }
    __device__ __forceinline__ const char* bbase(const Unit& u) const { return B + (size_t)u.pn * btile; }
    __device__ __forceinline__ void a_ready(const Unit&) const {}
    __device__ __forceinline__ void done(const Unit&) const {}
};
struct SchedMoe {
    int nN, G, c; const PG8_LAS int* pp; const char* A; const char* B; size_t atile, btile, bexp; int cap;
    __device__ __forceinline__ bool next(int i, Unit& u) const {
        const int L = i * G + c; int P = pp[8]; if (cap && P * nN > cap) P = cap / nN;
        const int tot = P * nN; if (L >= tot) return false;
        int pm, pn;
        {
            int wgid = L; { const int q = tot / NXCD, r = tot % NXCD, xcd = wgid % NXCD, off = wgid / NXCD; wgid = (xcd < r ? xcd * (q + 1) : r * (q + 1) + (xcd - r) * q) + off; }
            const int nig = WGM * nN, gid = wgid / nig, fm = gid * WGM, gsz = (P - fm) < WGM ? (P - fm) : WGM;
            pm = fm + ((wgid % nig) % gsz); pn = (wgid % nig) / gsz; }
        u.pm = pm; u.pn = pn; int e = 0;
#pragma unroll
        for (int k = 1; k < 8; ++k) e += (pm >= pp[k]) ? 1 : 0;
        u.e = __builtin_amdgcn_readfirstlane(e); return true; }
    __device__ __forceinline__ const char* abase(const Unit& u) const { return A + (size_t)u.pm * atile; }
    __device__ __forceinline__ const char* bbase(const Unit& u) const { return B + (size_t)u.e * bexp + (size_t)u.pn * btile; }
    __device__ __forceinline__ void a_ready(const Unit&) const {}
    __device__ __forceinline__ void done(const Unit&) const {}
};

struct SchedMoeTail {
    int nN, G, c, first, NS; const PG8_LAS int* pp; const char* A; const char* B; size_t atile, btile, bexp, kslice;
    __device__ __forceinline__ bool next(int i, Unit& u) const {
        if (i > 0) return false;
        const int L = first + c / NS, tot = pp[8] * nN; if (L >= tot) return false;
        const int pm = L / nN; u.pm = pm; u.pn = L - pm * nN; int e = 0;
#pragma unroll
        for (int k = 1; k < 8; ++k) e += (pm >= pp[k]) ? 1 : 0;
        u.e = __builtin_amdgcn_readfirstlane(e); return true; }
    __device__ __forceinline__ const char* abase(const Unit& u) const { return A + (size_t)u.pm * atile + (size_t)(c % NS) * kslice; }
    __device__ __forceinline__ const char* bbase(const Unit& u) const { return B + (size_t)u.e * bexp + (size_t)u.pn * btile + (size_t)(c % NS) * kslice; }
    __device__ __forceinline__ void a_ready(const Unit&) const {}
    __device__ __forceinline__ void done(const Unit&) const {}
};
#define PG8_PACK8(w, v0, v1) do { w.x = cvt_pk_bf16(v0[0], v0[1]); w.y = cvt_pk_bf16(v0[2], v0[3]); w.z = cvt_pk_bf16(v1[0], v1[1]); w.w = cvt_pk_bf16(v1[2], v1[3]); } while (0)

struct EpiQKV {
    static constexpr bool PERM = true, AFTER_DRAIN = false;
    bf16_t* O0; long d1, d2; float s0;
    __device__ __forceinline__ void operator()(const f32x4 (&acc)[2][2][4][2], const Unit& u, int wr, int wc, int fr, int fq) const {
        const int t = u.pn >> 2; bf16_t* base = O0 + (long)(t == 1) * d1 + (long)(t == 2) * d2; const float sc = t == 0 ? s0 : 1.0f;
        const int row0 = u.pm * BM + wr * 64 + fr, col0 = (u.pn & 3) * BM + wc * 32 + 8 * fq;
#pragma unroll
        for (int ai = 0; ai < 2; ++ai)
#pragma unroll
            for (int m = 0; m < 4; ++m) { bf16_t* rowp = base + (size_t)(row0 + ai * HALF + m * 16) * 1024 + col0;
#pragma unroll
                for (int bj = 0; bj < 2; ++bj) { const f32x4 v0 = acc[ai][bj][m][0] * sc, v1 = acc[ai][bj][m][1] * sc; u32x4 w; PG8_PACK8(w, v0, v1); *(u32x4*)(rowp + bj * HALF) = w; } }
    }
};
struct EpiRkv {
    static constexpr bool PERM = true, AFTER_DRAIN = false;
    bf16_t* RKV; long dLH; size_t mstride;
    __device__ __forceinline__ void operator()(const f32x4 (&acc)[2][2][4][2], const Unit& u, int wr, int wc, int fr, int fq) const {
        const int pn = u.pn; const bool lora = pn >= 12;
        bf16_t* base = (bf16_t*)((char*)RKV + (lora ? dLH : (long)((size_t)(pn >> 2) * mstride * 2))); const int colt = lora ? (pn - 12) * BM : (pn & 3) * BM;
        const int row0 = u.pm * BM + wr * 64 + fr, col0 = colt + wc * 32 + 8 * fq;
#pragma unroll
        for (int ai = 0; ai < 2; ++ai)
#pragma unroll
            for (int m = 0; m < 4; ++m) { bf16_t* rowp = base + (size_t)(row0 + ai * HALF + m * 16) * 1024 + col0;
#pragma unroll
                for (int bj = 0; bj < 2; ++bj) { f32x4 v0 = acc[ai][bj][m][0], v1 = acc[ai][bj][m][1];
                    if (pn == 12) {
#pragma unroll
                        for (int i = 0; i < 4; ++i) { v0[i] = ftanh(v0[i]); v1[i] = ftanh(v1[i]); } }
                    else if (pn == 15) {
#pragma unroll
                        for (int i = 0; i < 4; ++i) { v0[i] = fsigmoid(v0[i]); v1[i] = fsigmoid(v1[i]); } }
                    u32x4 w; PG8_PACK8(w, v0, v1); *(u32x4*)(rowp + bj * HALF) = w; } }
    }
};
template <int GRP> struct EpiLoraUp {
    static constexpr bool PERM = true, AFTER_DRAIN = false;
    void* O; const float* bias;
    __device__ __forceinline__ void operator()(const f32x4 (&acc)[2][2][4][2], const Unit& u, int wr, int wc, int fr, int fq) const {
        const int row0 = u.pm * BM + wr * 64 + fr, col0 = u.pn * BM + wc * 32 + 8 * fq;
#pragma unroll
        for (int bj = 0; bj < 2; ++bj) {
            f32x4 bv0 = (f32x4){0.f, 0.f, 0.f, 0.f}, bv1 = bv0;
            if (GRP < 3) { bv0 = *(const f32x4*)(bias + col0 + bj * HALF); bv1 = *(const f32x4*)(bias + col0 + bj * HALF + 4); }
#pragma unroll
            for (int ai = 0; ai < 2; ++ai)
#pragma unroll
                for (int m = 0; m < 4; ++m) { const size_t ro = (size_t)(row0 + ai * HALF + m * 16) * 1024 + col0 + bj * HALF;
                    f32x4 v0_ = acc[ai][bj][m][0] + bv0, v1_ = acc[ai][bj][m][1] + bv1;
                    if (GRP == 0) {
#pragma unroll
                        for (int i = 0; i < 4; ++i) { v0_[i] = __expf(-0.6065306597f * fsigmoid(v0_[i])); v1_[i] = __expf(-0.6065306597f * fsigmoid(v1_[i])); }
                    } else if (GRP < 3) {
#pragma unroll
                        for (int i = 0; i < 4; ++i) { v0_[i] = fsigmoid(v0_[i]); v1_[i] = fsigmoid(v1_[i]); }
                    }
                    if (GRP < 2) { *(f32x4*)((float*)O + ro) = v0_; *(f32x4*)((float*)O + ro + 4) = v1_; }
                    else { u32x4 w; PG8_PACK8(w, v0_, v1_); *(u32x4*)((bf16_t*)O + ro) = w; } }
        }
    }
};
struct EpiLoraUpAll {
    static constexpr bool PERM = true, AFTER_DRAIN = false;
    EpiLoraUp<0> e0; EpiLoraUp<1> e1; EpiLoraUp<2> e2; EpiLoraUp<3> e3;
    __device__ __forceinline__ void operator()(const f32x4 (&acc)[2][2][4][2], const Unit& u, int wr, int wc, int fr, int fq) const {
        Unit v = u; v.pn = u.pn & 3; const int g = u.pn >> 2;
        if (g == 0) e0(acc, v, wr, wc, fr, fq); else if (g == 1) e1(acc, v, wr, wc, fr, fq); else if (g == 2) e2(acc, v, wr, wc, fr, fq); else e3(acc, v, wr, wc, fr, fq);
    }
};
struct EpiResF32 {
    static constexpr bool PERM = false, AFTER_DRAIN = false;
    const float* base; float* out; float alpha;
    __device__ __forceinline__ void operator()(const f32x4 (&acc)[2][2][4][2], const Unit& u, int wr, int wc, int fr, int fq) const {
        const int row0 = u.pm * BM + wr * 64 + fr, col0 = u.pn * BM + wc * 32 + 4 * fq;
#pragma unroll
        for (int ai = 0; ai < 2; ++ai)
#pragma unroll
            for (int m = 0; m < 4; ++m) { const size_t ro = (size_t)(row0 + ai * HALF + m * 16) * 1024 + col0;
#pragma unroll
                for (int bj = 0; bj < 2; ++bj)
#pragma unroll
                    for (int n = 0; n < 2; ++n) { const f32x4 b = *(const f32x4*)(base + ro + bj * HALF + n * 16); *(f32x4*)(out + ro + bj * HALF + n * 16) = b * alpha + acc[ai][bj][m][n]; } }
    }
};
template <bool F8OUT> struct EpiSwiGLUT {
    static constexpr bool PERM = true, AFTER_DRAIN = false;
    void* Hd; int ldh; float sc, oscale;
    __device__ __forceinline__ void operator()(const f32x4 (&acc)[2][2][4][2], const Unit& u, int wr, int wc, int fr, int fq) const {
        const int row0 = u.pm * BM + wr * 64 + fr, col0 = u.pn * HALF + wc * 32 + 8 * fq;
#pragma unroll
        for (int ai = 0; ai < 2; ++ai)
#pragma unroll
            for (int m = 0; m < 4; ++m) { const size_t eo = (size_t)(row0 + ai * HALF + m * 16) * ldh + col0;
                f32x4 v0, v1;
#pragma unroll
                for (int i = 0; i < 4; ++i) { const float g0 = acc[ai][0][m][0][i] * sc, g1 = acc[ai][0][m][1][i] * sc;
                    v0[i] = g0 * fsigmoid(g0) * (acc[ai][1][m][0][i] * sc); v1[i] = g1 * fsigmoid(g1) * (acc[ai][1][m][1][i] * sc); }
                if constexpr (F8OUT) { v0 = v0 * oscale; v1 = v1 * oscale; typedef unsigned u32x2_ __attribute__((ext_vector_type(2)));
                    int lo = __builtin_amdgcn_cvt_pk_fp8_f32(v0[0], v0[1], 0, false); lo = __builtin_amdgcn_cvt_pk_fp8_f32(v0[2], v0[3], lo, true);
                    int hi = __builtin_amdgcn_cvt_pk_fp8_f32(v1[0], v1[1], 0, false); hi = __builtin_amdgcn_cvt_pk_fp8_f32(v1[2], v1[3], hi, true);
                    u32x2_ w; w.x = (unsigned)lo; w.y = (unsigned)hi; *(u32x2_*)((unsigned char*)Hd + eo) = w; }
                else { u32x4 w; PG8_PACK8(w, v0, v1); *(u32x4*)((bf16_t*)Hd + eo) = w; } }
    }
};
typedef EpiSwiGLUT<false> EpiSwiGLU;
struct EpiMoeDown {
    static constexpr bool PERM = false, AFTER_DRAIN = false;
    bf16_t* YP; const float* gw; float sc;
    __device__ __forceinline__ void operator()(const f32x4 (&acc)[2][2][4][2], const Unit& u, int wr, int wc, int fr, int fq) const {
        typedef unsigned u32x2_ __attribute__((ext_vector_type(2)));
        const int row0 = u.pm * BM + wr * 64 + fr, col0 = u.pn * BM + wc * 32 + 4 * fq;
#pragma unroll
        for (int ai = 0; ai < 2; ++ai)
#pragma unroll
            for (int m = 0; m < 4; ++m) { const int row = row0 + ai * HALF + m * 16; const float s = gw[row] * sc; const size_t ro = (size_t)row * 1024 + col0;
#pragma unroll
                for (int bj = 0; bj < 2; ++bj)
#pragma unroll
                    for (int n = 0; n < 2; ++n) { const f32x4 v = acc[ai][bj][m][n] * s; u32x2_ w; w.x = cvt_pk_bf16(v[0], v[1]); w.y = cvt_pk_bf16(v[2], v[3]); *(u32x2_*)(YP + ro + bj * HALF + n * 16) = w; } }
    }
};
struct EpiMoeDownSlab {
    static constexpr bool PERM = false, AFTER_DRAIN = false;
    float* YS; const float* gw; int c, NS; float sc;
    __device__ __forceinline__ void operator()(const f32x4 (&acc)[2][2][4][2], const Unit& u, int wr, int wc, int fr, int fq) const {
        const int row0 = u.pm * BM + wr * 64 + fr, col0 = u.pn * BM + wc * 32 + 4 * fq; float* slab = YS + (size_t)(c % NS) * 2048 * 1024;
#pragma unroll
        for (int ai = 0; ai < 2; ++ai)
#pragma unroll
            for (int m = 0; m < 4; ++m) { const int row = row0 + ai * HALF + m * 16; const float s = gw[row] * sc; const size_t ro = (size_t)(row - 32768) * 1024 + col0;
#pragma unroll
                for (int bj = 0; bj < 2; ++bj)
#pragma unroll
                    for (int n = 0; n < 2; ++n) *(f32x4*)(slab + ro + bj * HALF + n * 16) = acc[ai][bj][m][n] * s; }
    }
};
struct PanelStats {
    unsigned* xbuf;
    unsigned* cnt;
    unsigned* tmo;
    int ntn; float eps;
    unsigned code;
    __device__ __forceinline__ bool run(const f32x4 (&v)[2][2][4][2], const Unit& u, int wr, int wc, int fr, int fq, PG8_LAS unsigned char* lds, int wid, int lane) const {
        typedef float f32x2v __attribute__((ext_vector_type(2)));
        PG8_LAS f32x2v* P = (PG8_LAS f32x2v*)lds;
        PG8_LAS f32x2v* S = (PG8_LAS f32x2v*)(lds + 8192);
        PG8_LAS unsigned* flag = (PG8_LAS unsigned*)(lds + 8192 + 2048);
#pragma unroll
        for (int ai = 0; ai < 2; ++ai)
#pragma unroll
            for (int m = 0; m < 4; ++m) {
                float s = 0.f;
#pragma unroll
                for (int bj = 0; bj < 2; ++bj)
#pragma unroll
                    for (int n = 0; n < 2; ++n) { const f32x4 x = v[ai][bj][m][n]; s += (x[0] + x[1]) + (x[2] + x[3]); }
                s += __builtin_bit_cast(float, __builtin_amdgcn_ds_bpermute((lane ^ 16) << 2, __builtin_bit_cast(int, s))); s += __builtin_bit_cast(float, __builtin_amdgcn_ds_bpermute((lane ^ 32) << 2, __builtin_bit_cast(int, s)));
                const float mw = s * (1.0f / 64.0f); float q = 0.f;
#pragma unroll
                for (int bj = 0; bj < 2; ++bj)
#pragma unroll
                    for (int n = 0; n < 2; ++n) { const f32x4 d = v[ai][bj][m][n] - mw; q += (d[0] * d[0] + d[1] * d[1]) + (d[2] * d[2] + d[3] * d[3]); }
                q += __builtin_bit_cast(float, __builtin_amdgcn_ds_bpermute((lane ^ 16) << 2, __builtin_bit_cast(int, q))); q += __builtin_bit_cast(float, __builtin_amdgcn_ds_bpermute((lane ^ 32) << 2, __builtin_bit_cast(int, q)));
                if (fq == 0) P[(ai * HALF + wr * 64 + m * 16 + fr) * 4 + wc] = (f32x2v){mw, q};
            }
        asm volatile("s_waitcnt lgkmcnt(0)" ::: "memory"); __builtin_amdgcn_s_barrier(); asm volatile("" ::: "memory");
        const int row = wid * 32 + (lane & 31);
        if (lane < 32) {
            const f32x2v a = P[row * 4 + 0], b = P[row * 4 + 1], c = P[row * 4 + 2], d = P[row * 4 + 3];
            const float mt = (a.x + b.x + c.x + d.x) * 0.25f;
            const float da = a.x - mt, db = b.x - mt, dc = c.x - mt, dd = d.x - mt;
            const float m2 = (a.y + b.y) + (c.y + d.y) + 64.0f * ((da * da + db * db) + (dc * dc + dd * dd));
            unsigned long long* slot = (unsigned long long*)xbuf + ((size_t)(u.pm * BM + row) * 4 + u.pn);
            __hip_atomic_store(slot, ((unsigned long long)__float_as_uint(m2) << 32) | __float_as_uint(mt), __ATOMIC_RELAXED, __HIP_MEMORY_SCOPE_AGENT);
        }
        asm volatile("s_waitcnt vmcnt(0)" ::: "memory");
        if (lane == 0) __hip_atomic_fetch_add(cnt + 64 * u.pm, 1u, __ATOMIC_RELAXED, __HIP_MEMORY_SCOPE_AGENT);
        if (wid == 0) {
            bool dead = false; const unsigned long long t0 = __builtin_amdgcn_s_memrealtime(); const unsigned want = 8u * (unsigned)ntn;
            for (;;) {
                if ((unsigned)__builtin_amdgcn_readfirstlane(__hip_atomic_load(cnt + 64 * u.pm, __ATOMIC_RELAXED, __HIP_MEMORY_SCOPE_AGENT)) >= want) break;
                if (__builtin_amdgcn_s_memrealtime() - t0 > 2000000ull) {
                    if (lane == 0) { unsigned expect = 0u; __hip_atomic_compare_exchange_strong(tmo + 1, &expect, code | (unsigned)(u.pm & 0xff), __ATOMIC_RELAXED, __ATOMIC_RELAXED, __HIP_MEMORY_SCOPE_AGENT);
                                     __hip_atomic_store(tmo, 1u, __ATOMIC_RELAXED, __HIP_MEMORY_SCOPE_AGENT); }
                    dead = true; break; }
                __builtin_amdgcn_s_sleep(2);
            }
            __builtin_amdgcn_fence(__ATOMIC_ACQUIRE, "agent");
            if (lane == 0) flag[0] = dead ? 1u : 0u;
        }
        asm volatile("s_waitcnt vmcnt(0) lgkmcnt(0)" ::: "memory"); __builtin_amdgcn_s_barrier(); asm volatile("" ::: "memory");
        const bool bad = flag[0] != 0u;
        if (lane < 32) {
            const unsigned long long* slot = (const unsigned long long*)xbuf + (size_t)(u.pm * BM + row) * 4; float mt[4], m2[4]; float ms = 0.f;
#pragma unroll
            for (int t = 0; t < 4; ++t) { if (t < ntn) { const unsigned long long w = __hip_atomic_load(slot + t, __ATOMIC_RELAXED, __HIP_MEMORY_SCOPE_AGENT); mt[t] = __uint_as_float((unsigned)w); m2[t] = __uint_as_float((unsigned)(w >> 32)); } else { mt[t] = 0.f; m2[t] = 0.f; } ms += mt[t]; }
            const float mean = ms / (float)ntn; float q = 0.f;
#pragma unroll
            for (int t = 0; t < 4; ++t) if (t < ntn) { const float dm = mt[t] - mean; q += m2[t] + 256.0f * dm * dm; }
            S[row] = (f32x2v){mean, 1.0f / sqrtf(q / (256.0f * (float)ntn) + eps)};
        }
        asm volatile("s_waitcnt lgkmcnt(0)" ::: "memory"); __builtin_amdgcn_s_barrier(); asm volatile("" ::: "memory");
        return bad;
    }
};
struct EpiDeepNorm {
    static constexpr bool PERM = false, AFTER_DRAIN = true;
    const float* base; float* out; bf16_t* hb; const float* g; const float* b; float alpha; PanelStats st;
    __device__ __forceinline__ void fused(f32x4 (&acc)[2][2][4][2], const Unit& u, int wr, int wc, int fr, int fq, PG8_LAS unsigned char* lds, int wid, int lane) const {
        typedef float f32x2v __attribute__((ext_vector_type(2))); typedef unsigned u32x2v __attribute__((ext_vector_type(2)));
        const PG8_LAS f32x2v* S = (const PG8_LAS f32x2v*)(lds + 8192);
        const int col0 = u.pn * BM + wc * 32 + 4 * fq;
#pragma unroll
        for (int ai = 0; ai < 2; ++ai)
#pragma unroll
            for (int m = 0; m < 4; ++m) { const size_t off = (size_t)(u.pm * BM + ai * HALF + wr * 64 + m * 16 + fr) * 1024 + col0;
#pragma unroll
                for (int bj = 0; bj < 2; ++bj)
#pragma unroll
                    for (int n = 0; n < 2; ++n) acc[ai][bj][m][n] += *(const f32x4*)(base + off + bj * HALF + n * 16) * alpha;
                if (m & 1) asm volatile("" ::: "memory"); }
        const bool bad = st.run(acc, u, wr, wc, fr, fq, lds, wid, lane);
        const float qnan = __builtin_nanf("");
        f32x4 gv[2][2], bv[2][2];
#pragma unroll
        for (int bj = 0; bj < 2; ++bj)
#pragma unroll
            for (int n = 0; n < 2; ++n) { gv[bj][n] = *(const f32x4*)(g + col0 + bj * HALF + n * 16); bv[bj][n] = *(const f32x4*)(b + col0 + bj * HALF + n * 16); }
#pragma unroll
        for (int ai = 0; ai < 2; ++ai)
#pragma unroll
            for (int m = 0; m < 4; ++m) { const int r = ai * HALF + wr * 64 + m * 16 + fr; const f32x2v sr = S[r]; const size_t off = (size_t)(u.pm * BM + r) * 1024 + col0;
#pragma unroll
                for (int bj = 0; bj < 2; ++bj)
#pragma unroll
                    for (int n = 0; n < 2; ++n) { f32x4 o = (acc[ai][bj][m][n] - sr.x) * sr.y * gv[bj][n] + bv[bj][n]; if (bad) o = (f32x4){qnan, qnan, qnan, qnan};
                        *(f32x4*)(out + off + bj * HALF + n * 16) = o; u32x2v w; w.x = cvt_pk_bf16(o[0], o[1]); w.y = cvt_pk_bf16(o[2], o[3]); *(u32x2v*)(hb + off + bj * HALF + n * 16) = w; } }
    }
};
template <class Epi, class Sched, bool ALIGN_EPI = false, bool SP2 = false, bool F8 = false>
__device__ __forceinline__ void gemm_phase(PG8_LAS unsigned char* lds, const Gemm g, const Sched& S, const Epi& E, int wave) {
    const int lane = fresh_lane(), wid = wave, tid = wid * 64 + lane, wr = wid >> 2, wc = wid & 3, fr = lane & 15, fq = lane >> 4;
    const int K = g.K, nt = K / BK;
    unsigned voffA[2], voffB[2];
#pragma unroll
    for (int i = 0; i < 2; ++i) { int R, C; stage_rc(tid * 16 + i * 8192, R, C); const int Rb = Epi::PERM ? ((R & ~31) + perm32(R & 31)) : R;
        voffA[i] = (unsigned)(R * g.lda + C) * 2u; voffB[i] = (unsigned)(Rb * g.ldb + C) * 2u; }
    const size_t kstep = (size_t)(BK * 2);
    const size_t hsA = (size_t)HALF * g.lda * 2, hsB = (size_t)HALF * g.ldb * 2;
    const unsigned ldsw = (unsigned)wid * 1024u;
    const int aoff = lds_byte(wr * 64 + fr, fq * 8), boff = lds_byte(wc * 32 + fr, fq * 8);
#define PG8_SA(b, h) (((b) * 2 + (h)) * HTB)
#define PG8_SB(b, h) ((4 + (b) * 2 + (h)) * HTB)
#define PG8_STAGE(bufoff, gbase, voff) do { _Pragma("unroll") for (int _i = 0; _i < 2; ++_i) \
        __builtin_amdgcn_global_load_lds((const unsigned*)((const char*)(gbase) + (voff)[_i]), (PG8_LAS unsigned*)(lds + (bufoff) + ldsw + _i * 8192), 16, 0, 0); } while (0)
#define PG8_LDA(dst, b, h) do { _Pragma("unroll") for (int m = 0; m < 4; ++m) { const i32x4_ lo_ = *(const PG8_LAS i32x4_*)(lds + PG8_SA(b, h) + aoff + m * 2048), hi_ = *(const PG8_LAS i32x4_*)(lds + PG8_SA(b, h) + aoff + m * 2048 + 1024); \
        if constexpr (F8) dst##8[m] = __builtin_shufflevector(lo_, hi_, 0, 1, 2, 3, 4, 5, 6, 7); else { dst[m][0] = __builtin_bit_cast(bf16x8, lo_); dst[m][1] = __builtin_bit_cast(bf16x8, hi_); } } } while (0)
#define PG8_LDB(dst, b, h) do { _Pragma("unroll") for (int n = 0; n < 2; ++n) { const i32x4_ lo_ = *(const PG8_LAS i32x4_*)(lds + PG8_SB(b, h) + boff + n * 2048), hi_ = *(const PG8_LAS i32x4_*)(lds + PG8_SB(b, h) + boff + n * 2048 + 1024); \
        if constexpr (F8) dst##8[n] = __builtin_shufflevector(lo_, hi_, 0, 1, 2, 3, 4, 5, 6, 7); else { dst[n][0] = __builtin_bit_cast(bf16x8, lo_); dst[n][1] = __builtin_bit_cast(bf16x8, hi_); } } } while (0)
#define PG8_MMA(ai, bj, At, Bt) do { __builtin_amdgcn_s_setprio(1); _Pragma("unroll") for (int m = 0; m < 4; ++m) _Pragma("unroll") for (int n = 0; n < 2; ++n) { \
        if constexpr (F8) asm volatile("v_mfma_scale_f32_16x16x128_f8f6f4 %0, %1, %2, %0, %3, %3 op_sel_hi:[0,0,0]" : "+v"(acc[ai][bj][m][n]) : "v"(Bt##8[n]), "v"(At##8[m]), "v"(f8scale));   \
        else { _Pragma("unroll") for (int k = 0; k < 2; ++k) acc[ai][bj][m][n] = __builtin_amdgcn_mfma_f32_16x16x32_bf16(Bt[n][k], At[m][k], acc[ai][bj][m][n], 0, 0, 0); } } \
        __builtin_amdgcn_s_setprio(0); } while (0)
#define PG8_WAIT_V(n) asm volatile("s_waitcnt vmcnt(" #n ")" ::: "memory")
#define PG8_WAIT_L(n) asm volatile("s_waitcnt lgkmcnt(" #n ")" ::: "memory")
#define PG8_BAR __builtin_amdgcn_s_barrier()
#define PG8_SCHED __builtin_amdgcn_sched_barrier(0)
    Unit cur, nxt; int ui = 0;
    if (!S.next(0, cur)) return;
    f32x4 acc[2][2][4][2];
#pragma unroll
    for (int a = 0; a < 2; ++a)
#pragma unroll
        for (int b = 0; b < 2; ++b)
#pragma unroll
            for (int m = 0; m < 4; ++m)
#pragma unroll
                for (int n = 0; n < 2; ++n) acc[a][b][m][n] = (f32x4){0.f, 0.f, 0.f, 0.f};
    typedef int i32x4_ __attribute__((ext_vector_type(4))); typedef int i32x8_ __attribute__((ext_vector_type(8)));
    int f8scale = 0x7f7f7f7f; asm volatile("" : "+v"(f8scale));
    bf16x8 At[4][2], B0[2][2], B1[2][2]; i32x8_ At8[4], B08[2], B18[2];
    const char* cA = S.abase(cur); const char* cB = S.bbase(cur);
    S.a_ready(cur);
    if constexpr (SP2) {
        PG8_STAGE(PG8_SB(0, 0), cB, voffB); PG8_STAGE(PG8_SB(0, 1), cB + hsB, voffB); PG8_STAGE(PG8_SA(0, 0), cA, voffA); PG8_STAGE(PG8_SA(0, 1), cA + hsA, voffA);
        if (wr == 1) PG8_BAR;
        PG8_WAIT_V(2); PG8_BAR;
        PG8_STAGE(PG8_SB(1, 0), cB + kstep, voffB); PG8_STAGE(PG8_SA(1, 0), cA + kstep, voffA); PG8_STAGE(PG8_SB(1, 1), cB + hsB + kstep, voffB);
        PG8_WAIT_V(6); PG8_BAR;
    } else {
        PG8_STAGE(PG8_SB(0, 0), cB, voffB); PG8_STAGE(PG8_SA(0, 0), cA, voffA); PG8_STAGE(PG8_SB(0, 1), cB + hsB, voffB); PG8_STAGE(PG8_SA(0, 1), cA + hsA, voffA);
        if (wr == 1) PG8_BAR;
        PG8_WAIT_V(4); PG8_BAR;
        PG8_STAGE(PG8_SB(1, 0), cB + kstep, voffB); PG8_STAGE(PG8_SA(1, 0), cA + kstep, voffA); PG8_STAGE(PG8_SB(1, 1), cB + hsB + kstep, voffB);
        PG8_WAIT_V(6); PG8_BAR;
    }
    for (;;) {
        const bool has_next = S.next(ui + 1, nxt);
        const char* nA = has_next ? S.abase(nxt) : cA; const char* nB = has_next ? S.bbase(nxt) : cB;
#pragma nounroll
        for (int t = 0; t < nt; t += 2) {
            const bool last = (t == nt - 2);
            const char* a1 = cA + (size_t)(t + 1) * kstep;
            const char* a2 = last ? nA : cA + (size_t)(t + 2) * kstep; const char* b2 = last ? nB : cB + (size_t)(t + 2) * kstep;
            const char* a3 = a2 + kstep; const char* b3 = b2 + kstep;
            if (last && has_next) S.a_ready(nxt);
            if constexpr (SP2) {
            PG8_LDB(B0, 0, 0); PG8_LDB(B1, 0, 1); PG8_SCHED; PG8_LDA(At, 0, 0); PG8_STAGE(PG8_SA(1, 1), a1 + hsA, voffA);
            PG8_WAIT_V(8); PG8_WAIT_L(0); PG8_BAR; PG8_MMA(0, 0, At, B0); PG8_MMA(0, 1, At, B1); PG8_BAR; PG8_SCHED;
            PG8_LDA(At, 0, 1); PG8_STAGE(PG8_SB(0, 0), b2, voffB); PG8_STAGE(PG8_SB(0, 1), b2 + hsB, voffB); PG8_STAGE(PG8_SA(0, 0), a2, voffA);
            PG8_WAIT_V(8); PG8_WAIT_L(0); PG8_BAR; PG8_MMA(1, 0, At, B0); PG8_MMA(1, 1, At, B1); PG8_BAR; PG8_SCHED;
            PG8_LDB(B0, 1, 0); PG8_LDB(B1, 1, 1); PG8_SCHED; PG8_LDA(At, 1, 0); PG8_STAGE(PG8_SA(0, 1), a2 + hsA, voffA);
            PG8_WAIT_V(8); PG8_WAIT_L(0); PG8_BAR; PG8_MMA(0, 0, At, B0); PG8_MMA(0, 1, At, B1); PG8_BAR; PG8_SCHED;
            PG8_LDA(At, 1, 1); PG8_STAGE(PG8_SB(1, 0), b3, voffB); PG8_STAGE(PG8_SB(1, 1), b3 + hsB, voffB); PG8_STAGE(PG8_SA(1, 0), a3, voffA);
            PG8_WAIT_V(8); PG8_WAIT_L(0); PG8_BAR; PG8_MMA(1, 0, At, B0); PG8_MMA(1, 1, At, B1); PG8_BAR; PG8_SCHED;
            } else {
            PG8_LDB(B0, 0, 0); PG8_SCHED; PG8_LDA(At, 0, 0); PG8_STAGE(PG8_SA(1, 1), a1 + hsA, voffA);
            PG8_WAIT_L(8); PG8_BAR; PG8_WAIT_L(0); PG8_MMA(0, 0, At, B0); PG8_BAR; PG8_SCHED;
            PG8_LDB(B1, 0, 1); PG8_STAGE(PG8_SB(0, 0), b2, voffB);
            PG8_BAR; PG8_WAIT_L(0); PG8_MMA(0, 1, At, B1); PG8_BAR;
            PG8_LDA(At, 0, 1); PG8_STAGE(PG8_SA(0, 0), a2, voffA);
            PG8_BAR; PG8_WAIT_L(0); PG8_MMA(1, 0, At, B0); PG8_BAR; PG8_SCHED;
            PG8_STAGE(PG8_SB(0, 1), b2 + hsB, voffB);
            PG8_WAIT_V(6); PG8_BAR; PG8_MMA(1, 1, At, B1); PG8_BAR;
            PG8_LDB(B0, 1, 0); PG8_SCHED; PG8_LDA(At, 1, 0); PG8_STAGE(PG8_SA(0, 1), a2 + hsA, voffA);
            PG8_WAIT_L(8); PG8_BAR; PG8_WAIT_L(0); PG8_MMA(0, 0, At, B0); PG8_BAR; PG8_SCHED;
            PG8_LDB(B1, 1, 1); PG8_STAGE(PG8_SB(1, 0), b3, voffB);
            PG8_BAR; PG8_WAIT_L(0); PG8_MMA(0, 1, At, B1); PG8_BAR;
            PG8_LDA(At, 1, 1); PG8_STAGE(PG8_SA(1, 0), a3, voffA);
            PG8_BAR; PG8_WAIT_L(0); PG8_MMA(1, 0, At, B0); PG8_BAR; PG8_SCHED;
            PG8_STAGE(PG8_SB(1, 1), b3 + hsB, voffB);
            PG8_WAIT_V(6); PG8_BAR; PG8_MMA(1, 1, At, B1); PG8_BAR;
            }
        }
        if constexpr (ALIGN_EPI) { if (wr == 0) PG8_BAR; }
        if constexpr (!Epi::AFTER_DRAIN) { E(acc, cur, wr, wc, fr, fq); S.done(cur); }
        if (!has_next) break;
#pragma unroll
        for (int a = 0; a < 2; ++a)
#pragma unroll
            for (int b = 0; b < 2; ++b)
#pragma unroll
                for (int m = 0; m < 4; ++m)
#pragma unroll
                    for (int n = 0; n < 2; ++n) acc[a][b][m][n] = (f32x4){0.f, 0.f, 0.f, 0.f};
        cur = nxt; cA = nA; cB = nB; ++ui;
        if constexpr (ALIGN_EPI) { if (wr == 1) PG8_BAR; }
    }
    PG8_WAIT_V(0);
    if constexpr (!ALIGN_EPI) { if (wr == 0) PG8_BAR; }
    PG8_BAR;
    if constexpr (Epi::AFTER_DRAIN) { E.fused(acc, cur, wr, wc, fr, fq, lds, wid, lane); S.done(cur); }
#undef PG8_SA
#undef PG8_SB
#undef PG8_STAGE
#undef PG8_LDA
#undef PG8_LDB
#undef PG8_MMA
#undef PG8_WAIT_V
#undef PG8_WAIT_L
#undef PG8_BAR
#undef PG8_SCHED
}
}

#ifndef MOBA_MASK_ON
#define MOBA_MASK_ON 1
#endif
namespace attn_body {
using bf16=__hip_bfloat16;
using bf16x8=__attribute__((ext_vector_type(8)))short;
using s16x4=__attribute__((ext_vector_type(4)))short;
using f32x16=__attribute__((ext_vector_type(16)))float;
using u32x4=__attribute__((ext_vector_type(4)))unsigned;
constexpr int BATCH=2,NHEAD=16,SEQ=8192,D=64,DM=NHEAD*D;
constexpr int NW=8,QBLK=32,QB=QBLK*NW,KVBLK=64,NQB=SEQ/QB;
constexpr int ATTN_PITCH=DM, ATTN_UNIT_ROWS=QB;
__device__ __forceinline__ int crow(int r,int hi){return (r&3)+8*(r>>2)+4*hi;}
#define SBAR() __builtin_amdgcn_sched_barrier(0)
__device__ __forceinline__ void cmask(f32x16&p0,f32x16&p1,int jb,int qrel,int hi){
  const float NEG=-INFINITY; int d=qrel-(64*jb+4*hi); asm volatile("":"+v"(d));
  #pragma unroll
  for(int r=0;r<16;++r){const int c=(r&3)+8*(r>>2); if(c>d)p0[r]=NEG; if(c+32>d)p1[r]=NEG;}
}

constexpr int NSLOT=3, SLOTB=8192;
constexpr int LDS_K=0, LDS_V=NSLOT*SLOTB, LDS_WS=2*NSLOT*SLOTB, LDS_OST=LDS_WS+NW*64*4, LDS_BYTES=LDS_OST+NW*4096;
constexpr float C2=0.125f*1.4426950408889634f;
__device__ __forceinline__ void glds16(const void*gsrc,unsigned lds_dst){unsigned keep;
  asm volatile("s_mov_b32 %0, m0\n\ts_mov_b32 m0, %2\n\ts_nop 0\n\tglobal_load_lds_dwordx4 %1, off\n\ts_mov_b32 m0, %0":"=&s"(keep):"v"(gsrc),"s"(lds_dst):"memory");}
__device__ __forceinline__ float max3f(float a,float b,float c){float r;asm("v_max3_f32 %0, %1, %2, %3":"=v"(r):"v"(a),"v"(b),"v"(c));return r;}
__device__ __forceinline__ float max2f(float a,float b){float r;asm("v_max_f32_e32 %0, %1, %2":"=v"(r):"v"(a),"v"(b));return r;}
__device__ __forceinline__ float fadd_s(float a,float b){float r;asm("v_add_f32_e32 %0, %1, %2":"=v"(r):"v"(a),"v"(b));return r;}
__device__ __forceinline__ float fsub_s(float a,float b){float r;asm("v_sub_f32_e32 %0, %1, %2":"=v"(r):"v"(a),"v"(b));return r;}
typedef float f32x2_t __attribute__((ext_vector_type(2))); typedef __bf16 bf16x2_t __attribute__((ext_vector_type(2)));
__device__ __forceinline__ unsigned cvtpk_s(float lo,float hi){f32x2_t v={lo,hi};bf16x2_t b=__builtin_convertvector(v,bf16x2_t);return __builtin_bit_cast(unsigned,b);}
#define WAIT_BAR(N) asm volatile("s_waitcnt vmcnt(" #N ") lgkmcnt(0)\n\ts_barrier":::"memory")

__device__ __forceinline__ void qkt(f32x16&p0,f32x16&p1,const char*Kslot,const bf16x8*qr,int r32,int hi){
  const char*kb=Kslot+hi*1024+r32*16;
  #pragma unroll
  for(int d0=0;d0<4;++d0){
    const bf16x8 b0=*reinterpret_cast<const bf16x8*>(kb+d0*2048);
    const bf16x8 b1=*reinterpret_cast<const bf16x8*>(kb+d0*2048+512);
    if(d0==0){p0=__builtin_amdgcn_mfma_f32_32x32x16_bf16(b0,qr[0],f32x16{},0,0,0);p1=__builtin_amdgcn_mfma_f32_32x32x16_bf16(b1,qr[0],f32x16{},0,0,0);}
    else{p0=__builtin_amdgcn_mfma_f32_32x32x16_bf16(b0,qr[d0],p0,0,0,0);p1=__builtin_amdgcn_mfma_f32_32x32x16_bf16(b1,qr[d0],p1,0,0,0);}}
}
typedef __attribute__((address_space(3))) const char* lds_cptr;
typedef short v4i16_t __attribute__((ext_vector_type(4)));
__device__ __forceinline__ void kload8(bf16x8*kf,lds_cptr kp){
  kf[0]=*(const __attribute__((address_space(3))) bf16x8*)(kp);      kf[1]=*(const __attribute__((address_space(3))) bf16x8*)(kp+512);
  kf[2]=*(const __attribute__((address_space(3))) bf16x8*)(kp+2048); kf[3]=*(const __attribute__((address_space(3))) bf16x8*)(kp+2560);
  kf[4]=*(const __attribute__((address_space(3))) bf16x8*)(kp+4096); kf[5]=*(const __attribute__((address_space(3))) bf16x8*)(kp+4608);
  kf[6]=*(const __attribute__((address_space(3))) bf16x8*)(kp+6144); kf[7]=*(const __attribute__((address_space(3))) bf16x8*)(kp+6656);
}
__device__ __forceinline__ void kload2(bf16x8*kf,lds_cptr kp,int j){ kf[2*j]=*(const __attribute__((address_space(3))) bf16x8*)(kp+j*2048); kf[2*j+1]=*(const __attribute__((address_space(3))) bf16x8*)(kp+j*2048+512); }
__device__ __forceinline__ s16x4 vtr(lds_cptr p){ return __builtin_bit_cast(s16x4,__builtin_amdgcn_ds_read_tr16_b64_v4i16((__attribute__((address_space(3))) v4i16_t*)p)); }
__device__ __forceinline__ float rowmax(const f32x16&p0,const f32x16&p1){
  float a=max3f(p0[0],p0[1],p1[0]),b=max3f(p0[2],p0[3],p1[1]);a=max3f(a,p1[2],p1[3]);
  #pragma unroll
  for(int r=4;r<16;r+=4){a=max3f(a,p0[r],p0[r+1]);b=max3f(b,p0[r+2],p0[r+3]);a=max3f(a,p1[r],p1[r+1]);b=max3f(b,p1[r+2],p1[r+3]);}
  const float m=max2f(a,b);
  auto rr=__builtin_amdgcn_permlane32_swap(__float_as_uint(m),__float_as_uint(m),false,false);
  return max2f(__uint_as_float(rr[0]),__uint_as_float(rr[1]));
}
__device__ __forceinline__ void pv(f32x16*o,int vb,bf16x8 pa0,bf16x8 pa1,bf16x8 pa2,bf16x8 pa3){
  #pragma unroll
  for(int d0=0;d0<2;++d0){s16x4 lo[4],hi[4];
    #pragma unroll
    for(int ks=0;ks<4;++ks){
      asm volatile("ds_read_b64_tr_b16 %0,%1 offset:%c2":"=&v"(lo[ks]):"v"(vb),"i"(d0*4096+ks*1024):"memory");
      asm volatile("ds_read_b64_tr_b16 %0,%1 offset:%c2":"=&v"(hi[ks]):"v"(vb),"i"(d0*4096+ks*1024+512):"memory");}
    asm volatile("s_waitcnt lgkmcnt(0)":::"memory");SBAR();
    #define PK(k) (bf16x8){lo[k][0],lo[k][1],lo[k][2],lo[k][3],hi[k][0],hi[k][1],hi[k][2],hi[k][3]}
    o[d0]=__builtin_amdgcn_mfma_f32_32x32x16_bf16(pa0,PK(0),o[d0],0,0,0);
    o[d0]=__builtin_amdgcn_mfma_f32_32x32x16_bf16(pa1,PK(1),o[d0],0,0,0);
    o[d0]=__builtin_amdgcn_mfma_f32_32x32x16_bf16(pa2,PK(2),o[d0],0,0,0);
    o[d0]=__builtin_amdgcn_mfma_f32_32x32x16_bf16(pa3,PK(3),o[d0],0,0,0);
    #undef PK
  }
}

#ifndef ATTN_STORE16
#define ATTN_STORE16(p,v) (*(u32x4*)(p)=(v))
#endif
template<int THRL> __device__ __forceinline__ void attn_unit(int b,int h,int qb,const bf16*Q,const bf16*__restrict__ K,const bf16*__restrict__ V,bf16*O,const unsigned*__restrict__ SEL,char*shm,int wave){
  const int lane=fresh_lane(),wid=wave,tid=wid*64+lane,r32=lane&31,hi=lane>>5; (void)tid;
  const long rowbase=(long)b*SEQ; const int q0=qb*QB;
  const bf16*Qw=Q+(rowbase+q0+wid*QBLK)*DM+h*D;
  const bf16*Kh=K+rowbase*DM+h*D,*Vh=V+rowbase*DM+h*D;
  const unsigned lds0=(unsigned)(uintptr_t)shm;
  float*wsf=(float*)(shm+LDS_WS)+wid*64;
  const bf16*ksrc=Kh+(long)lane*DM+wid*8;
  const bf16*vsrc=Vh+(long)(16*(wid&3)+(lane>>2))*DM+(wid>>2)*32+(lane&3)*8;
  const unsigned kdst=lds0+LDS_K+wid*1024, vdst=lds0+LDS_V+wid*1024;
  #define DMA_K(t,slot) glds16(ksrc+(long)(t)*KVBLK*DM,(unsigned)__builtin_amdgcn_readfirstlane(kdst+(slot)))
  #define DMA_V(t,slot) glds16(vsrc+(long)(t)*KVBLK*DM,(unsigned)__builtin_amdgcn_readfirstlane(vdst+(slot)))
  const int vb0=(int)(lds0+LDS_V)+((lane>>4)&1)*32+(lane&3)*8+(4*hi+((lane&15)>>2))*64;
  const char*Kbase=shm+LDS_K; bf16x8 kf[8];
  const lds_cptr shm3=(lds_cptr)shm; const lds_cptr kp0=shm3+LDS_K+hi*1024+r32*16; const lds_cptr vp0=shm3+LDS_V+((lane>>4)&1)*32+(lane&3)*8+(4*hi+((lane&15)>>2))*64;
  const int NT=(q0+QB)/KVBLK;
  DMA_K(0,0);DMA_V(0,0);DMA_K(1,SLOTB);
  bf16x8 qr[4];
  #pragma unroll
  for(int d0=0;d0<4;++d0)qr[d0]=*reinterpret_cast<const bf16x8*>(&Qw[(long)r32*DM+d0*16+hi*8]);
  float mhat=0.f,l_reg=0.f;f32x16 o[2];o[0]=f32x16{};o[1]=f32x16{};
  const int qrel=wid*QBLK+r32;
  #define SELW() ((volatile __attribute__((address_space(3))) unsigned*)(lds_cptr)((const char*)wsf)+32+r32)
  if(hi==0)*SELW()=SEL[(rowbase+q0+qrel)*NHEAD+h];
  asm volatile("s_waitcnt vmcnt(0) lgkmcnt(0)":::"memory");
  #define CMASK(P0,P1,t) do{int jb_=(t)-(NT-4); if(jb_>=0)cmask(P0,P1,jb_,qrel,hi); else if(MOBA_MASK_ON && !(((*SELW())>>((t)>>2))&1u)){ _Pragma("unroll") for(int r_=0;r_<16;++r_){P0[r_]=-INFINITY;P1[r_]=-INFINITY;} } }while(0)
  bool resc=false;
  #define START(P0,P1) do{ const float rm=rowmax(P0,P1); resc=false; \
    { const float dl=max2f(rm,-100.f); mhat=fadd_s(mhat,dl); \
      _Pragma("unroll") for(int r=0;r<16;++r){P0[r]=fsub_s(P0[r],dl);P1[r]=fsub_s(P1[r],dl);} \
      } \
    _Pragma("unroll") for(int r=0;r<16;++r)P0[r]=__builtin_amdgcn_exp2f(P0[r]); }while(0)
  #define RESC() do{ if(resc){ asm volatile("s_waitcnt lgkmcnt(0)":::"memory"); \
      _Pragma("unroll") for(int d_=0;d_<2;++d_) _Pragma("unroll") for(int r=0;r<16;++r)o[d_][r]*=wsf[crow(r,hi)]; } }while(0)
  f32x16 pA0,pA1,pB0,pB1;
  int sl_prev=0,sl_cur=0,sl_next=SLOTB;
  #define ROT() do{sl_prev=sl_cur;sl_cur=sl_next;sl_next=(sl_next==(NSLOT-1)*SLOTB)?0:sl_next+SLOTB;}while(0)
  DMA_K(2,2*SLOTB);
  WAIT_BAR(3);
  qkt(pA0,pA1,Kbase,qr,r32,hi);asm volatile("s_nop 15\n\ts_nop 7":"+v"(pA0),"+v"(pA1));CMASK(pA0,pA1,0);
  START(pA0,pA1);
  _Pragma("unroll") for(int r=0;r<16;++r)pA1[r]=__builtin_amdgcn_exp2f(pA1[r]);
  WAIT_BAR(0);
  DMA_K(3,0);DMA_V(1,SLOTB);
  ROT();
  kload8(kf,kp0+sl_cur);
  WAIT_BAR(2);
  s16x4 vlo[8],vhi[8]; u32x4 pw0,pw1,pw2,pw3;
  #define PKW(P,B) cvtpk_s(P[B],P[B+1])
  #define PAF(k) __builtin_bit_cast(bf16x8,pw##k)
  #define VFR(i) (bf16x8){vlo[i][0],vlo[i][1],vlo[i][2],vlo[i][3],vhi[i][0],vhi[i][1],vhi[i][2],vhi[i][3]}
  #define PIN(x) asm volatile("":"+v"(x))
  #define MX3(a,b,c) __builtin_fmaxf(__builtin_fmaxf((a),(b)),(c))
  #define GAPA(MF,A0,A1,A2,A3,W0,W1,PW) do{ MF; sacc+=A0; sacc+=A1; sacc+=A2; sacc+=A3; PIN(sacc); W0; W1; PIN(PW); SBAR(); }while(0)
  #define EX(v) __builtin_amdgcn_exp2f(v)
  #define GAPB(MF,X,B) do{ MF; X[B]=EX(X[B]); X[B+1]=EX(X[B+1]); X[B+2]=EX(X[B+2]); X[B+3]=EX(X[B+3]); PIN(X); SBAR(); }while(0)
  #define VRD(i) do{ vlo[i]=vtr(vp_+(((i)>>2)*4096+((i)&3)*1024)); vhi[i]=vtr(vp_+(((i)>>2)*4096+((i)&3)*1024+512)); }while(0)
  #define KRD(G,j) do{ if(G){ kload2(kf,kp0+sl_next,j); SBAR(); } }while(0)
  #define STEP(C0,C1,P0,P1,t,GK,GV,GL) do{ SBAR(); \
    const lds_cptr vp_=vp0+sl_prev; \
    VRD(0); SBAR(); float sacc=(P0[0]+P0[1]); \
    GAPA(C0=__builtin_amdgcn_mfma_f32_32x32x16_bf16(kf[0],qr[0],f32x16{},0,0,0), P0[2],P0[3],P0[4],P0[5],     pw0[0]=PKW(P0,0), pw0[1]=PKW(P0,2), pw0); \
    VRD(4); SBAR(); GAPA(C1=__builtin_amdgcn_mfma_f32_32x32x16_bf16(kf[1],qr[0],f32x16{},0,0,0), P0[6],P0[7],P0[8],P0[9],     pw0[2]=PKW(P0,4), pw0[3]=PKW(P0,6), pw0); \
    VRD(1); SBAR(); GAPA(C0=__builtin_amdgcn_mfma_f32_32x32x16_bf16(kf[2],qr[1],C0,0,0,0),   P0[10],P0[11],P0[12],P0[13], pw1[0]=PKW(P0,8), pw1[1]=PKW(P0,10), pw1); \
    VRD(5); SBAR(); GAPA(C1=__builtin_amdgcn_mfma_f32_32x32x16_bf16(kf[3],qr[1],C1,0,0,0),   P0[14],P0[15],P1[0],P1[1],   pw1[2]=PKW(P0,12),pw1[3]=PKW(P0,14), pw1); \
    VRD(2); SBAR(); GAPA(C0=__builtin_amdgcn_mfma_f32_32x32x16_bf16(kf[4],qr[2],C0,0,0,0),   P1[2],P1[3],P1[4],P1[5],     pw2[0]=PKW(P1,0), pw2[1]=PKW(P1,2), pw2); \
    VRD(6); SBAR(); GAPA(C1=__builtin_amdgcn_mfma_f32_32x32x16_bf16(kf[5],qr[2],C1,0,0,0),   P1[6],P1[7],P1[8],P1[9],     pw2[2]=PKW(P1,4), pw2[3]=PKW(P1,6), pw2); \
    VRD(3); SBAR(); GAPA(C0=__builtin_amdgcn_mfma_f32_32x32x16_bf16(kf[6],qr[3],C0,0,0,0),   P1[10],P1[11],P1[12],P1[13], pw3[0]=PKW(P1,8), pw3[1]=PKW(P1,10), pw3); \
    VRD(7); SBAR(); GAPA(C1=__builtin_amdgcn_mfma_f32_32x32x16_bf16(kf[7],qr[3],C1,0,0,0),   P1[14],P1[15],0.f,0.f,       pw3[2]=PKW(P1,12),pw3[3]=PKW(P1,14), pw3); \
    l_reg+=sacc; \
    if(GK){DMA_K((t)+3,sl_cur);} if(GV){DMA_V((t)+1,sl_next);} \
    _Pragma("unroll") for(int r=0;r<16;++r){C0[r]-=mhat;C1[r]-=mhat;} \
    CMASK(C0,C1,t); \
    { float a=MX3(C0[0],C0[1],C1[0]),b=MX3(C0[2],C0[3],C1[1]); a=MX3(a,C1[2],C1[3]); \
      _Pragma("unroll") for(int r=4;r<16;r+=4){a=MX3(a,C0[r],C0[r+1]);b=MX3(b,C0[r+2],C0[r+3]);a=MX3(a,C1[r],C1[r+1]);b=MX3(b,C1[r+2],C1[r+3]);} \
      float rm=__builtin_fmaxf(a,b); { auto rr=__builtin_amdgcn_permlane32_swap(__float_as_uint(rm),__float_as_uint(rm),false,false); rm=__builtin_fmaxf(__uint_as_float(rr[0]),__uint_as_float(rr[1])); } \
      resc=false; \
      if(__builtin_expect(__any(rm>(float)THRL),0)){ const float dl=__builtin_fmaxf(rm,0.f); mhat+=dl; \
        _Pragma("unroll") for(int r=0;r<16;++r){C0[r]-=dl;C1[r]-=dl;} \
        const float f=__builtin_amdgcn_exp2f(-dl); l_reg*=f; if(hi==0)wsf[r32]=f; resc=true; } } \
    SBAR(); \
    GAPB(o[0]=__builtin_amdgcn_mfma_f32_32x32x16_bf16(PAF(0),VFR(0),o[0],0,0,0), C0,0); \
    GAPB(o[1]=__builtin_amdgcn_mfma_f32_32x32x16_bf16(PAF(0),VFR(4),o[1],0,0,0), C0,4); \
    KRD(GL,0); GAPB(o[0]=__builtin_amdgcn_mfma_f32_32x32x16_bf16(PAF(1),VFR(1),o[0],0,0,0), C0,8); \
    KRD(GL,1); GAPB(o[1]=__builtin_amdgcn_mfma_f32_32x32x16_bf16(PAF(1),VFR(5),o[1],0,0,0), C0,12); \
    KRD(GL,2); GAPB(o[0]=__builtin_amdgcn_mfma_f32_32x32x16_bf16(PAF(2),VFR(2),o[0],0,0,0), C1,0); \
    KRD(GL,3); GAPB(o[1]=__builtin_amdgcn_mfma_f32_32x32x16_bf16(PAF(2),VFR(6),o[1],0,0,0), C1,4); \
    GAPB(o[0]=__builtin_amdgcn_mfma_f32_32x32x16_bf16(PAF(3),VFR(3),o[0],0,0,0), C1,8); \
    GAPB(o[1]=__builtin_amdgcn_mfma_f32_32x32x16_bf16(PAF(3),VFR(7),o[1],0,0,0), C1,12); \
    }while(0)
  int t=1;
  for(;t+5<NT;t+=2){
    STEP(pB0,pB1,pA0,pA1,t,true,true,true);     WAIT_BAR(2); RESC(); ROT();
    STEP(pA0,pA1,pB0,pB1,t+1,true,true,true);   WAIT_BAR(2); RESC(); ROT();
  }
  #undef CMASK
  #define CMASK(P0,P1,t) do{int jb_=(t)-(NT-4); if(jb_>=0)cmask(P0,P1,jb_,qrel,hi); else if(MOBA_MASK_ON && !(((*SELW())>>((t)>>2))&1u)){ _Pragma("unroll") for(int r_=0;r_<16;++r_){P0[r_]=-INFINITY;P1[r_]=-INFINITY;} } }while(0)
  #define ENDW(tt) do{ if((tt)+3<NT){WAIT_BAR(2);} else if((tt)+2<NT){WAIT_BAR(1);} else {WAIT_BAR(0);} }while(0)
  for(;t+1<NT;t+=2){
    STEP(pB0,pB1,pA0,pA1,t,(t+3<NT),(t+1<NT),(t+1<NT));       ENDW(t);   RESC(); ROT();
    STEP(pA0,pA1,pB0,pB1,t+1,(t+4<NT),(t+2<NT),(t+2<NT));     ENDW(t+1); RESC(); ROT();
  }
  STEP(pB0,pB1,pA0,pA1,NT-1,false,false,false); RESC();
  { float sacc=pB0[0]+pB0[1]; _Pragma("unroll") for(int r=2;r<16;++r)sacc+=pB0[r]; _Pragma("unroll") for(int r=0;r<16;++r)sacc+=pB1[r]; l_reg+=sacc;
    pw0=(u32x4){PKW(pB0,0),PKW(pB0,2),PKW(pB0,4),PKW(pB0,6)};pw1=(u32x4){PKW(pB0,8),PKW(pB0,10),PKW(pB0,12),PKW(pB0,14)};pw2=(u32x4){PKW(pB1,0),PKW(pB1,2),PKW(pB1,4),PKW(pB1,6)};pw3=(u32x4){PKW(pB1,8),PKW(pB1,10),PKW(pB1,12),PKW(pB1,14)};
    SBAR(); pv(o,vb0+sl_cur,PAF(0),PAF(1),PAF(2),PAF(3)); }
  #undef PKW
  #undef PAF
  #undef VFR
  #undef PIN
  #undef MX3
  #undef GAPA
  #undef GAPB
  #undef EX
  #undef VRD
  #undef KRD
  #undef STEP
  #undef ENDW
  {auto rr=__builtin_amdgcn_permlane32_swap(__float_as_uint(l_reg),__float_as_uint(l_reg),false,false);l_reg=__uint_as_float(rr[0])+__uint_as_float(rr[1]);}
  if(hi==0)wsf[32+r32]=l_reg;asm volatile("s_waitcnt lgkmcnt(0)":::"memory");
  float rli[16];
  #pragma unroll
  for(int r=0;r<16;++r)rli[r]=__builtin_amdgcn_rcpf(wsf[32+crow(r,hi)]);
  bf16*Ow=O+(rowbase+q0+wid*QBLK)*DM+h*D;
  { bf16*stg=(bf16*)(shm+LDS_OST)+wid*2048;
    #pragma unroll
    for(int r=0;r<16;++r){const int orow=crow(r,hi);
      #pragma unroll
      for(int d0=0;d0<2;++d0)stg[orow*64+d0*32+r32]=__float2bfloat16(o[d0][r]*rli[r]);}
    asm volatile("s_waitcnt lgkmcnt(0)":::"memory");
    #pragma unroll
    for(int i=0;i<4;++i){const int row=i*8+(lane>>3),ch=lane&7; const u32x4 v=*(const u32x4*)(stg+row*64+ch*8); ATTN_STORE16(Ow+(long)row*DM+ch*8,v);} }
  asm volatile("s_waitcnt lgkmcnt(0)\n\ts_barrier":::"memory");
  #undef SELW
  #undef DMA_K
  #undef DMA_V
  #undef CMASK
  #undef START
  #undef RESC
  #undef ROT
}
constexpr int ATTN_LDS_BYTES=LDS_BYTES;
struct AttnTensors { const bf16* Q; const bf16* K; const bf16* V; bf16* O; const unsigned* SEL; };
struct AttnUnit { int bh; int qb; };
struct StaticOrder {
  int vcu;
  __device__ __forceinline__ explicit StaticOrder(int grid,int block):vcu((block%8)*(grid/8)+block/8){}
  __device__ __forceinline__ bool next(int i,AttnUnit&u)const{ if(i>=4)return false; const int s=vcu&7; u.bh=vcu>>3; u.qb=(i==0)?s:(i==1)?15-s:(i==2)?16+s:31-s; return true; }
  __device__ __forceinline__ void a_ready(const AttnUnit&)const{}
  __device__ __forceinline__ void done(const AttnUnit&)const{}
};
template<class Sched,int THRL=8> __device__ __forceinline__ void attn_phase(char*lds,const AttnTensors&T,const Sched&S,int wave){
  AttnUnit u;
  for(int i=0;S.next(i,u);++i){ S.a_ready(u); attn_unit<THRL>(u.bh/NHEAD,u.bh%NHEAD,u.qb,T.Q,T.K,T.V,T.O,T.SEL,lds,wave); S.done(u); }
}
#undef SBAR
#undef WAIT_BAR
}

constexpr int NWAVES = 8;
constexpr int BATCH = 2, T = 8192, D = 1024, H = 16, HD = 64, M = BATCH * T;
constexpr int FF = 2816, FFE = 3584, NE = 8, MOE_ROWS = 34816  ;
#ifndef MOE_DOWN_F8
#define MOE_DOWN_F8 1
#endif
constexpr float MOE_HSCALE = 16.f, MOE_DSCALE = 256.f;
constexpr float MOE_WSCALE = 64.f;
constexpr float LN_EPS = 1e-5f, GN_EPS = 64e-5f, ALPHA = 1.6817928305074292f  ;
constexpr size_t MiB = 1u << 20;
constexpr size_t WS_CTL = 0, CTL_ZERO_BYTES = 1 * MiB;
constexpr size_t WS_KMEAN = 1 * MiB;
constexpr size_t WS_SEL = 2 * MiB;
constexpr size_t WS_TOKE = 3 * MiB;
constexpr size_t WS_TOKW = WS_TOKE + 128 * 1024;
constexpr size_t WS_TOKR = WS_TOKW + 128 * 1024;
constexpr size_t WS_GW = WS_TOKR + 128 * 1024;
constexpr size_t WS_BLKCNT = WS_GW + 256 * 1024;
constexpr size_t WS_WMIX = 16 * MiB;
constexpr size_t WS_WFFN = 32 * MiB;
constexpr size_t WS_H = 200 * MiB;
constexpr size_t WS_HB = 264 * MiB;
constexpr size_t WS_K = 296 * MiB, WS_V = 328 * MiB;
constexpr size_t WS_VFIRST = WS_K;
constexpr size_t WS_Y = WS_V;
constexpr size_t WS_SCR = 360 * MiB;
constexpr size_t WS_END = 896 * MiB;
constexpr size_t RS_XM = WS_SCR;
constexpr size_t RS_KP = WS_SCR, RS_AP = WS_SCR + 32 * MiB, RS_VP = WS_SCR + 64 * MiB, RS_BP = WS_SCR + 96 * MiB;
constexpr size_t RS_RKV = WS_SCR + 192 * MiB;
constexpr size_t RS_PRE = RS_RKV;
constexpr size_t RS_LH = WS_SCR + 288 * MiB;
constexpr size_t RS_YG = RS_LH;
constexpr size_t RS_YGC = WS_SCR + 128 * MiB;
#ifdef WKV_SEQ
constexpr size_t RS_YGX = RS_YG;
#else
constexpr size_t RS_YGX = RS_YGC;
#endif
constexpr size_t RS_DEC = WS_SCR + 320 * MiB;
constexpr size_t RS_AB = WS_SCR + 384 * MiB;
constexpr size_t RS_REC0 = WS_SCR + 224 * MiB, RS_REC1 = WS_SCR + 384 * MiB;
constexpr size_t RS_VG = WS_SCR + 448 * MiB;
constexpr size_t RS_GG = WS_SCR + 480 * MiB;
constexpr size_t BS_Q = WS_SCR, BS_PRE = WS_SCR + 32 * MiB, BS_O = WS_SCR + 96 * MiB;
constexpr size_t BS_PO = WS_SCR + 128 * MiB, BS_ML = WS_SCR + 256 * MiB;
constexpr size_t FS_HID = WS_SCR, FS_PRE = WS_SCR + 88 * MiB;
constexpr size_t ES_XG = WS_SCR, ES_HID = WS_SCR + 68 * MiB, ES_YP = WS_SCR + 306 * MiB, ES_YS = WS_SCR + 442 * MiB;
static_assert(RS_GG + 32 * MiB <= WS_END && ES_YS + 56 * MiB <= WS_END && FS_PRE + 64 * MiB <= WS_END, "d_ws map");
constexpr size_t RW_LSTRIDE = 872 * MiB - WS_WMIX;
constexpr size_t WM_BT1 = WS_WMIX, WM_BT2 = WS_WMIX + 8 * MiB, WM_OUT = WS_WMIX + 10 * MiB;
constexpr size_t WM_QKV = WS_WMIX, WM_O = WS_WMIX + 8 * MiB;
constexpr size_t WF_GU = 4 * MiB, WF_DN = 884 * MiB;
constexpr size_t WE_SET = 84 * MiB, WE_GU = WS_WFFN, WE_DN = WS_WFFN + 56 * MiB;
static_assert(MOE_DOWN_F8 == 1, "the two-set MoE weight map assumes the fp8 down projection");
constexpr size_t WM_Q3 = WS_WMIX + 12 * MiB, WM_O3 = WS_WMIX + 14 * MiB;
constexpr size_t WS_XBUF = 15 * MiB;
constexpr int CW_SEAM = 16384, SEAM_BANK = 128 * 64;
constexpr int CW_TMO = 0, CW_CODE = 1, CW_QCTR = 2048  , CW_BAR = 4096;
constexpr int RING_OFF = 0, RING_BYTES = 131072;
constexpr int LDSCTL_OFF = RING_BYTES, MISC_OFF = LDSCTL_OFF + 320;
constexpr int LDS_BYTES = 147456;
static_assert(MISC_OFF + 128 <= LDS_BYTES, "LDS map");

#define GAS __attribute__((address_space(1)))
#define LAS __attribute__((address_space(3)))
typedef unsigned short bf16;
typedef unsigned v4u __attribute__((ext_vector_type(4)));
typedef float f32x4 __attribute__((ext_vector_type(4)));
typedef short bf16x8 __attribute__((ext_vector_type(8)));
typedef GAS unsigned gu32;
typedef GAS unsigned long long gu64;
#define RLX_AGENT __ATOMIC_RELAXED, __HIP_MEMORY_SCOPE_AGENT
#define LDS_WAIT() asm volatile("s_waitcnt lgkmcnt(0)" ::: "memory")
#define VM_WAIT() asm volatile("s_waitcnt vmcnt(0)" ::: "memory")
__device__ __forceinline__ unsigned long long rt() { return __builtin_amdgcn_s_memrealtime(); }
__device__ __forceinline__ unsigned f2bf(float f) { unsigned u = __builtin_bit_cast(unsigned, f); return (u + 0x7fffu + ((u >> 16) & 1u)) >> 16; }
__device__ __forceinline__ unsigned pk2(float lo, float hi) { return f2bf(lo) | (f2bf(hi) << 16); }

#define XB_TMO      128
#define XB_XCNT(j)  (256  + 64 * (j))
#define XB_XSUB(j)  (1280 + 64 * (j))
#define XB_XGEN(j)  (2304 + 64 * (j))
#define XB_TOP      3328
#define XB_TOPGEN   3392
#define XCD_BAR_WORDS 3456
#define XB_SPIN_CAP (1u << 18)

__device__ __forceinline__ unsigned xb_ld(unsigned* p)              { return __hip_atomic_load(p, __ATOMIC_RELAXED, __HIP_MEMORY_SCOPE_AGENT); }
__device__ __forceinline__ unsigned xb_add(unsigned* p, unsigned v) { return __hip_atomic_fetch_add(p, v, __ATOMIC_RELAXED, __HIP_MEMORY_SCOPE_AGENT); }
__device__ __forceinline__ unsigned xb_xcc_id() { return (unsigned)__builtin_amdgcn_s_getreg((3 << 11) | 20) & 0xFu; }
#define XB_SPIN(cond, bar) do { unsigned _sp = 0; while (cond) { __builtin_amdgcn_s_sleep(1); \
    if ((++_sp & 255u) == 0u) { if (xb_ld(&(bar)[XB_TMO])) break; if (_sp > XB_SPIN_CAP) { atomicAdd(&(bar)[XB_TMO], 1u); break; } } } } while (0)

struct XcdBarrier {
    unsigned* bar; unsigned x;
    volatile LAS unsigned* st;
};

__device__ __forceinline__ XcdBarrier xcd_barrier_post(unsigned* bar, volatile LAS unsigned* st, bool t0  ) {
    XcdBarrier b; b.bar = bar; b.x = xb_xcc_id(); b.st = st;
    if (t0) (void)xb_add(&bar[XB_XCNT(b.x)], 1u);
    return b;
}
__device__ __forceinline__ void xcd_barrier_complete(unsigned* bar, unsigned x, unsigned& nloc, unsigned& nx) {
    const unsigned G = gridDim.x * gridDim.y * gridDim.z;
    unsigned sum, cnt, mine, sp = 0u;
    for (;;) {
        sum = 0u; cnt = 0u; mine = 0u;
#pragma unroll
        for (unsigned j = 0; j < 16; ++j) { const unsigned c = xb_ld(&bar[XB_XCNT(j)]); sum += c; cnt += (c > 0u) ? 1u : 0u; mine = (j == x) ? c : mine; }
        if (sum == G) break;
        __builtin_amdgcn_s_sleep(1);
        if ((++sp & 255u) == 0u) { if (xb_ld(&bar[XB_TMO])) break; if (sp > XB_SPIN_CAP) { atomicAdd(&bar[XB_TMO], 1u); break; } }
    }
    nloc = mine > 0u ? mine : 1u; nx = cnt > 0u ? cnt : 1u;
}

__device__ __forceinline__ void xcd_barrier(const XcdBarrier& b, bool t0  ) {
    asm volatile("s_waitcnt vmcnt(0)" ::: "memory");
    __syncthreads();
    if (t0) {
        unsigned* bar = b.bar;
        __builtin_amdgcn_s_waitcnt(0);
        unsigned nloc = b.st[0], nx = b.st[1];
        if (nloc == 0u) { xcd_barrier_complete(bar, b.x, nloc, nx); b.st[0] = nloc; b.st[1] = nx; }
        const unsigned old = xb_add(&bar[XB_XSUB(b.x)], 1u);
        const unsigned gen = old / nloc;
        if (old + 1u == (gen + 1u) * nloc) {
            __builtin_amdgcn_fence(__ATOMIC_RELEASE, "agent");
            asm volatile("s_waitcnt vmcnt(0)" ::: "memory");
            const unsigned og = xb_add(&bar[XB_TOP], 1u);
            const unsigned tg = og / nx;
            if (og + 1u == (tg + 1u) * nx) xb_add(&bar[XB_TOPGEN], 1u);
            else XB_SPIN(xb_ld(&bar[XB_TOPGEN]) == tg, bar);
#ifdef XB_L2_INV
            __builtin_amdgcn_fence(__ATOMIC_ACQUIRE, "");
#else
            __builtin_amdgcn_fence(__ATOMIC_ACQUIRE, "agent");
#endif
            xb_add(&bar[XB_XGEN(b.x)], 1u);
            asm volatile("s_waitcnt vmcnt(0)" ::: "memory");
        } else {
            XB_SPIN(xb_ld(&bar[XB_XGEN(b.x)]) == gen, bar);
            __builtin_amdgcn_fence(__ATOMIC_ACQUIRE, "agent");
            asm volatile("s_waitcnt vmcnt(0)" ::: "memory");
        }
    }
    __syncthreads();
}

struct Args { const float* in[33]; float* out; unsigned char* ws; };
enum InIdx { I_X = 0, I_MU, I_WRKV, I_WOUT, I_W0, I_W1, I_W2, I_A0, I_A1, I_A2, I_V0, I_V1, I_V2, I_G1, I_G2, I_KK, I_KA, I_RK, I_GNG, I_GNB,
             I_MK, I_MV, I_MQ, I_MO, I_FG, I_FU, I_FD, I_ROUTER, I_EG, I_EU, I_ED, I_LNG, I_LNB };
struct Frame {
    LAS unsigned char* lds; volatile LAS unsigned* MISC; gu32* ctl; unsigned char* ws;
    int tid, lane, wave, vcu, G, gw, NGW;
};
typedef float f32x2 __attribute__((ext_vector_type(2)));
typedef unsigned u32x2 __attribute__((ext_vector_type(2)));
__device__ __forceinline__ float dpp_sum16(float v) {
    v += __builtin_bit_cast(float, __builtin_amdgcn_update_dpp(0, __builtin_bit_cast(int, v), 0xB1, 0xF, 0xF, true));
    v += __builtin_bit_cast(float, __builtin_amdgcn_update_dpp(0, __builtin_bit_cast(int, v), 0x4E, 0xF, 0xF, true));
    v += __builtin_bit_cast(float, __builtin_amdgcn_update_dpp(0, __builtin_bit_cast(int, v), 0x141, 0xF, 0xF, true));
    v += __builtin_bit_cast(float, __builtin_amdgcn_update_dpp(0, __builtin_bit_cast(int, v), 0x140, 0xF, 0xF, true));
    return v;
}
__device__ __forceinline__ float wave_sum(float v, int lane) {
    v = dpp_sum16(v);
    v += __builtin_bit_cast(float, __builtin_amdgcn_ds_bpermute((lane ^ 16) << 2, __builtin_bit_cast(int, v)));
    v += __builtin_bit_cast(float, __builtin_amdgcn_ds_bpermute((lane ^ 32) << 2, __builtin_bit_cast(int, v)));
    return v;
}
__device__ __forceinline__ float sum16(float v) { return dpp_sum16(v); }
__device__ __forceinline__ float bf2f(unsigned short b) { return __uint_as_float((unsigned)b << 16); }
__device__ __forceinline__ f32x4 bf4_to_f32(u32x2 w) { f32x4 r; r.x = __uint_as_float(w.x << 16); r.y = __uint_as_float(w.x & 0xffff0000u); r.z = __uint_as_float(w.y << 16); r.w = __uint_as_float(w.y & 0xffff0000u); return r; }
__device__ __forceinline__ u32x2 f32_to_bf4(f32x4 v) { u32x2 w; w.x = pk2(v.x, v.y); w.y = pk2(v.z, v.w); return w; }

__device__ __forceinline__ void tr_item(const float* W, int ldw, int Kr, int Nr, int nblk, bf16* WT, int ldt, int row0, int mode, LAS float* scr, int item, int lane) {
    const int kb = item / nblk, nb = item - kb * nblk, k0 = 64 * kb, n0 = 32 * nb;
    const int kg = lane >> 3, n = n0 + 4 * (lane & 7), kk = k0 + 8 * kg;
    f32x4 v[8];
#pragma unroll
    for (int i = 0; i < 8; ++i) { v[i] = (f32x4){0.f, 0.f, 0.f, 0.f}; if (kk + i < Kr && n < Nr) v[i] = *(const f32x4*)(W + (size_t)(kk + i) * ldw + n); }
#pragma unroll
    for (int e = 0; e < 4; ++e) { const int nn = n + e; const int drow = mode == 0 ? row0 + nn : row0 + ((nn >> 7) << 8) + (nn & 127);
        v4u o; o.x = pk2(v[0][e], v[1][e]); o.y = pk2(v[2][e], v[3][e]); o.z = pk2(v[4][e], v[5][e]); o.w = pk2(v[6][e], v[7][e]);
        *(GAS v4u*)(WT + (size_t)drow * ldt + kk) = o; }
}
__device__ __forceinline__ void tr_item8(const float* W, int ldw, int Kr, int Nr, int nblk, unsigned char* WT, int ldt, int row0, int mode, float scale, int item, int lane) {
    const int kb = item / nblk, nb = item - kb * nblk, k0 = 64 * kb, n0 = 32 * nb;
    const int kg = lane >> 3, n = n0 + 4 * (lane & 7), kk = k0 + 8 * kg;
    f32x4 v[8];
#pragma unroll
    for (int i = 0; i < 8; ++i) { v[i] = (f32x4){0.f, 0.f, 0.f, 0.f}; if (kk + i < Kr && n < Nr) v[i] = *(const f32x4*)(W + (size_t)(kk + i) * ldw + n) * scale; }
#pragma unroll
    for (int e = 0; e < 4; ++e) { const int nn = n + e; const int drow = mode == 0 ? row0 + nn : row0 + ((nn >> 7) << 8) + (nn & 127);
        int lo = __builtin_amdgcn_cvt_pk_fp8_f32(v[0][e], v[1][e], 0, false); lo = __builtin_amdgcn_cvt_pk_fp8_f32(v[2][e], v[3][e], lo, true);
        int hi = __builtin_amdgcn_cvt_pk_fp8_f32(v[4][e], v[5][e], 0, false); hi = __builtin_amdgcn_cvt_pk_fp8_f32(v[6][e], v[7][e], hi, true);
        u32x2 o; o.x = (unsigned)lo; o.y = (unsigned)hi; *(GAS u32x2*)(WT + (size_t)drow * ldt + kk) = o; }
}
#define KIN(i) ({ const __attribute__((address_space(4))) char* k_ = (const __attribute__((address_space(4))) char*)__builtin_amdgcn_kernarg_segment_ptr(); asm volatile("" : "+s"(k_)); const GAS float* g_ = (const GAS float*)(*(const float* const __attribute__((address_space(4)))*)(k_ + 8 * (i))); asm volatile("" : "+s"(g_)); (const float*)g_; })
#define CONV_BEGIN() F.lane = fresh_lane(); F.tid = F.wave * 64 + F.lane; asm volatile("" : "+s"(F.G), "+s"(F.wave), "+s"(F.vcu), "+s"(F.gw), "+s"(F.NGW)); GAS unsigned char* cws0_ = (GAS unsigned char*)F.ws; asm volatile("" : "+s"(cws0_)); unsigned char* cws_ = (unsigned char*)cws0_; LAS float* scr_ = (LAS float*)(F.lds + RING_OFF + F.wave * 16384); int it_ = F.gw, base_ = 0
#define JOB(W, ldw, Kr, Nr, Kp, Np, WT, ldt, row0, mode) do { const int nblk_ = (Np) / 32, n_ = ((Kp) / 64) * nblk_; \
    while (it_ < base_ + n_) { tr_item((W), (ldw), (Kr), (Nr), nblk_, (WT), (ldt), (row0), (mode), scr_, it_ - base_, F.lane); it_ += F.NGW; } base_ += n_; } while (0)
#define JOB8(W, ldw, Kr, Nr, Kp, Np, WT, ldt, row0, mode, scale) do { const int nblk_ = (Np) / 32, n_ = ((Kp) / 64) * nblk_; \
    while (it_ < base_ + n_) { tr_item8((W), (ldw), (Kr), (Nr), nblk_, (WT), (ldt), (row0), (mode), (scale), it_ - base_, F.lane); it_ += F.NGW; } base_ += n_; } while (0)

__device__ __forceinline__ void conv_rwkv(Frame& F, int l) {
    CONV_BEGIN();
    cws_ += (size_t)l * RW_LSTRIDE; bf16* BT1 = (bf16*)(cws_ + WM_BT1); bf16* BT2 = (bf16*)(cws_ + WM_BT2); bf16* WO = (bf16*)(cws_ + WM_OUT);
    for (int c = 0; c < 3; ++c) JOB(KIN(I_WRKV) + (size_t)(l * 3 + c) * D * D, D, D, D, D, D, BT1, D, c * D, 0);
    JOB(KIN(I_W1) + (size_t)l * D * 64, 64, D, 64, D, 256, BT1, D, 3072, 0);
    JOB(KIN(I_A1) + (size_t)l * D * 64, 64, D, 64, D, 256, BT1, D, 3328, 0);
    JOB(KIN(I_V1), 32, D, (l == 0 ? 0 : 32), D, 256, BT1, D, 3584, 0);
    JOB(KIN(I_G1) + (size_t)l * D * 160, 160, D, 160, D, 256, BT1, D, 3840, 0);
    JOB(KIN(I_W2) + (size_t)l * 64 * D, D, 64, D, 256, D, BT2, 256, 0, 0);
    JOB(KIN(I_A2) + (size_t)l * 64 * D, D, 64, D, 256, D, BT2, 256, 1024, 0);
    JOB(KIN(I_V2), D, (l == 0 ? 0 : 32), D, 256, D, BT2, 256, 2048, 0);
    JOB(KIN(I_G2) + (size_t)l * 160 * D, D, 160, D, 256, D, BT2, 256, 3072, 0);
    JOB(KIN(I_WOUT) + (size_t)l * D * D, D, D, D, D, D, WO, D, 0, 0);
}
__device__ __forceinline__ void conv_moba(Frame& F, int j) {
    CONV_BEGIN();
    bf16* WQ = (bf16*)(cws_ + (j == 0 ? WM_QKV : WM_Q3)); bf16* WO = (bf16*)(cws_ + (j == 0 ? WM_O : WM_O3));
    JOB(KIN(I_MQ) + (size_t)j * D * D, D, D, D, D, D, WQ, D, 0, 0);
    if (j == 0) { JOB(KIN(I_MK), D, D, D, D, D, WQ, D, D, 0); JOB(KIN(I_MV), D, D, D, D, D, WQ, D, 2 * D, 0); }
    JOB(KIN(I_MO) + (size_t)j * D * D, D, D, D, D, D, WO, D, 0, 0);
}
__device__ __forceinline__ void conv_dense(Frame& F, int e) {
    CONV_BEGIN();
    bf16* GU = (bf16*)(cws_ + WF_GU); bf16* DN = (bf16*)(cws_ + WF_DN);
    JOB(KIN(I_FG) + (size_t)e * D * FF, FF, D, FF, D, FF, GU, D, 0, 1);
    JOB(KIN(I_FU) + (size_t)e * D * FF, FF, D, FF, D, FF, GU, D, 128, 1);
    JOB(KIN(I_FD) + (size_t)e * FF * D, D, FF, D, FF, D, DN, FF, 0, 0);
}
__device__ __forceinline__ void conv_moe(Frame& F, int e) {
    CONV_BEGIN();
    bf16* GU = (bf16*)(cws_ + WE_GU + (size_t)e * WE_SET); bf16* DN = (bf16*)(cws_ + WE_DN + (size_t)e * WE_SET);
    for (int x = 0; x < NE; ++x) {
        JOB8(KIN(I_EG) + (size_t)(e * NE + x) * D * FFE, FFE, D, FFE, D, FFE, (unsigned char*)GU, D, x * 2 * FFE, 1, MOE_WSCALE);
        JOB8(KIN(I_EU) + (size_t)(e * NE + x) * D * FFE, FFE, D, FFE, D, FFE, (unsigned char*)GU, D, x * 2 * FFE + 128, 1, MOE_WSCALE);
        if (MOE_DOWN_F8) JOB8(KIN(I_ED) + (size_t)(e * NE + x) * FFE * D, D, FFE, D, FFE, D, (unsigned char*)DN, FFE, x * D, 0, MOE_DSCALE);
        else JOB(KIN(I_ED) + (size_t)(e * NE + x) * FFE * D, D, FFE, D, FFE, D, DN, FFE, x * D, 0);
    }
}

__device__ __forceinline__ void ln_stats(const f32x4 (&v)[4], float& mean, float& rstd, int lane) {
    float s = 0.f;
#pragma unroll
    for (int j = 0; j < 4; ++j) s += (v[j].x + v[j].y) + (v[j].z + v[j].w);
    mean = wave_sum(s, lane) * (1.f / D); float s2 = 0.f;
#pragma unroll
    for (int j = 0; j < 4; ++j) { const f32x4 d = v[j] - mean; s2 += (d.x * d.x + d.y * d.y) + (d.z * d.z + d.w * d.w); }
    rstd = 1.f / sqrtf(wave_sum(s2, lane) * (1.f / D) + LN_EPS);
}
template <int SRC, bool ROUTER>
__device__ __forceinline__ void ln_phase(Frame& F, const float* PRE, const float* Hin, const bf16* YP, const int* tokr, const float* gln, const float* bln,
                                         float* Hout, bf16* HB, const float* router, int* toke, float* tokw, int* blkcnt) {
    LAS int* cnt = (LAS int*)(F.lds + RING_OFF + 131072 - 64);
    if (ROUTER) { if (F.tid < 8) cnt[F.tid] = 0; __syncthreads(); }
    f32x4 g4[4], b4[4];
#pragma unroll
    for (int j = 0; j < 4; ++j) { g4[j] = *(const f32x4*)(gln + 4 * F.lane + 256 * j); b4[j] = *(const f32x4*)(bln + 4 * F.lane + 256 * j); }
    const int rpb = M / F.G, rpw = rpb / NWAVES;
    for (int i = 0; i < rpw; ++i) {
        const int m = blockIdx.x * rpb + F.wave * rpw + i;
        f32x4 v[4];
        if (SRC == 0) {
#pragma unroll
            for (int j = 0; j < 4; ++j) v[j] = *(const f32x4*)(PRE + (size_t)m * D + 4 * F.lane + 256 * j);
        } else {
            const int r0 = tokr[2 * m], r1 = tokr[2 * m + 1];
#pragma unroll
            for (int j = 0; j < 4; ++j) { const int c = 4 * F.lane + 256 * j;
                f32x4 y0, y1;
                if (r0 < 32768) y0 = bf4_to_f32(*(const u32x2*)(YP + (size_t)r0 * D + c)); else { y0 = (f32x4){0.f, 0.f, 0.f, 0.f}; for (int s = 0; s < 7; ++s) y0 += *(const f32x4*)(PRE + ((size_t)s * 2048 + (r0 - 32768)) * D + c); }
                if (r1 < 32768) y1 = bf4_to_f32(*(const u32x2*)(YP + (size_t)r1 * D + c)); else { y1 = (f32x4){0.f, 0.f, 0.f, 0.f}; for (int s = 0; s < 7; ++s) y1 += *(const f32x4*)(PRE + ((size_t)s * 2048 + (r1 - 32768)) * D + c); }
                v[j] = *(const f32x4*)(Hin + (size_t)m * D + c) * ALPHA + y0 + y1; }
        }
        float mean, rstd; ln_stats(v, mean, rstd, F.lane);
#pragma unroll
        for (int j = 0; j < 4; ++j) { v[j] = (v[j] - mean) * rstd * g4[j] + b4[j];
            *(f32x4*)(Hout + (size_t)m * D + 4 * F.lane + 256 * j) = v[j];
            if (HB) *(u32x2*)(HB + (size_t)m * D + 4 * F.lane + 256 * j) = f32_to_bf4(v[j]); }
        if (ROUTER) {
            float lg[8];
#pragma unroll
            for (int e = 0; e < 8; ++e) lg[e] = 0.f;
#pragma unroll
            for (int j = 0; j < 4; ++j)
#pragma unroll
                for (int q = 0; q < 4; ++q) { const float xv = v[j][q]; const f32x4* rp = (const f32x4*)(router + (size_t)(4 * F.lane + 256 * j + q) * 8); const f32x4 ra = rp[0], rb = rp[1];
                    lg[0] += xv * ra.x; lg[1] += xv * ra.y; lg[2] += xv * ra.z; lg[3] += xv * ra.w; lg[4] += xv * rb.x; lg[5] += xv * rb.y; lg[6] += xv * rb.z; lg[7] += xv * rb.w; }
#pragma unroll
            for (int e = 0; e < 8; ++e) lg[e] = wave_sum(lg[e], F.lane);
            int e0 = 0; float l0 = lg[0];
#pragma unroll
            for (int e = 1; e < 8; ++e) if (lg[e] > l0) { l0 = lg[e]; e0 = e; }
            int e1 = -1; float l1 = -INFINITY;
#pragma unroll
            for (int e = 0; e < 8; ++e) if (e != e0 && lg[e] > l1) { l1 = lg[e]; e1 = e; }
            const float w0 = 1.f / (1.f + __expf(l1 - l0)), w1 = 1.f - w0;
            if (F.lane == 0) { toke[2 * m] = e0; toke[2 * m + 1] = e1; tokw[2 * m] = w0; tokw[2 * m + 1] = w1; atomicAdd((int*)&cnt[e0], 1); atomicAdd((int*)&cnt[e1], 1); }
        }
    }
    if (ROUTER) { __syncthreads(); if (F.tid < 8) blkcnt[blockIdx.x * 8 + F.tid] = cnt[F.tid]; }
}

__device__ __forceinline__ void mix_phase(Frame& F, const float* Hx, const float* mu, bf16* XM) {
    f32x4 mu4[6][4];
#pragma unroll
    for (int c = 0; c < 6; ++c)
#pragma unroll
        for (int j = 0; j < 4; ++j) mu4[c][j] = *(const f32x4*)(mu + c * D + 4 * F.lane + 256 * j);
    for (int m = F.gw; m < M; m += F.NGW) {
        const bool first = (m % T) == 0;
#pragma unroll
        for (int j = 0; j < 4; ++j) { const int c0 = 4 * F.lane + 256 * j;
            const f32x4 x = *(const f32x4*)(Hx + (size_t)m * D + c0);
            f32x4 xp = (f32x4){0.f, 0.f, 0.f, 0.f}; if (!first) xp = *(const f32x4*)(Hx + (size_t)(m - 1) * D + c0);
            const f32x4 xx = xp - x;
#pragma unroll
            for (int c = 0; c < 6; ++c) *(u32x2*)(XM + ((size_t)c * M + m) * D + c0) = f32_to_bf4(x + xx * mu4[c][j]); }
    }
}
__device__ __forceinline__ void prep_phase(Frame& F, int l, const bf16* RKV, const float* AA, const bf16* LH, const float* v0, const float* v2, bf16* VF, const float* k_k, const float* k_a, bf16* KP, bf16* AP, bf16* BP, bf16* VP) {
    f32x4 kk4[4], ka4[4];
#pragma unroll
    for (int j = 0; j < 4; ++j) { kk4[j] = *(const f32x4*)(k_k + 4 * F.lane + 256 * j); ka4[j] = *(const f32x4*)(k_a + 4 * F.lane + 256 * j); }
    for (int m = F.gw; m < M; m += F.NGW) {
#pragma unroll
        for (int j = 0; j < 4; ++j) { const size_t o = (size_t)m * D + 4 * F.lane + 256 * j;
            const f32x4 k = bf4_to_f32(*(const u32x2*)(RKV + (size_t)M * D + o)); const u32x2 vraw = *(const u32x2*)(RKV + (size_t)2 * M * D + o); f32x4 v = bf4_to_f32(vraw);
            const f32x4 a = *(const f32x4*)(AA + o);
            f32x4 kk = k * kk4[j]; const float ss = sum16((kk.x * kk.x + kk.y * kk.y) + (kk.z * kk.z + kk.w * kk.w));
            kk = kk * (1.0f / sqrtf(fmaxf(ss, 1e-24f)));
            const f32x4 kp = k * ((a - 1.0f) * ka4[j] + 1.0f);
            if (l == 0) *(u32x2*)(VF + o) = vraw;
            else {
                f32x4 z = *(const f32x4*)(v0 + 4 * F.lane + 256 * j);
                const bf16* lh = LH + (size_t)m * D + 512;
#pragma unroll 8
                for (int q = 0; q < 32; ++q) z += *(const f32x4*)(v2 + (size_t)q * D + 4 * F.lane + 256 * j) * bf2f(lh[q]);
                f32x4 vg; vg.x = 1.f / (1.f + __expf(-z.x)); vg.y = 1.f / (1.f + __expf(-z.y)); vg.z = 1.f / (1.f + __expf(-z.z)); vg.w = 1.f / (1.f + __expf(-z.w));
                const f32x4 vf = bf4_to_f32(*(const u32x2*)(VF + o)); v = v + (vf - v) * vg; }
            *(u32x2*)(KP + o) = f32_to_bf4(kp); *(u32x2*)(VP + o) = f32_to_bf4(v); *(u32x2*)(AP + o) = f32_to_bf4(-kk); *(u32x2*)(BP + o) = f32_to_bf4(kk * a); }
    }
}
__device__ __forceinline__ void post_phase(Frame& F, const bf16* Y, const bf16* R, const bf16* KP, const bf16* VP, const bf16* GG, const float* r_k, const float* gng, const float* gnb, bf16* YG) {
    f32x4 rk4[4], gg4[4], gb4[4];
#pragma unroll
    for (int j = 0; j < 4; ++j) { rk4[j] = *(const f32x4*)(r_k + 4 * F.lane + 256 * j); gg4[j] = *(const f32x4*)(gng + 4 * F.lane + 256 * j); gb4[j] = *(const f32x4*)(gnb + 4 * F.lane + 256 * j); }
    for (int m = F.gw; m < M; m += F.NGW) {
#pragma unroll
        for (int j = 0; j < 4; ++j) { const size_t o = (size_t)m * D + 4 * F.lane + 256 * j;
            const f32x4 y = bf4_to_f32(*(const u32x2*)(Y + o)), r = bf4_to_f32(*(const u32x2*)(R + o)), g = bf4_to_f32(*(const u32x2*)(GG + o));
            const f32x4 kp = bf4_to_f32(*(const u32x2*)(KP + o)), vp = bf4_to_f32(*(const u32x2*)(VP + o));
            const float mean = sum16((y.x + y.y) + (y.z + y.w)) * (1.f / 64.f); const f32x4 d = y - mean;
            const float var = sum16((d.x * d.x + d.y * d.y) + (d.z * d.z + d.w * d.w)) * (1.f / 64.f);
            const f32x4 rkk = r * kp * rk4[j]; const float bon = sum16((rkk.x + rkk.y) + (rkk.z + rkk.w));
            const f32x4 yn = d * (1.0f / sqrtf(var + GN_EPS)) * gg4[j] + gb4[j] + vp * bon;
            *(u32x2*)(YG + o) = f32_to_bf4(yn * g); }
    }
}
__device__ __forceinline__ float fma_s(float a, float b, float c) { float r; asm("v_fma_f32 %0, %1, %2, %3" : "=v"(r) : "v"(a), "v"(b), "v"(c)); return r; }
__device__ __forceinline__ float mul_s(float a, float b) { float r; asm("v_mul_f32_e32 %0, %1, %2" : "=v"(r) : "v"(a), "v"(b)); return r; }
__device__ __forceinline__ float add_s(float a, float b) { float r; asm("v_add_f32_e32 %0, %1, %2" : "=v"(r) : "v"(a), "v"(b)); return r; }
__device__ __forceinline__ float dot4_s(const f32x4& x, const f32x4& y) { return add_s(fma_s(x.y, y.y, mul_s(x.x, y.x)), fma_s(x.w, y.w, mul_s(x.z, y.z))); }
__device__ __forceinline__ f32x4 upd_s(const f32x4& S, const f32x4& w, const f32x4& b, float sa, const f32x4& k, float v) {
    f32x4 r; r.x = fma_s(S.x, w.x, fma_s(b.x, sa, mul_s(k.x, v))); r.y = fma_s(S.y, w.y, fma_s(b.y, sa, mul_s(k.y, v))); r.z = fma_s(S.z, w.z, fma_s(b.z, sa, mul_s(k.z, v))); r.w = fma_s(S.w, w.w, fma_s(b.w, sa, mul_s(k.w, v))); return r; }
__device__ __forceinline__ void scan_phase(Frame& F, const bf16* R, const float* DEC, const bf16* KP, const bf16* AP, const bf16* BP, const bf16* VP, bf16* Y) {
    constexpr int TS = 32, BUFB = 57600, YB_OFF = 2 * BUFB;
    const int head = F.vcu >> 3, part = F.vcu & 7, b = head >> 4, hh = head & 15;
    const size_t rowb = (size_t)b * T; const int col0 = hh * 64;
    const int tr = F.tid >> 4, pc = F.tid & 15;
    const int tr2 = (F.tid & 255) >> 3, pc2 = F.tid & 7;
    const int rr = F.lane >> 4, q = F.lane & 15, myrow = 8 * part + 4 * F.wave + rr;
    LAS unsigned char* L = F.lds + RING_OFF;
    struct Stg { f32x4 lw; u32x2 rk, ra, rb, rv, rn; v4u lr; };
    Stg g0, g1;
#define SC_LOAD(c, G) do { const int t_ = (c) * TS + tr; const size_t g_ = (rowb + t_) * D + col0 + pc * 4; G.lw = *(const f32x4*)(DEC + g_); G.rk = *(const u32x2*)(KP + g_); G.ra = *(const u32x2*)(AP + g_); \
        G.rb = *(const u32x2*)(BP + g_); G.rv = *(const u32x2*)(VP + g_); G.rn = (u32x2){0u, 0u}; if (t_ + 1 < T) G.rn = *(const u32x2*)(AP + g_ + D); \
        if (F.tid < 256) G.lr = *(const v4u*)(R + (rowb + (size_t)(c) * TS + tr2) * D + col0 + pc2 * 8); } while (0)
#define SC_STORE(bf, G) do { const f32x4 lk_ = bf4_to_f32(G.rk), la_ = bf4_to_f32(G.ra), lb_ = bf4_to_f32(G.rb), lv_ = bf4_to_f32(G.rv), ln_ = bf4_to_f32(G.rn); LAS unsigned char* d_ = L + (bf) * BUFB + tr * 256 + pc * 16; *(LAS f32x4*)(d_) = G.lw; *(LAS f32x4*)(d_ + 8192) = lk_; *(LAS f32x4*)(d_ + 16384) = la_; \
        *(LAS f32x4*)(d_ + 24576) = lb_; *(LAS f32x4*)(d_ + 32768) = lv_; *(LAS f32x4*)(d_ + 49152) = G.lw * ln_; \
        { const f32x4 pb_ = lb_ * ln_, pk_ = lk_ * ln_; const float be_ = dpp_sum16((pb_.x + pb_.y) + (pb_.z + pb_.w)), ga_ = dpp_sum16((pk_.x + pk_.y) + (pk_.z + pk_.w)); \
          if (pc == 0) { *(LAS float*)(L + (bf) * BUFB + 57344 + tr * 4) = be_; *(LAS float*)(L + (bf) * BUFB + 57472 + tr * 4) = ga_; } } \
        if (F.tid < 256) { LAS unsigned char* r_ = L + (bf) * BUFB + 40960 + tr2 * 256 + pc2 * 32; \
            *(LAS f32x4*)(r_) = (f32x4){__uint_as_float(G.lr.x << 16), __uint_as_float(G.lr.x & 0xffff0000u), __uint_as_float(G.lr.y << 16), __uint_as_float(G.lr.y & 0xffff0000u)}; \
            *(LAS f32x4*)(r_ + 16) = (f32x4){__uint_as_float(G.lr.z << 16), __uint_as_float(G.lr.z & 0xffff0000u), __uint_as_float(G.lr.w << 16), __uint_as_float(G.lr.w & 0xffff0000u)}; } } while (0)
    SC_LOAD(0, g0); SC_STORE(0, g0); SC_LOAD(1, g0); __syncthreads();
    f32x4 S = (f32x4){0.f, 0.f, 0.f, 0.f};
    constexpr int NCH = T / TS;
    for (int c2 = 0; c2 < NCH; c2 += 2) {
#pragma unroll
      for (int par = 0; par < 2; ++par) {
        const int c = c2 + par, bf = par;
        if (c + 2 < NCH) { if (par == 0) SC_LOAD(c + 2, g1); else SC_LOAD(c + 2, g0); }
        if (F.wave < 2) {
            const LAS unsigned char* B0 = L + bf * BUFB + q * 16; const LAS unsigned char* Bv = L + bf * BUFB + 32768 + myrow * 4; const LAS unsigned char* Bs = L + bf * BUFB + 57344;
            LAS unsigned short* yb = (LAS unsigned short*)(L + YB_OFF + bf * 512) + q * 8 + 4 * F.wave + rr;
            struct Rnd { f32x4 a, aw, w0, b0, k0, r0, w1, b1, k1, r1; float v0, v1, be, ga; };
#define SC_FETCH(t_, X) do { X.a = *(const LAS f32x4*)(B0 + 16384 + (t_) * 256); X.aw = *(const LAS f32x4*)(B0 + 49152 + (t_) * 256); \
            X.w0 = *(const LAS f32x4*)(B0 + (t_) * 256); X.b0 = *(const LAS f32x4*)(B0 + 24576 + (t_) * 256); X.k0 = *(const LAS f32x4*)(B0 + 8192 + (t_) * 256); X.r0 = *(const LAS f32x4*)(B0 + 40960 + (t_) * 256); \
            X.w1 = *(const LAS f32x4*)(B0 + ((t_) + 1) * 256); X.b1 = *(const LAS f32x4*)(B0 + 24576 + ((t_) + 1) * 256); X.k1 = *(const LAS f32x4*)(B0 + 8192 + ((t_) + 1) * 256); X.r1 = *(const LAS f32x4*)(B0 + 40960 + ((t_) + 1) * 256); \
            X.v0 = *(const LAS float*)(Bv + (t_) * 256); X.v1 = *(const LAS float*)(Bv + ((t_) + 1) * 256); X.be = *(const LAS float*)(Bs + (t_) * 4); X.ga = *(const LAS float*)(Bs + 128 + (t_) * 4); } while (0)
            Rnd cu; float ykeep = 0.f, yra = 0.f, yrb = 0.f;
#define RED_STEP(x, ctl) asm volatile("v_add_f32_dpp %0, %0, %0 " ctl " row_mask:0xf bank_mask:0xf bound_ctrl:1" : "+v"(x))
#define RED_STEP0(x, ctl) asm volatile("s_nop 1\n\tv_add_f32_dpp %0, %0, %0 " ctl " row_mask:0xf bank_mask:0xf bound_ctrl:1" : "+v"(x))
#define RED4(a_, b_, c_, d_) do { \
            RED_STEP0(a_, "quad_perm:[1,0,3,2]"); RED_STEP0(b_, "quad_perm:[1,0,3,2]"); RED_STEP0(c_, "quad_perm:[1,0,3,2]"); RED_STEP0(d_, "quad_perm:[1,0,3,2]"); \
            RED_STEP(a_, "quad_perm:[2,3,0,1]"); RED_STEP(b_, "quad_perm:[2,3,0,1]"); RED_STEP(c_, "quad_perm:[2,3,0,1]"); RED_STEP(d_, "quad_perm:[2,3,0,1]"); \
            RED_STEP(a_, "row_half_mirror"); RED_STEP(b_, "row_half_mirror"); RED_STEP(c_, "row_half_mirror"); RED_STEP(d_, "row_half_mirror"); \
            RED_STEP(a_, "row_mirror"); RED_STEP(b_, "row_mirror"); RED_STEP(c_, "row_mirror"); RED_STEP(d_, "row_mirror"); } while (0)
            SC_FETCH(0, cu);
#pragma unroll
            for (int t = 0; t < TS; t += 2) {
                Rnd nx = cu;
                if (t + 2 < TS) SC_FETCH(t + 2, nx);
                const f32x4 p1 = S * cu.a, p2 = S * cu.aw;
                float u1 = (p1.x + p1.y) + (p1.z + p1.w), u2 = (p2.x + p2.y) + (p2.z + p2.w);
                RED4(u1, u2, yra, yrb);
                if (t > 0) { ykeep = (q == ((t - 2) & 15)) ? yra : ykeep; ykeep = (q == ((t - 1) & 15)) ? yrb : ykeep;
                             if (((t - 1) & 15) == 15) yb[(t - 16) * 8] = (unsigned short)f2bf(ykeep); }
                const float sa0 = u1, sa1 = u2 + sa0 * cu.be + cu.v0 * cu.ga;
                S = S * cu.w0 + (cu.b0 * sa0 + cu.k0 * cu.v0);
                const f32x4 y4a = S * cu.r0;
                S = S * cu.w1 + (cu.b1 * sa1 + cu.k1 * cu.v1);
                const f32x4 y4b = S * cu.r1;
                yra = (y4a.x + y4a.y) + (y4a.z + y4a.w); yrb = (y4b.x + y4b.y) + (y4b.z + y4b.w);
                cu = nx;
            }
            { float d0_ = 0.f, d1_ = 0.f; RED4(yra, yrb, d0_, d1_);
              ykeep = (q == 14) ? yra : ykeep; ykeep = (q == 15) ? yrb : ykeep; yb[16 * 8] = (unsigned short)f2bf(ykeep); }
#undef RED4
#undef RED_STEP0
#undef RED_STEP
#undef SC_FETCH
        }
        if (c + 1 < NCH) { if (par == 0) SC_STORE(1, g0); else SC_STORE(0, g1); }
        __syncthreads();
        if (F.tid < 32) { const v4u yv = *(const LAS v4u*)(L + YB_OFF + bf * 512 + F.tid * 16);
            *(v4u*)(Y + (rowb + (size_t)c * TS + F.tid) * D + col0 + part * 8) = yv; }
      }
    }
#undef SC_LOAD
#undef SC_STORE
}

__device__ __forceinline__ void kmean_phase(Frame& F, const bf16* Kb, float* KM) {
    LAS float* red = (LAS float*)(F.lds + RING_OFF);
    for (int u = blockIdx.x; u < 2 * 32 * 4; u += F.G) {
        const int qc = u & 3, blk = (u >> 2) & 31, b = u >> 7; const int c = F.tid & 255, rh = F.tid >> 8;
        const bf16* p = Kb + ((size_t)b * T + blk * 256 + rh * 128) * D + qc * 256 + c; float s = 0.f;
#pragma unroll 8
        for (int r = 0; r < 128; ++r) s += bf2f(p[(size_t)r * D]);
        if (rh == 1) red[c] = s;
        __syncthreads();
        if (rh == 0) { const int col = qc * 256 + c; KM[(((size_t)b * H + (col >> 6)) * 32 + blk) * 64 + (col & 63)] = (s + red[c]) * (1.f / 256.f); }
        __syncthreads();
    }
}
__device__ __forceinline__ void gate_phase(Frame& F, const bf16* Q, const float* KM, unsigned* SEL) {
    LAS float* km = (LAS float*)(F.lds + RING_OFF);
    for (int u = blockIdx.x; u < M / 64; u += F.G) {
        const int m0 = u * 64, b = m0 / T, own = (m0 % T) >> 8;
        for (int i = F.tid; i < 16 * 32 * 16; i += NWAVES * 64) *(LAS f32x4*)(km + 4 * i) = *(const f32x4*)(KM + (size_t)b * 16 * 32 * 64 + 4 * i);
        __syncthreads();
        const int m = m0 + F.lane;
#pragma unroll 1
        for (int hi = 0; hi < 2; ++hi) { const int h = 2 * F.wave + hi;
            float qv[64];
#pragma unroll
            for (int i = 0; i < 8; ++i) { const v4u w = *(const v4u*)(Q + (size_t)m * D + h * 64 + 8 * i);
                qv[8 * i + 0] = __uint_as_float(w.x << 16); qv[8 * i + 1] = __uint_as_float(w.x & 0xffff0000u); qv[8 * i + 2] = __uint_as_float(w.y << 16); qv[8 * i + 3] = __uint_as_float(w.y & 0xffff0000u);
                qv[8 * i + 4] = __uint_as_float(w.z << 16); qv[8 * i + 5] = __uint_as_float(w.z & 0xffff0000u); qv[8 * i + 6] = __uint_as_float(w.w << 16); qv[8 * i + 7] = __uint_as_float(w.w & 0xffff0000u); }
            float v0 = -INFINITY, v1 = -INFINITY, v2 = -INFINITY; int i0 = -1, i1 = -1, i2 = -1;
            for (int j = 0; j < own; ++j) { const LAS f32x4* kp = (const LAS f32x4*)(km + (h * 32 + j) * 64); float s = 0.f;
#pragma unroll
                for (int i = 0; i < 16; ++i) { const f32x4 kv = kp[i]; s += qv[4 * i] * kv.x + qv[4 * i + 1] * kv.y + qv[4 * i + 2] * kv.z + qv[4 * i + 3] * kv.w; }
                if (s > v0) { v2 = v1; i2 = i1; v1 = v0; i1 = i0; v0 = s; i0 = j; } else if (s > v1) { v2 = v1; i2 = i1; v1 = s; i1 = j; } else if (s > v2) { v2 = s; i2 = j; } }
            unsigned mask = 0u; if (i0 >= 0) mask |= 1u << i0; if (i1 >= 0) mask |= 1u << i1; if (i2 >= 0) mask |= 1u << i2;
            SEL[((size_t)b * H + h) * T + (m % T)] = mask; }
        __syncthreads();
    }
}

__device__ __forceinline__ void moe_prefix(Frame& F, const int* blkcnt, LAS int* pre_mine  ) {
    LAS int* tmp = (LAS int*)(F.lds + RING_OFF);
    for (int i = F.tid; i < F.G * 8; i += NWAVES * 64) tmp[i] = blkcnt[i];
    __syncthreads();
    if (F.tid < 8) { int tot = 0, mine = 0; for (int g = 0; g < F.G; ++g) { if (g == (int)blockIdx.x) mine = tot; tot += tmp[g * 8 + F.tid]; }
        pre_mine[F.tid] = mine; pre_mine[8 + F.tid] = tot; }
    __syncthreads();
    if (F.tid == 0) { int p = 0; for (int e = 0; e < 8; ++e) { F.MISC[16 + e] = (unsigned)p; p += (pre_mine[8 + e] + 255) >> 8; } F.MISC[24] = (unsigned)p; }
    __syncthreads();
}
__device__ __forceinline__ void moe_gather_phase(Frame& F, const int* blkcnt, const int* toke, const float* tokw, int* tokr, float* gw, const float* Hs, unsigned char* XG) {
    LAS int* pm = (LAS int*)(F.lds + RING_OFF + 16384);
    LAS int* rows = (LAS int*)(F.lds + RING_OFF + 16384 + 64);
    moe_prefix(F, blkcnt, pm);
    const int rpb = M / F.G;
    if (F.wave == 0) {
        const int m = blockIdx.x * rpb + F.lane; const bool ok = F.lane < rpb;
        const int e0 = ok ? toke[2 * m] : -1, e1 = ok ? toke[2 * m + 1] : -1;
        int r0 = 0, r1 = 0;
        for (int e = 0; e < 8; ++e) { const unsigned long long b0 = __ballot(e0 == e), b1 = __ballot(e1 == e); const unsigned long long lt = (1ull << F.lane) - 1ull;
            const int base = (int)F.MISC[16 + e] * 256 + pm[e];
            if (e0 == e) r0 = base + __popcll(b0 & lt);
            if (e1 == e) r1 = base + __popcll(b0) + __popcll(b1 & lt); }
        if (ok) { tokr[2 * m] = r0; tokr[2 * m + 1] = r1; gw[r0] = tokw[2 * m]; gw[r1] = tokw[2 * m + 1]; rows[2 * F.lane] = r0; rows[2 * F.lane + 1] = r1; }
    }
    __syncthreads();
    for (int i = F.wave; i < 2 * rpb; i += NWAVES) { const int m = blockIdx.x * rpb + (i >> 1), r = rows[i];
        const f32x4* s = (const f32x4*)(Hs + (size_t)m * D + 16 * F.lane); const f32x4 a = s[0], b_ = s[1], c = s[2], d = s[3];
        v4u o; int w;
        w = __builtin_amdgcn_cvt_pk_fp8_f32(a.x, a.y, 0, false); w = __builtin_amdgcn_cvt_pk_fp8_f32(a.z, a.w, w, true); o.x = (unsigned)w;
        w = __builtin_amdgcn_cvt_pk_fp8_f32(b_.x, b_.y, 0, false); w = __builtin_amdgcn_cvt_pk_fp8_f32(b_.z, b_.w, w, true); o.y = (unsigned)w;
        w = __builtin_amdgcn_cvt_pk_fp8_f32(c.x, c.y, 0, false); w = __builtin_amdgcn_cvt_pk_fp8_f32(c.z, c.w, w, true); o.z = (unsigned)w;
        w = __builtin_amdgcn_cvt_pk_fp8_f32(d.x, d.y, 0, false); w = __builtin_amdgcn_cvt_pk_fp8_f32(d.z, d.w, w, true); o.w = (unsigned)w;
        *(v4u*)(XG + (size_t)r * D + 16 * F.lane) = o; }
    __syncthreads();
}
__device__ __forceinline__ void attn_direct_phase(Frame& F, const bf16* Q, const bf16* Kb, const bf16* Vb, const unsigned* SEL, bf16* O) {
    for (int u = F.gw; u < (M / 64) * H; u += F.NGW) {
        const int h = u & 15, m0 = (u >> 4) * 64, b = m0 / T, t0 = m0 % T, own = t0 >> 8, m = m0 + F.lane, tpos = t0 + F.lane;
        float q[64], o[64];
#pragma unroll
        for (int i = 0; i < 8; ++i) { const v4u w = *(const v4u*)(Q + (size_t)m * D + h * 64 + 8 * i);
            q[8 * i + 0] = __uint_as_float(w.x << 16); q[8 * i + 1] = __uint_as_float(w.x & 0xffff0000u); q[8 * i + 2] = __uint_as_float(w.y << 16); q[8 * i + 3] = __uint_as_float(w.y & 0xffff0000u);
            q[8 * i + 4] = __uint_as_float(w.z << 16); q[8 * i + 5] = __uint_as_float(w.z & 0xffff0000u); q[8 * i + 6] = __uint_as_float(w.w << 16); q[8 * i + 7] = __uint_as_float(w.w & 0xffff0000u); }
#pragma unroll
        for (int i = 0; i < 64; ++i) o[i] = 0.f;
        const unsigned sel = SEL[((size_t)b * H + h) * T + tpos];
        float mrun = -INFINITY, l = 0.f;
        for (int j = 0; j <= own; ++j) {
            const bool pastsel = (sel >> j) & 1u;
            if (j < own && !__any(pastsel)) continue;
            const int nk = (j < own) ? 256 : (t0 & 255) + 64;
            for (int kk = 0; kk < nk; ++kk) {
                const int kpos = j * 256 + kk; const size_t ro = ((size_t)b * T + kpos) * D + h * 64;
                float s = 0.f;
#pragma unroll
                for (int i = 0; i < 8; ++i) { const v4u w = *(const v4u*)(Kb + ro + 8 * i);
                    s += q[8 * i + 0] * __uint_as_float(w.x << 16) + q[8 * i + 1] * __uint_as_float(w.x & 0xffff0000u) + q[8 * i + 2] * __uint_as_float(w.y << 16) + q[8 * i + 3] * __uint_as_float(w.y & 0xffff0000u)
                       + q[8 * i + 4] * __uint_as_float(w.z << 16) + q[8 * i + 5] * __uint_as_float(w.z & 0xffff0000u) + q[8 * i + 6] * __uint_as_float(w.w << 16) + q[8 * i + 7] * __uint_as_float(w.w & 0xffff0000u); }
                const bool act = (j < own) ? pastsel : (kpos <= tpos);
                if (act) {
                    if (s > mrun) { const float c = exp2f(mrun - s); l *= c;
#pragma unroll
                        for (int i = 0; i < 64; ++i) o[i] *= c;
                        mrun = s; }
                    const float p = exp2f(s - mrun); l += p;
#pragma unroll
                    for (int i = 0; i < 8; ++i) { const v4u w = *(const v4u*)(Vb + ro + 8 * i);
                        o[8 * i + 0] += p * __uint_as_float(w.x << 16); o[8 * i + 1] += p * __uint_as_float(w.x & 0xffff0000u); o[8 * i + 2] += p * __uint_as_float(w.y << 16); o[8 * i + 3] += p * __uint_as_float(w.y & 0xffff0000u);
                        o[8 * i + 4] += p * __uint_as_float(w.z << 16); o[8 * i + 5] += p * __uint_as_float(w.z & 0xffff0000u); o[8 * i + 6] += p * __uint_as_float(w.w << 16); o[8 * i + 7] += p * __uint_as_float(w.w & 0xffff0000u); }
                }
            }
        }
        const float rl = 1.0f / l;
#pragma unroll
        for (int i = 0; i < 8; ++i) { v4u w; w.x = pk2(o[8 * i] * rl, o[8 * i + 1] * rl); w.y = pk2(o[8 * i + 2] * rl, o[8 * i + 3] * rl); w.z = pk2(o[8 * i + 4] * rl, o[8 * i + 5] * rl); w.w = pk2(o[8 * i + 6] * rl, o[8 * i + 7] * rl);
            *(v4u*)(O + (size_t)m * D + h * 64 + 8 * i) = w; }
    }
}
namespace moba {
using attn_body::f32x16; using attn_body::crow;
constexpr int L_K = 0, L_V = 32768, L_LIST = 65536, L_WS = 81920, L_CTL = 84992;
__device__ __forceinline__ void qkt_l(f32x16& p0, f32x16& p1, const LAS unsigned char* Kslot, const bf16x8* qr, int r32, int hi) {
    const LAS unsigned char* kb = Kslot + hi * 1024 + r32 * 16;
#pragma unroll
    for (int d0 = 0; d0 < 4; ++d0) {
        const bf16x8 b0 = *(const LAS bf16x8*)(kb + d0 * 2048), b1 = *(const LAS bf16x8*)(kb + d0 * 2048 + 512);
        if (d0 == 0) { p0 = __builtin_amdgcn_mfma_f32_32x32x16_bf16(b0, qr[0], f32x16{}, 0, 0, 0); p1 = __builtin_amdgcn_mfma_f32_32x32x16_bf16(b1, qr[0], f32x16{}, 0, 0, 0); }
        else { p0 = __builtin_amdgcn_mfma_f32_32x32x16_bf16(b0, qr[d0], p0, 0, 0, 0); p1 = __builtin_amdgcn_mfma_f32_32x32x16_bf16(b1, qr[d0], p1, 0, 0, 0); } }
}
__device__ __forceinline__ float half_max(float v) { auto rr = __builtin_amdgcn_permlane32_swap(__float_as_uint(v), __float_as_uint(v), false, false); return fmaxf(__uint_as_float(rr[0]), __uint_as_float(rr[1])); }
__device__ __forceinline__ float half_sum(float v) { auto rr = __builtin_amdgcn_permlane32_swap(__float_as_uint(v), __float_as_uint(v), false, false); return __uint_as_float(rr[0]) + __uint_as_float(rr[1]); }
}
__device__ __forceinline__ void moba_attn_phase(Frame& F, const bf16* Q, const bf16* Kb, const bf16* Vb, const unsigned* SELT, bf16* PO, float* ML, gu32* qctr) {
    using namespace moba;
    const int lane = F.lane, wid = F.wave, r32 = lane & 31, hi = lane >> 5;
    LAS unsigned char* L = F.lds + RING_OFF;
    LAS unsigned short* list = (LAS unsigned short*)(L + L_LIST);
    LAS float* wsf = (LAS float*)(L + L_WS + wid * 256); LAS int* wsd = (LAS int*)(L + L_WS + wid * 256 + 128);
    LAS int* ctl = (LAS int*)(L + L_CTL);
    const int vb0 = RING_OFF + L_V + ((lane >> 4) & 1) * 32 + (lane & 3) * 8 + (4 * hi + ((lane & 15) >> 2)) * 64;
    for (;;) {
        __syncthreads();
        if (F.tid == 0) { ctl[0] = (int)__hip_atomic_fetch_add(qctr, 1u, __ATOMIC_RELAXED, __HIP_MEMORY_SCOPE_AGENT); ctl[1] = 0; }
        __syncthreads();
        const int u = __builtin_amdgcn_readfirstlane(ctl[0]);
        if (u >= 32 * 32) break;
        const int j = u >> 5, bh = u & 31, b = bh >> 4, h = bh & 15;
        const size_t rowb = (size_t)b * T;
        { const bf16* ksrc = Kb + (rowb + 256 * j + lane) * D + h * 64 + wid * 8;
          const bf16* vsrc = Vb + (rowb + 256 * j + 16 * (wid & 3) + (lane >> 2)) * D + h * 64 + (wid >> 2) * 32 + (lane & 3) * 8;
#pragma unroll
          for (int kt = 0; kt < 4; ++kt) { attn_body::glds16(ksrc + (size_t)kt * 64 * D, (unsigned)__builtin_amdgcn_readfirstlane(RING_OFF + L_K + kt * 8192 + wid * 1024));
                                           attn_body::glds16(vsrc + (size_t)kt * 64 * D, (unsigned)__builtin_amdgcn_readfirstlane(RING_OFF + L_V + kt * 8192 + wid * 1024)); } }
        const unsigned* selrow = SELT + (size_t)bh * T;
        for (int t0 = 256 * (j + 1); t0 < T; t0 += NWAVES * 64) { const int t = t0 + F.tid; const bool in = t < T;
            const bool p = in && ((selrow[in ? t : 0] >> j) & 1u);
            const unsigned long long bal = __ballot(p); const int np = __popcll(bal);
            int base = 0; if (lane == 0 && np) base = __hip_atomic_fetch_add(&ctl[1], np, __ATOMIC_RELAXED, __HIP_MEMORY_SCOPE_WORKGROUP);
            base = __builtin_amdgcn_readfirstlane(base);
            if (p) list[base + __popcll(bal & ((1ull << lane) - 1ull))] = (unsigned short)t; }
        asm volatile("s_waitcnt vmcnt(0) lgkmcnt(0)" ::: "memory");
        __syncthreads();
        const int total = 256 + ctl[1], nb = (total + 31) >> 5;
        for (int bi = wid; bi < nb; bi += NWAVES) {
            const int item = bi * 32 + r32; const bool valid = item < total; const int it2 = valid ? item : total - 1;
            const bool ownb = bi < 8;
            const int t = it2 < 256 ? 256 * j + it2 : (int)list[it2 - 256];
            const bf16* qrow = Q + (rowb + t) * D + h * 64;
            bf16x8 qr[4];
#pragma unroll
            for (int d0 = 0; d0 < 4; ++d0) qr[d0] = *(const bf16x8*)(qrow + d0 * 16 + hi * 8);
            f32x16 P[4][2];
#pragma unroll
            for (int kt = 0; kt < 4; ++kt) qkt_l(P[kt][0], P[kt][1], L + L_K + kt * 8192, qr, r32, hi);
            if (ownb) {
#pragma unroll
                for (int kt = 0; kt < 4; ++kt) attn_body::cmask(P[kt][0], P[kt][1], kt, t - 256 * j, hi); }
            float mx = -INFINITY;
#pragma unroll
            for (int kt = 0; kt < 4; ++kt)
#pragma unroll
                for (int r = 0; r < 16; ++r) mx = fmaxf(mx, fmaxf(P[kt][0][r], P[kt][1][r]));
            mx = half_max(mx);
            float ls = 0.f;
#pragma unroll
            for (int kt = 0; kt < 4; ++kt)
#pragma unroll
                for (int r = 0; r < 16; ++r) { P[kt][0][r] = __builtin_amdgcn_exp2f(P[kt][0][r] - mx); P[kt][1][r] = __builtin_amdgcn_exp2f(P[kt][1][r] - mx); ls += P[kt][0][r] + P[kt][1][r]; }
            ls = half_sum(ls);
            f32x16 o[2]; o[0] = f32x16{}; o[1] = f32x16{};
#pragma unroll
            for (int kt = 0; kt < 4; ++kt) {
                attn_body::u32x4 w0, w1, w2, w3;
#define PKW_(P_, B_) attn_body::cvtpk_s(P_[B_], P_[B_ + 1])
                w0 = (attn_body::u32x4){PKW_(P[kt][0], 0), PKW_(P[kt][0], 2), PKW_(P[kt][0], 4), PKW_(P[kt][0], 6)}; w1 = (attn_body::u32x4){PKW_(P[kt][0], 8), PKW_(P[kt][0], 10), PKW_(P[kt][0], 12), PKW_(P[kt][0], 14)};
                w2 = (attn_body::u32x4){PKW_(P[kt][1], 0), PKW_(P[kt][1], 2), PKW_(P[kt][1], 4), PKW_(P[kt][1], 6)}; w3 = (attn_body::u32x4){PKW_(P[kt][1], 8), PKW_(P[kt][1], 10), PKW_(P[kt][1], 12), PKW_(P[kt][1], 14)};
#undef PKW_
                attn_body::pv(o, vb0 + kt * 8192, __builtin_bit_cast(bf16x8, w0), __builtin_bit_cast(bf16x8, w1), __builtin_bit_cast(bf16x8, w2), __builtin_bit_cast(bf16x8, w3)); }
            const unsigned sel = selrow[t];
            const int slot = ownb ? 3 : __popc(sel & ((1u << j) - 1u));
            const int dest = (int)(((rowb + t) * H + h) * 4 + slot);
            if (hi == 0) { wsf[r32] = 1.0f / ls; wsd[r32] = valid ? dest : -1; if (valid) { ML[(size_t)dest * 2] = mx; ML[(size_t)dest * 2 + 1] = ls; } }
            asm volatile("s_waitcnt lgkmcnt(0)" ::: "memory");
#pragma unroll
            for (int r = 0; r < 16; ++r) { const int row = crow(r, hi); const float rl = wsf[row]; const int d = wsd[row];
                if (d >= 0) { PO[(size_t)d * 64 + r32] = (bf16)f2bf(o[0][r] * rl); PO[(size_t)d * 64 + 32 + r32] = (bf16)f2bf(o[1][r] * rl); } }
            asm volatile("s_waitcnt lgkmcnt(0)" ::: "memory");
        }
    }
}
__device__ __forceinline__ void moba_combine_phase(Frame& F, const unsigned* SELT, const bf16* PO, const float* ML, bf16* O) {
    for (int m = F.gw; m < M; m += F.NGW) {
        const int b = m / T, t = m % T, h = F.lane >> 2, qd = F.lane & 3;
        const unsigned sel = SELT[((size_t)b * H + h) * T + t]; const int cnt = __popc(sel);
        const size_t base = ((size_t)m * H + h) * 4;
        float ms[4], ls[4]; float mstar = -INFINITY;
#pragma unroll
        for (int s = 0; s < 4; ++s) { const bool on = (s == 3) || (s < cnt); ms[s] = on ? ML[(base + s) * 2] : -INFINITY; ls[s] = on ? ML[(base + s) * 2 + 1] : 0.f; mstar = fmaxf(mstar, ms[s]); }
        float wsum = 0.f, w[4];
#pragma unroll
        for (int s = 0; s < 4; ++s) { w[s] = ls[s] * __builtin_amdgcn_exp2f(ms[s] - mstar); wsum += w[s]; }
        const float rw = 1.0f / wsum;
        float acc[16];
#pragma unroll
        for (int i = 0; i < 16; ++i) acc[i] = 0.f;
#pragma unroll
        for (int s = 0; s < 4; ++s) { const bool on = (s == 3) || (s < cnt);
            if (on) { const float ws_ = w[s] * rw; const v4u a = *(const v4u*)(PO + (base + s) * 64 + qd * 16), c = *(const v4u*)(PO + (base + s) * 64 + qd * 16 + 8);
                const unsigned wv[8] = {a.x, a.y, a.z, a.w, c.x, c.y, c.z, c.w};
#pragma unroll
                for (int i = 0; i < 8; ++i) { acc[2 * i] += ws_ * __uint_as_float(wv[i] << 16); acc[2 * i + 1] += ws_ * __uint_as_float(wv[i] & 0xffff0000u); } } }
        v4u o0, o1; o0.x = pk2(acc[0], acc[1]); o0.y = pk2(acc[2], acc[3]); o0.z = pk2(acc[4], acc[5]); o0.w = pk2(acc[6], acc[7]); o1.x = pk2(acc[8], acc[9]); o1.y = pk2(acc[10], acc[11]); o1.z = pk2(acc[12], acc[13]); o1.w = pk2(acc[14], acc[15]);
        *(v4u*)(O + (size_t)m * D + h * 64 + qd * 16) = o0; *(v4u*)(O + (size_t)m * D + h * 64 + qd * 16 + 8) = o1;
    }
}
constexpr int WK_REC = 10496;
__device__ __forceinline__ void wkv_build_phase(Frame& F, const bf16* R, const float* DEC, const bf16* KP, const bf16* AP, const bf16* BP, unsigned char* REC0, unsigned char* REC1) {
    LAS unsigned char* L = F.lds + RING_OFF + F.wave * 16384;
    LAS unsigned short* tA = (LAS unsigned short*)L; LAS unsigned short* tB = tA + 1024; LAS unsigned short* tK = tA + 2048; LAS unsigned short* tR = tA + 3072;
    LAS float* fLab = (LAS float*)(L + 8192); LAS float* fLak = fLab + 256; LAS float* fT = fLab + 512;
    const int lane = F.lane, c = lane & 15, g = lane >> 4;
    float rw[16]; unsigned short rk[16], ra[16], rb[16], rr_[16];
#define WB_LOAD(u_) do { const int ch_ = (u_) & 511, bh_ = (u_) >> 9; const size_t base_ = ((size_t)(bh_ >> 4) * T + (size_t)ch_ * 16) * D + (bh_ & 15) * 64 + lane; \
        _Pragma("unroll") for (int t = 0; t < 16; ++t) { const size_t o = base_ + (size_t)t * D; rw[t] = DEC[o]; rk[t] = KP[o]; ra[t] = AP[o]; rb[t] = BP[o]; rr_[t] = R[o]; } } while (0)
    if (F.gw < 2 * H * 512) WB_LOAD(F.gw);
    for (int u = F.gw; u < 2 * H * 512; u += F.NGW) {
        const int ch = u & 511, bh = u >> 9, b = bh >> 4, h = bh & 15;
        unsigned char* rec = (b ? REC1 : REC0) + ((size_t)h * 512 + ch) * WK_REC;
        float Af[16], Bf[16], Kf[16], Rf[16]; float gm = 1.f;
#pragma unroll
        for (int t = 0; t < 16; ++t) {
            const float w = rw[t], kp = bf2f(rk[t]), ap = bf2f(ra[t]), bp = bf2f(rb[t]), rr = bf2f(rr_[t]);
            Af[t] = ap * gm; gm *= w; const float inv = __builtin_amdgcn_rcpf(gm); Bf[t] = bp * inv; Kf[t] = kp * inv; Rf[t] = rr * gm;
            tA[t * 64 + lane] = (unsigned short)f2bf(Af[t]); tB[t * 64 + lane] = (unsigned short)f2bf(Bf[t]); tK[t * 64 + lane] = (unsigned short)f2bf(Kf[t]); tR[t * 64 + lane] = (unsigned short)f2bf(Rf[t]); }
        if (u + F.NGW < 2 * H * 512) WB_LOAD(u + F.NGW);
        *(float*)(rec + 10240 + lane * 4) = gm;
#pragma unroll
        for (int gq = 0; gq < 4; ++gq) { v4u o; o.x = pk2(Bf[4 * gq], Bf[4 * gq + 1]); o.y = pk2(Bf[4 * gq + 2], Bf[4 * gq + 3]); o.z = pk2(Kf[4 * gq], Kf[4 * gq + 1]); o.w = pk2(Kf[4 * gq + 2], Kf[4 * gq + 3]);
            *(v4u*)(rec + 6144 + lane * 64 + gq * 16) = o; }
        LDS_WAIT(); asm volatile("" ::: "memory");
        pg8::f32x4 lab = {0.f, 0.f, 0.f, 0.f}, lak = lab, mrb = lab, mrk = lab;
#pragma unroll
        for (int s = 0; s < 2; ++s) { const int o = c * 64 + 8 * g + 32 * s;
            const bf16x8 fa = *(const LAS bf16x8*)(tA + o), fb = *(const LAS bf16x8*)(tB + o), fk = *(const LAS bf16x8*)(tK + o), fr = *(const LAS bf16x8*)(tR + o);
            lab = __builtin_amdgcn_mfma_f32_16x16x32_bf16(fa, fb, lab, 0, 0, 0); lak = __builtin_amdgcn_mfma_f32_16x16x32_bf16(fa, fk, lak, 0, 0, 0);
            mrb = __builtin_amdgcn_mfma_f32_16x16x32_bf16(fr, fb, mrb, 0, 0, 0); mrk = __builtin_amdgcn_mfma_f32_16x16x32_bf16(fr, fk, mrk, 0, 0, 0); }
#pragma unroll
        for (int r = 0; r < 4; ++r) { const int t = 4 * g + r; if (!(c < t)) { lab[r] = 0.f; lak[r] = 0.f; } if (!(c <= t)) { mrb[r] = 0.f; mrk[r] = 0.f; }
            fLab[t * 16 + c] = lab[r]; fLak[t * 16 + c] = lak[r]; }
        LDS_WAIT(); asm volatile("" ::: "memory");
        float Tc[16];
#pragma unroll
        for (int i = 0; i < 16; ++i) { float a_ = (i == c) ? 1.f : 0.f;
#pragma unroll
            for (int j = 0; j < i; ++j) a_ += fLab[i * 16 + j] * Tc[j];
            Tc[i] = a_; }
        if (g == 0) {
#pragma unroll
            for (int i = 0; i < 16; ++i) fT[i * 16 + c] = Tc[i]; }
        LDS_WAIT(); asm volatile("" ::: "memory");
        { const int kt = lane >> 4, gq = (lane >> 2) & 3, jj = lane & 3, slot = (kt >> 1) * 1024 + gq * 16 + (jj + 4 * (kt & 1)) * 2;
#pragma unroll
          for (int t = 0; t < 16; ++t) { float w_ = 0.f;
#pragma unroll
              for (int j = 0; j <= t; ++j) w_ += fT[t * 16 + j] * Af[j];
              *(unsigned short*)(rec + slot + t * 64) = (unsigned short)f2bf(w_); *(unsigned short*)(rec + 3072 + slot + t * 64) = (unsigned short)f2bf(Rf[t]); } }
        { const int gq = c >> 2, jq = c & 3;
#pragma unroll
          for (int r = 0; r < 4; ++r) { const int t = 4 * g + r; float tl = 0.f;
#pragma unroll
              for (int j = 0; j < 16; ++j) tl += fT[t * 16 + j] * fLak[j * 16 + c];
              unsigned char* p = rec + 2048 + t * 64 + gq * 16;
              *(unsigned short*)(p + jq * 2) = (unsigned short)f2bf(tl); *(unsigned short*)(p + 8 + jq * 2) = 0;
              *(unsigned short*)(p + 3072 + jq * 2) = (unsigned short)f2bf(mrb[r]); *(unsigned short*)(p + 3072 + 8 + jq * 2) = (unsigned short)f2bf(mrk[r]); } }
        LDS_WAIT(); asm volatile("" ::: "memory");
    }
#undef WB_LOAD
}
__device__ __forceinline__ void wkv_chain_phase(Frame& F, const unsigned char* REC0, const unsigned char* REC1, const bf16* VP, bf16* Y) {
    if (F.vcu >= 32) return;
    constexpr int GC = 4, GB = GC * WK_REC  , VBOFF = GB, BUFB = GB + 8192  , YB_OFF = 2 * BUFB, NG = 512 / GC;
    const int b = F.vcu >> 4, h = F.vcu & 15, lane = F.lane, c = lane & 15, g = lane >> 4, vt = F.wave;
    const unsigned char* rbase = (b ? REC1 : REC0) + (size_t)h * 512 * WK_REC; const size_t rowb = (size_t)b * T;
    LAS unsigned char* L = F.lds + RING_OFF;
    constexpr int NP = (GB / 16 + 511) / 512;
    struct Stg { v4u p[NP]; v4u v; };
    Stg g0, g1;
#define WK_LOAD(gi, G) do { const unsigned char* s_ = rbase + (size_t)(gi) * GB; _Pragma("unroll") for (int i = 0; i < NP; ++i) { const int o_ = (F.tid + i * 512) * 16; G.p[i] = *(const v4u*)(s_ + (o_ < GB ? o_ : 0)); }   \
        G.v = *(const v4u*)(VP + (rowb + (size_t)(gi) * 64 + (F.tid >> 3)) * D + h * 64 + (F.tid & 7) * 8); } while (0)
#define WK_STORE(bf, G) do { _Pragma("unroll") for (int i = 0; i < NP; ++i) { const int o_ = (F.tid + i * 512) * 16; if (o_ < GB) *(LAS v4u*)(L + (bf) * BUFB + o_) = G.p[i]; } \
        { const int t_ = F.tid >> 3, v0_ = (F.tid & 7) * 8; LAS unsigned short* d_ = (LAS unsigned short*)(L + (bf) * BUFB + VBOFF) + ((((t_ >> 4) * 4) * 4 + ((t_ >> 2) & 3)) * 16) * 4 + (t_ & 3); \
          const unsigned w_[4] = {G.v.x, G.v.y, G.v.z, G.v.w}; \
          _Pragma("unroll") for (int e = 0; e < 8; ++e) { const int v_ = v0_ + e; d_[((v_ >> 4) * 64 + (v_ & 15)) * 4] = (unsigned short)((e & 1) ? (w_[e >> 1] >> 16) : (w_[e >> 1] & 0xffffu)); } } } while (0)
    WK_LOAD(0, g0); WK_STORE(0, g0); WK_LOAD(1, g0); __syncthreads();
    pg8::f32x4 Hs[4]; Hs[0] = (pg8::f32x4){0.f, 0.f, 0.f, 0.f}; Hs[1] = Hs[0]; Hs[2] = Hs[0]; Hs[3] = Hs[0];
    for (int g2 = 0; g2 < NG; g2 += 2) {
#pragma unroll
      for (int par = 0; par < 2; ++par) {
        const int gi = g2 + par, bf = par;
        { const int gl_ = gi + 2 < NG ? gi + 2 : NG - 1; if (par == 0) WK_LOAD(gl_, g1); else WK_LOAD(gl_, g0); }
        if (F.wave < 4) {
            struct Ops { bf16x8 au0, au1, au2, ay0, ay1, ay2, bk0, bk1, bk2, bk3; pg8::f32x4 ga0, ga1, ga2, ga3; u32x2 vb; };
            const int ao = (c * 32 + g * 8) * 2;
#define WK_FETCH(ci_, X) do { const LAS unsigned char* rec_ = L + bf * BUFB + (ci_) * WK_REC; \
                X.au0 = *(const LAS bf16x8*)(rec_ + ao); X.au1 = *(const LAS bf16x8*)(rec_ + 1024 + ao); X.au2 = *(const LAS bf16x8*)(rec_ + 2048 + ao); \
                X.ay0 = *(const LAS bf16x8*)(rec_ + 3072 + ao); X.ay1 = *(const LAS bf16x8*)(rec_ + 4096 + ao); X.ay2 = *(const LAS bf16x8*)(rec_ + 5120 + ao); \
                X.bk0 = *(const LAS bf16x8*)(rec_ + 6144 + ao); X.bk1 = *(const LAS bf16x8*)(rec_ + 7168 + ao); X.bk2 = *(const LAS bf16x8*)(rec_ + 8192 + ao); X.bk3 = *(const LAS bf16x8*)(rec_ + 9216 + ao); \
                X.ga0 = *(const LAS pg8::f32x4*)(rec_ + 10240 + (4 * g) * 4); X.ga1 = *(const LAS pg8::f32x4*)(rec_ + 10240 + (16 + 4 * g) * 4); X.ga2 = *(const LAS pg8::f32x4*)(rec_ + 10240 + (32 + 4 * g) * 4); X.ga3 = *(const LAS pg8::f32x4*)(rec_ + 10240 + (48 + 4 * g) * 4); \
                X.vb = *(const LAS u32x2*)(L + bf * BUFB + VBOFF + (((((ci_) * 4 + vt) * 4 + g) * 16 + c) * 8)); } while (0)
            Ops cu; WK_FETCH(0, cu);
#pragma unroll
            for (int ci = 0; ci < GC; ++ci) {
                Ops nx = cu;
                if (ci + 1 < GC) WK_FETCH(ci + 1, nx);
                v4u h0, h1; h0.x = attn_body::cvtpk_s(Hs[0][0], Hs[0][1]); h0.y = attn_body::cvtpk_s(Hs[0][2], Hs[0][3]); h0.z = attn_body::cvtpk_s(Hs[1][0], Hs[1][1]); h0.w = attn_body::cvtpk_s(Hs[1][2], Hs[1][3]);
                h1.x = attn_body::cvtpk_s(Hs[2][0], Hs[2][1]); h1.y = attn_body::cvtpk_s(Hs[2][2], Hs[2][3]); h1.z = attn_body::cvtpk_s(Hs[3][0], Hs[3][1]); h1.w = attn_body::cvtpk_s(Hs[3][2], Hs[3][3]);
                const bf16x8 hb0 = __builtin_bit_cast(bf16x8, h0), hb1 = __builtin_bit_cast(bf16x8, h1);
                v4u vz; vz.x = cu.vb.x; vz.y = cu.vb.y; vz.z = 0u; vz.w = 0u;
                const pg8::f32x4 z4 = {0.f, 0.f, 0.f, 0.f};
                const pg8::f32x4 ua = __builtin_amdgcn_mfma_f32_16x16x32_bf16(cu.au0, hb0, z4, 0, 0, 0), ub_ = __builtin_amdgcn_mfma_f32_16x16x32_bf16(cu.au1, hb1, z4, 0, 0, 0),
                                 uc = __builtin_amdgcn_mfma_f32_16x16x32_bf16(cu.au2, __builtin_bit_cast(bf16x8, vz), z4, 0, 0, 0);
                pg8::f32x4 yt = __builtin_amdgcn_mfma_f32_16x16x32_bf16(cu.ay0, hb0, z4, 0, 0, 0);
                yt = __builtin_amdgcn_mfma_f32_16x16x32_bf16(cu.ay1, hb1, yt, 0, 0, 0);
                const pg8::f32x4 ut = (ua + ub_) + uc;
                v4u ubw; ubw.x = attn_body::cvtpk_s(ut[0], ut[1]); ubw.y = attn_body::cvtpk_s(ut[2], ut[3]); ubw.z = cu.vb.x; ubw.w = cu.vb.y;
                const bf16x8 ub = __builtin_bit_cast(bf16x8, ubw);
                Hs[0] = __builtin_amdgcn_mfma_f32_16x16x32_bf16(cu.bk0, ub, Hs[0], 0, 0, 0); Hs[1] = __builtin_amdgcn_mfma_f32_16x16x32_bf16(cu.bk1, ub, Hs[1], 0, 0, 0);
                Hs[2] = __builtin_amdgcn_mfma_f32_16x16x32_bf16(cu.bk2, ub, Hs[2], 0, 0, 0); Hs[3] = __builtin_amdgcn_mfma_f32_16x16x32_bf16(cu.bk3, ub, Hs[3], 0, 0, 0);
                yt = __builtin_amdgcn_mfma_f32_16x16x32_bf16(cu.ay2, ub, yt, 0, 0, 0);
                Hs[0] = Hs[0] * cu.ga0; Hs[1] = Hs[1] * cu.ga1; Hs[2] = Hs[2] * cu.ga2; Hs[3] = Hs[3] * cu.ga3;
                LAS unsigned short* yb = (LAS unsigned short*)(L + YB_OFF + bf * 8192) + (ci * 16 + 4 * g) * 64 + vt * 16 + c;
#pragma unroll
                for (int r = 0; r < 4; ++r) yb[r * 64] = (unsigned short)f2bf(yt[r]);
                cu = nx;
            }
#undef WK_FETCH
        }
        if (gi + 1 < NG) { if (par == 0) WK_STORE(1, g0); else WK_STORE(0, g1); }
        __syncthreads();
        { const v4u yv = *(const LAS v4u*)(L + YB_OFF + bf * 8192 + F.tid * 16);
          *(v4u*)(Y + (rowb + (size_t)gi * 64 + (F.tid >> 3)) * D + h * 64 + (F.tid & 7) * 8) = yv; }
      }
    }
#undef WK_LOAD
#undef WK_STORE
}


#ifdef DBG_CUT
__device__ __forceinline__ void dbg_copy(Frame& F, const void* src, bool is_bf16, float* out) {
    for (size_t i = (size_t)F.gw * 64 + F.lane; i < (size_t)M * D; i += (size_t)F.NGW * 64) out[i] = is_bf16 ? bf2f(((const bf16*)src)[i]) : ((const float*)src)[i];
}
#ifndef DBG_LAYER
#define DBG_LAYER -1
#endif
#ifndef DBG_SCALE
#define DBG_SCALE 100.f
#define DBG_SUB 1.f
#endif
#define CUT(k, off, isbf) if (DBG_CUT == (k) && (DBG_LAYER < 0 || layer == DBG_LAYER)) { unsigned char* ws = WSB(); dbg_copy(F, ws + (off), (isbf), GOUT()); return; }
#else
#define CUT(k, off, isbf)
#endif
#ifndef REP_GEMM
#define REP_GEMM 1
#endif
#ifndef REP_THIN
#define REP_THIN 1
#endif
#ifndef REP_CONV
#define REP_CONV REP_THIN
#endif
#ifndef REP_LN
#define REP_LN REP_THIN
#endif
#ifndef REP_RW
#define REP_RW REP_THIN
#endif
#ifndef REP_ATTN
#define REP_ATTN 1
#endif
#ifndef REP_SCAN
#define REP_SCAN 1
#endif
#ifndef REP_WKB
#define REP_WKB 1
#endif
#ifndef REP_WKC
#define REP_WKC 1
#endif
#ifndef REP_BAR
#define REP_BAR 1
#endif
#define GEMM_BIG(EpiT, SchedT) for (int rg_ = 0; rg_ < REP_GEMM; ++rg_) pg8::gemm_phase<EpiT, SchedT, true, true>
#define GEMM_ONE(EpiT, SchedT) for (int rg_ = 0; rg_ < REP_GEMM; ++rg_) pg8::gemm_phase<EpiT, SchedT, false, true>
__global__ void __launch_bounds__(NWAVES * 64, 2) fwd_kernel(Args args) {
    extern __shared__ __attribute__((aligned(16))) unsigned char lds[];
    Frame F;
    F.lds = (LAS unsigned char*)lds; F.MISC = (volatile LAS unsigned*)(F.lds + MISC_OFF);
    F.wave = __builtin_amdgcn_readfirstlane((int)threadIdx.x >> 6); F.lane = fresh_lane(); F.tid = F.wave * 64 + F.lane;
    F.G = gridDim.x; { const int bx = blockIdx.x; F.vcu = (F.G % 8 == 0) ? (bx % 8) * (F.G / 8) + bx / 8 : bx; }
    F.gw = F.vcu * NWAVES + F.wave; F.NGW = F.G * NWAVES;
    F.ws = args.ws; F.ctl = (gu32*)(args.ws + WS_CTL);
#ifdef DBG_LDSZERO
    for (int u = F.tid; u < LDS_BYTES / 4; u += NWAVES * 64) ((LAS unsigned*)(F.lds))[u] = 0u;
#else
    for (int u = F.tid; u < (LDS_BYTES - LDSCTL_OFF) / 4; u += NWAVES * 64) ((LAS unsigned*)(F.lds + LDSCTL_OFF))[u] = 0u;
#endif
    __syncthreads();
    XcdBarrier bar = xcd_barrier_post((unsigned*)(F.ctl + CW_BAR), F.MISC + 8, F.tid == 0);
#define GRID_BAR() do { { GAS unsigned* b_ = (GAS unsigned*)bar.bar; asm volatile("" : "+s"(b_), "+s"(bar.x)); bar.bar = (unsigned*)b_; } for (int rb_ = 0; rb_ < REP_BAR; ++rb_) xcd_barrier(bar, F.wave == 0 && fresh_lane() == 0); } while (0)
#define WSB() ({ F.lane = fresh_lane(); F.tid = F.wave * 64 + F.lane; asm volatile("" : "+s"(F.G), "+s"(F.wave), "+s"(F.vcu), "+s"(F.gw), "+s"(F.NGW), "+s"(bx)); GAS unsigned char* p_ = (GAS unsigned char*)args.ws; asm volatile("" : "+s"(p_)); (unsigned char*)p_; })
#define GOUT() ({ GAS float* o_ = (GAS float*)args.out; asm volatile("" : "+s"(o_)); (float*)o_; })
#define INP(i) ({ const __attribute__((address_space(4))) char* k_ = (const __attribute__((address_space(4))) char*)__builtin_amdgcn_kernarg_segment_ptr(); asm volatile("" : "+s"(k_)); const GAS float* g_ = (const GAS float*)(*(const float* const __attribute__((address_space(4)))*)(k_ + 8 * (i))); asm volatile("" : "+s"(g_)); (const float*)g_; })
    LAS unsigned char* ring = F.lds + RING_OFF;
    int bx = (int)blockIdx.x;

    for (int rt_ = 0; rt_ < REP_CONV; ++rt_) conv_rwkv(F, 0); for (int rt_ = 0; rt_ < REP_CONV; ++rt_) conv_dense(F, 0);
    { unsigned char* ws = WSB(); for (int rt_ = 0; rt_ < REP_RW; ++rt_) mix_phase(F, INP(I_X), INP(I_MU), (bf16*)(ws + RS_XM)); }
    GRID_BAR();

#ifndef LAYER_LO
#define LAYER_LO 0
#define LAYER_HI 4
#endif
    for (int layer = LAYER_LO; layer < LAYER_HI; ++layer) {
        const bool moe = (layer & 1) != 0; const int fe = layer >> 1;
        if (layer < 2) {
            const int l = layer;
            if (l > 0) { { unsigned char* ws = WSB(); for (int rt_ = 0; rt_ < REP_RW; ++rt_) mix_phase(F, (const float*)(ws + WS_H), INP(I_MU) + (size_t)l * 6 * D, (bf16*)(ws + RS_XM)); }
              GRID_BAR(); }
            { unsigned char* ws = WSB(); pg8::Gemm g{D, D, D}; pg8::SchedStd S; S.init(M, 4096, F.G, bx, ws + RS_XM, D, ws + WM_BT1 + (size_t)l * RW_LSTRIDE, D, 1, (size_t)M * D * 2);
              pg8::EpiRkv E{(bf16*)(ws + RS_RKV), (long)RS_LH - (long)RS_RKV, (size_t)M * D};
              GEMM_BIG(pg8::EpiRkv, pg8::SchedStd)(ring, g, S, E, F.wave); }
            GRID_BAR();
            CUT(1, RS_RKV, true)
            { unsigned char* ws = WSB(); pg8::Gemm g{256, D, 256}; pg8::SchedStd S; S.init(M, 3072, F.G, bx, ws + RS_LH, D, ws + WM_BT2 + (size_t)l * RW_LSTRIDE, 256, 2, 0);
              pg8::EpiLoraUpAll E{{(void*)(ws + RS_DEC), INP(I_W0) + (size_t)l * D}, {(void*)(ws + RS_AB), INP(I_A0) + (size_t)l * D}, {(void*)(ws + RS_VG), INP(I_V0)}, {(void*)(ws + RS_GG), nullptr}};
              GEMM_BIG(pg8::EpiLoraUpAll, pg8::SchedStd)(ring, g, S, E, F.wave); }
            GRID_BAR();
            CUT(2, RS_DEC, false) CUT(60, RS_VG, true) CUT(61, RS_GG, true) CUT(62, RS_LH, true) CUT(63, RS_AB, false)
            { unsigned char* ws = WSB(); for (int rt_ = 0; rt_ < REP_RW; ++rt_) prep_phase(F, l, (bf16*)(ws + RS_RKV), (const float*)(ws + RS_AB), (bf16*)(ws + RS_LH), INP(I_V0), INP(I_V2), (bf16*)(ws + WS_VFIRST), INP(I_KK) + (size_t)l * D, INP(I_KA) + (size_t)l * D,
                                                   (bf16*)(ws + RS_KP), (bf16*)(ws + RS_AP), (bf16*)(ws + RS_BP), (bf16*)(ws + RS_VP)); }
            GRID_BAR();
            CUT(3, RS_KP, true) CUT(7, RS_VP, true) CUT(8, RS_BP, true) CUT(9, RS_DEC, false)
#ifdef WKV_SEQ
            for (int rep_ = 0; rep_ < REP_SCAN; ++rep_) {
              { unsigned char* ws = WSB(); scan_phase(F, (bf16*)(ws + RS_RKV), (float*)(ws + RS_DEC), (bf16*)(ws + RS_KP), (bf16*)(ws + RS_AP), (bf16*)(ws + RS_BP), (bf16*)(ws + RS_VP), (bf16*)(ws + WS_Y)); }
              if (rep_ + 1 < REP_SCAN) GRID_BAR(); }
            GRID_BAR();
#else
            { unsigned char* ws = WSB(); for (int rq_ = 0; rq_ < REP_WKB; ++rq_) wkv_build_phase(F, (bf16*)(ws + RS_RKV), (float*)(ws + RS_DEC), (bf16*)(ws + RS_KP), (bf16*)(ws + RS_AP), (bf16*)(ws + RS_BP), ws + RS_REC0, ws + RS_REC1); }
            GRID_BAR();
#ifdef DBG_CUT
            if (DBG_CUT == 39 && (DBG_LAYER < 0 || layer == DBG_LAYER)) { unsigned char* ws = WSB(); const unsigned short* s_ = (const unsigned short*)(ws + RS_REC0); float* o_ = GOUT();
                for (size_t i = (size_t)F.gw * 64 + F.lane; i < (size_t)M * D; i += (size_t)F.NGW * 64) o_[i] = (float)s_[i]; return; }
#endif
            const int vcu_keep_ = F.vcu; F.vcu = bx;
            { unsigned char* ws = WSB(); for (int rq_ = 0; rq_ < REP_WKC; ++rq_) wkv_chain_phase(F, ws + RS_REC0, ws + RS_REC1, (bf16*)(ws + RS_VP), (bf16*)(ws + WS_Y)); }
            if (F.vcu >= 32) {
                const int gw_ = F.gw, ngw_ = F.NGW; F.gw = (F.vcu - 32) * NWAVES + F.wave; F.NGW = (F.G - 32) * NWAVES;
                for (int rt_ = 0; rt_ < REP_CONV; ++rt_) { if (l == 0) { conv_rwkv(F, 1); conv_moe(F, 0); } else { conv_moe(F, 1); conv_dense(F, 1); conv_moba(F, 0); conv_moba(F, 1); } }
                F.gw = gw_; F.NGW = ngw_; }
            F.vcu = vcu_keep_;
            GRID_BAR();
#endif
            CUT(4, WS_Y, true)
#ifdef DBG_CUT
            if (DBG_CUT == 38 && (DBG_LAYER < 0 || layer == DBG_LAYER)) {
                { unsigned char* ws = WSB(); scan_phase(F, (bf16*)(ws + RS_RKV), (float*)(ws + RS_DEC), (bf16*)(ws + RS_KP), (bf16*)(ws + RS_AP), (bf16*)(ws + RS_BP), (bf16*)(ws + RS_VP), (bf16*)(ws + WS_SCR + 128 * MiB)); }
                GRID_BAR();
                { unsigned char* ws = WSB(); const bf16* a_ = (const bf16*)(ws + WS_Y); const bf16* b_ = (const bf16*)(ws + WS_SCR + 128 * MiB); float* o_ = GOUT();
                  for (size_t i = (size_t)F.gw * 64 + F.lane; i < (size_t)M * D; i += (size_t)F.NGW * 64) { float d_ = DBG_SCALE * (bf2f(a_[i]) - DBG_SUB * bf2f(b_[i])); if (!(fabsf(d_) < 1e30f)) d_ = 1e6f; o_[i] = d_; } }
                return; }
#endif
            { unsigned char* ws = WSB(); for (int rt_ = 0; rt_ < REP_RW; ++rt_) post_phase(F, (bf16*)(ws + WS_Y), (bf16*)(ws + RS_RKV), (bf16*)(ws + RS_KP), (bf16*)(ws + RS_VP), (bf16*)(ws + RS_GG),
                                                   INP(I_RK) + (size_t)l * D, INP(I_GNG) + (size_t)l * D, INP(I_GNB) + (size_t)l * D, (bf16*)(ws + RS_YG)); }
            GRID_BAR();
            CUT(5, RS_YG, true)
            { unsigned char* ws = WSB(); pg8::Gemm g{D, D, D}; pg8::SchedStd S; S.init(M, D, F.G, bx, ws + RS_YG, D, ws + WM_OUT + (size_t)l * RW_LSTRIDE, D);
              pg8::EpiResF32 E{layer == 0 ? INP(I_X) : (const float*)(ws + WS_H), (float*)(ws + RS_PRE), ALPHA};
              GEMM_ONE(pg8::EpiResF32, pg8::SchedStd)(ring, g, S, E, F.wave); }
            GRID_BAR();
            CUT(6, RS_PRE, false)
        } else {
            const int j = layer - 2;
            { unsigned char* ws = WSB(); pg8::Gemm g{D, D, D}; pg8::SchedStd S; S.init(M, j == 0 ? 3 * D : D, F.G, bx, ws + WS_HB, D, ws + (j == 0 ? WM_QKV : WM_Q3), D);
              pg8::EpiQKV E{(bf16*)(ws + BS_Q), ((long)WS_K - (long)BS_Q) / 2, ((long)WS_V - (long)BS_Q) / 2, attn_body::C2};
              GEMM_BIG(pg8::EpiQKV, pg8::SchedStd)(ring, g, S, E, F.wave); }
            GRID_BAR();
            CUT(31, BS_Q, true) CUT(32, WS_K, true) CUT(33, WS_V, true)
            if (j == 0) { unsigned char* ws = WSB(); for (int rt_ = 0; rt_ < REP_THIN; ++rt_) kmean_phase(F, (bf16*)(ws + WS_K), (float*)(ws + WS_KMEAN)); GRID_BAR(); }
#ifndef NO_GATE
            { unsigned char* ws = WSB(); for (int rt_ = 0; rt_ < REP_THIN; ++rt_) gate_phase(F, (bf16*)(ws + BS_Q), (float*)(ws + WS_KMEAN), (unsigned*)(ws + WS_SEL)); }
#endif
            GRID_BAR();
#ifdef DBG_CUT
            if (DBG_CUT == 35) { unsigned char* ws = WSB(); const unsigned* s_ = (const unsigned*)(ws + WS_SEL); for (size_t i = (size_t)F.gw * 64 + F.lane; i < (size_t)M * D; i += (size_t)F.NGW * 64) args.out[i] = (float)(s_[i & (size_t)(M * 16 - 1)] % 65521u); return; }
#endif
#ifdef ATTN_DIRECT
            { unsigned char* ws = WSB(); attn_direct_phase(F, (const bf16*)(ws + BS_Q), (const bf16*)(ws + WS_K), (const bf16*)(ws + WS_V), (const unsigned*)(ws + WS_SEL), (bf16*)(ws + BS_O)); }
            GRID_BAR();
#else
            { unsigned char* ws = WSB(); for (int ra_ = 0; ra_ < REP_ATTN; ++ra_) moba_attn_phase(F, (const bf16*)(ws + BS_Q), (const bf16*)(ws + WS_K), (const bf16*)(ws + WS_V), (const unsigned*)(ws + WS_SEL), (bf16*)(ws + BS_PO), (float*)(ws + BS_ML), F.ctl + CW_QCTR + 64 * (j + 2 * ra_)); }
            GRID_BAR();
            { unsigned char* ws = WSB(); for (int rt_ = 0; rt_ < REP_THIN; ++rt_) moba_combine_phase(F, (const unsigned*)(ws + WS_SEL), (const bf16*)(ws + BS_PO), (const float*)(ws + BS_ML), (bf16*)(ws + BS_O)); }
            GRID_BAR();
#endif
            CUT(36, BS_O, true)
#ifdef DBG_CUT
            if (DBG_CUT == 37 && (DBG_LAYER < 0 || layer == DBG_LAYER)) {
                { unsigned char* ws = WSB(); attn_direct_phase(F, (const bf16*)(ws + BS_Q), (const bf16*)(ws + WS_K), (const bf16*)(ws + WS_V), (const unsigned*)(ws + WS_SEL), (bf16*)(ws + BS_PRE)); }
                GRID_BAR();
                { unsigned char* ws = WSB(); const bf16* a_ = (const bf16*)(ws + BS_O); const bf16* b_ = (const bf16*)(ws + BS_PRE); float* o_ = GOUT();
                  for (size_t i = (size_t)F.gw * 64 + F.lane; i < (size_t)M * D; i += (size_t)F.NGW * 64) o_[i] = 1000.f * (bf2f(a_[i]) - bf2f(b_[i])); }
                return; }
#endif
            { unsigned char* ws = WSB(); pg8::Gemm g{D, D, D}; pg8::SchedStd S; S.init(M, D, F.G, bx, ws + BS_O, D, ws + (j == 0 ? WM_O : WM_O3), D);
              pg8::EpiResF32 E{(const float*)(ws + WS_H), (float*)(ws + BS_PRE), ALPHA};
              GEMM_ONE(pg8::EpiResF32, pg8::SchedStd)(ring, g, S, E, F.wave); }
            GRID_BAR();
        }
        { unsigned char* ws = WSB(); const float* PREm = (const float*)(ws + (layer < 2 ? RS_PRE : BS_PRE));
          const float* g0 = INP(I_LNG) + (size_t)(layer * 2) * D; const float* b0 = INP(I_LNB) + (size_t)(layer * 2) * D;
          if (moe) for (int rt_ = 0; rt_ < REP_LN; ++rt_) ln_phase<0, true>(F, PREm, nullptr, nullptr, nullptr, g0, b0, (float*)(ws + WS_H), (bf16*)(ws + WS_HB), INP(I_ROUTER) + (size_t)fe * D * NE, (int*)(ws + WS_TOKE), (float*)(ws + WS_TOKW), (int*)(ws + WS_BLKCNT));
          else for (int rt_ = 0; rt_ < REP_LN; ++rt_) ln_phase<0, false>(F, PREm, nullptr, nullptr, nullptr, g0, b0, (float*)(ws + WS_H), (bf16*)(ws + WS_HB), nullptr, nullptr, nullptr, nullptr); }
        GRID_BAR();
        CUT(10 + layer, WS_H, false)
        if (!moe) {
            { unsigned char* ws = WSB(); pg8::Gemm g{D, D, D}; pg8::SchedStd S; S.init(M, 2 * FF, F.G, bx, ws + WS_HB, D, ws + WF_GU, D);
              pg8::EpiSwiGLU E{(void*)(ws + FS_HID), FF, 1.0f, 1.0f};
              GEMM_BIG(pg8::EpiSwiGLU, pg8::SchedStd)(ring, g, S, E, F.wave); }
            GRID_BAR();
            { unsigned char* ws = WSB(); pg8::Gemm g{FF, FF, FF}; pg8::SchedStd S; S.init(M, D, F.G, bx, ws + FS_HID, FF, ws + WF_DN, FF);
              pg8::EpiResF32 E{(const float*)(ws + WS_H), (float*)(ws + FS_PRE), ALPHA};
              GEMM_ONE(pg8::EpiResF32, pg8::SchedStd)(ring, g, S, E, F.wave); }
            GRID_BAR();
            { unsigned char* ws = WSB(); const float* g1 = INP(I_LNG) + (size_t)(layer * 2 + 1) * D; const float* b1 = INP(I_LNB) + (size_t)(layer * 2 + 1) * D;
              for (int rt_ = 0; rt_ < REP_LN; ++rt_) ln_phase<0, false>(F, (const float*)(ws + FS_PRE), nullptr, nullptr, nullptr, g1, b1, (float*)(ws + WS_H), (bf16*)(ws + WS_HB), nullptr, nullptr, nullptr, nullptr); }
            GRID_BAR();
        } else {
            { unsigned char* ws = WSB(); for (int rt_ = 0; rt_ < REP_THIN; ++rt_) moe_gather_phase(F, (const int*)(ws + WS_BLKCNT), (const int*)(ws + WS_TOKE), (const float*)(ws + WS_TOKW), (int*)(ws + WS_TOKR), (float*)(ws + WS_GW), (const float*)(ws + WS_H), (unsigned char*)(ws + ES_XG)); }
            GRID_BAR();
            { unsigned char* ws = WSB(); const LAS int* pp = (const LAS int*)(F.lds + MISC_OFF + 64);
              pg8::Gemm g{D / 2, D / 2, D / 2};
              pg8::SchedMoe S{2 * FFE / 256, F.G, bx, pp, (const char*)(ws + ES_XG), (const char*)(ws + WE_GU + (size_t)fe * WE_SET), (size_t)256 * D, (size_t)256 * D, (size_t)2 * FFE * D, 0};
              pg8::EpiSwiGLUT<MOE_DOWN_F8 != 0> E{(void*)(ws + ES_HID), FFE, 1.0f / MOE_WSCALE, MOE_HSCALE};
              for (int rg_ = 0; rg_ < REP_GEMM; ++rg_) pg8::gemm_phase<pg8::EpiSwiGLUT<MOE_DOWN_F8 != 0>, pg8::SchedMoe, true, true, true>(ring, g, S, E, F.wave); }
            GRID_BAR();
            { unsigned char* ws = WSB(); const LAS int* pp = (const LAS int*)(F.lds + MISC_OFF + 64);
#if MOE_DOWN_F8
              { pg8::Gemm g{FFE / 2, FFE / 2, FFE / 2}; pg8::SchedMoe S{D / 256, F.G, bx, pp, (const char*)(ws + ES_HID), (const char*)(ws + WE_DN + (size_t)fe * WE_SET), (size_t)256 * FFE, (size_t)256 * FFE, (size_t)D * FFE, 2 * 256};
                pg8::EpiMoeDown E{(pg8::bf16_t*)(ws + ES_YP), (const float*)(ws + WS_GW), 1.0f / (MOE_HSCALE * MOE_DSCALE)};
                for (int rg_ = 0; rg_ < REP_GEMM; ++rg_) pg8::gemm_phase<pg8::EpiMoeDown, pg8::SchedMoe, true, true, true>(ring, g, S, E, F.wave); }
              { pg8::Gemm g{256, FFE / 2, FFE / 2}; pg8::SchedMoeTail S{D / 256, F.G, bx, 2 * 256, 7, pp, (const char*)(ws + ES_HID), (const char*)(ws + WE_DN + (size_t)fe * WE_SET), (size_t)256 * FFE, (size_t)256 * FFE, (size_t)D * FFE, (size_t)512};
                pg8::EpiMoeDownSlab E{(float*)(ws + ES_YS), (const float*)(ws + WS_GW), bx, 7, 1.0f / (MOE_HSCALE * MOE_DSCALE)};
                for (int rg_ = 0; rg_ < REP_GEMM; ++rg_) pg8::gemm_phase<pg8::EpiMoeDownSlab, pg8::SchedMoeTail, false, true, true>(ring, g, S, E, F.wave); } }
#else
              { pg8::Gemm g{FFE, FFE, FFE}; pg8::SchedMoe S{D / 256, F.G, bx, pp, (const char*)(ws + ES_HID), (const char*)(ws + WE_DN + (size_t)fe * WE_SET), (size_t)256 * FFE * 2, (size_t)256 * FFE * 2, (size_t)D * FFE * 2, 2 * 256};
                pg8::EpiMoeDown E{(pg8::bf16_t*)(ws + ES_YP), (const float*)(ws + WS_GW), 1.0f};
                GEMM_BIG(pg8::EpiMoeDown, pg8::SchedMoe)(ring, g, S, E, F.wave); }
              { pg8::Gemm g{512, FFE, FFE}; pg8::SchedMoeTail S{D / 256, F.G, bx, 2 * 256, 7, pp, (const char*)(ws + ES_HID), (const char*)(ws + WE_DN + (size_t)fe * WE_SET), (size_t)256 * FFE * 2, (size_t)256 * FFE * 2, (size_t)D * FFE * 2, (size_t)512 * 2};
                pg8::EpiMoeDownSlab E{(float*)(ws + ES_YS), (const float*)(ws + WS_GW), bx, 7, 1.0f};
                GEMM_ONE(pg8::EpiMoeDownSlab, pg8::SchedMoeTail)(ring, g, S, E, F.wave); } }
#endif
            GRID_BAR();
            { unsigned char* ws = WSB(); const float* g1 = INP(I_LNG) + (size_t)(layer * 2 + 1) * D; const float* b1 = INP(I_LNB) + (size_t)(layer * 2 + 1) * D;
              if (layer == 3) ln_phase<1, false>(F, (const float*)(ws + ES_YS), (const float*)(ws + WS_H), (const bf16*)(ws + ES_YP), (const int*)(ws + WS_TOKR), g1, b1, GOUT(), nullptr, nullptr, nullptr, nullptr, nullptr);
              else ln_phase<1, false>(F, (const float*)(ws + ES_YS), (const float*)(ws + WS_H), (const bf16*)(ws + ES_YP), (const int*)(ws + WS_TOKR), g1, b1, (float*)(ws + WS_H), (bf16*)(ws + WS_HB), nullptr, nullptr, nullptr, nullptr); }
            GRID_BAR();
        }
        CUT(20 + layer, WS_H, false)
        CUT(40 + layer, WS_HB, true)
#ifdef DBG_CUT
        if (DBG_CUT == 50 + layer) { unsigned char* ws = WSB(); const bf16* s_ = (const bf16*)(ws + WS_WMIX); float* o_ = GOUT(); for (size_t i = (size_t)F.gw * 64 + F.lane; i < (size_t)M * D; i += (size_t)F.NGW * 64) o_[i] = i < (size_t)6 * 1024 * 1024 ? bf2f(s_[i]) : 0.f; return; }
#endif
    }
}

extern "C" void kernel_launch(void* const* d_in, const int* in_sizes, int n_in, void* d_out, int out_size, void* d_ws, size_t ws_size, hipStream_t stream) {
    static int grid = 0;
    if (grid == 0) {
        if (n_in != 33 || in_sizes[0] != M * D || out_size != M * D || ws_size < WS_END) { fprintf(stderr, "kernel_launch: unexpected problem shape (n_in %d, in0 %d, out %d, ws %zu); nothing launched\n", n_in, n_in > 0 ? in_sizes[0] : -1, out_size, ws_size); grid = -1; return; }
        int dev = 0, cus = 0, per_cu = 0;
        if (hipGetDevice(&dev) != hipSuccess || hipDeviceGetAttribute(&cus, hipDeviceAttributeMultiprocessorCount, dev) != hipSuccess) { grid = -1; return; }
        if (hipFuncSetAttribute((const void*)fwd_kernel, hipFuncAttributeMaxDynamicSharedMemorySize, LDS_BYTES) != hipSuccess) { fprintf(stderr, "kernel_launch: hipFuncSetAttribute failed\n"); grid = -1; return; }
        if (hipOccupancyMaxActiveBlocksPerMultiprocessor(&per_cu, (const void*)fwd_kernel, NWAVES * 64, LDS_BYTES) != hipSuccess || per_cu < 1) { fprintf(stderr, "kernel_launch: occupancy query reports %d workgroups per CU\n", per_cu); }
        (void)hipGetLastError();
        grid = cus;
        if (grid != 256) { fprintf(stderr, "kernel_launch: built for 256 CUs, device has %d; nothing launched\n", cus); grid = -1; return; }
    }
    if (grid < 0) return;
    if (hipMemsetAsync((char*)d_ws + WS_CTL, 0, CTL_ZERO_BYTES, stream) != hipSuccess) return;
#ifdef DBG_FILL
    (void)hipMemsetAsync((char*)d_ws + CTL_ZERO_BYTES, DBG_FILL, WS_END - CTL_ZERO_BYTES, stream);
#endif
    Args a{};
    for (int i = 0; i < 33; ++i) a.in[i] = (const float*)d_in[i];
    a.out = (float*)d_out; a.ws = (unsigned char*)d_ws;
    hipLaunchKernelGGL(fwd_kernel, dim3(grid), dim3(NWAVES * 64), LDS_BYTES, stream, a);
}
```
